# Optimizing an MI355X kernel written in HIP

```python
import jax, jax.numpy as jnp
from jax import lax
import numpy as np

D_MODEL = 1024
BATCH = 8
SEQ = 2048
DEPTH = 1

PLE_DIM = 256
LRU_WIDTH = D_MODEL
LRU_BLOCKS = 16
LRU_BLOCK_DIM = LRU_WIDTH // LRU_BLOCKS
CONV_WIDTH = 4
LRU_C = 8.0
SGU_WIDTH = D_MODEL
SGU_GROUPS = 8
SGU_GROUP_DIM = SGU_WIDTH // SGU_GROUPS
CHUNK = 128
N_GROUPS = 4
EXPERTS_PER_GROUP = 8
N_EXPERTS = N_GROUPS * EXPERTS_PER_GROUP
TOP_K = 2
D_EXPERT = 256
EPS = 1e-6
IN_COLS = 2 * LRU_WIDTH + 2 * SGU_WIDTH + 2 * D_MODEL

kernel_name = "hybrid_rglru_sgu_hmoe_block"


def rmsnorm(x, g):
    xf = x.astype(jnp.float32)
    y = xf * lax.rsqrt(jnp.mean(xf * xf, axis=-1, keepdims=True) + EPS)
    return (y * g.astype(jnp.float32)).astype(x.dtype)


def layernorm(x, g, b):
    xf = x.astype(jnp.float32)
    mu = jnp.mean(xf, axis=-1, keepdims=True)
    xc = xf - mu
    y = xc * lax.rsqrt(jnp.mean(xc * xc, axis=-1, keepdims=True) + EPS)
    return (y * g.astype(jnp.float32) + b.astype(jnp.float32)).astype(x.dtype)


def causal_depthwise_conv(x, w, b):
    s = x.shape[1]
    xp = jnp.pad(x, ((0, 0), (CONV_WIDTH - 1, 0), (0, 0)))
    y = b
    for k in range(CONV_WIDTH):
        y = y + xp[:, k:k + s, :] * w[k]
    return y


def rg_lru(x, w_a, b_a, w_i, b_i, lam):
    bsz, s, w = x.shape
    xb = x.reshape(bsz, s, LRU_BLOCKS, LRU_BLOCK_DIM)
    r = jax.nn.sigmoid(jnp.einsum('bshi,hij->bshj', xb, w_a).reshape(bsz, s, w) + b_a)
    i = jax.nn.sigmoid(jnp.einsum('bshi,hij->bshj', xb, w_i).reshape(bsz, s, w) + b_i)
    log_a = -LRU_C * r.astype(jnp.float32) * jax.nn.softplus(-lam.astype(jnp.float32))
    a = jnp.exp(log_a)
    u = jnp.sqrt(-jnp.expm1(2.0 * log_a)) * (i * x).astype(jnp.float32)

    def combine(left, right):
        a1, b1 = left
        a2, b2 = right
        return a1 * a2, a2 * b1 + b2

    _, h = lax.associative_scan(combine, (a, u), axis=1)
    return h.astype(x.dtype)


def spatial_gating(z, ln_g, ln_b, w_s, b_s):
    bsz, s, _ = z.shape
    u, v = jnp.split(z, 2, axis=-1)
    v = layernorm(v, ln_g, ln_b)
    vb = v.reshape(bsz, s // CHUNK, CHUNK, SGU_GROUPS, SGU_GROUP_DIM)
    mask = jnp.tril(jnp.ones((CHUNK, CHUNK), dtype=bool))
    ws = jnp.where(mask[None], w_s, jnp.zeros_like(w_s))
    sp = jnp.einsum('gts,bcsgd->bctgd', ws, vb) + jnp.transpose(b_s)[None, None, :, :, None]
    return u * sp.reshape(bsz, s, SGU_WIDTH)


def hierarchical_moe(h, w_rg, b_rg, w_re, b_re, w1, w3, w2):
    bsz, s, d = h.shape
    t = h.reshape(bsz * s, d)
    n_tok = t.shape[0]
    g_prob = jax.nn.softmax((t @ w_rg + b_rg).astype(jnp.float32), axis=-1)
    g_top, g_idx = lax.top_k(g_prob, 1)
    e_logits = (t @ w_re + b_re).astype(jnp.float32).reshape(n_tok, N_GROUPS, EXPERTS_PER_GROUP)
    e_sel = jnp.take_along_axis(e_logits, g_idx[:, :, None], axis=1)[:, 0]
    e_prob = jax.nn.softmax(e_sel, axis=-1)
    e_top, e_idx = lax.top_k(e_prob, TOP_K)
    e_top = e_top / jnp.sum(e_top, axis=-1, keepdims=True)
    gate = g_top * e_top
    gid = g_idx * EXPERTS_PER_GROUP + e_idx
    combine = jnp.sum(jax.nn.one_hot(gid, N_EXPERTS, dtype=jnp.float32) * gate[..., None], axis=1)
    hid = jax.nn.silu(jnp.einsum('td,edf->tef', t, w1)) * jnp.einsum('td,edf->tef', t, w3)
    hid = hid * combine[:, :, None].astype(hid.dtype)
    out = jnp.einsum('tef,efd->td', hid, w2)
    return out.reshape(bsz, s, d)


def setup_inputs(seed: int = 0) -> dict:
    key = jax.random.key(seed)
    ks = jax.random.split(key, 32)
    f32 = jnp.float32
    L, D = DEPTH, D_MODEL

    def nrm(k, shape, fan_in):
        return jax.random.normal(k, shape, f32) * (fan_in ** -0.5)

    def gain(k, shape):
        return 1.0 + 0.02 * jax.random.normal(k, shape, f32)

    def bias(k, shape):
        return 0.01 * jax.random.normal(k, shape, f32)

    a_c = jax.random.uniform(ks[9], (L, LRU_WIDTH), f32, 0.9, 0.999)
    a0 = a_c ** (1.0 / LRU_C)
    lam = jnp.log(a0) - jnp.log1p(-a0)

    return {
        "x": jax.random.normal(ks[0], (BATCH, SEQ, D), f32),
        "p": jax.random.normal(ks[1], (DEPTH, BATCH, SEQ, PLE_DIM), f32),
        "mix_norm": gain(ks[2], (L, D)),
        "w_in": nrm(ks[3], (L, D, IN_COLS), D),
        "conv_w": nrm(ks[4], (L, CONV_WIDTH, LRU_WIDTH), CONV_WIDTH),
        "conv_b": bias(ks[5], (L, LRU_WIDTH)),
        "lru_wa": nrm(ks[6], (L, LRU_BLOCKS, LRU_BLOCK_DIM, LRU_BLOCK_DIM), LRU_BLOCK_DIM),
        "lru_ba": bias(ks[7], (L, LRU_WIDTH)),
        "lru_wi": nrm(ks[8], (L, LRU_BLOCKS, LRU_BLOCK_DIM, LRU_BLOCK_DIM), LRU_BLOCK_DIM),
        "lru_bi": bias(ks[10], (L, LRU_WIDTH)),
        "lru_lambda": lam,
        "sgu_ln_g": gain(ks[11], (L, SGU_WIDTH)),
        "sgu_ln_b": bias(ks[12], (L, SGU_WIDTH)),
        "sgu_ws": nrm(ks[13], (L, SGU_GROUPS, CHUNK, CHUNK), CHUNK),
        "sgu_bs": gain(ks[14], (L, SGU_GROUPS, CHUNK)),
        "w_out": nrm(ks[15], (L, D, D), D),
        "ffn_norm": gain(ks[16], (L, D)),
        "router_group_w": nrm(ks[17], (L, D, N_GROUPS), D),
        "router_group_b": bias(ks[18], (L, N_GROUPS)),
        "router_expert_w": nrm(ks[19], (L, D, N_EXPERTS), D),
        "router_expert_b": bias(ks[20], (L, N_EXPERTS)),
        "expert_w1": nrm(ks[21], (L, N_EXPERTS, D, D_EXPERT), D),
        "expert_w3": nrm(ks[22], (L, N_EXPERTS, D, D_EXPERT), D),
        "expert_w2": nrm(ks[23], (L, N_EXPERTS, D_EXPERT, D), D_EXPERT),
        "ple_norm": gain(ks[24], (L, D)),
        "ple_gate_w": nrm(ks[25], (L, D, D), D),
        "ple_up_w": nrm(ks[26], (L, PLE_DIM, D), PLE_DIM),
        "final_norm": gain(ks[27], (D,)),
    }


def reference(x, p, mix_norm, w_in, conv_w, conv_b, lru_wa, lru_ba, lru_wi, lru_bi, lru_lambda,
              sgu_ln_g, sgu_ln_b, sgu_ws, sgu_bs, w_out, ffn_norm, router_group_w, router_group_b,
              router_expert_w, router_expert_b, expert_w1, expert_w3, expert_w2, ple_norm,
              ple_gate_w, ple_up_w, final_norm):
    splits = [LRU_WIDTH, 2 * LRU_WIDTH, 2 * LRU_WIDTH + 2 * SGU_WIDTH]
    for l in range(DEPTH):
        h = rmsnorm(x, mix_norm[l])
        z = h @ w_in[l]
        z_lru, z_gate, z_sgu, z_merge = jnp.split(z, splits, axis=-1)
        xa = causal_depthwise_conv(z_lru, conv_w[l], conv_b[l])
        y_a = rg_lru(xa, lru_wa[l], lru_ba[l], lru_wi[l], lru_bi[l], lru_lambda[l]) * jax.nn.gelu(z_gate)
        y_b = spatial_gating(jax.nn.gelu(z_sgu), sgu_ln_g[l], sgu_ln_b[l], sgu_ws[l], sgu_bs[l])
        m_a, m_b = jnp.split(z_merge, 2, axis=-1)
        merged = jax.nn.sigmoid(m_a) * y_a + jax.nn.sigmoid(m_b) * y_b
        x = x + merged @ w_out[l]
        h = rmsnorm(x, ffn_norm[l])
        x = x + hierarchical_moe(h, router_group_w[l], router_group_b[l], router_expert_w[l],
                                 router_expert_b[l], expert_w1[l], expert_w3[l], expert_w2[l])
        g = jax.nn.sigmoid(rmsnorm(x, ple_norm[l]) @ ple_gate_w[l])
        x = x + g * (p[l] @ ple_up_w[l])
    return rmsnorm(x, final_norm)
```

```cpp
#include <hip/hip_runtime.h>
#include <stdint.h>
#include <cstdio>

typedef unsigned short bf16;
constexpr int T = 16384, D = 1024, SEQ = 2048;
constexpr float EPS = 1e-6f;
constexpr size_t MiB = 1u << 20;
constexpr size_t WS_CTL = 0;
constexpr size_t WS_VPART = 2 * MiB;
constexpr size_t WS_SS1 = 4 * MiB;
constexpr size_t WS_SS3 = 5 * MiB;
constexpr size_t WS_AGG = 1 * MiB;
constexpr size_t WS_LIST = 6 * MiB;
constexpr size_t WS_TOKE = 8 * MiB;
constexpr size_t WS_TOKG = 8 * MiB + 128 * 1024;
constexpr size_t WS_RSTD2 = 8 * MiB + 256 * 1024;
constexpr size_t WS_A0 = 74 * MiB;
constexpr size_t WS_A1 = 106 * MiB;
constexpr size_t WS_A2 = 138 * MiB;
constexpr size_t WS_A3 = 170 * MiB;
constexpr size_t WS_A4 = 202 * MiB;
constexpr size_t WS_END = 234 * MiB;

__device__ __forceinline__ float bf2f(bf16 b) { return __uint_as_float(((unsigned)b) << 16); }
__device__ __forceinline__ bf16 f2bf(float f) { unsigned u = __float_as_uint(f); u += 0x7fffu + ((u >> 16) & 1u); return (bf16)(u >> 16); }
__device__ __forceinline__ float sigm(float x) { return 1.f / (1.f + expf(-x)); }
__device__ __forceinline__ float gelu_t(float x) { const float u = 0.7978845608028654f * (x + 0.044715f * x * x * x); return 0.5f * x * (1.f + tanhf(u)); }
__device__ __forceinline__ float wave_sum(float v) {
#pragma unroll
    for (int o = 1; o < 64; o <<= 1) v += __shfl_xor(v, o);
    return v;
}

#define LAS __attribute__((address_space(3)))
#define GAS __attribute__((address_space(1)))
namespace pg8 {
typedef short bf16x8 __attribute__((ext_vector_type(8)));
typedef float f32x4 __attribute__((ext_vector_type(4)));
typedef float f32x2 __attribute__((ext_vector_type(2)));
typedef unsigned u32x4 __attribute__((ext_vector_type(4)));
typedef unsigned u32x2 __attribute__((ext_vector_type(2)));
constexpr int BM = 256, BK = 64, HALF = 128, HTB = HALF * BK * 2, STAGE_BYTES = 8 * HTB, NXCD = 8, WGM = 8;

__host__ __device__ __forceinline__ int lds_byte(int r, int c) { const int st = (r >> 4) * 2 + (c >> 5), rr = r & 15, cc = c & 31, ob = rr * 64 + cc * 2; return st * 1024 + (ob ^ (((ob >> 9) & 1) << 5)); }
__host__ __device__ __forceinline__ void stage_rc(int b, int& R, int& C) { const int st = b / 1024, sb = b % 1024, swz = sb ^ (((sb >> 9) & 1) << 5); R = (st >> 1) * 16 + swz / 64; C = (st & 1) * 32 + (swz % 64) / 2; }
__host__ __device__ __forceinline__ int perm32(int rho) { const int n = rho >> 4, i = rho & 15; return 8 * (i >> 2) + 4 * n + (i & 3); }

__device__ __forceinline__ int lane_id() { int l; asm volatile("v_mbcnt_lo_u32_b32 %0, -1, 0\n\tv_mbcnt_hi_u32_b32 %0, -1, %0" : "=v"(l)); return l; }
struct Unit { int pm, pn, e, tile, cnt; };
struct Gemm { const bf16* A; const bf16* Bt; int K; };

struct StaticOrder {
    int nM, nN, nwg, G, c;
    __device__ void init(int M, int N, int G_, int c_) { nM = M / BM; nN = N / BM; nwg = nM * nN; G = G_; c = c_; }
    __device__ bool next(int i, Unit& u) const {
        const long L = (long)i * G + c; if (L >= nwg) return false;
        int wgid = (int)L; { const int q = nwg / NXCD, r = nwg % NXCD, xcd = wgid % NXCD, off = wgid / NXCD; wgid = (xcd < r ? xcd * (q + 1) : r * (q + 1) + (xcd - r) * q) + off; }
        const int nig = WGM * nN, gid = wgid / nig, fm = gid * WGM, gsz = (nM - fm) < WGM ? (nM - fm) : WGM;
        u.pm = fm + ((wgid % nig) % gsz); u.pn = (wgid % nig) / gsz; u.e = 0; u.tile = 0; u.cnt = 0; return true;
    }
    __device__ __forceinline__ unsigned row_off(const Unit&, int) const { return 0u; }
    __device__ __forceinline__ void a_ready(const Unit&) const {}
    __device__ __forceinline__ void done(const Unit&) const {}
    struct Pre {}; __device__ __forceinline__ void pre(int, Pre&) const {}
    __device__ __forceinline__ void post(int, Pre&) const {}
};

__device__ __forceinline__ unsigned cvt_pk_bf16(float lo, float hi) { unsigned r; asm volatile("v_cvt_pk_bf16_f32 %0, %1, %2" : "=v"(r) : "v"(lo), "v"(hi)); return r; }
typedef __bf16 bf16x2_t __attribute__((ext_vector_type(2)));
__device__ __forceinline__ unsigned cvt_pk_bf16_cv(float lo, float hi) { const f32x2 v = {lo, hi}; const bf16x2_t b = __builtin_convertvector(v, bf16x2_t); return __builtin_bit_cast(unsigned, b); }
__device__ __forceinline__ float fsigm(float x) { return __builtin_amdgcn_rcpf(1.0f + __builtin_amdgcn_exp2f(-1.4426950409f * x)); }
__device__ __forceinline__ float fgelu(float x) { const float u = x + 0.044715f * x * x * x; return x * __builtin_amdgcn_rcpf(1.0f + __builtin_amdgcn_exp2f(-2.3022082f * u)); }

template <class Epi, class Sched, bool ALIGN_EPI, bool SP2, bool GATHER>
__device__ __forceinline__ void gemm_phase(LAS unsigned char* lds, const Gemm g, const Sched& S, const Epi& E, const int wave_) {
    int lane = lane_id(); asm volatile("" : "+v"(lane));
    const int wid = wave_, tid = wid * 64 + lane, wr = wid >> 2, wc = wid & 3, fr = lane & 15, fq = lane >> 4;
    const int K = g.K, nt = K / BK;
    int sR[2], sC[2];
    unsigned voffB[2], vA0[2], vA1[2], nvA0[2], nvA1[2];
#pragma unroll
    for (int i = 0; i < 2; ++i) { stage_rc(tid * 16 + i * 8192, sR[i], sC[i]); const int Rb = Epi::PERM ? ((sR[i] & ~31) + perm32(sR[i] & 31)) : sR[i];
        voffB[i] = (unsigned)(Rb * K + sC[i]) * 2u; vA0[i] = (unsigned)(sR[i] * K + sC[i]) * 2u; vA1[i] = vA0[i]; nvA0[i] = vA0[i]; nvA1[i] = vA0[i]; }
    const size_t kstep = (size_t)(BK * 2);
    const size_t hstep = (size_t)HALF * K * 2;
    const size_t tstep = 2 * hstep;
    const size_t ahs = GATHER ? 0 : hstep;
    const unsigned ldsw = (unsigned)wid * 1024u;
    const int aoff = lds_byte(wr * 64 + fr, fq * 8), boff = lds_byte(wc * 32 + fr, fq * 8);
#define PG8_SA(b, h) (((b) * 2 + (h)) * HTB)
#define PG8_SB(b, h) ((4 + (b) * 2 + (h)) * HTB)
#define PG8_STAGE(bufoff, gbase, voff) do { _Pragma("unroll") for (int _i = 0; _i < 2; ++_i) \
        __builtin_amdgcn_global_load_lds((const unsigned*)((const char*)(gbase) + (voff)[_i]), (LAS unsigned*)(lds + (bufoff) + ldsw + _i * 8192), 16, 0, 0); } while (0)
#define PG8_LDA(dst, b, h) do { _Pragma("unroll") for (int m = 0; m < 4; ++m) _Pragma("unroll") for (int k = 0; k < 2; ++k) dst[m][k] = *(const LAS bf16x8*)(lds + PG8_SA(b, h) + aoff + m * 2048 + k * 1024); } while (0)
#define PG8_LDB(dst, b, h) do { _Pragma("unroll") for (int n = 0; n < 2; ++n) _Pragma("unroll") for (int k = 0; k < 2; ++k) dst[n][k] = *(const LAS bf16x8*)(lds + PG8_SB(b, h) + boff + n * 2048 + k * 1024); } while (0)
#define PG8_MMA(ai, bj, At, Bt) do { __builtin_amdgcn_s_setprio(1); _Pragma("unroll") for (int m = 0; m < 4; ++m) _Pragma("unroll") for (int n = 0; n < 2; ++n) _Pragma("unroll") for (int k = 0; k < 2; ++k) \
        acc[ai][bj][m][n] = __builtin_amdgcn_mfma_f32_16x16x32_bf16(Bt[n][k], At[m][k], acc[ai][bj][m][n], 0, 0, 0); __builtin_amdgcn_s_setprio(0); } while (0)
#define PG8_WAIT_V(n) asm volatile("s_waitcnt vmcnt(" #n ")" ::: "memory")
#define PG8_WAIT_L(n) asm volatile("s_waitcnt lgkmcnt(" #n ")" ::: "memory")
#define PG8_BAR __builtin_amdgcn_s_barrier()
#define PG8_SCHED __builtin_amdgcn_sched_barrier(0)
    Unit cur, nxt; int ui = 0;
    if (!S.next(0, cur)) return;
    f32x4 acc[2][2][4][2];
#pragma unroll
    for (int a = 0; a < 2; ++a)
#pragma unroll
        for (int b = 0; b < 2; ++b)
#pragma unroll
            for (int m = 0; m < 4; ++m)
#pragma unroll
                for (int n = 0; n < 2; ++n) acc[a][b][m][n] = (f32x4){0.f, 0.f, 0.f, 0.f};
    bf16x8 At[4][2], B0[2][2], B1[2][2];
    const char* cA = GATHER ? (const char*)g.A : (const char*)g.A + (size_t)cur.pm * tstep; const char* cB = (const char*)g.Bt + (size_t)cur.pn * tstep;
    if constexpr (GATHER) {
#pragma unroll
        for (int i = 0; i < 2; ++i) { vA0[i] = S.row_off(cur, sR[i]) + (unsigned)sC[i] * 2u; vA1[i] = S.row_off(cur, HALF + sR[i]) + (unsigned)sC[i] * 2u; nvA0[i] = vA0[i]; nvA1[i] = vA1[i]; }
    }
    S.a_ready(cur);
    if constexpr (SP2) {
        PG8_STAGE(PG8_SB(0, 0), cB, voffB); PG8_STAGE(PG8_SB(0, 1), cB + hstep, voffB); PG8_STAGE(PG8_SA(0, 0), cA, vA0); PG8_STAGE(PG8_SA(0, 1), cA + ahs, vA1);
        if (wr == 1) PG8_BAR;
        PG8_WAIT_V(2); PG8_BAR;
        PG8_STAGE(PG8_SB(1, 0), cB + kstep, voffB); PG8_STAGE(PG8_SA(1, 0), cA + kstep, vA0); PG8_STAGE(PG8_SB(1, 1), cB + hstep + kstep, voffB);
        PG8_WAIT_V(6); PG8_BAR;
    } else {
        PG8_STAGE(PG8_SB(0, 0), cB, voffB); PG8_STAGE(PG8_SA(0, 0), cA, vA0); PG8_STAGE(PG8_SB(0, 1), cB + hstep, voffB); PG8_STAGE(PG8_SA(0, 1), cA + ahs, vA1);
        if (wr == 1) PG8_BAR;
        PG8_WAIT_V(4); PG8_BAR;
        PG8_STAGE(PG8_SB(1, 0), cB + kstep, voffB); PG8_STAGE(PG8_SA(1, 0), cA + kstep, vA0); PG8_STAGE(PG8_SB(1, 1), cB + hstep + kstep, voffB);
        PG8_WAIT_V(6); PG8_BAR;
    }
    for (;;) {
        const bool has_next = S.next(ui + 1, nxt);
        const char* nA = has_next ? (GATHER ? (const char*)g.A : (const char*)g.A + (size_t)nxt.pm * tstep) : cA; const char* nB = has_next ? (const char*)g.Bt + (size_t)nxt.pn * tstep : cB;
        for (int t = 0; t < nt; t += 2) {
            const bool last = (t == nt - 2);
            const char* a1 = cA + (size_t)(t + 1) * kstep;
            const char* a2 = last ? nA : cA + (size_t)(t + 2) * kstep; const char* b2 = last ? nB : cB + (size_t)(t + 2) * kstep;
            const char* a3 = a2 + kstep; const char* b3 = b2 + kstep;
            if (last && has_next) S.a_ready(nxt);
            unsigned w0[2], w1[2];
            if constexpr (GATHER) {
                if (last && has_next) {
#pragma unroll
                    for (int i = 0; i < 2; ++i) { nvA0[i] = S.row_off(nxt, sR[i]) + (unsigned)sC[i] * 2u; nvA1[i] = S.row_off(nxt, HALF + sR[i]) + (unsigned)sC[i] * 2u; }
                }
#pragma unroll
                for (int i = 0; i < 2; ++i) { w0[i] = last ? nvA0[i] : vA0[i]; w1[i] = last ? nvA1[i] : vA1[i]; }
            } else {
#pragma unroll
                for (int i = 0; i < 2; ++i) { w0[i] = vA0[i]; w1[i] = vA0[i]; }
            }
            if constexpr (SP2) {
            PG8_LDB(B0, 0, 0); PG8_LDB(B1, 0, 1); PG8_SCHED; PG8_LDA(At, 0, 0); PG8_STAGE(PG8_SA(1, 1), a1 + ahs, vA1);
            PG8_WAIT_V(8); PG8_WAIT_L(0); PG8_BAR; PG8_MMA(0, 0, At, B0); PG8_MMA(0, 1, At, B1); PG8_BAR; PG8_SCHED;
            PG8_LDA(At, 0, 1); PG8_STAGE(PG8_SB(0, 0), b2, voffB); PG8_STAGE(PG8_SB(0, 1), b2 + hstep, voffB); PG8_STAGE(PG8_SA(0, 0), a2, w0);
            PG8_WAIT_V(8); PG8_WAIT_L(0); PG8_BAR; PG8_MMA(1, 0, At, B0); PG8_MMA(1, 1, At, B1); PG8_BAR; PG8_SCHED;
            PG8_LDB(B0, 1, 0); PG8_LDB(B1, 1, 1); PG8_SCHED; PG8_LDA(At, 1, 0); PG8_STAGE(PG8_SA(0, 1), a2 + ahs, w1);
            PG8_WAIT_V(8); PG8_WAIT_L(0); PG8_BAR; PG8_MMA(0, 0, At, B0); PG8_MMA(0, 1, At, B1); PG8_BAR; PG8_SCHED;
            PG8_LDA(At, 1, 1); PG8_STAGE(PG8_SB(1, 0), b3, voffB); PG8_STAGE(PG8_SB(1, 1), b3 + hstep, voffB); PG8_STAGE(PG8_SA(1, 0), a3, w0);
            PG8_WAIT_V(8); PG8_WAIT_L(0); PG8_BAR; PG8_MMA(1, 0, At, B0); PG8_MMA(1, 1, At, B1); PG8_BAR; PG8_SCHED;
            } else {
            PG8_LDB(B0, 0, 0); PG8_SCHED; PG8_LDA(At, 0, 0); PG8_STAGE(PG8_SA(1, 1), a1 + ahs, vA1);
            PG8_WAIT_L(8); PG8_BAR; PG8_WAIT_L(0); PG8_MMA(0, 0, At, B0); PG8_BAR; PG8_SCHED;
            PG8_LDB(B1, 0, 1); PG8_STAGE(PG8_SB(0, 0), b2, voffB);
            PG8_BAR; PG8_WAIT_L(0); PG8_MMA(0, 1, At, B1); PG8_BAR;
            PG8_LDA(At, 0, 1); PG8_STAGE(PG8_SA(0, 0), a2, w0);
            PG8_BAR; PG8_WAIT_L(0); PG8_MMA(1, 0, At, B0); PG8_BAR; PG8_SCHED;
            PG8_STAGE(PG8_SB(0, 1), b2 + hstep, voffB);
            PG8_WAIT_V(6); PG8_BAR; PG8_MMA(1, 1, At, B1); PG8_BAR;
            PG8_LDB(B0, 1, 0); PG8_SCHED; PG8_LDA(At, 1, 0); PG8_STAGE(PG8_SA(0, 1), a2 + ahs, w1);
            PG8_WAIT_L(8); PG8_BAR; PG8_WAIT_L(0); PG8_MMA(0, 0, At, B0); PG8_BAR; PG8_SCHED;
            PG8_LDB(B1, 1, 1); PG8_STAGE(PG8_SB(1, 0), b3, voffB);
            PG8_BAR; PG8_WAIT_L(0); PG8_MMA(0, 1, At, B1); PG8_BAR;
            PG8_LDA(At, 1, 1); PG8_STAGE(PG8_SA(1, 0), a3, w0);
            PG8_BAR; PG8_WAIT_L(0); PG8_MMA(1, 0, At, B0); PG8_BAR; PG8_SCHED;
            PG8_STAGE(PG8_SB(1, 1), b3 + hstep, voffB);
            PG8_WAIT_V(6); PG8_BAR; PG8_MMA(1, 1, At, B1); PG8_BAR;
            }
        }
        if constexpr (ALIGN_EPI) { if (wr == 0) PG8_BAR; }
        typename Sched::Pre pre_; S.pre(ui, pre_);
        E(acc, cur, wr, wc, fr, fq); S.done(cur); S.post(ui, pre_);
        if (!has_next) break;
#pragma unroll
        for (int a = 0; a < 2; ++a)
#pragma unroll
            for (int b = 0; b < 2; ++b)
#pragma unroll
                for (int m = 0; m < 4; ++m)
#pragma unroll
                    for (int n = 0; n < 2; ++n) acc[a][b][m][n] = (f32x4){0.f, 0.f, 0.f, 0.f};
        cur = nxt; cA = nA; cB = nB; ++ui;
        if constexpr (GATHER) {
#pragma unroll
            for (int i = 0; i < 2; ++i) { vA0[i] = nvA0[i]; vA1[i] = nvA1[i]; }
        }
        if constexpr (ALIGN_EPI) { if (wr == 1) PG8_BAR; }
    }
    PG8_WAIT_V(0);
    if constexpr (!ALIGN_EPI) { if (wr == 0) PG8_BAR; }
    PG8_BAR;
#undef PG8_SA
#undef PG8_SB
#undef PG8_STAGE
#undef PG8_LDA
#undef PG8_LDB
#undef PG8_MMA
#undef PG8_WAIT_V
#undef PG8_WAIT_L
#undef PG8_BAR
#undef PG8_SCHED
}

__device__ __forceinline__ u32x4 pack8(const f32x4 v0, const f32x4 v1) { u32x4 w; w.x = cvt_pk_bf16(v0[0], v0[1]); w.y = cvt_pk_bf16(v0[2], v0[3]); w.z = cvt_pk_bf16(v1[0], v1[1]); w.w = cvt_pk_bf16(v1[2], v1[3]); return w; }
__device__ __forceinline__ void unpack8(const u32x4 w, f32x4& v0, f32x4& v1) {
    v0[0] = __uint_as_float(w.x << 16); v0[1] = __uint_as_float(w.x & 0xffff0000u); v0[2] = __uint_as_float(w.y << 16); v0[3] = __uint_as_float(w.y & 0xffff0000u);
    v1[0] = __uint_as_float(w.z << 16); v1[1] = __uint_as_float(w.z & 0xffff0000u); v1[2] = __uint_as_float(w.w << 16); v1[3] = __uint_as_float(w.w & 0xffff0000u); }

struct Epi1 {
    static constexpr bool PERM = true;
    bf16 *Zl, *GA, *UB, *V; float* VPART;
    __device__ __forceinline__ void operator()(const f32x4 (&acc)[2][2][4][2], const Unit& u, int wr, int wc, int fr, int fq) const {
        const int row0 = u.pm * BM + wr * 64 + fr, pn = u.pn;
        if (pn < 4) {
            const int col0 = pn * 256 + wc * 32 + 8 * fq;
#pragma unroll
            for (int ai = 0; ai < 2; ++ai)
#pragma unroll
                for (int m = 0; m < 4; ++m) { bf16* rowp = Zl + (size_t)(row0 + ai * HALF + m * 16) * D + col0;
#pragma unroll
                    for (int bj = 0; bj < 2; ++bj) *(u32x4*)(rowp + bj * HALF) = pack8(acc[ai][bj][m][0], acc[ai][bj][m][1]); }
        } else if (pn < 20) {
            bf16* O = pn < 12 ? GA : UB; const int uu = pn < 12 ? pn - 4 : pn - 12; const int col0 = uu * 128 + wc * 32 + 8 * fq;
#pragma unroll
            for (int ai = 0; ai < 2; ++ai)
#pragma unroll
                for (int m = 0; m < 4; ++m) { f32x4 v[2];
#pragma unroll
                    for (int n = 0; n < 2; ++n)
#pragma unroll
                        for (int i = 0; i < 4; ++i) v[n][i] = fgelu(acc[ai][0][m][n][i]) * fsigm(acc[ai][1][m][n][i]);
                    *(u32x4*)(O + (size_t)(row0 + ai * HALF + m * 16) * D + col0) = pack8(v[0], v[1]); }
        } else {
            const int col0 = (pn - 20) * 256 + wc * 32 + 8 * fq;
#pragma unroll
            for (int ai = 0; ai < 2; ++ai)
#pragma unroll
                for (int m = 0; m < 4; ++m) { const int row = row0 + ai * HALF + m * 16; float s1 = 0.f, s2 = 0.f;
#pragma unroll
                    for (int bj = 0; bj < 2; ++bj) { f32x4 v[2];
#pragma unroll
                        for (int n = 0; n < 2; ++n)
#pragma unroll
                            for (int i = 0; i < 4; ++i) { const float gv = fgelu(acc[ai][bj][m][n][i]); v[n][i] = gv; s1 += gv; s2 += gv * gv; }
                        *(u32x4*)(V + (size_t)row * D + col0 + bj * HALF) = pack8(v[0], v[1]); }
                    s1 += __shfl_xor(s1, 16); s1 += __shfl_xor(s1, 32); s2 += __shfl_xor(s2, 16); s2 += __shfl_xor(s2, 32);
                    if (fq == 0) *(f32x2*)(VPART + (size_t)row * 32 + ((pn - 20) * 4 + wc) * 2) = (f32x2){s1, s2}; }
        }
    }
};
struct EpiPlain {
    static constexpr bool PERM = true;
    bf16* O;
    __device__ __forceinline__ void operator()(const f32x4 (&acc)[2][2][4][2], const Unit& u, int wr, int wc, int fr, int fq) const {
        const int row0 = u.pm * BM + wr * 64 + fr, col0 = u.pn * 256 + wc * 32 + 8 * fq;
#pragma unroll
        for (int ai = 0; ai < 2; ++ai)
#pragma unroll
            for (int m = 0; m < 4; ++m) { bf16* rowp = O + (size_t)(row0 + ai * HALF + m * 16) * D + col0;
#pragma unroll
                for (int bj = 0; bj < 2; ++bj) *(u32x4*)(rowp + bj * HALF) = pack8(acc[ai][bj][m][0], acc[ai][bj][m][1]); }
    }
};
struct Epi2 {
    static constexpr bool PERM = true;
    const float* x; bf16* X1b; float* SS1;
    __device__ __forceinline__ void operator()(const f32x4 (&acc)[2][2][4][2], const Unit& u, int wr, int wc, int fr, int fq) const {
        const int row0 = u.pm * BM + wr * 64 + fr, col0 = u.pn * 256 + wc * 32 + 8 * fq;
#pragma unroll
        for (int ai = 0; ai < 2; ++ai)
#pragma unroll
            for (int m = 0; m < 4; ++m) { const int row = row0 + ai * HALF + m * 16; float ss = 0.f;
#pragma unroll
                for (int bj = 0; bj < 2; ++bj) { const float* xp = x + (size_t)row * D + col0 + bj * HALF;
                    const f32x4 v0 = acc[ai][bj][m][0] + *(const f32x4*)xp, v1 = acc[ai][bj][m][1] + *(const f32x4*)(xp + 4);
                    ss += (v0[0] * v0[0] + v0[1] * v0[1]) + (v0[2] * v0[2] + v0[3] * v0[3]) + (v1[0] * v1[0] + v1[1] * v1[1]) + (v1[2] * v1[2] + v1[3] * v1[3]);
                    *(u32x4*)(X1b + (size_t)row * D + col0 + bj * HALF) = pack8(v0, v1); }
                ss += __shfl_xor(ss, 16); ss += __shfl_xor(ss, 32);
                if (fq == 0) SS1[(size_t)row * 16 + u.pn * 4 + wc] = ss; }
    }
};
struct EpiPle {
    static constexpr bool PERM = true;
    const bf16* X2b; const bf16* PU; const float* RSTD2; bf16* X3; float* SS3;
    __device__ __forceinline__ void operator()(const f32x4 (&acc)[2][2][4][2], const Unit& u, int wr, int wc, int fr, int fq) const {
        const int row0 = u.pm * BM + wr * 64 + fr, col0 = u.pn * 256 + wc * 32 + 8 * fq;
#pragma unroll
        for (int ai = 0; ai < 2; ++ai)
#pragma unroll
            for (int m = 0; m < 4; ++m) { const int row = row0 + ai * HALF + m * 16; float ss = 0.f; const float r2 = RSTD2[row];
#pragma unroll
                for (int bj = 0; bj < 2; ++bj) { const size_t o = (size_t)row * D + col0 + bj * HALF;
                    f32x4 x0, x1, p0, p1; unpack8(*(const u32x4*)(X2b + o), x0, x1); unpack8(*(const u32x4*)(PU + o), p0, p1);
                    f32x4 v0, v1;
#pragma unroll
                    for (int i = 0; i < 4; ++i) { v0[i] = x0[i] + fsigm(r2 * acc[ai][bj][m][0][i]) * p0[i]; v1[i] = x1[i] + fsigm(r2 * acc[ai][bj][m][1][i]) * p1[i]; }
                    ss += (v0[0] * v0[0] + v0[1] * v0[1]) + (v0[2] * v0[2] + v0[3] * v0[3]) + (v1[0] * v1[0] + v1[1] * v1[1]) + (v1[2] * v1[2] + v1[3] * v1[3]);
                    *(u32x4*)(X3 + o) = pack8(v0, v1); }
                ss += __shfl_xor(ss, 16); ss += __shfl_xor(ss, 32);
                if (fq == 0) SS3[(size_t)row * 16 + u.pn * 4 + wc] = ss; }
    }
};

struct EpiPleFinal {
    static constexpr bool PERM = true;
    const bf16* X2b; const bf16* PU; const float* RSTD2; const float* fn; float* out; float* XCH; unsigned* cnt; LAS float* xl; int wave;
    __device__ __forceinline__ void operator()(f32x4 (&acc)[2][2][4][2], const Unit& u, int wr, int wc, int fr, int fq) const {
        const int tid = wave * 64 + lane_id();
        const int rl0 = wr * 64 + fr, col0 = u.pn * 256 + wc * 32 + 8 * fq;
#pragma unroll
        for (int ai = 0; ai < 2; ++ai)
#pragma unroll
            for (int m = 0; m < 4; ++m) { const int rl = rl0 + ai * HALF + m * 16, row = u.pm * BM + rl; float ss = 0.f; const float r2 = RSTD2[row];
#pragma unroll
                for (int bj = 0; bj < 2; ++bj) { const size_t o = (size_t)row * D + col0 + bj * HALF;
                    f32x4 x0, x1, p0, p1; unpack8(*(const u32x4*)(X2b + o), x0, x1); unpack8(*(const u32x4*)(PU + o), p0, p1);
                    f32x4 v0, v1;
#pragma unroll
                    for (int i = 0; i < 4; ++i) { v0[i] = x0[i] + fsigm(r2 * acc[ai][bj][m][0][i]) * p0[i]; v1[i] = x1[i] + fsigm(r2 * acc[ai][bj][m][1][i]) * p1[i]; }
                    ss += (v0[0] * v0[0] + v0[1] * v0[1]) + (v0[2] * v0[2] + v0[3] * v0[3]) + (v1[0] * v1[0] + v1[1] * v1[1]) + (v1[2] * v1[2] + v1[3] * v1[3]);
                    acc[ai][bj][m][0] = v0; acc[ai][bj][m][1] = v1; }
                ss += __shfl_xor(ss, 16); ss += __shfl_xor(ss, 32);
                if (fq == 0) xl[rl * 4 + wc] = ss; }
        __syncthreads();
        if (tid < 256) { const f32x4 p = *(const LAS f32x4*)(xl + tid * 4);
            __hip_atomic_store(XCH + (size_t)(u.pm * BM + tid) * 4 + u.pn, (p[0] + p[1]) + (p[2] + p[3]), __ATOMIC_RELAXED, __HIP_MEMORY_SCOPE_AGENT); }
        asm volatile("s_waitcnt vmcnt(0)" ::: "memory");
        if (tid < 256 && (tid & 63) == 0) __hip_atomic_fetch_add(cnt + 64 * u.pm, 1u, __ATOMIC_RELAXED, __HIP_MEMORY_SCOPE_AGENT);
        if (tid < 64) { unsigned sp = 0;
            while ((unsigned)__builtin_amdgcn_readfirstlane(__hip_atomic_load(cnt + 64 * u.pm, __ATOMIC_RELAXED, __HIP_MEMORY_SCOPE_AGENT)) < 16u) { if (++sp > (1u << 22)) break; __builtin_amdgcn_s_sleep(1); } }
        __syncthreads();
        if (tid < 256) { const float* xs = XCH + (size_t)(u.pm * BM + tid) * 4; float tot = 0.f;
#pragma unroll
            for (int q = 0; q < 4; ++q) tot += __hip_atomic_load(xs + q, __ATOMIC_RELAXED, __HIP_MEMORY_SCOPE_AGENT);
            xl[1024 + tid] = rsqrtf(tot * (1.f / D) + EPS); }
        __syncthreads();
#pragma unroll
        for (int ai = 0; ai < 2; ++ai)
#pragma unroll
            for (int m = 0; m < 4; ++m) { const int rl = rl0 + ai * HALF + m * 16; const float rs = xl[1024 + rl]; float* op = out + (size_t)(u.pm * BM + rl) * D + col0;
#pragma unroll
                for (int bj = 0; bj < 2; ++bj) { const f32x4 f0 = *(const f32x4*)(fn + col0 + bj * HALF), f1 = *(const f32x4*)(fn + col0 + bj * HALF + 4);
                    *(f32x4*)(op + bj * HALF) = acc[ai][bj][m][0] * rs * f0; *(f32x4*)(op + bj * HALF + 4) = acc[ai][bj][m][1] * rs * f1; } }
    }
};

template <int MODE> struct MoeOrder {
    const LAS int* tab; const int* LIST; unsigned* dcnt;
    __device__ __forceinline__ bool next(int i, Unit& u) const {
        const int n = __builtin_amdgcn_readfirstlane(tab[0]); if (i >= n) return false;
        const LAS int* p = tab + 4 + 8 * i;
        u.pm = __builtin_amdgcn_readfirstlane(p[0]); u.pn = __builtin_amdgcn_readfirstlane(p[1]); u.e = __builtin_amdgcn_readfirstlane(p[2]);
        u.tile = __builtin_amdgcn_readfirstlane(p[3]); u.cnt = __builtin_amdgcn_readfirstlane(p[4]); return true;
    }
    __device__ __forceinline__ unsigned row_off(const Unit& u, int r) const { int idx = u.tile * 256 + r; idx = idx < u.cnt ? idx : u.cnt - 1; const int pair = LIST[u.e * 16384 + idx]; return (unsigned)(pair >> 1) * 2048u; }
    __device__ __forceinline__ void a_ready(const Unit&) const {}
    struct Pre {}; __device__ __forceinline__ void pre(int, Pre&) const {}
    __device__ __forceinline__ void post(int, Pre&) const {}
    __device__ __forceinline__ void done(const Unit& u) const {
        if constexpr (MODE == 1) {
            asm volatile("s_waitcnt vmcnt(0)" ::: "memory");
            if (lane_id() == 0) __hip_atomic_fetch_add(dcnt + 64 * u.pm, 1u, __ATOMIC_RELAXED, __HIP_MEMORY_SCOPE_AGENT);
        }
    }
};
__device__ __forceinline__ void store16_sc1(void* p, u32x4 v) { asm volatile("global_store_dwordx4 %0, %1, off sc1\n\ts_nop 1" :: "v"(p), "v"(v) : "memory"); }
struct EpiMoe1 {
    static constexpr bool PERM = true;
    bf16* H; const int* LIST; const float* RSTD1;
    __device__ __forceinline__ void operator()(const f32x4 (&acc)[2][2][4][2], const Unit& u, int wr, int wc, int fr, int fq) const {
        const int col0 = (u.pn & 1) * 128 + wc * 32 + 8 * fq;
#pragma unroll
        for (int ai = 0; ai < 2; ++ai)
#pragma unroll
            for (int m = 0; m < 4; ++m) { const int r = ai * HALF + wr * 64 + m * 16 + fr; int idx = u.tile * 256 + r; idx = idx < u.cnt ? idx : u.cnt - 1;
                const int pair = LIST[u.e * 16384 + idx]; const float rs = RSTD1[pair >> 1]; f32x4 v[2];
#pragma unroll
                for (int n = 0; n < 2; ++n)
#pragma unroll
                    for (int i = 0; i < 4; ++i) { const float a1 = rs * acc[ai][0][m][n][i], a3 = rs * acc[ai][1][m][n][i]; v[n][i] = a1 * fsigm(a1) * a3; }
                store16_sc1(H + (size_t)(u.pm * 256 + r) * 256 + col0, pack8(v[0], v[1])); }
    }
};
struct EpiMoe2 {
    static constexpr bool PERM = true;
    bf16* Y; const int* LIST; const float* TOKG;
    __device__ __forceinline__ void operator()(const f32x4 (&acc)[2][2][4][2], const Unit& u, int wr, int wc, int fr, int fq) const {
        const int col0 = (u.pn & 3) * 256 + wc * 32 + 8 * fq;
#pragma unroll
        for (int ai = 0; ai < 2; ++ai)
#pragma unroll
            for (int m = 0; m < 4; ++m) { const int r = ai * HALF + wr * 64 + m * 16 + fr; const int idx = u.tile * 256 + r;
                if (idx < u.cnt) { const int pair = LIST[u.e * 16384 + idx]; const float gt = TOKG[pair];
#pragma unroll
                    for (int bj = 0; bj < 2; ++bj) *(u32x4*)(Y + (size_t)pair * D + col0 + bj * HALF) = pack8(acc[ai][bj][m][0] * gt, acc[ai][bj][m][1] * gt); } }
    }
};
}

constexpr int NWAVES = 8;
constexpr int RING_BYTES = 131072, LDSCTL_OFF = 139264, MISC_OFF = LDSCTL_OFF + 320, TAB_OFF = LDSCTL_OFF + 512, LDS_BYTES = 147456;
constexpr size_t WS_WLRU = 8 * MiB + 512 * 1024;
constexpr size_t WS_WSGU = 8 * MiB + 768 * 1024;
constexpr size_t WS_WR = 9 * MiB;
constexpr size_t WS_WUP = 9 * MiB + 512 * 1024;
constexpr size_t WS_WIN = 10 * MiB;
constexpr size_t WS_WOUT = 22 * MiB;
constexpr size_t WS_WG = 24 * MiB;
constexpr size_t WS_W13 = 26 * MiB;
constexpr size_t WS_W2 = 58 * MiB;
constexpr size_t WS_PB = 234 * MiB;
constexpr size_t WS_RSTD1 = 242 * MiB;
constexpr size_t WS_SPL8 = 242 * MiB + 512 * 1024;
constexpr size_t WS_XCH = 243 * MiB;
constexpr size_t WS_MEGA_END = 244 * MiB;
constexpr int CW_BAR = 4096;
constexpr int CW_DONE1 = 131072;
constexpr int CW_PANEL = 65536;

typedef GAS unsigned gu32;
#define RLX_AGENT __ATOMIC_RELAXED, __HIP_MEMORY_SCOPE_AGENT
#define LDS_WAIT() asm volatile("s_waitcnt lgkmcnt(0)" ::: "memory")
#define VM_WAIT() asm volatile("s_waitcnt vmcnt(0)" ::: "memory")

#define XB_TMO      128
#define XB_XCNT(j)  (256  + 64 * (j))
#define XB_XSUB(j)  (1280 + 64 * (j))
#define XB_XGEN(j)  (2304 + 64 * (j))
#define XB_TOP      3328
#define XB_TOPGEN   3392
#define XCD_BAR_WORDS 3456
#define XB_SPIN_CAP (1u << 18)
__device__ __forceinline__ unsigned xb_ld(unsigned* p)              { return __hip_atomic_load(p, __ATOMIC_RELAXED, __HIP_MEMORY_SCOPE_AGENT); }
__device__ __forceinline__ unsigned xb_add(unsigned* p, unsigned v) { return __hip_atomic_fetch_add(p, v, __ATOMIC_RELAXED, __HIP_MEMORY_SCOPE_AGENT); }
__device__ __forceinline__ unsigned xb_xcc_id() { return (unsigned)__builtin_amdgcn_s_getreg((3 << 11) | 20) & 0xFu; }
#define XB_SPIN(cond, bar) do { unsigned _sp = 0; while (cond) { __builtin_amdgcn_s_sleep(1); \
    if ((++_sp & 255u) == 0u) { if (xb_ld(&(bar)[XB_TMO])) break; if (_sp > XB_SPIN_CAP) { atomicAdd(&(bar)[XB_TMO], 1u); break; } } } } while (0)
struct XcdBarrier { unsigned* bar; unsigned x; volatile LAS unsigned* st; int wave; };
__device__ __forceinline__ XcdBarrier xcd_barrier_post(unsigned* bar, volatile LAS unsigned* st, int wave) {
    XcdBarrier b; b.bar = bar; b.x = xb_xcc_id(); b.st = st; b.wave = wave;
    if (wave == 0 && pg8::lane_id() == 0) (void)xb_add(&bar[XB_XCNT(b.x)], 1u);
    return b;
}
__device__ __forceinline__ void xcd_barrier_complete(unsigned* bar, unsigned x, unsigned& nloc, unsigned& nx) {
    const unsigned G = gridDim.x * gridDim.y * gridDim.z;
    unsigned sum, cnt, mine, sp = 0u;
    for (;;) {
        sum = 0u; cnt = 0u; mine = 0u;
#pragma unroll
        for (unsigned j = 0; j < 16; ++j) { const unsigned c = xb_ld(&bar[XB_XCNT(j)]); sum += c; cnt += (c > 0u) ? 1u : 0u; mine = (j == x) ? c : mine; }
        if (sum == G) break;
        __builtin_amdgcn_s_sleep(1);
        if ((++sp & 255u) == 0u) { if (xb_ld(&bar[XB_TMO])) break; if (sp > XB_SPIN_CAP) { atomicAdd(&bar[XB_TMO], 1u); break; } }
    }
    nloc = mine > 0u ? mine : 1u; nx = cnt > 0u ? cnt : 1u;
}
__device__ __forceinline__ void xcd_barrier(const XcdBarrier& b) {
    asm volatile("s_waitcnt vmcnt(0)" ::: "memory");
    __syncthreads();
    if (b.wave == 0 && pg8::lane_id() == 0) {
        unsigned* bar = b.bar;
        __builtin_amdgcn_s_waitcnt(0);
        unsigned nloc = b.st[0], nx = b.st[1];
        if (nloc == 0u) { xcd_barrier_complete(bar, b.x, nloc, nx); b.st[0] = nloc; b.st[1] = nx; }
        const unsigned old = xb_add(&bar[XB_XSUB(b.x)], 1u);
        const unsigned gen = old / nloc;
        if (old + 1u == (gen + 1u) * nloc) {
            __builtin_amdgcn_fence(__ATOMIC_RELEASE, "agent");
            asm volatile("s_waitcnt vmcnt(0)" ::: "memory");
            const unsigned og = xb_add(&bar[XB_TOP], 1u);
            const unsigned tg = og / nx;
            if (og + 1u == (tg + 1u) * nx) xb_add(&bar[XB_TOPGEN], 1u);
            else XB_SPIN(xb_ld(&bar[XB_TOPGEN]) == tg, bar);
            __builtin_amdgcn_fence(__ATOMIC_ACQUIRE, "agent");
            xb_add(&bar[XB_XGEN(b.x)], 1u);
            asm volatile("s_waitcnt vmcnt(0)" ::: "memory");
        } else {
            XB_SPIN(xb_ld(&bar[XB_XGEN(b.x)]) == gen, bar);
            __builtin_amdgcn_fence(__ATOMIC_ACQUIRE, "agent");
            asm volatile("s_waitcnt vmcnt(0)" ::: "memory");
        }
    }
    __syncthreads();
}

__device__ __forceinline__ unsigned pk2(float lo, float hi) { return (unsigned)f2bf(lo) | ((unsigned)f2bf(hi) << 16); }

struct TrItem { pg8::f32x4 v[8]; };
__device__ __forceinline__ void tr_load(TrItem& t, const float* __restrict__ W, int ldn, int k0, int n_src0, int lane) {
    const int kb = lane >> 3, n4 = lane & 7;
    const float* src = W + (size_t)(k0 + 8 * kb) * ldn + n_src0 + 4 * n4;
#pragma unroll
    for (int q = 0; q < 8; ++q) t.v[q] = *(const pg8::f32x4*)(src + (size_t)q * ldn);
}
__device__ __forceinline__ void tr_store(TrItem& t, int k0, bf16* __restrict__ WT, int Kd, int drow0, const float* __restrict__ gk, int lane) {
    const int kb = lane >> 3, n4 = lane & 7;
    if (gk) { const pg8::f32x4 g0 = *(const pg8::f32x4*)(gk + k0 + 8 * kb), g1 = *(const pg8::f32x4*)(gk + k0 + 8 * kb + 4);
#pragma unroll
        for (int q = 0; q < 8; ++q) t.v[q] = t.v[q] * (q < 4 ? g0[q & 3] : g1[q & 3]); }
#pragma unroll
    for (int i = 0; i < 4; ++i) { pg8::u32x4 o; o.x = pk2(t.v[0][i], t.v[1][i]); o.y = pk2(t.v[2][i], t.v[3][i]); o.z = pk2(t.v[4][i], t.v[5][i]); o.w = pk2(t.v[6][i], t.v[7][i]);
        *(pg8::u32x4*)(WT + (size_t)(drow0 + 4 * n4 + i) * Kd + k0 + 8 * kb) = o; }
}
__device__ __forceinline__ void p0_transpose_item(const float* __restrict__ W, int ldn, int k0, int n_src0, bf16* __restrict__ WT, int Kd, int drow0, const float* __restrict__ gk, LAS float*, int lane) {
    TrItem t; tr_load(t, W, ldn, k0, n_src0, lane); tr_store(t, k0, WT, Kd, drow0, gk, lane);
}
__device__ __forceinline__ int win_dest_row(int n) {
    const int grp = n >> 10, j = n & 1023;
    switch (grp) {
        case 0: return j;
        case 1: return 1024 + (j >> 7) * 256 + (j & 127);
        case 2: return 3072 + (j >> 7) * 256 + (j & 127);
        case 3: return 5120 + j;
        case 4: return 1024 + (j >> 7) * 256 + 128 + (j & 127);
        default: return 3072 + (j >> 7) * 256 + 128 + (j & 127);
    }
}


struct DefW { const float *wout, *w1, *w3, *w2, *wg, *wup, *fnorm, *pnorm; bf16 *WoutT, *W13T, *W2T, *WgT, *WupT; };
constexpr int DF_OUT = 16 * 32, DF_E13 = 32 * 2 * 128, DF_E2 = 32 * 128, DF_G = 16 * 32, DF_UP = 4 * 32, DF_N = DF_OUT + DF_E13 + DF_E2 + DF_G + DF_UP;
struct DefDesc { const float* W; const float* gk; bf16* WT; int ldn, k0, n0, Kd, drow; };
__device__ __forceinline__ DefDesc deferred_desc(const DefW& w, int it) {
    int r = it; DefDesc d;
    if (r < DF_OUT) { const int kb = r / 32, nb = r % 32; d = DefDesc{w.wout, nullptr, w.WoutT, 1024, kb * 64, nb * 32, 1024, nb * 32}; return d; } r -= DF_OUT;
    if (r < DF_E13) { const int e = r / 256, which = (r / 128) & 1, q = r % 128, kb = q / 8, nb = q % 8;
        const int f0 = nb * 32, drow = e * 512 + (f0 >> 7) * 256 + which * 128 + (f0 & 127);
        d = DefDesc{(which ? w.w3 : w.w1) + (size_t)e * 1024 * 256, w.fnorm, w.W13T, 256, kb * 64, f0, 1024, drow}; return d; } r -= DF_E13;
    if (r < DF_E2) { const int e = r / 128, q = r % 128, kb = q / 32, nb = q % 32;
        d = DefDesc{w.w2 + (size_t)e * 256 * 1024, nullptr, w.W2T, 1024, kb * 64, nb * 32, 256, e * 1024 + nb * 32}; return d; } r -= DF_E2;
    if (r < DF_G) { const int kb = r / 32, nb = r % 32; d = DefDesc{w.wg, w.pnorm, w.WgT, 1024, kb * 64, nb * 32, 1024, nb * 32}; return d; } r -= DF_G;
    { const int kb = r / 32, nb = r % 32; d = DefDesc{w.wup, nullptr, w.WupT, 1024, kb * 64, nb * 32, 256, nb * 32}; return d; }
}
struct Gemm1Order : pg8::StaticOrder {
    DefW w; int wave;
    typedef TrItem Pre;
    __device__ __forceinline__ void pre(int ui, Pre& t) const {
        const int lane = pg8::lane_id(), it = (ui * G + c) * 8 + wave;
        if (it < DF_N) { const DefDesc d = deferred_desc(w, it); tr_load(t, d.W, d.ldn, d.k0, d.n0, lane); }
    }
    __device__ __forceinline__ void post(int ui, Pre& t) const {
        const int lane = pg8::lane_id(); int it = (ui * G + c) * 8 + wave;
        if (it < DF_N) { const DefDesc d = deferred_desc(w, it); tr_store(t, d.k0, d.WT, d.Kd, d.drow, d.gk, lane); }
        for (it += nwg * 8; it < DF_N; it += nwg * 8) { const DefDesc d = deferred_desc(w, it); TrItem t2; tr_load(t2, d.W, d.ldn, d.k0, d.n0, lane); tr_store(t2, d.k0, d.WT, d.Kd, d.drow, d.gk, lane); }
    }
};

constexpr int MY_VT = 0, MY_XA = 32768, MY_SP = 67584, MY_WS = 102400, MY_ST = 135168, MY_RS = 272;
__device__ __forceinline__ float bflo(unsigned u) { return __uint_as_float(u << 16); }
__device__ __forceinline__ float bfhi(unsigned u) { return __uint_as_float(u & 0xffff0000u); }
template <int N> __device__ __forceinline__ float row_shr(float ident, float v) {
    return __builtin_bit_cast(float, __builtin_amdgcn_update_dpp(__builtin_bit_cast(int, ident), __builtin_bit_cast(int, v), 0x110 + N, 0xf, 0xf, false)); }
#define MX_SCAN_STEP(N, A, U) { const float pa_ = row_shr<N>(1.f, A), pu_ = row_shr<N>(0.f, U); U = pu_ * A + U; A = pa_ * A; }
#define MX_SCAN16(A, U) { MX_SCAN_STEP(1, A, U) MX_SCAN_STEP(2, A, U) MX_SCAN_STEP(4, A, U) MX_SCAN_STEP(8, A, U) }
__device__ __forceinline__ void mixer_phase(LAS unsigned char* lds, const int vcu, const int G, const int tid, const int lane, const int wave,
                                            const bf16* __restrict__ Zl, const bf16* __restrict__ GA, const bf16* __restrict__ UB, const bf16* __restrict__ V, const float* __restrict__ VPART,
                                            unsigned long long* AGG, bf16* __restrict__ MG, const bf16* __restrict__ WLRU, const bf16* __restrict__ WSGU, const float* __restrict__ SPL8, const float* const* in) {
    using namespace pg8;
    constexpr int RS = MY_RS;
    constexpr float L2E = 1.4426950409f;
    const int fr = lane & 15, grp = lane >> 4, cp = tid & 63, tg = wave;
    const int pr = lane & 3, sch = lane >> 2, srow = 8 * sch + 2 * pr;
    LAS float* ST = (LAS float*)(lds + MY_ST);
    int gprev = -1;
    f32x2 cw0, cw1, cw2, cw3, ccb;
    u32x4 zqa, zqb, zqc, zqd, zqe, vv00, vv01, vv10, vv11;
#define MX_ZR(k) ((k) < 4 ? zqa[(k) & 3] : (k) < 8 ? zqb[(k) & 3] : (k) < 12 ? zqc[(k) & 3] : (k) < 16 ? zqd[(k) & 3] : zqe[(k) & 3])
#define MX_SETZR(k, v) do { if ((k) < 4) zqa[(k) & 3] = (v); else if ((k) < 8) zqb[(k) & 3] = (v); else if ((k) < 12) zqc[(k) & 3] = (v); else if ((k) < 16) zqd[(k) & 3] = (v); else zqe[(k) & 3] = (v); } while (0)
#define MX_PREFETCH(uu) do { const int ck_ = (uu) >> 3, g_ = (uu) & 7, t0_ = ck_ * 128, c0_ = g_ * 128; const bool first_ = (ck_ & 15) == 0; \
        const unsigned zo_ = ((unsigned)(t0_ + 16 * tg) * D + c0_ + 2 * cp) * 2u; \
        _Pragma("unroll") for (int k = 0; k < 19; ++k) { unsigned zv_ = 0u; if (!(k < 3 && first_ && tg == 0)) zv_ = *(const unsigned*)((const char*)Zl + (zo_ + (unsigned)((k - 3) * D * 2))); MX_SETZR(k, zv_); } \
        { const unsigned vo_ = ((unsigned)(t0_ + srow) * D + c0_ + 16 * wave) * 2u; vv00 = *(const u32x4*)((const char*)V + vo_); vv01 = *(const u32x4*)((const char*)V + (vo_ + D * 2)); vv10 = *(const u32x4*)((const char*)V + (vo_ + 16)); vv11 = *(const u32x4*)((const char*)V + (vo_ + D * 2 + 16)); } \
        } while (0)
    zqe = (u32x4){0u, 0u, 0u, 0u};
#define MX_STATS_LOAD(uu, q0, q1) do { const unsigned vpo_ = ((unsigned)(((uu) >> 3) * 128 + (tid >> 2)) * 32 + (tid & 3) * 8) * 4u; q0 = *(const f32x4*)((const char*)VPART + vpo_); q1 = *(const f32x4*)((const char*)VPART + (vpo_ + 16)); } while (0)
#define MX_STATS_WRITE(q0, q1) do { float s1 = (q0[0] + q0[2]) + (q1[0] + q1[2]), s2 = (q0[1] + q0[3]) + (q1[1] + q1[3]); \
        s1 += __shfl_xor(s1, 1); s1 += __shfl_xor(s1, 2); s2 += __shfl_xor(s2, 1); s2 += __shfl_xor(s2, 2); \
        if ((tid & 3) == 0) { const float mean = s1 * (1.f / 1024.f); float var = s2 * (1.f / 1024.f) - mean * mean; var = var < 0.f ? 0.f : var; ST[tid >> 2] = mean; ST[128 + (tid >> 2)] = rsqrtf(var + EPS); } } while (0)
    int u = vcu;
    if (u < 1024) { MX_PREFETCH(u); f32x4 q0, q1; MX_STATS_LOAD(u, q0, q1); MX_STATS_WRITE(q0, q1); }
    for (; u < 1024; u += G) {
        const int ck = u >> 3, g = u & 7, t0 = ck * 128, c0 = g * 128, j = ck & 15;
        const int cch = c0 + 16 * wave + 4 * grp;
        if (g != gprev) {
            gprev = g;
#pragma unroll
            for (int it = 0; it < 4; ++it) { const int idx = it * 512 + tid, row = idx >> 4, ch = idx & 15;
                *(LAS u32x4*)(lds + MY_WS + row * 256 + ((ch ^ (row & 15)) << 4)) = *(const u32x4*)(WSGU + ((size_t)(g * 128 + row)) * 128 + ch * 8); }
            const int cc = c0 + 2 * cp;
            cw0 = *(const f32x2*)(in[4] + cc); cw1 = *(const f32x2*)(in[4] + 1024 + cc); cw2 = *(const f32x2*)(in[4] + 2048 + cc); cw3 = *(const f32x2*)(in[4] + 3072 + cc); ccb = *(const f32x2*)(in[5] + cc);
        }
        const int hblk = 2 * g + (wave >> 2), jj0 = (16 * wave) & 63;
        const bf16x8 bw00 = *(const bf16x8*)(WLRU + ((size_t)((0 * 16 + hblk) * 64 + jj0 + fr)) * 64 + 0 * 32 + 8 * grp), bw01 = *(const bf16x8*)(WLRU + ((size_t)((0 * 16 + hblk) * 64 + jj0 + fr)) * 64 + 1 * 32 + 8 * grp);
        const bf16x8 bw10 = *(const bf16x8*)(WLRU + ((size_t)((1 * 16 + hblk) * 64 + jj0 + fr)) * 64 + 0 * 32 + 8 * grp), bw11 = *(const bf16x8*)(WLRU + ((size_t)((1 * 16 + hblk) * 64 + jj0 + fr)) * 64 + 1 * 32 + 8 * grp);
        const f32x4 nba = *(const f32x4*)(in[7] + cch) * (-L2E), nbi = *(const f32x4*)(in[9] + cch) * (-L2E), ksp = *(const f32x4*)(SPL8 + cch);
        {
#pragma unroll
            for (int i = 0; i < 16; ++i) {
                const unsigned z0 = MX_ZR(i), z1 = MX_ZR(i + 1), z2 = MX_ZR(i + 2), z3 = MX_ZR(i + 3);
                const float x0 = ccb.x + cw0.x * bflo(z0) + cw1.x * bflo(z1) + cw2.x * bflo(z2) + cw3.x * bflo(z3);
                const float x1 = ccb.y + cw0.y * bfhi(z0) + cw1.y * bfhi(z1) + cw2.y * bfhi(z2) + cw3.y * bfhi(z3);
                *(LAS unsigned*)(lds + MY_XA + (16 * tg + i) * RS + 4 * cp) = cvt_pk_bf16(x0, x1);
            }
        }
        __syncthreads();
        {
            const float mua = ST[srow], rsa = ST[128 + srow], mub = ST[srow + 1], rsb = ST[128 + srow + 1];
#pragma unroll
            for (int ci = 0; ci < 2; ++ci) { const int chunk = 2 * wave + ci, cbase = c0 + 8 * chunk;
                f32x4 a0, a1, b0, b1; unpack8(ci ? vv10 : vv00, a0, a1); unpack8(ci ? vv11 : vv01, b0, b1);
                const f32x4 g0 = *(const f32x4*)(in[11] + cbase), g1 = *(const f32x4*)(in[11] + cbase + 4), l0 = *(const f32x4*)(in[12] + cbase), l1 = *(const f32x4*)(in[12] + cbase + 4);
                a0 = (a0 - mua) * rsa * g0 + l0; a1 = (a1 - mua) * rsa * g1 + l1; b0 = (b0 - mub) * rsb * g0 + l0; b1 = (b1 - mub) * rsb * g1 + l1;
#pragma unroll
                for (int i = 0; i < 8; ++i) { const int cl = 8 * chunk + i; const float va = i < 4 ? a0[i & 3] : a1[i & 3], vb = i < 4 ? b0[i & 3] : b1[i & 3];
                    *(LAS unsigned*)(lds + MY_VT + cl * 256 + ((sch ^ (cl & 15)) << 4) + 4 * pr) = cvt_pk_bf16(va, vb); }
            }
        }
        f32x4 R[8], I[8];
#pragma unroll
        for (int mt = 0; mt < 8; ++mt) { R[mt] = (f32x4){0.f, 0.f, 0.f, 0.f}; I[mt] = (f32x4){0.f, 0.f, 0.f, 0.f};
#pragma unroll
            for (int ks = 0; ks < 2; ++ks) { const bf16x8 a = *(const LAS bf16x8*)(lds + MY_XA + (mt * 16 + fr) * RS + ((wave >> 2) * 64 + ks * 32 + 8 * grp) * 2);
                R[mt] = __builtin_amdgcn_mfma_f32_16x16x32_bf16(ks ? bw01 : bw00, a, R[mt], 0, 0, 0); I[mt] = __builtin_amdgcn_mfma_f32_16x16x32_bf16(ks ? bw11 : bw10, a, I[mt], 0, 0, 0); } }
#pragma unroll
        for (int mt = 0; mt < 8; ++mt) {
            const u32x2 xw = *(const LAS u32x2*)(lds + MY_XA + (mt * 16 + fr) * RS + (16 * wave + 4 * grp) * 2);
            const f32x4 xa4 = {bflo(xw.x), bfhi(xw.x), bflo(xw.y), bfhi(xw.y)};
            const f32x4 t1 = R[mt] * (-L2E) + nba, t2 = I[mt] * (-L2E) + nbi;
            f32x4 d1, d2, inv;
#pragma unroll
            for (int r = 0; r < 4; ++r) { d1[r] = 1.f + __builtin_amdgcn_exp2f(t1[r]); d2[r] = 1.f + __builtin_amdgcn_exp2f(t2[r]); }
            const f32x4 dd = d1 * d2;
#pragma unroll
            for (int r = 0; r < 4; ++r) inv[r] = __builtin_amdgcn_rcpf(dd[r]);
            const f32x4 rr = d2 * inv, ii = d1 * inv, la = rr * ksp, x2 = la + la;
            const f32x4 av = 1.f + la * (1.f + la * (0.5f + la * (0.16666667f + la * (0.041666667f + la * 0.0083333333f))));
            const f32x4 om = -x2 * (1.f + x2 * (0.5f + x2 * (0.16666667f + x2 * (0.041666667f + x2 * 0.0083333333f))));
            f32x4 uv;
#pragma unroll
            for (int r = 0; r < 4; ++r) uv[r] = __builtin_amdgcn_sqrtf(om[r]);
            uv = uv * ii * xa4;
#pragma unroll
            for (int r = 0; r < 4; ++r) { float A_ = av[r], U_ = uv[r]; MX_SCAN16(A_, U_); R[mt][r] = A_; I[mt][r] = U_; }
        }
        {
            f32x4 Pc = {1.f, 1.f, 1.f, 1.f}, Hc = {0.f, 0.f, 0.f, 0.f};
#pragma unroll
            for (int mt = 0; mt < 8; ++mt) { Hc = Hc * R[mt] + I[mt]; Pc = Pc * R[mt]; }
            if (fr == 15) {
#pragma unroll
                for (int r = 0; r < 4; ++r) __hip_atomic_store(AGG + (size_t)ck * 1024 + cch + r, ((unsigned long long)__float_as_uint(Hc[r]) << 32) | (unsigned long long)__float_as_uint(Pc[r]), __ATOMIC_RELAXED, __HIP_MEMORY_SCOPE_AGENT);
            }
        }
        __syncthreads();
        if (u + G < 1024) MX_PREFETCH(u + G);
        unsigned long long ag0 = 0x000000003f800000ull, ag1 = 0x000000003f800000ull, ag2 = 0x000000003f800000ull, ag3 = 0x000000003f800000ull;
        if (j > 0 && fr < j) { const unsigned long long* ap = AGG + (size_t)(ck - j + fr) * 1024 + cch;
            ag0 = __hip_atomic_load(ap, __ATOMIC_RELAXED, __HIP_MEMORY_SCOPE_AGENT); ag1 = __hip_atomic_load(ap + 1, __ATOMIC_RELAXED, __HIP_MEMORY_SCOPE_AGENT);
            ag2 = __hip_atomic_load(ap + 2, __ATOMIC_RELAXED, __HIP_MEMORY_SCOPE_AGENT); ag3 = __hip_atomic_load(ap + 3, __ATOMIC_RELAXED, __HIP_MEMORY_SCOPE_AGENT); }
        {
            bf16x8 q[4];
#pragma unroll
            for (int ks = 0; ks < 4; ++ks) q[ks] = *(const LAS bf16x8*)(lds + MY_VT + (16 * wave + fr) * 256 + (((ks * 4 + grp) ^ fr) << 4));
#pragma unroll
            for (int mt = 0; mt < 8; ++mt) { f32x4 Sx = {0.f, 0.f, 0.f, 0.f};
#pragma unroll
                for (int ks = 0; ks <= mt / 2; ++ks) { const bf16x8 p = *(const LAS bf16x8*)(lds + MY_WS + (mt * 16 + fr) * 256 + (((ks * 4 + grp) ^ fr) << 4));
                    Sx = __builtin_amdgcn_mfma_f32_16x16x32_bf16(q[ks], p, Sx, 0, 0, 0); }
                *(LAS u32x2*)(lds + MY_SP + (mt * 16 + fr) * RS + (16 * wave + 4 * grp) * 2) = (u32x2){cvt_pk_bf16_cv(Sx[0], Sx[1]), cvt_pk_bf16_cv(Sx[2], Sx[3])}; }
        }
        {
            f32x4 hc0 = {0.f, 0.f, 0.f, 0.f};
            if (j > 0) {
                f32x4 lp, lh; unsigned spin = 0;
                for (;;) {
                    lp[0] = __uint_as_float((unsigned)ag0); lh[0] = __uint_as_float((unsigned)(ag0 >> 32)); lp[1] = __uint_as_float((unsigned)ag1); lh[1] = __uint_as_float((unsigned)(ag1 >> 32));
                    lp[2] = __uint_as_float((unsigned)ag2); lh[2] = __uint_as_float((unsigned)(ag2 >> 32)); lp[3] = __uint_as_float((unsigned)ag3); lh[3] = __uint_as_float((unsigned)(ag3 >> 32));
                    const bool ok = (lp[0] != 0.f) && (lp[1] != 0.f) && (lp[2] != 0.f) && (lp[3] != 0.f);
                    if (__all(ok)) break;
                    if (++spin > (1u << 22)) break;
                    __builtin_amdgcn_s_sleep(1);
                    if (fr < j) { const unsigned long long* ap = AGG + (size_t)(ck - j + fr) * 1024 + cch;
                        ag0 = __hip_atomic_load(ap, __ATOMIC_RELAXED, __HIP_MEMORY_SCOPE_AGENT); ag1 = __hip_atomic_load(ap + 1, __ATOMIC_RELAXED, __HIP_MEMORY_SCOPE_AGENT);
                        ag2 = __hip_atomic_load(ap + 2, __ATOMIC_RELAXED, __HIP_MEMORY_SCOPE_AGENT); ag3 = __hip_atomic_load(ap + 3, __ATOMIC_RELAXED, __HIP_MEMORY_SCOPE_AGENT); } }
#pragma unroll
                for (int r = 0; r < 4; ++r) { float A_ = lp[r], U_ = lh[r]; MX_SCAN16(A_, U_); hc0[r] = __shfl(U_, (lane & 48) | 15); }
            }
            f32x4 s = hc0;
#pragma unroll
            for (int mt = 0; mt < 8; ++mt) { f32x4 hb;
#pragma unroll
                for (int r = 0; r < 4; ++r) hb[r] = __shfl(s[r], (lane & 48) | 15);
                s = R[mt] * s + I[mt];
                const f32x4 hv = I[mt] + R[mt] * hb;
                *(LAS u32x2*)(lds + MY_XA + (mt * 16 + fr) * RS + (16 * wave + 4 * grp) * 2) = (u32x2){cvt_pk_bf16(hv[0], hv[1]), cvt_pk_bf16(hv[2], hv[3])}; }
        }
        u32x4 ga[4], ub[4]; float bsr[4]; f32x4 nq0 = {0.f, 0.f, 0.f, 0.f}, nq1 = {0.f, 0.f, 0.f, 0.f};
        if (u + G < 1024) MX_STATS_LOAD(u + G, nq0, nq1);
#pragma unroll
        for (int it = 0; it < 4; ++it) { const int idx = it * 512 + tid, row = idx >> 4, ch = idx & 15; const unsigned o = ((unsigned)(t0 + row) * D + c0 + ch * 8) * 2u; ga[it] = *(const u32x4*)((const char*)GA + o); ub[it] = *(const u32x4*)((const char*)UB + o); bsr[it] = in[14][g * 128 + row]; }
        __syncthreads();
#pragma unroll
        for (int it = 0; it < 4; ++it) { const int idx = it * 512 + tid, row = idx >> 4, ch = idx & 15;
            f32x4 g0, g1, u0, u1, h0, h1, s0, s1; unpack8(ga[it], g0, g1); unpack8(ub[it], u0, u1);
            unpack8(*(const LAS u32x4*)(lds + MY_XA + row * RS + ch * 16), h0, h1); unpack8(*(const LAS u32x4*)(lds + MY_SP + row * RS + ch * 16), s0, s1);
            *(u32x4*)((char*)MG + ((unsigned)(t0 + row) * D + c0 + ch * 8) * 2u) = pack8(g0 * h0 + u0 * (s0 + bsr[it]), g1 * h1 + u1 * (s1 + bsr[it])); }
        if (u + G < 1024) MX_STATS_WRITE(nq0, nq1);
        __syncthreads();
    }
#undef MX_PREFETCH
#undef MX_STATS_LOAD
#undef MX_STATS_WRITE
#undef MX_ZR
#undef MX_SETZR
}

__device__ __forceinline__ void build_moe_units(LAS int* tab1, LAS int* tab2, LAS int* tab3, const int* CNT, int vcu, int G, int wave) {
    if (wave == 0 && pg8::lane_id() == 0) {
        int NT = 0;
        for (int e = 0; e < 32; ++e) NT += (CNT[e] + 255) >> 8;
        const int U1 = 2 * NT; int nlate = (U1 > G && U1 < 2 * G) ? U1 - G : 0; if (G - nlate < 64) nlate = 0;
        const int Ge = G - nlate, c2 = vcu - nlate, rsplit = nlate ? G / 2 : NT;
        int n1 = 0, n2 = 0, n3 = 0, rt0 = 0; long L1 = vcu, L2 = c2 >= 0 ? c2 : (1L << 40);
        for (int e = 0; e < 32; ++e) { const int cnt = CNT[e]; const int ntl = (cnt + 255) >> 8;
            while (L1 < (long)(rt0 + ntl) * 2 && n1 < 12) { const int rt = (int)(L1 / 2), q = (int)(L1 % 2);
                LAS int* p = tab1 + 4 + 8 * n1; p[0] = rt; p[1] = e * 2 + q; p[2] = e; p[3] = rt - rt0; p[4] = cnt; ++n1; L1 += G; }
            while (L2 < (long)(rt0 + ntl) * 4) { const int rt = (int)(L2 / 4), q = (int)(L2 % 4);
                if (rt < rsplit) { if (n2 < 12) { LAS int* p = tab2 + 4 + 8 * n2; p[0] = rt; p[1] = e * 4 + q; p[2] = e; p[3] = rt - rt0; p[4] = cnt; ++n2; } }
                else if (n3 < 12) { LAS int* p = tab3 + 4 + 8 * n3; p[0] = rt; p[1] = e * 4 + q; p[2] = e; p[3] = rt - rt0; p[4] = cnt; ++n3; }
                L2 += Ge; }
            rt0 += ntl; }
        tab1[0] = n1; tab2[0] = n2; tab3[0] = n3;
    }
    __syncthreads();
}
__device__ __forceinline__ void moe_wait_tiles(const LAS int* tab, unsigned* dcnt, int wave) {
    if (wave == 0) {
        const int n = __builtin_amdgcn_readfirstlane(tab[0]);
        for (int i = 0; i < n; ++i) { const int rt = __builtin_amdgcn_readfirstlane(tab[4 + 8 * i]); unsigned sp = 0;
            while ((unsigned)__builtin_amdgcn_readfirstlane(__hip_atomic_load(dcnt + 64 * rt, __ATOMIC_RELAXED, __HIP_MEMORY_SCOPE_AGENT)) < 16u) { if (++sp > (1u << 22)) break; __builtin_amdgcn_s_sleep(2); } }
        __builtin_amdgcn_fence(__ATOMIC_ACQUIRE, "agent");
        asm volatile("s_waitcnt vmcnt(0)" ::: "memory");
    }
    __syncthreads();
}

struct Args { const float* in[28]; float* out; unsigned char* ws; int ph_lo, ph_hi, li, pad; };

__global__ void __launch_bounds__(NWAVES * 64, 2) mega_fwd(Args args) {
    extern __shared__ __attribute__((aligned(16))) unsigned char lds_raw[];
    LAS unsigned char* lds = (LAS unsigned char*)lds_raw;
    volatile LAS unsigned* MISC = (volatile LAS unsigned*)(lds + MISC_OFF);
    const int tid0 = threadIdx.x, wave = __builtin_amdgcn_readfirstlane(tid0 >> 6);
#define PHASE_IDS() int lane = pg8::lane_id(); asm volatile("" : "+v"(lane)); const int tid = wave * 64 + lane; (void)tid
    const int G = gridDim.x;
    const int vcu = (G % 8 == 0) ? ((int)blockIdx.x % 8) * (G / 8) + (int)blockIdx.x / 8 : (int)blockIdx.x;
    unsigned char* ws = args.ws;
    unsigned* ctl = (unsigned*)(ws + WS_CTL);
    for (int u = tid0; u < (LDS_BYTES - LDSCTL_OFF) / 4; u += NWAVES * 64) ((LAS unsigned*)(lds + LDSCTL_OFF))[u] = 0u;
    __syncthreads();
    XcdBarrier bar = xcd_barrier_post(ctl + CW_BAR + args.li * XCD_BAR_WORDS, MISC + 8, wave);
    const int lo = args.ph_lo, hi = args.ph_hi;
#define IN(k) (lo <= (k) && (k) < hi)
#define BOTH(k) (IN(k) && IN((k) + 1))
    const float* const* in = args.in;
    bf16 *XN = (bf16*)(ws + WS_A0), *MG = (bf16*)(ws + WS_A0), *X2b = (bf16*)(ws + WS_A0);
    bf16 *Zl = (bf16*)(ws + WS_A1), *X1b = (bf16*)(ws + WS_A1);
    bf16 *GA = (bf16*)(ws + WS_A2), *UB = (bf16*)(ws + WS_A3), *V = (bf16*)(ws + WS_A4);
    bf16 *X3 = (bf16*)(ws + WS_A1);
    bf16 *PU = (bf16*)(ws + WS_A2);
    bf16 *Pb = (bf16*)(ws + WS_PB);
    bf16 *WinT = (bf16*)(ws + WS_WIN), *WoutT = (bf16*)(ws + WS_WOUT), *WgT = (bf16*)(ws + WS_WG), *W13T = (bf16*)(ws + WS_W13), *W2T = (bf16*)(ws + WS_W2), *WupT = (bf16*)(ws + WS_WUP);
    float *VPART = (float*)(ws + WS_VPART), *SS1 = (float*)(ws + WS_SS1), *SS3 = (float*)(ws + WS_SS3), *RSTD2 = (float*)(ws + WS_RSTD2), *RSTD1 = (float*)(ws + WS_RSTD1), *TOKG = (float*)(ws + WS_TOKG);
    int *CNT = (int*)(ws + WS_CTL), *LIST = (int*)(ws + WS_LIST), *TOKE = (int*)(ws + WS_TOKE);
    bf16 *Hb = (bf16*)(ws + WS_A2), *Yb = (bf16*)(ws + WS_A3), *WrT = (bf16*)(ws + WS_WR), *WLRU = (bf16*)(ws + WS_WLRU), *WSGU = (bf16*)(ws + WS_WSGU);
    unsigned long long* AGGQ = (unsigned long long*)(ws + WS_AGG); float* SPL8 = (float*)(ws + WS_SPL8);

    if (IN(0)) {
        PHASE_IDS();
        LAS float* scr = (LAS float*)(lds + wave * 16384);
        const int gw = vcu * NWAVES + wave, NGW = G * NWAVES;
        for (int it = gw; it < 16 * 192; it += NGW) { const int kb = it / 192, nb = it % 192; p0_transpose_item(in[3], 6144, kb * 64, nb * 32, WinT, 1024, win_dest_row(nb * 32), nullptr, scr, lane); }
        for (int m = gw; m < T; m += 2 * NGW) {
            const int m2 = m + NGW < T ? m + NGW : m;
            const pg8::f32x4* xr = (const pg8::f32x4*)(in[0] + (size_t)m * D) + lane; const pg8::f32x4* xr2 = (const pg8::f32x4*)(in[0] + (size_t)m2 * D) + lane; const pg8::f32x4* gr = (const pg8::f32x4*)in[2] + lane;
            pg8::f32x4 v[4], w[4]; float s = 0.f, s2 = 0.f;
#pragma unroll
            for (int j = 0; j < 4; ++j) { v[j] = xr[64 * j]; w[j] = xr2[64 * j]; }
#pragma unroll
            for (int j = 0; j < 4; ++j) { s += (v[j].x * v[j].x + v[j].y * v[j].y) + (v[j].z * v[j].z + v[j].w * v[j].w); s2 += (w[j].x * w[j].x + w[j].y * w[j].y) + (w[j].z * w[j].z + w[j].w * w[j].w); }
            const float rstd = rsqrtf(wave_sum(s) * (1.f / D) + EPS), rstd2 = rsqrtf(wave_sum(s2) * (1.f / D) + EPS);
            unsigned long long* o8 = (unsigned long long*)(XN + (size_t)m * D) + lane; unsigned long long* o82 = (unsigned long long*)(XN + (size_t)m2 * D) + lane;
#pragma unroll
            for (int j = 0; j < 4; ++j) { const pg8::f32x4 gg = gr[64 * j];
                o8[64 * j] = (unsigned long long)pk2(v[j].x * rstd * gg.x, v[j].y * rstd * gg.y) | ((unsigned long long)pk2(v[j].z * rstd * gg.z, v[j].w * rstd * gg.w) << 32);
                o82[64 * j] = (unsigned long long)pk2(w[j].x * rstd2 * gg.x, w[j].y * rstd2 * gg.y) | ((unsigned long long)pk2(w[j].z * rstd2 * gg.z, w[j].w * rstd2 * gg.w) << 32); }
        }
        for (size_t i = (size_t)(vcu * 512 + tid); i < (size_t)T * 256 / 4; i += (size_t)G * 512) { const pg8::f32x4 v = ((const pg8::f32x4*)in[1])[i];
            ((unsigned long long*)Pb)[i] = (unsigned long long)pk2(v.x, v.y) | ((unsigned long long)pk2(v.z, v.w) << 32); }
        for (int i = vcu * 512 + tid; i < 2 * 16 * 64 * 64; i += G * 512) { const int gate = i >> 16, h = (i >> 12) & 15, j = (i >> 6) & 63, ii = i & 63;
            WLRU[i] = f2bf(in[gate ? 8 : 6][(h * 64 + ii) * 64 + j]); }
        for (int i = vcu * 512 + tid; i < 8 * 128 * 128; i += G * 512) { const int t = (i >> 7) & 127, s = i & 127; WSGU[i] = s <= t ? f2bf(in[13][i]) : (bf16)0; }
        for (int i = vcu * 512 + tid; i < 1024; i += G * 512) SPL8[i] = -8.f * log1pf(expf(-in[10][i]));
        for (int i = vcu * 512 + tid; i < 64 * 1024; i += G * 512) { const int n = i >> 10, k = i & 1023; float v = 0.f;
            if (n < 4) v = in[17][k * 4 + n] * in[16][k]; else if (n < 36) v = in[19][k * 32 + (n - 4)] * in[16][k];
            WrT[i] = f2bf(v); }
        if (BOTH(0)) xcd_barrier(bar);
    }
    if (IN(1)) {
        { pg8::Gemm g{XN, WinT, 1024}; Gemm1Order S; S.init(T, 6144, G, (int)blockIdx.x);
          S.wave = wave; S.w = DefW{in[15], in[21], in[22], in[23], in[25], in[26], in[16], in[24], WoutT, W13T, W2T, WgT, WupT};
          pg8::Epi1 E{Zl, GA, UB, V, VPART};
          pg8::gemm_phase<pg8::Epi1, Gemm1Order, true, true, false>(lds, g, S, E, wave); }
        if (BOTH(1)) xcd_barrier(bar);
    }

    if (IN(3)) {
        PHASE_IDS();
        mixer_phase(lds, vcu, G, tid, lane, wave, Zl, GA, UB, V, VPART, AGGQ, MG, WLRU, WSGU, SPL8, in);
        if (BOTH(3)) xcd_barrier(bar);
    }
    if (IN(4)) {
        pg8::Gemm g{MG, WoutT, 1024}; pg8::StaticOrder S; S.init(T, 1024, G, (int)blockIdx.x);
        pg8::Epi2 E{in[0], X1b, SS1};
        pg8::gemm_phase<pg8::Epi2, pg8::StaticOrder, true, true, false>(lds, g, S, E, wave);
        if (BOTH(4)) xcd_barrier(bar);
    }

    if (IN(5)) {
        PHASE_IDS();
        constexpr int RS = 528;
        LAS unsigned char* sA = lds; LAS unsigned char* sB = lds + 64 * RS; LAS float* sL = (LAS float*)(lds + 2 * 64 * RS);
        LAS int* sCnt = (LAS int*)(lds + 2 * 64 * RS + 64 * 65 * 4); LAS int* sBase = sCnt + 32;
        const int fr = lane & 15, grp = lane >> 4, mtile = wave & 3, np = wave >> 2;
        for (int tile = vcu; tile < T / 64; tile += G) {
            const int tok0 = tile * 64;
            if (tid < 32) sCnt[tid] = 0;
            pg8::f32x4 acc0 = {0.f, 0.f, 0.f, 0.f}, acc1 = {0.f, 0.f, 0.f, 0.f};
            for (int kc = 0; kc < 4; ++kc) {
#pragma unroll
                for (int it = 0; it < 4; ++it) { const int idx = it * 512 + tid, row = idx >> 5, ch = idx & 31;
                    *(LAS pg8::u32x4*)(sA + row * RS + ch * 16) = *(const pg8::u32x4*)(X1b + (size_t)(tok0 + row) * D + kc * 256 + ch * 8);
                    *(LAS pg8::u32x4*)(sB + row * RS + ch * 16) = *(const pg8::u32x4*)(WrT + (size_t)row * D + kc * 256 + ch * 8); }
                __syncthreads();
#pragma unroll
                for (int ks = 0; ks < 8; ++ks) {
                    const pg8::bf16x8 a = *(const LAS pg8::bf16x8*)(sA + (16 * mtile + fr) * RS + (ks * 32 + 8 * grp) * 2);
                    const pg8::bf16x8 b0 = *(const LAS pg8::bf16x8*)(sB + (32 * np + fr) * RS + (ks * 32 + 8 * grp) * 2);
                    const pg8::bf16x8 b1 = *(const LAS pg8::bf16x8*)(sB + (32 * np + 16 + fr) * RS + (ks * 32 + 8 * grp) * 2);
                    acc0 = __builtin_amdgcn_mfma_f32_16x16x32_bf16(a, b0, acc0, 0, 0, 0);
                    acc1 = __builtin_amdgcn_mfma_f32_16x16x32_bf16(a, b1, acc1, 0, 0, 0);
                }
                __syncthreads();
            }
#pragma unroll
            for (int r = 0; r < 4; ++r) { const int tk = 16 * mtile + 4 * grp + r; sL[tk * 65 + 32 * np + fr] = acc0[r]; sL[tk * 65 + 32 * np + 16 + fr] = acc1[r]; }
            __syncthreads();
            int e1 = 0, e2 = 0, r1 = 0, r2 = 0; float g1 = 0.f, g2 = 0.f;
            if (tid < 64) {
                const int t = tok0 + tid; float ss = 0.f;
#pragma unroll
                for (int q = 0; q < 16; ++q) ss += SS1[(size_t)t * 16 + q];
                const float rstd = rsqrtf(ss * (1.f / D) + EPS);
                RSTD1[t] = rstd;
                const LAS float* l = sL + tid * 65;
                float gl[4];
#pragma unroll
                for (int q = 0; q < 4; ++q) gl[q] = rstd * l[q] + in[18][q];
                float mx = gl[0]; int gi = 0;
#pragma unroll
                for (int q = 1; q < 4; ++q) if (gl[q] > mx) { mx = gl[q]; gi = q; }
                float den = 0.f;
#pragma unroll
                for (int q = 0; q < 4; ++q) den += expf(gl[q] - mx);
                const float gtop = 1.f / den;
                float m1 = -3.0e38f, m2 = -3.0e38f; int i1 = 0, i2 = 0;
                for (int j = 0; j < 8; ++j) { const float v = rstd * l[4 + gi * 8 + j] + in[20][gi * 8 + j];
                    if (v > m1) { m2 = m1; i2 = i1; m1 = v; i1 = j; } else if (v > m2) { m2 = v; i2 = j; } }
                const float p2 = expf(m2 - m1);
                g1 = gtop / (1.f + p2); g2 = gtop * p2 / (1.f + p2);
                e1 = gi * 8 + i1; e2 = gi * 8 + i2;
                r1 = __hip_atomic_fetch_add(&sCnt[e1], 1, __ATOMIC_RELAXED, __HIP_MEMORY_SCOPE_WORKGROUP); r2 = __hip_atomic_fetch_add(&sCnt[e2], 1, __ATOMIC_RELAXED, __HIP_MEMORY_SCOPE_WORKGROUP);
                TOKE[t * 2] = e1; TOKE[t * 2 + 1] = e2; TOKG[t * 2] = g1; TOKG[t * 2 + 1] = g2;
            }
            __syncthreads();
            if (tid < 32) { const int c = sCnt[tid]; sBase[tid] = c ? atomicAdd(&CNT[tid], c) : 0; }
            __syncthreads();
            if (tid < 64) { const int t = tok0 + tid; LIST[e1 * 16384 + sBase[e1] + r1] = t * 2; LIST[e2 * 16384 + sBase[e2] + r2] = t * 2 + 1; }
            __syncthreads();
        }
        if (BOTH(5)) xcd_barrier(bar);
    }
    if (IN(6)) {
        LAS int* tab1 = (LAS int*)(lds + TAB_OFF); LAS int* tab2 = (LAS int*)(lds + TAB_OFF + 512); LAS int* tab3 = (LAS int*)(lds + TAB_OFF + 1024);
        build_moe_units(tab1, tab2, tab3, CNT, vcu, G, wave);
        unsigned* dcnt = ctl + CW_DONE1;
        { pg8::Gemm g{X1b, W13T, 1024}; pg8::MoeOrder<1> S{tab1, LIST, dcnt};
          pg8::EpiMoe1 E{Hb, LIST, RSTD1};
          pg8::gemm_phase<pg8::EpiMoe1, pg8::MoeOrder<1>, true, true, true>(lds, g, S, E, wave); }
        pg8::Gemm g2{Hb, W2T, 256}; pg8::EpiMoe2 E2{Yb, LIST, TOKG};
        moe_wait_tiles(tab2, dcnt, wave);
        { pg8::MoeOrder<0> S{tab2, LIST, dcnt}; pg8::gemm_phase<pg8::EpiMoe2, pg8::MoeOrder<0>, true, true, false>(lds, g2, S, E2, wave); }
        moe_wait_tiles(tab3, dcnt, wave);
        { pg8::MoeOrder<0> S{tab3, LIST, dcnt}; pg8::gemm_phase<pg8::EpiMoe2, pg8::MoeOrder<0>, true, true, false>(lds, g2, S, E2, wave); }
        if (BOTH(6)) xcd_barrier(bar);
    }
    if (IN(8)) {
        PHASE_IDS();
        const int gw = vcu * NWAVES + wave, NGW = G * NWAVES;
        for (int row = gw; row < T; row += NGW) { float ss = 0.f;
#pragma unroll
            for (int hh = 0; hh < 2; ++hh) { const size_t o = (size_t)row * D + hh * 512 + lane * 8;
                pg8::f32x4 a0, a1, b0, b1, c0, c1; pg8::unpack8(*(const pg8::u32x4*)(X1b + o), a0, a1);
                pg8::unpack8(*(const pg8::u32x4*)(Yb + (size_t)row * 2 * D + hh * 512 + lane * 8), b0, b1); pg8::unpack8(*(const pg8::u32x4*)(Yb + ((size_t)row * 2 + 1) * D + hh * 512 + lane * 8), c0, c1);
                a0 = a0 + b0 + c0; a1 = a1 + b1 + c1;
                ss += (a0[0] * a0[0] + a0[1] * a0[1]) + (a0[2] * a0[2] + a0[3] * a0[3]) + (a1[0] * a1[0] + a1[1] * a1[1]) + (a1[2] * a1[2] + a1[3] * a1[3]);
                *(pg8::u32x4*)(X2b + o) = pg8::pack8(a0, a1); }
            ss = wave_sum(ss);
            if (lane == 0) RSTD2[row] = rsqrtf(ss * (1.f / D) + EPS); }
        if (BOTH(8)) xcd_barrier(bar);
    }
    const bool fuse_final = (G == 256);
    if (IN(9)) {
        { pg8::Gemm g{Pb, WupT, 256}; pg8::StaticOrder S; S.init(T, 1024, G, (int)blockIdx.x);
          pg8::EpiPlain E{PU};
          pg8::gemm_phase<pg8::EpiPlain, pg8::StaticOrder, true, true, false>(lds, g, S, E, wave); }
        pg8::Gemm g{X2b, WgT, 1024}; pg8::StaticOrder S; S.init(T, 1024, G, (int)blockIdx.x);
        if (fuse_final) {
            pg8::EpiPleFinal E{X2b, PU, RSTD2, in[27], args.out, (float*)(ws + WS_XCH), ctl + CW_PANEL, (LAS float*)(lds + RING_BYTES), wave};
            pg8::gemm_phase<pg8::EpiPleFinal, pg8::StaticOrder, true, true, false>(lds, g, S, E, wave);
        } else {
            pg8::EpiPle E{X2b, PU, RSTD2, X3, SS3};
            pg8::gemm_phase<pg8::EpiPle, pg8::StaticOrder, true, true, false>(lds, g, S, E, wave);
            if (BOTH(9)) xcd_barrier(bar);
        }
    }

    if (IN(10) && !fuse_final) {
        PHASE_IDS();
        const int gw = vcu * NWAVES + wave, NGW = G * NWAVES;
        for (int row = gw; row < T; row += NGW) { float ss = 0.f;
            if (lane < 16) ss = SS3[(size_t)row * 16 + lane];
            ss = wave_sum(ss);
            const float rstd = rsqrtf(ss * (1.f / D) + EPS);
#pragma unroll
            for (int hh = 0; hh < 2; ++hh) { const size_t o = (size_t)row * D + hh * 512 + lane * 8; pg8::f32x4 a0, a1; pg8::unpack8(*(const pg8::u32x4*)(X3 + o), a0, a1);
                const pg8::f32x4 f0 = *(const pg8::f32x4*)(in[27] + hh * 512 + lane * 8), f1 = *(const pg8::f32x4*)(in[27] + hh * 512 + lane * 8 + 4);
                *(pg8::f32x4*)(args.out + o) = a0 * rstd * f0; *(pg8::f32x4*)(args.out + o + 4) = a1 * rstd * f1; } }
    }
#undef IN
#undef BOTH
#undef PHASE_IDS
}

static int mega_grid() {
    static int grid = 0;
    if (grid == 0) {
        int dev = 0, cus = 0;
        if (hipGetDevice(&dev) != hipSuccess || hipDeviceGetAttribute(&cus, hipDeviceAttributeMultiprocessorCount, dev) != hipSuccess) { fprintf(stderr, "mega: device query failed\n"); grid = -1; return grid; }
        if (hipFuncSetAttribute((const void*)mega_fwd, hipFuncAttributeMaxDynamicSharedMemorySize, LDS_BYTES) != hipSuccess) { fprintf(stderr, "mega: hipFuncSetAttribute failed\n"); grid = -1; return grid; }
        (void)hipGetLastError();
        grid = cus;
    }
    return grid;
}
static void launch_mega(void* const* d_in, void* d_out, void* d_ws, int lo, int hi, int li, hipStream_t stream) {
    const int grid = mega_grid(); if (grid <= 0) return;
    Args a{};
    for (int i = 0; i < 28; ++i) a.in[i] = (const float*)d_in[i];
    a.out = (float*)d_out; a.ws = (unsigned char*)d_ws; a.ph_lo = lo; a.ph_hi = hi; a.li = li; a.pad = 0;
    hipLaunchKernelGGL(mega_fwd, dim3(grid), dim3(NWAVES * 64), LDS_BYTES, stream, a);
}

extern "C" void kernel_launch(void* const* d_in, const int* in_sizes, int n_in, void* d_out, int out_size, void* d_ws, size_t ws_size, hipStream_t stream) {
    if (n_in != 28 || in_sizes[0] != T * D || out_size != T * D || ws_size < WS_MEGA_END) { fprintf(stderr, "kernel_launch: unexpected shapes (n_in %d, ws %zu)\n", n_in, ws_size); return; }
    (void)hipMemsetAsync(d_ws, 0, 2 * MiB, stream);
    launch_mega(d_in, d_out, d_ws, 0, 11, 0, stream);
}
```

```cpp
#include <hip/hip_runtime.h>
#include <stdint.h>
#include <cstdio>

typedef unsigned short bf16;
constexpr int T = 16384, D = 1024, SEQ = 2048;
constexpr float EPS = 1e-6f;
constexpr size_t MiB = 1u << 20;
constexpr size_t WS_CTL = 0;
constexpr size_t WS_VPART = 2 * MiB;
constexpr size_t WS_SS1 = 4 * MiB;
constexpr size_t WS_SS3 = 5 * MiB;
constexpr size_t WS_AGG = 1 * MiB;
constexpr size_t WS_LIST = 6 * MiB;
constexpr size_t WS_TOKE = 8 * MiB;
constexpr size_t WS_TOKG = 8 * MiB + 128 * 1024;
constexpr size_t WS_RSTD2 = 8 * MiB + 256 * 1024;
constexpr size_t WS_A0 = 74 * MiB;
constexpr size_t WS_A1 = 106 * MiB;
constexpr size_t WS_A2 = 138 * MiB;
constexpr size_t WS_A3 = 170 * MiB;
constexpr size_t WS_A4 = 202 * MiB;
constexpr size_t WS_END = 234 * MiB;

__device__ __forceinline__ float bf2f(bf16 b) { return __uint_as_float(((unsigned)b) << 16); }
__device__ __forceinline__ bf16 f2bf(float f) { unsigned u = __float_as_uint(f); u += 0x7fffu + ((u >> 16) & 1u); return (bf16)(u >> 16); }
__device__ __forceinline__ float sigm(float x) { return 1.f / (1.f + expf(-x)); }
__device__ __forceinline__ float gelu_t(float x) { const float u = 0.7978845608028654f * (x + 0.044715f * x * x * x); return 0.5f * x * (1.f + tanhf(u)); }
__device__ __forceinline__ float wave_sum(float v) {
#pragma unroll
    for (int o = 1; o < 64; o <<= 1) v += __shfl_xor(v, o);
    return v;
}

#define LAS __attribute__((address_space(3)))
#define GAS __attribute__((address_space(1)))
namespace pg8 {
typedef short bf16x8 __attribute__((ext_vector_type(8)));
typedef float f32x4 __attribute__((ext_vector_type(4)));
typedef float f32x2 __attribute__((ext_vector_type(2)));
typedef unsigned u32x4 __attribute__((ext_vector_type(4)));
typedef unsigned u32x2 __attribute__((ext_vector_type(2)));
constexpr int BM = 256, BK = 64, HALF = 128, HTB = HALF * BK * 2, STAGE_BYTES = 8 * HTB, NXCD = 8, WGM = 8;

__host__ __device__ __forceinline__ int lds_byte(int r, int c) { const int st = (r >> 4) * 2 + (c >> 5), rr = r & 15, cc = c & 31, ob = rr * 64 + cc * 2; return st * 1024 + (ob ^ (((ob >> 9) & 1) << 5)); }
__host__ __device__ __forceinline__ void stage_rc(int b, int& R, int& C) { const int st = b / 1024, sb = b % 1024, swz = sb ^ (((sb >> 9) & 1) << 5); R = (st >> 1) * 16 + swz / 64; C = (st & 1) * 32 + (swz % 64) / 2; }
__host__ __device__ __forceinline__ int perm32(int rho) { const int n = rho >> 4, i = rho & 15; return 8 * (i >> 2) + 4 * n + (i & 3); }

__device__ __forceinline__ int lane_id() { int l; asm volatile("v_mbcnt_lo_u32_b32 %0, -1, 0\n\tv_mbcnt_hi_u32_b32 %0, -1, %0" : "=v"(l)); return l; }
struct Unit { int pm, pn, e, tile, cnt; };
struct Gemm { const bf16* A; const bf16* Bt; int K; };

struct StaticOrder {
    int nM, nN, nwg, G, c;
    __device__ void init(int M, int N, int G_, int c_) { nM = M / BM; nN = N / BM; nwg = nM * nN; G = G_; c = c_; }
    __device__ bool next(int i, Unit& u) const {
        const long L = (long)i * G + c; if (L >= nwg) return false;
        int wgid = (int)L; { const int q = nwg / NXCD, r = nwg % NXCD, xcd = wgid % NXCD, off = wgid / NXCD; wgid = (xcd < r ? xcd * (q + 1) : r * (q + 1) + (xcd - r) * q) + off; }
        const int nig = WGM * nN, gid = wgid / nig, fm = gid * WGM, gsz = (nM - fm) < WGM ? (nM - fm) : WGM;
        u.pm = fm + ((wgid % nig) % gsz); u.pn = (wgid % nig) / gsz; u.e = 0; u.tile = 0; u.cnt = 0; return true;
    }
    __device__ __forceinline__ unsigned row_off(const Unit&, int) const { return 0u; }
    __device__ __forceinline__ void a_ready(const Unit&) const {}
    __device__ __forceinline__ void done(const Unit&) const {}
    struct Pre {}; __device__ __forceinline__ void pre(int, Pre&) const {}
    __device__ __forceinline__ void post(int, Pre&) const {}
    __device__ __forceinline__ bool half(const Unit&) const { return false; }
};

__device__ __forceinline__ unsigned cvt_pk_bf16(float lo, float hi) { unsigned r; asm volatile("v_cvt_pk_bf16_f32 %0, %1, %2" : "=v"(r) : "v"(lo), "v"(hi)); return r; }
typedef __bf16 bf16x2_t __attribute__((ext_vector_type(2)));
__device__ __forceinline__ unsigned cvt_pk_bf16_cv(float lo, float hi) { const f32x2 v = {lo, hi}; const bf16x2_t b = __builtin_convertvector(v, bf16x2_t); return __builtin_bit_cast(unsigned, b); }
__device__ __forceinline__ float fsigm(float x) { return __builtin_amdgcn_rcpf(1.0f + __builtin_amdgcn_exp2f(-1.4426950409f * x)); }
__device__ __forceinline__ float fgelu(float x) { const float u = x + 0.044715f * x * x * x; return x * __builtin_amdgcn_rcpf(1.0f + __builtin_amdgcn_exp2f(-2.3022082f * u)); }

template <class Epi, class Sched, bool ALIGN_EPI, bool SP2, bool GATHER>
__device__ __forceinline__ void gemm_phase(LAS unsigned char* lds, const Gemm g, const Sched& S, const Epi& E, const int wave_) {
    int lane = lane_id(); asm volatile("" : "+v"(lane));
    const int wid = wave_, tid = wid * 64 + lane, wr = wid >> 2, wc = wid & 3, fr = lane & 15, fq = lane >> 4;
    const int K = g.K, nt = K / BK;
    int sR[2], sC[2];
    unsigned voffB[2], vA0[2], vA1[2], nvA0[2], nvA1[2];
#pragma unroll
    for (int i = 0; i < 2; ++i) { stage_rc(tid * 16 + i * 8192, sR[i], sC[i]); const int Rb = Epi::PERM ? ((sR[i] & ~31) + perm32(sR[i] & 31)) : sR[i];
        voffB[i] = (unsigned)(Rb * K + sC[i]) * 2u; vA0[i] = (unsigned)(sR[i] * K + sC[i]) * 2u; vA1[i] = vA0[i]; nvA0[i] = vA0[i]; nvA1[i] = vA0[i]; }
    const size_t kstep = (size_t)(BK * 2);
    const size_t hstep = (size_t)HALF * K * 2;
    const size_t tstep = 2 * hstep;
    const size_t ahs = GATHER ? 0 : hstep;
    const unsigned ldsw = (unsigned)wid * 1024u;
    const int aoff = lds_byte(wr * 64 + fr, fq * 8), boff = lds_byte(wc * 32 + fr, fq * 8);
#define PG8_SA(b, h) (((b) * 2 + (h)) * HTB)
#define PG8_SB(b, h) ((4 + (b) * 2 + (h)) * HTB)
#define PG8_STAGE(bufoff, gbase, voff) do { _Pragma("unroll") for (int _i = 0; _i < 2; ++_i) \
        __builtin_amdgcn_global_load_lds((const unsigned*)((const char*)(gbase) + (voff)[_i]), (LAS unsigned*)(lds + (bufoff) + ldsw + _i * 8192), 16, 0, 0); } while (0)
#define PG8_LDA(dst, b, h) do { _Pragma("unroll") for (int m = 0; m < 4; ++m) _Pragma("unroll") for (int k = 0; k < 2; ++k) dst[m][k] = *(const LAS bf16x8*)(lds + PG8_SA(b, h) + aoff + m * 2048 + k * 1024); } while (0)
#define PG8_LDB(dst, b, h) do { _Pragma("unroll") for (int n = 0; n < 2; ++n) _Pragma("unroll") for (int k = 0; k < 2; ++k) dst[n][k] = *(const LAS bf16x8*)(lds + PG8_SB(b, h) + boff + n * 2048 + k * 1024); } while (0)
#define PG8_MMA(ai, bj, At, Bt) do { __builtin_amdgcn_s_setprio(1); _Pragma("unroll") for (int m = 0; m < 4; ++m) _Pragma("unroll") for (int n = 0; n < 2; ++n) _Pragma("unroll") for (int k = 0; k < 2; ++k) \
        acc[ai][bj][m][n] = __builtin_amdgcn_mfma_f32_16x16x32_bf16(Bt[n][k], At[m][k], acc[ai][bj][m][n], 0, 0, 0); __builtin_amdgcn_s_setprio(0); } while (0)
#define PG8_WAIT_V(n) asm volatile("s_waitcnt vmcnt(" #n ")" ::: "memory")
#define PG8_WAIT_L(n) asm volatile("s_waitcnt lgkmcnt(" #n ")" ::: "memory")
#define PG8_BAR __builtin_amdgcn_s_barrier()
#define PG8_SCHED __builtin_amdgcn_sched_barrier(0)
    Unit cur, nxt; int ui = 0;
    if (!S.next(0, cur)) return;
    f32x4 acc[2][2][4][2];
#pragma unroll
    for (int a = 0; a < 2; ++a)
#pragma unroll
        for (int b = 0; b < 2; ++b)
#pragma unroll
            for (int m = 0; m < 4; ++m)
#pragma unroll
                for (int n = 0; n < 2; ++n) acc[a][b][m][n] = (f32x4){0.f, 0.f, 0.f, 0.f};
    bf16x8 At[4][2], B0[2][2], B1[2][2];
    const char* cA = GATHER ? (const char*)g.A : (const char*)g.A + (size_t)cur.pm * tstep; const char* cB = (const char*)g.Bt + (size_t)cur.pn * tstep;
    if constexpr (GATHER) {
#pragma unroll
        for (int i = 0; i < 2; ++i) { vA0[i] = S.row_off(cur, sR[i]) + (unsigned)sC[i] * 2u; vA1[i] = S.row_off(cur, HALF + sR[i]) + (unsigned)sC[i] * 2u; nvA0[i] = vA0[i]; nvA1[i] = vA1[i]; }
    }
    S.a_ready(cur);
    if constexpr (SP2) {
        PG8_STAGE(PG8_SB(0, 0), cB, voffB); PG8_STAGE(PG8_SB(0, 1), cB + hstep, voffB); PG8_STAGE(PG8_SA(0, 0), cA, vA0); PG8_STAGE(PG8_SA(0, 1), cA + ahs, vA1);
        if (wr == 1) PG8_BAR;
        PG8_WAIT_V(2); PG8_BAR;
        PG8_STAGE(PG8_SB(1, 0), cB + kstep, voffB); PG8_STAGE(PG8_SA(1, 0), cA + kstep, vA0); PG8_STAGE(PG8_SB(1, 1), cB + hstep + kstep, voffB);
        PG8_WAIT_V(6); PG8_BAR;
    } else {
        PG8_STAGE(PG8_SB(0, 0), cB, voffB); PG8_STAGE(PG8_SA(0, 0), cA, vA0); PG8_STAGE(PG8_SB(0, 1), cB + hstep, voffB); PG8_STAGE(PG8_SA(0, 1), cA + ahs, vA1);
        if (wr == 1) PG8_BAR;
        PG8_WAIT_V(4); PG8_BAR;
        PG8_STAGE(PG8_SB(1, 0), cB + kstep, voffB); PG8_STAGE(PG8_SA(1, 0), cA + kstep, vA0); PG8_STAGE(PG8_SB(1, 1), cB + hstep + kstep, voffB);
        PG8_WAIT_V(6); PG8_BAR;
    }
    for (;;) {
        const bool has_next = S.next(ui + 1, nxt);
        const char* nA = has_next ? (GATHER ? (const char*)g.A : (const char*)g.A + (size_t)nxt.pm * tstep) : cA; const char* nB = has_next ? (const char*)g.Bt + (size_t)nxt.pn * tstep : cB;
        const bool hf = S.half(cur);
        for (int t = 0; t < nt; t += 2) {
            const bool last = (t == nt - 2);
            const char* a1 = cA + (size_t)(t + 1) * kstep;
            const char* a2 = last ? nA : cA + (size_t)(t + 2) * kstep; const char* b2 = last ? nB : cB + (size_t)(t + 2) * kstep;
            const char* a3 = a2 + kstep; const char* b3 = b2 + kstep;
            if (last && has_next) S.a_ready(nxt);
            unsigned w0[2], w1[2];
            if constexpr (GATHER) {
                if (last && has_next) {
#pragma unroll
                    for (int i = 0; i < 2; ++i) { nvA0[i] = S.row_off(nxt, sR[i]) + (unsigned)sC[i] * 2u; nvA1[i] = S.row_off(nxt, HALF + sR[i]) + (unsigned)sC[i] * 2u; }
                }
#pragma unroll
                for (int i = 0; i < 2; ++i) { w0[i] = last ? nvA0[i] : vA0[i]; w1[i] = last ? nvA1[i] : vA1[i]; }
            } else {
#pragma unroll
                for (int i = 0; i < 2; ++i) { w0[i] = vA0[i]; w1[i] = vA0[i]; }
            }
            if constexpr (SP2) {
            PG8_LDB(B0, 0, 0); PG8_LDB(B1, 0, 1); PG8_SCHED; PG8_LDA(At, 0, 0); PG8_STAGE(PG8_SA(1, 1), a1 + ahs, vA1);
            PG8_WAIT_V(8); PG8_WAIT_L(0); PG8_BAR; PG8_MMA(0, 0, At, B0); PG8_MMA(0, 1, At, B1); PG8_BAR; PG8_SCHED;
            if (!hf) PG8_LDA(At, 0, 1); PG8_STAGE(PG8_SB(0, 0), b2, voffB); PG8_STAGE(PG8_SB(0, 1), b2 + hstep, voffB); PG8_STAGE(PG8_SA(0, 0), a2, w0);
            PG8_WAIT_V(8); PG8_WAIT_L(0); PG8_BAR; if (!hf) { PG8_MMA(1, 0, At, B0); PG8_MMA(1, 1, At, B1); } PG8_BAR; PG8_SCHED;
            PG8_LDB(B0, 1, 0); PG8_LDB(B1, 1, 1); PG8_SCHED; PG8_LDA(At, 1, 0); PG8_STAGE(PG8_SA(0, 1), a2 + ahs, w1);
            PG8_WAIT_V(8); PG8_WAIT_L(0); PG8_BAR; PG8_MMA(0, 0, At, B0); PG8_MMA(0, 1, At, B1); PG8_BAR; PG8_SCHED;
            if (!hf) PG8_LDA(At, 1, 1); PG8_STAGE(PG8_SB(1, 0), b3, voffB); PG8_STAGE(PG8_SB(1, 1), b3 + hstep, voffB); PG8_STAGE(PG8_SA(1, 0), a3, w0);
            PG8_WAIT_V(8); PG8_WAIT_L(0); PG8_BAR; if (!hf) { PG8_MMA(1, 0, At, B0); PG8_MMA(1, 1, At, B1); } PG8_BAR; PG8_SCHED;
            } else {
            PG8_LDB(B0, 0, 0); PG8_SCHED; PG8_LDA(At, 0, 0); PG8_STAGE(PG8_SA(1, 1), a1 + ahs, vA1);
            PG8_WAIT_L(8); PG8_BAR; PG8_WAIT_L(0); PG8_MMA(0, 0, At, B0); PG8_BAR; PG8_SCHED;
            PG8_LDB(B1, 0, 1); PG8_STAGE(PG8_SB(0, 0), b2, voffB);
            PG8_BAR; PG8_WAIT_L(0); PG8_MMA(0, 1, At, B1); PG8_BAR;
            PG8_LDA(At, 0, 1); PG8_STAGE(PG8_SA(0, 0), a2, w0);
            PG8_BAR; PG8_WAIT_L(0); PG8_MMA(1, 0, At, B0); PG8_BAR; PG8_SCHED;
            PG8_STAGE(PG8_SB(0, 1), b2 + hstep, voffB);
            PG8_WAIT_V(6); PG8_BAR; PG8_MMA(1, 1, At, B1); PG8_BAR;
            PG8_LDB(B0, 1, 0); PG8_SCHED; PG8_LDA(At, 1, 0); PG8_STAGE(PG8_SA(0, 1), a2 + ahs, w1);
            PG8_WAIT_L(8); PG8_BAR; PG8_WAIT_L(0); PG8_MMA(0, 0, At, B0); PG8_BAR; PG8_SCHED;
            PG8_LDB(B1, 1, 1); PG8_STAGE(PG8_SB(1, 0), b3, voffB);
            PG8_BAR; PG8_WAIT_L(0); PG8_MMA(0, 1, At, B1); PG8_BAR;
            PG8_LDA(At, 1, 1); PG8_STAGE(PG8_SA(1, 0), a3, w0);
            PG8_BAR; PG8_WAIT_L(0); PG8_MMA(1, 0, At, B0); PG8_BAR; PG8_SCHED;
            PG8_STAGE(PG8_SB(1, 1), b3 + hstep, voffB);
            PG8_WAIT_V(6); PG8_BAR; PG8_MMA(1, 1, At, B1); PG8_BAR;
            }
        }
        if constexpr (ALIGN_EPI) { if (wr == 0) PG8_BAR; }
        typename Sched::Pre pre_; S.pre(ui, pre_);
        E(acc, cur, wr, wc, fr, fq); S.done(cur); S.post(ui, pre_);
        if (!has_next) break;
#pragma unroll
        for (int a = 0; a < 2; ++a)
#pragma unroll
            for (int b = 0; b < 2; ++b)
#pragma unroll
                for (int m = 0; m < 4; ++m)
#pragma unroll
                    for (int n = 0; n < 2; ++n) acc[a][b][m][n] = (f32x4){0.f, 0.f, 0.f, 0.f};
        cur = nxt; cA = nA; cB = nB; ++ui;
        if constexpr (GATHER) {
#pragma unroll
            for (int i = 0; i < 2; ++i) { vA0[i] = nvA0[i]; vA1[i] = nvA1[i]; }
        }
        if constexpr (ALIGN_EPI) { if (wr == 1) PG8_BAR; }
    }
    PG8_WAIT_V(0);
    if constexpr (!ALIGN_EPI) { if (wr == 0) PG8_BAR; }
    PG8_BAR;
#undef PG8_SA
#undef PG8_SB
#undef PG8_STAGE
#undef PG8_LDA
#undef PG8_LDB
#undef PG8_MMA
#undef PG8_WAIT_V
#undef PG8_WAIT_L
#undef PG8_BAR
#undef PG8_SCHED
}

__device__ __forceinline__ u32x4 pack8(const f32x4 v0, const f32x4 v1) { u32x4 w; w.x = cvt_pk_bf16(v0[0], v0[1]); w.y = cvt_pk_bf16(v0[2], v0[3]); w.z = cvt_pk_bf16(v1[0], v1[1]); w.w = cvt_pk_bf16(v1[2], v1[3]); return w; }
__device__ __forceinline__ void unpack8(const u32x4 w, f32x4& v0, f32x4& v1) {
    v0[0] = __uint_as_float(w.x << 16); v0[1] = __uint_as_float(w.x & 0xffff0000u); v0[2] = __uint_as_float(w.y << 16); v0[3] = __uint_as_float(w.y & 0xffff0000u);
    v1[0] = __uint_as_float(w.z << 16); v1[1] = __uint_as_float(w.z & 0xffff0000u); v1[2] = __uint_as_float(w.w << 16); v1[3] = __uint_as_float(w.w & 0xffff0000u); }

struct Epi1 {
    static constexpr bool PERM = true;
    bf16 *Zl, *GA, *UB, *V; float* VPART;
    __device__ __forceinline__ void operator()(const f32x4 (&acc)[2][2][4][2], const Unit& u, int wr, int wc, int fr, int fq) const {
        const int row0 = u.pm * BM + wr * 64 + fr, pn = u.pn;
        if (pn < 4) {
            const int col0 = pn * 256 + wc * 32 + 8 * fq;
#pragma unroll
            for (int ai = 0; ai < 2; ++ai)
#pragma unroll
                for (int m = 0; m < 4; ++m) { bf16* rowp = Zl + (size_t)(row0 + ai * HALF + m * 16) * D + col0;
#pragma unroll
                    for (int bj = 0; bj < 2; ++bj) *(u32x4*)(rowp + bj * HALF) = pack8(acc[ai][bj][m][0], acc[ai][bj][m][1]); }
        } else if (pn < 20) {
            bf16* O = pn < 12 ? GA : UB; const int uu = pn < 12 ? pn - 4 : pn - 12; const int col0 = uu * 128 + wc * 32 + 8 * fq;
#pragma unroll
            for (int ai = 0; ai < 2; ++ai)
#pragma unroll
                for (int m = 0; m < 4; ++m) { f32x4 v[2];
#pragma unroll
                    for (int n = 0; n < 2; ++n)
#pragma unroll
                        for (int i = 0; i < 4; ++i) v[n][i] = fgelu(acc[ai][0][m][n][i]) * fsigm(acc[ai][1][m][n][i]);
                    *(u32x4*)(O + (size_t)(row0 + ai * HALF + m * 16) * D + col0) = pack8(v[0], v[1]); }
        } else {
            const int col0 = (pn - 20) * 256 + wc * 32 + 8 * fq;
#pragma unroll
            for (int ai = 0; ai < 2; ++ai)
#pragma unroll
                for (int m = 0; m < 4; ++m) { const int row = row0 + ai * HALF + m * 16; float s1 = 0.f, s2 = 0.f;
#pragma unroll
                    for (int bj = 0; bj < 2; ++bj) { f32x4 v[2];
#pragma unroll
                        for (int n = 0; n < 2; ++n)
#pragma unroll
                            for (int i = 0; i < 4; ++i) { const float gv = fgelu(acc[ai][bj][m][n][i]); v[n][i] = gv; s1 += gv; s2 += gv * gv; }
                        *(u32x4*)(V + (size_t)row * D + col0 + bj * HALF) = pack8(v[0], v[1]); }
                    s1 += __shfl_xor(s1, 16); s1 += __shfl_xor(s1, 32); s2 += __shfl_xor(s2, 16); s2 += __shfl_xor(s2, 32);
                    if (fq == 0) *(f32x2*)(VPART + (size_t)row * 32 + ((pn - 20) * 4 + wc) * 2) = (f32x2){s1, s2}; }
        }
    }
};
struct EpiPlain {
    static constexpr bool PERM = true;
    bf16* O;
    __device__ __forceinline__ void operator()(const f32x4 (&acc)[2][2][4][2], const Unit& u, int wr, int wc, int fr, int fq) const {
        const int row0 = u.pm * BM + wr * 64 + fr, col0 = u.pn * 256 + wc * 32 + 8 * fq;
#pragma unroll
        for (int ai = 0; ai < 2; ++ai)
#pragma unroll
            for (int m = 0; m < 4; ++m) { bf16* rowp = O + (size_t)(row0 + ai * HALF + m * 16) * D + col0;
#pragma unroll
                for (int bj = 0; bj < 2; ++bj) *(u32x4*)(rowp + bj * HALF) = pack8(acc[ai][bj][m][0], acc[ai][bj][m][1]); }
    }
};
struct Epi2 {
    static constexpr bool PERM = true;
    const float* x; bf16* X1b; float* SS1;
    __device__ __forceinline__ void operator()(const f32x4 (&acc)[2][2][4][2], const Unit& u, int wr, int wc, int fr, int fq) const {
        const int row0 = u.pm * BM + wr * 64 + fr, col0 = u.pn * 256 + wc * 32 + 8 * fq;
#pragma unroll
        for (int ai = 0; ai < 2; ++ai)
#pragma unroll
            for (int m = 0; m < 4; ++m) { const int row = row0 + ai * HALF + m * 16; float ss = 0.f;
#pragma unroll
                for (int bj = 0; bj < 2; ++bj) { const float* xp = x + (size_t)row * D + col0 + bj * HALF;
                    const f32x4 v0 = acc[ai][bj][m][0] + *(const f32x4*)xp, v1 = acc[ai][bj][m][1] + *(const f32x4*)(xp + 4);
                    ss += (v0[0] * v0[0] + v0[1] * v0[1]) + (v0[2] * v0[2] + v0[3] * v0[3]) + (v1[0] * v1[0] + v1[1] * v1[1]) + (v1[2] * v1[2] + v1[3] * v1[3]);
                    *(u32x4*)(X1b + (size_t)row * D + col0 + bj * HALF) = pack8(v0, v1); }
                ss += __shfl_xor(ss, 16); ss += __shfl_xor(ss, 32);
                if (fq == 0) SS1[(size_t)row * 16 + u.pn * 4 + wc] = ss; }
    }
};
struct EpiPle {
    static constexpr bool PERM = true;
    const bf16* X2b; const bf16* PU; const float* RSTD2; bf16* X3; float* SS3;
    __device__ __forceinline__ void operator()(const f32x4 (&acc)[2][2][4][2], const Unit& u, int wr, int wc, int fr, int fq) const {
        const int row0 = u.pm * BM + wr * 64 + fr, col0 = u.pn * 256 + wc * 32 + 8 * fq;
#pragma unroll
        for (int ai = 0; ai < 2; ++ai)
#pragma unroll
            for (int m = 0; m < 4; ++m) { const int row = row0 + ai * HALF + m * 16; float ss = 0.f; const float r2 = RSTD2[row];
#pragma unroll
                for (int bj = 0; bj < 2; ++bj) { const size_t o = (size_t)row * D + col0 + bj * HALF;
                    f32x4 x0, x1, p0, p1; unpack8(*(const u32x4*)(X2b + o), x0, x1); unpack8(*(const u32x4*)(PU + o), p0, p1);
                    f32x4 v0, v1;
#pragma unroll
                    for (int i = 0; i < 4; ++i) { v0[i] = x0[i] + fsigm(r2 * acc[ai][bj][m][0][i]) * p0[i]; v1[i] = x1[i] + fsigm(r2 * acc[ai][bj][m][1][i]) * p1[i]; }
                    ss += (v0[0] * v0[0] + v0[1] * v0[1]) + (v0[2] * v0[2] + v0[3] * v0[3]) + (v1[0] * v1[0] + v1[1] * v1[1]) + (v1[2] * v1[2] + v1[3] * v1[3]);
                    *(u32x4*)(X3 + o) = pack8(v0, v1); }
                ss += __shfl_xor(ss, 16); ss += __shfl_xor(ss, 32);
                if (fq == 0) SS3[(size_t)row * 16 + u.pn * 4 + wc] = ss; }
    }
};

struct EpiPleFinal {
    static constexpr bool PERM = true;
    const bf16* X2b; const bf16* PU; const float* RSTD2; const float* fn; float* out; float* XCH; unsigned* cnt; LAS float* xl; int wave;
    __device__ __forceinline__ void operator()(f32x4 (&acc)[2][2][4][2], const Unit& u, int wr, int wc, int fr, int fq) const {
        const int tid = wave * 64 + lane_id();
        const int rl0 = wr * 64 + fr, col0 = u.pn * 256 + wc * 32 + 8 * fq;
#pragma unroll
        for (int ai = 0; ai < 2; ++ai)
#pragma unroll
            for (int m = 0; m < 4; ++m) { const int rl = rl0 + ai * HALF + m * 16, row = u.pm * BM + rl; float ss = 0.f; const float r2 = RSTD2[row];
#pragma unroll
                for (int bj = 0; bj < 2; ++bj) { const size_t o = (size_t)row * D + col0 + bj * HALF;
                    f32x4 x0, x1, p0, p1; unpack8(*(const u32x4*)(X2b + o), x0, x1); unpack8(*(const u32x4*)(PU + o), p0, p1);
                    f32x4 v0, v1;
#pragma unroll
                    for (int i = 0; i < 4; ++i) { v0[i] = x0[i] + fsigm(r2 * acc[ai][bj][m][0][i]) * p0[i]; v1[i] = x1[i] + fsigm(r2 * acc[ai][bj][m][1][i]) * p1[i]; }
                    ss += (v0[0] * v0[0] + v0[1] * v0[1]) + (v0[2] * v0[2] + v0[3] * v0[3]) + (v1[0] * v1[0] + v1[1] * v1[1]) + (v1[2] * v1[2] + v1[3] * v1[3]);
                    acc[ai][bj][m][0] = v0; acc[ai][bj][m][1] = v1; }
                ss += __shfl_xor(ss, 16); ss += __shfl_xor(ss, 32);
                if (fq == 0) xl[rl * 4 + wc] = ss; }
        __syncthreads();
        if (tid < 256) { const f32x4 p = *(const LAS f32x4*)(xl + tid * 4);
            __hip_atomic_store(XCH + (size_t)(u.pm * BM + tid) * 4 + u.pn, (p[0] + p[1]) + (p[2] + p[3]), __ATOMIC_RELAXED, __HIP_MEMORY_SCOPE_AGENT); }
        asm volatile("s_waitcnt vmcnt(0)" ::: "memory");
        if (tid < 256 && (tid & 63) == 0) __hip_atomic_fetch_add(cnt + 64 * u.pm, 1u, __ATOMIC_RELAXED, __HIP_MEMORY_SCOPE_AGENT);
        if (tid < 64) { unsigned sp = 0;
            while ((unsigned)__builtin_amdgcn_readfirstlane(__hip_atomic_load(cnt + 64 * u.pm, __ATOMIC_RELAXED, __HIP_MEMORY_SCOPE_AGENT)) < 16u) { if (++sp > (1u << 22)) break; __builtin_amdgcn_s_sleep(1); } }
        __syncthreads();
        if (tid < 256) { const float* xs = XCH + (size_t)(u.pm * BM + tid) * 4; float tot = 0.f;
#pragma unroll
            for (int q = 0; q < 4; ++q) tot += __hip_atomic_load(xs + q, __ATOMIC_RELAXED, __HIP_MEMORY_SCOPE_AGENT);
            xl[1024 + tid] = rsqrtf(tot * (1.f / D) + EPS); }
        __syncthreads();
#pragma unroll
        for (int ai = 0; ai < 2; ++ai)
#pragma unroll
            for (int m = 0; m < 4; ++m) { const int rl = rl0 + ai * HALF + m * 16; const float rs = xl[1024 + rl]; float* op = out + (size_t)(u.pm * BM + rl) * D + col0;
#pragma unroll
                for (int bj = 0; bj < 2; ++bj) { const f32x4 f0 = *(const f32x4*)(fn + col0 + bj * HALF), f1 = *(const f32x4*)(fn + col0 + bj * HALF + 4);
                    *(f32x4*)(op + bj * HALF) = acc[ai][bj][m][0] * rs * f0; *(f32x4*)(op + bj * HALF + 4) = acc[ai][bj][m][1] * rs * f1; } }
    }
};

template <int MODE> struct MoeOrder {
    const LAS int* tab; const int* LIST; unsigned* dcnt;
    __device__ __forceinline__ bool next(int i, Unit& u) const {
        const int n = __builtin_amdgcn_readfirstlane(tab[0]); if (i >= n) return false;
        const LAS int* p = tab + 4 + 8 * i;
        u.pm = __builtin_amdgcn_readfirstlane(p[0]); u.pn = __builtin_amdgcn_readfirstlane(p[1]); u.e = __builtin_amdgcn_readfirstlane(p[2]);
        u.tile = __builtin_amdgcn_readfirstlane(p[3]); u.cnt = __builtin_amdgcn_readfirstlane(p[4]); return true;
    }
    __device__ __forceinline__ unsigned row_off(const Unit& u, int r) const { int idx = u.tile * 256 + r; idx = idx < u.cnt ? idx : u.cnt - 1; const int pair = LIST[u.e * 16384 + idx]; return (unsigned)(pair >> 1) * 2048u; }
    __device__ __forceinline__ void a_ready(const Unit&) const {}
    struct Pre {}; __device__ __forceinline__ void pre(int, Pre&) const {}
    __device__ __forceinline__ void post(int, Pre&) const {}
    __device__ __forceinline__ bool half(const Unit& u) const { return MODE == 1 && (u.cnt - u.tile * 256) <= 128; }
    __device__ __forceinline__ void done(const Unit& u) const {
        if constexpr (MODE == 1) {
            asm volatile("s_waitcnt vmcnt(0)" ::: "memory");
            if (lane_id() == 0) __hip_atomic_fetch_add(dcnt + 64 * u.pm, 1u, __ATOMIC_RELAXED, __HIP_MEMORY_SCOPE_AGENT);
        }
    }
};
__device__ __forceinline__ void store16_sc1(void* p, u32x4 v) { asm volatile("global_store_dwordx4 %0, %1, off sc1\n\ts_nop 1" :: "v"(p), "v"(v) : "memory"); }
struct EpiMoe1 {
    static constexpr bool PERM = true;
    bf16* H; const int* LIST; const float* RSTD1;
    __device__ __forceinline__ void operator()(const f32x4 (&acc)[2][2][4][2], const Unit& u, int wr, int wc, int fr, int fq) const {
        const int col0 = (u.pn & 1) * 128 + wc * 32 + 8 * fq;
#pragma unroll
        for (int ai = 0; ai < 2; ++ai)
#pragma unroll
            for (int m = 0; m < 4; ++m) { const int r = ai * HALF + wr * 64 + m * 16 + fr; int idx = u.tile * 256 + r; idx = idx < u.cnt ? idx : u.cnt - 1;
                const int pair = LIST[u.e * 16384 + idx]; const float rs = RSTD1[pair >> 1]; f32x4 v[2];
#pragma unroll
                for (int n = 0; n < 2; ++n)
#pragma unroll
                    for (int i = 0; i < 4; ++i) { const float a1 = rs * acc[ai][0][m][n][i], a3 = rs * acc[ai][1][m][n][i]; v[n][i] = a1 * fsigm(a1) * a3; }
                store16_sc1(H + (size_t)(u.pm * 256 + r) * 256 + col0, pack8(v[0], v[1])); }
    }
};
struct EpiMoe2 {
    static constexpr bool PERM = true;
    bf16* Y; const int* LIST; const float* TOKG;
    __device__ __forceinline__ void operator()(const f32x4 (&acc)[2][2][4][2], const Unit& u, int wr, int wc, int fr, int fq) const {
        const int col0 = (u.pn & 3) * 256 + wc * 32 + 8 * fq;
        int pr[2][4]; float gt[2][4];
#pragma unroll
        for (int ai = 0; ai < 2; ++ai)
#pragma unroll
            for (int m = 0; m < 4; ++m) { int idx = u.tile * 256 + ai * HALF + wr * 64 + m * 16 + fr; idx = idx < u.cnt ? idx : u.cnt - 1; pr[ai][m] = LIST[u.e * 16384 + idx]; }
#pragma unroll
        for (int ai = 0; ai < 2; ++ai)
#pragma unroll
            for (int m = 0; m < 4; ++m) gt[ai][m] = TOKG[pr[ai][m]];
#pragma unroll
        for (int ai = 0; ai < 2; ++ai)
#pragma unroll
            for (int m = 0; m < 4; ++m) { const int idx = u.tile * 256 + ai * HALF + wr * 64 + m * 16 + fr;
                if (idx < u.cnt) { const float g = gt[ai][m]; bf16* yp = Y + (size_t)pr[ai][m] * D + col0;
#pragma unroll
                    for (int bj = 0; bj < 2; ++bj) *(u32x4*)(yp + bj * HALF) = pack8(acc[ai][bj][m][0] * g, acc[ai][bj][m][1] * g); } }
    }
};
}

constexpr int NWAVES = 8;
constexpr int RING_BYTES = 131072, LDSCTL_OFF = 139264, MISC_OFF = LDSCTL_OFF + 320, TAB_OFF = LDSCTL_OFF + 512, LDS_BYTES = 147456;
constexpr size_t WS_WLRU = 8 * MiB + 512 * 1024;
constexpr size_t WS_WSGU = 8 * MiB + 768 * 1024;
constexpr size_t WS_WR = 9 * MiB;
constexpr size_t WS_WUP = 9 * MiB + 512 * 1024;
constexpr size_t WS_WIN = 10 * MiB;
constexpr size_t WS_WOUT = 22 * MiB;
constexpr size_t WS_WG = 24 * MiB;
constexpr size_t WS_W13 = 26 * MiB;
constexpr size_t WS_W2 = 58 * MiB;
constexpr size_t WS_PB = 234 * MiB;
constexpr size_t WS_RSTD1 = 242 * MiB;
constexpr size_t WS_SPL8 = 242 * MiB + 512 * 1024;
constexpr size_t WS_XCH = 243 * MiB;
constexpr size_t WS_MEGA_END = 244 * MiB;
constexpr int CW_BAR = 4096;
constexpr int CW_DONE1 = 131072;
constexpr int CW_PANEL = 65536;

typedef GAS unsigned gu32;
#define RLX_AGENT __ATOMIC_RELAXED, __HIP_MEMORY_SCOPE_AGENT
#define LDS_WAIT() asm volatile("s_waitcnt lgkmcnt(0)" ::: "memory")
#define VM_WAIT() asm volatile("s_waitcnt vmcnt(0)" ::: "memory")

#define XB_TMO      128
#define XB_XCNT(j)  (256  + 64 * (j))
#define XB_XSUB(j)  (1280 + 64 * (j))
#define XB_XGEN(j)  (2304 + 64 * (j))
#define XB_TOP      3328
#define XB_TOPGEN   3392
#define XCD_BAR_WORDS 3456
#define XB_SPIN_CAP (1u << 18)
__device__ __forceinline__ unsigned xb_ld(unsigned* p)              { return __hip_atomic_load(p, __ATOMIC_RELAXED, __HIP_MEMORY_SCOPE_AGENT); }
__device__ __forceinline__ unsigned xb_add(unsigned* p, unsigned v) { return __hip_atomic_fetch_add(p, v, __ATOMIC_RELAXED, __HIP_MEMORY_SCOPE_AGENT); }
__device__ __forceinline__ unsigned xb_xcc_id() { return (unsigned)__builtin_amdgcn_s_getreg((3 << 11) | 20) & 0xFu; }
#define XB_SPIN(cond, bar) do { unsigned _sp = 0; while (cond) { __builtin_amdgcn_s_sleep(1); \
    if ((++_sp & 255u) == 0u) { if (xb_ld(&(bar)[XB_TMO])) break; if (_sp > XB_SPIN_CAP) { atomicAdd(&(bar)[XB_TMO], 1u); break; } } } } while (0)
struct XcdBarrier { unsigned* bar; unsigned x; volatile LAS unsigned* st; int wave; };
__device__ __forceinline__ XcdBarrier xcd_barrier_post(unsigned* bar, volatile LAS unsigned* st, int wave) {
    XcdBarrier b; b.bar = bar; b.x = xb_xcc_id(); b.st = st; b.wave = wave;
    if (wave == 0 && pg8::lane_id() == 0) (void)xb_add(&bar[XB_XCNT(b.x)], 1u);
    return b;
}
__device__ __forceinline__ void xcd_barrier_complete(unsigned* bar, unsigned x, unsigned& nloc, unsigned& nx) {
    const unsigned G = gridDim.x * gridDim.y * gridDim.z;
    unsigned sum, cnt, mine, sp = 0u;
    for (;;) {
        sum = 0u; cnt = 0u; mine = 0u;
#pragma unroll
        for (unsigned j = 0; j < 16; ++j) { const unsigned c = xb_ld(&bar[XB_XCNT(j)]); sum += c; cnt += (c > 0u) ? 1u : 0u; mine = (j == x) ? c : mine; }
        if (sum == G) break;
        __builtin_amdgcn_s_sleep(1);
        if ((++sp & 255u) == 0u) { if (xb_ld(&bar[XB_TMO])) break; if (sp > XB_SPIN_CAP) { atomicAdd(&bar[XB_TMO], 1u); break; } }
    }
    nloc = mine > 0u ? mine : 1u; nx = cnt > 0u ? cnt : 1u;
}
__device__ __forceinline__ void xcd_barrier(const XcdBarrier& b) {
    asm volatile("s_waitcnt vmcnt(0)" ::: "memory");
    __syncthreads();
    if (b.wave == 0 && pg8::lane_id() == 0) {
        unsigned* bar = b.bar;
        __builtin_amdgcn_s_waitcnt(0);
        unsigned nloc = b.st[0], nx = b.st[1];
        if (nloc == 0u) { xcd_barrier_complete(bar, b.x, nloc, nx); b.st[0] = nloc; b.st[1] = nx; }
        const unsigned old = xb_add(&bar[XB_XSUB(b.x)], 1u);
        const unsigned gen = old / nloc;
        if (old + 1u == (gen + 1u) * nloc) {
            __builtin_amdgcn_fence(__ATOMIC_RELEASE, "agent");
            asm volatile("s_waitcnt vmcnt(0)" ::: "memory");
            const unsigned og = xb_add(&bar[XB_TOP], 1u);
            const unsigned tg = og / nx;
            if (og + 1u == (tg + 1u) * nx) xb_add(&bar[XB_TOPGEN], 1u);
            else XB_SPIN(xb_ld(&bar[XB_TOPGEN]) == tg, bar);
            __builtin_amdgcn_fence(__ATOMIC_ACQUIRE, "agent");
            xb_add(&bar[XB_XGEN(b.x)], 1u);
            asm volatile("s_waitcnt vmcnt(0)" ::: "memory");
        } else {
            XB_SPIN(xb_ld(&bar[XB_XGEN(b.x)]) == gen, bar);
            __builtin_amdgcn_fence(__ATOMIC_ACQUIRE, "agent");
            asm volatile("s_waitcnt vmcnt(0)" ::: "memory");
        }
    }
    __syncthreads();
}

__device__ __forceinline__ unsigned pk2(float lo, float hi) { return (unsigned)f2bf(lo) | ((unsigned)f2bf(hi) << 16); }

struct TrItem { pg8::f32x4 v[8]; };
__device__ __forceinline__ void tr_load(TrItem& t, const float* __restrict__ W, int ldn, int k0, int n_src0, int lane) {
    const int kb = lane >> 3, n4 = lane & 7;
    const float* src = W + (size_t)(k0 + 8 * kb) * ldn + n_src0 + 4 * n4;
#pragma unroll
    for (int q = 0; q < 8; ++q) t.v[q] = *(const pg8::f32x4*)(src + (size_t)q * ldn);
}
__device__ __forceinline__ void tr_store(TrItem& t, int k0, bf16* __restrict__ WT, int Kd, int drow0, const float* __restrict__ gk, int lane) {
    const int kb = lane >> 3, n4 = lane & 7;
    if (gk) { const pg8::f32x4 g0 = *(const pg8::f32x4*)(gk + k0 + 8 * kb), g1 = *(const pg8::f32x4*)(gk + k0 + 8 * kb + 4);
#pragma unroll
        for (int q = 0; q < 8; ++q) t.v[q] = t.v[q] * (q < 4 ? g0[q & 3] : g1[q & 3]); }
#pragma unroll
    for (int i = 0; i < 4; ++i) { pg8::u32x4 o; o.x = pk2(t.v[0][i], t.v[1][i]); o.y = pk2(t.v[2][i], t.v[3][i]); o.z = pk2(t.v[4][i], t.v[5][i]); o.w = pk2(t.v[6][i], t.v[7][i]);
        *(pg8::u32x4*)(WT + (size_t)(drow0 + 4 * n4 + i) * Kd + k0 + 8 * kb) = o; }
}
__device__ __forceinline__ void p0_transpose_item(const float* __restrict__ W, int ldn, int k0, int n_src0, bf16* __restrict__ WT, int Kd, int drow0, const float* __restrict__ gk, LAS float*, int lane) {
    TrItem t; tr_load(t, W, ldn, k0, n_src0, lane); tr_store(t, k0, WT, Kd, drow0, gk, lane);
}
__device__ __forceinline__ int win_dest_row(int n) {
    const int grp = n >> 10, j = n & 1023;
    switch (grp) {
        case 0: return j;
        case 1: return 1024 + (j >> 7) * 256 + (j & 127);
        case 2: return 3072 + (j >> 7) * 256 + (j & 127);
        case 3: return 5120 + j;
        case 4: return 1024 + (j >> 7) * 256 + 128 + (j & 127);
        default: return 3072 + (j >> 7) * 256 + 128 + (j & 127);
    }
}


struct DefW { const float *wout, *w1, *w3, *w2, *wg, *wup, *fnorm, *pnorm; bf16 *WoutT, *W13T, *W2T, *WgT, *WupT; };
constexpr int DF_OUT = 16 * 32, DF_E13 = 32 * 2 * 128, DF_E2 = 32 * 128, DF_G = 16 * 32, DF_UP = 4 * 32, DF_N = DF_OUT + DF_E13 + DF_E2 + DF_G + DF_UP;
struct DefDesc { const float* W; const float* gk; bf16* WT; int ldn, k0, n0, Kd, drow; };
__device__ __forceinline__ DefDesc deferred_desc(const DefW& w, int it) {
    int r = it; DefDesc d;
    if (r < DF_OUT) { const int kb = r / 32, nb = r % 32; d = DefDesc{w.wout, nullptr, w.WoutT, 1024, kb * 64, nb * 32, 1024, nb * 32}; return d; } r -= DF_OUT;
    if (r < DF_E13) { const int e = r / 256, which = (r / 128) & 1, q = r % 128, kb = q / 8, nb = q % 8;
        const int f0 = nb * 32, drow = e * 512 + (f0 >> 7) * 256 + which * 128 + (f0 & 127);
        d = DefDesc{(which ? w.w3 : w.w1) + (size_t)e * 1024 * 256, w.fnorm, w.W13T, 256, kb * 64, f0, 1024, drow}; return d; } r -= DF_E13;
    if (r < DF_E2) { const int e = r / 128, q = r % 128, kb = q / 32, nb = q % 32;
        d = DefDesc{w.w2 + (size_t)e * 256 * 1024, nullptr, w.W2T, 1024, kb * 64, nb * 32, 256, e * 1024 + nb * 32}; return d; } r -= DF_E2;
    if (r < DF_G) { const int kb = r / 32, nb = r % 32; d = DefDesc{w.wg, w.pnorm, w.WgT, 1024, kb * 64, nb * 32, 1024, nb * 32}; return d; } r -= DF_G;
    { const int kb = r / 32, nb = r % 32; d = DefDesc{w.wup, nullptr, w.WupT, 1024, kb * 64, nb * 32, 256, nb * 32}; return d; }
}
struct Gemm1Order : pg8::StaticOrder {
    DefW w; int wave;
    typedef TrItem Pre;
    __device__ __forceinline__ void pre(int ui, Pre& t) const {
        const int lane = pg8::lane_id(), it = (ui * G + c) * 8 + wave;
        if (it < DF_N) { const DefDesc d = deferred_desc(w, it); tr_load(t, d.W, d.ldn, d.k0, d.n0, lane); }
    }
    __device__ __forceinline__ void post(int ui, Pre& t) const {
        const int lane = pg8::lane_id(); int it = (ui * G + c) * 8 + wave;
        if (it < DF_N) { const DefDesc d = deferred_desc(w, it); tr_store(t, d.k0, d.WT, d.Kd, d.drow, d.gk, lane); }
        for (it += nwg * 8; it < DF_N; it += nwg * 8) { const DefDesc d = deferred_desc(w, it); TrItem t2; tr_load(t2, d.W, d.ldn, d.k0, d.n0, lane); tr_store(t2, d.k0, d.WT, d.Kd, d.drow, d.gk, lane); }
    }
};

constexpr int MY_VT = 0, MY_XA = 32768, MY_SP = 67584, MY_WS = 102400, MY_ST = 135168, MY_RS = 272;
__device__ __forceinline__ float bflo(unsigned u) { return __uint_as_float(u << 16); }
__device__ __forceinline__ float bfhi(unsigned u) { return __uint_as_float(u & 0xffff0000u); }
template <int N> __device__ __forceinline__ float row_shr(float ident, float v) {
    return __builtin_bit_cast(float, __builtin_amdgcn_update_dpp(__builtin_bit_cast(int, ident), __builtin_bit_cast(int, v), 0x110 + N, 0xf, 0xf, false)); }
#define MX_SCAN_STEP(N, A, U) { const float pa_ = row_shr<N>(1.f, A), pu_ = row_shr<N>(0.f, U); U = pu_ * A + U; A = pa_ * A; }
#define MX_SCAN16(A, U) { MX_SCAN_STEP(1, A, U) MX_SCAN_STEP(2, A, U) MX_SCAN_STEP(4, A, U) MX_SCAN_STEP(8, A, U) }
__device__ __forceinline__ void mixer_phase(LAS unsigned char* lds, const int vcu, const int G, const int tid, const int lane, const int wave,
                                            const bf16* __restrict__ Zl, const bf16* __restrict__ GA, const bf16* __restrict__ UB, const bf16* __restrict__ V, const float* __restrict__ VPART,
                                            unsigned long long* AGG, bf16* __restrict__ MG, const bf16* __restrict__ WLRU, const bf16* __restrict__ WSGU, const float* __restrict__ SPL8, const float* const* in) {
    using namespace pg8;
    constexpr int RS = MY_RS;
    constexpr float L2E = 1.4426950409f;
    const int fr = lane & 15, grp = lane >> 4, cp = tid & 63, tg = wave;
    const int pr = lane & 3, sch = lane >> 2, srow = 8 * sch + 2 * pr;
    LAS float* ST = (LAS float*)(lds + MY_ST);
    int gprev = -1;
    f32x2 cw0, cw1, cw2, cw3, ccb;
    u32x4 zqa, zqb, zqc, zqd, zqe, vv00, vv01, vv10, vv11;
#define MX_ZR(k) ((k) < 4 ? zqa[(k) & 3] : (k) < 8 ? zqb[(k) & 3] : (k) < 12 ? zqc[(k) & 3] : (k) < 16 ? zqd[(k) & 3] : zqe[(k) & 3])
#define MX_SETZR(k, v) do { if ((k) < 4) zqa[(k) & 3] = (v); else if ((k) < 8) zqb[(k) & 3] = (v); else if ((k) < 12) zqc[(k) & 3] = (v); else if ((k) < 16) zqd[(k) & 3] = (v); else zqe[(k) & 3] = (v); } while (0)
#define MX_PREFETCH(uu) do { const int ck_ = (uu) >> 3, g_ = (uu) & 7, t0_ = ck_ * 128, c0_ = g_ * 128; const bool first_ = (ck_ & 15) == 0; \
        const unsigned zo_ = ((unsigned)(t0_ + 16 * tg) * D + c0_ + 2 * cp) * 2u; \
        _Pragma("unroll") for (int k = 0; k < 19; ++k) { unsigned zv_ = 0u; if (!(k < 3 && first_ && tg == 0)) zv_ = *(const unsigned*)((const char*)Zl + (zo_ + (unsigned)((k - 3) * D * 2))); MX_SETZR(k, zv_); } \
        { const unsigned vo_ = ((unsigned)(t0_ + srow) * D + c0_ + 16 * wave) * 2u; vv00 = *(const u32x4*)((const char*)V + vo_); vv01 = *(const u32x4*)((const char*)V + (vo_ + D * 2)); vv10 = *(const u32x4*)((const char*)V + (vo_ + 16)); vv11 = *(const u32x4*)((const char*)V + (vo_ + D * 2 + 16)); } \
        } while (0)
    zqe = (u32x4){0u, 0u, 0u, 0u};
#define MX_STATS_LOAD(uu, q0, q1) do { const unsigned vpo_ = ((unsigned)(((uu) >> 3) * 128 + (tid >> 2)) * 32 + (tid & 3) * 8) * 4u; q0 = *(const f32x4*)((const char*)VPART + vpo_); q1 = *(const f32x4*)((const char*)VPART + (vpo_ + 16)); } while (0)
#define MX_STATS_WRITE(q0, q1) do { float s1 = (q0[0] + q0[2]) + (q1[0] + q1[2]), s2 = (q0[1] + q0[3]) + (q1[1] + q1[3]); \
        s1 += __shfl_xor(s1, 1); s1 += __shfl_xor(s1, 2); s2 += __shfl_xor(s2, 1); s2 += __shfl_xor(s2, 2); \
        if ((tid & 3) == 0) { const float mean = s1 * (1.f / 1024.f); float var = s2 * (1.f / 1024.f) - mean * mean; var = var < 0.f ? 0.f : var; ST[tid >> 2] = mean; ST[128 + (tid >> 2)] = rsqrtf(var + EPS); } } while (0)
    int u = vcu;
    if (u < 1024) { MX_PREFETCH(u); f32x4 q0, q1; MX_STATS_LOAD(u, q0, q1); MX_STATS_WRITE(q0, q1); }
    for (; u < 1024; u += G) {
        const int ck = u >> 3, g = u & 7, t0 = ck * 128, c0 = g * 128, j = ck & 15;
        const int cch = c0 + 16 * wave + 4 * grp;
        if (g != gprev) {
            gprev = g;
#pragma unroll
            for (int it = 0; it < 4; ++it) { const int idx = it * 512 + tid, row = idx >> 4, ch = idx & 15;
                *(LAS u32x4*)(lds + MY_WS + row * 256 + ((ch ^ (row & 15)) << 4)) = *(const u32x4*)(WSGU + ((size_t)(g * 128 + row)) * 128 + ch * 8); }
            const int cc = c0 + 2 * cp;
            cw0 = *(const f32x2*)(in[4] + cc); cw1 = *(const f32x2*)(in[4] + 1024 + cc); cw2 = *(const f32x2*)(in[4] + 2048 + cc); cw3 = *(const f32x2*)(in[4] + 3072 + cc); ccb = *(const f32x2*)(in[5] + cc);
        }
        const int hblk = 2 * g + (wave >> 2), jj0 = (16 * wave) & 63;
        const bf16x8 bw00 = *(const bf16x8*)(WLRU + ((size_t)((0 * 16 + hblk) * 64 + jj0 + fr)) * 64 + 0 * 32 + 8 * grp), bw01 = *(const bf16x8*)(WLRU + ((size_t)((0 * 16 + hblk) * 64 + jj0 + fr)) * 64 + 1 * 32 + 8 * grp);
        const bf16x8 bw10 = *(const bf16x8*)(WLRU + ((size_t)((1 * 16 + hblk) * 64 + jj0 + fr)) * 64 + 0 * 32 + 8 * grp), bw11 = *(const bf16x8*)(WLRU + ((size_t)((1 * 16 + hblk) * 64 + jj0 + fr)) * 64 + 1 * 32 + 8 * grp);
        const f32x4 nba = *(const f32x4*)(in[7] + cch) * (-L2E), nbi = *(const f32x4*)(in[9] + cch) * (-L2E), ksp = *(const f32x4*)(SPL8 + cch);
        {
#pragma unroll
            for (int i = 0; i < 16; ++i) {
                const unsigned z0 = MX_ZR(i), z1 = MX_ZR(i + 1), z2 = MX_ZR(i + 2), z3 = MX_ZR(i + 3);
                const float x0 = ccb.x + cw0.x * bflo(z0) + cw1.x * bflo(z1) + cw2.x * bflo(z2) + cw3.x * bflo(z3);
                const float x1 = ccb.y + cw0.y * bfhi(z0) + cw1.y * bfhi(z1) + cw2.y * bfhi(z2) + cw3.y * bfhi(z3);
                *(LAS unsigned*)(lds + MY_XA + (16 * tg + i) * RS + 4 * cp) = cvt_pk_bf16(x0, x1);
            }
        }
        __syncthreads();
        {
            const float mua = ST[srow], rsa = ST[128 + srow], mub = ST[srow + 1], rsb = ST[128 + srow + 1];
#pragma unroll
            for (int ci = 0; ci < 2; ++ci) { const int chunk = 2 * wave + ci, cbase = c0 + 8 * chunk;
                f32x4 a0, a1, b0, b1; unpack8(ci ? vv10 : vv00, a0, a1); unpack8(ci ? vv11 : vv01, b0, b1);
                const f32x4 g0 = *(const f32x4*)(in[11] + cbase), g1 = *(const f32x4*)(in[11] + cbase + 4), l0 = *(const f32x4*)(in[12] + cbase), l1 = *(const f32x4*)(in[12] + cbase + 4);
                a0 = (a0 - mua) * rsa * g0 + l0; a1 = (a1 - mua) * rsa * g1 + l1; b0 = (b0 - mub) * rsb * g0 + l0; b1 = (b1 - mub) * rsb * g1 + l1;
#pragma unroll
                for (int i = 0; i < 8; ++i) { const int cl = 8 * chunk + i; const float va = i < 4 ? a0[i & 3] : a1[i & 3], vb = i < 4 ? b0[i & 3] : b1[i & 3];
                    *(LAS unsigned*)(lds + MY_VT + cl * 256 + ((sch ^ (cl & 15)) << 4) + 4 * pr) = cvt_pk_bf16(va, vb); }
            }
        }
        f32x4 R[8], I[8];
#pragma unroll
        for (int mt = 0; mt < 8; ++mt) { R[mt] = (f32x4){0.f, 0.f, 0.f, 0.f}; I[mt] = (f32x4){0.f, 0.f, 0.f, 0.f};
#pragma unroll
            for (int ks = 0; ks < 2; ++ks) { const bf16x8 a = *(const LAS bf16x8*)(lds + MY_XA + (mt * 16 + fr) * RS + ((wave >> 2) * 64 + ks * 32 + 8 * grp) * 2);
                R[mt] = __builtin_amdgcn_mfma_f32_16x16x32_bf16(ks ? bw01 : bw00, a, R[mt], 0, 0, 0); I[mt] = __builtin_amdgcn_mfma_f32_16x16x32_bf16(ks ? bw11 : bw10, a, I[mt], 0, 0, 0); } }
#pragma unroll
        for (int mt = 0; mt < 8; ++mt) {
            const u32x2 xw = *(const LAS u32x2*)(lds + MY_XA + (mt * 16 + fr) * RS + (16 * wave + 4 * grp) * 2);
            const f32x4 xa4 = {bflo(xw.x), bfhi(xw.x), bflo(xw.y), bfhi(xw.y)};
            const f32x4 t1 = R[mt] * (-L2E) + nba, t2 = I[mt] * (-L2E) + nbi;
            f32x4 d1, d2, inv;
#pragma unroll
            for (int r = 0; r < 4; ++r) { d1[r] = 1.f + __builtin_amdgcn_exp2f(t1[r]); d2[r] = 1.f + __builtin_amdgcn_exp2f(t2[r]); }
            const f32x4 dd = d1 * d2;
#pragma unroll
            for (int r = 0; r < 4; ++r) inv[r] = __builtin_amdgcn_rcpf(dd[r]);
            const f32x4 rr = d2 * inv, ii = d1 * inv, la = rr * ksp, x2 = la + la;
            const f32x4 av = 1.f + la * (1.f + la * (0.5f + la * (0.16666667f + la * (0.041666667f + la * 0.0083333333f))));
            const f32x4 om = -x2 * (1.f + x2 * (0.5f + x2 * (0.16666667f + x2 * (0.041666667f + x2 * 0.0083333333f))));
            f32x4 uv;
#pragma unroll
            for (int r = 0; r < 4; ++r) uv[r] = __builtin_amdgcn_sqrtf(om[r]);
            uv = uv * ii * xa4;
#pragma unroll
            for (int r = 0; r < 4; ++r) { float A_ = av[r], U_ = uv[r]; MX_SCAN16(A_, U_); R[mt][r] = A_; I[mt][r] = U_; }
        }
        {
            f32x4 Pc = {1.f, 1.f, 1.f, 1.f}, Hc = {0.f, 0.f, 0.f, 0.f};
#pragma unroll
            for (int mt = 0; mt < 8; ++mt) { Hc = Hc * R[mt] + I[mt]; Pc = Pc * R[mt]; }
            if (fr == 15) {
#pragma unroll
                for (int r = 0; r < 4; ++r) __hip_atomic_store(AGG + (size_t)ck * 1024 + cch + r, ((unsigned long long)__float_as_uint(Hc[r]) << 32) | (unsigned long long)__float_as_uint(Pc[r]), __ATOMIC_RELAXED, __HIP_MEMORY_SCOPE_AGENT);
            }
        }
        __syncthreads();
        if (u + G < 1024) MX_PREFETCH(u + G);
        unsigned long long ag0 = 0x000000003f800000ull, ag1 = 0x000000003f800000ull, ag2 = 0x000000003f800000ull, ag3 = 0x000000003f800000ull;
        if (j > 0 && fr < j) { const unsigned long long* ap = AGG + (size_t)(ck - j + fr) * 1024 + cch;
            ag0 = __hip_atomic_load(ap, __ATOMIC_RELAXED, __HIP_MEMORY_SCOPE_AGENT); ag1 = __hip_atomic_load(ap + 1, __ATOMIC_RELAXED, __HIP_MEMORY_SCOPE_AGENT);
            ag2 = __hip_atomic_load(ap + 2, __ATOMIC_RELAXED, __HIP_MEMORY_SCOPE_AGENT); ag3 = __hip_atomic_load(ap + 3, __ATOMIC_RELAXED, __HIP_MEMORY_SCOPE_AGENT); }
        {
            bf16x8 q[4];
#pragma unroll
            for (int ks = 0; ks < 4; ++ks) q[ks] = *(const LAS bf16x8*)(lds + MY_VT + (16 * wave + fr) * 256 + (((ks * 4 + grp) ^ fr) << 4));
#pragma unroll
            for (int mt = 0; mt < 8; ++mt) { f32x4 Sx = {0.f, 0.f, 0.f, 0.f};
#pragma unroll
                for (int ks = 0; ks <= mt / 2; ++ks) { const bf16x8 p = *(const LAS bf16x8*)(lds + MY_WS + (mt * 16 + fr) * 256 + (((ks * 4 + grp) ^ fr) << 4));
                    Sx = __builtin_amdgcn_mfma_f32_16x16x32_bf16(q[ks], p, Sx, 0, 0, 0); }
                *(LAS u32x2*)(lds + MY_SP + (mt * 16 + fr) * RS + (16 * wave + 4 * grp) * 2) = (u32x2){cvt_pk_bf16_cv(Sx[0], Sx[1]), cvt_pk_bf16_cv(Sx[2], Sx[3])}; }
        }
        {
            f32x4 hc0 = {0.f, 0.f, 0.f, 0.f};
            if (j > 0) {
                f32x4 lp, lh; unsigned spin = 0;
                for (;;) {
                    lp[0] = __uint_as_float((unsigned)ag0); lh[0] = __uint_as_float((unsigned)(ag0 >> 32)); lp[1] = __uint_as_float((unsigned)ag1); lh[1] = __uint_as_float((unsigned)(ag1 >> 32));
                    lp[2] = __uint_as_float((unsigned)ag2); lh[2] = __uint_as_float((unsigned)(ag2 >> 32)); lp[3] = __uint_as_float((unsigned)ag3); lh[3] = __uint_as_float((unsigned)(ag3 >> 32));
                    const bool ok = (lp[0] != 0.f) && (lp[1] != 0.f) && (lp[2] != 0.f) && (lp[3] != 0.f);
                    if (__all(ok)) break;
                    if (++spin > (1u << 22)) break;
                    __builtin_amdgcn_s_sleep(1);
                    if (fr < j) { const unsigned long long* ap = AGG + (size_t)(ck - j + fr) * 1024 + cch;
                        ag0 = __hip_atomic_load(ap, __ATOMIC_RELAXED, __HIP_MEMORY_SCOPE_AGENT); ag1 = __hip_atomic_load(ap + 1, __ATOMIC_RELAXED, __HIP_MEMORY_SCOPE_AGENT);
                        ag2 = __hip_atomic_load(ap + 2, __ATOMIC_RELAXED, __HIP_MEMORY_SCOPE_AGENT); ag3 = __hip_atomic_load(ap + 3, __ATOMIC_RELAXED, __HIP_MEMORY_SCOPE_AGENT); } }
#pragma unroll
                for (int r = 0; r < 4; ++r) { float A_ = lp[r], U_ = lh[r]; MX_SCAN16(A_, U_); hc0[r] = __shfl(U_, (lane & 48) | 15); }
            }
            f32x4 s = hc0;
#pragma unroll
            for (int mt = 0; mt < 8; ++mt) { f32x4 hb;
#pragma unroll
                for (int r = 0; r < 4; ++r) hb[r] = __shfl(s[r], (lane & 48) | 15);
                s = R[mt] * s + I[mt];
                const f32x4 hv = I[mt] + R[mt] * hb;
                *(LAS u32x2*)(lds + MY_XA + (mt * 16 + fr) * RS + (16 * wave + 4 * grp) * 2) = (u32x2){cvt_pk_bf16(hv[0], hv[1]), cvt_pk_bf16(hv[2], hv[3])}; }
        }
        u32x4 ga[4], ub[4]; float bsr[4]; f32x4 nq0 = {0.f, 0.f, 0.f, 0.f}, nq1 = {0.f, 0.f, 0.f, 0.f};
        if (u + G < 1024) MX_STATS_LOAD(u + G, nq0, nq1);
#pragma unroll
        for (int it = 0; it < 4; ++it) { const int idx = it * 512 + tid, row = idx >> 4, ch = idx & 15; const unsigned o = ((unsigned)(t0 + row) * D + c0 + ch * 8) * 2u; ga[it] = *(const u32x4*)((const char*)GA + o); ub[it] = *(const u32x4*)((const char*)UB + o); bsr[it] = in[14][g * 128 + row]; }
        __syncthreads();
#pragma unroll
        for (int it = 0; it < 4; ++it) { const int idx = it * 512 + tid, row = idx >> 4, ch = idx & 15;
            f32x4 g0, g1, u0, u1, h0, h1, s0, s1; unpack8(ga[it], g0, g1); unpack8(ub[it], u0, u1);
            unpack8(*(const LAS u32x4*)(lds + MY_XA + row * RS + ch * 16), h0, h1); unpack8(*(const LAS u32x4*)(lds + MY_SP + row * RS + ch * 16), s0, s1);
            *(u32x4*)((char*)MG + ((unsigned)(t0 + row) * D + c0 + ch * 8) * 2u) = pack8(g0 * h0 + u0 * (s0 + bsr[it]), g1 * h1 + u1 * (s1 + bsr[it])); }
        if (u + G < 1024) MX_STATS_WRITE(nq0, nq1);
        __syncthreads();
    }
#undef MX_PREFETCH
#undef MX_STATS_LOAD
#undef MX_STATS_WRITE
#undef MX_ZR
#undef MX_SETZR
}

__device__ __forceinline__ void build_moe_units(LAS int* tab1, LAS int* tab2, LAS int* tab3, const int* CNT, int vcu, int G, int wave, LAS int* flags) {
    const int tid = wave * 64 + pg8::lane_id();
    int NT = 0, my_e = 0, my_tile = 0, my_cnt = 0, my_rt = 0;
    for (int e = 0; e < 32; ++e) { const int cnt = CNT[e]; const int ntl = (cnt + 255) >> 8;
        if (tid >= NT && tid < NT + ntl) { my_e = e; my_tile = tid - NT; my_cnt = cnt; my_rt = tid; }
        NT += ntl; }
    const bool have = tid < NT;
    const bool heavy = have && (my_cnt - my_tile * 256) > 128;
    flags[tid] = heavy ? 1 : 0;
    __syncthreads();
    int hb = 0, NH = 0;
    for (int i = 0; i < NT; ++i) { const int f = flags[i]; NH += f; hb += (i < tid) ? f : 0; }
    const int slot = heavy ? hb : NH + (tid - hb);
    const int U1 = 2 * NT, U2 = 4 * NT; int nlate = (U1 > G && U1 < 2 * G) ? U1 - G : 0; if (G - nlate < 64) nlate = 0;
    const int Ge = G - nlate, c2 = vcu - nlate, ssplit = nlate ? G / 2 : NT, Lsplit = 4 * ssplit;
    const int n1 = vcu < U1 ? (U1 - 1 - vcu) / G + 1 : 0;
    const int tot2 = (c2 >= 0 && c2 < U2) ? (U2 - 1 - c2) / Ge + 1 : 0;
    int n2 = (c2 >= 0 && c2 < Lsplit) ? (Lsplit - 1 - c2) / Ge + 1 : 0; n2 = n2 < tot2 ? n2 : tot2;
    const int n3 = tot2 - n2;
    if (tid == 0) { tab1[0] = n1 < 12 ? n1 : 12; tab2[0] = n2 < 12 ? n2 : 12; tab3[0] = n3 < 12 ? n3 : 12; }
    if (have) {
#pragma unroll
        for (int q = 0; q < 2; ++q) { const int L = 2 * slot + q; if (L % G == vcu && L / G < 12) { LAS int* p = tab1 + 4 + 8 * (L / G); p[0] = my_rt; p[1] = my_e * 2 + q; p[2] = my_e; p[3] = my_tile; p[4] = my_cnt; } }
        if (c2 >= 0) {
#pragma unroll
            for (int q = 0; q < 4; ++q) { const int L2 = 4 * slot + q; if (L2 % Ge == c2) { const int k = L2 / Ge; const bool early = slot < ssplit; const int idx = early ? k : k - n2;
                if (idx >= 0 && idx < 12) { LAS int* p = (early ? tab2 : tab3) + 4 + 8 * idx; p[0] = my_rt; p[1] = my_e * 4 + q; p[2] = my_e; p[3] = my_tile; p[4] = my_cnt; } } }
        }
    }
    __syncthreads();
}
__device__ __forceinline__ void moe_wait_tiles(const LAS int* tab, unsigned* dcnt, int wave) {
    if (wave == 0) {
        const int n = __builtin_amdgcn_readfirstlane(tab[0]);
        for (int i = 0; i < n; ++i) { const int rt = __builtin_amdgcn_readfirstlane(tab[4 + 8 * i]); unsigned sp = 0;
            while ((unsigned)__builtin_amdgcn_readfirstlane(__hip_atomic_load(dcnt + 64 * rt, __ATOMIC_RELAXED, __HIP_MEMORY_SCOPE_AGENT)) < 16u) { if (++sp > (1u << 22)) break; __builtin_amdgcn_s_sleep(2); } }
        __builtin_amdgcn_fence(__ATOMIC_ACQUIRE, "agent");
        asm volatile("s_waitcnt vmcnt(0)" ::: "memory");
    }
    __syncthreads();
}

struct Args { const float* in[28]; float* out; unsigned char* ws; int ph_lo, ph_hi, li, pad; };

__global__ void __launch_bounds__(NWAVES * 64, 2) mega_fwd(Args args) {
    extern __shared__ __attribute__((aligned(16))) unsigned char lds_raw[];
    LAS unsigned char* lds = (LAS unsigned char*)lds_raw;
    volatile LAS unsigned* MISC = (volatile LAS unsigned*)(lds + MISC_OFF);
    const int tid0 = threadIdx.x, wave = __builtin_amdgcn_readfirstlane(tid0 >> 6);
#define PHASE_IDS() int lane = pg8::lane_id(); asm volatile("" : "+v"(lane)); const int tid = wave * 64 + lane; (void)tid
    const int G = gridDim.x;
    const int vcu = (G % 8 == 0) ? ((int)blockIdx.x % 8) * (G / 8) + (int)blockIdx.x / 8 : (int)blockIdx.x;
    unsigned char* ws = args.ws;
    unsigned* ctl = (unsigned*)(ws + WS_CTL);
    for (int u = tid0; u < (LDS_BYTES - LDSCTL_OFF) / 4; u += NWAVES * 64) ((LAS unsigned*)(lds + LDSCTL_OFF))[u] = 0u;
    __syncthreads();
    XcdBarrier bar = xcd_barrier_post(ctl + CW_BAR + args.li * XCD_BAR_WORDS, MISC + 8, wave);
    const int lo = args.ph_lo, hi = args.ph_hi;
#define IN(k) (lo <= (k) && (k) < hi)
#define BOTH(k) (IN(k) && IN((k) + 1))
    const float* const* in = args.in;
    bf16 *XN = (bf16*)(ws + WS_A0), *MG = (bf16*)(ws + WS_A0), *X2b = (bf16*)(ws + WS_A0);
    bf16 *Zl = (bf16*)(ws + WS_A1), *X1b = (bf16*)(ws + WS_A1);
    bf16 *GA = (bf16*)(ws + WS_A2), *UB = (bf16*)(ws + WS_A3), *V = (bf16*)(ws + WS_A4);
    bf16 *X3 = (bf16*)(ws + WS_A1);
    bf16 *PU = (bf16*)(ws + WS_A2);
    bf16 *Pb = (bf16*)(ws + WS_PB);
    bf16 *WinT = (bf16*)(ws + WS_WIN), *WoutT = (bf16*)(ws + WS_WOUT), *WgT = (bf16*)(ws + WS_WG), *W13T = (bf16*)(ws + WS_W13), *W2T = (bf16*)(ws + WS_W2), *WupT = (bf16*)(ws + WS_WUP);
    float *VPART = (float*)(ws + WS_VPART), *SS1 = (float*)(ws + WS_SS1), *SS3 = (float*)(ws + WS_SS3), *RSTD2 = (float*)(ws + WS_RSTD2), *RSTD1 = (float*)(ws + WS_RSTD1), *TOKG = (float*)(ws + WS_TOKG);
    int *CNT = (int*)(ws + WS_CTL), *LIST = (int*)(ws + WS_LIST), *TOKE = (int*)(ws + WS_TOKE);
    bf16 *Hb = (bf16*)(ws + WS_A2), *Yb = (bf16*)(ws + WS_A3), *WrT = (bf16*)(ws + WS_WR), *WLRU = (bf16*)(ws + WS_WLRU), *WSGU = (bf16*)(ws + WS_WSGU);
    unsigned long long* AGGQ = (unsigned long long*)(ws + WS_AGG); float* SPL8 = (float*)(ws + WS_SPL8);

    if (IN(0)) {
        PHASE_IDS();
        LAS float* scr = (LAS float*)(lds + wave * 16384);
        const int gw = vcu * NWAVES + wave, NGW = G * NWAVES;
        for (int it = gw; it < 16 * 192; it += NGW) { const int kb = it / 192, nb = it % 192; p0_transpose_item(in[3], 6144, kb * 64, nb * 32, WinT, 1024, win_dest_row(nb * 32), nullptr, scr, lane); }
        for (int m = gw; m < T; m += 2 * NGW) {
            const int m2 = m + NGW < T ? m + NGW : m;
            const pg8::f32x4* xr = (const pg8::f32x4*)(in[0] + (size_t)m * D) + lane; const pg8::f32x4* xr2 = (const pg8::f32x4*)(in[0] + (size_t)m2 * D) + lane; const pg8::f32x4* gr = (const pg8::f32x4*)in[2] + lane;
            pg8::f32x4 v[4], w[4]; float s = 0.f, s2 = 0.f;
#pragma unroll
            for (int j = 0; j < 4; ++j) { v[j] = xr[64 * j]; w[j] = xr2[64 * j]; }
#pragma unroll
            for (int j = 0; j < 4; ++j) { s += (v[j].x * v[j].x + v[j].y * v[j].y) + (v[j].z * v[j].z + v[j].w * v[j].w); s2 += (w[j].x * w[j].x + w[j].y * w[j].y) + (w[j].z * w[j].z + w[j].w * w[j].w); }
            const float rstd = rsqrtf(wave_sum(s) * (1.f / D) + EPS), rstd2 = rsqrtf(wave_sum(s2) * (1.f / D) + EPS);
            unsigned long long* o8 = (unsigned long long*)(XN + (size_t)m * D) + lane; unsigned long long* o82 = (unsigned long long*)(XN + (size_t)m2 * D) + lane;
#pragma unroll
            for (int j = 0; j < 4; ++j) { const pg8::f32x4 gg = gr[64 * j];
                o8[64 * j] = (unsigned long long)pk2(v[j].x * rstd * gg.x, v[j].y * rstd * gg.y) | ((unsigned long long)pk2(v[j].z * rstd * gg.z, v[j].w * rstd * gg.w) << 32);
                o82[64 * j] = (unsigned long long)pk2(w[j].x * rstd2 * gg.x, w[j].y * rstd2 * gg.y) | ((unsigned long long)pk2(w[j].z * rstd2 * gg.z, w[j].w * rstd2 * gg.w) << 32); }
        }
        for (size_t i = (size_t)(vcu * 512 + tid); i < (size_t)T * 256 / 4; i += (size_t)G * 512) { const pg8::f32x4 v = ((const pg8::f32x4*)in[1])[i];
            ((unsigned long long*)Pb)[i] = (unsigned long long)pk2(v.x, v.y) | ((unsigned long long)pk2(v.z, v.w) << 32); }
        for (int i = vcu * 512 + tid; i < 2 * 16 * 64 * 64; i += G * 512) { const int gate = i >> 16, h = (i >> 12) & 15, j = (i >> 6) & 63, ii = i & 63;
            WLRU[i] = f2bf(in[gate ? 8 : 6][(h * 64 + ii) * 64 + j]); }
        for (int i = vcu * 512 + tid; i < 8 * 128 * 128; i += G * 512) { const int t = (i >> 7) & 127, s = i & 127; WSGU[i] = s <= t ? f2bf(in[13][i]) : (bf16)0; }
        for (int i = vcu * 512 + tid; i < 1024; i += G * 512) SPL8[i] = -8.f * log1pf(expf(-in[10][i]));
        for (int i = vcu * 512 + tid; i < 64 * 1024; i += G * 512) { const int n = i >> 10, k = i & 1023; float v = 0.f;
            if (n < 4) v = in[17][k * 4 + n] * in[16][k]; else if (n < 36) v = in[19][k * 32 + (n - 4)] * in[16][k];
            WrT[i] = f2bf(v); }
        if (BOTH(0)) xcd_barrier(bar);
    }
    if (IN(1)) {
        { pg8::Gemm g{XN, WinT, 1024}; Gemm1Order S; S.init(T, 6144, G, (int)blockIdx.x);
          S.wave = wave; S.w = DefW{in[15], in[21], in[22], in[23], in[25], in[26], in[16], in[24], WoutT, W13T, W2T, WgT, WupT};
          pg8::Epi1 E{Zl, GA, UB, V, VPART};
          pg8::gemm_phase<pg8::Epi1, Gemm1Order, true, true, false>(lds, g, S, E, wave); }
        if (BOTH(1)) xcd_barrier(bar);
    }

    if (IN(3)) {
        PHASE_IDS();
        mixer_phase(lds, vcu, G, tid, lane, wave, Zl, GA, UB, V, VPART, AGGQ, MG, WLRU, WSGU, SPL8, in);
        if (BOTH(3)) xcd_barrier(bar);
    }
    if (IN(4)) {
        pg8::Gemm g{MG, WoutT, 1024}; pg8::StaticOrder S; S.init(T, 1024, G, (int)blockIdx.x);
        pg8::Epi2 E{in[0], X1b, SS1};
        pg8::gemm_phase<pg8::Epi2, pg8::StaticOrder, true, true, false>(lds, g, S, E, wave);
        if (BOTH(4)) xcd_barrier(bar);
    }

    if (IN(5)) {
        PHASE_IDS();
        constexpr int RS = 528;
        LAS unsigned char* sA = lds; LAS unsigned char* sB = lds + 64 * RS; LAS float* sL = (LAS float*)(lds + 2 * 64 * RS);
        LAS int* sCnt = (LAS int*)(lds + 2 * 64 * RS + 64 * 65 * 4); LAS int* sBase = sCnt + 32;
        const int fr = lane & 15, grp = lane >> 4, mtile = wave & 3, np = wave >> 2;
        for (int tile = vcu; tile < T / 64; tile += G) {
            const int tok0 = tile * 64;
            if (tid < 32) sCnt[tid] = 0;
            pg8::f32x4 acc0 = {0.f, 0.f, 0.f, 0.f}, acc1 = {0.f, 0.f, 0.f, 0.f};
            for (int kc = 0; kc < 4; ++kc) {
#pragma unroll
                for (int it = 0; it < 4; ++it) { const int idx = it * 512 + tid, row = idx >> 5, ch = idx & 31;
                    *(LAS pg8::u32x4*)(sA + row * RS + ch * 16) = *(const pg8::u32x4*)(X1b + (size_t)(tok0 + row) * D + kc * 256 + ch * 8);
                    *(LAS pg8::u32x4*)(sB + row * RS + ch * 16) = *(const pg8::u32x4*)(WrT + (size_t)row * D + kc * 256 + ch * 8); }
                __syncthreads();
#pragma unroll
                for (int ks = 0; ks < 8; ++ks) {
                    const pg8::bf16x8 a = *(const LAS pg8::bf16x8*)(sA + (16 * mtile + fr) * RS + (ks * 32 + 8 * grp) * 2);
                    const pg8::bf16x8 b0 = *(const LAS pg8::bf16x8*)(sB + (32 * np + fr) * RS + (ks * 32 + 8 * grp) * 2);
                    const pg8::bf16x8 b1 = *(const LAS pg8::bf16x8*)(sB + (32 * np + 16 + fr) * RS + (ks * 32 + 8 * grp) * 2);
                    acc0 = __builtin_amdgcn_mfma_f32_16x16x32_bf16(a, b0, acc0, 0, 0, 0);
                    acc1 = __builtin_amdgcn_mfma_f32_16x16x32_bf16(a, b1, acc1, 0, 0, 0);
                }
                __syncthreads();
            }
#pragma unroll
            for (int r = 0; r < 4; ++r) { const int tk = 16 * mtile + 4 * grp + r; sL[tk * 65 + 32 * np + fr] = acc0[r]; sL[tk * 65 + 32 * np + 16 + fr] = acc1[r]; }
            __syncthreads();
            int e1 = 0, e2 = 0, r1 = 0, r2 = 0; float g1 = 0.f, g2 = 0.f;
            if (tid < 64) {
                const int t = tok0 + tid; float ss = 0.f;
#pragma unroll
                for (int q = 0; q < 16; ++q) ss += SS1[(size_t)t * 16 + q];
                const float rstd = rsqrtf(ss * (1.f / D) + EPS);
                RSTD1[t] = rstd;
                const LAS float* l = sL + tid * 65;
                float gl[4];
#pragma unroll
                for (int q = 0; q < 4; ++q) gl[q] = rstd * l[q] + in[18][q];
                float mx = gl[0]; int gi = 0;
#pragma unroll
                for (int q = 1; q < 4; ++q) if (gl[q] > mx) { mx = gl[q]; gi = q; }
                float den = 0.f;
#pragma unroll
                for (int q = 0; q < 4; ++q) den += expf(gl[q] - mx);
                const float gtop = 1.f / den;
                float m1 = -3.0e38f, m2 = -3.0e38f; int i1 = 0, i2 = 0;
                for (int j = 0; j < 8; ++j) { const float v = rstd * l[4 + gi * 8 + j] + in[20][gi * 8 + j];
                    if (v > m1) { m2 = m1; i2 = i1; m1 = v; i1 = j; } else if (v > m2) { m2 = v; i2 = j; } }
                const float p2 = expf(m2 - m1);
                g1 = gtop / (1.f + p2); g2 = gtop * p2 / (1.f + p2);
                e1 = gi * 8 + i1; e2 = gi * 8 + i2;
                r1 = __hip_atomic_fetch_add(&sCnt[e1], 1, __ATOMIC_RELAXED, __HIP_MEMORY_SCOPE_WORKGROUP); r2 = __hip_atomic_fetch_add(&sCnt[e2], 1, __ATOMIC_RELAXED, __HIP_MEMORY_SCOPE_WORKGROUP);
                TOKE[t * 2] = e1; TOKE[t * 2 + 1] = e2; TOKG[t * 2] = g1; TOKG[t * 2 + 1] = g2;
            }
            __syncthreads();
            if (tid < 32) { const int c = sCnt[tid]; sBase[tid] = c ? atomicAdd(&CNT[tid], c) : 0; }
            __syncthreads();
            if (tid < 64) { const int t = tok0 + tid; LIST[e1 * 16384 + sBase[e1] + r1] = t * 2; LIST[e2 * 16384 + sBase[e2] + r2] = t * 2 + 1; }
            __syncthreads();
        }
        if (BOTH(5)) xcd_barrier(bar);
    }
    if (IN(6)) {
        LAS int* tab1 = (LAS int*)(lds + TAB_OFF); LAS int* tab2 = (LAS int*)(lds + TAB_OFF + 512); LAS int* tab3 = (LAS int*)(lds + TAB_OFF + 1024);
        build_moe_units(tab1, tab2, tab3, CNT, vcu, G, wave, (LAS int*)lds);
        unsigned* dcnt = ctl + CW_DONE1;
        { pg8::Gemm g{X1b, W13T, 1024}; pg8::MoeOrder<1> S{tab1, LIST, dcnt};
          pg8::EpiMoe1 E{Hb, LIST, RSTD1};
          pg8::gemm_phase<pg8::EpiMoe1, pg8::MoeOrder<1>, true, true, true>(lds, g, S, E, wave); }
        pg8::Gemm g2{Hb, W2T, 256}; pg8::EpiMoe2 E2{Yb, LIST, TOKG};
        moe_wait_tiles(tab2, dcnt, wave);
        { pg8::MoeOrder<0> S{tab2, LIST, dcnt}; pg8::gemm_phase<pg8::EpiMoe2, pg8::MoeOrder<0>, true, true, false>(lds, g2, S, E2, wave); }
        moe_wait_tiles(tab3, dcnt, wave);
        { pg8::MoeOrder<0> S{tab3, LIST, dcnt}; pg8::gemm_phase<pg8::EpiMoe2, pg8::MoeOrder<0>, true, true, false>(lds, g2, S, E2, wave); }
        if (BOTH(6)) xcd_barrier(bar);
    }
    if (IN(8)) {
        PHASE_IDS();
        const int gw = vcu * NWAVES + wave, NGW = G * NWAVES;
        for (int row = gw; row < T; row += NGW) { float ss = 0.f;
#pragma unroll
            for (int hh = 0; hh < 2; ++hh) { const size_t o = (size_t)row * D + hh * 512 + lane * 8;
                pg8::f32x4 a0, a1, b0, b1, c0, c1; pg8::unpack8(*(const pg8::u32x4*)(X1b + o), a0, a1);
                pg8::unpack8(*(const pg8::u32x4*)(Yb + (size_t)row * 2 * D + hh * 512 + lane * 8), b0, b1); pg8::unpack8(*(const pg8::u32x4*)(Yb + ((size_t)row * 2 + 1) * D + hh * 512 + lane * 8), c0, c1);
                a0 = a0 + b0 + c0; a1 = a1 + b1 + c1;
                ss += (a0[0] * a0[0] + a0[1] * a0[1]) + (a0[2] * a0[2] + a0[3] * a0[3]) + (a1[0] * a1[0] + a1[1] * a1[1]) + (a1[2] * a1[2] + a1[3] * a1[3]);
                *(pg8::u32x4*)(X2b + o) = pg8::pack8(a0, a1); }
            ss = wave_sum(ss);
            if (lane == 0) RSTD2[row] = rsqrtf(ss * (1.f / D) + EPS); }
        if (BOTH(8)) xcd_barrier(bar);
    }
    const bool fuse_final = (G == 256);
    if (IN(9)) {
        { pg8::Gemm g{Pb, WupT, 256}; pg8::StaticOrder S; S.init(T, 1024, G, (int)blockIdx.x);
          pg8::EpiPlain E{PU};
          pg8::gemm_phase<pg8::EpiPlain, pg8::StaticOrder, true, true, false>(lds, g, S, E, wave); }
        pg8::Gemm g{X2b, WgT, 1024}; pg8::StaticOrder S; S.init(T, 1024, G, (int)blockIdx.x);
        if (fuse_final) {
            pg8::EpiPleFinal E{X2b, PU, RSTD2, in[27], args.out, (float*)(ws + WS_XCH), ctl + CW_PANEL, (LAS float*)(lds + RING_BYTES), wave};
            pg8::gemm_phase<pg8::EpiPleFinal, pg8::StaticOrder, true, true, false>(lds, g, S, E, wave);
        } else {
            pg8::EpiPle E{X2b, PU, RSTD2, X3, SS3};
            pg8::gemm_phase<pg8::EpiPle, pg8::StaticOrder, true, true, false>(lds, g, S, E, wave);
            if (BOTH(9)) xcd_barrier(bar);
        }
    }

    if (IN(10) && !fuse_final) {
        PHASE_IDS();
        const int gw = vcu * NWAVES + wave, NGW = G * NWAVES;
        for (int row = gw; row < T; row += NGW) { float ss = 0.f;
            if (lane < 16) ss = SS3[(size_t)row * 16 + lane];
            ss = wave_sum(ss);
            const float rstd = rsqrtf(ss * (1.f / D) + EPS);
#pragma unroll
            for (int hh = 0; hh < 2; ++hh) { const size_t o = (size_t)row * D + hh * 512 + lane * 8; pg8::f32x4 a0, a1; pg8::unpack8(*(const pg8::u32x4*)(X3 + o), a0, a1);
                const pg8::f32x4 f0 = *(const pg8::f32x4*)(in[27] + hh * 512 + lane * 8), f1 = *(const pg8::f32x4*)(in[27] + hh * 512 + lane * 8 + 4);
                *(pg8::f32x4*)(args.out + o) = a0 * rstd * f0; *(pg8::f32x4*)(args.out + o + 4) = a1 * rstd * f1; } }
    }
#undef IN
#undef BOTH
#undef PHASE_IDS
}

static int mega_grid() {
    static int grid = 0;
    if (grid == 0) {
        int dev = 0, cus = 0;
        if (hipGetDevice(&dev) != hipSuccess || hipDeviceGetAttribute(&cus, hipDeviceAttributeMultiprocessorCount, dev) != hipSuccess) { fprintf(stderr, "mega: device query failed\n"); grid = -1; return grid; }
        if (hipFuncSetAttribute((const void*)mega_fwd, hipFuncAttributeMaxDynamicSharedMemorySize, LDS_BYTES) != hipSuccess) { fprintf(stderr, "mega: hipFuncSetAttribute failed\n"); grid = -1; return grid; }
        (void)hipGetLastError();
        grid = cus;
    }
    return grid;
}
static void launch_mega(void* const* d_in, void* d_out, void* d_ws, int lo, int hi, int li, hipStream_t stream) {
    const int grid = mega_grid(); if (grid <= 0) return;
    Args a{};
    for (int i = 0; i < 28; ++i) a.in[i] = (const float*)d_in[i];
    a.out = (float*)d_out; a.ws = (unsigned char*)d_ws; a.ph_lo = lo; a.ph_hi = hi; a.li = li; a.pad = 0;
    hipLaunchKernelGGL(mega_fwd, dim3(grid), dim3(NWAVES * 64), LDS_BYTES, stream, a);
}

extern "C" void kernel_launch(void* const* d_in, const int* in_sizes, int n_in, void* d_out, int out_size, void* d_ws, size_t ws_size, hipStream_t stream) {
    if (n_in != 28 || in_sizes[0] != T * D || out_size != T * D || ws_size < WS_MEGA_END) { fprintf(stderr, "kernel_launch: unexpected shapes (n_in %d, ws %zu)\n", n_in, ws_size); return; }
    (void)hipMemsetAsync(d_ws, 0, 2 * MiB, stream);
    launch_mega(d_in, d_out, d_ws, 0, 11, 0, stream);
}
```

```cpp
#include <hip/hip_runtime.h>
#include <stdint.h>
#include <cstdio>

typedef unsigned short bf16;
constexpr int T = 16384, D = 1024, SEQ = 2048;
constexpr float EPS = 1e-6f;
constexpr size_t MiB = 1u << 20;
constexpr size_t WS_CTL = 0;
constexpr size_t WS_VPART = 2 * MiB;
constexpr size_t WS_SS1 = 4 * MiB;
constexpr size_t WS_SS3 = 5 * MiB;
constexpr size_t WS_AGG = 1 * MiB;
constexpr size_t WS_LIST = 6 * MiB;
constexpr size_t WS_TOKE = 8 * MiB;
constexpr size_t WS_TOKG = 8 * MiB + 128 * 1024;
constexpr size_t WS_RSTD2 = 8 * MiB + 256 * 1024;
constexpr size_t WS_A0 = 74 * MiB;
constexpr size_t WS_A1 = 106 * MiB;
constexpr size_t WS_A2 = 138 * MiB;
constexpr size_t WS_A3 = 170 * MiB;
constexpr size_t WS_A4 = 202 * MiB;
constexpr size_t WS_END = 234 * MiB;

__device__ __forceinline__ float bf2f(bf16 b) { return __uint_as_float(((unsigned)b) << 16); }
__device__ __forceinline__ bf16 f2bf(float f) { unsigned u = __float_as_uint(f); u += 0x7fffu + ((u >> 16) & 1u); return (bf16)(u >> 16); }
__device__ __forceinline__ float sigm(float x) { return 1.f / (1.f + expf(-x)); }
__device__ __forceinline__ float gelu_t(float x) { const float u = 0.7978845608028654f * (x + 0.044715f * x * x * x); return 0.5f * x * (1.f + tanhf(u)); }
__device__ __forceinline__ float wave_sum(float v) {
#pragma unroll
    for (int o = 1; o < 64; o <<= 1) v += __shfl_xor(v, o);
    return v;
}

#define LAS __attribute__((address_space(3)))
#define GAS __attribute__((address_space(1)))
namespace pg8 {
typedef short bf16x8 __attribute__((ext_vector_type(8)));
typedef float f32x4 __attribute__((ext_vector_type(4)));
typedef float f32x2 __attribute__((ext_vector_type(2)));
typedef unsigned u32x4 __attribute__((ext_vector_type(4)));
typedef unsigned u32x2 __attribute__((ext_vector_type(2)));
constexpr int BM = 256, BK = 64, HALF = 128, HTB = HALF * BK * 2, STAGE_BYTES = 8 * HTB, NXCD = 8, WGM = 8;

__host__ __device__ __forceinline__ int lds_byte(int r, int c) { const int st = (r >> 4) * 2 + (c >> 5), rr = r & 15, cc = c & 31, ob = rr * 64 + cc * 2; return st * 1024 + (ob ^ (((ob >> 9) & 1) << 5)); }
__host__ __device__ __forceinline__ void stage_rc(int b, int& R, int& C) { const int st = b / 1024, sb = b % 1024, swz = sb ^ (((sb >> 9) & 1) << 5); R = (st >> 1) * 16 + swz / 64; C = (st & 1) * 32 + (swz % 64) / 2; }
__host__ __device__ __forceinline__ int perm32(int rho) { const int n = rho >> 4, i = rho & 15; return 8 * (i >> 2) + 4 * n + (i & 3); }

__device__ __forceinline__ int lane_id() { int l; asm volatile("v_mbcnt_lo_u32_b32 %0, -1, 0\n\tv_mbcnt_hi_u32_b32 %0, -1, %0" : "=v"(l)); return l; }
struct Unit { int pm, pn, e, tile, cnt; };
struct Gemm { const bf16* A; const bf16* Bt; int K; };

struct StaticOrder {
    int nM, nN, nwg, G, c;
    __device__ void init(int M, int N, int G_, int c_) { nM = M / BM; nN = N / BM; nwg = nM * nN; G = G_; c = c_; }
    __device__ bool next(int i, Unit& u) const {
        const long L = (long)i * G + c; if (L >= nwg) return false;
        int wgid = (int)L; { const int q = nwg / NXCD, r = nwg % NXCD, xcd = wgid % NXCD, off = wgid / NXCD; wgid = (xcd < r ? xcd * (q + 1) : r * (q + 1) + (xcd - r) * q) + off; }
        const int nig = WGM * nN, gid = wgid / nig, fm = gid * WGM, gsz = (nM - fm) < WGM ? (nM - fm) : WGM;
        u.pm = fm + ((wgid % nig) % gsz); u.pn = (wgid % nig) / gsz; u.e = 0; u.tile = 0; u.cnt = 0; return true;
    }
    __device__ __forceinline__ unsigned row_off(const Unit&, int) const { return 0u; }
    __device__ __forceinline__ void a_ready(const Unit&) const {}
    __device__ __forceinline__ void done(const Unit&) const {}
    struct Pre {}; __device__ __forceinline__ void pre(int, Pre&) const {}
    __device__ __forceinline__ void post(int, Pre&) const {}
    __device__ __forceinline__ bool half(const Unit&) const { return false; }
};

__device__ __forceinline__ unsigned cvt_pk_bf16(float lo, float hi) { unsigned r; asm volatile("v_cvt_pk_bf16_f32 %0, %1, %2" : "=v"(r) : "v"(lo), "v"(hi)); return r; }
typedef __bf16 bf16x2_t __attribute__((ext_vector_type(2)));
__device__ __forceinline__ unsigned cvt_pk_bf16_cv(float lo, float hi) { const f32x2 v = {lo, hi}; const bf16x2_t b = __builtin_convertvector(v, bf16x2_t); return __builtin_bit_cast(unsigned, b); }
__device__ __forceinline__ float fsigm(float x) { return __builtin_amdgcn_rcpf(1.0f + __builtin_amdgcn_exp2f(-1.4426950409f * x)); }
__device__ __forceinline__ float fgelu(float x) { const float u = x + 0.044715f * x * x * x; return x * __builtin_amdgcn_rcpf(1.0f + __builtin_amdgcn_exp2f(-2.3022082f * u)); }

template <class Epi, class Sched, bool ALIGN_EPI, bool SP2, bool GATHER>
__device__ __forceinline__ void gemm_phase(LAS unsigned char* lds, const Gemm g, const Sched& S, const Epi& E, const int wave_) {
    int lane = lane_id(); asm volatile("" : "+v"(lane));
    const int wid = wave_, tid = wid * 64 + lane, wr = wid >> 2, wc = wid & 3, fr = lane & 15, fq = lane >> 4;
    const int K = g.K, nt = K / BK;
    int sR[2], sC[2];
    unsigned voffB[2], vA0[2], vA1[2], nvA0[2], nvA1[2];
#pragma unroll
    for (int i = 0; i < 2; ++i) { stage_rc(tid * 16 + i * 8192, sR[i], sC[i]); const int Rb = Epi::PERM ? ((sR[i] & ~31) + perm32(sR[i] & 31)) : sR[i];
        voffB[i] = (unsigned)(Rb * K + sC[i]) * 2u; vA0[i] = (unsigned)(sR[i] * K + sC[i]) * 2u; vA1[i] = vA0[i]; nvA0[i] = vA0[i]; nvA1[i] = vA0[i]; }
    const size_t kstep = (size_t)(BK * 2);
    const size_t hstep = (size_t)HALF * K * 2;
    const size_t tstep = 2 * hstep;
    const size_t ahs = GATHER ? 0 : hstep;
    const unsigned ldsw = (unsigned)wid * 1024u;
    const int aoff = lds_byte(wr * 64 + fr, fq * 8), boff = lds_byte(wc * 32 + fr, fq * 8);
#define PG8_SA(b, h) (((b) * 2 + (h)) * HTB)
#define PG8_SB(b, h) ((4 + (b) * 2 + (h)) * HTB)
#define PG8_STAGE(bufoff, gbase, voff) do { _Pragma("unroll") for (int _i = 0; _i < 2; ++_i) \
        __builtin_amdgcn_global_load_lds((const unsigned*)((const char*)(gbase) + (voff)[_i]), (LAS unsigned*)(lds + (bufoff) + ldsw + _i * 8192), 16, 0, 0); } while (0)
#define PG8_LDA(dst, b, h) do { _Pragma("unroll") for (int m = 0; m < 4; ++m) _Pragma("unroll") for (int k = 0; k < 2; ++k) dst[m][k] = *(const LAS bf16x8*)(lds + PG8_SA(b, h) + aoff + m * 2048 + k * 1024); } while (0)
#define PG8_LDB(dst, b, h) do { _Pragma("unroll") for (int n = 0; n < 2; ++n) _Pragma("unroll") for (int k = 0; k < 2; ++k) dst[n][k] = *(const LAS bf16x8*)(lds + PG8_SB(b, h) + boff + n * 2048 + k * 1024); } while (0)
#define PG8_MMA(ai, bj, At, Bt) do { __builtin_amdgcn_s_setprio(1); _Pragma("unroll") for (int m = 0; m < 4; ++m) _Pragma("unroll") for (int n = 0; n < 2; ++n) _Pragma("unroll") for (int k = 0; k < 2; ++k) \
        acc[ai][bj][m][n] = __builtin_amdgcn_mfma_f32_16x16x32_bf16(Bt[n][k], At[m][k], acc[ai][bj][m][n], 0, 0, 0); __builtin_amdgcn_s_setprio(0); } while (0)
#define PG8_WAIT_V(n) asm volatile("s_waitcnt vmcnt(" #n ")" ::: "memory")
#define PG8_WAIT_L(n) asm volatile("s_waitcnt lgkmcnt(" #n ")" ::: "memory")
#define PG8_BAR __builtin_amdgcn_s_barrier()
#define PG8_SCHED __builtin_amdgcn_sched_barrier(0)
    Unit cur, nxt; int ui = 0;
    if (!S.next(0, cur)) return;
    f32x4 acc[2][2][4][2];
#pragma unroll
    for (int a = 0; a < 2; ++a)
#pragma unroll
        for (int b = 0; b < 2; ++b)
#pragma unroll
            for (int m = 0; m < 4; ++m)
#pragma unroll
                for (int n = 0; n < 2; ++n) acc[a][b][m][n] = (f32x4){0.f, 0.f, 0.f, 0.f};
    bf16x8 At[4][2], B0[2][2], B1[2][2];
    const char* cA = GATHER ? (const char*)g.A : (const char*)g.A + (size_t)cur.pm * tstep; const char* cB = (const char*)g.Bt + (size_t)cur.pn * tstep;
    if constexpr (GATHER) {
#pragma unroll
        for (int i = 0; i < 2; ++i) { vA0[i] = S.row_off(cur, sR[i]) + (unsigned)sC[i] * 2u; vA1[i] = S.row_off(cur, HALF + sR[i]) + (unsigned)sC[i] * 2u; nvA0[i] = vA0[i]; nvA1[i] = vA1[i]; }
    }
    S.a_ready(cur);
    if constexpr (SP2) {
        PG8_STAGE(PG8_SB(0, 0), cB, voffB); PG8_STAGE(PG8_SB(0, 1), cB + hstep, voffB); PG8_STAGE(PG8_SA(0, 0), cA, vA0); PG8_STAGE(PG8_SA(0, 1), cA + ahs, vA1);
        if (wr == 1) PG8_BAR;
        PG8_WAIT_V(2); PG8_BAR;
        PG8_STAGE(PG8_SB(1, 0), cB + kstep, voffB); PG8_STAGE(PG8_SA(1, 0), cA + kstep, vA0); PG8_STAGE(PG8_SB(1, 1), cB + hstep + kstep, voffB);
        PG8_WAIT_V(6); PG8_BAR;
    } else {
        PG8_STAGE(PG8_SB(0, 0), cB, voffB); PG8_STAGE(PG8_SA(0, 0), cA, vA0); PG8_STAGE(PG8_SB(0, 1), cB + hstep, voffB); PG8_STAGE(PG8_SA(0, 1), cA + ahs, vA1);
        if (wr == 1) PG8_BAR;
        PG8_WAIT_V(4); PG8_BAR;
        PG8_STAGE(PG8_SB(1, 0), cB + kstep, voffB); PG8_STAGE(PG8_SA(1, 0), cA + kstep, vA0); PG8_STAGE(PG8_SB(1, 1), cB + hstep + kstep, voffB);
        PG8_WAIT_V(6); PG8_BAR;
    }
    for (;;) {
        const bool has_next = S.next(ui + 1, nxt);
        const char* nA = has_next ? (GATHER ? (const char*)g.A : (const char*)g.A + (size_t)nxt.pm * tstep) : cA; const char* nB = has_next ? (const char*)g.Bt + (size_t)nxt.pn * tstep : cB;
        const bool hf = S.half(cur);
        for (int t = 0; t < nt; t += 2) {
            const bool last = (t == nt - 2);
            const char* a1 = cA + (size_t)(t + 1) * kstep;
            const char* a2 = last ? nA : cA + (size_t)(t + 2) * kstep; const char* b2 = last ? nB : cB + (size_t)(t + 2) * kstep;
            const char* a3 = a2 + kstep; const char* b3 = b2 + kstep;
            if (last && has_next) S.a_ready(nxt);
            unsigned w0[2], w1[2];
            if constexpr (GATHER) {
                if (last && has_next) {
#pragma unroll
                    for (int i = 0; i < 2; ++i) { nvA0[i] = S.row_off(nxt, sR[i]) + (unsigned)sC[i] * 2u; nvA1[i] = S.row_off(nxt, HALF + sR[i]) + (unsigned)sC[i] * 2u; }
                }
#pragma unroll
                for (int i = 0; i < 2; ++i) { w0[i] = last ? nvA0[i] : vA0[i]; w1[i] = last ? nvA1[i] : vA1[i]; }
            } else {
#pragma unroll
                for (int i = 0; i < 2; ++i) { w0[i] = vA0[i]; w1[i] = vA0[i]; }
            }
            if constexpr (SP2) {
            PG8_LDB(B0, 0, 0); PG8_LDB(B1, 0, 1); PG8_SCHED; PG8_LDA(At, 0, 0); PG8_STAGE(PG8_SA(1, 1), a1 + ahs, vA1);
            PG8_WAIT_V(8); PG8_WAIT_L(0); PG8_BAR; PG8_MMA(0, 0, At, B0); PG8_MMA(0, 1, At, B1); PG8_BAR; PG8_SCHED;
            if (!hf) PG8_LDA(At, 0, 1); PG8_STAGE(PG8_SB(0, 0), b2, voffB); PG8_STAGE(PG8_SB(0, 1), b2 + hstep, voffB); PG8_STAGE(PG8_SA(0, 0), a2, w0);
            PG8_WAIT_V(8); PG8_WAIT_L(0); PG8_BAR; if (!hf) { PG8_MMA(1, 0, At, B0); PG8_MMA(1, 1, At, B1); } PG8_BAR; PG8_SCHED;
            PG8_LDB(B0, 1, 0); PG8_LDB(B1, 1, 1); PG8_SCHED; PG8_LDA(At, 1, 0); PG8_STAGE(PG8_SA(0, 1), a2 + ahs, w1);
            PG8_WAIT_V(8); PG8_WAIT_L(0); PG8_BAR; PG8_MMA(0, 0, At, B0); PG8_MMA(0, 1, At, B1); PG8_BAR; PG8_SCHED;
            if (!hf) PG8_LDA(At, 1, 1); PG8_STAGE(PG8_SB(1, 0), b3, voffB); PG8_STAGE(PG8_SB(1, 1), b3 + hstep, voffB); PG8_STAGE(PG8_SA(1, 0), a3, w0);
            PG8_WAIT_V(8); PG8_WAIT_L(0); PG8_BAR; if (!hf) { PG8_MMA(1, 0, At, B0); PG8_MMA(1, 1, At, B1); } PG8_BAR; PG8_SCHED;
            } else {
            PG8_LDB(B0, 0, 0); PG8_SCHED; PG8_LDA(At, 0, 0); PG8_STAGE(PG8_SA(1, 1), a1 + ahs, vA1);
            PG8_WAIT_L(8); PG8_BAR; PG8_WAIT_L(0); PG8_MMA(0, 0, At, B0); PG8_BAR; PG8_SCHED;
            PG8_LDB(B1, 0, 1); PG8_STAGE(PG8_SB(0, 0), b2, voffB);
            PG8_BAR; PG8_WAIT_L(0); PG8_MMA(0, 1, At, B1); PG8_BAR;
            PG8_LDA(At, 0, 1); PG8_STAGE(PG8_SA(0, 0), a2, w0);
            PG8_BAR; PG8_WAIT_L(0); PG8_MMA(1, 0, At, B0); PG8_BAR; PG8_SCHED;
            PG8_STAGE(PG8_SB(0, 1), b2 + hstep, voffB);
            PG8_WAIT_V(6); PG8_BAR; PG8_MMA(1, 1, At, B1); PG8_BAR;
            PG8_LDB(B0, 1, 0); PG8_SCHED; PG8_LDA(At, 1, 0); PG8_STAGE(PG8_SA(0, 1), a2 + ahs, w1);
            PG8_WAIT_L(8); PG8_BAR; PG8_WAIT_L(0); PG8_MMA(0, 0, At, B0); PG8_BAR; PG8_SCHED;
            PG8_LDB(B1, 1, 1); PG8_STAGE(PG8_SB(1, 0), b3, voffB);
            PG8_BAR; PG8_WAIT_L(0); PG8_MMA(0, 1, At, B1); PG8_BAR;
            PG8_LDA(At, 1, 1); PG8_STAGE(PG8_SA(1, 0), a3, w0);
            PG8_BAR; PG8_WAIT_L(0); PG8_MMA(1, 0, At, B0); PG8_BAR; PG8_SCHED;
            PG8_STAGE(PG8_SB(1, 1), b3 + hstep, voffB);
            PG8_WAIT_V(6); PG8_BAR; PG8_MMA(1, 1, At, B1); PG8_BAR;
            }
        }
        if constexpr (ALIGN_EPI) { if (wr == 0) PG8_BAR; }
        typename Sched::Pre pre_; S.pre(ui, pre_);
        E(acc, cur, wr, wc, fr, fq); S.done(cur); S.post(ui, pre_);
        if (!has_next) break;
#pragma unroll
        for (int a = 0; a < 2; ++a)
#pragma unroll
            for (int b = 0; b < 2; ++b)
#pragma unroll
                for (int m = 0; m < 4; ++m)
#pragma unroll
                    for (int n = 0; n < 2; ++n) acc[a][b][m][n] = (f32x4){0.f, 0.f, 0.f, 0.f};
        cur = nxt; cA = nA; cB = nB; ++ui;
        if constexpr (GATHER) {
#pragma unroll
            for (int i = 0; i < 2; ++i) { vA0[i] = nvA0[i]; vA1[i] = nvA1[i]; }
        }
        if constexpr (ALIGN_EPI) { if (wr == 1) PG8_BAR; }
    }
    PG8_WAIT_V(0);
    if constexpr (!ALIGN_EPI) { if (wr == 0) PG8_BAR; }
    PG8_BAR;
#undef PG8_SA
#undef PG8_SB
#undef PG8_STAGE
#undef PG8_LDA
#undef PG8_LDB
#undef PG8_MMA
#undef PG8_WAIT_V
#undef PG8_WAIT_L
#undef PG8_BAR
#undef PG8_SCHED
}

__device__ __forceinline__ u32x4 pack8(const f32x4 v0, const f32x4 v1) { u32x4 w; w.x = cvt_pk_bf16(v0[0], v0[1]); w.y = cvt_pk_bf16(v0[2], v0[3]); w.z = cvt_pk_bf16(v1[0], v1[1]); w.w = cvt_pk_bf16(v1[2], v1[3]); return w; }
__device__ __forceinline__ void unpack8(const u32x4 w, f32x4& v0, f32x4& v1) {
    v0[0] = __uint_as_float(w.x << 16); v0[1] = __uint_as_float(w.x & 0xffff0000u); v0[2] = __uint_as_float(w.y << 16); v0[3] = __uint_as_float(w.y & 0xffff0000u);
    v1[0] = __uint_as_float(w.z << 16); v1[1] = __uint_as_float(w.z & 0xffff0000u); v1[2] = __uint_as_float(w.w << 16); v1[3] = __uint_as_float(w.w & 0xffff0000u); }

struct Epi1 {
    static constexpr bool PERM = true;
    bf16 *Zl, *GA, *UB, *V; float* VPART;
    __device__ __forceinline__ void operator()(const f32x4 (&acc)[2][2][4][2], const Unit& u, int wr, int wc, int fr, int fq) const {
        const int row0 = u.pm * BM + wr * 64 + fr, pn = u.pn;
        if (pn < 4) {
            const int col0 = pn * 256 + wc * 32 + 8 * fq;
#pragma unroll
            for (int ai = 0; ai < 2; ++ai)
#pragma unroll
                for (int m = 0; m < 4; ++m) { bf16* rowp = Zl + (size_t)(row0 + ai * HALF + m * 16) * D + col0;
#pragma unroll
                    for (int bj = 0; bj < 2; ++bj) *(u32x4*)(rowp + bj * HALF) = pack8(acc[ai][bj][m][0], acc[ai][bj][m][1]); }
        } else if (pn < 20) {
            bf16* O = pn < 12 ? GA : UB; const int uu = pn < 12 ? pn - 4 : pn - 12; const int col0 = uu * 128 + wc * 32 + 8 * fq;
#pragma unroll
            for (int ai = 0; ai < 2; ++ai)
#pragma unroll
                for (int m = 0; m < 4; ++m) { f32x4 v[2];
#pragma unroll
                    for (int n = 0; n < 2; ++n)
#pragma unroll
                        for (int i = 0; i < 4; ++i) v[n][i] = fgelu(acc[ai][0][m][n][i]) * fsigm(acc[ai][1][m][n][i]);
                    *(u32x4*)(O + (size_t)(row0 + ai * HALF + m * 16) * D + col0) = pack8(v[0], v[1]); }
        } else {
            const int col0 = (pn - 20) * 256 + wc * 32 + 8 * fq;
#pragma unroll
            for (int ai = 0; ai < 2; ++ai)
#pragma unroll
                for (int m = 0; m < 4; ++m) { const int row = row0 + ai * HALF + m * 16; float s1 = 0.f, s2 = 0.f;
#pragma unroll
                    for (int bj = 0; bj < 2; ++bj) { f32x4 v[2];
#pragma unroll
                        for (int n = 0; n < 2; ++n)
#pragma unroll
                            for (int i = 0; i < 4; ++i) { const float gv = fgelu(acc[ai][bj][m][n][i]); v[n][i] = gv; s1 += gv; s2 += gv * gv; }
                        *(u32x4*)(V + (size_t)row * D + col0 + bj * HALF) = pack8(v[0], v[1]); }
                    s1 += __shfl_xor(s1, 16); s1 += __shfl_xor(s1, 32); s2 += __shfl_xor(s2, 16); s2 += __shfl_xor(s2, 32);
                    if (fq == 0) *(f32x2*)(VPART + (size_t)row * 32 + ((pn - 20) * 4 + wc) * 2) = (f32x2){s1, s2}; }
        }
    }
};
struct EpiPlain {
    static constexpr bool PERM = true;
    bf16* O;
    __device__ __forceinline__ void operator()(const f32x4 (&acc)[2][2][4][2], const Unit& u, int wr, int wc, int fr, int fq) const {
        const int row0 = u.pm * BM + wr * 64 + fr, col0 = u.pn * 256 + wc * 32 + 8 * fq;
#pragma unroll
        for (int ai = 0; ai < 2; ++ai)
#pragma unroll
            for (int m = 0; m < 4; ++m) { bf16* rowp = O + (size_t)(row0 + ai * HALF + m * 16) * D + col0;
#pragma unroll
                for (int bj = 0; bj < 2; ++bj) *(u32x4*)(rowp + bj * HALF) = pack8(acc[ai][bj][m][0], acc[ai][bj][m][1]); }
    }
};
struct Epi2 {
    static constexpr bool PERM = true;
    const float* x; bf16* X1b; float* SS1;
    __device__ __forceinline__ void operator()(const f32x4 (&acc)[2][2][4][2], const Unit& u, int wr, int wc, int fr, int fq) const {
        const int row0 = u.pm * BM + wr * 64 + fr, col0 = u.pn * 256 + wc * 32 + 8 * fq;
#pragma unroll
        for (int ai = 0; ai < 2; ++ai)
#pragma unroll
            for (int m = 0; m < 4; ++m) { const int row = row0 + ai * HALF + m * 16; float ss = 0.f;
#pragma unroll
                for (int bj = 0; bj < 2; ++bj) { const float* xp = x + (size_t)row * D + col0 + bj * HALF;
                    const f32x4 v0 = acc[ai][bj][m][0] + *(const f32x4*)xp, v1 = acc[ai][bj][m][1] + *(const f32x4*)(xp + 4);
                    ss += (v0[0] * v0[0] + v0[1] * v0[1]) + (v0[2] * v0[2] + v0[3] * v0[3]) + (v1[0] * v1[0] + v1[1] * v1[1]) + (v1[2] * v1[2] + v1[3] * v1[3]);
                    *(u32x4*)(X1b + (size_t)row * D + col0 + bj * HALF) = pack8(v0, v1); }
                ss += __shfl_xor(ss, 16); ss += __shfl_xor(ss, 32);
                if (fq == 0) SS1[(size_t)row * 16 + u.pn * 4 + wc] = ss; }
    }
};
struct EpiPle {
    static constexpr bool PERM = true;
    const bf16* X2b; const bf16* PU; const float* RSTD2; bf16* X3; float* SS3;
    __device__ __forceinline__ void operator()(const f32x4 (&acc)[2][2][4][2], const Unit& u, int wr, int wc, int fr, int fq) const {
        const int row0 = u.pm * BM + wr * 64 + fr, col0 = u.pn * 256 + wc * 32 + 8 * fq;
#pragma unroll
        for (int ai = 0; ai < 2; ++ai)
#pragma unroll
            for (int m = 0; m < 4; ++m) { const int row = row0 + ai * HALF + m * 16; float ss = 0.f; const float r2 = RSTD2[row];
#pragma unroll
                for (int bj = 0; bj < 2; ++bj) { const size_t o = (size_t)row * D + col0 + bj * HALF;
                    f32x4 x0, x1, p0, p1; unpack8(*(const u32x4*)(X2b + o), x0, x1); unpack8(*(const u32x4*)(PU + o), p0, p1);
                    f32x4 v0, v1;
#pragma unroll
                    for (int i = 0; i < 4; ++i) { v0[i] = x0[i] + fsigm(r2 * acc[ai][bj][m][0][i]) * p0[i]; v1[i] = x1[i] + fsigm(r2 * acc[ai][bj][m][1][i]) * p1[i]; }
                    ss += (v0[0] * v0[0] + v0[1] * v0[1]) + (v0[2] * v0[2] + v0[3] * v0[3]) + (v1[0] * v1[0] + v1[1] * v1[1]) + (v1[2] * v1[2] + v1[3] * v1[3]);
                    *(u32x4*)(X3 + o) = pack8(v0, v1); }
                ss += __shfl_xor(ss, 16); ss += __shfl_xor(ss, 32);
                if (fq == 0) SS3[(size_t)row * 16 + u.pn * 4 + wc] = ss; }
    }
};

struct EpiPleFinal {
    static constexpr bool PERM = true;
    const bf16* X2b; const bf16* PU; const float* RSTD2; const float* fn; float* out; float* XCH; unsigned* cnt; LAS float* xl; int wave;
    __device__ __forceinline__ void operator()(f32x4 (&acc)[2][2][4][2], const Unit& u, int wr, int wc, int fr, int fq) const {
        const int tid = wave * 64 + lane_id();
        const int rl0 = wr * 64 + fr, col0 = u.pn * 256 + wc * 32 + 8 * fq;
#pragma unroll
        for (int ai = 0; ai < 2; ++ai)
#pragma unroll
            for (int m = 0; m < 4; ++m) { const int rl = rl0 + ai * HALF + m * 16, row = u.pm * BM + rl; float ss = 0.f; const float r2 = RSTD2[row];
#pragma unroll
                for (int bj = 0; bj < 2; ++bj) { const size_t o = (size_t)row * D + col0 + bj * HALF;
                    f32x4 x0, x1, p0, p1; unpack8(*(const u32x4*)(X2b + o), x0, x1); unpack8(*(const u32x4*)(PU + o), p0, p1);
                    f32x4 v0, v1;
#pragma unroll
                    for (int i = 0; i < 4; ++i) { v0[i] = x0[i] + fsigm(r2 * acc[ai][bj][m][0][i]) * p0[i]; v1[i] = x1[i] + fsigm(r2 * acc[ai][bj][m][1][i]) * p1[i]; }
                    ss += (v0[0] * v0[0] + v0[1] * v0[1]) + (v0[2] * v0[2] + v0[3] * v0[3]) + (v1[0] * v1[0] + v1[1] * v1[1]) + (v1[2] * v1[2] + v1[3] * v1[3]);
                    acc[ai][bj][m][0] = v0; acc[ai][bj][m][1] = v1; }
                ss += __shfl_xor(ss, 16); ss += __shfl_xor(ss, 32);
                if (fq == 0) xl[rl * 4 + wc] = ss; }
        __syncthreads();
        if (tid < 256) { const f32x4 p = *(const LAS f32x4*)(xl + tid * 4);
            __hip_atomic_store(XCH + (size_t)(u.pm * BM + tid) * 4 + u.pn, (p[0] + p[1]) + (p[2] + p[3]), __ATOMIC_RELAXED, __HIP_MEMORY_SCOPE_AGENT); }
        asm volatile("s_waitcnt vmcnt(0)" ::: "memory");
        if (tid < 256 && (tid & 63) == 0) __hip_atomic_fetch_add(cnt + 64 * u.pm, 1u, __ATOMIC_RELAXED, __HIP_MEMORY_SCOPE_AGENT);
        if (tid < 64) { unsigned sp = 0;
            while ((unsigned)__builtin_amdgcn_readfirstlane(__hip_atomic_load(cnt + 64 * u.pm, __ATOMIC_RELAXED, __HIP_MEMORY_SCOPE_AGENT)) < 16u) { if (++sp > (1u << 22)) break; __builtin_amdgcn_s_sleep(1); } }
        __syncthreads();
        if (tid < 256) { const float* xs = XCH + (size_t)(u.pm * BM + tid) * 4; float tot = 0.f;
#pragma unroll
            for (int q = 0; q < 4; ++q) tot += __hip_atomic_load(xs + q, __ATOMIC_RELAXED, __HIP_MEMORY_SCOPE_AGENT);
            xl[1024 + tid] = rsqrtf(tot * (1.f / D) + EPS); }
        __syncthreads();
#pragma unroll
        for (int ai = 0; ai < 2; ++ai)
#pragma unroll
            for (int m = 0; m < 4; ++m) { const int rl = rl0 + ai * HALF + m * 16; const float rs = xl[1024 + rl]; float* op = out + (size_t)(u.pm * BM + rl) * D + col0;
#pragma unroll
                for (int bj = 0; bj < 2; ++bj) { const f32x4 f0 = *(const f32x4*)(fn + col0 + bj * HALF), f1 = *(const f32x4*)(fn + col0 + bj * HALF + 4);
                    *(f32x4*)(op + bj * HALF) = acc[ai][bj][m][0] * rs * f0; *(f32x4*)(op + bj * HALF + 4) = acc[ai][bj][m][1] * rs * f1; } }
    }
};

template <int MODE> struct MoeOrder {
    const LAS int* tab; const int* LIST; unsigned* dcnt;
    __device__ __forceinline__ bool next(int i, Unit& u) const {
        const int n = __builtin_amdgcn_readfirstlane(tab[0]); if (i >= n) return false;
        const LAS int* p = tab + 4 + 8 * i;
        u.pm = __builtin_amdgcn_readfirstlane(p[0]); u.pn = __builtin_amdgcn_readfirstlane(p[1]); u.e = __builtin_amdgcn_readfirstlane(p[2]);
        u.tile = __builtin_amdgcn_readfirstlane(p[3]); u.cnt = __builtin_amdgcn_readfirstlane(p[4]); return true;
    }
    __device__ __forceinline__ unsigned row_off(const Unit& u, int r) const { int idx = u.tile * 256 + r; idx = idx < u.cnt ? idx : u.cnt - 1; const int pair = LIST[u.e * 16384 + idx]; return (unsigned)(pair >> 1) * 2048u; }
    __device__ __forceinline__ void a_ready(const Unit&) const {}
    struct Pre {}; __device__ __forceinline__ void pre(int, Pre&) const {}
    __device__ __forceinline__ void post(int, Pre&) const {}
    __device__ __forceinline__ bool half(const Unit& u) const { return MODE == 1 && (u.cnt - u.tile * 256) <= 128; }
    __device__ __forceinline__ void done(const Unit& u) const {
        if constexpr (MODE == 1) {
            asm volatile("s_waitcnt vmcnt(0)" ::: "memory");
            if (lane_id() == 0) __hip_atomic_fetch_add(dcnt + 64 * u.pm, 1u, __ATOMIC_RELAXED, __HIP_MEMORY_SCOPE_AGENT);
        }
    }
};
__device__ __forceinline__ void store16_sc1(void* p, u32x4 v) { asm volatile("global_store_dwordx4 %0, %1, off sc1\n\ts_nop 1" :: "v"(p), "v"(v) : "memory"); }
struct EpiMoe1 {
    static constexpr bool PERM = true;
    bf16* H; const int* LIST; const float* RSTD1;
    __device__ __forceinline__ void operator()(const f32x4 (&acc)[2][2][4][2], const Unit& u, int wr, int wc, int fr, int fq) const {
        const int col0 = (u.pn & 1) * 128 + wc * 32 + 8 * fq;
#pragma unroll
        for (int ai = 0; ai < 2; ++ai)
#pragma unroll
            for (int m = 0; m < 4; ++m) { const int r = ai * HALF + wr * 64 + m * 16 + fr; int idx = u.tile * 256 + r; idx = idx < u.cnt ? idx : u.cnt - 1;
                const int pair = LIST[u.e * 16384 + idx]; const float rs = RSTD1[pair >> 1]; f32x4 v[2];
#pragma unroll
                for (int n = 0; n < 2; ++n)
#pragma unroll
                    for (int i = 0; i < 4; ++i) { const float a1 = rs * acc[ai][0][m][n][i], a3 = rs * acc[ai][1][m][n][i]; v[n][i] = a1 * fsigm(a1) * a3; }
                store16_sc1(H + (size_t)(u.pm * 256 + r) * 256 + col0, pack8(v[0], v[1])); }
    }
};
struct EpiMoe2 {
    static constexpr bool PERM = true;
    bf16* Y; const int* LIST; const float* TOKG;
    __device__ __forceinline__ void operator()(const f32x4 (&acc)[2][2][4][2], const Unit& u, int wr, int wc, int fr, int fq) const {
        const int col0 = (u.pn & 3) * 256 + wc * 32 + 8 * fq;
        int pr[2][4]; float gt[2][4];
#pragma unroll
        for (int ai = 0; ai < 2; ++ai)
#pragma unroll
            for (int m = 0; m < 4; ++m) { int idx = u.tile * 256 + ai * HALF + wr * 64 + m * 16 + fr; idx = idx < u.cnt ? idx : u.cnt - 1; pr[ai][m] = LIST[u.e * 16384 + idx]; }
#pragma unroll
        for (int ai = 0; ai < 2; ++ai)
#pragma unroll
            for (int m = 0; m < 4; ++m) gt[ai][m] = TOKG[pr[ai][m]];
#pragma unroll
        for (int ai = 0; ai < 2; ++ai)
#pragma unroll
            for (int m = 0; m < 4; ++m) { const int idx = u.tile * 256 + ai * HALF + wr * 64 + m * 16 + fr;
                if (idx < u.cnt) { const float g = gt[ai][m]; bf16* yp = Y + (size_t)pr[ai][m] * D + col0;
#pragma unroll
                    for (int bj = 0; bj < 2; ++bj) *(u32x4*)(yp + bj * HALF) = pack8(acc[ai][bj][m][0] * g, acc[ai][bj][m][1] * g); } }
    }
};
}

constexpr int NWAVES = 8;
constexpr int RING_BYTES = 131072, LDSCTL_OFF = 139264, MISC_OFF = LDSCTL_OFF + 320, TAB_OFF = LDSCTL_OFF + 512, LDS_BYTES = 147456;
constexpr size_t WS_WLRU = 8 * MiB + 512 * 1024;
constexpr size_t WS_WSGU = 8 * MiB + 768 * 1024;
constexpr size_t WS_WR = 9 * MiB;
constexpr size_t WS_WUP = 9 * MiB + 512 * 1024;
constexpr size_t WS_WIN = 10 * MiB;
constexpr size_t WS_WOUT = 22 * MiB;
constexpr size_t WS_WG = 24 * MiB;
constexpr size_t WS_W13 = 26 * MiB;
constexpr size_t WS_W2 = 58 * MiB;
constexpr size_t WS_PB = 234 * MiB;
constexpr size_t WS_RSTD1 = 242 * MiB;
constexpr size_t WS_SPL8 = 242 * MiB + 512 * 1024;
constexpr size_t WS_XCH = 243 * MiB;
constexpr size_t WS_MEGA_END = 244 * MiB;
constexpr int CW_BAR = 4096;
constexpr int CW_DONE1 = 131072;
constexpr int CW_PANEL = 65536;

typedef GAS unsigned gu32;
#define RLX_AGENT __ATOMIC_RELAXED, __HIP_MEMORY_SCOPE_AGENT
#define LDS_WAIT() asm volatile("s_waitcnt lgkmcnt(0)" ::: "memory")
#define VM_WAIT() asm volatile("s_waitcnt vmcnt(0)" ::: "memory")

#define XB_TMO      128
#define XB_XCNT(j)  (256  + 64 * (j))
#define XB_XSUB(j)  (1280 + 64 * (j))
#define XB_XGEN(j)  (2304 + 64 * (j))
#define XB_TOP      3328
#define XB_TOPGEN   3392
#define XCD_BAR_WORDS 3456
#define XB_SPIN_CAP (1u << 18)
__device__ __forceinline__ unsigned xb_ld(unsigned* p)              { return __hip_atomic_load(p, __ATOMIC_RELAXED, __HIP_MEMORY_SCOPE_AGENT); }
__device__ __forceinline__ unsigned xb_add(unsigned* p, unsigned v) { return __hip_atomic_fetch_add(p, v, __ATOMIC_RELAXED, __HIP_MEMORY_SCOPE_AGENT); }
__device__ __forceinline__ unsigned xb_xcc_id() { return (unsigned)__builtin_amdgcn_s_getreg((3 << 11) | 20) & 0xFu; }
#define XB_SPIN(cond, bar) do { unsigned _sp = 0; while (cond) { __builtin_amdgcn_s_sleep(1); \
    if ((++_sp & 255u) == 0u) { if (xb_ld(&(bar)[XB_TMO])) break; if (_sp > XB_SPIN_CAP) { atomicAdd(&(bar)[XB_TMO], 1u); break; } } } } while (0)
struct XcdBarrier { unsigned* bar; unsigned x; volatile LAS unsigned* st; int wave; };
__device__ __forceinline__ XcdBarrier xcd_barrier_post(unsigned* bar, volatile LAS unsigned* st, int wave) {
    XcdBarrier b; b.bar = bar; b.x = xb_xcc_id(); b.st = st; b.wave = wave;
    if (wave == 0 && pg8::lane_id() == 0) (void)xb_add(&bar[XB_XCNT(b.x)], 1u);
    return b;
}
__device__ __forceinline__ void xcd_barrier_complete(unsigned* bar, unsigned x, unsigned& nloc, unsigned& nx) {
    const unsigned G = gridDim.x * gridDim.y * gridDim.z;
    unsigned sum, cnt, mine, sp = 0u;
    for (;;) {
        sum = 0u; cnt = 0u; mine = 0u;
#pragma unroll
        for (unsigned j = 0; j < 16; ++j) { const unsigned c = xb_ld(&bar[XB_XCNT(j)]); sum += c; cnt += (c > 0u) ? 1u : 0u; mine = (j == x) ? c : mine; }
        if (sum == G) break;
        __builtin_amdgcn_s_sleep(1);
        if ((++sp & 255u) == 0u) { if (xb_ld(&bar[XB_TMO])) break; if (sp > XB_SPIN_CAP) { atomicAdd(&bar[XB_TMO], 1u); break; } }
    }
    nloc = mine > 0u ? mine : 1u; nx = cnt > 0u ? cnt : 1u;
}
__device__ __forceinline__ void xcd_barrier(const XcdBarrier& b) {
    asm volatile("s_waitcnt vmcnt(0)" ::: "memory");
    __syncthreads();
    if (b.wave == 0 && pg8::lane_id() == 0) {
        unsigned* bar = b.bar;
        __builtin_amdgcn_s_waitcnt(0);
        unsigned nloc = b.st[0], nx = b.st[1];
        if (nloc == 0u) { xcd_barrier_complete(bar, b.x, nloc, nx); b.st[0] = nloc; b.st[1] = nx; }
        const unsigned old = xb_add(&bar[XB_XSUB(b.x)], 1u);
        const unsigned gen = old / nloc;
        if (old + 1u == (gen + 1u) * nloc) {
            __builtin_amdgcn_fence(__ATOMIC_RELEASE, "agent");
            asm volatile("s_waitcnt vmcnt(0)" ::: "memory");
            const unsigned og = xb_add(&bar[XB_TOP], 1u);
            const unsigned tg = og / nx;
            if (og + 1u == (tg + 1u) * nx) xb_add(&bar[XB_TOPGEN], 1u);
            else XB_SPIN(xb_ld(&bar[XB_TOPGEN]) == tg, bar);
            __builtin_amdgcn_fence(__ATOMIC_ACQUIRE, "agent");
            xb_add(&bar[XB_XGEN(b.x)], 1u);
            asm volatile("s_waitcnt vmcnt(0)" ::: "memory");
        } else {
            XB_SPIN(xb_ld(&bar[XB_XGEN(b.x)]) == gen, bar);
            __builtin_amdgcn_fence(__ATOMIC_ACQUIRE, "agent");
            asm volatile("s_waitcnt vmcnt(0)" ::: "memory");
        }
    }
    __syncthreads();
}

__device__ __forceinline__ unsigned pk2(float lo, float hi) { return (unsigned)f2bf(lo) | ((unsigned)f2bf(hi) << 16); }

struct TrItem { pg8::f32x4 v[8]; };
__device__ __forceinline__ void tr_load(TrItem& t, const float* __restrict__ W, int ldn, int k0, int n_src0, int lane) {
    const int kb = lane >> 3, n4 = lane & 7;
    const float* src = W + (size_t)(k0 + 8 * kb) * ldn + n_src0 + 4 * n4;
#pragma unroll
    for (int q = 0; q < 8; ++q) t.v[q] = *(const pg8::f32x4*)(src + (size_t)q * ldn);
}
__device__ __forceinline__ void tr_store(TrItem& t, int k0, bf16* __restrict__ WT, int Kd, int drow0, const float* __restrict__ gk, int lane) {
    const int kb = lane >> 3, n4 = lane & 7;
    if (gk) { const pg8::f32x4 g0 = *(const pg8::f32x4*)(gk + k0 + 8 * kb), g1 = *(const pg8::f32x4*)(gk + k0 + 8 * kb + 4);
#pragma unroll
        for (int q = 0; q < 8; ++q) t.v[q] = t.v[q] * (q < 4 ? g0[q & 3] : g1[q & 3]); }
#pragma unroll
    for (int i = 0; i < 4; ++i) { pg8::u32x4 o; o.x = pk2(t.v[0][i], t.v[1][i]); o.y = pk2(t.v[2][i], t.v[3][i]); o.z = pk2(t.v[4][i], t.v[5][i]); o.w = pk2(t.v[6][i], t.v[7][i]);
        *(pg8::u32x4*)(WT + (size_t)(drow0 + 4 * n4 + i) * Kd + k0 + 8 * kb) = o; }
}
__device__ __forceinline__ void p0_transpose_item(const float* __restrict__ W, int ldn, int k0, int n_src0, bf16* __restrict__ WT, int Kd, int drow0, const float* __restrict__ gk, LAS float*, int lane) {
    TrItem t; tr_load(t, W, ldn, k0, n_src0, lane); tr_store(t, k0, WT, Kd, drow0, gk, lane);
}
__device__ __forceinline__ int win_dest_row(int n) {
    const int grp = n >> 10, j = n & 1023;
    switch (grp) {
        case 0: return j;
        case 1: return 1024 + (j >> 7) * 256 + (j & 127);
        case 2: return 3072 + (j >> 7) * 256 + (j & 127);
        case 3: return 5120 + j;
        case 4: return 1024 + (j >> 7) * 256 + 128 + (j & 127);
        default: return 3072 + (j >> 7) * 256 + 128 + (j & 127);
    }
}


struct DefW { const float* const* in; unsigned char* ws; };
constexpr int DF_OUT = 16 * 32, DF_E13 = 32 * 2 * 128, DF_E2 = 32 * 128, DF_G = 16 * 32, DF_UP = 4 * 32, DF_N = DF_OUT + DF_E13 + DF_E2 + DF_G + DF_UP;
struct DefDesc { const float* W; const float* gk; bf16* WT; int ldn, k0, n0, Kd, drow; };
__device__ __forceinline__ DefDesc deferred_desc(const DefW& w, int it) {
    int r = it; DefDesc d;
    if (r < DF_OUT) { const int kb = r / 32, nb = r % 32; d = DefDesc{w.in[15], nullptr, (bf16*)(w.ws + WS_WOUT), 1024, kb * 64, nb * 32, 1024, nb * 32}; return d; } r -= DF_OUT;
    if (r < DF_E13) { const int e = r / 256, which = (r / 128) & 1, q = r % 128, kb = q / 8, nb = q % 8;
        const int f0 = nb * 32, drow = e * 512 + (f0 >> 7) * 256 + which * 128 + (f0 & 127);
        d = DefDesc{w.in[which ? 22 : 21] + (size_t)e * 1024 * 256, w.in[16], (bf16*)(w.ws + WS_W13), 256, kb * 64, f0, 1024, drow}; return d; } r -= DF_E13;
    if (r < DF_E2) { const int e = r / 128, q = r % 128, kb = q / 32, nb = q % 32;
        d = DefDesc{w.in[23] + (size_t)e * 256 * 1024, nullptr, (bf16*)(w.ws + WS_W2), 1024, kb * 64, nb * 32, 256, e * 1024 + nb * 32}; return d; } r -= DF_E2;
    if (r < DF_G) { const int kb = r / 32, nb = r % 32; d = DefDesc{w.in[25], w.in[24], (bf16*)(w.ws + WS_WG), 1024, kb * 64, nb * 32, 1024, nb * 32}; return d; } r -= DF_G;
    { const int kb = r / 32, nb = r % 32; d = DefDesc{w.in[26], nullptr, (bf16*)(w.ws + WS_WUP), 1024, kb * 64, nb * 32, 256, nb * 32}; return d; }
}
struct Gemm1Order : pg8::StaticOrder {
    DefW w; int wave;
    typedef TrItem Pre;
    __device__ __forceinline__ void pre(int ui, Pre& t) const {
        const int lane = pg8::lane_id(), it = (ui * G + c) * 8 + wave;
        if (it < DF_N) { const DefDesc d = deferred_desc(w, it); tr_load(t, d.W, d.ldn, d.k0, d.n0, lane); }
    }
    __device__ __forceinline__ void post(int ui, Pre& t) const {
        const int lane = pg8::lane_id(); int it = (ui * G + c) * 8 + wave;
        if (it < DF_N) { const DefDesc d = deferred_desc(w, it); tr_store(t, d.k0, d.WT, d.Kd, d.drow, d.gk, lane); }
        for (it += nwg * 8; it < DF_N; it += nwg * 8) { const DefDesc d = deferred_desc(w, it); TrItem t2; tr_load(t2, d.W, d.ldn, d.k0, d.n0, lane); tr_store(t2, d.k0, d.WT, d.Kd, d.drow, d.gk, lane); }
        { const int slot = (ui * G + c) * 8 + wave;
          if (slot < 8192) { const size_t i0 = (size_t)slot * 128 + lane; const pg8::f32x4* psrc = (const pg8::f32x4*)w.in[1]; unsigned long long* pdst = (unsigned long long*)(w.ws + WS_PB); const pg8::f32x4 v0 = psrc[i0], v1 = psrc[i0 + 64];
              pdst[i0] = (unsigned long long)pk2(v0.x, v0.y) | ((unsigned long long)pk2(v0.z, v0.w) << 32);
              pdst[i0 + 64] = (unsigned long long)pk2(v1.x, v1.y) | ((unsigned long long)pk2(v1.z, v1.w) << 32); } }
    }
};

constexpr int MY_VT = 0, MY_XA = 32768, MY_SP = 67584, MY_WS = 102400, MY_ST = 135168, MY_RS = 272;
__device__ __forceinline__ float bflo(unsigned u) { return __uint_as_float(u << 16); }
__device__ __forceinline__ float bfhi(unsigned u) { return __uint_as_float(u & 0xffff0000u); }
template <int N> __device__ __forceinline__ float row_shr(float ident, float v) {
    return __builtin_bit_cast(float, __builtin_amdgcn_update_dpp(__builtin_bit_cast(int, ident), __builtin_bit_cast(int, v), 0x110 + N, 0xf, 0xf, false)); }
#define MX_SCAN_STEP(N, A, U) { const float pa_ = row_shr<N>(1.f, A), pu_ = row_shr<N>(0.f, U); U = pu_ * A + U; A = pa_ * A; }
#define MX_SCAN16(A, U) { MX_SCAN_STEP(1, A, U) MX_SCAN_STEP(2, A, U) MX_SCAN_STEP(4, A, U) MX_SCAN_STEP(8, A, U) }
__device__ __forceinline__ void mixer_phase(LAS unsigned char* lds, const int vcu, const int G, const int tid, const int lane, const int wave,
                                            const bf16* __restrict__ Zl, const bf16* __restrict__ GA, const bf16* __restrict__ UB, const bf16* __restrict__ V, const float* __restrict__ VPART,
                                            unsigned long long* AGG, bf16* __restrict__ MG, const bf16* __restrict__ WLRU, const bf16* __restrict__ WSGU, const float* __restrict__ SPL8, const float* const* in) {
    using namespace pg8;
    constexpr int RS = MY_RS;
    constexpr float L2E = 1.4426950409f;
    const int fr = lane & 15, grp = lane >> 4, cp = tid & 63, tg = wave;
    const int pr = lane & 3, sch = lane >> 2, srow = 8 * sch + 2 * pr;
    LAS float* ST = (LAS float*)(lds + MY_ST);
    int gprev = -1;
    f32x2 cw0, cw1, cw2, cw3, ccb;
    u32x4 zqa, zqb, zqc, zqd, zqe, vv00, vv01, vv10, vv11;
#define MX_ZR(k) ((k) < 4 ? zqa[(k) & 3] : (k) < 8 ? zqb[(k) & 3] : (k) < 12 ? zqc[(k) & 3] : (k) < 16 ? zqd[(k) & 3] : zqe[(k) & 3])
#define MX_SETZR(k, v) do { if ((k) < 4) zqa[(k) & 3] = (v); else if ((k) < 8) zqb[(k) & 3] = (v); else if ((k) < 12) zqc[(k) & 3] = (v); else if ((k) < 16) zqd[(k) & 3] = (v); else zqe[(k) & 3] = (v); } while (0)
#define MX_PREFETCH(uu) do { const int ck_ = (uu) >> 3, g_ = (uu) & 7, t0_ = ck_ * 128, c0_ = g_ * 128; const bool first_ = (ck_ & 15) == 0; \
        const unsigned zo_ = ((unsigned)(t0_ + 16 * tg) * D + c0_ + 2 * cp) * 2u; \
        _Pragma("unroll") for (int k = 0; k < 19; ++k) { unsigned zv_ = 0u; if (!(k < 3 && first_ && tg == 0)) zv_ = *(const unsigned*)((const char*)Zl + (zo_ + (unsigned)((k - 3) * D * 2))); MX_SETZR(k, zv_); } \
        { const unsigned vo_ = ((unsigned)(t0_ + srow) * D + c0_ + 16 * wave) * 2u; vv00 = *(const u32x4*)((const char*)V + vo_); vv01 = *(const u32x4*)((const char*)V + (vo_ + D * 2)); vv10 = *(const u32x4*)((const char*)V + (vo_ + 16)); vv11 = *(const u32x4*)((const char*)V + (vo_ + D * 2 + 16)); } \
        } while (0)
    zqe = (u32x4){0u, 0u, 0u, 0u};
#define MX_STATS_LOAD(uu, q0, q1) do { const unsigned vpo_ = ((unsigned)(((uu) >> 3) * 128 + (tid >> 2)) * 32 + (tid & 3) * 8) * 4u; q0 = *(const f32x4*)((const char*)VPART + vpo_); q1 = *(const f32x4*)((const char*)VPART + (vpo_ + 16)); } while (0)
#define MX_STATS_WRITE(q0, q1) do { float s1 = (q0[0] + q0[2]) + (q1[0] + q1[2]), s2 = (q0[1] + q0[3]) + (q1[1] + q1[3]); \
        s1 += __shfl_xor(s1, 1); s1 += __shfl_xor(s1, 2); s2 += __shfl_xor(s2, 1); s2 += __shfl_xor(s2, 2); \
        if ((tid & 3) == 0) { const float mean = s1 * (1.f / 1024.f); float var = s2 * (1.f / 1024.f) - mean * mean; var = var < 0.f ? 0.f : var; ST[tid >> 2] = mean; ST[128 + (tid >> 2)] = rsqrtf(var + EPS); } } while (0)
    int u = vcu;
    if (u < 1024) { MX_PREFETCH(u); f32x4 q0, q1; MX_STATS_LOAD(u, q0, q1); MX_STATS_WRITE(q0, q1); }
    for (; u < 1024; u += G) {
        const int ck = u >> 3, g = u & 7, t0 = ck * 128, c0 = g * 128, j = ck & 15;
        const int cch = c0 + 16 * wave + 4 * grp;
        if (g != gprev) {
            gprev = g;
#pragma unroll
            for (int it = 0; it < 4; ++it) { const int idx = it * 512 + tid, row = idx >> 4, ch = idx & 15;
                *(LAS u32x4*)(lds + MY_WS + row * 256 + ((ch ^ (row & 15)) << 4)) = *(const u32x4*)(WSGU + ((size_t)(g * 128 + row)) * 128 + ch * 8); }
            const int cc = c0 + 2 * cp;
            cw0 = *(const f32x2*)(in[4] + cc); cw1 = *(const f32x2*)(in[4] + 1024 + cc); cw2 = *(const f32x2*)(in[4] + 2048 + cc); cw3 = *(const f32x2*)(in[4] + 3072 + cc); ccb = *(const f32x2*)(in[5] + cc);
        }
        const int hblk = 2 * g + (wave >> 2), jj0 = (16 * wave) & 63;
        const bf16x8 bw00 = *(const bf16x8*)(WLRU + ((size_t)((0 * 16 + hblk) * 64 + jj0 + fr)) * 64 + 0 * 32 + 8 * grp), bw01 = *(const bf16x8*)(WLRU + ((size_t)((0 * 16 + hblk) * 64 + jj0 + fr)) * 64 + 1 * 32 + 8 * grp);
        const bf16x8 bw10 = *(const bf16x8*)(WLRU + ((size_t)((1 * 16 + hblk) * 64 + jj0 + fr)) * 64 + 0 * 32 + 8 * grp), bw11 = *(const bf16x8*)(WLRU + ((size_t)((1 * 16 + hblk) * 64 + jj0 + fr)) * 64 + 1 * 32 + 8 * grp);
        const f32x4 nba = *(const f32x4*)(in[7] + cch) * (-L2E), nbi = *(const f32x4*)(in[9] + cch) * (-L2E), ksp = *(const f32x4*)(SPL8 + cch);
        {
#pragma unroll
            for (int i = 0; i < 16; ++i) {
                const unsigned z0 = MX_ZR(i), z1 = MX_ZR(i + 1), z2 = MX_ZR(i + 2), z3 = MX_ZR(i + 3);
                const float x0 = ccb.x + cw0.x * bflo(z0) + cw1.x * bflo(z1) + cw2.x * bflo(z2) + cw3.x * bflo(z3);
                const float x1 = ccb.y + cw0.y * bfhi(z0) + cw1.y * bfhi(z1) + cw2.y * bfhi(z2) + cw3.y * bfhi(z3);
                *(LAS unsigned*)(lds + MY_XA + (16 * tg + i) * RS + 4 * cp) = cvt_pk_bf16(x0, x1);
            }
        }
        __syncthreads();
        {
            const float mua = ST[srow], rsa = ST[128 + srow], mub = ST[srow + 1], rsb = ST[128 + srow + 1];
#pragma unroll
            for (int ci = 0; ci < 2; ++ci) { const int chunk = 2 * wave + ci, cbase = c0 + 8 * chunk;
                f32x4 a0, a1, b0, b1; unpack8(ci ? vv10 : vv00, a0, a1); unpack8(ci ? vv11 : vv01, b0, b1);
                const f32x4 g0 = *(const f32x4*)(in[11] + cbase), g1 = *(const f32x4*)(in[11] + cbase + 4), l0 = *(const f32x4*)(in[12] + cbase), l1 = *(const f32x4*)(in[12] + cbase + 4);
                a0 = (a0 - mua) * rsa * g0 + l0; a1 = (a1 - mua) * rsa * g1 + l1; b0 = (b0 - mub) * rsb * g0 + l0; b1 = (b1 - mub) * rsb * g1 + l1;
#pragma unroll
                for (int i = 0; i < 8; ++i) { const int cl = 8 * chunk + i; const float va = i < 4 ? a0[i & 3] : a1[i & 3], vb = i < 4 ? b0[i & 3] : b1[i & 3];
                    *(LAS unsigned*)(lds + MY_VT + cl * 256 + ((sch ^ (cl & 15)) << 4) + 4 * pr) = cvt_pk_bf16(va, vb); }
            }
        }
        f32x4 R[8], I[8];
#pragma unroll
        for (int mt = 0; mt < 8; ++mt) { R[mt] = (f32x4){0.f, 0.f, 0.f, 0.f}; I[mt] = (f32x4){0.f, 0.f, 0.f, 0.f};
#pragma unroll
            for (int ks = 0; ks < 2; ++ks) { const bf16x8 a = *(const LAS bf16x8*)(lds + MY_XA + (mt * 16 + fr) * RS + ((wave >> 2) * 64 + ks * 32 + 8 * grp) * 2);
                R[mt] = __builtin_amdgcn_mfma_f32_16x16x32_bf16(ks ? bw01 : bw00, a, R[mt], 0, 0, 0); I[mt] = __builtin_amdgcn_mfma_f32_16x16x32_bf16(ks ? bw11 : bw10, a, I[mt], 0, 0, 0); } }
#pragma unroll
        for (int mt = 0; mt < 8; ++mt) {
            const u32x2 xw = *(const LAS u32x2*)(lds + MY_XA + (mt * 16 + fr) * RS + (16 * wave + 4 * grp) * 2);
            const f32x4 xa4 = {bflo(xw.x), bfhi(xw.x), bflo(xw.y), bfhi(xw.y)};
            const f32x4 t1 = R[mt] * (-L2E) + nba, t2 = I[mt] * (-L2E) + nbi;
            f32x4 d1, d2, inv;
#pragma unroll
            for (int r = 0; r < 4; ++r) { d1[r] = 1.f + __builtin_amdgcn_exp2f(t1[r]); d2[r] = 1.f + __builtin_amdgcn_exp2f(t2[r]); }
            const f32x4 dd = d1 * d2;
#pragma unroll
            for (int r = 0; r < 4; ++r) inv[r] = __builtin_amdgcn_rcpf(dd[r]);
            const f32x4 rr = d2 * inv, ii = d1 * inv, la = rr * ksp, x2 = la + la;
            const f32x4 av = 1.f + la * (1.f + la * (0.5f + la * (0.16666667f + la * (0.041666667f + la * 0.0083333333f))));
            const f32x4 om = -x2 * (1.f + x2 * (0.5f + x2 * (0.16666667f + x2 * (0.041666667f + x2 * 0.0083333333f))));
            f32x4 uv;
#pragma unroll
            for (int r = 0; r < 4; ++r) uv[r] = __builtin_amdgcn_sqrtf(om[r]);
            uv = uv * ii * xa4;
#pragma unroll
            for (int r = 0; r < 4; ++r) { float A_ = av[r], U_ = uv[r]; MX_SCAN16(A_, U_); R[mt][r] = A_; I[mt][r] = U_; }
        }
        {
            f32x4 Pc = {1.f, 1.f, 1.f, 1.f}, Hc = {0.f, 0.f, 0.f, 0.f};
#pragma unroll
            for (int mt = 0; mt < 8; ++mt) { Hc = Hc * R[mt] + I[mt]; Pc = Pc * R[mt]; }
            if (fr == 15) {
#pragma unroll
                for (int r = 0; r < 4; ++r) __hip_atomic_store(AGG + (size_t)ck * 1024 + cch + r, ((unsigned long long)__float_as_uint(Hc[r]) << 32) | (unsigned long long)__float_as_uint(Pc[r]), __ATOMIC_RELAXED, __HIP_MEMORY_SCOPE_AGENT);
            }
        }
        __syncthreads();
        if (u + G < 1024) MX_PREFETCH(u + G);
        unsigned long long ag0 = 0x000000003f800000ull, ag1 = 0x000000003f800000ull, ag2 = 0x000000003f800000ull, ag3 = 0x000000003f800000ull;
        if (j > 0 && fr < j) { const unsigned long long* ap = AGG + (size_t)(ck - j + fr) * 1024 + cch;
            ag0 = __hip_atomic_load(ap, __ATOMIC_RELAXED, __HIP_MEMORY_SCOPE_AGENT); ag1 = __hip_atomic_load(ap + 1, __ATOMIC_RELAXED, __HIP_MEMORY_SCOPE_AGENT);
            ag2 = __hip_atomic_load(ap + 2, __ATOMIC_RELAXED, __HIP_MEMORY_SCOPE_AGENT); ag3 = __hip_atomic_load(ap + 3, __ATOMIC_RELAXED, __HIP_MEMORY_SCOPE_AGENT); }
        {
            bf16x8 q[4];
#pragma unroll
            for (int ks = 0; ks < 4; ++ks) q[ks] = *(const LAS bf16x8*)(lds + MY_VT + (16 * wave + fr) * 256 + (((ks * 4 + grp) ^ fr) << 4));
#pragma unroll
            for (int mt = 0; mt < 8; ++mt) { f32x4 Sx = {0.f, 0.f, 0.f, 0.f};
#pragma unroll
                for (int ks = 0; ks <= mt / 2; ++ks) { const bf16x8 p = *(const LAS bf16x8*)(lds + MY_WS + (mt * 16 + fr) * 256 + (((ks * 4 + grp) ^ fr) << 4));
                    Sx = __builtin_amdgcn_mfma_f32_16x16x32_bf16(q[ks], p, Sx, 0, 0, 0); }
                *(LAS u32x2*)(lds + MY_SP + (mt * 16 + fr) * RS + (16 * wave + 4 * grp) * 2) = (u32x2){cvt_pk_bf16_cv(Sx[0], Sx[1]), cvt_pk_bf16_cv(Sx[2], Sx[3])}; }
        }
        {
            f32x4 hc0 = {0.f, 0.f, 0.f, 0.f};
            if (j > 0) {
                f32x4 lp, lh; unsigned spin = 0;
                for (;;) {
                    lp[0] = __uint_as_float((unsigned)ag0); lh[0] = __uint_as_float((unsigned)(ag0 >> 32)); lp[1] = __uint_as_float((unsigned)ag1); lh[1] = __uint_as_float((unsigned)(ag1 >> 32));
                    lp[2] = __uint_as_float((unsigned)ag2); lh[2] = __uint_as_float((unsigned)(ag2 >> 32)); lp[3] = __uint_as_float((unsigned)ag3); lh[3] = __uint_as_float((unsigned)(ag3 >> 32));
                    const bool ok = (lp[0] != 0.f) && (lp[1] != 0.f) && (lp[2] != 0.f) && (lp[3] != 0.f);
                    if (__all(ok)) break;
                    if (++spin > (1u << 22)) break;
                    __builtin_amdgcn_s_sleep(1);
                    if (fr < j) { const unsigned long long* ap = AGG + (size_t)(ck - j + fr) * 1024 + cch;
                        ag0 = __hip_atomic_load(ap, __ATOMIC_RELAXED, __HIP_MEMORY_SCOPE_AGENT); ag1 = __hip_atomic_load(ap + 1, __ATOMIC_RELAXED, __HIP_MEMORY_SCOPE_AGENT);
                        ag2 = __hip_atomic_load(ap + 2, __ATOMIC_RELAXED, __HIP_MEMORY_SCOPE_AGENT); ag3 = __hip_atomic_load(ap + 3, __ATOMIC_RELAXED, __HIP_MEMORY_SCOPE_AGENT); } }
#pragma unroll
                for (int r = 0; r < 4; ++r) { float A_ = lp[r], U_ = lh[r]; MX_SCAN16(A_, U_); hc0[r] = __shfl(U_, (lane & 48) | 15); }
            }
            f32x4 s = hc0;
#pragma unroll
            for (int mt = 0; mt < 8; ++mt) { f32x4 hb;
#pragma unroll
                for (int r = 0; r < 4; ++r) hb[r] = __shfl(s[r], (lane & 48) | 15);
                s = R[mt] * s + I[mt];
                const f32x4 hv = I[mt] + R[mt] * hb;
                *(LAS u32x2*)(lds + MY_XA + (mt * 16 + fr) * RS + (16 * wave + 4 * grp) * 2) = (u32x2){cvt_pk_bf16(hv[0], hv[1]), cvt_pk_bf16(hv[2], hv[3])}; }
        }
        u32x4 ga[4], ub[4]; float bsr[4]; f32x4 nq0 = {0.f, 0.f, 0.f, 0.f}, nq1 = {0.f, 0.f, 0.f, 0.f};
        if (u + G < 1024) MX_STATS_LOAD(u + G, nq0, nq1);
#pragma unroll
        for (int it = 0; it < 4; ++it) { const int idx = it * 512 + tid, row = idx >> 4, ch = idx & 15; const unsigned o = ((unsigned)(t0 + row) * D + c0 + ch * 8) * 2u; ga[it] = *(const u32x4*)((const char*)GA + o); ub[it] = *(const u32x4*)((const char*)UB + o); bsr[it] = in[14][g * 128 + row]; }
        __syncthreads();
#pragma unroll
        for (int it = 0; it < 4; ++it) { const int idx = it * 512 + tid, row = idx >> 4, ch = idx & 15;
            f32x4 g0, g1, u0, u1, h0, h1, s0, s1; unpack8(ga[it], g0, g1); unpack8(ub[it], u0, u1);
            unpack8(*(const LAS u32x4*)(lds + MY_XA + row * RS + ch * 16), h0, h1); unpack8(*(const LAS u32x4*)(lds + MY_SP + row * RS + ch * 16), s0, s1);
            *(u32x4*)((char*)MG + ((unsigned)(t0 + row) * D + c0 + ch * 8) * 2u) = pack8(g0 * h0 + u0 * (s0 + bsr[it]), g1 * h1 + u1 * (s1 + bsr[it])); }
        if (u + G < 1024) MX_STATS_WRITE(nq0, nq1);
        __syncthreads();
    }
#undef MX_PREFETCH
#undef MX_STATS_LOAD
#undef MX_STATS_WRITE
#undef MX_ZR
#undef MX_SETZR
}

__device__ __forceinline__ void build_moe_units(LAS int* tab1, LAS int* tab2, LAS int* tab3, const int* CNT, int vcu, int G, int wave, LAS int* flags) {
    const int tid = wave * 64 + pg8::lane_id();
    int NT = 0, my_e = 0, my_tile = 0, my_cnt = 0, my_rt = 0;
    for (int e = 0; e < 32; ++e) { const int cnt = CNT[e]; const int ntl = (cnt + 255) >> 8;
        if (tid >= NT && tid < NT + ntl) { my_e = e; my_tile = tid - NT; my_cnt = cnt; my_rt = tid; }
        NT += ntl; }
    const bool have = tid < NT;
    const bool heavy = have && (my_cnt - my_tile * 256) > 128;
    flags[tid] = heavy ? 1 : 0;
    __syncthreads();
    int hb = 0, NH = 0;
    for (int i = 0; i < NT; ++i) { const int f = flags[i]; NH += f; hb += (i < tid) ? f : 0; }
    const int slot = heavy ? hb : NH + (tid - hb);
    const int U1 = 2 * NT, U2 = 4 * NT; int nlate = (U1 > G && U1 < 2 * G) ? U1 - G : 0; if (G - nlate < 64) nlate = 0;
    const int Ge = G - nlate, c2 = vcu - nlate, ssplit = nlate ? G / 2 : NT, Lsplit = 4 * ssplit;
    const int n1 = vcu < U1 ? (U1 - 1 - vcu) / G + 1 : 0;
    const int tot2 = (c2 >= 0 && c2 < U2) ? (U2 - 1 - c2) / Ge + 1 : 0;
    int n2 = (c2 >= 0 && c2 < Lsplit) ? (Lsplit - 1 - c2) / Ge + 1 : 0; n2 = n2 < tot2 ? n2 : tot2;
    const int n3 = tot2 - n2;
    if (tid == 0) { tab1[0] = n1 < 12 ? n1 : 12; tab2[0] = n2 < 12 ? n2 : 12; tab3[0] = n3 < 12 ? n3 : 12; }
    if (have) {
#pragma unroll
        for (int q = 0; q < 2; ++q) { const int L = 2 * slot + q; if (L % G == vcu && L / G < 12) { LAS int* p = tab1 + 4 + 8 * (L / G); p[0] = my_rt; p[1] = my_e * 2 + q; p[2] = my_e; p[3] = my_tile; p[4] = my_cnt; } }
        if (c2 >= 0) {
#pragma unroll
            for (int q = 0; q < 4; ++q) { const int L2 = 4 * slot + q; if (L2 % Ge == c2) { const int k = L2 / Ge; const bool early = slot < ssplit; const int idx = early ? k : k - n2;
                if (idx >= 0 && idx < 12) { LAS int* p = (early ? tab2 : tab3) + 4 + 8 * idx; p[0] = my_rt; p[1] = my_e * 4 + q; p[2] = my_e; p[3] = my_tile; p[4] = my_cnt; } } }
        }
    }
    __syncthreads();
}
__device__ __forceinline__ void moe_wait_tiles(const LAS int* tab, unsigned* dcnt, int wave) {
    if (wave == 0) {
        const int n = __builtin_amdgcn_readfirstlane(tab[0]);
        for (int i = 0; i < n; ++i) { const int rt = __builtin_amdgcn_readfirstlane(tab[4 + 8 * i]); unsigned sp = 0;
            while ((unsigned)__builtin_amdgcn_readfirstlane(__hip_atomic_load(dcnt + 64 * rt, __ATOMIC_RELAXED, __HIP_MEMORY_SCOPE_AGENT)) < 16u) { if (++sp > (1u << 22)) break; __builtin_amdgcn_s_sleep(2); } }
        __builtin_amdgcn_fence(__ATOMIC_ACQUIRE, "agent");
        asm volatile("s_waitcnt vmcnt(0)" ::: "memory");
    }
    __syncthreads();
}

struct Args { const float* in[28]; float* out; unsigned char* ws; int ph_lo, ph_hi, li, pad; };

__global__ void __launch_bounds__(NWAVES * 64, 2) mega_fwd(Args args) {
    extern __shared__ __attribute__((aligned(16))) unsigned char lds_raw[];
    LAS unsigned char* lds = (LAS unsigned char*)lds_raw;
    volatile LAS unsigned* MISC = (volatile LAS unsigned*)(lds + MISC_OFF);
    const int tid0 = threadIdx.x, wave = __builtin_amdgcn_readfirstlane(tid0 >> 6);
#define PHASE_IDS() int lane = pg8::lane_id(); asm volatile("" : "+v"(lane)); const int tid = wave * 64 + lane; (void)tid
    const int G = gridDim.x;
    const int vcu = (G % 8 == 0) ? ((int)blockIdx.x % 8) * (G / 8) + (int)blockIdx.x / 8 : (int)blockIdx.x;
    unsigned char* ws = args.ws;
    unsigned* ctl = (unsigned*)(ws + WS_CTL);
    for (int u = tid0; u < (LDS_BYTES - LDSCTL_OFF) / 4; u += NWAVES * 64) ((LAS unsigned*)(lds + LDSCTL_OFF))[u] = 0u;
    __syncthreads();
    XcdBarrier bar = xcd_barrier_post(ctl + CW_BAR + args.li * XCD_BAR_WORDS, MISC + 8, wave);
    const int lo = args.ph_lo, hi = args.ph_hi;
#define IN(k) (lo <= (k) && (k) < hi)
#define BOTH(k) (IN(k) && IN((k) + 1))
    const float* const* in = args.in;
    bf16 *XN = (bf16*)(ws + WS_A0), *MG = (bf16*)(ws + WS_A0), *X2b = (bf16*)(ws + WS_A0);
    bf16 *Zl = (bf16*)(ws + WS_A1), *X1b = (bf16*)(ws + WS_A1);
    bf16 *GA = (bf16*)(ws + WS_A2), *UB = (bf16*)(ws + WS_A3), *V = (bf16*)(ws + WS_A4);
    bf16 *X3 = (bf16*)(ws + WS_A1);
    bf16 *PU = (bf16*)(ws + WS_A2);
    bf16 *Pb = (bf16*)(ws + WS_PB);
    bf16 *WinT = (bf16*)(ws + WS_WIN), *WoutT = (bf16*)(ws + WS_WOUT), *WgT = (bf16*)(ws + WS_WG), *W13T = (bf16*)(ws + WS_W13), *W2T = (bf16*)(ws + WS_W2), *WupT = (bf16*)(ws + WS_WUP);
    float *VPART = (float*)(ws + WS_VPART), *SS1 = (float*)(ws + WS_SS1), *SS3 = (float*)(ws + WS_SS3), *RSTD2 = (float*)(ws + WS_RSTD2), *RSTD1 = (float*)(ws + WS_RSTD1), *TOKG = (float*)(ws + WS_TOKG);
    int *CNT = (int*)(ws + WS_CTL), *LIST = (int*)(ws + WS_LIST), *TOKE = (int*)(ws + WS_TOKE);
    bf16 *Hb = (bf16*)(ws + WS_A2), *Yb = (bf16*)(ws + WS_A3), *WrT = (bf16*)(ws + WS_WR), *WLRU = (bf16*)(ws + WS_WLRU), *WSGU = (bf16*)(ws + WS_WSGU);
    unsigned long long* AGGQ = (unsigned long long*)(ws + WS_AGG); float* SPL8 = (float*)(ws + WS_SPL8);

    if (IN(0)) {
        PHASE_IDS();
        LAS float* scr = (LAS float*)(lds + wave * 16384);
        const int gw = vcu * NWAVES + wave, NGW = G * NWAVES;
        for (int it = gw; it < 16 * 192; it += NGW) { const int kb = it / 192, nb = it % 192; p0_transpose_item(in[3], 6144, kb * 64, nb * 32, WinT, 1024, win_dest_row(nb * 32), nullptr, scr, lane); }
        for (int m = gw; m < T; m += 2 * NGW) {
            const int m2 = m + NGW < T ? m + NGW : m;
            const pg8::f32x4* xr = (const pg8::f32x4*)(in[0] + (size_t)m * D) + lane; const pg8::f32x4* xr2 = (const pg8::f32x4*)(in[0] + (size_t)m2 * D) + lane; const pg8::f32x4* gr = (const pg8::f32x4*)in[2] + lane;
            pg8::f32x4 v[4], w[4]; float s = 0.f, s2 = 0.f;
#pragma unroll
            for (int j = 0; j < 4; ++j) { v[j] = xr[64 * j]; w[j] = xr2[64 * j]; }
#pragma unroll
            for (int j = 0; j < 4; ++j) { s += (v[j].x * v[j].x + v[j].y * v[j].y) + (v[j].z * v[j].z + v[j].w * v[j].w); s2 += (w[j].x * w[j].x + w[j].y * w[j].y) + (w[j].z * w[j].z + w[j].w * w[j].w); }
            const float rstd = rsqrtf(wave_sum(s) * (1.f / D) + EPS), rstd2 = rsqrtf(wave_sum(s2) * (1.f / D) + EPS);
            unsigned long long* o8 = (unsigned long long*)(XN + (size_t)m * D) + lane; unsigned long long* o82 = (unsigned long long*)(XN + (size_t)m2 * D) + lane;
#pragma unroll
            for (int j = 0; j < 4; ++j) { const pg8::f32x4 gg = gr[64 * j];
                o8[64 * j] = (unsigned long long)pk2(v[j].x * rstd * gg.x, v[j].y * rstd * gg.y) | ((unsigned long long)pk2(v[j].z * rstd * gg.z, v[j].w * rstd * gg.w) << 32);
                o82[64 * j] = (unsigned long long)pk2(w[j].x * rstd2 * gg.x, w[j].y * rstd2 * gg.y) | ((unsigned long long)pk2(w[j].z * rstd2 * gg.z, w[j].w * rstd2 * gg.w) << 32); }
        }
        for (int i = vcu * 512 + tid; i < 2 * 16 * 64 * 64; i += G * 512) { const int gate = i >> 16, h = (i >> 12) & 15, j = (i >> 6) & 63, ii = i & 63;
            WLRU[i] = f2bf(in[gate ? 8 : 6][(h * 64 + ii) * 64 + j]); }
        for (int i = vcu * 512 + tid; i < 8 * 128 * 128; i += G * 512) { const int t = (i >> 7) & 127, s = i & 127; WSGU[i] = s <= t ? f2bf(in[13][i]) : (bf16)0; }
        for (int i = vcu * 512 + tid; i < 1024; i += G * 512) SPL8[i] = -8.f * log1pf(expf(-in[10][i]));
        for (int i = vcu * 512 + tid; i < 64 * 1024; i += G * 512) { const int n = i >> 10, k = i & 1023; float v = 0.f;
            if (n < 4) v = in[17][k * 4 + n] * in[16][k]; else if (n < 36) v = in[19][k * 32 + (n - 4)] * in[16][k];
            WrT[i] = f2bf(v); }
        if (BOTH(0)) xcd_barrier(bar);
    }
    if (IN(1)) {
        { pg8::Gemm g{XN, WinT, 1024}; Gemm1Order S; S.init(T, 6144, G, (int)blockIdx.x);
          S.wave = wave; S.w = DefW{args.in, ws};
          pg8::Epi1 E{Zl, GA, UB, V, VPART};
          pg8::gemm_phase<pg8::Epi1, Gemm1Order, true, true, false>(lds, g, S, E, wave); }
        if (BOTH(1)) xcd_barrier(bar);
    }

    if (IN(3)) {
        PHASE_IDS();
        mixer_phase(lds, vcu, G, tid, lane, wave, Zl, GA, UB, V, VPART, AGGQ, MG, WLRU, WSGU, SPL8, in);
        if (BOTH(3)) xcd_barrier(bar);
    }
    if (IN(4)) {
        pg8::Gemm g{MG, WoutT, 1024}; pg8::StaticOrder S; S.init(T, 1024, G, (int)blockIdx.x);
        pg8::Epi2 E{in[0], X1b, SS1};
        pg8::gemm_phase<pg8::Epi2, pg8::StaticOrder, true, true, false>(lds, g, S, E, wave);
        if (BOTH(4)) xcd_barrier(bar);
    }

    if (IN(5)) {
        PHASE_IDS();
        constexpr int RS = 528;
        LAS unsigned char* sA = lds; LAS unsigned char* sB = lds + 64 * RS; LAS float* sL = (LAS float*)(lds + 2 * 64 * RS);
        LAS int* sCnt = (LAS int*)(lds + 2 * 64 * RS + 64 * 65 * 4); LAS int* sBase = sCnt + 32;
        const int fr = lane & 15, grp = lane >> 4, mtile = wave & 3, np = wave >> 2;
        for (int tile = vcu; tile < T / 64; tile += G) {
            const int tok0 = tile * 64;
            if (tid < 32) sCnt[tid] = 0;
            pg8::f32x4 acc0 = {0.f, 0.f, 0.f, 0.f}, acc1 = {0.f, 0.f, 0.f, 0.f};
            for (int kc = 0; kc < 4; ++kc) {
#pragma unroll
                for (int it = 0; it < 4; ++it) { const int idx = it * 512 + tid, row = idx >> 5, ch = idx & 31;
                    *(LAS pg8::u32x4*)(sA + row * RS + ch * 16) = *(const pg8::u32x4*)(X1b + (size_t)(tok0 + row) * D + kc * 256 + ch * 8);
                    *(LAS pg8::u32x4*)(sB + row * RS + ch * 16) = *(const pg8::u32x4*)(WrT + (size_t)row * D + kc * 256 + ch * 8); }
                __syncthreads();
#pragma unroll
                for (int ks = 0; ks < 8; ++ks) {
                    const pg8::bf16x8 a = *(const LAS pg8::bf16x8*)(sA + (16 * mtile + fr) * RS + (ks * 32 + 8 * grp) * 2);
                    const pg8::bf16x8 b0 = *(const LAS pg8::bf16x8*)(sB + (32 * np + fr) * RS + (ks * 32 + 8 * grp) * 2);
                    const pg8::bf16x8 b1 = *(const LAS pg8::bf16x8*)(sB + (32 * np + 16 + fr) * RS + (ks * 32 + 8 * grp) * 2);
                    acc0 = __builtin_amdgcn_mfma_f32_16x16x32_bf16(a, b0, acc0, 0, 0, 0);
                    acc1 = __builtin_amdgcn_mfma_f32_16x16x32_bf16(a, b1, acc1, 0, 0, 0);
                }
                __syncthreads();
            }
#pragma unroll
            for (int r = 0; r < 4; ++r) { const int tk = 16 * mtile + 4 * grp + r; sL[tk * 65 + 32 * np + fr] = acc0[r]; sL[tk * 65 + 32 * np + 16 + fr] = acc1[r]; }
            __syncthreads();
            int e1 = 0, e2 = 0, r1 = 0, r2 = 0; float g1 = 0.f, g2 = 0.f;
            if (tid < 64) {
                const int t = tok0 + tid; float ss = 0.f;
#pragma unroll
                for (int q = 0; q < 16; ++q) ss += SS1[(size_t)t * 16 + q];
                const float rstd = rsqrtf(ss * (1.f / D) + EPS);
                RSTD1[t] = rstd;
                const LAS float* l = sL + tid * 65;
                float gl[4];
#pragma unroll
                for (int q = 0; q < 4; ++q) gl[q] = rstd * l[q] + in[18][q];
                float mx = gl[0]; int gi = 0;
#pragma unroll
                for (int q = 1; q < 4; ++q) if (gl[q] > mx) { mx = gl[q]; gi = q; }
                float den = 0.f;
#pragma unroll
                for (int q = 0; q < 4; ++q) den += expf(gl[q] - mx);
                const float gtop = 1.f / den;
                float m1 = -3.0e38f, m2 = -3.0e38f; int i1 = 0, i2 = 0;
                for (int j = 0; j < 8; ++j) { const float v = rstd * l[4 + gi * 8 + j] + in[20][gi * 8 + j];
                    if (v > m1) { m2 = m1; i2 = i1; m1 = v; i1 = j; } else if (v > m2) { m2 = v; i2 = j; } }
                const float p2 = expf(m2 - m1);
                g1 = gtop / (1.f + p2); g2 = gtop * p2 / (1.f + p2);
                e1 = gi * 8 + i1; e2 = gi * 8 + i2;
                r1 = __hip_atomic_fetch_add(&sCnt[e1], 1, __ATOMIC_RELAXED, __HIP_MEMORY_SCOPE_WORKGROUP); r2 = __hip_atomic_fetch_add(&sCnt[e2], 1, __ATOMIC_RELAXED, __HIP_MEMORY_SCOPE_WORKGROUP);
                TOKE[t * 2] = e1; TOKE[t * 2 + 1] = e2; TOKG[t * 2] = g1; TOKG[t * 2 + 1] = g2;
            }
            __syncthreads();
            if (tid < 32) { const int c = sCnt[tid]; sBase[tid] = c ? atomicAdd(&CNT[tid], c) : 0; }
            __syncthreads();
            if (tid < 64) { const int t = tok0 + tid; LIST[e1 * 16384 + sBase[e1] + r1] = t * 2; LIST[e2 * 16384 + sBase[e2] + r2] = t * 2 + 1; }
            __syncthreads();
        }
        if (BOTH(5)) xcd_barrier(bar);
    }
    if (IN(6)) {
        LAS int* tab1 = (LAS int*)(lds + TAB_OFF); LAS int* tab2 = (LAS int*)(lds + TAB_OFF + 512); LAS int* tab3 = (LAS int*)(lds + TAB_OFF + 1024);
        build_moe_units(tab1, tab2, tab3, CNT, vcu, G, wave, (LAS int*)lds);
        unsigned* dcnt = ctl + CW_DONE1;
        { pg8::Gemm g{X1b, W13T, 1024}; pg8::MoeOrder<1> S{tab1, LIST, dcnt};
          pg8::EpiMoe1 E{Hb, LIST, RSTD1};
          pg8::gemm_phase<pg8::EpiMoe1, pg8::MoeOrder<1>, true, true, true>(lds, g, S, E, wave); }
        pg8::Gemm g2{Hb, W2T, 256}; pg8::EpiMoe2 E2{Yb, LIST, TOKG};
        moe_wait_tiles(tab2, dcnt, wave);
        { pg8::MoeOrder<0> S{tab2, LIST, dcnt}; pg8::gemm_phase<pg8::EpiMoe2, pg8::MoeOrder<0>, true, true, false>(lds, g2, S, E2, wave); }
        moe_wait_tiles(tab3, dcnt, wave);
        { pg8::MoeOrder<0> S{tab3, LIST, dcnt}; pg8::gemm_phase<pg8::EpiMoe2, pg8::MoeOrder<0>, true, true, false>(lds, g2, S, E2, wave); }
        if (BOTH(6)) xcd_barrier(bar);
    }
    if (IN(8)) {
        PHASE_IDS();
        const int gw = vcu * NWAVES + wave, NGW = G * NWAVES;
        for (int row = gw; row < T; row += NGW) { float ss = 0.f;
#pragma unroll
            for (int hh = 0; hh < 2; ++hh) { const size_t o = (size_t)row * D + hh * 512 + lane * 8;
                pg8::f32x4 a0, a1, b0, b1, c0, c1; pg8::unpack8(*(const pg8::u32x4*)(X1b + o), a0, a1);
                pg8::unpack8(*(const pg8::u32x4*)(Yb + (size_t)row * 2 * D + hh * 512 + lane * 8), b0, b1); pg8::unpack8(*(const pg8::u32x4*)(Yb + ((size_t)row * 2 + 1) * D + hh * 512 + lane * 8), c0, c1);
                a0 = a0 + b0 + c0; a1 = a1 + b1 + c1;
                ss += (a0[0] * a0[0] + a0[1] * a0[1]) + (a0[2] * a0[2] + a0[3] * a0[3]) + (a1[0] * a1[0] + a1[1] * a1[1]) + (a1[2] * a1[2] + a1[3] * a1[3]);
                *(pg8::u32x4*)(X2b + o) = pg8::pack8(a0, a1); }
            ss = wave_sum(ss);
            if (lane == 0) RSTD2[row] = rsqrtf(ss * (1.f / D) + EPS); }
        if (BOTH(8)) xcd_barrier(bar);
    }
    const bool fuse_final = (G == 256);
    if (IN(9)) {
        { pg8::Gemm g{Pb, WupT, 256}; pg8::StaticOrder S; S.init(T, 1024, G, (int)blockIdx.x);
          pg8::EpiPlain E{PU};
          pg8::gemm_phase<pg8::EpiPlain, pg8::StaticOrder, true, true, false>(lds, g, S, E, wave); }
        pg8::Gemm g{X2b, WgT, 1024}; pg8::StaticOrder S; S.init(T, 1024, G, (int)blockIdx.x);
        if (fuse_final) {
            pg8::EpiPleFinal E{X2b, PU, RSTD2, in[27], args.out, (float*)(ws + WS_XCH), ctl + CW_PANEL, (LAS float*)(lds + RING_BYTES), wave};
            pg8::gemm_phase<pg8::EpiPleFinal, pg8::StaticOrder, true, true, false>(lds, g, S, E, wave);
        } else {
            pg8::EpiPle E{X2b, PU, RSTD2, X3, SS3};
            pg8::gemm_phase<pg8::EpiPle, pg8::StaticOrder, true, true, false>(lds, g, S, E, wave);
            if (BOTH(9)) xcd_barrier(bar);
        }
    }

    if (IN(10) && !fuse_final) {
        PHASE_IDS();
        const int gw = vcu * NWAVES + wave, NGW = G * NWAVES;
        for (int row = gw; row < T; row += NGW) { float ss = 0.f;
            if (lane < 16) ss = SS3[(size_t)row * 16 + lane];
            ss = wave_sum(ss);
            const float rstd = rsqrtf(ss * (1.f / D) + EPS);
#pragma unroll
            for (int hh = 0; hh < 2; ++hh) { const size_t o = (size_t)row * D + hh * 512 + lane * 8; pg8::f32x4 a0, a1; pg8::unpack8(*(const pg8::u32x4*)(X3 + o), a0, a1);
                const pg8::f32x4 f0 = *(const pg8::f32x4*)(in[27] + hh * 512 + lane * 8), f1 = *(const pg8::f32x4*)(in[27] + hh * 512 + lane * 8 + 4);
                *(pg8::f32x4*)(args.out + o) = a0 * rstd * f0; *(pg8::f32x4*)(args.out + o + 4) = a1 * rstd * f1; } }
    }
#undef IN
#undef BOTH
#undef PHASE_IDS
}

static int mega_grid() {
    static int grid = 0;
    if (grid == 0) {
        int dev = 0, cus = 0;
        if (hipGetDevice(&dev) != hipSuccess || hipDeviceGetAttribute(&cus, hipDeviceAttributeMultiprocessorCount, dev) != hipSuccess) { fprintf(stderr, "mega: device query failed\n"); grid = -1; return grid; }
        if (hipFuncSetAttribute((const void*)mega_fwd, hipFuncAttributeMaxDynamicSharedMemorySize, LDS_BYTES) != hipSuccess) { fprintf(stderr, "mega: hipFuncSetAttribute failed\n"); grid = -1; return grid; }
        (void)hipGetLastError();
        grid = cus;
    }
    return grid;
}
static void launch_mega(void* const* d_in, void* d_out, void* d_ws, int lo, int hi, int li, hipStream_t stream) {
    const int grid = mega_grid(); if (grid <= 0) return;
    Args a{};
    for (int i = 0; i < 28; ++i) a.in[i] = (const float*)d_in[i];
    a.out = (float*)d_out; a.ws = (unsigned char*)d_ws; a.ph_lo = lo; a.ph_hi = hi; a.li = li; a.pad = 0;
    hipLaunchKernelGGL(mega_fwd, dim3(grid), dim3(NWAVES * 64), LDS_BYTES, stream, a);
}

extern "C" void kernel_launch(void* const* d_in, const int* in_sizes, int n_in, void* d_out, int out_size, void* d_ws, size_t ws_size, hipStream_t stream) {
    if (n_in != 28 || in_sizes[0] != T * D || out_size != T * D || ws_size < WS_MEGA_END) { fprintf(stderr, "kernel_launch: unexpected shapes (n_in %d, ws %zu)\n", n_in, ws_size); return; }
    (void)hipMemsetAsync(d_ws, 0, 2 * MiB, stream);
    launch_mega(d_in, d_out, d_ws, 0, 11, 0, stream);
}
```

```cpp
#include <hip/hip_runtime.h>
#include <stdint.h>
#include <cstdio>

typedef unsigned short bf16;
constexpr int T = 16384, D = 1024, SEQ = 2048;
constexpr float EPS = 1e-6f;
constexpr size_t MiB = 1u << 20;
constexpr size_t WS_CTL = 0;
constexpr size_t WS_VPART = 2 * MiB;
constexpr size_t WS_SS1 = 4 * MiB;
constexpr size_t WS_SS3 = 5 * MiB;
constexpr size_t WS_AGG = 1 * MiB;
constexpr size_t WS_LIST = 6 * MiB;
constexpr size_t WS_TOKE = 8 * MiB;
constexpr size_t WS_TOKG = 8 * MiB + 128 * 1024;
constexpr size_t WS_RSTD2 = 8 * MiB + 256 * 1024;
constexpr size_t WS_A0 = 74 * MiB;
constexpr size_t WS_A1 = 106 * MiB;
constexpr size_t WS_A2 = 138 * MiB;
constexpr size_t WS_A3 = 170 * MiB;
constexpr size_t WS_A4 = 202 * MiB;
constexpr size_t WS_END = 234 * MiB;

__device__ __forceinline__ float bf2f(bf16 b) { return __uint_as_float(((unsigned)b) << 16); }
__device__ __forceinline__ bf16 f2bf(float f) { unsigned u = __float_as_uint(f); u += 0x7fffu + ((u >> 16) & 1u); return (bf16)(u >> 16); }
__device__ __forceinline__ float sigm(float x) { return 1.f / (1.f + expf(-x)); }
__device__ __forceinline__ float gelu_t(float x) { const float u = 0.7978845608028654f * (x + 0.044715f * x * x * x); return 0.5f * x * (1.f + tanhf(u)); }
__device__ __forceinline__ float wave_sum(float v) {
#pragma unroll
    for (int o = 1; o < 64; o <<= 1) v += __shfl_xor(v, o);
    return v;
}

#define LAS __attribute__((address_space(3)))
#define GAS __attribute__((address_space(1)))
namespace pg8 {
typedef short bf16x8 __attribute__((ext_vector_type(8)));
typedef float f32x4 __attribute__((ext_vector_type(4)));
typedef float f32x2 __attribute__((ext_vector_type(2)));
typedef unsigned u32x4 __attribute__((ext_vector_type(4)));
typedef unsigned u32x2 __attribute__((ext_vector_type(2)));
constexpr int BM = 256, BK = 64, HALF = 128, HTB = HALF * BK * 2, STAGE_BYTES = 8 * HTB, NXCD = 8, WGM = 8;

__host__ __device__ __forceinline__ int lds_byte(int r, int c) { const int st = (r >> 4) * 2 + (c >> 5), rr = r & 15, cc = c & 31, ob = rr * 64 + cc * 2; return st * 1024 + (ob ^ (((ob >> 9) & 1) << 5)); }
__host__ __device__ __forceinline__ void stage_rc(int b, int& R, int& C) { const int st = b / 1024, sb = b % 1024, swz = sb ^ (((sb >> 9) & 1) << 5); R = (st >> 1) * 16 + swz / 64; C = (st & 1) * 32 + (swz % 64) / 2; }
__host__ __device__ __forceinline__ int perm32(int rho) { const int n = rho >> 4, i = rho & 15; return 8 * (i >> 2) + 4 * n + (i & 3); }

__device__ __forceinline__ int lane_id() { int l; asm volatile("v_mbcnt_lo_u32_b32 %0, -1, 0\n\tv_mbcnt_hi_u32_b32 %0, -1, %0" : "=v"(l)); return l; }
struct Unit { int pm, pn, e, tile, cnt; };
struct Gemm { const bf16* A; const bf16* Bt; int K; };

struct StaticOrder {
    int nM, nN, nwg, G, c;
    __device__ void init(int M, int N, int G_, int c_) { nM = M / BM; nN = N / BM; nwg = nM * nN; G = G_; c = c_; }
    __device__ bool next(int i, Unit& u) const {
        const long L = (long)i * G + c; if (L >= nwg) return false;
        int wgid = (int)L; { const int q = nwg / NXCD, r = nwg % NXCD, xcd = wgid % NXCD, off = wgid / NXCD; wgid = (xcd < r ? xcd * (q + 1) : r * (q + 1) + (xcd - r) * q) + off; }
        const int nig = WGM * nN, gid = wgid / nig, fm = gid * WGM, gsz = (nM - fm) < WGM ? (nM - fm) : WGM;
        u.pm = fm + ((wgid % nig) % gsz); u.pn = (wgid % nig) / gsz; u.e = 0; u.tile = 0; u.cnt = 0; return true;
    }
    __device__ __forceinline__ unsigned row_off(const Unit&, int) const { return 0u; }
    __device__ __forceinline__ void a_ready(const Unit&) const {}
    __device__ __forceinline__ void done(const Unit&) const {}
    struct Pre {}; __device__ __forceinline__ void pre(int, Pre&) const {}
    __device__ __forceinline__ void post(int, Pre&) const {}
    __device__ __forceinline__ bool half(const Unit&) const { return false; }
};

__device__ __forceinline__ unsigned cvt_pk_bf16(float lo, float hi) { unsigned r; asm volatile("v_cvt_pk_bf16_f32 %0, %1, %2" : "=v"(r) : "v"(lo), "v"(hi)); return r; }
typedef __bf16 bf16x2_t __attribute__((ext_vector_type(2)));
__device__ __forceinline__ unsigned cvt_pk_bf16_cv(float lo, float hi) { const f32x2 v = {lo, hi}; const bf16x2_t b = __builtin_convertvector(v, bf16x2_t); return __builtin_bit_cast(unsigned, b); }
__device__ __forceinline__ float fsigm(float x) { return __builtin_amdgcn_rcpf(1.0f + __builtin_amdgcn_exp2f(-1.4426950409f * x)); }
__device__ __forceinline__ float fgelu(float x) { const float u = x + 0.044715f * x * x * x; return x * __builtin_amdgcn_rcpf(1.0f + __builtin_amdgcn_exp2f(-2.3022082f * u)); }

template <class Epi, class Sched, bool ALIGN_EPI, bool SP2, bool GATHER>
__device__ __forceinline__ void gemm_phase(LAS unsigned char* lds, const Gemm g, const Sched& S, const Epi& E, const int wave_) {
    int lane = lane_id(); asm volatile("" : "+v"(lane));
    const int wid = wave_, tid = wid * 64 + lane, wr = wid >> 2, wc = wid & 3, fr = lane & 15, fq = lane >> 4;
    const int K = g.K, nt = K / BK;
    int sR[2], sC[2];
    unsigned voffB[2], vA0[2], vA1[2], nvA0[2], nvA1[2];
#pragma unroll
    for (int i = 0; i < 2; ++i) { stage_rc(tid * 16 + i * 8192, sR[i], sC[i]); const int Rb = Epi::PERM ? ((sR[i] & ~31) + perm32(sR[i] & 31)) : sR[i];
        voffB[i] = (unsigned)(Rb * K + sC[i]) * 2u; vA0[i] = (unsigned)(sR[i] * K + sC[i]) * 2u; vA1[i] = vA0[i]; nvA0[i] = vA0[i]; nvA1[i] = vA0[i]; }
    const size_t kstep = (size_t)(BK * 2);
    const size_t hstep = (size_t)HALF * K * 2;
    const size_t tstep = 2 * hstep;
    const size_t ahs = GATHER ? 0 : hstep;
    const unsigned ldsw = (unsigned)wid * 1024u;
    const int aoff = lds_byte(wr * 64 + fr, fq * 8), boff = lds_byte(wc * 32 + fr, fq * 8);
#define PG8_SA(b, h) (((b) * 2 + (h)) * HTB)
#define PG8_SB(b, h) ((4 + (b) * 2 + (h)) * HTB)
#define PG8_STAGE(bufoff, gbase, voff) do { _Pragma("unroll") for (int _i = 0; _i < 2; ++_i) \
        __builtin_amdgcn_global_load_lds((const unsigned*)((const char*)(gbase) + (voff)[_i]), (LAS unsigned*)(lds + (bufoff) + ldsw + _i * 8192), 16, 0, 0); } while (0)
#define PG8_LDA(dst, b, h) do { _Pragma("unroll") for (int m = 0; m < 4; ++m) _Pragma("unroll") for (int k = 0; k < 2; ++k) dst[m][k] = *(const LAS bf16x8*)(lds + PG8_SA(b, h) + aoff + m * 2048 + k * 1024); } while (0)
#define PG8_LDB(dst, b, h) do { _Pragma("unroll") for (int n = 0; n < 2; ++n) _Pragma("unroll") for (int k = 0; k < 2; ++k) dst[n][k] = *(const LAS bf16x8*)(lds + PG8_SB(b, h) + boff + n * 2048 + k * 1024); } while (0)
#define PG8_MMA(ai, bj, At, Bt) do { __builtin_amdgcn_s_setprio(1); _Pragma("unroll") for (int m = 0; m < 4; ++m) _Pragma("unroll") for (int n = 0; n < 2; ++n) _Pragma("unroll") for (int k = 0; k < 2; ++k) \
        acc[ai][bj][m][n] = __builtin_amdgcn_mfma_f32_16x16x32_bf16(Bt[n][k], At[m][k], acc[ai][bj][m][n], 0, 0, 0); __builtin_amdgcn_s_setprio(0); } while (0)
#define PG8_WAIT_V(n) asm volatile("s_waitcnt vmcnt(" #n ")" ::: "memory")
#define PG8_WAIT_L(n) asm volatile("s_waitcnt lgkmcnt(" #n ")" ::: "memory")
#define PG8_BAR __builtin_amdgcn_s_barrier()
#define PG8_SCHED __builtin_amdgcn_sched_barrier(0)
    Unit cur, nxt; int ui = 0;
    if (!S.next(0, cur)) return;
    f32x4 acc[2][2][4][2];
#pragma unroll
    for (int a = 0; a < 2; ++a)
#pragma unroll
        for (int b = 0; b < 2; ++b)
#pragma unroll
            for (int m = 0; m < 4; ++m)
#pragma unroll
                for (int n = 0; n < 2; ++n) acc[a][b][m][n] = (f32x4){0.f, 0.f, 0.f, 0.f};
    bf16x8 At[4][2], B0[2][2], B1[2][2];
    const char* cA = GATHER ? (const char*)g.A : (const char*)g.A + (size_t)cur.pm * tstep; const char* cB = (const char*)g.Bt + (size_t)cur.pn * tstep;
    if constexpr (GATHER) {
#pragma unroll
        for (int i = 0; i < 2; ++i) { vA0[i] = S.row_off(cur, sR[i]) + (unsigned)sC[i] * 2u; vA1[i] = S.row_off(cur, HALF + sR[i]) + (unsigned)sC[i] * 2u; nvA0[i] = vA0[i]; nvA1[i] = vA1[i]; }
    }
    S.a_ready(cur);
    if constexpr (SP2) {
        PG8_STAGE(PG8_SB(0, 0), cB, voffB); PG8_STAGE(PG8_SB(0, 1), cB + hstep, voffB); PG8_STAGE(PG8_SA(0, 0), cA, vA0); PG8_STAGE(PG8_SA(0, 1), cA + ahs, vA1);
        if (wr == 1) PG8_BAR;
        PG8_WAIT_V(2); PG8_BAR;
        PG8_STAGE(PG8_SB(1, 0), cB + kstep, voffB); PG8_STAGE(PG8_SA(1, 0), cA + kstep, vA0); PG8_STAGE(PG8_SB(1, 1), cB + hstep + kstep, voffB);
        PG8_WAIT_V(6); PG8_BAR;
    } else {
        PG8_STAGE(PG8_SB(0, 0), cB, voffB); PG8_STAGE(PG8_SA(0, 0), cA, vA0); PG8_STAGE(PG8_SB(0, 1), cB + hstep, voffB); PG8_STAGE(PG8_SA(0, 1), cA + ahs, vA1);
        if (wr == 1) PG8_BAR;
        PG8_WAIT_V(4); PG8_BAR;
        PG8_STAGE(PG8_SB(1, 0), cB + kstep, voffB); PG8_STAGE(PG8_SA(1, 0), cA + kstep, vA0); PG8_STAGE(PG8_SB(1, 1), cB + hstep + kstep, voffB);
        PG8_WAIT_V(6); PG8_BAR;
    }
    for (;;) {
        const bool has_next = S.next(ui + 1, nxt);
        const char* nA = has_next ? (GATHER ? (const char*)g.A : (const char*)g.A + (size_t)nxt.pm * tstep) : cA; const char* nB = has_next ? (const char*)g.Bt + (size_t)nxt.pn * tstep : cB;
        const bool hf = S.half(cur);
        for (int t = 0; t < nt; t += 2) {
            const bool last = (t == nt - 2);
            const char* a1 = cA + (size_t)(t + 1) * kstep;
            const char* a2 = last ? nA : cA + (size_t)(t + 2) * kstep; const char* b2 = last ? nB : cB + (size_t)(t + 2) * kstep;
            const char* a3 = a2 + kstep; const char* b3 = b2 + kstep;
            if (last && has_next) S.a_ready(nxt);
            unsigned w0[2], w1[2];
            if constexpr (GATHER) {
                if (last && has_next) {
#pragma unroll
                    for (int i = 0; i < 2; ++i) { nvA0[i] = S.row_off(nxt, sR[i]) + (unsigned)sC[i] * 2u; nvA1[i] = S.row_off(nxt, HALF + sR[i]) + (unsigned)sC[i] * 2u; }
                }
#pragma unroll
                for (int i = 0; i < 2; ++i) { w0[i] = last ? nvA0[i] : vA0[i]; w1[i] = last ? nvA1[i] : vA1[i]; }
            } else {
#pragma unroll
                for (int i = 0; i < 2; ++i) { w0[i] = vA0[i]; w1[i] = vA0[i]; }
            }
            if constexpr (SP2) {
            PG8_LDB(B0, 0, 0); PG8_LDB(B1, 0, 1); PG8_SCHED; PG8_LDA(At, 0, 0); PG8_STAGE(PG8_SA(1, 1), a1 + ahs, vA1);
            PG8_WAIT_V(8); PG8_WAIT_L(0); PG8_BAR; PG8_MMA(0, 0, At, B0); PG8_MMA(0, 1, At, B1); PG8_BAR; PG8_SCHED;
            if (!hf) PG8_LDA(At, 0, 1); PG8_STAGE(PG8_SB(0, 0), b2, voffB); PG8_STAGE(PG8_SB(0, 1), b2 + hstep, voffB); PG8_STAGE(PG8_SA(0, 0), a2, w0);
            PG8_WAIT_V(8); PG8_WAIT_L(0); PG8_BAR; if (!hf) { PG8_MMA(1, 0, At, B0); PG8_MMA(1, 1, At, B1); } PG8_BAR; PG8_SCHED;
            PG8_LDB(B0, 1, 0); PG8_LDB(B1, 1, 1); PG8_SCHED; PG8_LDA(At, 1, 0); PG8_STAGE(PG8_SA(0, 1), a2 + ahs, w1);
            PG8_WAIT_V(8); PG8_WAIT_L(0); PG8_BAR; PG8_MMA(0, 0, At, B0); PG8_MMA(0, 1, At, B1); PG8_BAR; PG8_SCHED;
            if (!hf) PG8_LDA(At, 1, 1); PG8_STAGE(PG8_SB(1, 0), b3, voffB); PG8_STAGE(PG8_SB(1, 1), b3 + hstep, voffB); PG8_STAGE(PG8_SA(1, 0), a3, w0);
            PG8_WAIT_V(8); PG8_WAIT_L(0); PG8_BAR; if (!hf) { PG8_MMA(1, 0, At, B0); PG8_MMA(1, 1, At, B1); } PG8_BAR; PG8_SCHED;
            } else {
            PG8_LDB(B0, 0, 0); PG8_SCHED; PG8_LDA(At, 0, 0); PG8_STAGE(PG8_SA(1, 1), a1 + ahs, vA1);
            PG8_WAIT_L(8); PG8_BAR; PG8_WAIT_L(0); PG8_MMA(0, 0, At, B0); PG8_BAR; PG8_SCHED;
            PG8_LDB(B1, 0, 1); PG8_STAGE(PG8_SB(0, 0), b2, voffB);
            PG8_BAR; PG8_WAIT_L(0); PG8_MMA(0, 1, At, B1); PG8_BAR;
            PG8_LDA(At, 0, 1); PG8_STAGE(PG8_SA(0, 0), a2, w0);
            PG8_BAR; PG8_WAIT_L(0); PG8_MMA(1, 0, At, B0); PG8_BAR; PG8_SCHED;
            PG8_STAGE(PG8_SB(0, 1), b2 + hstep, voffB);
            PG8_WAIT_V(6); PG8_BAR; PG8_MMA(1, 1, At, B1); PG8_BAR;
            PG8_LDB(B0, 1, 0); PG8_SCHED; PG8_LDA(At, 1, 0); PG8_STAGE(PG8_SA(0, 1), a2 + ahs, w1);
            PG8_WAIT_L(8); PG8_BAR; PG8_WAIT_L(0); PG8_MMA(0, 0, At, B0); PG8_BAR; PG8_SCHED;
            PG8_LDB(B1, 1, 1); PG8_STAGE(PG8_SB(1, 0), b3, voffB);
            PG8_BAR; PG8_WAIT_L(0); PG8_MMA(0, 1, At, B1); PG8_BAR;
            PG8_LDA(At, 1, 1); PG8_STAGE(PG8_SA(1, 0), a3, w0);
            PG8_BAR; PG8_WAIT_L(0); PG8_MMA(1, 0, At, B0); PG8_BAR; PG8_SCHED;
            PG8_STAGE(PG8_SB(1, 1), b3 + hstep, voffB);
            PG8_WAIT_V(6); PG8_BAR; PG8_MMA(1, 1, At, B1); PG8_BAR;
            }
        }
        typename Sched::Pre pre_; S.pre(ui, pre_);
        if constexpr (ALIGN_EPI) { if (wr == 0) PG8_BAR; }
        E(acc, cur, wr, wc, fr, fq); S.done(cur); S.post(ui, pre_);
        if (!has_next) break;
#pragma unroll
        for (int a = 0; a < 2; ++a)
#pragma unroll
            for (int b = 0; b < 2; ++b)
#pragma unroll
                for (int m = 0; m < 4; ++m)
#pragma unroll
                    for (int n = 0; n < 2; ++n) acc[a][b][m][n] = (f32x4){0.f, 0.f, 0.f, 0.f};
        cur = nxt; cA = nA; cB = nB; ++ui;
        if constexpr (GATHER) {
#pragma unroll
            for (int i = 0; i < 2; ++i) { vA0[i] = nvA0[i]; vA1[i] = nvA1[i]; }
        }
        if constexpr (ALIGN_EPI) { if (wr == 1) PG8_BAR; }
    }
    PG8_WAIT_V(0);
    if constexpr (!ALIGN_EPI) { if (wr == 0) PG8_BAR; }
    PG8_BAR;
#undef PG8_SA
#undef PG8_SB
#undef PG8_STAGE
#undef PG8_LDA
#undef PG8_LDB
#undef PG8_MMA
#undef PG8_WAIT_V
#undef PG8_WAIT_L
#undef PG8_BAR
#undef PG8_SCHED
}

__device__ __forceinline__ u32x4 pack8(const f32x4 v0, const f32x4 v1) { u32x4 w; w.x = cvt_pk_bf16(v0[0], v0[1]); w.y = cvt_pk_bf16(v0[2], v0[3]); w.z = cvt_pk_bf16(v1[0], v1[1]); w.w = cvt_pk_bf16(v1[2], v1[3]); return w; }
__device__ __forceinline__ void unpack8(const u32x4 w, f32x4& v0, f32x4& v1) {
    v0[0] = __uint_as_float(w.x << 16); v0[1] = __uint_as_float(w.x & 0xffff0000u); v0[2] = __uint_as_float(w.y << 16); v0[3] = __uint_as_float(w.y & 0xffff0000u);
    v1[0] = __uint_as_float(w.z << 16); v1[1] = __uint_as_float(w.z & 0xffff0000u); v1[2] = __uint_as_float(w.w << 16); v1[3] = __uint_as_float(w.w & 0xffff0000u); }

struct Epi1 {
    static constexpr bool PERM = true;
    bf16 *Zl, *GA, *UB, *V; float* VPART;
    __device__ __forceinline__ void operator()(const f32x4 (&acc)[2][2][4][2], const Unit& u, int wr, int wc, int fr, int fq) const {
        const int row0 = u.pm * BM + wr * 64 + fr, pn = u.pn;
        if (pn < 4) {
            const int col0 = pn * 256 + wc * 32 + 8 * fq;
#pragma unroll
            for (int ai = 0; ai < 2; ++ai)
#pragma unroll
                for (int m = 0; m < 4; ++m) { bf16* rowp = Zl + (size_t)(row0 + ai * HALF + m * 16) * D + col0;
#pragma unroll
                    for (int bj = 0; bj < 2; ++bj) *(u32x4*)(rowp + bj * HALF) = pack8(acc[ai][bj][m][0], acc[ai][bj][m][1]); }
        } else if (pn < 20) {
            bf16* O = pn < 12 ? GA : UB; const int uu = pn < 12 ? pn - 4 : pn - 12; const int col0 = uu * 128 + wc * 32 + 8 * fq;
#pragma unroll
            for (int ai = 0; ai < 2; ++ai)
#pragma unroll
                for (int m = 0; m < 4; ++m) { f32x4 v[2];
#pragma unroll
                    for (int n = 0; n < 2; ++n)
#pragma unroll
                        for (int i = 0; i < 4; ++i) v[n][i] = fgelu(acc[ai][0][m][n][i]) * fsigm(acc[ai][1][m][n][i]);
                    *(u32x4*)(O + (size_t)(row0 + ai * HALF + m * 16) * D + col0) = pack8(v[0], v[1]); }
        } else {
            const int col0 = (pn - 20) * 256 + wc * 32 + 8 * fq;
#pragma unroll
            for (int ai = 0; ai < 2; ++ai)
#pragma unroll
                for (int m = 0; m < 4; ++m) { const int row = row0 + ai * HALF + m * 16; float s1 = 0.f, s2 = 0.f;
#pragma unroll
                    for (int bj = 0; bj < 2; ++bj) { f32x4 v[2];
#pragma unroll
                        for (int n = 0; n < 2; ++n)
#pragma unroll
                            for (int i = 0; i < 4; ++i) { const float gv = fgelu(acc[ai][bj][m][n][i]); v[n][i] = gv; s1 += gv; s2 += gv * gv; }
                        *(u32x4*)(V + (size_t)row * D + col0 + bj * HALF) = pack8(v[0], v[1]); }
                    s1 += __shfl_xor(s1, 16); s1 += __shfl_xor(s1, 32); s2 += __shfl_xor(s2, 16); s2 += __shfl_xor(s2, 32);
                    if (fq == 0) *(f32x2*)(VPART + (size_t)row * 32 + ((pn - 20) * 4 + wc) * 2) = (f32x2){s1, s2}; }
        }
    }
};
struct EpiPlain {
    static constexpr bool PERM = true;
    bf16* O;
    __device__ __forceinline__ void operator()(const f32x4 (&acc)[2][2][4][2], const Unit& u, int wr, int wc, int fr, int fq) const {
        const int row0 = u.pm * BM + wr * 64 + fr, col0 = u.pn * 256 + wc * 32 + 8 * fq;
#pragma unroll
        for (int ai = 0; ai < 2; ++ai)
#pragma unroll
            for (int m = 0; m < 4; ++m) { bf16* rowp = O + (size_t)(row0 + ai * HALF + m * 16) * D + col0;
#pragma unroll
                for (int bj = 0; bj < 2; ++bj) *(u32x4*)(rowp + bj * HALF) = pack8(acc[ai][bj][m][0], acc[ai][bj][m][1]); }
    }
};
struct Epi2 {
    static constexpr bool PERM = true;
    const float* x; bf16* X1b; float* SS1;
    __device__ __forceinline__ void operator()(const f32x4 (&acc)[2][2][4][2], const Unit& u, int wr, int wc, int fr, int fq) const {
        const int row0 = u.pm * BM + wr * 64 + fr, col0 = u.pn * 256 + wc * 32 + 8 * fq;
#pragma unroll
        for (int ai = 0; ai < 2; ++ai)
#pragma unroll
            for (int m = 0; m < 4; ++m) { const int row = row0 + ai * HALF + m * 16; float ss = 0.f;
#pragma unroll
                for (int bj = 0; bj < 2; ++bj) { const float* xp = x + (size_t)row * D + col0 + bj * HALF;
                    const f32x4 v0 = acc[ai][bj][m][0] + *(const f32x4*)xp, v1 = acc[ai][bj][m][1] + *(const f32x4*)(xp + 4);
                    ss += (v0[0] * v0[0] + v0[1] * v0[1]) + (v0[2] * v0[2] + v0[3] * v0[3]) + (v1[0] * v1[0] + v1[1] * v1[1]) + (v1[2] * v1[2] + v1[3] * v1[3]);
                    *(u32x4*)(X1b + (size_t)row * D + col0 + bj * HALF) = pack8(v0, v1); }
                ss += __shfl_xor(ss, 16); ss += __shfl_xor(ss, 32);
                if (fq == 0) SS1[(size_t)row * 16 + u.pn * 4 + wc] = ss; }
    }
};
struct EpiPle {
    static constexpr bool PERM = true;
    const bf16* X2b; const bf16* PU; const float* RSTD2; bf16* X3; float* SS3;
    __device__ __forceinline__ void operator()(const f32x4 (&acc)[2][2][4][2], const Unit& u, int wr, int wc, int fr, int fq) const {
        const int row0 = u.pm * BM + wr * 64 + fr, col0 = u.pn * 256 + wc * 32 + 8 * fq;
#pragma unroll
        for (int ai = 0; ai < 2; ++ai)
#pragma unroll
            for (int m = 0; m < 4; ++m) { const int row = row0 + ai * HALF + m * 16; float ss = 0.f; const float r2 = RSTD2[row];
#pragma unroll
                for (int bj = 0; bj < 2; ++bj) { const size_t o = (size_t)row * D + col0 + bj * HALF;
                    f32x4 x0, x1, p0, p1; unpack8(*(const u32x4*)(X2b + o), x0, x1); unpack8(*(const u32x4*)(PU + o), p0, p1);
                    f32x4 v0, v1;
#pragma unroll
                    for (int i = 0; i < 4; ++i) { v0[i] = x0[i] + fsigm(r2 * acc[ai][bj][m][0][i]) * p0[i]; v1[i] = x1[i] + fsigm(r2 * acc[ai][bj][m][1][i]) * p1[i]; }
                    ss += (v0[0] * v0[0] + v0[1] * v0[1]) + (v0[2] * v0[2] + v0[3] * v0[3]) + (v1[0] * v1[0] + v1[1] * v1[1]) + (v1[2] * v1[2] + v1[3] * v1[3]);
                    *(u32x4*)(X3 + o) = pack8(v0, v1); }
                ss += __shfl_xor(ss, 16); ss += __shfl_xor(ss, 32);
                if (fq == 0) SS3[(size_t)row * 16 + u.pn * 4 + wc] = ss; }
    }
};

struct EpiPleFinal {
    static constexpr bool PERM = true;
    const bf16* X2b; const bf16* PU; const float* RSTD2; const float* fn; float* out; float* XCH; unsigned* cnt; LAS float* xl; int wave;
    __device__ __forceinline__ void operator()(f32x4 (&acc)[2][2][4][2], const Unit& u, int wr, int wc, int fr, int fq) const {
        const int tid = wave * 64 + lane_id();
        const int rl0 = wr * 64 + fr, col0 = u.pn * 256 + wc * 32 + 8 * fq;
#pragma unroll
        for (int ai = 0; ai < 2; ++ai)
#pragma unroll
            for (int m = 0; m < 4; ++m) { const int rl = rl0 + ai * HALF + m * 16, row = u.pm * BM + rl; float ss = 0.f; const float r2 = RSTD2[row];
#pragma unroll
                for (int bj = 0; bj < 2; ++bj) { const size_t o = (size_t)row * D + col0 + bj * HALF;
                    f32x4 x0, x1, p0, p1; unpack8(*(const u32x4*)(X2b + o), x0, x1); unpack8(*(const u32x4*)(PU + o), p0, p1);
                    f32x4 v0, v1;
#pragma unroll
                    for (int i = 0; i < 4; ++i) { v0[i] = x0[i] + fsigm(r2 * acc[ai][bj][m][0][i]) * p0[i]; v1[i] = x1[i] + fsigm(r2 * acc[ai][bj][m][1][i]) * p1[i]; }
                    ss += (v0[0] * v0[0] + v0[1] * v0[1]) + (v0[2] * v0[2] + v0[3] * v0[3]) + (v1[0] * v1[0] + v1[1] * v1[1]) + (v1[2] * v1[2] + v1[3] * v1[3]);
                    acc[ai][bj][m][0] = v0; acc[ai][bj][m][1] = v1; }
                ss += __shfl_xor(ss, 16); ss += __shfl_xor(ss, 32);
                if (fq == 0) xl[rl * 4 + wc] = ss; }
        __syncthreads();
        if (tid < 256) { const f32x4 p = *(const LAS f32x4*)(xl + tid * 4);
            __hip_atomic_store(XCH + (size_t)(u.pm * BM + tid) * 4 + u.pn, (p[0] + p[1]) + (p[2] + p[3]), __ATOMIC_RELAXED, __HIP_MEMORY_SCOPE_AGENT); }
        asm volatile("s_waitcnt vmcnt(0)" ::: "memory");
        if (tid < 256 && (tid & 63) == 0) __hip_atomic_fetch_add(cnt + 64 * u.pm, 1u, __ATOMIC_RELAXED, __HIP_MEMORY_SCOPE_AGENT);
        if (tid < 64) { unsigned sp = 0;
            while ((unsigned)__builtin_amdgcn_readfirstlane(__hip_atomic_load(cnt + 64 * u.pm, __ATOMIC_RELAXED, __HIP_MEMORY_SCOPE_AGENT)) < 16u) { if (++sp > (1u << 22)) break; __builtin_amdgcn_s_sleep(1); } }
        __syncthreads();
        if (tid < 256) { const float* xs = XCH + (size_t)(u.pm * BM + tid) * 4; float tot = 0.f;
#pragma unroll
            for (int q = 0; q < 4; ++q) tot += __hip_atomic_load(xs + q, __ATOMIC_RELAXED, __HIP_MEMORY_SCOPE_AGENT);
            xl[1024 + tid] = rsqrtf(tot * (1.f / D) + EPS); }
        __syncthreads();
#pragma unroll
        for (int ai = 0; ai < 2; ++ai)
#pragma unroll
            for (int m = 0; m < 4; ++m) { const int rl = rl0 + ai * HALF + m * 16; const float rs = xl[1024 + rl]; float* op = out + (size_t)(u.pm * BM + rl) * D + col0;
#pragma unroll
                for (int bj = 0; bj < 2; ++bj) { const f32x4 f0 = *(const f32x4*)(fn + col0 + bj * HALF), f1 = *(const f32x4*)(fn + col0 + bj * HALF + 4);
                    *(f32x4*)(op + bj * HALF) = acc[ai][bj][m][0] * rs * f0; *(f32x4*)(op + bj * HALF + 4) = acc[ai][bj][m][1] * rs * f1; } }
    }
};

template <int MODE> struct MoeOrder {
    const LAS int* tab; const int* LIST; unsigned* dcnt;
    __device__ __forceinline__ bool next(int i, Unit& u) const {
        const int n = __builtin_amdgcn_readfirstlane(tab[0]); if (i >= n) return false;
        const LAS int* p = tab + 4 + 8 * i;
        u.pm = __builtin_amdgcn_readfirstlane(p[0]); u.pn = __builtin_amdgcn_readfirstlane(p[1]); u.e = __builtin_amdgcn_readfirstlane(p[2]);
        u.tile = __builtin_amdgcn_readfirstlane(p[3]); u.cnt = __builtin_amdgcn_readfirstlane(p[4]); return true;
    }
    __device__ __forceinline__ unsigned row_off(const Unit& u, int r) const { int idx = u.tile * 256 + r; idx = idx < u.cnt ? idx : u.cnt - 1; const int pair = LIST[u.e * 16384 + idx]; return (unsigned)(pair >> 1) * 2048u; }
    __device__ __forceinline__ void a_ready(const Unit&) const {}
    struct Pre {}; __device__ __forceinline__ void pre(int, Pre&) const {}
    __device__ __forceinline__ void post(int, Pre&) const {}
    __device__ __forceinline__ bool half(const Unit& u) const { return MODE == 1 && (u.cnt - u.tile * 256) <= 128; }
    __device__ __forceinline__ void done(const Unit& u) const {
        if constexpr (MODE == 1) {
            asm volatile("s_waitcnt vmcnt(0)" ::: "memory");
            if (lane_id() == 0) __hip_atomic_fetch_add(dcnt + 64 * u.pm, 1u, __ATOMIC_RELAXED, __HIP_MEMORY_SCOPE_AGENT);
        }
    }
};
__device__ __forceinline__ void store16_sc1(void* p, u32x4 v) { asm volatile("global_store_dwordx4 %0, %1, off sc1\n\ts_nop 1" :: "v"(p), "v"(v) : "memory"); }
struct EpiMoe1 {
    static constexpr bool PERM = true;
    bf16* H; const int* LIST; const float* RSTD1;
    __device__ __forceinline__ void operator()(const f32x4 (&acc)[2][2][4][2], const Unit& u, int wr, int wc, int fr, int fq) const {
        const int col0 = (u.pn & 1) * 128 + wc * 32 + 8 * fq;
#pragma unroll
        for (int ai = 0; ai < 2; ++ai)
#pragma unroll
            for (int m = 0; m < 4; ++m) { const int r = ai * HALF + wr * 64 + m * 16 + fr; int idx = u.tile * 256 + r; idx = idx < u.cnt ? idx : u.cnt - 1;
                const int pair = LIST[u.e * 16384 + idx]; const float rs = RSTD1[pair >> 1]; f32x4 v[2];
#pragma unroll
                for (int n = 0; n < 2; ++n)
#pragma unroll
                    for (int i = 0; i < 4; ++i) { const float a1 = rs * acc[ai][0][m][n][i], a3 = rs * acc[ai][1][m][n][i]; v[n][i] = a1 * fsigm(a1) * a3; }
                store16_sc1(H + (size_t)(u.pm * 256 + r) * 256 + col0, pack8(v[0], v[1])); }
    }
};
struct EpiMoe2 {
    static constexpr bool PERM = true;
    bf16* Y; const int* LIST; const float* TOKG;
    __device__ __forceinline__ void operator()(const f32x4 (&acc)[2][2][4][2], const Unit& u, int wr, int wc, int fr, int fq) const {
        const int col0 = (u.pn & 3) * 256 + wc * 32 + 8 * fq;
        int pr[2][4]; float gt[2][4];
#pragma unroll
        for (int ai = 0; ai < 2; ++ai)
#pragma unroll
            for (int m = 0; m < 4; ++m) { int idx = u.tile * 256 + ai * HALF + wr * 64 + m * 16 + fr; idx = idx < u.cnt ? idx : u.cnt - 1; pr[ai][m] = LIST[u.e * 16384 + idx]; }
#pragma unroll
        for (int ai = 0; ai < 2; ++ai)
#pragma unroll
            for (int m = 0; m < 4; ++m) gt[ai][m] = TOKG[pr[ai][m]];
#pragma unroll
        for (int ai = 0; ai < 2; ++ai)
#pragma unroll
            for (int m = 0; m < 4; ++m) { const int idx = u.tile * 256 + ai * HALF + wr * 64 + m * 16 + fr;
                if (idx < u.cnt) { const float g = gt[ai][m]; bf16* yp = Y + (size_t)pr[ai][m] * D + col0;
#pragma unroll
                    for (int bj = 0; bj < 2; ++bj) *(u32x4*)(yp + bj * HALF) = pack8(acc[ai][bj][m][0] * g, acc[ai][bj][m][1] * g); } }
    }
};
}

constexpr int NWAVES = 8;
constexpr int RING_BYTES = 131072, LDSCTL_OFF = 139264, MISC_OFF = LDSCTL_OFF + 320, TAB_OFF = LDSCTL_OFF + 512, LDS_BYTES = 147456;
constexpr size_t WS_WLRU = 8 * MiB + 512 * 1024;
constexpr size_t WS_WSGU = 8 * MiB + 768 * 1024;
constexpr size_t WS_WR = 9 * MiB;
constexpr size_t WS_WUP = 9 * MiB + 512 * 1024;
constexpr size_t WS_WIN = 10 * MiB;
constexpr size_t WS_WOUT = 22 * MiB;
constexpr size_t WS_WG = 24 * MiB;
constexpr size_t WS_W13 = 26 * MiB;
constexpr size_t WS_W2 = 58 * MiB;
constexpr size_t WS_PB = 234 * MiB;
constexpr size_t WS_RSTD1 = 242 * MiB;
constexpr size_t WS_SPL8 = 242 * MiB + 512 * 1024;
constexpr size_t WS_XCH = 243 * MiB;
constexpr size_t WS_MEGA_END = 244 * MiB;
constexpr int CW_BAR = 4096;
constexpr int CW_DONE1 = 131072;
constexpr int CW_PANEL = 65536;

typedef GAS unsigned gu32;
#define RLX_AGENT __ATOMIC_RELAXED, __HIP_MEMORY_SCOPE_AGENT
#define LDS_WAIT() asm volatile("s_waitcnt lgkmcnt(0)" ::: "memory")
#define VM_WAIT() asm volatile("s_waitcnt vmcnt(0)" ::: "memory")

#define XB_TMO      128
#define XB_XCNT(j)  (256  + 64 * (j))
#define XB_XSUB(j)  (1280 + 64 * (j))
#define XB_XGEN(j)  (2304 + 64 * (j))
#define XB_TOP      3328
#define XB_TOPGEN   3392
#define XCD_BAR_WORDS 3456
#define XB_SPIN_CAP (1u << 18)
__device__ __forceinline__ unsigned xb_ld(unsigned* p)              { return __hip_atomic_load(p, __ATOMIC_RELAXED, __HIP_MEMORY_SCOPE_AGENT); }
__device__ __forceinline__ unsigned xb_add(unsigned* p, unsigned v) { return __hip_atomic_fetch_add(p, v, __ATOMIC_RELAXED, __HIP_MEMORY_SCOPE_AGENT); }
__device__ __forceinline__ unsigned xb_xcc_id() { return (unsigned)__builtin_amdgcn_s_getreg((3 << 11) | 20) & 0xFu; }
#define XB_SPIN(cond, bar) do { unsigned _sp = 0; while (cond) { __builtin_amdgcn_s_sleep(1); \
    if ((++_sp & 255u) == 0u) { if (xb_ld(&(bar)[XB_TMO])) break; if (_sp > XB_SPIN_CAP) { atomicAdd(&(bar)[XB_TMO], 1u); break; } } } } while (0)
struct XcdBarrier { unsigned* bar; unsigned x; volatile LAS unsigned* st; int wave; };
__device__ __forceinline__ XcdBarrier xcd_barrier_post(unsigned* bar, volatile LAS unsigned* st, int wave) {
    XcdBarrier b; b.bar = bar; b.x = xb_xcc_id(); b.st = st; b.wave = wave;
    if (wave == 0 && pg8::lane_id() == 0) (void)xb_add(&bar[XB_XCNT(b.x)], 1u);
    return b;
}
__device__ __forceinline__ void xcd_barrier_complete(unsigned* bar, unsigned x, unsigned& nloc, unsigned& nx) {
    const unsigned G = gridDim.x * gridDim.y * gridDim.z;
    unsigned sum, cnt, mine, sp = 0u;
    for (;;) {
        sum = 0u; cnt = 0u; mine = 0u;
#pragma unroll
        for (unsigned j = 0; j < 16; ++j) { const unsigned c = xb_ld(&bar[XB_XCNT(j)]); sum += c; cnt += (c > 0u) ? 1u : 0u; mine = (j == x) ? c : mine; }
        if (sum == G) break;
        __builtin_amdgcn_s_sleep(1);
        if ((++sp & 255u) == 0u) { if (xb_ld(&bar[XB_TMO])) break; if (sp > XB_SPIN_CAP) { atomicAdd(&bar[XB_TMO], 1u); break; } }
    }
    nloc = mine > 0u ? mine : 1u; nx = cnt > 0u ? cnt : 1u;
}
__device__ __forceinline__ void xcd_barrier(const XcdBarrier& b) {
    asm volatile("s_waitcnt vmcnt(0)" ::: "memory");
    __syncthreads();
    if (b.wave == 0 && pg8::lane_id() == 0) {
        unsigned* bar = b.bar;
        __builtin_amdgcn_s_waitcnt(0);
        unsigned nloc = b.st[0], nx = b.st[1];
        if (nloc == 0u) { xcd_barrier_complete(bar, b.x, nloc, nx); b.st[0] = nloc; b.st[1] = nx; }
        const unsigned old = xb_add(&bar[XB_XSUB(b.x)], 1u);
        const unsigned gen = old / nloc;
        if (old + 1u == (gen + 1u) * nloc) {
            __builtin_amdgcn_fence(__ATOMIC_RELEASE, "agent");
            asm volatile("s_waitcnt vmcnt(0)" ::: "memory");
            const unsigned og = xb_add(&bar[XB_TOP], 1u);
            const unsigned tg = og / nx;
            if (og + 1u == (tg + 1u) * nx) xb_add(&bar[XB_TOPGEN], 1u);
            else XB_SPIN(xb_ld(&bar[XB_TOPGEN]) == tg, bar);
            __builtin_amdgcn_fence(__ATOMIC_ACQUIRE, "agent");
            xb_add(&bar[XB_XGEN(b.x)], 1u);
            asm volatile("s_waitcnt vmcnt(0)" ::: "memory");
        } else {
            XB_SPIN(xb_ld(&bar[XB_XGEN(b.x)]) == gen, bar);
            __builtin_amdgcn_fence(__ATOMIC_ACQUIRE, "agent");
            asm volatile("s_waitcnt vmcnt(0)" ::: "memory");
        }
    }
    __syncthreads();
}

__device__ __forceinline__ unsigned pk2(float lo, float hi) { return (unsigned)f2bf(lo) | ((unsigned)f2bf(hi) << 16); }

struct TrItem { pg8::f32x4 v[8]; };
__device__ __forceinline__ void tr_load(TrItem& t, const float* __restrict__ W, int ldn, int k0, int n_src0, int lane) {
    const int kb = lane >> 3, n4 = lane & 7;
    const float* src = W + (size_t)(k0 + 8 * kb) * ldn + n_src0 + 4 * n4;
#pragma unroll
    for (int q = 0; q < 8; ++q) t.v[q] = *(const pg8::f32x4*)(src + (size_t)q * ldn);
}
__device__ __forceinline__ void tr_store(TrItem& t, int k0, bf16* __restrict__ WT, int Kd, int drow0, const float* __restrict__ gk, int lane) {
    const int kb = lane >> 3, n4 = lane & 7;
    if (gk) { const pg8::f32x4 g0 = *(const pg8::f32x4*)(gk + k0 + 8 * kb), g1 = *(const pg8::f32x4*)(gk + k0 + 8 * kb + 4);
#pragma unroll
        for (int q = 0; q < 8; ++q) t.v[q] = t.v[q] * (q < 4 ? g0[q & 3] : g1[q & 3]); }
#pragma unroll
    for (int i = 0; i < 4; ++i) { pg8::u32x4 o; o.x = pk2(t.v[0][i], t.v[1][i]); o.y = pk2(t.v[2][i], t.v[3][i]); o.z = pk2(t.v[4][i], t.v[5][i]); o.w = pk2(t.v[6][i], t.v[7][i]);
        *(pg8::u32x4*)(WT + (size_t)(drow0 + 4 * n4 + i) * Kd + k0 + 8 * kb) = o; }
}
__device__ __forceinline__ void p0_transpose_item(const float* __restrict__ W, int ldn, int k0, int n_src0, bf16* __restrict__ WT, int Kd, int drow0, const float* __restrict__ gk, LAS float*, int lane) {
    TrItem t; tr_load(t, W, ldn, k0, n_src0, lane); tr_store(t, k0, WT, Kd, drow0, gk, lane);
}
__device__ __forceinline__ int win_dest_row(int n) {
    const int grp = n >> 10, j = n & 1023;
    switch (grp) {
        case 0: return j;
        case 1: return 1024 + (j >> 7) * 256 + (j & 127);
        case 2: return 3072 + (j >> 7) * 256 + (j & 127);
        case 3: return 5120 + j;
        case 4: return 1024 + (j >> 7) * 256 + 128 + (j & 127);
        default: return 3072 + (j >> 7) * 256 + 128 + (j & 127);
    }
}


struct DefW { const float* const* in; unsigned char* ws; };
constexpr int DF_OUT = 16 * 32, DF_E13 = 32 * 2 * 128, DF_E2 = 32 * 128, DF_G = 16 * 32, DF_UP = 4 * 32, DF_N = DF_OUT + DF_E13 + DF_E2 + DF_G + DF_UP;
struct DefDesc { const float* W; const float* gk; bf16* WT; int ldn, k0, n0, Kd, drow; };
__device__ __forceinline__ DefDesc deferred_desc(const DefW& w, int it) {
    int r = it; DefDesc d;
    if (r < DF_OUT) { const int kb = r / 32, nb = r % 32; d = DefDesc{w.in[15], nullptr, (bf16*)(w.ws + WS_WOUT), 1024, kb * 64, nb * 32, 1024, nb * 32}; return d; } r -= DF_OUT;
    if (r < DF_E13) { const int e = r / 256, which = (r / 128) & 1, q = r % 128, kb = q / 8, nb = q % 8;
        const int f0 = nb * 32, drow = e * 512 + (f0 >> 7) * 256 + which * 128 + (f0 & 127);
        d = DefDesc{w.in[which ? 22 : 21] + (size_t)e * 1024 * 256, w.in[16], (bf16*)(w.ws + WS_W13), 256, kb * 64, f0, 1024, drow}; return d; } r -= DF_E13;
    if (r < DF_E2) { const int e = r / 128, q = r % 128, kb = q / 32, nb = q % 32;
        d = DefDesc{w.in[23] + (size_t)e * 256 * 1024, nullptr, (bf16*)(w.ws + WS_W2), 1024, kb * 64, nb * 32, 256, e * 1024 + nb * 32}; return d; } r -= DF_E2;
    if (r < DF_G) { const int kb = r / 32, nb = r % 32; d = DefDesc{w.in[25], w.in[24], (bf16*)(w.ws + WS_WG), 1024, kb * 64, nb * 32, 1024, nb * 32}; return d; } r -= DF_G;
    { const int kb = r / 32, nb = r % 32; d = DefDesc{w.in[26], nullptr, (bf16*)(w.ws + WS_WUP), 1024, kb * 64, nb * 32, 256, nb * 32}; return d; }
}
struct Gemm1Order : pg8::StaticOrder {
    DefW w; int wave;
    typedef TrItem Pre;
    __device__ __forceinline__ void pre(int ui, Pre& t) const {
        const int lane = pg8::lane_id(), it = (ui * G + c) * 8 + wave;
        if (it < DF_N) { const DefDesc d = deferred_desc(w, it); tr_load(t, d.W, d.ldn, d.k0, d.n0, lane); }
    }
    __device__ __forceinline__ void post(int ui, Pre& t) const {
        const int lane = pg8::lane_id(); int it = (ui * G + c) * 8 + wave;
        if (it < DF_N) { const DefDesc d = deferred_desc(w, it); tr_store(t, d.k0, d.WT, d.Kd, d.drow, d.gk, lane); }
        for (it += nwg * 8; it < DF_N; it += nwg * 8) { const DefDesc d = deferred_desc(w, it); TrItem t2; tr_load(t2, d.W, d.ldn, d.k0, d.n0, lane); tr_store(t2, d.k0, d.WT, d.Kd, d.drow, d.gk, lane); }
        { const int slot = (ui * G + c) * 8 + wave;
          if (slot < 8192) { const size_t i0 = (size_t)slot * 128 + lane; const pg8::f32x4* psrc = (const pg8::f32x4*)w.in[1]; unsigned long long* pdst = (unsigned long long*)(w.ws + WS_PB); const pg8::f32x4 v0 = psrc[i0], v1 = psrc[i0 + 64];
              pdst[i0] = (unsigned long long)pk2(v0.x, v0.y) | ((unsigned long long)pk2(v0.z, v0.w) << 32);
              pdst[i0 + 64] = (unsigned long long)pk2(v1.x, v1.y) | ((unsigned long long)pk2(v1.z, v1.w) << 32); } }
    }
};

constexpr int MY_VT = 0, MY_XA = 32768, MY_SP = 67584, MY_WS = 102400, MY_ST = 135168, MY_RS = 272;
__device__ __forceinline__ float bflo(unsigned u) { return __uint_as_float(u << 16); }
__device__ __forceinline__ float bfhi(unsigned u) { return __uint_as_float(u & 0xffff0000u); }
template <int N> __device__ __forceinline__ float row_shr(float ident, float v) {
    return __builtin_bit_cast(float, __builtin_amdgcn_update_dpp(__builtin_bit_cast(int, ident), __builtin_bit_cast(int, v), 0x110 + N, 0xf, 0xf, false)); }
#define MX_SCAN_STEP(N, A, U) { const float pa_ = row_shr<N>(1.f, A), pu_ = row_shr<N>(0.f, U); U = pu_ * A + U; A = pa_ * A; }
#define MX_SCAN16(A, U) { MX_SCAN_STEP(1, A, U) MX_SCAN_STEP(2, A, U) MX_SCAN_STEP(4, A, U) MX_SCAN_STEP(8, A, U) }
__device__ __forceinline__ void mixer_phase(LAS unsigned char* lds, const int vcu, const int G, const int tid, const int lane, const int wave,
                                            const bf16* __restrict__ Zl, const bf16* __restrict__ GA, const bf16* __restrict__ UB, const bf16* __restrict__ V, const float* __restrict__ VPART,
                                            unsigned long long* AGG, bf16* __restrict__ MG, const bf16* __restrict__ WLRU, const bf16* __restrict__ WSGU, const float* __restrict__ SPL8, const float* const* in) {
    using namespace pg8;
    constexpr int RS = MY_RS;
    constexpr float L2E = 1.4426950409f;
    const int fr = lane & 15, grp = lane >> 4, cp = tid & 63, tg = wave;
    const int pr = lane & 3, sch = lane >> 2, srow = 8 * sch + 2 * pr;
    LAS float* ST = (LAS float*)(lds + MY_ST);
    int gprev = -1;
    f32x2 cw0, cw1, cw2, cw3, ccb;
    u32x4 zqa, zqb, zqc, zqd, zqe, vv00, vv01, vv10, vv11;
#define MX_ZR(k) ((k) < 4 ? zqa[(k) & 3] : (k) < 8 ? zqb[(k) & 3] : (k) < 12 ? zqc[(k) & 3] : (k) < 16 ? zqd[(k) & 3] : zqe[(k) & 3])
#define MX_SETZR(k, v) do { if ((k) < 4) zqa[(k) & 3] = (v); else if ((k) < 8) zqb[(k) & 3] = (v); else if ((k) < 12) zqc[(k) & 3] = (v); else if ((k) < 16) zqd[(k) & 3] = (v); else zqe[(k) & 3] = (v); } while (0)
#define MX_PREFETCH(uu) do { const int ck_ = (uu) >> 3, g_ = (uu) & 7, t0_ = ck_ * 128, c0_ = g_ * 128; const bool first_ = (ck_ & 15) == 0; \
        const unsigned zo_ = ((unsigned)(t0_ + 16 * tg) * D + c0_ + 2 * cp) * 2u; \
        _Pragma("unroll") for (int k = 0; k < 19; ++k) { unsigned zv_ = 0u; if (!(k < 3 && first_ && tg == 0)) zv_ = *(const unsigned*)((const char*)Zl + (zo_ + (unsigned)((k - 3) * D * 2))); MX_SETZR(k, zv_); } \
        { const unsigned vo_ = ((unsigned)(t0_ + srow) * D + c0_ + 16 * wave) * 2u; vv00 = *(const u32x4*)((const char*)V + vo_); vv01 = *(const u32x4*)((const char*)V + (vo_ + D * 2)); vv10 = *(const u32x4*)((const char*)V + (vo_ + 16)); vv11 = *(const u32x4*)((const char*)V + (vo_ + D * 2 + 16)); } \
        } while (0)
    zqe = (u32x4){0u, 0u, 0u, 0u};
#define MX_STATS_LOAD(uu, q0, q1) do { const unsigned vpo_ = ((unsigned)(((uu) >> 3) * 128 + (tid >> 2)) * 32 + (tid & 3) * 8) * 4u; q0 = *(const f32x4*)((const char*)VPART + vpo_); q1 = *(const f32x4*)((const char*)VPART + (vpo_ + 16)); } while (0)
#define MX_STATS_WRITE(q0, q1) do { float s1 = (q0[0] + q0[2]) + (q1[0] + q1[2]), s2 = (q0[1] + q0[3]) + (q1[1] + q1[3]); \
        s1 += __shfl_xor(s1, 1); s1 += __shfl_xor(s1, 2); s2 += __shfl_xor(s2, 1); s2 += __shfl_xor(s2, 2); \
        if ((tid & 3) == 0) { const float mean = s1 * (1.f / 1024.f); float var = s2 * (1.f / 1024.f) - mean * mean; var = var < 0.f ? 0.f : var; ST[tid >> 2] = mean; ST[128 + (tid >> 2)] = rsqrtf(var + EPS); } } while (0)
    int u = vcu;
    if (u < 1024) { MX_PREFETCH(u); f32x4 q0, q1; MX_STATS_LOAD(u, q0, q1); MX_STATS_WRITE(q0, q1); }
    for (; u < 1024; u += G) {
        const int ck = u >> 3, g = u & 7, t0 = ck * 128, c0 = g * 128, j = ck & 15;
        const int cch = c0 + 16 * wave + 4 * grp;
        if (g != gprev) {
            gprev = g;
#pragma unroll
            for (int it = 0; it < 4; ++it) { const int idx = it * 512 + tid, row = idx >> 4, ch = idx & 15;
                *(LAS u32x4*)(lds + MY_WS + row * 256 + ((ch ^ (row & 15)) << 4)) = *(const u32x4*)(WSGU + ((size_t)(g * 128 + row)) * 128 + ch * 8); }
            const int cc = c0 + 2 * cp;
            cw0 = *(const f32x2*)(in[4] + cc); cw1 = *(const f32x2*)(in[4] + 1024 + cc); cw2 = *(const f32x2*)(in[4] + 2048 + cc); cw3 = *(const f32x2*)(in[4] + 3072 + cc); ccb = *(const f32x2*)(in[5] + cc);
        }
        const int hblk = 2 * g + (wave >> 2), jj0 = (16 * wave) & 63;
        const bf16x8 bw00 = *(const bf16x8*)(WLRU + ((size_t)((0 * 16 + hblk) * 64 + jj0 + fr)) * 64 + 0 * 32 + 8 * grp), bw01 = *(const bf16x8*)(WLRU + ((size_t)((0 * 16 + hblk) * 64 + jj0 + fr)) * 64 + 1 * 32 + 8 * grp);
        const bf16x8 bw10 = *(const bf16x8*)(WLRU + ((size_t)((1 * 16 + hblk) * 64 + jj0 + fr)) * 64 + 0 * 32 + 8 * grp), bw11 = *(const bf16x8*)(WLRU + ((size_t)((1 * 16 + hblk) * 64 + jj0 + fr)) * 64 + 1 * 32 + 8 * grp);
        const f32x4 nba = *(const f32x4*)(in[7] + cch) * (-L2E), nbi = *(const f32x4*)(in[9] + cch) * (-L2E), ksp = *(const f32x4*)(SPL8 + cch);
        {
#pragma unroll
            for (int i = 0; i < 16; ++i) {
                const unsigned z0 = MX_ZR(i), z1 = MX_ZR(i + 1), z2 = MX_ZR(i + 2), z3 = MX_ZR(i + 3);
                const float x0 = ccb.x + cw0.x * bflo(z0) + cw1.x * bflo(z1) + cw2.x * bflo(z2) + cw3.x * bflo(z3);
                const float x1 = ccb.y + cw0.y * bfhi(z0) + cw1.y * bfhi(z1) + cw2.y * bfhi(z2) + cw3.y * bfhi(z3);
                *(LAS unsigned*)(lds + MY_XA + (16 * tg + i) * RS + 4 * cp) = cvt_pk_bf16(x0, x1);
            }
        }
        __syncthreads();
        {
            const float mua = ST[srow], rsa = ST[128 + srow], mub = ST[srow + 1], rsb = ST[128 + srow + 1];
#pragma unroll
            for (int ci = 0; ci < 2; ++ci) { const int chunk = 2 * wave + ci, cbase = c0 + 8 * chunk;
                f32x4 a0, a1, b0, b1; unpack8(ci ? vv10 : vv00, a0, a1); unpack8(ci ? vv11 : vv01, b0, b1);
                const f32x4 g0 = *(const f32x4*)(in[11] + cbase), g1 = *(const f32x4*)(in[11] + cbase + 4), l0 = *(const f32x4*)(in[12] + cbase), l1 = *(const f32x4*)(in[12] + cbase + 4);
                a0 = (a0 - mua) * rsa * g0 + l0; a1 = (a1 - mua) * rsa * g1 + l1; b0 = (b0 - mub) * rsb * g0 + l0; b1 = (b1 - mub) * rsb * g1 + l1;
#pragma unroll
                for (int i = 0; i < 8; ++i) { const int cl = 8 * chunk + i; const float va = i < 4 ? a0[i & 3] : a1[i & 3], vb = i < 4 ? b0[i & 3] : b1[i & 3];
                    *(LAS unsigned*)(lds + MY_VT + cl * 256 + ((sch ^ (cl & 15)) << 4) + 4 * pr) = cvt_pk_bf16(va, vb); }
            }
        }
        f32x4 R[8], I[8];
#pragma unroll
        for (int mt = 0; mt < 8; ++mt) { R[mt] = (f32x4){0.f, 0.f, 0.f, 0.f}; I[mt] = (f32x4){0.f, 0.f, 0.f, 0.f};
#pragma unroll
            for (int ks = 0; ks < 2; ++ks) { const bf16x8 a = *(const LAS bf16x8*)(lds + MY_XA + (mt * 16 + fr) * RS + ((wave >> 2) * 64 + ks * 32 + 8 * grp) * 2);
                R[mt] = __builtin_amdgcn_mfma_f32_16x16x32_bf16(ks ? bw01 : bw00, a, R[mt], 0, 0, 0); I[mt] = __builtin_amdgcn_mfma_f32_16x16x32_bf16(ks ? bw11 : bw10, a, I[mt], 0, 0, 0); } }
#pragma unroll
        for (int mt = 0; mt < 8; ++mt) {
            const u32x2 xw = *(const LAS u32x2*)(lds + MY_XA + (mt * 16 + fr) * RS + (16 * wave + 4 * grp) * 2);
            const f32x4 xa4 = {bflo(xw.x), bfhi(xw.x), bflo(xw.y), bfhi(xw.y)};
            const f32x4 t1 = R[mt] * (-L2E) + nba, t2 = I[mt] * (-L2E) + nbi;
            f32x4 d1, d2, inv;
#pragma unroll
            for (int r = 0; r < 4; ++r) { d1[r] = 1.f + __builtin_amdgcn_exp2f(t1[r]); d2[r] = 1.f + __builtin_amdgcn_exp2f(t2[r]); }
            const f32x4 dd = d1 * d2;
#pragma unroll
            for (int r = 0; r < 4; ++r) inv[r] = __builtin_amdgcn_rcpf(dd[r]);
            const f32x4 rr = d2 * inv, ii = d1 * inv, la = rr * ksp, x2 = la + la;
            const f32x4 av = 1.f + la * (1.f + la * (0.5f + la * (0.16666667f + la * (0.041666667f + la * 0.0083333333f))));
            const f32x4 om = -x2 * (1.f + x2 * (0.5f + x2 * (0.16666667f + x2 * (0.041666667f + x2 * 0.0083333333f))));
            f32x4 uv;
#pragma unroll
            for (int r = 0; r < 4; ++r) uv[r] = __builtin_amdgcn_sqrtf(om[r]);
            uv = uv * ii * xa4;
#pragma unroll
            for (int r = 0; r < 4; ++r) { float A_ = av[r], U_ = uv[r]; MX_SCAN16(A_, U_); R[mt][r] = A_; I[mt][r] = U_; }
        }
        {
            f32x4 Pc = {1.f, 1.f, 1.f, 1.f}, Hc = {0.f, 0.f, 0.f, 0.f};
#pragma unroll
            for (int mt = 0; mt < 8; ++mt) { Hc = Hc * R[mt] + I[mt]; Pc = Pc * R[mt]; }
            if (fr == 15) {
#pragma unroll
                for (int r = 0; r < 4; ++r) __hip_atomic_store(AGG + (size_t)ck * 1024 + cch + r, ((unsigned long long)__float_as_uint(Hc[r]) << 32) | (unsigned long long)__float_as_uint(Pc[r]), __ATOMIC_RELAXED, __HIP_MEMORY_SCOPE_AGENT);
            }
        }
        __syncthreads();
        if (u + G < 1024) MX_PREFETCH(u + G);
        unsigned long long ag0 = 0x000000003f800000ull, ag1 = 0x000000003f800000ull, ag2 = 0x000000003f800000ull, ag3 = 0x000000003f800000ull;
        if (j > 0 && fr < j) { const unsigned long long* ap = AGG + (size_t)(ck - j + fr) * 1024 + cch;
            ag0 = __hip_atomic_load(ap, __ATOMIC_RELAXED, __HIP_MEMORY_SCOPE_AGENT); ag1 = __hip_atomic_load(ap + 1, __ATOMIC_RELAXED, __HIP_MEMORY_SCOPE_AGENT);
            ag2 = __hip_atomic_load(ap + 2, __ATOMIC_RELAXED, __HIP_MEMORY_SCOPE_AGENT); ag3 = __hip_atomic_load(ap + 3, __ATOMIC_RELAXED, __HIP_MEMORY_SCOPE_AGENT); }
        {
            bf16x8 q[4];
#pragma unroll
            for (int ks = 0; ks < 4; ++ks) q[ks] = *(const LAS bf16x8*)(lds + MY_VT + (16 * wave + fr) * 256 + (((ks * 4 + grp) ^ fr) << 4));
#pragma unroll
            for (int mt = 0; mt < 8; ++mt) { f32x4 Sx = {0.f, 0.f, 0.f, 0.f};
#pragma unroll
                for (int ks = 0; ks <= mt / 2; ++ks) { const bf16x8 p = *(const LAS bf16x8*)(lds + MY_WS + (mt * 16 + fr) * 256 + (((ks * 4 + grp) ^ fr) << 4));
                    Sx = __builtin_amdgcn_mfma_f32_16x16x32_bf16(q[ks], p, Sx, 0, 0, 0); }
                *(LAS u32x2*)(lds + MY_SP + (mt * 16 + fr) * RS + (16 * wave + 4 * grp) * 2) = (u32x2){cvt_pk_bf16_cv(Sx[0], Sx[1]), cvt_pk_bf16_cv(Sx[2], Sx[3])}; }
        }
        {
            f32x4 hc0 = {0.f, 0.f, 0.f, 0.f};
            if (j > 0) {
                f32x4 lp, lh; unsigned spin = 0;
                for (;;) {
                    lp[0] = __uint_as_float((unsigned)ag0); lh[0] = __uint_as_float((unsigned)(ag0 >> 32)); lp[1] = __uint_as_float((unsigned)ag1); lh[1] = __uint_as_float((unsigned)(ag1 >> 32));
                    lp[2] = __uint_as_float((unsigned)ag2); lh[2] = __uint_as_float((unsigned)(ag2 >> 32)); lp[3] = __uint_as_float((unsigned)ag3); lh[3] = __uint_as_float((unsigned)(ag3 >> 32));
                    const bool ok = (lp[0] != 0.f) && (lp[1] != 0.f) && (lp[2] != 0.f) && (lp[3] != 0.f);
                    if (__all(ok)) break;
                    if (++spin > (1u << 22)) break;
                    __builtin_amdgcn_s_sleep(1);
                    if (fr < j) { const unsigned long long* ap = AGG + (size_t)(ck - j + fr) * 1024 + cch;
                        ag0 = __hip_atomic_load(ap, __ATOMIC_RELAXED, __HIP_MEMORY_SCOPE_AGENT); ag1 = __hip_atomic_load(ap + 1, __ATOMIC_RELAXED, __HIP_MEMORY_SCOPE_AGENT);
                        ag2 = __hip_atomic_load(ap + 2, __ATOMIC_RELAXED, __HIP_MEMORY_SCOPE_AGENT); ag3 = __hip_atomic_load(ap + 3, __ATOMIC_RELAXED, __HIP_MEMORY_SCOPE_AGENT); } }
#pragma unroll
                for (int r = 0; r < 4; ++r) { float A_ = lp[r], U_ = lh[r]; MX_SCAN16(A_, U_); hc0[r] = __shfl(U_, (lane & 48) | 15); }
            }
            f32x4 s = hc0;
#pragma unroll
            for (int mt = 0; mt < 8; ++mt) { f32x4 hb;
#pragma unroll
                for (int r = 0; r < 4; ++r) hb[r] = __shfl(s[r], (lane & 48) | 15);
                s = R[mt] * s + I[mt];
                const f32x4 hv = I[mt] + R[mt] * hb;
                *(LAS u32x2*)(lds + MY_XA + (mt * 16 + fr) * RS + (16 * wave + 4 * grp) * 2) = (u32x2){cvt_pk_bf16(hv[0], hv[1]), cvt_pk_bf16(hv[2], hv[3])}; }
        }
        u32x4 ga[4], ub[4]; float bsr[4]; f32x4 nq0 = {0.f, 0.f, 0.f, 0.f}, nq1 = {0.f, 0.f, 0.f, 0.f};
        if (u + G < 1024) MX_STATS_LOAD(u + G, nq0, nq1);
#pragma unroll
        for (int it = 0; it < 4; ++it) { const int idx = it * 512 + tid, row = idx >> 4, ch = idx & 15; const unsigned o = ((unsigned)(t0 + row) * D + c0 + ch * 8) * 2u; ga[it] = *(const u32x4*)((const char*)GA + o); ub[it] = *(const u32x4*)((const char*)UB + o); bsr[it] = in[14][g * 128 + row]; }
        __syncthreads();
#pragma unroll
        for (int it = 0; it < 4; ++it) { const int idx = it * 512 + tid, row = idx >> 4, ch = idx & 15;
            f32x4 g0, g1, u0, u1, h0, h1, s0, s1; unpack8(ga[it], g0, g1); unpack8(ub[it], u0, u1);
            unpack8(*(const LAS u32x4*)(lds + MY_XA + row * RS + ch * 16), h0, h1); unpack8(*(const LAS u32x4*)(lds + MY_SP + row * RS + ch * 16), s0, s1);
            *(u32x4*)((char*)MG + ((unsigned)(t0 + row) * D + c0 + ch * 8) * 2u) = pack8(g0 * h0 + u0 * (s0 + bsr[it]), g1 * h1 + u1 * (s1 + bsr[it])); }
        if (u + G < 1024) MX_STATS_WRITE(nq0, nq1);
        __syncthreads();
    }
#undef MX_PREFETCH
#undef MX_STATS_LOAD
#undef MX_STATS_WRITE
#undef MX_ZR
#undef MX_SETZR
}

__device__ __forceinline__ void build_moe_units(LAS int* tab1, LAS int* tab2, LAS int* tab3, const int* CNT, int vcu, int G, int wave, LAS int* flags) {
    const int tid = wave * 64 + pg8::lane_id();
    int NT = 0, my_e = 0, my_tile = 0, my_cnt = 0, my_rt = 0;
    for (int e = 0; e < 32; ++e) { const int cnt = CNT[e]; const int ntl = (cnt + 255) >> 8;
        if (tid >= NT && tid < NT + ntl) { my_e = e; my_tile = tid - NT; my_cnt = cnt; my_rt = tid; }
        NT += ntl; }
    const bool have = tid < NT;
    const bool heavy = have && (my_cnt - my_tile * 256) > 128;
    flags[tid] = heavy ? 1 : 0;
    __syncthreads();
    int hb = 0, NH = 0;
    for (int i = 0; i < NT; ++i) { const int f = flags[i]; NH += f; hb += (i < tid) ? f : 0; }
    const int slot = heavy ? hb : NH + (tid - hb);
    const int U1 = 2 * NT, U2 = 4 * NT; int nlate = (U1 > G && U1 < 2 * G) ? U1 - G : 0; if (G - nlate < 64) nlate = 0;
    const int Ge = G - nlate, c2 = vcu - nlate, ssplit = nlate ? G / 2 : NT, Lsplit = 4 * ssplit;
    const int n1 = vcu < U1 ? (U1 - 1 - vcu) / G + 1 : 0;
    const int tot2 = (c2 >= 0 && c2 < U2) ? (U2 - 1 - c2) / Ge + 1 : 0;
    int n2 = (c2 >= 0 && c2 < Lsplit) ? (Lsplit - 1 - c2) / Ge + 1 : 0; n2 = n2 < tot2 ? n2 : tot2;
    const int n3 = tot2 - n2;
    if (tid == 0) { tab1[0] = n1 < 12 ? n1 : 12; tab2[0] = n2 < 12 ? n2 : 12; tab3[0] = n3 < 12 ? n3 : 12; }
    if (have) {
#pragma unroll
        for (int q = 0; q < 2; ++q) { const int L = 2 * slot + q; if (L % G == vcu && L / G < 12) { LAS int* p = tab1 + 4 + 8 * (L / G); p[0] = my_rt; p[1] = my_e * 2 + q; p[2] = my_e; p[3] = my_tile; p[4] = my_cnt; } }
        if (c2 >= 0) {
#pragma unroll
            for (int q = 0; q < 4; ++q) { const int L2 = 4 * slot + q; if (L2 % Ge == c2) { const int k = L2 / Ge; const bool early = slot < ssplit; const int idx = early ? k : k - n2;
                if (idx >= 0 && idx < 12) { LAS int* p = (early ? tab2 : tab3) + 4 + 8 * idx; p[0] = my_rt; p[1] = my_e * 4 + q; p[2] = my_e; p[3] = my_tile; p[4] = my_cnt; } } }
        }
    }
    __syncthreads();
}
__device__ __forceinline__ void moe_wait_tiles(const LAS int* tab, unsigned* dcnt, int wave) {
    if (wave == 0) {
        const int n = __builtin_amdgcn_readfirstlane(tab[0]);
        for (int i = 0; i < n; ++i) { const int rt = __builtin_amdgcn_readfirstlane(tab[4 + 8 * i]); unsigned sp = 0;
            while ((unsigned)__builtin_amdgcn_readfirstlane(__hip_atomic_load(dcnt + 64 * rt, __ATOMIC_RELAXED, __HIP_MEMORY_SCOPE_AGENT)) < 16u) { if (++sp > (1u << 22)) break; __builtin_amdgcn_s_sleep(2); } }
        __builtin_amdgcn_fence(__ATOMIC_ACQUIRE, "agent");
        asm volatile("s_waitcnt vmcnt(0)" ::: "memory");
    }
    __syncthreads();
}

struct Args { const float* in[28]; float* out; unsigned char* ws; int ph_lo, ph_hi, li, pad; };

__global__ void __launch_bounds__(NWAVES * 64, 2) mega_fwd(Args args) {
    extern __shared__ __attribute__((aligned(16))) unsigned char lds_raw[];
    LAS unsigned char* lds = (LAS unsigned char*)lds_raw;
    volatile LAS unsigned* MISC = (volatile LAS unsigned*)(lds + MISC_OFF);
    const int tid0 = threadIdx.x, wave = __builtin_amdgcn_readfirstlane(tid0 >> 6);
#define PHASE_IDS() int lane = pg8::lane_id(); asm volatile("" : "+v"(lane)); const int tid = wave * 64 + lane; (void)tid
    const int G = gridDim.x;
    const int vcu = (G % 8 == 0) ? ((int)blockIdx.x % 8) * (G / 8) + (int)blockIdx.x / 8 : (int)blockIdx.x;
    unsigned char* ws = args.ws;
    unsigned* ctl = (unsigned*)(ws + WS_CTL);
    for (int u = tid0; u < (LDS_BYTES - LDSCTL_OFF) / 4; u += NWAVES * 64) ((LAS unsigned*)(lds + LDSCTL_OFF))[u] = 0u;
    __syncthreads();
    XcdBarrier bar = xcd_barrier_post(ctl + CW_BAR + args.li * XCD_BAR_WORDS, MISC + 8, wave);
    const int lo = args.ph_lo, hi = args.ph_hi;
#define IN(k) (lo <= (k) && (k) < hi)
#define BOTH(k) (IN(k) && IN((k) + 1))
    const float* const* in = args.in;
    bf16 *XN = (bf16*)(ws + WS_A0), *MG = (bf16*)(ws + WS_A0), *X2b = (bf16*)(ws + WS_A0);
    bf16 *Zl = (bf16*)(ws + WS_A1), *X1b = (bf16*)(ws + WS_A1);
    bf16 *GA = (bf16*)(ws + WS_A2), *UB = (bf16*)(ws + WS_A3), *V = (bf16*)(ws + WS_A4);
    bf16 *X3 = (bf16*)(ws + WS_A1);
    bf16 *PU = (bf16*)(ws + WS_A2);
    bf16 *Pb = (bf16*)(ws + WS_PB);
    bf16 *WinT = (bf16*)(ws + WS_WIN), *WoutT = (bf16*)(ws + WS_WOUT), *WgT = (bf16*)(ws + WS_WG), *W13T = (bf16*)(ws + WS_W13), *W2T = (bf16*)(ws + WS_W2), *WupT = (bf16*)(ws + WS_WUP);
    float *VPART = (float*)(ws + WS_VPART), *SS1 = (float*)(ws + WS_SS1), *SS3 = (float*)(ws + WS_SS3), *RSTD2 = (float*)(ws + WS_RSTD2), *RSTD1 = (float*)(ws + WS_RSTD1), *TOKG = (float*)(ws + WS_TOKG);
    int *CNT = (int*)(ws + WS_CTL), *LIST = (int*)(ws + WS_LIST), *TOKE = (int*)(ws + WS_TOKE);
    bf16 *Hb = (bf16*)(ws + WS_A2), *Yb = (bf16*)(ws + WS_A3), *WrT = (bf16*)(ws + WS_WR), *WLRU = (bf16*)(ws + WS_WLRU), *WSGU = (bf16*)(ws + WS_WSGU);
    unsigned long long* AGGQ = (unsigned long long*)(ws + WS_AGG); float* SPL8 = (float*)(ws + WS_SPL8);

    if (IN(0)) {
        PHASE_IDS();
        LAS float* scr = (LAS float*)(lds + wave * 16384);
        const int gw = vcu * NWAVES + wave, NGW = G * NWAVES;
        for (int it = gw; it < 16 * 192; it += NGW) { const int kb = it / 192, nb = it % 192; p0_transpose_item(in[3], 6144, kb * 64, nb * 32, WinT, 1024, win_dest_row(nb * 32), nullptr, scr, lane); }
        for (int m = gw; m < T; m += 2 * NGW) {
            const int m2 = m + NGW < T ? m + NGW : m;
            const pg8::f32x4* xr = (const pg8::f32x4*)(in[0] + (size_t)m * D) + lane; const pg8::f32x4* xr2 = (const pg8::f32x4*)(in[0] + (size_t)m2 * D) + lane; const pg8::f32x4* gr = (const pg8::f32x4*)in[2] + lane;
            pg8::f32x4 v[4], w[4]; float s = 0.f, s2 = 0.f;
#pragma unroll
            for (int j = 0; j < 4; ++j) { v[j] = xr[64 * j]; w[j] = xr2[64 * j]; }
#pragma unroll
            for (int j = 0; j < 4; ++j) { s += (v[j].x * v[j].x + v[j].y * v[j].y) + (v[j].z * v[j].z + v[j].w * v[j].w); s2 += (w[j].x * w[j].x + w[j].y * w[j].y) + (w[j].z * w[j].z + w[j].w * w[j].w); }
            const float rstd = rsqrtf(wave_sum(s) * (1.f / D) + EPS), rstd2 = rsqrtf(wave_sum(s2) * (1.f / D) + EPS);
            unsigned long long* o8 = (unsigned long long*)(XN + (size_t)m * D) + lane; unsigned long long* o82 = (unsigned long long*)(XN + (size_t)m2 * D) + lane;
#pragma unroll
            for (int j = 0; j < 4; ++j) { const pg8::f32x4 gg = gr[64 * j];
                o8[64 * j] = (unsigned long long)pk2(v[j].x * rstd * gg.x, v[j].y * rstd * gg.y) | ((unsigned long long)pk2(v[j].z * rstd * gg.z, v[j].w * rstd * gg.w) << 32);
                o82[64 * j] = (unsigned long long)pk2(w[j].x * rstd2 * gg.x, w[j].y * rstd2 * gg.y) | ((unsigned long long)pk2(w[j].z * rstd2 * gg.z, w[j].w * rstd2 * gg.w) << 32); }
        }
        for (int i = vcu * 512 + tid; i < 2 * 16 * 64 * 64; i += G * 512) { const int gate = i >> 16, h = (i >> 12) & 15, j = (i >> 6) & 63, ii = i & 63;
            WLRU[i] = f2bf(in[gate ? 8 : 6][(h * 64 + ii) * 64 + j]); }
        for (int i = vcu * 512 + tid; i < 8 * 128 * 128; i += G * 512) { const int t = (i >> 7) & 127, s = i & 127; WSGU[i] = s <= t ? f2bf(in[13][i]) : (bf16)0; }
        for (int i = vcu * 512 + tid; i < 1024; i += G * 512) SPL8[i] = -8.f * log1pf(expf(-in[10][i]));
        for (int i = vcu * 512 + tid; i < 64 * 1024; i += G * 512) { const int n = i >> 10, k = i & 1023; float v = 0.f;
            if (n < 4) v = in[17][k * 4 + n] * in[16][k]; else if (n < 36) v = in[19][k * 32 + (n - 4)] * in[16][k];
            WrT[i] = f2bf(v); }
        if (BOTH(0)) xcd_barrier(bar);
    }
    if (IN(1)) {
        { pg8::Gemm g{XN, WinT, 1024}; Gemm1Order S; S.init(T, 6144, G, (int)blockIdx.x);
          S.wave = wave; S.w = DefW{args.in, ws};
          pg8::Epi1 E{Zl, GA, UB, V, VPART};
          pg8::gemm_phase<pg8::Epi1, Gemm1Order, true, true, false>(lds, g, S, E, wave); }
        if (BOTH(1)) xcd_barrier(bar);
    }

    if (IN(3)) {
        PHASE_IDS();
        mixer_phase(lds, vcu, G, tid, lane, wave, Zl, GA, UB, V, VPART, AGGQ, MG, WLRU, WSGU, SPL8, in);
        if (BOTH(3)) xcd_barrier(bar);
    }
    if (IN(4)) {
        pg8::Gemm g{MG, WoutT, 1024}; pg8::StaticOrder S; S.init(T, 1024, G, (int)blockIdx.x);
        pg8::Epi2 E{in[0], X1b, SS1};
        pg8::gemm_phase<pg8::Epi2, pg8::StaticOrder, true, true, false>(lds, g, S, E, wave);
        if (BOTH(4)) xcd_barrier(bar);
    }

    if (IN(5)) {
        PHASE_IDS();
        constexpr int RS = 528;
        LAS unsigned char* sA = lds; LAS unsigned char* sB = lds + 64 * RS; LAS float* sL = (LAS float*)(lds + 2 * 64 * RS);
        LAS int* sCnt = (LAS int*)(lds + 2 * 64 * RS + 64 * 65 * 4); LAS int* sBase = sCnt + 32;
        const int fr = lane & 15, grp = lane >> 4, mtile = wave & 3, np = wave >> 2;
        for (int tile = vcu; tile < T / 64; tile += G) {
            const int tok0 = tile * 64;
            if (tid < 32) sCnt[tid] = 0;
            pg8::f32x4 acc0 = {0.f, 0.f, 0.f, 0.f}, acc1 = {0.f, 0.f, 0.f, 0.f};
            for (int kc = 0; kc < 4; ++kc) {
#pragma unroll
                for (int it = 0; it < 4; ++it) { const int idx = it * 512 + tid, row = idx >> 5, ch = idx & 31;
                    *(LAS pg8::u32x4*)(sA + row * RS + ch * 16) = *(const pg8::u32x4*)(X1b + (size_t)(tok0 + row) * D + kc * 256 + ch * 8);
                    *(LAS pg8::u32x4*)(sB + row * RS + ch * 16) = *(const pg8::u32x4*)(WrT + (size_t)row * D + kc * 256 + ch * 8); }
                __syncthreads();
#pragma unroll
                for (int ks = 0; ks < 8; ++ks) {
                    const pg8::bf16x8 a = *(const LAS pg8::bf16x8*)(sA + (16 * mtile + fr) * RS + (ks * 32 + 8 * grp) * 2);
                    const pg8::bf16x8 b0 = *(const LAS pg8::bf16x8*)(sB + (32 * np + fr) * RS + (ks * 32 + 8 * grp) * 2);
                    const pg8::bf16x8 b1 = *(const LAS pg8::bf16x8*)(sB + (32 * np + 16 + fr) * RS + (ks * 32 + 8 * grp) * 2);
                    acc0 = __builtin_amdgcn_mfma_f32_16x16x32_bf16(a, b0, acc0, 0, 0, 0);
                    acc1 = __builtin_amdgcn_mfma_f32_16x16x32_bf16(a, b1, acc1, 0, 0, 0);
                }
                __syncthreads();
            }
#pragma unroll
            for (int r = 0; r < 4; ++r) { const int tk = 16 * mtile + 4 * grp + r; sL[tk * 65 + 32 * np + fr] = acc0[r]; sL[tk * 65 + 32 * np + 16 + fr] = acc1[r]; }
            __syncthreads();
            int e1 = 0, e2 = 0, r1 = 0, r2 = 0; float g1 = 0.f, g2 = 0.f;
            if (tid < 64) {
                const int t = tok0 + tid; float ss = 0.f;
#pragma unroll
                for (int q = 0; q < 16; ++q) ss += SS1[(size_t)t * 16 + q];
                const float rstd = rsqrtf(ss * (1.f / D) + EPS);
                RSTD1[t] = rstd;
                const LAS float* l = sL + tid * 65;
                float gl[4];
#pragma unroll
                for (int q = 0; q < 4; ++q) gl[q] = rstd * l[q] + in[18][q];
                float mx = gl[0]; int gi = 0;
#pragma unroll
                for (int q = 1; q < 4; ++q) if (gl[q] > mx) { mx = gl[q]; gi = q; }
                float den = 0.f;
#pragma unroll
                for (int q = 0; q < 4; ++q) den += expf(gl[q] - mx);
                const float gtop = 1.f / den;
                float m1 = -3.0e38f, m2 = -3.0e38f; int i1 = 0, i2 = 0;
                for (int j = 0; j < 8; ++j) { const float v = rstd * l[4 + gi * 8 + j] + in[20][gi * 8 + j];
                    if (v > m1) { m2 = m1; i2 = i1; m1 = v; i1 = j; } else if (v > m2) { m2 = v; i2 = j; } }
                const float p2 = expf(m2 - m1);
                g1 = gtop / (1.f + p2); g2 = gtop * p2 / (1.f + p2);
                e1 = gi * 8 + i1; e2 = gi * 8 + i2;
                r1 = __hip_atomic_fetch_add(&sCnt[e1], 1, __ATOMIC_RELAXED, __HIP_MEMORY_SCOPE_WORKGROUP); r2 = __hip_atomic_fetch_add(&sCnt[e2], 1, __ATOMIC_RELAXED, __HIP_MEMORY_SCOPE_WORKGROUP);
                TOKE[t * 2] = e1; TOKE[t * 2 + 1] = e2; TOKG[t * 2] = g1; TOKG[t * 2 + 1] = g2;
            }
            __syncthreads();
            if (tid < 32) { const int c = sCnt[tid]; sBase[tid] = c ? atomicAdd(&CNT[tid], c) : 0; }
            __syncthreads();
            if (tid < 64) { const int t = tok0 + tid; LIST[e1 * 16384 + sBase[e1] + r1] = t * 2; LIST[e2 * 16384 + sBase[e2] + r2] = t * 2 + 1; }
            __syncthreads();
        }
        if (BOTH(5)) xcd_barrier(bar);
    }
    if (IN(6)) {
        LAS int* tab1 = (LAS int*)(lds + TAB_OFF); LAS int* tab2 = (LAS int*)(lds + TAB_OFF + 512); LAS int* tab3 = (LAS int*)(lds + TAB_OFF + 1024);
        build_moe_units(tab1, tab2, tab3, CNT, vcu, G, wave, (LAS int*)lds);
        unsigned* dcnt = ctl + CW_DONE1;
        { pg8::Gemm g{X1b, W13T, 1024}; pg8::MoeOrder<1> S{tab1, LIST, dcnt};
          pg8::EpiMoe1 E{Hb, LIST, RSTD1};
          pg8::gemm_phase<pg8::EpiMoe1, pg8::MoeOrder<1>, true, true, true>(lds, g, S, E, wave); }
        pg8::Gemm g2{Hb, W2T, 256}; pg8::EpiMoe2 E2{Yb, LIST, TOKG};
        moe_wait_tiles(tab2, dcnt, wave);
        { pg8::MoeOrder<0> S{tab2, LIST, dcnt}; pg8::gemm_phase<pg8::EpiMoe2, pg8::MoeOrder<0>, true, true, false>(lds, g2, S, E2, wave); }
        moe_wait_tiles(tab3, dcnt, wave);
        { pg8::MoeOrder<0> S{tab3, LIST, dcnt}; pg8::gemm_phase<pg8::EpiMoe2, pg8::MoeOrder<0>, true, true, false>(lds, g2, S, E2, wave); }
        if (BOTH(6)) xcd_barrier(bar);
    }
    if (IN(8)) {
        PHASE_IDS();
        const int gw = vcu * NWAVES + wave, NGW = G * NWAVES;
        for (int row = gw; row < T; row += NGW) { float ss = 0.f;
#pragma unroll
            for (int hh = 0; hh < 2; ++hh) { const size_t o = (size_t)row * D + hh * 512 + lane * 8;
                pg8::f32x4 a0, a1, b0, b1, c0, c1; pg8::unpack8(*(const pg8::u32x4*)(X1b + o), a0, a1);
                pg8::unpack8(*(const pg8::u32x4*)(Yb + (size_t)row * 2 * D + hh * 512 + lane * 8), b0, b1); pg8::unpack8(*(const pg8::u32x4*)(Yb + ((size_t)row * 2 + 1) * D + hh * 512 + lane * 8), c0, c1);
                a0 = a0 + b0 + c0; a1 = a1 + b1 + c1;
                ss += (a0[0] * a0[0] + a0[1] * a0[1]) + (a0[2] * a0[2] + a0[3] * a0[3]) + (a1[0] * a1[0] + a1[1] * a1[1]) + (a1[2] * a1[2] + a1[3] * a1[3]);
                *(pg8::u32x4*)(X2b + o) = pg8::pack8(a0, a1); }
            ss = wave_sum(ss);
            if (lane == 0) RSTD2[row] = rsqrtf(ss * (1.f / D) + EPS); }
        if (BOTH(8)) xcd_barrier(bar);
    }
    const bool fuse_final = (G == 256);
    if (IN(9)) {
        { pg8::Gemm g{Pb, WupT, 256}; pg8::StaticOrder S; S.init(T, 1024, G, (int)blockIdx.x);
          pg8::EpiPlain E{PU};
          pg8::gemm_phase<pg8::EpiPlain, pg8::StaticOrder, true, true, false>(lds, g, S, E, wave); }
        pg8::Gemm g{X2b, WgT, 1024}; pg8::StaticOrder S; S.init(T, 1024, G, (int)blockIdx.x);
        if (fuse_final) {
            pg8::EpiPleFinal E{X2b, PU, RSTD2, in[27], args.out, (float*)(ws + WS_XCH), ctl + CW_PANEL, (LAS float*)(lds + RING_BYTES), wave};
            pg8::gemm_phase<pg8::EpiPleFinal, pg8::StaticOrder, true, true, false>(lds, g, S, E, wave);
        } else {
            pg8::EpiPle E{X2b, PU, RSTD2, X3, SS3};
            pg8::gemm_phase<pg8::EpiPle, pg8::StaticOrder, true, true, false>(lds, g, S, E, wave);
            if (BOTH(9)) xcd_barrier(bar);
        }
    }

    if (IN(10) && !fuse_final) {
        PHASE_IDS();
        const int gw = vcu * NWAVES + wave, NGW = G * NWAVES;
        for (int row = gw; row < T; row += NGW) { float ss = 0.f;
            if (lane < 16) ss = SS3[(size_t)row * 16 + lane];
            ss = wave_sum(ss);
            const float rstd = rsqrtf(ss * (1.f / D) + EPS);
#pragma unroll
            for (int hh = 0; hh < 2; ++hh) { const size_t o = (size_t)row * D + hh * 512 + lane * 8; pg8::f32x4 a0, a1; pg8::unpack8(*(const pg8::u32x4*)(X3 + o), a0, a1);
                const pg8::f32x4 f0 = *(const pg8::f32x4*)(in[27] + hh * 512 + lane * 8), f1 = *(const pg8::f32x4*)(in[27] + hh * 512 + lane * 8 + 4);
                *(pg8::f32x4*)(args.out + o) = a0 * rstd * f0; *(pg8::f32x4*)(args.out + o + 4) = a1 * rstd * f1; } }
    }
#undef IN
#undef BOTH
#undef PHASE_IDS
}

static int mega_grid() {
    static int grid = 0;
    if (grid == 0) {
        int dev = 0, cus = 0;
        if (hipGetDevice(&dev) != hipSuccess || hipDeviceGetAttribute(&cus, hipDeviceAttributeMultiprocessorCount, dev) != hipSuccess) { fprintf(stderr, "mega: device query failed\n"); grid = -1; return grid; }
        if (hipFuncSetAttribute((const void*)mega_fwd, hipFuncAttributeMaxDynamicSharedMemorySize, LDS_BYTES) != hipSuccess) { fprintf(stderr, "mega: hipFuncSetAttribute failed\n"); grid = -1; return grid; }
        (void)hipGetLastError();
        grid = cus;
    }
    return grid;
}
static void launch_mega(void* const* d_in, void* d_out, void* d_ws, int lo, int hi, int li, hipStream_t stream) {
    const int grid = mega_grid(); if (grid <= 0) return;
    Args a{};
    for (int i = 0; i < 28; ++i) a.in[i] = (const float*)d_in[i];
    a.out = (float*)d_out; a.ws = (unsigned char*)d_ws; a.ph_lo = lo; a.ph_hi = hi; a.li = li; a.pad = 0;
    hipLaunchKernelGGL(mega_fwd, dim3(grid), dim3(NWAVES * 64), LDS_BYTES, stream, a);
}

extern "C" void kernel_launch(void* const* d_in, const int* in_sizes, int n_in, void* d_out, int out_size, void* d_ws, size_t ws_size, hipStream_t stream) {
    if (n_in != 28 || in_sizes[0] != T * D || out_size != T * D || ws_size < WS_MEGA_END) { fprintf(stderr, "kernel_launch: unexpected shapes (n_in %d, ws %zu)\n", n_in, ws_size); return; }
    (void)hipMemsetAsync(d_ws, 0, 2 * MiB, stream);
    launch_mega(d_in, d_out, d_ws, 0, 11, 0, stream);
}
```

```cpp
#include <hip/hip_runtime.h>
#include <stdint.h>
#include <cstdio>

typedef unsigned short bf16;
constexpr int T = 16384, D = 1024, SEQ = 2048;
constexpr float EPS = 1e-6f;
constexpr size_t MiB = 1u << 20;
constexpr size_t WS_CTL = 0;
constexpr size_t WS_VPART = 2 * MiB;
constexpr size_t WS_SS1 = 4 * MiB;
constexpr size_t WS_SS3 = 5 * MiB;
constexpr size_t WS_AGG = 1 * MiB;
constexpr size_t WS_LIST = 6 * MiB;
constexpr size_t WS_TOKE = 8 * MiB;
constexpr size_t WS_TOKG = 8 * MiB + 128 * 1024;
constexpr size_t WS_RSTD2 = 8 * MiB + 256 * 1024;
constexpr size_t WS_A0 = 74 * MiB;
constexpr size_t WS_A1 = 106 * MiB;
constexpr size_t WS_A2 = 138 * MiB;
constexpr size_t WS_A3 = 170 * MiB;
constexpr size_t WS_A4 = 202 * MiB;
constexpr size_t WS_END = 234 * MiB;

__device__ __forceinline__ float bf2f(bf16 b) { return __uint_as_float(((unsigned)b) << 16); }
__device__ __forceinline__ bf16 f2bf(float f) { unsigned u = __float_as_uint(f); u += 0x7fffu + ((u >> 16) & 1u); return (bf16)(u >> 16); }
__device__ __forceinline__ float sigm(float x) { return 1.f / (1.f + expf(-x)); }
__device__ __forceinline__ float gelu_t(float x) { const float u = 0.7978845608028654f * (x + 0.044715f * x * x * x); return 0.5f * x * (1.f + tanhf(u)); }
__device__ __forceinline__ float wave_sum(float v) {
#pragma unroll
    for (int o = 1; o < 64; o <<= 1) v += __shfl_xor(v, o);
    return v;
}

#define LAS __attribute__((address_space(3)))
#define GAS __attribute__((address_space(1)))
namespace pg8 {
typedef short bf16x8 __attribute__((ext_vector_type(8)));
typedef float f32x4 __attribute__((ext_vector_type(4)));
typedef float f32x2 __attribute__((ext_vector_type(2)));
typedef unsigned u32x4 __attribute__((ext_vector_type(4)));
typedef unsigned u32x2 __attribute__((ext_vector_type(2)));
constexpr int BM = 256, BK = 64, HALF = 128, HTB = HALF * BK * 2, STAGE_BYTES = 8 * HTB, NXCD = 8, WGM = 8;

__host__ __device__ __forceinline__ int lds_byte(int r, int c) { const int st = (r >> 4) * 2 + (c >> 5), rr = r & 15, cc = c & 31, ob = rr * 64 + cc * 2; return st * 1024 + (ob ^ (((ob >> 9) & 1) << 5)); }
__host__ __device__ __forceinline__ void stage_rc(int b, int& R, int& C) { const int st = b / 1024, sb = b % 1024, swz = sb ^ (((sb >> 9) & 1) << 5); R = (st >> 1) * 16 + swz / 64; C = (st & 1) * 32 + (swz % 64) / 2; }
__host__ __device__ __forceinline__ int perm32(int rho) { const int n = rho >> 4, i = rho & 15; return 8 * (i >> 2) + 4 * n + (i & 3); }

__device__ __forceinline__ int lane_id() { int l; asm volatile("v_mbcnt_lo_u32_b32 %0, -1, 0\n\tv_mbcnt_hi_u32_b32 %0, -1, %0" : "=v"(l)); return l; }
struct Unit { int pm, pn, e, tile, cnt; };
struct Gemm { const bf16* A; const bf16* Bt; int K; };

struct StaticOrder {
    int nM, nN, nwg, G, c;
    __device__ void init(int M, int N, int G_, int c_) { nM = M / BM; nN = N / BM; nwg = nM * nN; G = G_; c = c_; }
    __device__ bool next(int i, Unit& u) const {
        const long L = (long)i * G + c; if (L >= nwg) return false;
        int wgid = (int)L; { const int q = nwg / NXCD, r = nwg % NXCD, xcd = wgid % NXCD, off = wgid / NXCD; wgid = (xcd < r ? xcd * (q + 1) : r * (q + 1) + (xcd - r) * q) + off; }
        const int nig = WGM * nN, gid = wgid / nig, fm = gid * WGM, gsz = (nM - fm) < WGM ? (nM - fm) : WGM;
        u.pm = fm + ((wgid % nig) % gsz); u.pn = (wgid % nig) / gsz; u.e = 0; u.tile = 0; u.cnt = 0; return true;
    }
    __device__ __forceinline__ unsigned row_off(const Unit&, int) const { return 0u; }
    __device__ __forceinline__ void a_ready(const Unit&) const {}
    __device__ __forceinline__ void done(const Unit&) const {}
    struct Pre {}; __device__ __forceinline__ void pre(int, Pre&) const {}
    __device__ __forceinline__ void post(int, Pre&) const {}
    __device__ __forceinline__ bool half(const Unit&) const { return false; }
};

__device__ __forceinline__ unsigned cvt_pk_bf16(float lo, float hi) { unsigned r; asm volatile("v_cvt_pk_bf16_f32 %0, %1, %2" : "=v"(r) : "v"(lo), "v"(hi)); return r; }
typedef __bf16 bf16x2_t __attribute__((ext_vector_type(2)));
__device__ __forceinline__ unsigned cvt_pk_bf16_cv(float lo, float hi) { const f32x2 v = {lo, hi}; const bf16x2_t b = __builtin_convertvector(v, bf16x2_t); return __builtin_bit_cast(unsigned, b); }
__device__ __forceinline__ float fsigm(float x) { return __builtin_amdgcn_rcpf(1.0f + __builtin_amdgcn_exp2f(-1.4426950409f * x)); }
__device__ __forceinline__ float fgelu(float x) { const float u = x + 0.044715f * x * x * x; return x * __builtin_amdgcn_rcpf(1.0f + __builtin_amdgcn_exp2f(-2.3022082f * u)); }

template <class Epi, class Sched, bool ALIGN_EPI, bool SP2, bool GATHER>
__device__ __forceinline__ void gemm_phase(LAS unsigned char* lds, const Gemm g, const Sched& S, const Epi& E, const int wave_) {
    int lane = lane_id(); asm volatile("" : "+v"(lane));
    const int wid = wave_, tid = wid * 64 + lane, wr = wid >> 2, wc = wid & 3, fr = lane & 15, fq = lane >> 4;
    const int K = g.K, nt = K / BK;
    int sR[2], sC[2];
    unsigned voffB[2], vA0[2], vA1[2], nvA0[2], nvA1[2];
#pragma unroll
    for (int i = 0; i < 2; ++i) { stage_rc(tid * 16 + i * 8192, sR[i], sC[i]); const int Rb = Epi::PERM ? ((sR[i] & ~31) + perm32(sR[i] & 31)) : sR[i];
        voffB[i] = (unsigned)(Rb * K + sC[i]) * 2u; vA0[i] = (unsigned)(sR[i] * K + sC[i]) * 2u; vA1[i] = vA0[i]; nvA0[i] = vA0[i]; nvA1[i] = vA0[i]; }
    const size_t kstep = (size_t)(BK * 2);
    const size_t hstep = (size_t)HALF * K * 2;
    const size_t tstep = 2 * hstep;
    const size_t ahs = GATHER ? 0 : hstep;
    const unsigned ldsw = (unsigned)wid * 1024u;
    const int aoff = lds_byte(wr * 64 + fr, fq * 8), boff = lds_byte(wc * 32 + fr, fq * 8);
#define PG8_SA(b, h) (((b) * 2 + (h)) * HTB)
#define PG8_SB(b, h) ((4 + (b) * 2 + (h)) * HTB)
#define PG8_STAGE(bufoff, gbase, voff) do { _Pragma("unroll") for (int _i = 0; _i < 2; ++_i) \
        __builtin_amdgcn_global_load_lds((const unsigned*)((const char*)(gbase) + (voff)[_i]), (LAS unsigned*)(lds + (bufoff) + ldsw + _i * 8192), 16, 0, 0); } while (0)
#define PG8_LDA(dst, b, h) do { _Pragma("unroll") for (int m = 0; m < 4; ++m) _Pragma("unroll") for (int k = 0; k < 2; ++k) dst[m][k] = *(const LAS bf16x8*)(lds + PG8_SA(b, h) + aoff + m * 2048 + k * 1024); } while (0)
#define PG8_LDB(dst, b, h) do { _Pragma("unroll") for (int n = 0; n < 2; ++n) _Pragma("unroll") for (int k = 0; k < 2; ++k) dst[n][k] = *(const LAS bf16x8*)(lds + PG8_SB(b, h) + boff + n * 2048 + k * 1024); } while (0)
#define PG8_MMA(ai, bj, At, Bt) do { __builtin_amdgcn_s_setprio(1); _Pragma("unroll") for (int m = 0; m < 4; ++m) _Pragma("unroll") for (int n = 0; n < 2; ++n) _Pragma("unroll") for (int k = 0; k < 2; ++k) \
        acc[ai][bj][m][n] = __builtin_amdgcn_mfma_f32_16x16x32_bf16(Bt[n][k], At[m][k], acc[ai][bj][m][n], 0, 0, 0); __builtin_amdgcn_s_setprio(0); } while (0)
#define PG8_WAIT_V(n) asm volatile("s_waitcnt vmcnt(" #n ")" ::: "memory")
#define PG8_WAIT_L(n) asm volatile("s_waitcnt lgkmcnt(" #n ")" ::: "memory")
#define PG8_BAR __builtin_amdgcn_s_barrier()
#define PG8_SCHED __builtin_amdgcn_sched_barrier(0)
    Unit cur, nxt; int ui = 0;
    if (!S.next(0, cur)) return;
    f32x4 acc[2][2][4][2];
#pragma unroll
    for (int a = 0; a < 2; ++a)
#pragma unroll
        for (int b = 0; b < 2; ++b)
#pragma unroll
            for (int m = 0; m < 4; ++m)
#pragma unroll
                for (int n = 0; n < 2; ++n) acc[a][b][m][n] = (f32x4){0.f, 0.f, 0.f, 0.f};
    bf16x8 At[4][2], B0[2][2], B1[2][2];
    const char* cA = GATHER ? (const char*)g.A : (const char*)g.A + (size_t)cur.pm * tstep; const char* cB = (const char*)g.Bt + (size_t)cur.pn * tstep;
    if constexpr (GATHER) {
#pragma unroll
        for (int i = 0; i < 2; ++i) { vA0[i] = S.row_off(cur, sR[i]) + (unsigned)sC[i] * 2u; vA1[i] = S.row_off(cur, HALF + sR[i]) + (unsigned)sC[i] * 2u; nvA0[i] = vA0[i]; nvA1[i] = vA1[i]; }
    }
    S.a_ready(cur);
    if constexpr (SP2) {
        PG8_STAGE(PG8_SB(0, 0), cB, voffB); PG8_STAGE(PG8_SB(0, 1), cB + hstep, voffB); PG8_STAGE(PG8_SA(0, 0), cA, vA0); PG8_STAGE(PG8_SA(0, 1), cA + ahs, vA1);
        if (wr == 1) PG8_BAR;
        PG8_WAIT_V(2); PG8_BAR;
        PG8_STAGE(PG8_SB(1, 0), cB + kstep, voffB); PG8_STAGE(PG8_SA(1, 0), cA + kstep, vA0); PG8_STAGE(PG8_SB(1, 1), cB + hstep + kstep, voffB);
        PG8_WAIT_V(6); PG8_BAR;
    } else {
        PG8_STAGE(PG8_SB(0, 0), cB, voffB); PG8_STAGE(PG8_SA(0, 0), cA, vA0); PG8_STAGE(PG8_SB(0, 1), cB + hstep, voffB); PG8_STAGE(PG8_SA(0, 1), cA + ahs, vA1);
        if (wr == 1) PG8_BAR;
        PG8_WAIT_V(4); PG8_BAR;
        PG8_STAGE(PG8_SB(1, 0), cB + kstep, voffB); PG8_STAGE(PG8_SA(1, 0), cA + kstep, vA0); PG8_STAGE(PG8_SB(1, 1), cB + hstep + kstep, voffB);
        PG8_WAIT_V(6); PG8_BAR;
    }
    for (;;) {
        const bool has_next = S.next(ui + 1, nxt);
        const char* nA = has_next ? (GATHER ? (const char*)g.A : (const char*)g.A + (size_t)nxt.pm * tstep) : cA; const char* nB = has_next ? (const char*)g.Bt + (size_t)nxt.pn * tstep : cB;
        const bool hf = S.half(cur);
        for (int t = 0; t < nt; t += 2) {
            const bool last = (t == nt - 2);
            const char* a1 = cA + (size_t)(t + 1) * kstep;
            const char* a2 = last ? nA : cA + (size_t)(t + 2) * kstep; const char* b2 = last ? nB : cB + (size_t)(t + 2) * kstep;
            const char* a3 = a2 + kstep; const char* b3 = b2 + kstep;
            if (last && has_next) S.a_ready(nxt);
            unsigned w0[2], w1[2];
            if constexpr (GATHER) {
                if (last && has_next) {
#pragma unroll
                    for (int i = 0; i < 2; ++i) { nvA0[i] = S.row_off(nxt, sR[i]) + (unsigned)sC[i] * 2u; nvA1[i] = S.row_off(nxt, HALF + sR[i]) + (unsigned)sC[i] * 2u; }
                }
#pragma unroll
                for (int i = 0; i < 2; ++i) { w0[i] = last ? nvA0[i] : vA0[i]; w1[i] = last ? nvA1[i] : vA1[i]; }
            } else {
#pragma unroll
                for (int i = 0; i < 2; ++i) { w0[i] = vA0[i]; w1[i] = vA0[i]; }
            }
            if constexpr (SP2) {
            PG8_LDB(B0, 0, 0); PG8_LDB(B1, 0, 1); PG8_SCHED; PG8_LDA(At, 0, 0); PG8_STAGE(PG8_SA(1, 1), a1 + ahs, vA1);
            PG8_WAIT_V(8); PG8_WAIT_L(0); PG8_BAR; PG8_MMA(0, 0, At, B0); PG8_MMA(0, 1, At, B1); PG8_BAR; PG8_SCHED;
            if (!hf) PG8_LDA(At, 0, 1); PG8_STAGE(PG8_SB(0, 0), b2, voffB); PG8_STAGE(PG8_SB(0, 1), b2 + hstep, voffB); PG8_STAGE(PG8_SA(0, 0), a2, w0);
            PG8_WAIT_V(8); PG8_WAIT_L(0); PG8_BAR; if (!hf) { PG8_MMA(1, 0, At, B0); PG8_MMA(1, 1, At, B1); } PG8_BAR; PG8_SCHED;
            PG8_LDB(B0, 1, 0); PG8_LDB(B1, 1, 1); PG8_SCHED; PG8_LDA(At, 1, 0); PG8_STAGE(PG8_SA(0, 1), a2 + ahs, w1);
            PG8_WAIT_V(8); PG8_WAIT_L(0); PG8_BAR; PG8_MMA(0, 0, At, B0); PG8_MMA(0, 1, At, B1); PG8_BAR; PG8_SCHED;
            if (!hf) PG8_LDA(At, 1, 1); PG8_STAGE(PG8_SB(1, 0), b3, voffB); PG8_STAGE(PG8_SB(1, 1), b3 + hstep, voffB); PG8_STAGE(PG8_SA(1, 0), a3, w0);
            PG8_WAIT_V(8); PG8_WAIT_L(0); PG8_BAR; if (!hf) { PG8_MMA(1, 0, At, B0); PG8_MMA(1, 1, At, B1); } PG8_BAR; PG8_SCHED;
            } else {
            PG8_LDB(B0, 0, 0); PG8_SCHED; PG8_LDA(At, 0, 0); PG8_STAGE(PG8_SA(1, 1), a1 + ahs, vA1);
            PG8_WAIT_L(8); PG8_BAR; PG8_WAIT_L(0); PG8_MMA(0, 0, At, B0); PG8_BAR; PG8_SCHED;
            PG8_LDB(B1, 0, 1); PG8_STAGE(PG8_SB(0, 0), b2, voffB);
            PG8_BAR; PG8_WAIT_L(0); PG8_MMA(0, 1, At, B1); PG8_BAR;
            PG8_LDA(At, 0, 1); PG8_STAGE(PG8_SA(0, 0), a2, w0);
            PG8_BAR; PG8_WAIT_L(0); PG8_MMA(1, 0, At, B0); PG8_BAR; PG8_SCHED;
            PG8_STAGE(PG8_SB(0, 1), b2 + hstep, voffB);
            PG8_WAIT_V(6); PG8_BAR; PG8_MMA(1, 1, At, B1); PG8_BAR;
            PG8_LDB(B0, 1, 0); PG8_SCHED; PG8_LDA(At, 1, 0); PG8_STAGE(PG8_SA(0, 1), a2 + ahs, w1);
            PG8_WAIT_L(8); PG8_BAR; PG8_WAIT_L(0); PG8_MMA(0, 0, At, B0); PG8_BAR; PG8_SCHED;
            PG8_LDB(B1, 1, 1); PG8_STAGE(PG8_SB(1, 0), b3, voffB);
            PG8_BAR; PG8_WAIT_L(0); PG8_MMA(0, 1, At, B1); PG8_BAR;
            PG8_LDA(At, 1, 1); PG8_STAGE(PG8_SA(1, 0), a3, w0);
            PG8_BAR; PG8_WAIT_L(0); PG8_MMA(1, 0, At, B0); PG8_BAR; PG8_SCHED;
            PG8_STAGE(PG8_SB(1, 1), b3 + hstep, voffB);
            PG8_WAIT_V(6); PG8_BAR; PG8_MMA(1, 1, At, B1); PG8_BAR;
            }
        }
        typename Sched::Pre pre_; S.pre(ui, pre_);
        if constexpr (ALIGN_EPI) { if (wr == 0) PG8_BAR; }
        E(acc, cur, wr, wc, fr, fq); S.done(cur); S.post(ui, pre_);
        if (!has_next) break;
#pragma unroll
        for (int a = 0; a < 2; ++a)
#pragma unroll
            for (int b = 0; b < 2; ++b)
#pragma unroll
                for (int m = 0; m < 4; ++m)
#pragma unroll
                    for (int n = 0; n < 2; ++n) acc[a][b][m][n] = (f32x4){0.f, 0.f, 0.f, 0.f};
        cur = nxt; cA = nA; cB = nB; ++ui;
        if constexpr (GATHER) {
#pragma unroll
            for (int i = 0; i < 2; ++i) { vA0[i] = nvA0[i]; vA1[i] = nvA1[i]; }
        }
        if constexpr (ALIGN_EPI) { if (wr == 1) PG8_BAR; }
    }
    PG8_WAIT_V(0);
    if constexpr (!ALIGN_EPI) { if (wr == 0) PG8_BAR; }
    PG8_BAR;
#undef PG8_SA
#undef PG8_SB
#undef PG8_STAGE
#undef PG8_LDA
#undef PG8_LDB
#undef PG8_MMA
#undef PG8_WAIT_V
#undef PG8_WAIT_L
#undef PG8_BAR
#undef PG8_SCHED
}

__device__ __forceinline__ u32x4 pack8(const f32x4 v0, const f32x4 v1) { u32x4 w; w.x = cvt_pk_bf16(v0[0], v0[1]); w.y = cvt_pk_bf16(v0[2], v0[3]); w.z = cvt_pk_bf16(v1[0], v1[1]); w.w = cvt_pk_bf16(v1[2], v1[3]); return w; }
__device__ __forceinline__ void unpack8(const u32x4 w, f32x4& v0, f32x4& v1) {
    v0[0] = __uint_as_float(w.x << 16); v0[1] = __uint_as_float(w.x & 0xffff0000u); v0[2] = __uint_as_float(w.y << 16); v0[3] = __uint_as_float(w.y & 0xffff0000u);
    v1[0] = __uint_as_float(w.z << 16); v1[1] = __uint_as_float(w.z & 0xffff0000u); v1[2] = __uint_as_float(w.w << 16); v1[3] = __uint_as_float(w.w & 0xffff0000u); }

struct Epi1 {
    static constexpr bool PERM = true;
    bf16 *Zl, *GA, *UB, *V; float* VPART;
    __device__ __forceinline__ void operator()(const f32x4 (&acc)[2][2][4][2], const Unit& u, int wr, int wc, int fr, int fq) const {
        const int row0 = u.pm * BM + wr * 64 + fr, pn = u.pn;
        if (pn < 4) {
            const int col0 = pn * 256 + wc * 32 + 8 * fq;
#pragma unroll
            for (int ai = 0; ai < 2; ++ai)
#pragma unroll
                for (int m = 0; m < 4; ++m) { bf16* rowp = Zl + (size_t)(row0 + ai * HALF + m * 16) * D + col0;
#pragma unroll
                    for (int bj = 0; bj < 2; ++bj) *(u32x4*)(rowp + bj * HALF) = pack8(acc[ai][bj][m][0], acc[ai][bj][m][1]); }
        } else if (pn < 20) {
            bf16* O = pn < 12 ? GA : UB; const int uu = pn < 12 ? pn - 4 : pn - 12; const int col0 = uu * 128 + wc * 32 + 8 * fq;
#pragma unroll
            for (int ai = 0; ai < 2; ++ai)
#pragma unroll
                for (int m = 0; m < 4; ++m) { f32x4 v[2];
#pragma unroll
                    for (int n = 0; n < 2; ++n)
#pragma unroll
                        for (int i = 0; i < 4; ++i) v[n][i] = fgelu(acc[ai][0][m][n][i]) * fsigm(acc[ai][1][m][n][i]);
                    *(u32x4*)(O + (size_t)(row0 + ai * HALF + m * 16) * D + col0) = pack8(v[0], v[1]); }
        } else {
            const int col0 = (pn - 20) * 256 + wc * 32 + 8 * fq;
#pragma unroll
            for (int ai = 0; ai < 2; ++ai)
#pragma unroll
                for (int m = 0; m < 4; ++m) { const int row = row0 + ai * HALF + m * 16; float s1 = 0.f, s2 = 0.f;
#pragma unroll
                    for (int bj = 0; bj < 2; ++bj) { f32x4 v[2];
#pragma unroll
                        for (int n = 0; n < 2; ++n)
#pragma unroll
                            for (int i = 0; i < 4; ++i) { const float gv = fgelu(acc[ai][bj][m][n][i]); v[n][i] = gv; s1 += gv; s2 += gv * gv; }
                        *(u32x4*)(V + (size_t)row * D + col0 + bj * HALF) = pack8(v[0], v[1]); }
                    s1 += __shfl_xor(s1, 16); s1 += __shfl_xor(s1, 32); s2 += __shfl_xor(s2, 16); s2 += __shfl_xor(s2, 32);
                    if (fq == 0) *(f32x2*)(VPART + (size_t)row * 32 + ((pn - 20) * 4 + wc) * 2) = (f32x2){s1, s2}; }
        }
    }
};
struct EpiPlain {
    static constexpr bool PERM = true;
    bf16* O;
    __device__ __forceinline__ void operator()(const f32x4 (&acc)[2][2][4][2], const Unit& u, int wr, int wc, int fr, int fq) const {
        const int row0 = u.pm * BM + wr * 64 + fr, col0 = u.pn * 256 + wc * 32 + 8 * fq;
#pragma unroll
        for (int ai = 0; ai < 2; ++ai)
#pragma unroll
            for (int m = 0; m < 4; ++m) { bf16* rowp = O + (size_t)(row0 + ai * HALF + m * 16) * D + col0;
#pragma unroll
                for (int bj = 0; bj < 2; ++bj) *(u32x4*)(rowp + bj * HALF) = pack8(acc[ai][bj][m][0], acc[ai][bj][m][1]); }
    }
};
struct Epi2 {
    static constexpr bool PERM = true;
    const float* x; bf16* X1b; float* SS1;
    __device__ __forceinline__ void operator()(const f32x4 (&acc)[2][2][4][2], const Unit& u, int wr, int wc, int fr, int fq) const {
        const int row0 = u.pm * BM + wr * 64 + fr, col0 = u.pn * 256 + wc * 32 + 8 * fq;
#pragma unroll
        for (int ai = 0; ai < 2; ++ai)
#pragma unroll
            for (int m = 0; m < 4; ++m) { const int row = row0 + ai * HALF + m * 16; float ss = 0.f;
#pragma unroll
                for (int bj = 0; bj < 2; ++bj) { const float* xp = x + (size_t)row * D + col0 + bj * HALF;
                    const f32x4 v0 = acc[ai][bj][m][0] + __builtin_nontemporal_load((const f32x4*)xp), v1 = acc[ai][bj][m][1] + __builtin_nontemporal_load((const f32x4*)(xp + 4));
                    ss += (v0[0] * v0[0] + v0[1] * v0[1]) + (v0[2] * v0[2] + v0[3] * v0[3]) + (v1[0] * v1[0] + v1[1] * v1[1]) + (v1[2] * v1[2] + v1[3] * v1[3]);
                    *(u32x4*)(X1b + (size_t)row * D + col0 + bj * HALF) = pack8(v0, v1); }
                ss += __shfl_xor(ss, 16); ss += __shfl_xor(ss, 32);
                if (fq == 0) SS1[(size_t)row * 16 + u.pn * 4 + wc] = ss; }
    }
};
struct EpiPle {
    static constexpr bool PERM = true;
    const bf16* X2b; const bf16* PU; const float* RSTD2; bf16* X3; float* SS3;
    __device__ __forceinline__ void operator()(const f32x4 (&acc)[2][2][4][2], const Unit& u, int wr, int wc, int fr, int fq) const {
        const int row0 = u.pm * BM + wr * 64 + fr, col0 = u.pn * 256 + wc * 32 + 8 * fq;
#pragma unroll
        for (int ai = 0; ai < 2; ++ai)
#pragma unroll
            for (int m = 0; m < 4; ++m) { const int row = row0 + ai * HALF + m * 16; float ss = 0.f; const float r2 = RSTD2[row];
#pragma unroll
                for (int bj = 0; bj < 2; ++bj) { const size_t o = (size_t)row * D + col0 + bj * HALF;
                    f32x4 x0, x1, p0, p1; unpack8(*(const u32x4*)(X2b + o), x0, x1); unpack8(*(const u32x4*)(PU + o), p0, p1);
                    f32x4 v0, v1;
#pragma unroll
                    for (int i = 0; i < 4; ++i) { v0[i] = x0[i] + fsigm(r2 * acc[ai][bj][m][0][i]) * p0[i]; v1[i] = x1[i] + fsigm(r2 * acc[ai][bj][m][1][i]) * p1[i]; }
                    ss += (v0[0] * v0[0] + v0[1] * v0[1]) + (v0[2] * v0[2] + v0[3] * v0[3]) + (v1[0] * v1[0] + v1[1] * v1[1]) + (v1[2] * v1[2] + v1[3] * v1[3]);
                    *(u32x4*)(X3 + o) = pack8(v0, v1); }
                ss += __shfl_xor(ss, 16); ss += __shfl_xor(ss, 32);
                if (fq == 0) SS3[(size_t)row * 16 + u.pn * 4 + wc] = ss; }
    }
};

struct EpiPleFinal {
    static constexpr bool PERM = true;
    const bf16* X2b; const bf16* PU; const float* RSTD2; const float* fn; float* out; float* XCH; unsigned* cnt; LAS float* xl; int wave;
    __device__ __forceinline__ void operator()(f32x4 (&acc)[2][2][4][2], const Unit& u, int wr, int wc, int fr, int fq) const {
        const int tid = wave * 64 + lane_id();
        const int rl0 = wr * 64 + fr, col0 = u.pn * 256 + wc * 32 + 8 * fq;
#pragma unroll
        for (int ai = 0; ai < 2; ++ai)
#pragma unroll
            for (int m = 0; m < 4; ++m) { const int rl = rl0 + ai * HALF + m * 16, row = u.pm * BM + rl; float ss = 0.f; const float r2 = RSTD2[row];
#pragma unroll
                for (int bj = 0; bj < 2; ++bj) { const size_t o = (size_t)row * D + col0 + bj * HALF;
                    f32x4 x0, x1, p0, p1; unpack8(*(const u32x4*)(X2b + o), x0, x1); unpack8(*(const u32x4*)(PU + o), p0, p1);
                    f32x4 v0, v1;
#pragma unroll
                    for (int i = 0; i < 4; ++i) { v0[i] = x0[i] + fsigm(r2 * acc[ai][bj][m][0][i]) * p0[i]; v1[i] = x1[i] + fsigm(r2 * acc[ai][bj][m][1][i]) * p1[i]; }
                    ss += (v0[0] * v0[0] + v0[1] * v0[1]) + (v0[2] * v0[2] + v0[3] * v0[3]) + (v1[0] * v1[0] + v1[1] * v1[1]) + (v1[2] * v1[2] + v1[3] * v1[3]);
                    acc[ai][bj][m][0] = v0; acc[ai][bj][m][1] = v1; }
                ss += __shfl_xor(ss, 16); ss += __shfl_xor(ss, 32);
                if (fq == 0) xl[rl * 4 + wc] = ss; }
        __syncthreads();
        if (tid < 256) { const f32x4 p = *(const LAS f32x4*)(xl + tid * 4);
            __hip_atomic_store(XCH + (size_t)(u.pm * BM + tid) * 4 + u.pn, (p[0] + p[1]) + (p[2] + p[3]), __ATOMIC_RELAXED, __HIP_MEMORY_SCOPE_AGENT); }
        asm volatile("s_waitcnt vmcnt(0)" ::: "memory");
        if (tid < 256 && (tid & 63) == 0) __hip_atomic_fetch_add(cnt + 64 * u.pm, 1u, __ATOMIC_RELAXED, __HIP_MEMORY_SCOPE_AGENT);
        if (tid < 64) { unsigned sp = 0;
            while ((unsigned)__builtin_amdgcn_readfirstlane(__hip_atomic_load(cnt + 64 * u.pm, __ATOMIC_RELAXED, __HIP_MEMORY_SCOPE_AGENT)) < 16u) { if (++sp > (1u << 22)) break; __builtin_amdgcn_s_sleep(1); } }
        __syncthreads();
        if (tid < 256) { const float* xs = XCH + (size_t)(u.pm * BM + tid) * 4; float tot = 0.f;
#pragma unroll
            for (int q = 0; q < 4; ++q) tot += __hip_atomic_load(xs + q, __ATOMIC_RELAXED, __HIP_MEMORY_SCOPE_AGENT);
            xl[1024 + tid] = rsqrtf(tot * (1.f / D) + EPS); }
        __syncthreads();
#pragma unroll
        for (int ai = 0; ai < 2; ++ai)
#pragma unroll
            for (int m = 0; m < 4; ++m) { const int rl = rl0 + ai * HALF + m * 16; const float rs = xl[1024 + rl]; float* op = out + (size_t)(u.pm * BM + rl) * D + col0;
#pragma unroll
                for (int bj = 0; bj < 2; ++bj) { const f32x4 f0 = *(const f32x4*)(fn + col0 + bj * HALF), f1 = *(const f32x4*)(fn + col0 + bj * HALF + 4);
                    *(f32x4*)(op + bj * HALF) = acc[ai][bj][m][0] * rs * f0; *(f32x4*)(op + bj * HALF + 4) = acc[ai][bj][m][1] * rs * f1; } }
    }
};

template <int MODE> struct MoeOrder {
    const LAS int* tab; const int* LIST; unsigned* dcnt;
    __device__ __forceinline__ bool next(int i, Unit& u) const {
        const int n = __builtin_amdgcn_readfirstlane(tab[0]); if (i >= n) return false;
        const LAS int* p = tab + 4 + 8 * i;
        u.pm = __builtin_amdgcn_readfirstlane(p[0]); u.pn = __builtin_amdgcn_readfirstlane(p[1]); u.e = __builtin_amdgcn_readfirstlane(p[2]);
        u.tile = __builtin_amdgcn_readfirstlane(p[3]); u.cnt = __builtin_amdgcn_readfirstlane(p[4]); return true;
    }
    __device__ __forceinline__ unsigned row_off(const Unit& u, int r) const { int idx = u.tile * 256 + r; idx = idx < u.cnt ? idx : u.cnt - 1; const int pair = LIST[u.e * 16384 + idx]; return (unsigned)(pair >> 1) * 2048u; }
    __device__ __forceinline__ void a_ready(const Unit&) const {}
    struct Pre {}; __device__ __forceinline__ void pre(int, Pre&) const {}
    __device__ __forceinline__ void post(int, Pre&) const {}
    __device__ __forceinline__ bool half(const Unit& u) const { return MODE == 1 && (u.cnt - u.tile * 256) <= 128; }
    __device__ __forceinline__ void done(const Unit& u) const {
        if constexpr (MODE == 1) {
            asm volatile("s_waitcnt vmcnt(0)" ::: "memory");
            if (lane_id() == 0) __hip_atomic_fetch_add(dcnt + 64 * u.pm, 1u, __ATOMIC_RELAXED, __HIP_MEMORY_SCOPE_AGENT);
        }
    }
};
__device__ __forceinline__ void store16_sc1(void* p, u32x4 v) { asm volatile("global_store_dwordx4 %0, %1, off sc1\n\ts_nop 1" :: "v"(p), "v"(v) : "memory"); }
struct EpiMoe1 {
    static constexpr bool PERM = true;
    bf16* H; const int* LIST; const float* RSTD1;
    __device__ __forceinline__ void operator()(const f32x4 (&acc)[2][2][4][2], const Unit& u, int wr, int wc, int fr, int fq) const {
        const int col0 = (u.pn & 1) * 128 + wc * 32 + 8 * fq;
#pragma unroll
        for (int ai = 0; ai < 2; ++ai)
#pragma unroll
            for (int m = 0; m < 4; ++m) { const int r = ai * HALF + wr * 64 + m * 16 + fr; int idx = u.tile * 256 + r; idx = idx < u.cnt ? idx : u.cnt - 1;
                const int pair = LIST[u.e * 16384 + idx]; const float rs = RSTD1[pair >> 1]; f32x4 v[2];
#pragma unroll
                for (int n = 0; n < 2; ++n)
#pragma unroll
                    for (int i = 0; i < 4; ++i) { const float a1 = rs * acc[ai][0][m][n][i], a3 = rs * acc[ai][1][m][n][i]; v[n][i] = a1 * fsigm(a1) * a3; }
                store16_sc1(H + (size_t)(u.pm * 256 + r) * 256 + col0, pack8(v[0], v[1])); }
    }
};
struct EpiMoe2 {
    static constexpr bool PERM = true;
    bf16* Y; const int* LIST; const float* TOKG;
    __device__ __forceinline__ void operator()(const f32x4 (&acc)[2][2][4][2], const Unit& u, int wr, int wc, int fr, int fq) const {
        const int col0 = (u.pn & 3) * 256 + wc * 32 + 8 * fq;
        int pr[2][4]; float gt[2][4];
#pragma unroll
        for (int ai = 0; ai < 2; ++ai)
#pragma unroll
            for (int m = 0; m < 4; ++m) { int idx = u.tile * 256 + ai * HALF + wr * 64 + m * 16 + fr; idx = idx < u.cnt ? idx : u.cnt - 1; pr[ai][m] = LIST[u.e * 16384 + idx]; }
#pragma unroll
        for (int ai = 0; ai < 2; ++ai)
#pragma unroll
            for (int m = 0; m < 4; ++m) gt[ai][m] = TOKG[pr[ai][m]];
#pragma unroll
        for (int ai = 0; ai < 2; ++ai)
#pragma unroll
            for (int m = 0; m < 4; ++m) { const int idx = u.tile * 256 + ai * HALF + wr * 64 + m * 16 + fr;
                if (idx < u.cnt) { const float g = gt[ai][m]; bf16* yp = Y + (size_t)pr[ai][m] * D + col0;
#pragma unroll
                    for (int bj = 0; bj < 2; ++bj) *(u32x4*)(yp + bj * HALF) = pack8(acc[ai][bj][m][0] * g, acc[ai][bj][m][1] * g); } }
    }
};
}

constexpr int NWAVES = 8;
constexpr int RING_BYTES = 131072, LDSCTL_OFF = 139264, MISC_OFF = LDSCTL_OFF + 320, TAB_OFF = LDSCTL_OFF + 512, LDS_BYTES = 147456;
constexpr size_t WS_WLRU = 8 * MiB + 512 * 1024;
constexpr size_t WS_WSGU = 8 * MiB + 768 * 1024;
constexpr size_t WS_WR = 9 * MiB;
constexpr size_t WS_WUP = 9 * MiB + 512 * 1024;
constexpr size_t WS_WIN = 10 * MiB;
constexpr size_t WS_WOUT = 22 * MiB;
constexpr size_t WS_WG = 24 * MiB;
constexpr size_t WS_W13 = 26 * MiB;
constexpr size_t WS_W2 = 58 * MiB;
constexpr size_t WS_PB = 234 * MiB;
constexpr size_t WS_RSTD1 = 242 * MiB;
constexpr size_t WS_SPL8 = 242 * MiB + 512 * 1024;
constexpr size_t WS_XCH = 243 * MiB;
constexpr size_t WS_MEGA_END = 244 * MiB;
constexpr int CW_BAR = 4096;
constexpr int CW_DONE1 = 131072;
constexpr int CW_PANEL = 65536;

typedef GAS unsigned gu32;
#define RLX_AGENT __ATOMIC_RELAXED, __HIP_MEMORY_SCOPE_AGENT
#define LDS_WAIT() asm volatile("s_waitcnt lgkmcnt(0)" ::: "memory")
#define VM_WAIT() asm volatile("s_waitcnt vmcnt(0)" ::: "memory")

#define XB_TMO      128
#define XB_XCNT(j)  (256  + 64 * (j))
#define XB_XSUB(j)  (1280 + 64 * (j))
#define XB_XGEN(j)  (2304 + 64 * (j))
#define XB_TOP      3328
#define XB_TOPGEN   3392
#define XCD_BAR_WORDS 3456
#define XB_SPIN_CAP (1u << 18)
__device__ __forceinline__ unsigned xb_ld(unsigned* p)              { return __hip_atomic_load(p, __ATOMIC_RELAXED, __HIP_MEMORY_SCOPE_AGENT); }
__device__ __forceinline__ unsigned xb_add(unsigned* p, unsigned v) { return __hip_atomic_fetch_add(p, v, __ATOMIC_RELAXED, __HIP_MEMORY_SCOPE_AGENT); }
__device__ __forceinline__ unsigned xb_xcc_id() { return (unsigned)__builtin_amdgcn_s_getreg((3 << 11) | 20) & 0xFu; }
#define XB_SPIN(cond, bar) do { unsigned _sp = 0; while (cond) { __builtin_amdgcn_s_sleep(1); \
    if ((++_sp & 255u) == 0u) { if (xb_ld(&(bar)[XB_TMO])) break; if (_sp > XB_SPIN_CAP) { atomicAdd(&(bar)[XB_TMO], 1u); break; } } } } while (0)
struct XcdBarrier { unsigned* bar; unsigned x; volatile LAS unsigned* st; int wave; };
__device__ __forceinline__ XcdBarrier xcd_barrier_post(unsigned* bar, volatile LAS unsigned* st, int wave) {
    XcdBarrier b; b.bar = bar; b.x = xb_xcc_id(); b.st = st; b.wave = wave;
    if (wave == 0 && pg8::lane_id() == 0) (void)xb_add(&bar[XB_XCNT(b.x)], 1u);
    return b;
}
__device__ __forceinline__ void xcd_barrier_complete(unsigned* bar, unsigned x, unsigned& nloc, unsigned& nx) {
    const unsigned G = gridDim.x * gridDim.y * gridDim.z;
    unsigned sum, cnt, mine, sp = 0u;
    for (;;) {
        sum = 0u; cnt = 0u; mine = 0u;
#pragma unroll
        for (unsigned j = 0; j < 16; ++j) { const unsigned c = xb_ld(&bar[XB_XCNT(j)]); sum += c; cnt += (c > 0u) ? 1u : 0u; mine = (j == x) ? c : mine; }
        if (sum == G) break;
        __builtin_amdgcn_s_sleep(1);
        if ((++sp & 255u) == 0u) { if (xb_ld(&bar[XB_TMO])) break; if (sp > XB_SPIN_CAP) { atomicAdd(&bar[XB_TMO], 1u); break; } }
    }
    nloc = mine > 0u ? mine : 1u; nx = cnt > 0u ? cnt : 1u;
}
__device__ __forceinline__ void xcd_barrier(const XcdBarrier& b) {
    asm volatile("s_waitcnt vmcnt(0)" ::: "memory");
    __syncthreads();
    if (b.wave == 0 && pg8::lane_id() == 0) {
        unsigned* bar = b.bar;
        __builtin_amdgcn_s_waitcnt(0);
        unsigned nloc = b.st[0], nx = b.st[1];
        if (nloc == 0u) { xcd_barrier_complete(bar, b.x, nloc, nx); b.st[0] = nloc; b.st[1] = nx; }
        const unsigned old = xb_add(&bar[XB_XSUB(b.x)], 1u);
        const unsigned gen = old / nloc;
        if (old + 1u == (gen + 1u) * nloc) {
            __builtin_amdgcn_fence(__ATOMIC_RELEASE, "agent");
            asm volatile("s_waitcnt vmcnt(0)" ::: "memory");
            const unsigned og = xb_add(&bar[XB_TOP], 1u);
            const unsigned tg = og / nx;
            if (og + 1u == (tg + 1u) * nx) xb_add(&bar[XB_TOPGEN], 1u);
            else XB_SPIN(xb_ld(&bar[XB_TOPGEN]) == tg, bar);
            __builtin_amdgcn_fence(__ATOMIC_ACQUIRE, "agent");
            xb_add(&bar[XB_XGEN(b.x)], 1u);
            asm volatile("s_waitcnt vmcnt(0)" ::: "memory");
        } else {
            XB_SPIN(xb_ld(&bar[XB_XGEN(b.x)]) == gen, bar);
            __builtin_amdgcn_fence(__ATOMIC_ACQUIRE, "agent");
            asm volatile("s_waitcnt vmcnt(0)" ::: "memory");
        }
    }
    __syncthreads();
}

__device__ __forceinline__ unsigned pk2(float lo, float hi) { return (unsigned)f2bf(lo) | ((unsigned)f2bf(hi) << 16); }

struct TrItem { pg8::f32x4 v[8]; };
template <bool NT = false> __device__ __forceinline__ void tr_load(TrItem& t, const float* __restrict__ W, int ldn, int k0, int n_src0, int lane) {
    const int kb = lane >> 3, n4 = lane & 7;
    const float* src = W + (size_t)(k0 + 8 * kb) * ldn + n_src0 + 4 * n4;
#pragma unroll
    for (int q = 0; q < 8; ++q) t.v[q] = NT ? __builtin_nontemporal_load((const pg8::f32x4*)(src + (size_t)q * ldn)) : *(const pg8::f32x4*)(src + (size_t)q * ldn);
}
template <bool NT = false> __device__ __forceinline__ void tr_store(TrItem& t, int k0, bf16* __restrict__ WT, int Kd, int drow0, const float* __restrict__ gk, int lane) {
    const int kb = lane >> 3, n4 = lane & 7;
    if (gk) { const pg8::f32x4 g0 = *(const pg8::f32x4*)(gk + k0 + 8 * kb), g1 = *(const pg8::f32x4*)(gk + k0 + 8 * kb + 4);
#pragma unroll
        for (int q = 0; q < 8; ++q) t.v[q] = t.v[q] * (q < 4 ? g0[q & 3] : g1[q & 3]); }
#pragma unroll
    for (int i = 0; i < 4; ++i) { pg8::u32x4 o; o.x = pk2(t.v[0][i], t.v[1][i]); o.y = pk2(t.v[2][i], t.v[3][i]); o.z = pk2(t.v[4][i], t.v[5][i]); o.w = pk2(t.v[6][i], t.v[7][i]);
        if (NT) __builtin_nontemporal_store(o, (pg8::u32x4*)(WT + (size_t)(drow0 + 4 * n4 + i) * Kd + k0 + 8 * kb)); else *(pg8::u32x4*)(WT + (size_t)(drow0 + 4 * n4 + i) * Kd + k0 + 8 * kb) = o; }
}
__device__ __forceinline__ void p0_transpose_item(const float* __restrict__ W, int ldn, int k0, int n_src0, bf16* __restrict__ WT, int Kd, int drow0, const float* __restrict__ gk, LAS float*, int lane) {
    TrItem t; tr_load<true>(t, W, ldn, k0, n_src0, lane); tr_store(t, k0, WT, Kd, drow0, gk, lane);
}
__device__ __forceinline__ int win_dest_row(int n) {
    const int grp = n >> 10, j = n & 1023;
    switch (grp) {
        case 0: return j;
        case 1: return 1024 + (j >> 7) * 256 + (j & 127);
        case 2: return 3072 + (j >> 7) * 256 + (j & 127);
        case 3: return 5120 + j;
        case 4: return 1024 + (j >> 7) * 256 + 128 + (j & 127);
        default: return 3072 + (j >> 7) * 256 + 128 + (j & 127);
    }
}


struct DefW { const float* const* in; unsigned char* ws; };
constexpr int DF_OUT = 8 * 32, DF_E13 = 32 * 2 * 64, DF_E2 = 32 * 64, DF_G = 8 * 32, DF_UP = 2 * 32, DF_N = DF_OUT + DF_E13 + DF_E2 + DF_G + DF_UP;
struct DefDesc { const float* W; const float* gk; bf16* WT; int ldn, k0, n0, Kd, drow; };
__device__ __forceinline__ DefDesc deferred_desc(const DefW& w, int it) {
    int r = it; DefDesc d;
    if (r < DF_OUT) { const int kb = r / 16, np = r % 16; d = DefDesc{w.in[15], nullptr, (bf16*)(w.ws + WS_WOUT), 1024, kb * 64, np * 64, 1024, np * 64}; return d; } r -= DF_OUT;
    if (r < DF_E13) { const int e = r / 128, which = (r / 64) & 1, q = r % 64, kb = q / 4, np = q % 4;
        const int f0 = np * 64, drow = e * 512 + (f0 >> 7) * 256 + which * 128 + (f0 & 127);
        d = DefDesc{w.in[which ? 22 : 21] + (size_t)e * 1024 * 256, w.in[16], (bf16*)(w.ws + WS_W13), 256, kb * 64, f0, 1024, drow}; return d; } r -= DF_E13;
    if (r < DF_E2) { const int e = r / 64, q = r % 64, kb = q / 16, np = q % 16;
        d = DefDesc{w.in[23] + (size_t)e * 256 * 1024, nullptr, (bf16*)(w.ws + WS_W2), 1024, kb * 64, np * 64, 256, e * 1024 + np * 64}; return d; } r -= DF_E2;
    if (r < DF_G) { const int kb = r / 16, np = r % 16; d = DefDesc{w.in[25], w.in[24], (bf16*)(w.ws + WS_WG), 1024, kb * 64, np * 64, 1024, np * 64}; return d; } r -= DF_G;
    { const int kb = r / 16, np = r % 16; d = DefDesc{w.in[26], nullptr, (bf16*)(w.ws + WS_WUP), 1024, kb * 64, np * 64, 256, np * 64}; return d; }
}
struct Gemm1Order : pg8::StaticOrder {
    DefW w; int wave; int gi;
    struct Pre {}; __device__ __forceinline__ void pre(int, Pre&) const {}
    __device__ __forceinline__ void post(int ui, Pre&) const {
        if (ui != gi) return;
        const int lane = pg8::lane_id(), slot = c * 8 + wave, nslot = G * 8;
        for (int it = slot; it < DF_N; it += nslot) { const DefDesc d = deferred_desc(w, it); TrItem t0, t1;
            tr_load<true>(t0, d.W, d.ldn, d.k0, d.n0, lane); tr_load<true>(t1, d.W, d.ldn, d.k0, d.n0 + 32, lane);
            tr_store<true>(t0, d.k0, d.WT, d.Kd, d.drow, d.gk, lane); tr_store<true>(t1, d.k0, d.WT, d.Kd, d.drow + 32, d.gk, lane); }
        const pg8::f32x4* psrc = (const pg8::f32x4*)w.in[1]; unsigned long long* pdst = (unsigned long long*)(w.ws + WS_PB);
        for (int ch = slot; ch < 8192; ch += nslot) { const size_t i0 = (size_t)ch * 128 + lane; const pg8::f32x4 v0 = __builtin_nontemporal_load(psrc + i0), v1 = __builtin_nontemporal_load(psrc + i0 + 64);
            __builtin_nontemporal_store((unsigned long long)pk2(v0.x, v0.y) | ((unsigned long long)pk2(v0.z, v0.w) << 32), pdst + i0); __builtin_nontemporal_store((unsigned long long)pk2(v1.x, v1.y) | ((unsigned long long)pk2(v1.z, v1.w) << 32), pdst + i0 + 64); }
    }
};

constexpr int MY_VT = 0, MY_XA = 32768, MY_SP = 67584, MY_WS = 102400, MY_ST = 135168, MY_RS = 272;
__device__ __forceinline__ float bflo(unsigned u) { return __uint_as_float(u << 16); }
__device__ __forceinline__ float bfhi(unsigned u) { return __uint_as_float(u & 0xffff0000u); }
template <int N> __device__ __forceinline__ float row_shr(float ident, float v) {
    return __builtin_bit_cast(float, __builtin_amdgcn_update_dpp(__builtin_bit_cast(int, ident), __builtin_bit_cast(int, v), 0x110 + N, 0xf, 0xf, false)); }
#define MX_SCAN_STEP(N, A, U) { const float pa_ = row_shr<N>(1.f, A), pu_ = row_shr<N>(0.f, U); U = pu_ * A + U; A = pa_ * A; }
#define MX_SCAN16(A, U) { MX_SCAN_STEP(1, A, U) MX_SCAN_STEP(2, A, U) MX_SCAN_STEP(4, A, U) MX_SCAN_STEP(8, A, U) }
__device__ __forceinline__ void mixer_phase(LAS unsigned char* lds, const int vcu, const int G, const int tid, const int lane, const int wave,
                                            const bf16* __restrict__ Zl, const bf16* __restrict__ GA, const bf16* __restrict__ UB, const bf16* __restrict__ V, const float* __restrict__ VPART,
                                            unsigned long long* AGG, bf16* __restrict__ MG, const bf16* __restrict__ WLRU, const bf16* __restrict__ WSGU, const float* __restrict__ SPL8, const float* const* in) {
    using namespace pg8;
    constexpr int RS = MY_RS;
    constexpr float L2E = 1.4426950409f;
    const int fr = lane & 15, grp = lane >> 4, cp = tid & 63, tg = wave;
    const int pr = lane & 3, sch = lane >> 2, srow = 8 * sch + 2 * pr;
    LAS float* ST = (LAS float*)(lds + MY_ST);
    int gprev = -1;
    f32x2 cw0, cw1, cw2, cw3, ccb;
    u32x4 zqa, zqb, zqc, zqd, zqe, vv00, vv01, vv10, vv11;
#define MX_ZR(k) ((k) < 4 ? zqa[(k) & 3] : (k) < 8 ? zqb[(k) & 3] : (k) < 12 ? zqc[(k) & 3] : (k) < 16 ? zqd[(k) & 3] : zqe[(k) & 3])
#define MX_SETZR(k, v) do { if ((k) < 4) zqa[(k) & 3] = (v); else if ((k) < 8) zqb[(k) & 3] = (v); else if ((k) < 12) zqc[(k) & 3] = (v); else if ((k) < 16) zqd[(k) & 3] = (v); else zqe[(k) & 3] = (v); } while (0)
#define MX_PREFETCH(uu) do { const int ck_ = (uu) >> 3, g_ = (uu) & 7, t0_ = ck_ * 128, c0_ = g_ * 128; const bool first_ = (ck_ & 15) == 0; \
        const unsigned zo_ = ((unsigned)(t0_ + 16 * tg) * D + c0_ + 2 * cp) * 2u; \
        _Pragma("unroll") for (int k = 0; k < 19; ++k) { unsigned zv_ = 0u; if (!(k < 3 && first_ && tg == 0)) zv_ = *(const unsigned*)((const char*)Zl + (zo_ + (unsigned)((k - 3) * D * 2))); MX_SETZR(k, zv_); } \
        { const unsigned vo_ = ((unsigned)(t0_ + srow) * D + c0_ + 16 * wave) * 2u; vv00 = *(const u32x4*)((const char*)V + vo_); vv01 = *(const u32x4*)((const char*)V + (vo_ + D * 2)); vv10 = *(const u32x4*)((const char*)V + (vo_ + 16)); vv11 = *(const u32x4*)((const char*)V + (vo_ + D * 2 + 16)); } \
        } while (0)
    zqe = (u32x4){0u, 0u, 0u, 0u};
#define MX_STATS_LOAD(uu, q0, q1) do { const unsigned vpo_ = ((unsigned)(((uu) >> 3) * 128 + (tid >> 2)) * 32 + (tid & 3) * 8) * 4u; q0 = *(const f32x4*)((const char*)VPART + vpo_); q1 = *(const f32x4*)((const char*)VPART + (vpo_ + 16)); } while (0)
#define MX_STATS_WRITE(q0, q1) do { float s1 = (q0[0] + q0[2]) + (q1[0] + q1[2]), s2 = (q0[1] + q0[3]) + (q1[1] + q1[3]); \
        s1 += __shfl_xor(s1, 1); s1 += __shfl_xor(s1, 2); s2 += __shfl_xor(s2, 1); s2 += __shfl_xor(s2, 2); \
        if ((tid & 3) == 0) { const float mean = s1 * (1.f / 1024.f); float var = s2 * (1.f / 1024.f) - mean * mean; var = var < 0.f ? 0.f : var; ST[tid >> 2] = mean; ST[128 + (tid >> 2)] = rsqrtf(var + EPS); } } while (0)
    int u = vcu;
    if (u < 1024) { MX_PREFETCH(u); f32x4 q0, q1; MX_STATS_LOAD(u, q0, q1); MX_STATS_WRITE(q0, q1); }
    for (; u < 1024; u += G) {
        const int ck = u >> 3, g = u & 7, t0 = ck * 128, c0 = g * 128, j = ck & 15;
        const int cch = c0 + 16 * wave + 4 * grp;
        if (g != gprev) {
            gprev = g;
#pragma unroll
            for (int it = 0; it < 4; ++it) { const int idx = it * 512 + tid, row = idx >> 4, ch = idx & 15;
                *(LAS u32x4*)(lds + MY_WS + row * 256 + ((ch ^ (row & 15)) << 4)) = *(const u32x4*)(WSGU + ((size_t)(g * 128 + row)) * 128 + ch * 8); }
            const int cc = c0 + 2 * cp;
            cw0 = *(const f32x2*)(in[4] + cc); cw1 = *(const f32x2*)(in[4] + 1024 + cc); cw2 = *(const f32x2*)(in[4] + 2048 + cc); cw3 = *(const f32x2*)(in[4] + 3072 + cc); ccb = *(const f32x2*)(in[5] + cc);
        }
        const int hblk = 2 * g + (wave >> 2), jj0 = (16 * wave) & 63;
        const bf16x8 bw00 = *(const bf16x8*)(WLRU + ((size_t)((0 * 16 + hblk) * 64 + jj0 + fr)) * 64 + 0 * 32 + 8 * grp), bw01 = *(const bf16x8*)(WLRU + ((size_t)((0 * 16 + hblk) * 64 + jj0 + fr)) * 64 + 1 * 32 + 8 * grp);
        const bf16x8 bw10 = *(const bf16x8*)(WLRU + ((size_t)((1 * 16 + hblk) * 64 + jj0 + fr)) * 64 + 0 * 32 + 8 * grp), bw11 = *(const bf16x8*)(WLRU + ((size_t)((1 * 16 + hblk) * 64 + jj0 + fr)) * 64 + 1 * 32 + 8 * grp);
        const f32x4 nba = *(const f32x4*)(in[7] + cch) * (-L2E), nbi = *(const f32x4*)(in[9] + cch) * (-L2E), ksp = *(const f32x4*)(SPL8 + cch);
        {
#pragma unroll
            for (int i = 0; i < 16; ++i) {
                const unsigned z0 = MX_ZR(i), z1 = MX_ZR(i + 1), z2 = MX_ZR(i + 2), z3 = MX_ZR(i + 3);
                const float x0 = ccb.x + cw0.x * bflo(z0) + cw1.x * bflo(z1) + cw2.x * bflo(z2) + cw3.x * bflo(z3);
                const float x1 = ccb.y + cw0.y * bfhi(z0) + cw1.y * bfhi(z1) + cw2.y * bfhi(z2) + cw3.y * bfhi(z3);
                *(LAS unsigned*)(lds + MY_XA + (16 * tg + i) * RS + 4 * cp) = cvt_pk_bf16(x0, x1);
            }
        }
        __syncthreads();
        {
            const float mua = ST[srow], rsa = ST[128 + srow], mub = ST[srow + 1], rsb = ST[128 + srow + 1];
#pragma unroll
            for (int ci = 0; ci < 2; ++ci) { const int chunk = 2 * wave + ci, cbase = c0 + 8 * chunk;
                f32x4 a0, a1, b0, b1; unpack8(ci ? vv10 : vv00, a0, a1); unpack8(ci ? vv11 : vv01, b0, b1);
                const f32x4 g0 = *(const f32x4*)(in[11] + cbase), g1 = *(const f32x4*)(in[11] + cbase + 4), l0 = *(const f32x4*)(in[12] + cbase), l1 = *(const f32x4*)(in[12] + cbase + 4);
                a0 = (a0 - mua) * rsa * g0 + l0; a1 = (a1 - mua) * rsa * g1 + l1; b0 = (b0 - mub) * rsb * g0 + l0; b1 = (b1 - mub) * rsb * g1 + l1;
#pragma unroll
                for (int i = 0; i < 8; ++i) { const int cl = 8 * chunk + i; const float va = i < 4 ? a0[i & 3] : a1[i & 3], vb = i < 4 ? b0[i & 3] : b1[i & 3];
                    *(LAS unsigned*)(lds + MY_VT + cl * 256 + ((sch ^ (cl & 15)) << 4) + 4 * pr) = cvt_pk_bf16(va, vb); }
            }
        }
        f32x4 R[8], I[8];
#pragma unroll
        for (int mt = 0; mt < 8; ++mt) { R[mt] = (f32x4){0.f, 0.f, 0.f, 0.f}; I[mt] = (f32x4){0.f, 0.f, 0.f, 0.f};
#pragma unroll
            for (int ks = 0; ks < 2; ++ks) { const bf16x8 a = *(const LAS bf16x8*)(lds + MY_XA + (mt * 16 + fr) * RS + ((wave >> 2) * 64 + ks * 32 + 8 * grp) * 2);
                R[mt] = __builtin_amdgcn_mfma_f32_16x16x32_bf16(ks ? bw01 : bw00, a, R[mt], 0, 0, 0); I[mt] = __builtin_amdgcn_mfma_f32_16x16x32_bf16(ks ? bw11 : bw10, a, I[mt], 0, 0, 0); } }
#pragma unroll
        for (int mt = 0; mt < 8; ++mt) {
            const u32x2 xw = *(const LAS u32x2*)(lds + MY_XA + (mt * 16 + fr) * RS + (16 * wave + 4 * grp) * 2);
            const f32x4 xa4 = {bflo(xw.x), bfhi(xw.x), bflo(xw.y), bfhi(xw.y)};
            const f32x4 t1 = R[mt] * (-L2E) + nba, t2 = I[mt] * (-L2E) + nbi;
            f32x4 d1, d2, inv;
#pragma unroll
            for (int r = 0; r < 4; ++r) { d1[r] = 1.f + __builtin_amdgcn_exp2f(t1[r]); d2[r] = 1.f + __builtin_amdgcn_exp2f(t2[r]); }
            const f32x4 dd = d1 * d2;
#pragma unroll
            for (int r = 0; r < 4; ++r) inv[r] = __builtin_amdgcn_rcpf(dd[r]);
            const f32x4 rr = d2 * inv, ii = d1 * inv, la = rr * ksp, x2 = la + la;
            const f32x4 av = 1.f + la * (1.f + la * (0.5f + la * (0.16666667f + la * (0.041666667f + la * 0.0083333333f))));
            const f32x4 om = -x2 * (1.f + x2 * (0.5f + x2 * (0.16666667f + x2 * (0.041666667f + x2 * 0.0083333333f))));
            f32x4 uv;
#pragma unroll
            for (int r = 0; r < 4; ++r) uv[r] = __builtin_amdgcn_sqrtf(om[r]);
            uv = uv * ii * xa4;
#pragma unroll
            for (int r = 0; r < 4; ++r) { float A_ = av[r], U_ = uv[r]; MX_SCAN16(A_, U_); R[mt][r] = A_; I[mt][r] = U_; }
        }
        {
            f32x4 Pc = {1.f, 1.f, 1.f, 1.f}, Hc = {0.f, 0.f, 0.f, 0.f};
#pragma unroll
            for (int mt = 0; mt < 8; ++mt) { Hc = Hc * R[mt] + I[mt]; Pc = Pc * R[mt]; }
            if (fr == 15) {
#pragma unroll
                for (int r = 0; r < 4; ++r) __hip_atomic_store(AGG + (size_t)ck * 1024 + cch + r, ((unsigned long long)__float_as_uint(Hc[r]) << 32) | (unsigned long long)__float_as_uint(Pc[r]), __ATOMIC_RELAXED, __HIP_MEMORY_SCOPE_AGENT);
            }
        }
        __syncthreads();
        if (u + G < 1024) MX_PREFETCH(u + G);
        unsigned long long ag0 = 0x000000003f800000ull, ag1 = 0x000000003f800000ull, ag2 = 0x000000003f800000ull, ag3 = 0x000000003f800000ull;
        if (j > 0 && fr < j) { const unsigned long long* ap = AGG + (size_t)(ck - j + fr) * 1024 + cch;
            ag0 = __hip_atomic_load(ap, __ATOMIC_RELAXED, __HIP_MEMORY_SCOPE_AGENT); ag1 = __hip_atomic_load(ap + 1, __ATOMIC_RELAXED, __HIP_MEMORY_SCOPE_AGENT);
            ag2 = __hip_atomic_load(ap + 2, __ATOMIC_RELAXED, __HIP_MEMORY_SCOPE_AGENT); ag3 = __hip_atomic_load(ap + 3, __ATOMIC_RELAXED, __HIP_MEMORY_SCOPE_AGENT); }
        {
            bf16x8 q[4];
#pragma unroll
            for (int ks = 0; ks < 4; ++ks) q[ks] = *(const LAS bf16x8*)(lds + MY_VT + (16 * wave + fr) * 256 + (((ks * 4 + grp) ^ fr) << 4));
#pragma unroll
            for (int mt = 0; mt < 8; ++mt) { f32x4 Sx = {0.f, 0.f, 0.f, 0.f};
#pragma unroll
                for (int ks = 0; ks <= mt / 2; ++ks) { const bf16x8 p = *(const LAS bf16x8*)(lds + MY_WS + (mt * 16 + fr) * 256 + (((ks * 4 + grp) ^ fr) << 4));
                    Sx = __builtin_amdgcn_mfma_f32_16x16x32_bf16(q[ks], p, Sx, 0, 0, 0); }
                *(LAS u32x2*)(lds + MY_SP + (mt * 16 + fr) * RS + (16 * wave + 4 * grp) * 2) = (u32x2){cvt_pk_bf16_cv(Sx[0], Sx[1]), cvt_pk_bf16_cv(Sx[2], Sx[3])}; }
        }
        {
            f32x4 hc0 = {0.f, 0.f, 0.f, 0.f};
            if (j > 0) {
                f32x4 lp, lh; unsigned spin = 0;
                for (;;) {
                    lp[0] = __uint_as_float((unsigned)ag0); lh[0] = __uint_as_float((unsigned)(ag0 >> 32)); lp[1] = __uint_as_float((unsigned)ag1); lh[1] = __uint_as_float((unsigned)(ag1 >> 32));
                    lp[2] = __uint_as_float((unsigned)ag2); lh[2] = __uint_as_float((unsigned)(ag2 >> 32)); lp[3] = __uint_as_float((unsigned)ag3); lh[3] = __uint_as_float((unsigned)(ag3 >> 32));
                    const bool ok = (lp[0] != 0.f) && (lp[1] != 0.f) && (lp[2] != 0.f) && (lp[3] != 0.f);
                    if (__all(ok)) break;
                    if (++spin > (1u << 22)) break;
                    __builtin_amdgcn_s_sleep(1);
                    if (fr < j) { const unsigned long long* ap = AGG + (size_t)(ck - j + fr) * 1024 + cch;
                        ag0 = __hip_atomic_load(ap, __ATOMIC_RELAXED, __HIP_MEMORY_SCOPE_AGENT); ag1 = __hip_atomic_load(ap + 1, __ATOMIC_RELAXED, __HIP_MEMORY_SCOPE_AGENT);
                        ag2 = __hip_atomic_load(ap + 2, __ATOMIC_RELAXED, __HIP_MEMORY_SCOPE_AGENT); ag3 = __hip_atomic_load(ap + 3, __ATOMIC_RELAXED, __HIP_MEMORY_SCOPE_AGENT); } }
#pragma unroll
                for (int r = 0; r < 4; ++r) { float A_ = lp[r], U_ = lh[r]; MX_SCAN16(A_, U_); hc0[r] = __shfl(U_, (lane & 48) | 15); }
            }
            f32x4 s = hc0;
#pragma unroll
            for (int mt = 0; mt < 8; ++mt) { f32x4 hb;
#pragma unroll
                for (int r = 0; r < 4; ++r) hb[r] = __shfl(s[r], (lane & 48) | 15);
                s = R[mt] * s + I[mt];
                const f32x4 hv = I[mt] + R[mt] * hb;
                *(LAS u32x2*)(lds + MY_XA + (mt * 16 + fr) * RS + (16 * wave + 4 * grp) * 2) = (u32x2){cvt_pk_bf16(hv[0], hv[1]), cvt_pk_bf16(hv[2], hv[3])}; }
        }
        u32x4 ga[4], ub[4]; float bsr[4]; f32x4 nq0 = {0.f, 0.f, 0.f, 0.f}, nq1 = {0.f, 0.f, 0.f, 0.f};
        if (u + G < 1024) MX_STATS_LOAD(u + G, nq0, nq1);
#pragma unroll
        for (int it = 0; it < 4; ++it) { const int idx = it * 512 + tid, row = idx >> 4, ch = idx & 15; const unsigned o = ((unsigned)(t0 + row) * D + c0 + ch * 8) * 2u; ga[it] = *(const u32x4*)((const char*)GA + o); ub[it] = *(const u32x4*)((const char*)UB + o); bsr[it] = in[14][g * 128 + row]; }
        __syncthreads();
#pragma unroll
        for (int it = 0; it < 4; ++it) { const int idx = it * 512 + tid, row = idx >> 4, ch = idx & 15;
            f32x4 g0, g1, u0, u1, h0, h1, s0, s1; unpack8(ga[it], g0, g1); unpack8(ub[it], u0, u1);
            unpack8(*(const LAS u32x4*)(lds + MY_XA + row * RS + ch * 16), h0, h1); unpack8(*(const LAS u32x4*)(lds + MY_SP + row * RS + ch * 16), s0, s1);
            *(u32x4*)((char*)MG + ((unsigned)(t0 + row) * D + c0 + ch * 8) * 2u) = pack8(g0 * h0 + u0 * (s0 + bsr[it]), g1 * h1 + u1 * (s1 + bsr[it])); }
        if (u + G < 1024) MX_STATS_WRITE(nq0, nq1);
        __syncthreads();
    }
#undef MX_PREFETCH
#undef MX_STATS_LOAD
#undef MX_STATS_WRITE
#undef MX_ZR
#undef MX_SETZR
}

__device__ __forceinline__ void build_moe_units(LAS int* tab1, LAS int* tab2, LAS int* tab3, const int* CNT, int vcu, int G, int wave, LAS int* flags) {
    const int tid = wave * 64 + pg8::lane_id();
    int NT = 0, my_e = 0, my_tile = 0, my_cnt = 0, my_rt = 0;
    for (int e = 0; e < 32; ++e) { const int cnt = CNT[e]; const int ntl = (cnt + 255) >> 8;
        if (tid >= NT && tid < NT + ntl) { my_e = e; my_tile = tid - NT; my_cnt = cnt; my_rt = tid; }
        NT += ntl; }
    const bool have = tid < NT;
    const bool heavy = have && (my_cnt - my_tile * 256) > 128;
    flags[tid] = heavy ? 1 : 0;
    __syncthreads();
    int hb = 0, NH = 0;
    for (int i = 0; i < NT; ++i) { const int f = flags[i]; NH += f; hb += (i < tid) ? f : 0; }
    const int slot = heavy ? hb : NH + (tid - hb);
    const int U1 = 2 * NT, U2 = 4 * NT; int nlate = (U1 > G && U1 < 2 * G) ? U1 - G : 0; if (G - nlate < 64) nlate = 0;
    const int Ge = G - nlate, c2 = vcu - nlate, ssplit = nlate ? G / 2 : NT, Lsplit = 4 * ssplit;
    const int n1 = vcu < U1 ? (U1 - 1 - vcu) / G + 1 : 0;
    const int tot2 = (c2 >= 0 && c2 < U2) ? (U2 - 1 - c2) / Ge + 1 : 0;
    int n2 = (c2 >= 0 && c2 < Lsplit) ? (Lsplit - 1 - c2) / Ge + 1 : 0; n2 = n2 < tot2 ? n2 : tot2;
    const int n3 = tot2 - n2;
    if (tid == 0) { tab1[0] = n1 < 12 ? n1 : 12; tab2[0] = n2 < 12 ? n2 : 12; tab3[0] = n3 < 12 ? n3 : 12; }
    if (have) {
#pragma unroll
        for (int q = 0; q < 2; ++q) { const int L = 2 * slot + q; if (L % G == vcu && L / G < 12) { LAS int* p = tab1 + 4 + 8 * (L / G); p[0] = my_rt; p[1] = my_e * 2 + q; p[2] = my_e; p[3] = my_tile; p[4] = my_cnt; } }
        if (c2 >= 0) {
#pragma unroll
            for (int q = 0; q < 4; ++q) { const int L2 = 4 * slot + q; if (L2 % Ge == c2) { const int k = L2 / Ge; const bool early = slot < ssplit; const int idx = early ? k : k - n2;
                if (idx >= 0 && idx < 12) { LAS int* p = (early ? tab2 : tab3) + 4 + 8 * idx; p[0] = my_rt; p[1] = my_e * 4 + q; p[2] = my_e; p[3] = my_tile; p[4] = my_cnt; } } }
        }
    }
    __syncthreads();
}
__device__ __forceinline__ void moe_wait_tiles(const LAS int* tab, unsigned* dcnt, int wave) {
    if (wave == 0) {
        const int n = __builtin_amdgcn_readfirstlane(tab[0]);
        for (int i = 0; i < n; ++i) { const int rt = __builtin_amdgcn_readfirstlane(tab[4 + 8 * i]); unsigned sp = 0;
            while ((unsigned)__builtin_amdgcn_readfirstlane(__hip_atomic_load(dcnt + 64 * rt, __ATOMIC_RELAXED, __HIP_MEMORY_SCOPE_AGENT)) < 16u) { if (++sp > (1u << 22)) break; __builtin_amdgcn_s_sleep(2); } }
        __builtin_amdgcn_fence(__ATOMIC_ACQUIRE, "agent");
        asm volatile("s_waitcnt vmcnt(0)" ::: "memory");
    }
    __syncthreads();
}

struct Args { const float* in[28]; float* out; unsigned char* ws; int ph_lo, ph_hi, li, pad; };

__global__ void __launch_bounds__(NWAVES * 64, 2) mega_fwd(Args args) {
    extern __shared__ __attribute__((aligned(16))) unsigned char lds_raw[];
    LAS unsigned char* lds = (LAS unsigned char*)lds_raw;
    volatile LAS unsigned* MISC = (volatile LAS unsigned*)(lds + MISC_OFF);
    const int tid0 = threadIdx.x, wave = __builtin_amdgcn_readfirstlane(tid0 >> 6);
#define PHASE_IDS() int lane = pg8::lane_id(); asm volatile("" : "+v"(lane)); const int tid = wave * 64 + lane; (void)tid
    const int G = gridDim.x;
    const int vcu = (G % 8 == 0) ? ((int)blockIdx.x % 8) * (G / 8) + (int)blockIdx.x / 8 : (int)blockIdx.x;
    unsigned char* ws = args.ws;
    unsigned* ctl = (unsigned*)(ws + WS_CTL);
    for (int u = tid0; u < (LDS_BYTES - LDSCTL_OFF) / 4; u += NWAVES * 64) ((LAS unsigned*)(lds + LDSCTL_OFF))[u] = 0u;
    __syncthreads();
    XcdBarrier bar = xcd_barrier_post(ctl + CW_BAR + args.li * XCD_BAR_WORDS, MISC + 8, wave);
    const int lo = args.ph_lo, hi = args.ph_hi;
#define IN(k) (lo <= (k) && (k) < hi)
#define BOTH(k) (IN(k) && IN((k) + 1))
    const float* const* in = args.in;
    bf16 *XN = (bf16*)(ws + WS_A0), *MG = (bf16*)(ws + WS_A0), *X2b = (bf16*)(ws + WS_A0);
    bf16 *Zl = (bf16*)(ws + WS_A1), *X1b = (bf16*)(ws + WS_A1);
    bf16 *GA = (bf16*)(ws + WS_A2), *UB = (bf16*)(ws + WS_A3), *V = (bf16*)(ws + WS_A4);
    bf16 *X3 = (bf16*)(ws + WS_A1);
    bf16 *PU = (bf16*)(ws + WS_A2);
    bf16 *Pb = (bf16*)(ws + WS_PB);
    bf16 *WinT = (bf16*)(ws + WS_WIN), *WoutT = (bf16*)(ws + WS_WOUT), *WgT = (bf16*)(ws + WS_WG), *W13T = (bf16*)(ws + WS_W13), *W2T = (bf16*)(ws + WS_W2), *WupT = (bf16*)(ws + WS_WUP);
    float *VPART = (float*)(ws + WS_VPART), *SS1 = (float*)(ws + WS_SS1), *SS3 = (float*)(ws + WS_SS3), *RSTD2 = (float*)(ws + WS_RSTD2), *RSTD1 = (float*)(ws + WS_RSTD1), *TOKG = (float*)(ws + WS_TOKG);
    int *CNT = (int*)(ws + WS_CTL), *LIST = (int*)(ws + WS_LIST), *TOKE = (int*)(ws + WS_TOKE);
    bf16 *Hb = (bf16*)(ws + WS_A2), *Yb = (bf16*)(ws + WS_A3), *WrT = (bf16*)(ws + WS_WR), *WLRU = (bf16*)(ws + WS_WLRU), *WSGU = (bf16*)(ws + WS_WSGU);
    unsigned long long* AGGQ = (unsigned long long*)(ws + WS_AGG); float* SPL8 = (float*)(ws + WS_SPL8);

    if (IN(0)) {
        PHASE_IDS();
        LAS float* scr = (LAS float*)(lds + wave * 16384);
        const int gw = vcu * NWAVES + wave, NGW = G * NWAVES;
        for (int it = gw; it < 16 * 192; it += NGW) { const int kb = it / 192, nb = it % 192; p0_transpose_item(in[3], 6144, kb * 64, nb * 32, WinT, 1024, win_dest_row(nb * 32), nullptr, scr, lane); }
        for (int m = gw; m < T; m += 2 * NGW) {
            const int m2 = m + NGW < T ? m + NGW : m;
            const pg8::f32x4* xr = (const pg8::f32x4*)(in[0] + (size_t)m * D) + lane; const pg8::f32x4* xr2 = (const pg8::f32x4*)(in[0] + (size_t)m2 * D) + lane; const pg8::f32x4* gr = (const pg8::f32x4*)in[2] + lane;
            pg8::f32x4 v[4], w[4]; float s = 0.f, s2 = 0.f;
#pragma unroll
            for (int j = 0; j < 4; ++j) { v[j] = __builtin_nontemporal_load(xr + 64 * j); w[j] = __builtin_nontemporal_load(xr2 + 64 * j); }
#pragma unroll
            for (int j = 0; j < 4; ++j) { s += (v[j].x * v[j].x + v[j].y * v[j].y) + (v[j].z * v[j].z + v[j].w * v[j].w); s2 += (w[j].x * w[j].x + w[j].y * w[j].y) + (w[j].z * w[j].z + w[j].w * w[j].w); }
            const float rstd = rsqrtf(wave_sum(s) * (1.f / D) + EPS), rstd2 = rsqrtf(wave_sum(s2) * (1.f / D) + EPS);
            unsigned long long* o8 = (unsigned long long*)(XN + (size_t)m * D) + lane; unsigned long long* o82 = (unsigned long long*)(XN + (size_t)m2 * D) + lane;
#pragma unroll
            for (int j = 0; j < 4; ++j) { const pg8::f32x4 gg = gr[64 * j];
                o8[64 * j] = (unsigned long long)pk2(v[j].x * rstd * gg.x, v[j].y * rstd * gg.y) | ((unsigned long long)pk2(v[j].z * rstd * gg.z, v[j].w * rstd * gg.w) << 32);
                o82[64 * j] = (unsigned long long)pk2(w[j].x * rstd2 * gg.x, w[j].y * rstd2 * gg.y) | ((unsigned long long)pk2(w[j].z * rstd2 * gg.z, w[j].w * rstd2 * gg.w) << 32); }
        }
        for (int i = vcu * 512 + tid; i < 2 * 16 * 64 * 64; i += G * 512) { const int gate = i >> 16, h = (i >> 12) & 15, j = (i >> 6) & 63, ii = i & 63;
            WLRU[i] = f2bf(in[gate ? 8 : 6][(h * 64 + ii) * 64 + j]); }
        for (int i = vcu * 512 + tid; i < 8 * 128 * 128; i += G * 512) { const int t = (i >> 7) & 127, s = i & 127; WSGU[i] = s <= t ? f2bf(in[13][i]) : (bf16)0; }
        for (int i = vcu * 512 + tid; i < 1024; i += G * 512) SPL8[i] = -8.f * log1pf(expf(-in[10][i]));
        for (int i = vcu * 512 + tid; i < 64 * 1024; i += G * 512) { const int n = i >> 10, k = i & 1023; float v = 0.f;
            if (n < 4) v = in[17][k * 4 + n] * in[16][k]; else if (n < 36) v = in[19][k * 32 + (n - 4)] * in[16][k];
            WrT[i] = f2bf(v); }
        if (BOTH(0)) xcd_barrier(bar);
    }
    if (IN(1)) {
        { pg8::Gemm g{XN, WinT, 1024}; Gemm1Order S; S.init(T, 6144, G, (int)blockIdx.x);
          S.wave = wave; { const int upw = (64 * 24) / G > 0 ? (64 * 24) / G : 1; S.gi = (int)blockIdx.x % upw; } S.w = DefW{args.in, ws};
          pg8::Epi1 E{Zl, GA, UB, V, VPART};
          pg8::gemm_phase<pg8::Epi1, Gemm1Order, true, true, false>(lds, g, S, E, wave); }
        if (BOTH(1)) xcd_barrier(bar);
    }

    if (IN(3)) {
        PHASE_IDS();
        mixer_phase(lds, vcu, G, tid, lane, wave, Zl, GA, UB, V, VPART, AGGQ, MG, WLRU, WSGU, SPL8, in);
        if (BOTH(3)) xcd_barrier(bar);
    }
    if (IN(4)) {
        pg8::Gemm g{MG, WoutT, 1024}; pg8::StaticOrder S; S.init(T, 1024, G, (int)blockIdx.x);
        pg8::Epi2 E{in[0], X1b, SS1};
        pg8::gemm_phase<pg8::Epi2, pg8::StaticOrder, true, true, false>(lds, g, S, E, wave);
        if (BOTH(4)) xcd_barrier(bar);
    }

    if (IN(5)) {
        PHASE_IDS();
        constexpr int RS = 528;
        LAS unsigned char* sA = lds; LAS unsigned char* sB = lds + 64 * RS; LAS float* sL = (LAS float*)(lds + 2 * 64 * RS);
        LAS int* sCnt = (LAS int*)(lds + 2 * 64 * RS + 64 * 65 * 4); LAS int* sBase = sCnt + 32;
        const int fr = lane & 15, grp = lane >> 4, mtile = wave & 3, np = wave >> 2;
        for (int tile = vcu; tile < T / 64; tile += G) {
            const int tok0 = tile * 64;
            if (tid < 32) sCnt[tid] = 0;
            pg8::f32x4 acc0 = {0.f, 0.f, 0.f, 0.f}, acc1 = {0.f, 0.f, 0.f, 0.f};
            for (int kc = 0; kc < 4; ++kc) {
#pragma unroll
                for (int it = 0; it < 4; ++it) { const int idx = it * 512 + tid, row = idx >> 5, ch = idx & 31;
                    *(LAS pg8::u32x4*)(sA + row * RS + ch * 16) = *(const pg8::u32x4*)(X1b + (size_t)(tok0 + row) * D + kc * 256 + ch * 8);
                    *(LAS pg8::u32x4*)(sB + row * RS + ch * 16) = *(const pg8::u32x4*)(WrT + (size_t)row * D + kc * 256 + ch * 8); }
                __syncthreads();
#pragma unroll
                for (int ks = 0; ks < 8; ++ks) {
                    const pg8::bf16x8 a = *(const LAS pg8::bf16x8*)(sA + (16 * mtile + fr) * RS + (ks * 32 + 8 * grp) * 2);
                    const pg8::bf16x8 b0 = *(const LAS pg8::bf16x8*)(sB + (32 * np + fr) * RS + (ks * 32 + 8 * grp) * 2);
                    const pg8::bf16x8 b1 = *(const LAS pg8::bf16x8*)(sB + (32 * np + 16 + fr) * RS + (ks * 32 + 8 * grp) * 2);
                    acc0 = __builtin_amdgcn_mfma_f32_16x16x32_bf16(a, b0, acc0, 0, 0, 0);
                    acc1 = __builtin_amdgcn_mfma_f32_16x16x32_bf16(a, b1, acc1, 0, 0, 0);
                }
                __syncthreads();
            }
#pragma unroll
            for (int r = 0; r < 4; ++r) { const int tk = 16 * mtile + 4 * grp + r; sL[tk * 65 + 32 * np + fr] = acc0[r]; sL[tk * 65 + 32 * np + 16 + fr] = acc1[r]; }
            __syncthreads();
            int e1 = 0, e2 = 0, r1 = 0, r2 = 0; float g1 = 0.f, g2 = 0.f;
            if (tid < 64) {
                const int t = tok0 + tid; float ss = 0.f;
#pragma unroll
                for (int q = 0; q < 16; ++q) ss += SS1[(size_t)t * 16 + q];
                const float rstd = rsqrtf(ss * (1.f / D) + EPS);
                RSTD1[t] = rstd;
                const LAS float* l = sL + tid * 65;
                float gl[4];
#pragma unroll
                for (int q = 0; q < 4; ++q) gl[q] = rstd * l[q] + in[18][q];
                float mx = gl[0]; int gi = 0;
#pragma unroll
                for (int q = 1; q < 4; ++q) if (gl[q] > mx) { mx = gl[q]; gi = q; }
                float den = 0.f;
#pragma unroll
                for (int q = 0; q < 4; ++q) den += expf(gl[q] - mx);
                const float gtop = 1.f / den;
                float m1 = -3.0e38f, m2 = -3.0e38f; int i1 = 0, i2 = 0;
                for (int j = 0; j < 8; ++j) { const float v = rstd * l[4 + gi * 8 + j] + in[20][gi * 8 + j];
                    if (v > m1) { m2 = m1; i2 = i1; m1 = v; i1 = j; } else if (v > m2) { m2 = v; i2 = j; } }
                const float p2 = expf(m2 - m1);
                g1 = gtop / (1.f + p2); g2 = gtop * p2 / (1.f + p2);
                e1 = gi * 8 + i1; e2 = gi * 8 + i2;
                r1 = __hip_atomic_fetch_add(&sCnt[e1], 1, __ATOMIC_RELAXED, __HIP_MEMORY_SCOPE_WORKGROUP); r2 = __hip_atomic_fetch_add(&sCnt[e2], 1, __ATOMIC_RELAXED, __HIP_MEMORY_SCOPE_WORKGROUP);
                TOKE[t * 2] = e1; TOKE[t * 2 + 1] = e2; TOKG[t * 2] = g1; TOKG[t * 2 + 1] = g2;
            }
            __syncthreads();
            if (tid < 32) { const int c = sCnt[tid]; sBase[tid] = c ? atomicAdd(&CNT[tid], c) : 0; }
            __syncthreads();
            if (tid < 64) { const int t = tok0 + tid; LIST[e1 * 16384 + sBase[e1] + r1] = t * 2; LIST[e2 * 16384 + sBase[e2] + r2] = t * 2 + 1; }
            __syncthreads();
        }
        if (BOTH(5)) xcd_barrier(bar);
    }
    if (IN(6)) {
        LAS int* tab1 = (LAS int*)(lds + TAB_OFF); LAS int* tab2 = (LAS int*)(lds + TAB_OFF + 512); LAS int* tab3 = (LAS int*)(lds + TAB_OFF + 1024);
        build_moe_units(tab1, tab2, tab3, CNT, vcu, G, wave, (LAS int*)lds);
        unsigned* dcnt = ctl + CW_DONE1;
        { pg8::Gemm g{X1b, W13T, 1024}; pg8::MoeOrder<1> S{tab1, LIST, dcnt};
          pg8::EpiMoe1 E{Hb, LIST, RSTD1};
          pg8::gemm_phase<pg8::EpiMoe1, pg8::MoeOrder<1>, true, true, true>(lds, g, S, E, wave); }
        pg8::Gemm g2{Hb, W2T, 256}; pg8::EpiMoe2 E2{Yb, LIST, TOKG};
        moe_wait_tiles(tab2, dcnt, wave);
        { pg8::MoeOrder<0> S{tab2, LIST, dcnt}; pg8::gemm_phase<pg8::EpiMoe2, pg8::MoeOrder<0>, true, true, false>(lds, g2, S, E2, wave); }
        moe_wait_tiles(tab3, dcnt, wave);
        { pg8::MoeOrder<0> S{tab3, LIST, dcnt}; pg8::gemm_phase<pg8::EpiMoe2, pg8::MoeOrder<0>, true, true, false>(lds, g2, S, E2, wave); }
        if (BOTH(6)) xcd_barrier(bar);
    }
    if (IN(8)) {
        PHASE_IDS();
        const int gw = vcu * NWAVES + wave, NGW = G * NWAVES;
        for (int row = gw; row < T; row += NGW) { float ss = 0.f;
#pragma unroll
            for (int hh = 0; hh < 2; ++hh) { const size_t o = (size_t)row * D + hh * 512 + lane * 8;
                pg8::f32x4 a0, a1, b0, b1, c0, c1; pg8::unpack8(__builtin_nontemporal_load((const pg8::u32x4*)(X1b + o)), a0, a1);
                pg8::unpack8(__builtin_nontemporal_load((const pg8::u32x4*)(Yb + (size_t)row * 2 * D + hh * 512 + lane * 8)), b0, b1); pg8::unpack8(__builtin_nontemporal_load((const pg8::u32x4*)(Yb + ((size_t)row * 2 + 1) * D + hh * 512 + lane * 8)), c0, c1);
                a0 = a0 + b0 + c0; a1 = a1 + b1 + c1;
                ss += (a0[0] * a0[0] + a0[1] * a0[1]) + (a0[2] * a0[2] + a0[3] * a0[3]) + (a1[0] * a1[0] + a1[1] * a1[1]) + (a1[2] * a1[2] + a1[3] * a1[3]);
                *(pg8::u32x4*)(X2b + o) = pg8::pack8(a0, a1); }
            ss = wave_sum(ss);
            if (lane == 0) RSTD2[row] = rsqrtf(ss * (1.f / D) + EPS); }
        if (BOTH(8)) xcd_barrier(bar);
    }
    const bool fuse_final = (G == 256);
    if (IN(9)) {
        { pg8::Gemm g{Pb, WupT, 256}; pg8::StaticOrder S; S.init(T, 1024, G, (int)blockIdx.x);
          pg8::EpiPlain E{PU};
          pg8::gemm_phase<pg8::EpiPlain, pg8::StaticOrder, true, true, false>(lds, g, S, E, wave); }
        pg8::Gemm g{X2b, WgT, 1024}; pg8::StaticOrder S; S.init(T, 1024, G, (int)blockIdx.x);
        if (fuse_final) {
            pg8::EpiPleFinal E{X2b, PU, RSTD2, in[27], args.out, (float*)(ws + WS_XCH), ctl + CW_PANEL, (LAS float*)(lds + RING_BYTES), wave};
            pg8::gemm_phase<pg8::EpiPleFinal, pg8::StaticOrder, true, true, false>(lds, g, S, E, wave);
        } else {
            pg8::EpiPle E{X2b, PU, RSTD2, X3, SS3};
            pg8::gemm_phase<pg8::EpiPle, pg8::StaticOrder, true, true, false>(lds, g, S, E, wave);
            if (BOTH(9)) xcd_barrier(bar);
        }
    }

    if (IN(10) && !fuse_final) {
        PHASE_IDS();
        const int gw = vcu * NWAVES + wave, NGW = G * NWAVES;
        for (int row = gw; row < T; row += NGW) { float ss = 0.f;
            if (lane < 16) ss = SS3[(size_t)row * 16 + lane];
            ss = wave_sum(ss);
            const float rstd = rsqrtf(ss * (1.f / D) + EPS);
#pragma unroll
            for (int hh = 0; hh < 2; ++hh) { const size_t o = (size_t)row * D + hh * 512 + lane * 8; pg8::f32x4 a0, a1; pg8::unpack8(*(const pg8::u32x4*)(X3 + o), a0, a1);
                const pg8::f32x4 f0 = *(const pg8::f32x4*)(in[27] + hh * 512 + lane * 8), f1 = *(const pg8::f32x4*)(in[27] + hh * 512 + lane * 8 + 4);
                *(pg8::f32x4*)(args.out + o) = a0 * rstd * f0; *(pg8::f32x4*)(args.out + o + 4) = a1 * rstd * f1; } }
    }
#undef IN
#undef BOTH
#undef PHASE_IDS
}

static int mega_grid() {
    static int grid = 0;
    if (grid == 0) {
        int dev = 0, cus = 0;
        if (hipGetDevice(&dev) != hipSuccess || hipDeviceGetAttribute(&cus, hipDeviceAttributeMultiprocessorCount, dev) != hipSuccess) { fprintf(stderr, "mega: device query failed\n"); grid = -1; return grid; }
        if (hipFuncSetAttribute((const void*)mega_fwd, hipFuncAttributeMaxDynamicSharedMemorySize, LDS_BYTES) != hipSuccess) { fprintf(stderr, "mega: hipFuncSetAttribute failed\n"); grid = -1; return grid; }
        (void)hipGetLastError();
        grid = cus;
    }
    return grid;
}
static void launch_mega(void* const* d_in, void* d_out, void* d_ws, int lo, int hi, int li, hipStream_t stream) {
    const int grid = mega_grid(); if (grid <= 0) return;
    Args a{};
    for (int i = 0; i < 28; ++i) a.in[i] = (const float*)d_in[i];
    a.out = (float*)d_out; a.ws = (unsigned char*)d_ws; a.ph_lo = lo; a.ph_hi = hi; a.li = li; a.pad = 0;
    hipLaunchKernelGGL(mega_fwd, dim3(grid), dim3(NWAVES * 64), LDS_BYTES, stream, a);
}

extern "C" void kernel_launch(void* const* d_in, const int* in_sizes, int n_in, void* d_out, int out_size, void* d_ws, size_t ws_size, hipStream_t stream) {
    if (n_in != 28 || in_sizes[0] != T * D || out_size != T * D || ws_size < WS_MEGA_END) { fprintf(stderr, "kernel_launch: unexpected shapes (n_in %d, ws %zu)\n", n_in, ws_size); return; }
    (void)hipMemsetAsync(d_ws, 0, 2 * MiB, stream);
    launch_mega(d_in, d_out, d_ws, 0, 11, 0, stream);
}
```

```cpp
#include <hip/hip_runtime.h>
#include <stdint.h>
#include <cstdio>

typedef unsigned short bf16;
constexpr int T = 16384, D = 1024, SEQ = 2048;
constexpr float EPS = 1e-6f;
constexpr size_t MiB = 1u << 20;
constexpr size_t WS_CTL = 0;
constexpr size_t WS_VPART = 2 * MiB;
constexpr size_t WS_SS1 = 4 * MiB;
constexpr size_t WS_SS3 = 5 * MiB;
constexpr size_t WS_AGG = 1 * MiB;
constexpr size_t WS_LIST = 6 * MiB;
constexpr size_t WS_TOKE = 8 * MiB;
constexpr size_t WS_TOKG = 8 * MiB + 128 * 1024;
constexpr size_t WS_RSTD2 = 8 * MiB + 256 * 1024;
constexpr size_t WS_A0 = 74 * MiB;
constexpr size_t WS_A1 = 106 * MiB;
constexpr size_t WS_A2 = 138 * MiB;
constexpr size_t WS_A3 = 170 * MiB;
constexpr size_t WS_A4 = 202 * MiB;
constexpr size_t WS_END = 234 * MiB;

__device__ __forceinline__ float bf2f(bf16 b) { return __uint_as_float(((unsigned)b) << 16); }
__device__ __forceinline__ bf16 f2bf(float f) { unsigned u = __float_as_uint(f); u += 0x7fffu + ((u >> 16) & 1u); return (bf16)(u >> 16); }
__device__ __forceinline__ float sigm(float x) { return 1.f / (1.f + expf(-x)); }
__device__ __forceinline__ float gelu_t(float x) { const float u = 0.7978845608028654f * (x + 0.044715f * x * x * x); return 0.5f * x * (1.f + tanhf(u)); }
__device__ __forceinline__ float wave_sum(float v) {
#pragma unroll
    for (int o = 1; o < 64; o <<= 1) v += __shfl_xor(v, o);
    return v;
}

#define LAS __attribute__((address_space(3)))
#define GAS __attribute__((address_space(1)))
namespace pg8 {
typedef short bf16x8 __attribute__((ext_vector_type(8)));
typedef float f32x4 __attribute__((ext_vector_type(4)));
typedef float f32x2 __attribute__((ext_vector_type(2)));
typedef unsigned u32x4 __attribute__((ext_vector_type(4)));
typedef unsigned u32x2 __attribute__((ext_vector_type(2)));
constexpr int BM = 256, BK = 64, HALF = 128, HTB = HALF * BK * 2, STAGE_BYTES = 8 * HTB, NXCD = 8, WGM = 8;

__host__ __device__ __forceinline__ int lds_byte(int r, int c) { const int st = (r >> 4) * 2 + (c >> 5), rr = r & 15, cc = c & 31, ob = rr * 64 + cc * 2; return st * 1024 + (ob ^ (((ob >> 9) & 1) << 5)); }
__host__ __device__ __forceinline__ void stage_rc(int b, int& R, int& C) { const int st = b / 1024, sb = b % 1024, swz = sb ^ (((sb >> 9) & 1) << 5); R = (st >> 1) * 16 + swz / 64; C = (st & 1) * 32 + (swz % 64) / 2; }
__host__ __device__ __forceinline__ int perm32(int rho) { const int n = rho >> 4, i = rho & 15; return 8 * (i >> 2) + 4 * n + (i & 3); }

__device__ __forceinline__ int lane_id() { int l; asm volatile("v_mbcnt_lo_u32_b32 %0, -1, 0\n\tv_mbcnt_hi_u32_b32 %0, -1, %0" : "=v"(l)); return l; }
struct Unit { int pm, pn, e, tile, cnt; };
struct Gemm { const bf16* A; const bf16* Bt; int K; };

struct StaticOrder {
    int nM, nN, nwg, G, c;
    __device__ void init(int M, int N, int G_, int c_) { nM = M / BM; nN = N / BM; nwg = nM * nN; G = G_; c = c_; }
    __device__ bool next(int i, Unit& u) const {
        const long L = (long)i * G + c; if (L >= nwg) return false;
        int wgid = (int)L; { const int q = nwg / NXCD, r = nwg % NXCD, xcd = wgid % NXCD, off = wgid / NXCD; wgid = (xcd < r ? xcd * (q + 1) : r * (q + 1) + (xcd - r) * q) + off; }
        const int nig = WGM * nN, gid = wgid / nig, fm = gid * WGM, gsz = (nM - fm) < WGM ? (nM - fm) : WGM;
        u.pm = fm + ((wgid % nig) % gsz); u.pn = (wgid % nig) / gsz; u.e = 0; u.tile = 0; u.cnt = 0; return true;
    }
    __device__ __forceinline__ unsigned row_off(const Unit&, int) const { return 0u; }
    __device__ __forceinline__ void a_ready(const Unit&) const {}
    __device__ __forceinline__ void done(const Unit&) const {}
    struct Pre {}; __device__ __forceinline__ void pre(int, Pre&) const {}
    __device__ __forceinline__ void post(int, Pre&) const {}
    __device__ __forceinline__ bool half(const Unit&) const { return false; }
};

__device__ __forceinline__ unsigned cvt_pk_bf16(float lo, float hi) { unsigned r; asm volatile("v_cvt_pk_bf16_f32 %0, %1, %2" : "=v"(r) : "v"(lo), "v"(hi)); return r; }
typedef __bf16 bf16x2_t __attribute__((ext_vector_type(2)));
__device__ __forceinline__ unsigned cvt_pk_bf16_cv(float lo, float hi) { const f32x2 v = {lo, hi}; const bf16x2_t b = __builtin_convertvector(v, bf16x2_t); return __builtin_bit_cast(unsigned, b); }
__device__ __forceinline__ float fsigm(float x) { return __builtin_amdgcn_rcpf(1.0f + __builtin_amdgcn_exp2f(-1.4426950409f * x)); }
__device__ __forceinline__ float fgelu(float x) { const float u = x + 0.044715f * x * x * x; return x * __builtin_amdgcn_rcpf(1.0f + __builtin_amdgcn_exp2f(-2.3022082f * u)); }

template <class Epi, class Sched, bool ALIGN_EPI, bool SP2, bool GATHER>
__device__ __forceinline__ void gemm_phase(LAS unsigned char* lds, const Gemm g, const Sched& S, const Epi& E, const int wave_) {
    int lane = lane_id(); asm volatile("" : "+v"(lane));
    const int wid = wave_, tid = wid * 64 + lane, wr = wid >> 2, wc = wid & 3, fr = lane & 15, fq = lane >> 4;
    const int K = g.K, nt = K / BK;
    int sR[2], sC[2];
    unsigned voffB[2], vA0[2], vA1[2], nvA0[2], nvA1[2];
#pragma unroll
    for (int i = 0; i < 2; ++i) { stage_rc(tid * 16 + i * 8192, sR[i], sC[i]); const int Rb = Epi::PERM ? ((sR[i] & ~31) + perm32(sR[i] & 31)) : sR[i];
        voffB[i] = (unsigned)(Rb * K + sC[i]) * 2u; vA0[i] = (unsigned)(sR[i] * K + sC[i]) * 2u; vA1[i] = vA0[i]; nvA0[i] = vA0[i]; nvA1[i] = vA0[i]; }
    const size_t kstep = (size_t)(BK * 2);
    const size_t hstep = (size_t)HALF * K * 2;
    const size_t tstep = 2 * hstep;
    const size_t ahs = GATHER ? 0 : hstep;
    const unsigned ldsw = (unsigned)wid * 1024u;
    const int aoff = lds_byte(wr * 64 + fr, fq * 8), boff = lds_byte(wc * 32 + fr, fq * 8);
#define PG8_SA(b, h) (((b) * 2 + (h)) * HTB)
#define PG8_SB(b, h) ((4 + (b) * 2 + (h)) * HTB)
#define PG8_STAGE(bufoff, gbase, voff) do { _Pragma("unroll") for (int _i = 0; _i < 2; ++_i) \
        __builtin_amdgcn_global_load_lds((const unsigned*)((const char*)(gbase) + (voff)[_i]), (LAS unsigned*)(lds + (bufoff) + ldsw + _i * 8192), 16, 0, 0); } while (0)
#define PG8_LDA(dst, b, h) do { _Pragma("unroll") for (int m = 0; m < 4; ++m) _Pragma("unroll") for (int k = 0; k < 2; ++k) dst[m][k] = *(const LAS bf16x8*)(lds + PG8_SA(b, h) + aoff + m * 2048 + k * 1024); } while (0)
#define PG8_LDB(dst, b, h) do { _Pragma("unroll") for (int n = 0; n < 2; ++n) _Pragma("unroll") for (int k = 0; k < 2; ++k) dst[n][k] = *(const LAS bf16x8*)(lds + PG8_SB(b, h) + boff + n * 2048 + k * 1024); } while (0)
#define PG8_MMA(ai, bj, At, Bt) do { __builtin_amdgcn_s_setprio(1); _Pragma("unroll") for (int m = 0; m < 4; ++m) _Pragma("unroll") for (int n = 0; n < 2; ++n) _Pragma("unroll") for (int k = 0; k < 2; ++k) \
        acc[ai][bj][m][n] = __builtin_amdgcn_mfma_f32_16x16x32_bf16(Bt[n][k], At[m][k], acc[ai][bj][m][n], 0, 0, 0); __builtin_amdgcn_s_setprio(0); } while (0)
#define PG8_WAIT_V(n) asm volatile("s_waitcnt vmcnt(" #n ")" ::: "memory")
#define PG8_WAIT_L(n) asm volatile("s_waitcnt lgkmcnt(" #n ")" ::: "memory")
#define PG8_BAR __builtin_amdgcn_s_barrier()
#define PG8_SCHED __builtin_amdgcn_sched_barrier(0)
    Unit cur, nxt; int ui = 0;
    if (!S.next(0, cur)) return;
    f32x4 acc[2][2][4][2];
#pragma unroll
    for (int a = 0; a < 2; ++a)
#pragma unroll
        for (int b = 0; b < 2; ++b)
#pragma unroll
            for (int m = 0; m < 4; ++m)
#pragma unroll
                for (int n = 0; n < 2; ++n) acc[a][b][m][n] = (f32x4){0.f, 0.f, 0.f, 0.f};
    bf16x8 At[4][2], B0[2][2], B1[2][2];
    const char* cA = GATHER ? (const char*)g.A : (const char*)g.A + (size_t)cur.pm * tstep; const char* cB = (const char*)g.Bt + (size_t)cur.pn * tstep;
    if constexpr (GATHER) {
#pragma unroll
        for (int i = 0; i < 2; ++i) { vA0[i] = S.row_off(cur, sR[i]) + (unsigned)sC[i] * 2u; vA1[i] = S.row_off(cur, HALF + sR[i]) + (unsigned)sC[i] * 2u; nvA0[i] = vA0[i]; nvA1[i] = vA1[i]; }
    }
    S.a_ready(cur);
    if constexpr (SP2) {
        PG8_STAGE(PG8_SB(0, 0), cB, voffB); PG8_STAGE(PG8_SB(0, 1), cB + hstep, voffB); PG8_STAGE(PG8_SA(0, 0), cA, vA0); PG8_STAGE(PG8_SA(0, 1), cA + ahs, vA1);
        if (wr == 1) PG8_BAR;
        PG8_WAIT_V(2); PG8_BAR;
        PG8_STAGE(PG8_SB(1, 0), cB + kstep, voffB); PG8_STAGE(PG8_SA(1, 0), cA + kstep, vA0); PG8_STAGE(PG8_SB(1, 1), cB + hstep + kstep, voffB);
        PG8_WAIT_V(6); PG8_BAR;
    } else {
        PG8_STAGE(PG8_SB(0, 0), cB, voffB); PG8_STAGE(PG8_SA(0, 0), cA, vA0); PG8_STAGE(PG8_SB(0, 1), cB + hstep, voffB); PG8_STAGE(PG8_SA(0, 1), cA + ahs, vA1);
        if (wr == 1) PG8_BAR;
        PG8_WAIT_V(4); PG8_BAR;
        PG8_STAGE(PG8_SB(1, 0), cB + kstep, voffB); PG8_STAGE(PG8_SA(1, 0), cA + kstep, vA0); PG8_STAGE(PG8_SB(1, 1), cB + hstep + kstep, voffB);
        PG8_WAIT_V(6); PG8_BAR;
    }
    for (;;) {
        const bool has_next = S.next(ui + 1, nxt);
        const char* nA = has_next ? (GATHER ? (const char*)g.A : (const char*)g.A + (size_t)nxt.pm * tstep) : cA; const char* nB = has_next ? (const char*)g.Bt + (size_t)nxt.pn * tstep : cB;
        const bool hf = S.half(cur);
        for (int t = 0; t < nt; t += 2) {
            const bool last = (t == nt - 2);
            const char* a1 = cA + (size_t)(t + 1) * kstep;
            const char* a2 = last ? nA : cA + (size_t)(t + 2) * kstep; const char* b2 = last ? nB : cB + (size_t)(t + 2) * kstep;
            const char* a3 = a2 + kstep; const char* b3 = b2 + kstep;
            if (last && has_next) S.a_ready(nxt);
            unsigned w0[2], w1[2];
            if constexpr (GATHER) {
                if (last && has_next) {
#pragma unroll
                    for (int i = 0; i < 2; ++i) { nvA0[i] = S.row_off(nxt, sR[i]) + (unsigned)sC[i] * 2u; nvA1[i] = S.row_off(nxt, HALF + sR[i]) + (unsigned)sC[i] * 2u; }
                }
#pragma unroll
                for (int i = 0; i < 2; ++i) { w0[i] = last ? nvA0[i] : vA0[i]; w1[i] = last ? nvA1[i] : vA1[i]; }
            } else {
#pragma unroll
                for (int i = 0; i < 2; ++i) { w0[i] = vA0[i]; w1[i] = vA0[i]; }
            }
            if constexpr (SP2) {
            PG8_LDB(B0, 0, 0); PG8_LDB(B1, 0, 1); PG8_SCHED; PG8_LDA(At, 0, 0); PG8_STAGE(PG8_SA(1, 1), a1 + ahs, vA1);
            PG8_WAIT_V(8); PG8_WAIT_L(0); PG8_BAR; PG8_MMA(0, 0, At, B0); PG8_MMA(0, 1, At, B1); PG8_BAR; PG8_SCHED;
            if (!hf) PG8_LDA(At, 0, 1); PG8_STAGE(PG8_SB(0, 0), b2, voffB); PG8_STAGE(PG8_SB(0, 1), b2 + hstep, voffB); PG8_STAGE(PG8_SA(0, 0), a2, w0);
            PG8_WAIT_V(8); PG8_WAIT_L(0); PG8_BAR; if (!hf) { PG8_MMA(1, 0, At, B0); PG8_MMA(1, 1, At, B1); } PG8_BAR; PG8_SCHED;
            PG8_LDB(B0, 1, 0); PG8_LDB(B1, 1, 1); PG8_SCHED; PG8_LDA(At, 1, 0); PG8_STAGE(PG8_SA(0, 1), a2 + ahs, w1);
            PG8_WAIT_V(8); PG8_WAIT_L(0); PG8_BAR; PG8_MMA(0, 0, At, B0); PG8_MMA(0, 1, At, B1); PG8_BAR; PG8_SCHED;
            if (!hf) PG8_LDA(At, 1, 1); PG8_STAGE(PG8_SB(1, 0), b3, voffB); PG8_STAGE(PG8_SB(1, 1), b3 + hstep, voffB); PG8_STAGE(PG8_SA(1, 0), a3, w0);
            PG8_WAIT_V(8); PG8_WAIT_L(0); PG8_BAR; if (!hf) { PG8_MMA(1, 0, At, B0); PG8_MMA(1, 1, At, B1); } PG8_BAR; PG8_SCHED;
            } else {
            PG8_LDB(B0, 0, 0); PG8_SCHED; PG8_LDA(At, 0, 0); PG8_STAGE(PG8_SA(1, 1), a1 + ahs, vA1);
            PG8_WAIT_L(8); PG8_BAR; PG8_WAIT_L(0); PG8_MMA(0, 0, At, B0); PG8_BAR; PG8_SCHED;
            PG8_LDB(B1, 0, 1); PG8_STAGE(PG8_SB(0, 0), b2, voffB);
            PG8_BAR; PG8_WAIT_L(0); PG8_MMA(0, 1, At, B1); PG8_BAR;
            PG8_LDA(At, 0, 1); PG8_STAGE(PG8_SA(0, 0), a2, w0);
            PG8_BAR; PG8_WAIT_L(0); PG8_MMA(1, 0, At, B0); PG8_BAR; PG8_SCHED;
            PG8_STAGE(PG8_SB(0, 1), b2 + hstep, voffB);
            PG8_WAIT_V(6); PG8_BAR; PG8_MMA(1, 1, At, B1); PG8_BAR;
            PG8_LDB(B0, 1, 0); PG8_SCHED; PG8_LDA(At, 1, 0); PG8_STAGE(PG8_SA(0, 1), a2 + ahs, w1);
            PG8_WAIT_L(8); PG8_BAR; PG8_WAIT_L(0); PG8_MMA(0, 0, At, B0); PG8_BAR; PG8_SCHED;
            PG8_LDB(B1, 1, 1); PG8_STAGE(PG8_SB(1, 0), b3, voffB);
            PG8_BAR; PG8_WAIT_L(0); PG8_MMA(0, 1, At, B1); PG8_BAR;
            PG8_LDA(At, 1, 1); PG8_STAGE(PG8_SA(1, 0), a3, w0);
            PG8_BAR; PG8_WAIT_L(0); PG8_MMA(1, 0, At, B0); PG8_BAR; PG8_SCHED;
            PG8_STAGE(PG8_SB(1, 1), b3 + hstep, voffB);
            PG8_WAIT_V(6); PG8_BAR; PG8_MMA(1, 1, At, B1); PG8_BAR;
            }
        }
        typename Sched::Pre pre_; S.pre(ui, pre_);
        if constexpr (ALIGN_EPI) { if (wr == 0) PG8_BAR; }
        E(acc, cur, wr, wc, fr, fq); S.done(cur); S.post(ui, pre_);
        if (!has_next) break;
#pragma unroll
        for (int a = 0; a < 2; ++a)
#pragma unroll
            for (int b = 0; b < 2; ++b)
#pragma unroll
                for (int m = 0; m < 4; ++m)
#pragma unroll
                    for (int n = 0; n < 2; ++n) acc[a][b][m][n] = (f32x4){0.f, 0.f, 0.f, 0.f};
        cur = nxt; cA = nA; cB = nB; ++ui;
        if constexpr (GATHER) {
#pragma unroll
            for (int i = 0; i < 2; ++i) { vA0[i] = nvA0[i]; vA1[i] = nvA1[i]; }
        }
        if constexpr (ALIGN_EPI) { if (wr == 1) PG8_BAR; }
    }
    PG8_WAIT_V(0);
    if constexpr (!ALIGN_EPI) { if (wr == 0) PG8_BAR; }
    PG8_BAR;
#undef PG8_SA
#undef PG8_SB
#undef PG8_STAGE
#undef PG8_LDA
#undef PG8_LDB
#undef PG8_MMA
#undef PG8_WAIT_V
#undef PG8_WAIT_L
#undef PG8_BAR
#undef PG8_SCHED
}

__device__ __forceinline__ u32x4 pack8(const f32x4 v0, const f32x4 v1) { u32x4 w; w.x = cvt_pk_bf16(v0[0], v0[1]); w.y = cvt_pk_bf16(v0[2], v0[3]); w.z = cvt_pk_bf16(v1[0], v1[1]); w.w = cvt_pk_bf16(v1[2], v1[3]); return w; }
__device__ __forceinline__ void unpack8(const u32x4 w, f32x4& v0, f32x4& v1) {
    v0[0] = __uint_as_float(w.x << 16); v0[1] = __uint_as_float(w.x & 0xffff0000u); v0[2] = __uint_as_float(w.y << 16); v0[3] = __uint_as_float(w.y & 0xffff0000u);
    v1[0] = __uint_as_float(w.z << 16); v1[1] = __uint_as_float(w.z & 0xffff0000u); v1[2] = __uint_as_float(w.w << 16); v1[3] = __uint_as_float(w.w & 0xffff0000u); }

struct Epi1 {
    static constexpr bool PERM = true;
    bf16 *Zl, *GA, *UB, *V; float* VPART;
    __device__ __forceinline__ void operator()(const f32x4 (&acc)[2][2][4][2], const Unit& u, int wr, int wc, int fr, int fq) const {
        const int row0 = u.pm * BM + wr * 64 + fr, pn = u.pn;
        if (pn < 4) {
            const int col0 = pn * 256 + wc * 32 + 8 * fq;
#pragma unroll
            for (int ai = 0; ai < 2; ++ai)
#pragma unroll
                for (int m = 0; m < 4; ++m) { bf16* rowp = Zl + (size_t)(row0 + ai * HALF + m * 16) * D + col0;
#pragma unroll
                    for (int bj = 0; bj < 2; ++bj) *(u32x4*)(rowp + bj * HALF) = pack8(acc[ai][bj][m][0], acc[ai][bj][m][1]); }
        } else if (pn < 20) {
            bf16* O = pn < 12 ? GA : UB; const int uu = pn < 12 ? pn - 4 : pn - 12; const int col0 = uu * 128 + wc * 32 + 8 * fq;
#pragma unroll
            for (int ai = 0; ai < 2; ++ai)
#pragma unroll
                for (int m = 0; m < 4; ++m) { f32x4 v[2];
#pragma unroll
                    for (int n = 0; n < 2; ++n)
#pragma unroll
                        for (int i = 0; i < 4; ++i) v[n][i] = fgelu(acc[ai][0][m][n][i]) * fsigm(acc[ai][1][m][n][i]);
                    *(u32x4*)(O + (size_t)(row0 + ai * HALF + m * 16) * D + col0) = pack8(v[0], v[1]); }
        } else {
            const int col0 = (pn - 20) * 256 + wc * 32 + 8 * fq;
#pragma unroll
            for (int ai = 0; ai < 2; ++ai)
#pragma unroll
                for (int m = 0; m < 4; ++m) { const int row = row0 + ai * HALF + m * 16; float s1 = 0.f, s2 = 0.f;
#pragma unroll
                    for (int bj = 0; bj < 2; ++bj) { f32x4 v[2];
#pragma unroll
                        for (int n = 0; n < 2; ++n)
#pragma unroll
                            for (int i = 0; i < 4; ++i) { const float gv = fgelu(acc[ai][bj][m][n][i]); v[n][i] = gv; s1 += gv; s2 += gv * gv; }
                        *(u32x4*)(V + (size_t)row * D + col0 + bj * HALF) = pack8(v[0], v[1]); }
                    s1 += __shfl_xor(s1, 16); s1 += __shfl_xor(s1, 32); s2 += __shfl_xor(s2, 16); s2 += __shfl_xor(s2, 32);
                    if (fq == 0) *(f32x2*)(VPART + (size_t)row * 32 + ((pn - 20) * 4 + wc) * 2) = (f32x2){s1, s2}; }
        }
    }
};
struct EpiPlain {
    static constexpr bool PERM = true;
    bf16* O;
    __device__ __forceinline__ void operator()(const f32x4 (&acc)[2][2][4][2], const Unit& u, int wr, int wc, int fr, int fq) const {
        const int row0 = u.pm * BM + wr * 64 + fr, col0 = u.pn * 256 + wc * 32 + 8 * fq;
#pragma unroll
        for (int ai = 0; ai < 2; ++ai)
#pragma unroll
            for (int m = 0; m < 4; ++m) { bf16* rowp = O + (size_t)(row0 + ai * HALF + m * 16) * D + col0;
#pragma unroll
                for (int bj = 0; bj < 2; ++bj) *(u32x4*)(rowp + bj * HALF) = pack8(acc[ai][bj][m][0], acc[ai][bj][m][1]); }
    }
};
struct Epi2 {
    static constexpr bool PERM = true;
    const bf16* XN; const float* RI0; const float* GINV; bf16* X1b; float* SS1;
    __device__ __forceinline__ void operator()(const f32x4 (&acc)[2][2][4][2], const Unit& u, int wr, int wc, int fr, int fq) const {
        const int row0 = u.pm * BM + wr * 64 + fr, col0 = u.pn * 256 + wc * 32 + 8 * fq;
#pragma unroll
        for (int ai = 0; ai < 2; ++ai)
#pragma unroll
            for (int m = 0; m < 4; ++m) { const int row = row0 + ai * HALF + m * 16; float ss = 0.f; const float ri = RI0[row];
#pragma unroll
                for (int bj = 0; bj < 2; ++bj) { f32x4 x0, x1; unpack8(__builtin_nontemporal_load((const u32x4*)(XN + (size_t)row * D + col0 + bj * HALF)), x0, x1);
                    const f32x4 g0 = *(const f32x4*)(GINV + col0 + bj * HALF), g1 = *(const f32x4*)(GINV + col0 + bj * HALF + 4);
                    const f32x4 v0 = acc[ai][bj][m][0] + x0 * ri * g0, v1 = acc[ai][bj][m][1] + x1 * ri * g1;
                    ss += (v0[0] * v0[0] + v0[1] * v0[1]) + (v0[2] * v0[2] + v0[3] * v0[3]) + (v1[0] * v1[0] + v1[1] * v1[1]) + (v1[2] * v1[2] + v1[3] * v1[3]);
                    *(u32x4*)(X1b + (size_t)row * D + col0 + bj * HALF) = pack8(v0, v1); }
                ss += __shfl_xor(ss, 16); ss += __shfl_xor(ss, 32);
                if (fq == 0) SS1[(size_t)row * 16 + u.pn * 4 + wc] = ss; }
    }
};
struct EpiPle {
    static constexpr bool PERM = true;
    const bf16* X2b; const bf16* PU; const float* RSTD2; bf16* X3; float* SS3;
    __device__ __forceinline__ void operator()(const f32x4 (&acc)[2][2][4][2], const Unit& u, int wr, int wc, int fr, int fq) const {
        const int row0 = u.pm * BM + wr * 64 + fr, col0 = u.pn * 256 + wc * 32 + 8 * fq;
#pragma unroll
        for (int ai = 0; ai < 2; ++ai)
#pragma unroll
            for (int m = 0; m < 4; ++m) { const int row = row0 + ai * HALF + m * 16; float ss = 0.f; const float r2 = RSTD2[row];
#pragma unroll
                for (int bj = 0; bj < 2; ++bj) { const size_t o = (size_t)row * D + col0 + bj * HALF;
                    f32x4 x0, x1, p0, p1; unpack8(*(const u32x4*)(X2b + o), x0, x1); unpack8(*(const u32x4*)(PU + o), p0, p1);
                    f32x4 v0, v1;
#pragma unroll
                    for (int i = 0; i < 4; ++i) { v0[i] = x0[i] + fsigm(r2 * acc[ai][bj][m][0][i]) * p0[i]; v1[i] = x1[i] + fsigm(r2 * acc[ai][bj][m][1][i]) * p1[i]; }
                    ss += (v0[0] * v0[0] + v0[1] * v0[1]) + (v0[2] * v0[2] + v0[3] * v0[3]) + (v1[0] * v1[0] + v1[1] * v1[1]) + (v1[2] * v1[2] + v1[3] * v1[3]);
                    *(u32x4*)(X3 + o) = pack8(v0, v1); }
                ss += __shfl_xor(ss, 16); ss += __shfl_xor(ss, 32);
                if (fq == 0) SS3[(size_t)row * 16 + u.pn * 4 + wc] = ss; }
    }
};

struct EpiPleFinal {
    static constexpr bool PERM = true;
    const bf16* X2b; const bf16* PU; const float* RSTD2; const float* fn; float* out; float* XCH; unsigned* cnt; LAS float* xl; int wave;
    __device__ __forceinline__ void operator()(f32x4 (&acc)[2][2][4][2], const Unit& u, int wr, int wc, int fr, int fq) const {
        const int tid = wave * 64 + lane_id();
        const int rl0 = wr * 64 + fr, col0 = u.pn * 256 + wc * 32 + 8 * fq;
#pragma unroll
        for (int ai = 0; ai < 2; ++ai)
#pragma unroll
            for (int m = 0; m < 4; ++m) { const int rl = rl0 + ai * HALF + m * 16, row = u.pm * BM + rl; float ss = 0.f; const float r2 = RSTD2[row];
#pragma unroll
                for (int bj = 0; bj < 2; ++bj) { const size_t o = (size_t)row * D + col0 + bj * HALF;
                    f32x4 x0, x1, p0, p1; unpack8(*(const u32x4*)(X2b + o), x0, x1); unpack8(*(const u32x4*)(PU + o), p0, p1);
                    f32x4 v0, v1;
#pragma unroll
                    for (int i = 0; i < 4; ++i) { v0[i] = x0[i] + fsigm(r2 * acc[ai][bj][m][0][i]) * p0[i]; v1[i] = x1[i] + fsigm(r2 * acc[ai][bj][m][1][i]) * p1[i]; }
                    ss += (v0[0] * v0[0] + v0[1] * v0[1]) + (v0[2] * v0[2] + v0[3] * v0[3]) + (v1[0] * v1[0] + v1[1] * v1[1]) + (v1[2] * v1[2] + v1[3] * v1[3]);
                    acc[ai][bj][m][0] = v0; acc[ai][bj][m][1] = v1; }
                ss += __shfl_xor(ss, 16); ss += __shfl_xor(ss, 32);
                if (fq == 0) xl[rl * 4 + wc] = ss; }
        __syncthreads();
        if (tid < 256) { const f32x4 p = *(const LAS f32x4*)(xl + tid * 4);
            __hip_atomic_store(XCH + (size_t)(u.pm * BM + tid) * 4 + u.pn, (p[0] + p[1]) + (p[2] + p[3]), __ATOMIC_RELAXED, __HIP_MEMORY_SCOPE_AGENT); }
        asm volatile("s_waitcnt vmcnt(0)" ::: "memory");
        if (tid < 256 && (tid & 63) == 0) __hip_atomic_fetch_add(cnt + 64 * u.pm, 1u, __ATOMIC_RELAXED, __HIP_MEMORY_SCOPE_AGENT);
        if (tid < 64) { unsigned sp = 0;
            while ((unsigned)__builtin_amdgcn_readfirstlane(__hip_atomic_load(cnt + 64 * u.pm, __ATOMIC_RELAXED, __HIP_MEMORY_SCOPE_AGENT)) < 16u) { if (++sp > (1u << 22)) break; __builtin_amdgcn_s_sleep(1); } }
        __syncthreads();
        if (tid < 256) { const float* xs = XCH + (size_t)(u.pm * BM + tid) * 4; float tot = 0.f;
#pragma unroll
            for (int q = 0; q < 4; ++q) tot += __hip_atomic_load(xs + q, __ATOMIC_RELAXED, __HIP_MEMORY_SCOPE_AGENT);
            xl[1024 + tid] = rsqrtf(tot * (1.f / D) + EPS); }
        __syncthreads();
#pragma unroll
        for (int ai = 0; ai < 2; ++ai)
#pragma unroll
            for (int m = 0; m < 4; ++m) { const int rl = rl0 + ai * HALF + m * 16; const float rs = xl[1024 + rl]; float* op = out + (size_t)(u.pm * BM + rl) * D + col0;
#pragma unroll
                for (int bj = 0; bj < 2; ++bj) { const f32x4 f0 = *(const f32x4*)(fn + col0 + bj * HALF), f1 = *(const f32x4*)(fn + col0 + bj * HALF + 4);
                    *(f32x4*)(op + bj * HALF) = acc[ai][bj][m][0] * rs * f0; *(f32x4*)(op + bj * HALF + 4) = acc[ai][bj][m][1] * rs * f1; } }
    }
};

template <int MODE> struct MoeOrder {
    const LAS int* tab; const int* LIST; unsigned* dcnt;
    __device__ __forceinline__ bool next(int i, Unit& u) const {
        const int n = __builtin_amdgcn_readfirstlane(tab[0]); if (i >= n) return false;
        const LAS int* p = tab + 4 + 8 * i;
        u.pm = __builtin_amdgcn_readfirstlane(p[0]); u.pn = __builtin_amdgcn_readfirstlane(p[1]); u.e = __builtin_amdgcn_readfirstlane(p[2]);
        u.tile = __builtin_amdgcn_readfirstlane(p[3]); u.cnt = __builtin_amdgcn_readfirstlane(p[4]); return true;
    }
    __device__ __forceinline__ unsigned row_off(const Unit& u, int r) const { int idx = u.tile * 256 + r; idx = idx < u.cnt ? idx : u.cnt - 1; const int pair = LIST[u.e * 16384 + idx]; return (unsigned)(pair >> 1) * 2048u; }
    __device__ __forceinline__ void a_ready(const Unit&) const {}
    struct Pre {}; __device__ __forceinline__ void pre(int, Pre&) const {}
    __device__ __forceinline__ void post(int, Pre&) const {}
    __device__ __forceinline__ bool half(const Unit& u) const { return MODE == 1 && (u.cnt - u.tile * 256) <= 128; }
    __device__ __forceinline__ void done(const Unit& u) const {
        if constexpr (MODE == 1) {
            asm volatile("s_waitcnt vmcnt(0)" ::: "memory");
            if (lane_id() == 0) __hip_atomic_fetch_add(dcnt + 64 * u.pm, 1u, __ATOMIC_RELAXED, __HIP_MEMORY_SCOPE_AGENT);
        }
    }
};
__device__ __forceinline__ void store16_sc1(void* p, u32x4 v) { asm volatile("global_store_dwordx4 %0, %1, off sc1\n\ts_nop 1" :: "v"(p), "v"(v) : "memory"); }
struct EpiMoe1 {
    static constexpr bool PERM = true;
    bf16* H; const int* LIST; const float* RSTD1;
    __device__ __forceinline__ void operator()(const f32x4 (&acc)[2][2][4][2], const Unit& u, int wr, int wc, int fr, int fq) const {
        const int col0 = (u.pn & 1) * 128 + wc * 32 + 8 * fq;
#pragma unroll
        for (int ai = 0; ai < 2; ++ai)
#pragma unroll
            for (int m = 0; m < 4; ++m) { const int r = ai * HALF + wr * 64 + m * 16 + fr; int idx = u.tile * 256 + r; idx = idx < u.cnt ? idx : u.cnt - 1;
                const int pair = LIST[u.e * 16384 + idx]; const float rs = RSTD1[pair >> 1]; f32x4 v[2];
#pragma unroll
                for (int n = 0; n < 2; ++n)
#pragma unroll
                    for (int i = 0; i < 4; ++i) { const float a1 = rs * acc[ai][0][m][n][i], a3 = rs * acc[ai][1][m][n][i]; v[n][i] = a1 * fsigm(a1) * a3; }
                store16_sc1(H + (size_t)(u.pm * 256 + r) * 256 + col0, pack8(v[0], v[1])); }
    }
};
struct EpiMoe2 {
    static constexpr bool PERM = true;
    bf16* Y; const int* LIST; const float* TOKG;
    __device__ __forceinline__ void operator()(const f32x4 (&acc)[2][2][4][2], const Unit& u, int wr, int wc, int fr, int fq) const {
        const int col0 = (u.pn & 3) * 256 + wc * 32 + 8 * fq;
        int pr[2][4]; float gt[2][4];
#pragma unroll
        for (int ai = 0; ai < 2; ++ai)
#pragma unroll
            for (int m = 0; m < 4; ++m) { int idx = u.tile * 256 + ai * HALF + wr * 64 + m * 16 + fr; idx = idx < u.cnt ? idx : u.cnt - 1; pr[ai][m] = LIST[u.e * 16384 + idx]; }
#pragma unroll
        for (int ai = 0; ai < 2; ++ai)
#pragma unroll
            for (int m = 0; m < 4; ++m) gt[ai][m] = TOKG[pr[ai][m]];
#pragma unroll
        for (int ai = 0; ai < 2; ++ai)
#pragma unroll
            for (int m = 0; m < 4; ++m) { const int idx = u.tile * 256 + ai * HALF + wr * 64 + m * 16 + fr;
                if (idx < u.cnt) { const float g = gt[ai][m]; bf16* yp = Y + (size_t)pr[ai][m] * D + col0;
#pragma unroll
                    for (int bj = 0; bj < 2; ++bj) *(u32x4*)(yp + bj * HALF) = pack8(acc[ai][bj][m][0] * g, acc[ai][bj][m][1] * g); } }
    }
};
}

constexpr int NWAVES = 8;
constexpr int RING_BYTES = 131072, LDSCTL_OFF = 139264, MISC_OFF = LDSCTL_OFF + 320, TAB_OFF = LDSCTL_OFF + 512, LDS_BYTES = 147456;
constexpr size_t WS_WLRU = 8 * MiB + 512 * 1024;
constexpr size_t WS_WSGU = 8 * MiB + 768 * 1024;
constexpr size_t WS_WR = 9 * MiB;
constexpr size_t WS_WUP = 9 * MiB + 512 * 1024;
constexpr size_t WS_WIN = 10 * MiB;
constexpr size_t WS_WOUT = 22 * MiB;
constexpr size_t WS_WG = 24 * MiB;
constexpr size_t WS_W13 = 26 * MiB;
constexpr size_t WS_W2 = 58 * MiB;
constexpr size_t WS_PB = 234 * MiB;
constexpr size_t WS_RSTD1 = 242 * MiB;
constexpr size_t WS_RSTD0 = 242 * MiB + 128 * 1024;
constexpr size_t WS_GINV = 242 * MiB + 256 * 1024;
constexpr size_t WS_SPL8 = 242 * MiB + 512 * 1024;
constexpr size_t WS_XCH = 243 * MiB;
constexpr size_t WS_MEGA_END = 244 * MiB;
constexpr int CW_BAR = 4096;
constexpr int CW_DONE1 = 131072;
constexpr int CW_PANEL = 65536;

typedef GAS unsigned gu32;
#define RLX_AGENT __ATOMIC_RELAXED, __HIP_MEMORY_SCOPE_AGENT
#define LDS_WAIT() asm volatile("s_waitcnt lgkmcnt(0)" ::: "memory")
#define VM_WAIT() asm volatile("s_waitcnt vmcnt(0)" ::: "memory")

#define XB_TMO      128
#define XB_XCNT(j)  (256  + 64 * (j))
#define XB_XSUB(j)  (1280 + 64 * (j))
#define XB_XGEN(j)  (2304 + 64 * (j))
#define XB_TOP      3328
#define XB_TOPGEN   3392
#define XCD_BAR_WORDS 3456
#define XB_SPIN_CAP (1u << 18)
__device__ __forceinline__ unsigned xb_ld(unsigned* p)              { return __hip_atomic_load(p, __ATOMIC_RELAXED, __HIP_MEMORY_SCOPE_AGENT); }
__device__ __forceinline__ unsigned xb_add(unsigned* p, unsigned v) { return __hip_atomic_fetch_add(p, v, __ATOMIC_RELAXED, __HIP_MEMORY_SCOPE_AGENT); }
__device__ __forceinline__ unsigned xb_xcc_id() { return (unsigned)__builtin_amdgcn_s_getreg((3 << 11) | 20) & 0xFu; }
#define XB_SPIN(cond, bar) do { unsigned _sp = 0; while (cond) { __builtin_amdgcn_s_sleep(1); \
    if ((++_sp & 255u) == 0u) { if (xb_ld(&(bar)[XB_TMO])) break; if (_sp > XB_SPIN_CAP) { atomicAdd(&(bar)[XB_TMO], 1u); break; } } } } while (0)
struct XcdBarrier { unsigned* bar; unsigned x; volatile LAS unsigned* st; int wave; };
__device__ __forceinline__ XcdBarrier xcd_barrier_post(unsigned* bar, volatile LAS unsigned* st, int wave) {
    XcdBarrier b; b.bar = bar; b.x = xb_xcc_id(); b.st = st; b.wave = wave;
    if (wave == 0 && pg8::lane_id() == 0) (void)xb_add(&bar[XB_XCNT(b.x)], 1u);
    return b;
}
__device__ __forceinline__ void xcd_barrier_complete(unsigned* bar, unsigned x, unsigned& nloc, unsigned& nx) {
    const unsigned G = gridDim.x * gridDim.y * gridDim.z;
    unsigned sum, cnt, mine, sp = 0u;
    for (;;) {
        sum = 0u; cnt = 0u; mine = 0u;
#pragma unroll
        for (unsigned j = 0; j < 16; ++j) { const unsigned c = xb_ld(&bar[XB_XCNT(j)]); sum += c; cnt += (c > 0u) ? 1u : 0u; mine = (j == x) ? c : mine; }
        if (sum == G) break;
        __builtin_amdgcn_s_sleep(1);
        if ((++sp & 255u) == 0u) { if (xb_ld(&bar[XB_TMO])) break; if (sp > XB_SPIN_CAP) { atomicAdd(&bar[XB_TMO], 1u); break; } }
    }
    nloc = mine > 0u ? mine : 1u; nx = cnt > 0u ? cnt : 1u;
}
__device__ __forceinline__ void xcd_barrier(const XcdBarrier& b) {
    asm volatile("s_waitcnt vmcnt(0)" ::: "memory");
    __syncthreads();
    if (b.wave == 0 && pg8::lane_id() == 0) {
        unsigned* bar = b.bar;
        __builtin_amdgcn_s_waitcnt(0);
        unsigned nloc = b.st[0], nx = b.st[1];
        if (nloc == 0u) { xcd_barrier_complete(bar, b.x, nloc, nx); b.st[0] = nloc; b.st[1] = nx; }
        const unsigned old = xb_add(&bar[XB_XSUB(b.x)], 1u);
        const unsigned gen = old / nloc;
        if (old + 1u == (gen + 1u) * nloc) {
            __builtin_amdgcn_fence(__ATOMIC_RELEASE, "agent");
            asm volatile("s_waitcnt vmcnt(0)" ::: "memory");
            const unsigned og = xb_add(&bar[XB_TOP], 1u);
            const unsigned tg = og / nx;
            if (og + 1u == (tg + 1u) * nx) xb_add(&bar[XB_TOPGEN], 1u);
            else XB_SPIN(xb_ld(&bar[XB_TOPGEN]) == tg, bar);
            __builtin_amdgcn_fence(__ATOMIC_ACQUIRE, "agent");
            xb_add(&bar[XB_XGEN(b.x)], 1u);
            asm volatile("s_waitcnt vmcnt(0)" ::: "memory");
        } else {
            XB_SPIN(xb_ld(&bar[XB_XGEN(b.x)]) == gen, bar);
            __builtin_amdgcn_fence(__ATOMIC_ACQUIRE, "agent");
            asm volatile("s_waitcnt vmcnt(0)" ::: "memory");
        }
    }
    __syncthreads();
}

__device__ __forceinline__ unsigned pk2(float lo, float hi) { return (unsigned)f2bf(lo) | ((unsigned)f2bf(hi) << 16); }

struct TrItem { pg8::f32x4 v[8]; };
template <bool NT = false> __device__ __forceinline__ void tr_load(TrItem& t, const float* __restrict__ W, int ldn, int k0, int n_src0, int lane) {
    const int kb = lane >> 3, n4 = lane & 7;
    const float* src = W + (size_t)(k0 + 8 * kb) * ldn + n_src0 + 4 * n4;
#pragma unroll
    for (int q = 0; q < 8; ++q) t.v[q] = NT ? __builtin_nontemporal_load((const pg8::f32x4*)(src + (size_t)q * ldn)) : *(const pg8::f32x4*)(src + (size_t)q * ldn);
}
template <bool NT = false> __device__ __forceinline__ void tr_store(TrItem& t, int k0, bf16* __restrict__ WT, int Kd, int drow0, const float* __restrict__ gk, int lane) {
    const int kb = lane >> 3, n4 = lane & 7;
    if (gk) { const pg8::f32x4 g0 = *(const pg8::f32x4*)(gk + k0 + 8 * kb), g1 = *(const pg8::f32x4*)(gk + k0 + 8 * kb + 4);
#pragma unroll
        for (int q = 0; q < 8; ++q) t.v[q] = t.v[q] * (q < 4 ? g0[q & 3] : g1[q & 3]); }
#pragma unroll
    for (int i = 0; i < 4; ++i) { pg8::u32x4 o; o.x = pk2(t.v[0][i], t.v[1][i]); o.y = pk2(t.v[2][i], t.v[3][i]); o.z = pk2(t.v[4][i], t.v[5][i]); o.w = pk2(t.v[6][i], t.v[7][i]);
        if (NT) __builtin_nontemporal_store(o, (pg8::u32x4*)(WT + (size_t)(drow0 + 4 * n4 + i) * Kd + k0 + 8 * kb)); else *(pg8::u32x4*)(WT + (size_t)(drow0 + 4 * n4 + i) * Kd + k0 + 8 * kb) = o; }
}
__device__ __forceinline__ void p0_transpose_item(const float* __restrict__ W, int ldn, int k0, int n_src0, bf16* __restrict__ WT, int Kd, int drow0, const float* __restrict__ gk, LAS float*, int lane) {
    TrItem t; tr_load<true>(t, W, ldn, k0, n_src0, lane); tr_store(t, k0, WT, Kd, drow0, gk, lane);
}
__device__ __forceinline__ int win_dest_row(int n) {
    const int grp = n >> 10, j = n & 1023;
    switch (grp) {
        case 0: return j;
        case 1: return 1024 + (j >> 7) * 256 + (j & 127);
        case 2: return 3072 + (j >> 7) * 256 + (j & 127);
        case 3: return 5120 + j;
        case 4: return 1024 + (j >> 7) * 256 + 128 + (j & 127);
        default: return 3072 + (j >> 7) * 256 + 128 + (j & 127);
    }
}


struct DefW { const float* const* in; unsigned char* ws; };
constexpr int DF_OUT = 8 * 32, DF_E13 = 32 * 2 * 64, DF_E2 = 32 * 64, DF_G = 8 * 32, DF_UP = 2 * 32, DF_N = DF_OUT + DF_E13 + DF_E2 + DF_G + DF_UP;
struct DefDesc { const float* W; const float* gk; bf16* WT; int ldn, k0, n0, Kd, drow; };
__device__ __forceinline__ DefDesc deferred_desc(const DefW& w, int it) {
    int r = it; DefDesc d;
    if (r < DF_OUT) { const int kb = r / 16, np = r % 16; d = DefDesc{w.in[15], nullptr, (bf16*)(w.ws + WS_WOUT), 1024, kb * 64, np * 64, 1024, np * 64}; return d; } r -= DF_OUT;
    if (r < DF_E13) { const int e = r / 128, which = (r / 64) & 1, q = r % 64, kb = q / 4, np = q % 4;
        const int f0 = np * 64, drow = e * 512 + (f0 >> 7) * 256 + which * 128 + (f0 & 127);
        d = DefDesc{w.in[which ? 22 : 21] + (size_t)e * 1024 * 256, w.in[16], (bf16*)(w.ws + WS_W13), 256, kb * 64, f0, 1024, drow}; return d; } r -= DF_E13;
    if (r < DF_E2) { const int e = r / 64, q = r % 64, kb = q / 16, np = q % 16;
        d = DefDesc{w.in[23] + (size_t)e * 256 * 1024, nullptr, (bf16*)(w.ws + WS_W2), 1024, kb * 64, np * 64, 256, e * 1024 + np * 64}; return d; } r -= DF_E2;
    if (r < DF_G) { const int kb = r / 16, np = r % 16; d = DefDesc{w.in[25], w.in[24], (bf16*)(w.ws + WS_WG), 1024, kb * 64, np * 64, 1024, np * 64}; return d; } r -= DF_G;
    { const int kb = r / 16, np = r % 16; d = DefDesc{w.in[26], nullptr, (bf16*)(w.ws + WS_WUP), 1024, kb * 64, np * 64, 256, np * 64}; return d; }
}
struct Gemm1Order : pg8::StaticOrder {
    DefW w; int wave; int gi;
    struct Pre {}; __device__ __forceinline__ void pre(int, Pre&) const {}
    __device__ __forceinline__ void post(int ui, Pre&) const {
        if (ui != gi) return;
        const int lane = pg8::lane_id(), slot = c * 8 + wave, nslot = G * 8;
        for (int it = slot; it < DF_N; it += nslot) { const DefDesc d = deferred_desc(w, it); TrItem t0, t1;
            tr_load<true>(t0, d.W, d.ldn, d.k0, d.n0, lane); tr_load<true>(t1, d.W, d.ldn, d.k0, d.n0 + 32, lane);
            tr_store<true>(t0, d.k0, d.WT, d.Kd, d.drow, d.gk, lane); tr_store<true>(t1, d.k0, d.WT, d.Kd, d.drow + 32, d.gk, lane); }
        const pg8::f32x4* psrc = (const pg8::f32x4*)w.in[1]; unsigned long long* pdst = (unsigned long long*)(w.ws + WS_PB);
        for (int ch = slot; ch < 8192; ch += nslot) { const size_t i0 = (size_t)ch * 128 + lane; const pg8::f32x4 v0 = __builtin_nontemporal_load(psrc + i0), v1 = __builtin_nontemporal_load(psrc + i0 + 64);
            __builtin_nontemporal_store((unsigned long long)pk2(v0.x, v0.y) | ((unsigned long long)pk2(v0.z, v0.w) << 32), pdst + i0); __builtin_nontemporal_store((unsigned long long)pk2(v1.x, v1.y) | ((unsigned long long)pk2(v1.z, v1.w) << 32), pdst + i0 + 64); }
    }
};

constexpr int MY_VT = 0, MY_XA = 32768, MY_SP = 67584, MY_WS = 102400, MY_ST = 135168, MY_RS = 272;
__device__ __forceinline__ float bflo(unsigned u) { return __uint_as_float(u << 16); }
__device__ __forceinline__ float bfhi(unsigned u) { return __uint_as_float(u & 0xffff0000u); }
template <int N> __device__ __forceinline__ float row_shr(float ident, float v) {
    return __builtin_bit_cast(float, __builtin_amdgcn_update_dpp(__builtin_bit_cast(int, ident), __builtin_bit_cast(int, v), 0x110 + N, 0xf, 0xf, false)); }
#define MX_SCAN_STEP(N, A, U) { const float pa_ = row_shr<N>(1.f, A), pu_ = row_shr<N>(0.f, U); U = pu_ * A + U; A = pa_ * A; }
#define MX_SCAN16(A, U) { MX_SCAN_STEP(1, A, U) MX_SCAN_STEP(2, A, U) MX_SCAN_STEP(4, A, U) MX_SCAN_STEP(8, A, U) }
__device__ __forceinline__ void mixer_phase(LAS unsigned char* lds, const int vcu, const int G, const int tid, const int lane, const int wave,
                                            const bf16* __restrict__ Zl, const bf16* __restrict__ GA, const bf16* __restrict__ UB, const bf16* __restrict__ V, const float* __restrict__ VPART,
                                            unsigned long long* AGG, bf16* __restrict__ MG, const bf16* __restrict__ WLRU, const bf16* __restrict__ WSGU, const float* __restrict__ SPL8, const float* const* in) {
    using namespace pg8;
    constexpr int RS = MY_RS;
    constexpr float L2E = 1.4426950409f;
    const int fr = lane & 15, grp = lane >> 4, cp = tid & 63, tg = wave;
    const int pr = lane & 3, sch = lane >> 2, srow = 8 * sch + 2 * pr;
    LAS float* ST = (LAS float*)(lds + MY_ST);
    int gprev = -1;
    f32x2 cw0, cw1, cw2, cw3, ccb;
    u32x4 zqa, zqb, zqc, zqd, zqe, vv00, vv01, vv10, vv11;
#define MX_ZR(k) ((k) < 4 ? zqa[(k) & 3] : (k) < 8 ? zqb[(k) & 3] : (k) < 12 ? zqc[(k) & 3] : (k) < 16 ? zqd[(k) & 3] : zqe[(k) & 3])
#define MX_SETZR(k, v) do { if ((k) < 4) zqa[(k) & 3] = (v); else if ((k) < 8) zqb[(k) & 3] = (v); else if ((k) < 12) zqc[(k) & 3] = (v); else if ((k) < 16) zqd[(k) & 3] = (v); else zqe[(k) & 3] = (v); } while (0)
#define MX_PREFETCH(uu) do { const int ck_ = (uu) >> 3, g_ = (uu) & 7, t0_ = ck_ * 128, c0_ = g_ * 128; const bool first_ = (ck_ & 15) == 0; \
        const unsigned zo_ = ((unsigned)(t0_ + 16 * tg) * D + c0_ + 2 * cp) * 2u; \
        _Pragma("unroll") for (int k = 0; k < 19; ++k) { unsigned zv_ = 0u; if (!(k < 3 && first_ && tg == 0)) zv_ = *(const unsigned*)((const char*)Zl + (zo_ + (unsigned)((k - 3) * D * 2))); MX_SETZR(k, zv_); } \
        { const unsigned vo_ = ((unsigned)(t0_ + srow) * D + c0_ + 16 * wave) * 2u; vv00 = *(const u32x4*)((const char*)V + vo_); vv01 = *(const u32x4*)((const char*)V + (vo_ + D * 2)); vv10 = *(const u32x4*)((const char*)V + (vo_ + 16)); vv11 = *(const u32x4*)((const char*)V + (vo_ + D * 2 + 16)); } \
        } while (0)
    zqe = (u32x4){0u, 0u, 0u, 0u};
#define MX_STATS_LOAD(uu, q0, q1) do { const unsigned vpo_ = ((unsigned)(((uu) >> 3) * 128 + (tid >> 2)) * 32 + (tid & 3) * 8) * 4u; q0 = *(const f32x4*)((const char*)VPART + vpo_); q1 = *(const f32x4*)((const char*)VPART + (vpo_ + 16)); } while (0)
#define MX_STATS_WRITE(q0, q1) do { float s1 = (q0[0] + q0[2]) + (q1[0] + q1[2]), s2 = (q0[1] + q0[3]) + (q1[1] + q1[3]); \
        s1 += __shfl_xor(s1, 1); s1 += __shfl_xor(s1, 2); s2 += __shfl_xor(s2, 1); s2 += __shfl_xor(s2, 2); \
        if ((tid & 3) == 0) { const float mean = s1 * (1.f / 1024.f); float var = s2 * (1.f / 1024.f) - mean * mean; var = var < 0.f ? 0.f : var; ST[tid >> 2] = mean; ST[128 + (tid >> 2)] = rsqrtf(var + EPS); } } while (0)
    int u = vcu;
    if (u < 1024) { MX_PREFETCH(u); f32x4 q0, q1; MX_STATS_LOAD(u, q0, q1); MX_STATS_WRITE(q0, q1); }
    for (; u < 1024; u += G) {
        const int ck = u >> 3, g = u & 7, t0 = ck * 128, c0 = g * 128, j = ck & 15;
        const int cch = c0 + 16 * wave + 4 * grp;
        if (g != gprev) {
            gprev = g;
#pragma unroll
            for (int it = 0; it < 4; ++it) { const int idx = it * 512 + tid, row = idx >> 4, ch = idx & 15;
                *(LAS u32x4*)(lds + MY_WS + row * 256 + ((ch ^ (row & 15)) << 4)) = *(const u32x4*)(WSGU + ((size_t)(g * 128 + row)) * 128 + ch * 8); }
            const int cc = c0 + 2 * cp;
            cw0 = *(const f32x2*)(in[4] + cc); cw1 = *(const f32x2*)(in[4] + 1024 + cc); cw2 = *(const f32x2*)(in[4] + 2048 + cc); cw3 = *(const f32x2*)(in[4] + 3072 + cc); ccb = *(const f32x2*)(in[5] + cc);
        }
        const int hblk = 2 * g + (wave >> 2), jj0 = (16 * wave) & 63;
        const bf16x8 bw00 = *(const bf16x8*)(WLRU + ((size_t)((0 * 16 + hblk) * 64 + jj0 + fr)) * 64 + 0 * 32 + 8 * grp), bw01 = *(const bf16x8*)(WLRU + ((size_t)((0 * 16 + hblk) * 64 + jj0 + fr)) * 64 + 1 * 32 + 8 * grp);
        const bf16x8 bw10 = *(const bf16x8*)(WLRU + ((size_t)((1 * 16 + hblk) * 64 + jj0 + fr)) * 64 + 0 * 32 + 8 * grp), bw11 = *(const bf16x8*)(WLRU + ((size_t)((1 * 16 + hblk) * 64 + jj0 + fr)) * 64 + 1 * 32 + 8 * grp);
        const f32x4 nba = *(const f32x4*)(in[7] + cch) * (-L2E), nbi = *(const f32x4*)(in[9] + cch) * (-L2E), ksp = *(const f32x4*)(SPL8 + cch);
        {
#pragma unroll
            for (int i = 0; i < 16; ++i) {
                const unsigned z0 = MX_ZR(i), z1 = MX_ZR(i + 1), z2 = MX_ZR(i + 2), z3 = MX_ZR(i + 3);
                const float x0 = ccb.x + cw0.x * bflo(z0) + cw1.x * bflo(z1) + cw2.x * bflo(z2) + cw3.x * bflo(z3);
                const float x1 = ccb.y + cw0.y * bfhi(z0) + cw1.y * bfhi(z1) + cw2.y * bfhi(z2) + cw3.y * bfhi(z3);
                *(LAS unsigned*)(lds + MY_XA + (16 * tg + i) * RS + 4 * cp) = cvt_pk_bf16(x0, x1);
            }
        }
        __syncthreads();
        {
            const float mua = ST[srow], rsa = ST[128 + srow], mub = ST[srow + 1], rsb = ST[128 + srow + 1];
#pragma unroll
            for (int ci = 0; ci < 2; ++ci) { const int chunk = 2 * wave + ci, cbase = c0 + 8 * chunk;
                f32x4 a0, a1, b0, b1; unpack8(ci ? vv10 : vv00, a0, a1); unpack8(ci ? vv11 : vv01, b0, b1);
                const f32x4 g0 = *(const f32x4*)(in[11] + cbase), g1 = *(const f32x4*)(in[11] + cbase + 4), l0 = *(const f32x4*)(in[12] + cbase), l1 = *(const f32x4*)(in[12] + cbase + 4);
                a0 = (a0 - mua) * rsa * g0 + l0; a1 = (a1 - mua) * rsa * g1 + l1; b0 = (b0 - mub) * rsb * g0 + l0; b1 = (b1 - mub) * rsb * g1 + l1;
#pragma unroll
                for (int i = 0; i < 8; ++i) { const int cl = 8 * chunk + i; const float va = i < 4 ? a0[i & 3] : a1[i & 3], vb = i < 4 ? b0[i & 3] : b1[i & 3];
                    *(LAS unsigned*)(lds + MY_VT + cl * 256 + ((sch ^ (cl & 15)) << 4) + 4 * pr) = cvt_pk_bf16(va, vb); }
            }
        }
        f32x4 R[8], I[8];
#pragma unroll
        for (int mt = 0; mt < 8; ++mt) { R[mt] = (f32x4){0.f, 0.f, 0.f, 0.f}; I[mt] = (f32x4){0.f, 0.f, 0.f, 0.f};
#pragma unroll
            for (int ks = 0; ks < 2; ++ks) { const bf16x8 a = *(const LAS bf16x8*)(lds + MY_XA + (mt * 16 + fr) * RS + ((wave >> 2) * 64 + ks * 32 + 8 * grp) * 2);
                R[mt] = __builtin_amdgcn_mfma_f32_16x16x32_bf16(ks ? bw01 : bw00, a, R[mt], 0, 0, 0); I[mt] = __builtin_amdgcn_mfma_f32_16x16x32_bf16(ks ? bw11 : bw10, a, I[mt], 0, 0, 0); } }
#pragma unroll
        for (int mt = 0; mt < 8; ++mt) {
            const u32x2 xw = *(const LAS u32x2*)(lds + MY_XA + (mt * 16 + fr) * RS + (16 * wave + 4 * grp) * 2);
            const f32x4 xa4 = {bflo(xw.x), bfhi(xw.x), bflo(xw.y), bfhi(xw.y)};
            const f32x4 t1 = R[mt] * (-L2E) + nba, t2 = I[mt] * (-L2E) + nbi;
            f32x4 d1, d2, inv;
#pragma unroll
            for (int r = 0; r < 4; ++r) { d1[r] = 1.f + __builtin_amdgcn_exp2f(t1[r]); d2[r] = 1.f + __builtin_amdgcn_exp2f(t2[r]); }
            const f32x4 dd = d1 * d2;
#pragma unroll
            for (int r = 0; r < 4; ++r) inv[r] = __builtin_amdgcn_rcpf(dd[r]);
            const f32x4 rr = d2 * inv, ii = d1 * inv, la = rr * ksp, x2 = la + la;
            const f32x4 av = 1.f + la * (1.f + la * (0.5f + la * (0.16666667f + la * (0.041666667f + la * 0.0083333333f))));
            const f32x4 om = -x2 * (1.f + x2 * (0.5f + x2 * (0.16666667f + x2 * (0.041666667f + x2 * 0.0083333333f))));
            f32x4 uv;
#pragma unroll
            for (int r = 0; r < 4; ++r) uv[r] = __builtin_amdgcn_sqrtf(om[r]);
            uv = uv * ii * xa4;
#pragma unroll
            for (int r = 0; r < 4; ++r) { float A_ = av[r], U_ = uv[r]; MX_SCAN16(A_, U_); R[mt][r] = A_; I[mt][r] = U_; }
        }
        {
            f32x4 Pc = {1.f, 1.f, 1.f, 1.f}, Hc = {0.f, 0.f, 0.f, 0.f};
#pragma unroll
            for (int mt = 0; mt < 8; ++mt) { Hc = Hc * R[mt] + I[mt]; Pc = Pc * R[mt]; }
            if (fr == 15) {
#pragma unroll
                for (int r = 0; r < 4; ++r) __hip_atomic_store(AGG + (size_t)ck * 1024 + cch + r, ((unsigned long long)__float_as_uint(Hc[r]) << 32) | (unsigned long long)__float_as_uint(Pc[r]), __ATOMIC_RELAXED, __HIP_MEMORY_SCOPE_AGENT);
            }
        }
        __syncthreads();
        if (u + G < 1024) MX_PREFETCH(u + G);
        unsigned long long ag0 = 0x000000003f800000ull, ag1 = 0x000000003f800000ull, ag2 = 0x000000003f800000ull, ag3 = 0x000000003f800000ull;
        if (j > 0 && fr < j) { const unsigned long long* ap = AGG + (size_t)(ck - j + fr) * 1024 + cch;
            ag0 = __hip_atomic_load(ap, __ATOMIC_RELAXED, __HIP_MEMORY_SCOPE_AGENT); ag1 = __hip_atomic_load(ap + 1, __ATOMIC_RELAXED, __HIP_MEMORY_SCOPE_AGENT);
            ag2 = __hip_atomic_load(ap + 2, __ATOMIC_RELAXED, __HIP_MEMORY_SCOPE_AGENT); ag3 = __hip_atomic_load(ap + 3, __ATOMIC_RELAXED, __HIP_MEMORY_SCOPE_AGENT); }
        {
            bf16x8 q[4];
#pragma unroll
            for (int ks = 0; ks < 4; ++ks) q[ks] = *(const LAS bf16x8*)(lds + MY_VT + (16 * wave + fr) * 256 + (((ks * 4 + grp) ^ fr) << 4));
#pragma unroll
            for (int mt = 0; mt < 8; ++mt) { f32x4 Sx = {0.f, 0.f, 0.f, 0.f};
#pragma unroll
                for (int ks = 0; ks <= mt / 2; ++ks) { const bf16x8 p = *(const LAS bf16x8*)(lds + MY_WS + (mt * 16 + fr) * 256 + (((ks * 4 + grp) ^ fr) << 4));
                    Sx = __builtin_amdgcn_mfma_f32_16x16x32_bf16(q[ks], p, Sx, 0, 0, 0); }
                *(LAS u32x2*)(lds + MY_SP + (mt * 16 + fr) * RS + (16 * wave + 4 * grp) * 2) = (u32x2){cvt_pk_bf16_cv(Sx[0], Sx[1]), cvt_pk_bf16_cv(Sx[2], Sx[3])}; }
        }
        {
            f32x4 hc0 = {0.f, 0.f, 0.f, 0.f};
            if (j > 0) {
                f32x4 lp, lh; unsigned spin = 0;
                for (;;) {
                    lp[0] = __uint_as_float((unsigned)ag0); lh[0] = __uint_as_float((unsigned)(ag0 >> 32)); lp[1] = __uint_as_float((unsigned)ag1); lh[1] = __uint_as_float((unsigned)(ag1 >> 32));
                    lp[2] = __uint_as_float((unsigned)ag2); lh[2] = __uint_as_float((unsigned)(ag2 >> 32)); lp[3] = __uint_as_float((unsigned)ag3); lh[3] = __uint_as_float((unsigned)(ag3 >> 32));
                    const bool ok = (lp[0] != 0.f) && (lp[1] != 0.f) && (lp[2] != 0.f) && (lp[3] != 0.f);
                    if (__all(ok)) break;
                    if (++spin > (1u << 22)) break;
                    __builtin_amdgcn_s_sleep(1);
                    if (fr < j) { const unsigned long long* ap = AGG + (size_t)(ck - j + fr) * 1024 + cch;
                        ag0 = __hip_atomic_load(ap, __ATOMIC_RELAXED, __HIP_MEMORY_SCOPE_AGENT); ag1 = __hip_atomic_load(ap + 1, __ATOMIC_RELAXED, __HIP_MEMORY_SCOPE_AGENT);
                        ag2 = __hip_atomic_load(ap + 2, __ATOMIC_RELAXED, __HIP_MEMORY_SCOPE_AGENT); ag3 = __hip_atomic_load(ap + 3, __ATOMIC_RELAXED, __HIP_MEMORY_SCOPE_AGENT); } }
#pragma unroll
                for (int r = 0; r < 4; ++r) { float A_ = lp[r], U_ = lh[r]; MX_SCAN16(A_, U_); hc0[r] = __shfl(U_, (lane & 48) | 15); }
            }
            f32x4 s = hc0;
#pragma unroll
            for (int mt = 0; mt < 8; ++mt) { f32x4 hb;
#pragma unroll
                for (int r = 0; r < 4; ++r) hb[r] = __shfl(s[r], (lane & 48) | 15);
                s = R[mt] * s + I[mt];
                const f32x4 hv = I[mt] + R[mt] * hb;
                *(LAS u32x2*)(lds + MY_XA + (mt * 16 + fr) * RS + (16 * wave + 4 * grp) * 2) = (u32x2){cvt_pk_bf16(hv[0], hv[1]), cvt_pk_bf16(hv[2], hv[3])}; }
        }
        u32x4 ga[4], ub[4]; float bsr[4]; f32x4 nq0 = {0.f, 0.f, 0.f, 0.f}, nq1 = {0.f, 0.f, 0.f, 0.f};
        if (u + G < 1024) MX_STATS_LOAD(u + G, nq0, nq1);
#pragma unroll
        for (int it = 0; it < 4; ++it) { const int idx = it * 512 + tid, row = idx >> 4, ch = idx & 15; const unsigned o = ((unsigned)(t0 + row) * D + c0 + ch * 8) * 2u; ga[it] = *(const u32x4*)((const char*)GA + o); ub[it] = *(const u32x4*)((const char*)UB + o); bsr[it] = in[14][g * 128 + row]; }
        __syncthreads();
#pragma unroll
        for (int it = 0; it < 4; ++it) { const int idx = it * 512 + tid, row = idx >> 4, ch = idx & 15;
            f32x4 g0, g1, u0, u1, h0, h1, s0, s1; unpack8(ga[it], g0, g1); unpack8(ub[it], u0, u1);
            unpack8(*(const LAS u32x4*)(lds + MY_XA + row * RS + ch * 16), h0, h1); unpack8(*(const LAS u32x4*)(lds + MY_SP + row * RS + ch * 16), s0, s1);
            *(u32x4*)((char*)MG + ((unsigned)(t0 + row) * D + c0 + ch * 8) * 2u) = pack8(g0 * h0 + u0 * (s0 + bsr[it]), g1 * h1 + u1 * (s1 + bsr[it])); }
        if (u + G < 1024) MX_STATS_WRITE(nq0, nq1);
        __syncthreads();
    }
#undef MX_PREFETCH
#undef MX_STATS_LOAD
#undef MX_STATS_WRITE
#undef MX_ZR
#undef MX_SETZR
}

__device__ __forceinline__ void build_moe_units(LAS int* tab1, LAS int* tab2, LAS int* tab3, const int* CNT, int vcu, int G, int wave, LAS int* flags) {
    const int tid = wave * 64 + pg8::lane_id();
    int NT = 0, my_e = 0, my_tile = 0, my_cnt = 0, my_rt = 0;
    for (int e = 0; e < 32; ++e) { const int cnt = CNT[e]; const int ntl = (cnt + 255) >> 8;
        if (tid >= NT && tid < NT + ntl) { my_e = e; my_tile = tid - NT; my_cnt = cnt; my_rt = tid; }
        NT += ntl; }
    const bool have = tid < NT;
    const bool heavy = have && (my_cnt - my_tile * 256) > 128;
    flags[tid] = heavy ? 1 : 0;
    __syncthreads();
    int hb = 0, NH = 0;
    for (int i = 0; i < NT; ++i) { const int f = flags[i]; NH += f; hb += (i < tid) ? f : 0; }
    const int slot = heavy ? hb : NH + (tid - hb);
    const int U1 = 2 * NT, U2 = 4 * NT; int nlate = (U1 > G && U1 < 2 * G) ? U1 - G : 0; if (G - nlate < 64) nlate = 0;
    const int Ge = G - nlate, c2 = vcu - nlate, ssplit = nlate ? G / 2 : NT, Lsplit = 4 * ssplit;
    const int n1 = vcu < U1 ? (U1 - 1 - vcu) / G + 1 : 0;
    const int tot2 = (c2 >= 0 && c2 < U2) ? (U2 - 1 - c2) / Ge + 1 : 0;
    int n2 = (c2 >= 0 && c2 < Lsplit) ? (Lsplit - 1 - c2) / Ge + 1 : 0; n2 = n2 < tot2 ? n2 : tot2;
    const int n3 = tot2 - n2;
    if (tid == 0) { tab1[0] = n1 < 12 ? n1 : 12; tab2[0] = n2 < 12 ? n2 : 12; tab3[0] = n3 < 12 ? n3 : 12; }
    if (have) {
#pragma unroll
        for (int q = 0; q < 2; ++q) { const int L = 2 * slot + q; if (L % G == vcu && L / G < 12) { LAS int* p = tab1 + 4 + 8 * (L / G); p[0] = my_rt; p[1] = my_e * 2 + q; p[2] = my_e; p[3] = my_tile; p[4] = my_cnt; } }
        if (c2 >= 0) {
#pragma unroll
            for (int q = 0; q < 4; ++q) { const int L2 = 4 * slot + q; if (L2 % Ge == c2) { const int k = L2 / Ge; const bool early = slot < ssplit; const int idx = early ? k : k - n2;
                if (idx >= 0 && idx < 12) { LAS int* p = (early ? tab2 : tab3) + 4 + 8 * idx; p[0] = my_rt; p[1] = my_e * 4 + q; p[2] = my_e; p[3] = my_tile; p[4] = my_cnt; } } }
        }
    }
    __syncthreads();
}
__device__ __forceinline__ void moe_wait_tiles(const LAS int* tab, unsigned* dcnt, int wave) {
    if (wave == 0) {
        const int n = __builtin_amdgcn_readfirstlane(tab[0]);
        for (int i = 0; i < n; ++i) { const int rt = __builtin_amdgcn_readfirstlane(tab[4 + 8 * i]); unsigned sp = 0;
            while ((unsigned)__builtin_amdgcn_readfirstlane(__hip_atomic_load(dcnt + 64 * rt, __ATOMIC_RELAXED, __HIP_MEMORY_SCOPE_AGENT)) < 16u) { if (++sp > (1u << 22)) break; __builtin_amdgcn_s_sleep(2); } }
        __builtin_amdgcn_fence(__ATOMIC_ACQUIRE, "agent");
        asm volatile("s_waitcnt vmcnt(0)" ::: "memory");
    }
    __syncthreads();
}

struct Args { const float* in[28]; float* out; unsigned char* ws; int ph_lo, ph_hi, li, pad; };

__global__ void __launch_bounds__(NWAVES * 64, 2) mega_fwd(Args args) {
    extern __shared__ __attribute__((aligned(16))) unsigned char lds_raw[];
    LAS unsigned char* lds = (LAS unsigned char*)lds_raw;
    volatile LAS unsigned* MISC = (volatile LAS unsigned*)(lds + MISC_OFF);
    const int tid0 = threadIdx.x, wave = __builtin_amdgcn_readfirstlane(tid0 >> 6);
#define PHASE_IDS() int lane = pg8::lane_id(); asm volatile("" : "+v"(lane)); const int tid = wave * 64 + lane; (void)tid
    const int G = gridDim.x;
    const int vcu = (G % 8 == 0) ? ((int)blockIdx.x % 8) * (G / 8) + (int)blockIdx.x / 8 : (int)blockIdx.x;
    unsigned char* ws = args.ws;
    unsigned* ctl = (unsigned*)(ws + WS_CTL);
    for (int u = tid0; u < (LDS_BYTES - LDSCTL_OFF) / 4; u += NWAVES * 64) ((LAS unsigned*)(lds + LDSCTL_OFF))[u] = 0u;
    __syncthreads();
    XcdBarrier bar = xcd_barrier_post(ctl + CW_BAR + args.li * XCD_BAR_WORDS, MISC + 8, wave);
    const int lo = args.ph_lo, hi = args.ph_hi;
#define IN(k) (lo <= (k) && (k) < hi)
#define BOTH(k) (IN(k) && IN((k) + 1))
    const float* const* in = args.in;
    bf16 *XN = (bf16*)(ws + WS_A0), *MG = (bf16*)args.out, *X2b = (bf16*)(ws + WS_A0);
    float *RSTD0 = (float*)(ws + WS_RSTD0), *GINV = (float*)(ws + WS_GINV);
    bf16 *Zl = (bf16*)(ws + WS_A1), *X1b = (bf16*)(ws + WS_A1);
    bf16 *GA = (bf16*)(ws + WS_A2), *UB = (bf16*)(ws + WS_A3), *V = (bf16*)(ws + WS_A4);
    bf16 *X3 = (bf16*)(ws + WS_A1);
    bf16 *PU = (bf16*)(ws + WS_A2);
    bf16 *Pb = (bf16*)(ws + WS_PB);
    bf16 *WinT = (bf16*)(ws + WS_WIN), *WoutT = (bf16*)(ws + WS_WOUT), *WgT = (bf16*)(ws + WS_WG), *W13T = (bf16*)(ws + WS_W13), *W2T = (bf16*)(ws + WS_W2), *WupT = (bf16*)(ws + WS_WUP);
    float *VPART = (float*)(ws + WS_VPART), *SS1 = (float*)(ws + WS_SS1), *SS3 = (float*)(ws + WS_SS3), *RSTD2 = (float*)(ws + WS_RSTD2), *RSTD1 = (float*)(ws + WS_RSTD1), *TOKG = (float*)(ws + WS_TOKG);
    int *CNT = (int*)(ws + WS_CTL), *LIST = (int*)(ws + WS_LIST), *TOKE = (int*)(ws + WS_TOKE);
    bf16 *Hb = (bf16*)(ws + WS_A2), *Yb = (bf16*)(ws + WS_A3), *WrT = (bf16*)(ws + WS_WR), *WLRU = (bf16*)(ws + WS_WLRU), *WSGU = (bf16*)(ws + WS_WSGU);
    unsigned long long* AGGQ = (unsigned long long*)(ws + WS_AGG); float* SPL8 = (float*)(ws + WS_SPL8);

    if (IN(0)) {
        PHASE_IDS();
        LAS float* scr = (LAS float*)(lds + wave * 16384);
        const int gw = vcu * NWAVES + wave, NGW = G * NWAVES;
        for (int it = gw; it < 16 * 192; it += NGW) { const int kb = it / 192, nb = it % 192; p0_transpose_item(in[3], 6144, kb * 64, nb * 32, WinT, 1024, win_dest_row(nb * 32), nullptr, scr, lane); }
        for (int m = gw; m < T; m += 2 * NGW) {
            const int m2 = m + NGW < T ? m + NGW : m;
            const pg8::f32x4* xr = (const pg8::f32x4*)(in[0] + (size_t)m * D) + lane; const pg8::f32x4* xr2 = (const pg8::f32x4*)(in[0] + (size_t)m2 * D) + lane; const pg8::f32x4* gr = (const pg8::f32x4*)in[2] + lane;
            pg8::f32x4 v[4], w[4]; float s = 0.f, s2 = 0.f;
#pragma unroll
            for (int j = 0; j < 4; ++j) { v[j] = __builtin_nontemporal_load(xr + 64 * j); w[j] = __builtin_nontemporal_load(xr2 + 64 * j); }
#pragma unroll
            for (int j = 0; j < 4; ++j) { s += (v[j].x * v[j].x + v[j].y * v[j].y) + (v[j].z * v[j].z + v[j].w * v[j].w); s2 += (w[j].x * w[j].x + w[j].y * w[j].y) + (w[j].z * w[j].z + w[j].w * w[j].w); }
            const float rstd = rsqrtf(wave_sum(s) * (1.f / D) + EPS), rstd2 = rsqrtf(wave_sum(s2) * (1.f / D) + EPS);
            if (lane == 0) { RSTD0[m] = 1.f / rstd; RSTD0[m2] = 1.f / rstd2; }
            unsigned long long* o8 = (unsigned long long*)(XN + (size_t)m * D) + lane; unsigned long long* o82 = (unsigned long long*)(XN + (size_t)m2 * D) + lane;
#pragma unroll
            for (int j = 0; j < 4; ++j) { const pg8::f32x4 gg = gr[64 * j];
                o8[64 * j] = (unsigned long long)pk2(v[j].x * rstd * gg.x, v[j].y * rstd * gg.y) | ((unsigned long long)pk2(v[j].z * rstd * gg.z, v[j].w * rstd * gg.w) << 32);
                o82[64 * j] = (unsigned long long)pk2(w[j].x * rstd2 * gg.x, w[j].y * rstd2 * gg.y) | ((unsigned long long)pk2(w[j].z * rstd2 * gg.z, w[j].w * rstd2 * gg.w) << 32); }
        }
        for (int i = vcu * 512 + tid; i < 2 * 16 * 64 * 64; i += G * 512) { const int gate = i >> 16, h = (i >> 12) & 15, j = (i >> 6) & 63, ii = i & 63;
            WLRU[i] = f2bf(in[gate ? 8 : 6][(h * 64 + ii) * 64 + j]); }
        for (int i = vcu * 512 + tid; i < 8 * 128 * 128; i += G * 512) { const int t = (i >> 7) & 127, s = i & 127; WSGU[i] = s <= t ? f2bf(in[13][i]) : (bf16)0; }
        for (int i = vcu * 512 + tid; i < 1024; i += G * 512) { SPL8[i] = -8.f * log1pf(expf(-in[10][i])); GINV[i] = 1.f / in[2][i]; }
        for (int i = vcu * 512 + tid; i < 64 * 1024; i += G * 512) { const int n = i >> 10, k = i & 1023; float v = 0.f;
            if (n < 4) v = in[17][k * 4 + n] * in[16][k]; else if (n < 36) v = in[19][k * 32 + (n - 4)] * in[16][k];
            WrT[i] = f2bf(v); }
        if (BOTH(0)) xcd_barrier(bar);
    }
    if (IN(1)) {
        { pg8::Gemm g{XN, WinT, 1024}; Gemm1Order S; S.init(T, 6144, G, (int)blockIdx.x);
          S.wave = wave; { const int upw = (64 * 24) / G > 0 ? (64 * 24) / G : 1; S.gi = (int)blockIdx.x % upw; } S.w = DefW{args.in, ws};
          pg8::Epi1 E{Zl, GA, UB, V, VPART};
          pg8::gemm_phase<pg8::Epi1, Gemm1Order, true, true, false>(lds, g, S, E, wave); }
        if (BOTH(1)) xcd_barrier(bar);
    }

    if (IN(3)) {
        PHASE_IDS();
        mixer_phase(lds, vcu, G, tid, lane, wave, Zl, GA, UB, V, VPART, AGGQ, MG, WLRU, WSGU, SPL8, in);
        if (BOTH(3)) xcd_barrier(bar);
    }
    if (IN(4)) {
        pg8::Gemm g{MG, WoutT, 1024}; pg8::StaticOrder S; S.init(T, 1024, G, (int)blockIdx.x);
        pg8::Epi2 E{XN, RSTD0, GINV, X1b, SS1};
        pg8::gemm_phase<pg8::Epi2, pg8::StaticOrder, true, true, false>(lds, g, S, E, wave);
        if (BOTH(4)) xcd_barrier(bar);
    }

    if (IN(5)) {
        PHASE_IDS();
        constexpr int RS = 528;
        LAS unsigned char* sA = lds; LAS unsigned char* sB = lds + 64 * RS; LAS float* sL = (LAS float*)(lds + 2 * 64 * RS);
        LAS int* sCnt = (LAS int*)(lds + 2 * 64 * RS + 64 * 65 * 4); LAS int* sBase = sCnt + 32;
        const int fr = lane & 15, grp = lane >> 4, mtile = wave & 3, np = wave >> 2;
        for (int tile = vcu; tile < T / 64; tile += G) {
            const int tok0 = tile * 64;
            if (tid < 32) sCnt[tid] = 0;
            pg8::f32x4 acc0 = {0.f, 0.f, 0.f, 0.f}, acc1 = {0.f, 0.f, 0.f, 0.f};
            for (int kc = 0; kc < 4; ++kc) {
#pragma unroll
                for (int it = 0; it < 4; ++it) { const int idx = it * 512 + tid, row = idx >> 5, ch = idx & 31;
                    *(LAS pg8::u32x4*)(sA + row * RS + ch * 16) = *(const pg8::u32x4*)(X1b + (size_t)(tok0 + row) * D + kc * 256 + ch * 8);
                    *(LAS pg8::u32x4*)(sB + row * RS + ch * 16) = *(const pg8::u32x4*)(WrT + (size_t)row * D + kc * 256 + ch * 8); }
                __syncthreads();
#pragma unroll
                for (int ks = 0; ks < 8; ++ks) {
                    const pg8::bf16x8 a = *(const LAS pg8::bf16x8*)(sA + (16 * mtile + fr) * RS + (ks * 32 + 8 * grp) * 2);
                    const pg8::bf16x8 b0 = *(const LAS pg8::bf16x8*)(sB + (32 * np + fr) * RS + (ks * 32 + 8 * grp) * 2);
                    const pg8::bf16x8 b1 = *(const LAS pg8::bf16x8*)(sB + (32 * np + 16 + fr) * RS + (ks * 32 + 8 * grp) * 2);
                    acc0 = __builtin_amdgcn_mfma_f32_16x16x32_bf16(a, b0, acc0, 0, 0, 0);
                    acc1 = __builtin_amdgcn_mfma_f32_16x16x32_bf16(a, b1, acc1, 0, 0, 0);
                }
                __syncthreads();
            }
#pragma unroll
            for (int r = 0; r < 4; ++r) { const int tk = 16 * mtile + 4 * grp + r; sL[tk * 65 + 32 * np + fr] = acc0[r]; sL[tk * 65 + 32 * np + 16 + fr] = acc1[r]; }
            __syncthreads();
            int e1 = 0, e2 = 0, r1 = 0, r2 = 0; float g1 = 0.f, g2 = 0.f;
            if (tid < 64) {
                const int t = tok0 + tid; float ss = 0.f;
#pragma unroll
                for (int q = 0; q < 16; ++q) ss += SS1[(size_t)t * 16 + q];
                const float rstd = rsqrtf(ss * (1.f / D) + EPS);
                RSTD1[t] = rstd;
                const LAS float* l = sL + tid * 65;
                float gl[4];
#pragma unroll
                for (int q = 0; q < 4; ++q) gl[q] = rstd * l[q] + in[18][q];
                float mx = gl[0]; int gi = 0;
#pragma unroll
                for (int q = 1; q < 4; ++q) if (gl[q] > mx) { mx = gl[q]; gi = q; }
                float den = 0.f;
#pragma unroll
                for (int q = 0; q < 4; ++q) den += expf(gl[q] - mx);
                const float gtop = 1.f / den;
                float m1 = -3.0e38f, m2 = -3.0e38f; int i1 = 0, i2 = 0;
                for (int j = 0; j < 8; ++j) { const float v = rstd * l[4 + gi * 8 + j] + in[20][gi * 8 + j];
                    if (v > m1) { m2 = m1; i2 = i1; m1 = v; i1 = j; } else if (v > m2) { m2 = v; i2 = j; } }
                const float p2 = expf(m2 - m1);
                g1 = gtop / (1.f + p2); g2 = gtop * p2 / (1.f + p2);
                e1 = gi * 8 + i1; e2 = gi * 8 + i2;
                r1 = __hip_atomic_fetch_add(&sCnt[e1], 1, __ATOMIC_RELAXED, __HIP_MEMORY_SCOPE_WORKGROUP); r2 = __hip_atomic_fetch_add(&sCnt[e2], 1, __ATOMIC_RELAXED, __HIP_MEMORY_SCOPE_WORKGROUP);
                TOKE[t * 2] = e1; TOKE[t * 2 + 1] = e2; TOKG[t * 2] = g1; TOKG[t * 2 + 1] = g2;
            }
            __syncthreads();
            if (tid < 32) { const int c = sCnt[tid]; sBase[tid] = c ? atomicAdd(&CNT[tid], c) : 0; }
            __syncthreads();
            if (tid < 64) { const int t = tok0 + tid; LIST[e1 * 16384 + sBase[e1] + r1] = t * 2; LIST[e2 * 16384 + sBase[e2] + r2] = t * 2 + 1; }
            __syncthreads();
        }
        if (BOTH(5)) xcd_barrier(bar);
    }
    if (IN(6)) {
        LAS int* tab1 = (LAS int*)(lds + TAB_OFF); LAS int* tab2 = (LAS int*)(lds + TAB_OFF + 512); LAS int* tab3 = (LAS int*)(lds + TAB_OFF + 1024);
        build_moe_units(tab1, tab2, tab3, CNT, vcu, G, wave, (LAS int*)lds);
        unsigned* dcnt = ctl + CW_DONE1;
        { pg8::Gemm g{X1b, W13T, 1024}; pg8::MoeOrder<1> S{tab1, LIST, dcnt};
          pg8::EpiMoe1 E{Hb, LIST, RSTD1};
          pg8::gemm_phase<pg8::EpiMoe1, pg8::MoeOrder<1>, true, true, true>(lds, g, S, E, wave); }
        pg8::Gemm g2{Hb, W2T, 256}; pg8::EpiMoe2 E2{Yb, LIST, TOKG};
        moe_wait_tiles(tab2, dcnt, wave);
        { pg8::MoeOrder<0> S{tab2, LIST, dcnt}; pg8::gemm_phase<pg8::EpiMoe2, pg8::MoeOrder<0>, true, true, false>(lds, g2, S, E2, wave); }
        moe_wait_tiles(tab3, dcnt, wave);
        { pg8::MoeOrder<0> S{tab3, LIST, dcnt}; pg8::gemm_phase<pg8::EpiMoe2, pg8::MoeOrder<0>, true, true, false>(lds, g2, S, E2, wave); }
        if (BOTH(6)) xcd_barrier(bar);
    }
    if (IN(8)) {
        PHASE_IDS();
        const int gw = vcu * NWAVES + wave, NGW = G * NWAVES;
        for (int row = gw; row < T; row += NGW) { float ss = 0.f;
#pragma unroll
            for (int hh = 0; hh < 2; ++hh) { const size_t o = (size_t)row * D + hh * 512 + lane * 8;
                pg8::f32x4 a0, a1, b0, b1, c0, c1; pg8::unpack8(__builtin_nontemporal_load((const pg8::u32x4*)(X1b + o)), a0, a1);
                pg8::unpack8(__builtin_nontemporal_load((const pg8::u32x4*)(Yb + (size_t)row * 2 * D + hh * 512 + lane * 8)), b0, b1); pg8::unpack8(__builtin_nontemporal_load((const pg8::u32x4*)(Yb + ((size_t)row * 2 + 1) * D + hh * 512 + lane * 8)), c0, c1);
                a0 = a0 + b0 + c0; a1 = a1 + b1 + c1;
                ss += (a0[0] * a0[0] + a0[1] * a0[1]) + (a0[2] * a0[2] + a0[3] * a0[3]) + (a1[0] * a1[0] + a1[1] * a1[1]) + (a1[2] * a1[2] + a1[3] * a1[3]);
                *(pg8::u32x4*)(X2b + o) = pg8::pack8(a0, a1); }
            ss = wave_sum(ss);
            if (lane == 0) RSTD2[row] = rsqrtf(ss * (1.f / D) + EPS); }
        if (BOTH(8)) xcd_barrier(bar);
    }
    const bool fuse_final = (G == 256);
    if (IN(9)) {
        { pg8::Gemm g{Pb, WupT, 256}; pg8::StaticOrder S; S.init(T, 1024, G, (int)blockIdx.x);
          pg8::EpiPlain E{PU};
          pg8::gemm_phase<pg8::EpiPlain, pg8::StaticOrder, true, true, false>(lds, g, S, E, wave); }
        pg8::Gemm g{X2b, WgT, 1024}; pg8::StaticOrder S; S.init(T, 1024, G, (int)blockIdx.x);
        if (fuse_final) {
            pg8::EpiPleFinal E{X2b, PU, RSTD2, in[27], args.out, (float*)(ws + WS_XCH), ctl + CW_PANEL, (LAS float*)(lds + RING_BYTES), wave};
            pg8::gemm_phase<pg8::EpiPleFinal, pg8::StaticOrder, true, true, false>(lds, g, S, E, wave);
        } else {
            pg8::EpiPle E{X2b, PU, RSTD2, X3, SS3};
            pg8::gemm_phase<pg8::EpiPle, pg8::StaticOrder, true, true, false>(lds, g, S, E, wave);
            if (BOTH(9)) xcd_barrier(bar);
        }
    }

    if (IN(10) && !fuse_final) {
        PHASE_IDS();
        const int gw = vcu * NWAVES + wave, NGW = G * NWAVES;
        for (int row = gw; row < T; row += NGW) { float ss = 0.f;
            if (lane < 16) ss = SS3[(size_t)row * 16 + lane];
            ss = wave_sum(ss);
            const float rstd = rsqrtf(ss * (1.f / D) + EPS);
#pragma unroll
            for (int hh = 0; hh < 2; ++hh) { const size_t o = (size_t)row * D + hh * 512 + lane * 8; pg8::f32x4 a0, a1; pg8::unpack8(*(const pg8::u32x4*)(X3 + o), a0, a1);
                const pg8::f32x4 f0 = *(const pg8::f32x4*)(in[27] + hh * 512 + lane * 8), f1 = *(const pg8::f32x4*)(in[27] + hh * 512 + lane * 8 + 4);
                *(pg8::f32x4*)(args.out + o) = a0 * rstd * f0; *(pg8::f32x4*)(args.out + o + 4) = a1 * rstd * f1; } }
    }
#undef IN
#undef BOTH
#undef PHASE_IDS
}

static int mega_grid() {
    static int grid = 0;
    if (grid == 0) {
        int dev = 0, cus = 0;
        if (hipGetDevice(&dev) != hipSuccess || hipDeviceGetAttribute(&cus, hipDeviceAttributeMultiprocessorCount, dev) != hipSuccess) { fprintf(stderr, "mega: device query failed\n"); grid = -1; return grid; }
        if (hipFuncSetAttribute((const void*)mega_fwd, hipFuncAttributeMaxDynamicSharedMemorySize, LDS_BYTES) != hipSuccess) { fprintf(stderr, "mega: hipFuncSetAttribute failed\n"); grid = -1; return grid; }
        (void)hipGetLastError();
        grid = cus;
    }
    return grid;
}
static void launch_mega(void* const* d_in, void* d_out, void* d_ws, int lo, int hi, int li, hipStream_t stream) {
    const int grid = mega_grid(); if (grid <= 0) return;
    Args a{};
    for (int i = 0; i < 28; ++i) a.in[i] = (const float*)d_in[i];
    a.out = (float*)d_out; a.ws = (unsigned char*)d_ws; a.ph_lo = lo; a.ph_hi = hi; a.li = li; a.pad = 0;
    hipLaunchKernelGGL(mega_fwd, dim3(grid), dim3(NWAVES * 64), LDS_BYTES, stream, a);
}

extern "C" void kernel_launch(void* const* d_in, const int* in_sizes, int n_in, void* d_out, int out_size, void* d_ws, size_t ws_size, hipStream_t stream) {
    if (n_in != 28 || in_sizes[0] != T * D || out_size != T * D || ws_size < WS_MEGA_END) { fprintf(stderr, "kernel_launch: unexpected shapes (n_in %d, ws %zu)\n", n_in, ws_size); return; }
    (void)hipMemsetAsync(d_ws, 0, 2 * MiB, stream);
    launch_mega(d_in, d_out, d_ws, 0, 11, 0, stream);
}
```

```cpp
#include <hip/hip_runtime.h>
#include <stdint.h>
#include <cstdio>

typedef unsigned short bf16;
constexpr int T = 16384, D = 1024, SEQ = 2048;
constexpr float EPS = 1e-6f;
constexpr size_t MiB = 1u << 20;
constexpr size_t WS_CTL = 0;
constexpr size_t WS_VPART = 2 * MiB;
constexpr size_t WS_SS1 = 4 * MiB;
constexpr size_t WS_SS3 = 5 * MiB;
constexpr size_t WS_AGG = 1 * MiB;
constexpr size_t WS_LIST = 6 * MiB;
constexpr size_t WS_TOKE = 8 * MiB;
constexpr size_t WS_TOKG = 8 * MiB + 128 * 1024;
constexpr size_t WS_RSTD2 = 8 * MiB + 256 * 1024;
constexpr size_t WS_A0 = 74 * MiB;
constexpr size_t WS_A1 = 106 * MiB;
constexpr size_t WS_A2 = 138 * MiB;
constexpr size_t WS_A3 = 170 * MiB;
constexpr size_t WS_A4 = 202 * MiB;
constexpr size_t WS_END = 234 * MiB;

__device__ __forceinline__ float bf2f(bf16 b) { return __uint_as_float(((unsigned)b) << 16); }
__device__ __forceinline__ bf16 f2bf(float f) { unsigned u = __float_as_uint(f); u += 0x7fffu + ((u >> 16) & 1u); return (bf16)(u >> 16); }
__device__ __forceinline__ float sigm(float x) { return 1.f / (1.f + expf(-x)); }
__device__ __forceinline__ float gelu_t(float x) { const float u = 0.7978845608028654f * (x + 0.044715f * x * x * x); return 0.5f * x * (1.f + tanhf(u)); }
__device__ __forceinline__ float wave_sum(float v) {
#pragma unroll
    for (int o = 1; o < 64; o <<= 1) v += __shfl_xor(v, o);
    return v;
}

#define LAS __attribute__((address_space(3)))
#define GAS __attribute__((address_space(1)))
namespace pg8 {
typedef short bf16x8 __attribute__((ext_vector_type(8)));
typedef float f32x4 __attribute__((ext_vector_type(4)));
typedef float f32x2 __attribute__((ext_vector_type(2)));
typedef unsigned u32x4 __attribute__((ext_vector_type(4)));
typedef unsigned u32x2 __attribute__((ext_vector_type(2)));
constexpr int BM = 256, BK = 64, HALF = 128, HTB = HALF * BK * 2, STAGE_BYTES = 8 * HTB, NXCD = 8, WGM = 8;

__host__ __device__ __forceinline__ int lds_byte(int r, int c) { const int st = (r >> 4) * 2 + (c >> 5), rr = r & 15, cc = c & 31, ob = rr * 64 + cc * 2; return st * 1024 + (ob ^ (((ob >> 9) & 1) << 5)); }
__host__ __device__ __forceinline__ void stage_rc(int b, int& R, int& C) { const int st = b / 1024, sb = b % 1024, swz = sb ^ (((sb >> 9) & 1) << 5); R = (st >> 1) * 16 + swz / 64; C = (st & 1) * 32 + (swz % 64) / 2; }
__host__ __device__ __forceinline__ int perm32(int rho) { const int n = rho >> 4, i = rho & 15; return 8 * (i >> 2) + 4 * n + (i & 3); }

__device__ __forceinline__ int lane_id() { int l; asm volatile("v_mbcnt_lo_u32_b32 %0, -1, 0\n\tv_mbcnt_hi_u32_b32 %0, -1, %0" : "=v"(l)); return l; }
struct Unit { int pm, pn, e, tile, cnt; };
struct Gemm { const bf16* A; const bf16* Bt; int K; };

struct StaticOrder {
    int nM, nN, nwg, G, c;
    __device__ void init(int M, int N, int G_, int c_) { nM = M / BM; nN = N / BM; nwg = nM * nN; G = G_; c = c_; }
    __device__ bool next(int i, Unit& u) const {
        const long L = (long)i * G + c; if (L >= nwg) return false;
        int wgid = (int)L; { const int q = nwg / NXCD, r = nwg % NXCD, xcd = wgid % NXCD, off = wgid / NXCD; wgid = (xcd < r ? xcd * (q + 1) : r * (q + 1) + (xcd - r) * q) + off; }
        const int nig = WGM * nN, gid = wgid / nig, fm = gid * WGM, gsz = (nM - fm) < WGM ? (nM - fm) : WGM;
        u.pm = fm + ((wgid % nig) % gsz); u.pn = (wgid % nig) / gsz; u.e = 0; u.tile = 0; u.cnt = 0; return true;
    }
    __device__ __forceinline__ unsigned row_off(const Unit&, int) const { return 0u; }
    __device__ __forceinline__ void a_ready(const Unit&) const {}
    __device__ __forceinline__ void done(const Unit&) const {}
    struct Pre {}; __device__ __forceinline__ void pre(int, Pre&) const {}
    __device__ __forceinline__ void post(int, Pre&) const {}
    __device__ __forceinline__ bool half(const Unit&) const { return false; }
};

__device__ __forceinline__ unsigned cvt_pk_bf16(float lo, float hi) { unsigned r; asm volatile("v_cvt_pk_bf16_f32 %0, %1, %2" : "=v"(r) : "v"(lo), "v"(hi)); return r; }
typedef __bf16 bf16x2_t __attribute__((ext_vector_type(2)));
__device__ __forceinline__ unsigned cvt_pk_bf16_cv(float lo, float hi) { const f32x2 v = {lo, hi}; const bf16x2_t b = __builtin_convertvector(v, bf16x2_t); return __builtin_bit_cast(unsigned, b); }
__device__ __forceinline__ float fsigm(float x) { return __builtin_amdgcn_rcpf(1.0f + __builtin_amdgcn_exp2f(-1.4426950409f * x)); }
__device__ __forceinline__ float fgelu(float x) { const float u = x + 0.044715f * x * x * x; return x * __builtin_amdgcn_rcpf(1.0f + __builtin_amdgcn_exp2f(-2.3022082f * u)); }
__device__ __forceinline__ f32x4 vexp2(const f32x4 t) { f32x4 e;
#pragma unroll
    for (int i = 0; i < 4; ++i) e[i] = __builtin_amdgcn_exp2f(t[i]);
    return e; }
__device__ __forceinline__ f32x4 vrcp(const f32x4 t) { f32x4 e;
#pragma unroll
    for (int i = 0; i < 4; ++i) e[i] = __builtin_amdgcn_rcpf(t[i]);
    return e; }
__device__ __forceinline__ f32x4 vgelu_den(const f32x4 x) { return 1.f + vexp2(x * (x * x * (-0.10294324f) + (-2.3022082f))); }
__device__ __forceinline__ f32x4 vsigm_den(const f32x4 x) { return 1.f + vexp2(x * (-1.4426950409f)); }
__device__ __forceinline__ float hsum4(const f32x4 v) { return (v[0] + v[1]) + (v[2] + v[3]); }

template <class Epi, class Sched, bool ALIGN_EPI, bool SP2, bool GATHER>
__device__ __forceinline__ void gemm_phase(LAS unsigned char* lds, const Gemm g, const Sched& S, const Epi& E, const int wave_) {
    int lane = lane_id(); asm volatile("" : "+v"(lane));
    const int wid = wave_, tid = wid * 64 + lane, wr = wid >> 2, wc = wid & 3, fr = lane & 15, fq = lane >> 4;
    const int K = g.K, nt = K / BK;
    int sR[2], sC[2];
    unsigned voffB[2], vA0[2], vA1[2], nvA0[2], nvA1[2];
#pragma unroll
    for (int i = 0; i < 2; ++i) { stage_rc(tid * 16 + i * 8192, sR[i], sC[i]); const int Rb = Epi::PERM ? ((sR[i] & ~31) + perm32(sR[i] & 31)) : sR[i];
        voffB[i] = (unsigned)(Rb * K + sC[i]) * 2u; vA0[i] = (unsigned)(sR[i] * K + sC[i]) * 2u; vA1[i] = vA0[i]; nvA0[i] = vA0[i]; nvA1[i] = vA0[i]; }
    const size_t kstep = (size_t)(BK * 2);
    const size_t hstep = (size_t)HALF * K * 2;
    const size_t tstep = 2 * hstep;
    const size_t ahs = GATHER ? 0 : hstep;
    const unsigned ldsw = (unsigned)wid * 1024u;
    const int aoff = lds_byte(wr * 64 + fr, fq * 8), boff = lds_byte(wc * 32 + fr, fq * 8);
#define PG8_SA(b, h) (((b) * 2 + (h)) * HTB)
#define PG8_SB(b, h) ((4 + (b) * 2 + (h)) * HTB)
#define PG8_STAGE(bufoff, gbase, voff) do { _Pragma("unroll") for (int _i = 0; _i < 2; ++_i) \
        __builtin_amdgcn_global_load_lds((const unsigned*)((const char*)(gbase) + (voff)[_i]), (LAS unsigned*)(lds + (bufoff) + ldsw + _i * 8192), 16, 0, 0); } while (0)
#define PG8_LDA(dst, b, h) do { _Pragma("unroll") for (int m = 0; m < 4; ++m) _Pragma("unroll") for (int k = 0; k < 2; ++k) dst[m][k] = *(const LAS bf16x8*)(lds + PG8_SA(b, h) + aoff + m * 2048 + k * 1024); } while (0)
#define PG8_LDB(dst, b, h) do { _Pragma("unroll") for (int n = 0; n < 2; ++n) _Pragma("unroll") for (int k = 0; k < 2; ++k) dst[n][k] = *(const LAS bf16x8*)(lds + PG8_SB(b, h) + boff + n * 2048 + k * 1024); } while (0)
#define PG8_MMA(ai, bj, At, Bt) do { __builtin_amdgcn_s_setprio(1); _Pragma("unroll") for (int m = 0; m < 4; ++m) _Pragma("unroll") for (int n = 0; n < 2; ++n) _Pragma("unroll") for (int k = 0; k < 2; ++k) \
        acc[ai][bj][m][n] = __builtin_amdgcn_mfma_f32_16x16x32_bf16(Bt[n][k], At[m][k], acc[ai][bj][m][n], 0, 0, 0); __builtin_amdgcn_s_setprio(0); } while (0)
#define PG8_WAIT_V(n) asm volatile("s_waitcnt vmcnt(" #n ")" ::: "memory")
#define PG8_WAIT_L(n) asm volatile("s_waitcnt lgkmcnt(" #n ")" ::: "memory")
#define PG8_BAR __builtin_amdgcn_s_barrier()
#define PG8_SCHED __builtin_amdgcn_sched_barrier(0)
    Unit cur, nxt; int ui = 0;
    if (!S.next(0, cur)) return;
    f32x4 acc[2][2][4][2];
#pragma unroll
    for (int a = 0; a < 2; ++a)
#pragma unroll
        for (int b = 0; b < 2; ++b)
#pragma unroll
            for (int m = 0; m < 4; ++m)
#pragma unroll
                for (int n = 0; n < 2; ++n) acc[a][b][m][n] = (f32x4){0.f, 0.f, 0.f, 0.f};
    bf16x8 At[4][2], B0[2][2], B1[2][2];
    const char* cA = GATHER ? (const char*)g.A : (const char*)g.A + (size_t)cur.pm * tstep; const char* cB = (const char*)g.Bt + (size_t)cur.pn * tstep;
    if constexpr (GATHER) {
#pragma unroll
        for (int i = 0; i < 2; ++i) { vA0[i] = S.row_off(cur, sR[i]) + (unsigned)sC[i] * 2u; vA1[i] = S.row_off(cur, HALF + sR[i]) + (unsigned)sC[i] * 2u; nvA0[i] = vA0[i]; nvA1[i] = vA1[i]; }
    }
    S.a_ready(cur);
    if constexpr (SP2) {
        PG8_STAGE(PG8_SB(0, 0), cB, voffB); PG8_STAGE(PG8_SB(0, 1), cB + hstep, voffB); PG8_STAGE(PG8_SA(0, 0), cA, vA0); PG8_STAGE(PG8_SA(0, 1), cA + ahs, vA1);
        if (wr == 1) PG8_BAR;
        PG8_WAIT_V(2); PG8_BAR;
        PG8_STAGE(PG8_SB(1, 0), cB + kstep, voffB); PG8_STAGE(PG8_SA(1, 0), cA + kstep, vA0); PG8_STAGE(PG8_SB(1, 1), cB + hstep + kstep, voffB);
        PG8_WAIT_V(6); PG8_BAR;
    } else {
        PG8_STAGE(PG8_SB(0, 0), cB, voffB); PG8_STAGE(PG8_SA(0, 0), cA, vA0); PG8_STAGE(PG8_SB(0, 1), cB + hstep, voffB); PG8_STAGE(PG8_SA(0, 1), cA + ahs, vA1);
        if (wr == 1) PG8_BAR;
        PG8_WAIT_V(4); PG8_BAR;
        PG8_STAGE(PG8_SB(1, 0), cB + kstep, voffB); PG8_STAGE(PG8_SA(1, 0), cA + kstep, vA0); PG8_STAGE(PG8_SB(1, 1), cB + hstep + kstep, voffB);
        PG8_WAIT_V(6); PG8_BAR;
    }
    for (;;) {
        const bool has_next = S.next(ui + 1, nxt);
        const char* nA = has_next ? (GATHER ? (const char*)g.A : (const char*)g.A + (size_t)nxt.pm * tstep) : cA; const char* nB = has_next ? (const char*)g.Bt + (size_t)nxt.pn * tstep : cB;
        const bool hf = S.half(cur);
        for (int t = 0; t < nt; t += 2) {
            const bool last = (t == nt - 2);
            const char* a1 = cA + (size_t)(t + 1) * kstep;
            const char* a2 = last ? nA : cA + (size_t)(t + 2) * kstep; const char* b2 = last ? nB : cB + (size_t)(t + 2) * kstep;
            const char* a3 = a2 + kstep; const char* b3 = b2 + kstep;
            if (last && has_next) S.a_ready(nxt);
            unsigned w0[2], w1[2];
            if constexpr (GATHER) {
                if (last && has_next) {
#pragma unroll
                    for (int i = 0; i < 2; ++i) { nvA0[i] = S.row_off(nxt, sR[i]) + (unsigned)sC[i] * 2u; nvA1[i] = S.row_off(nxt, HALF + sR[i]) + (unsigned)sC[i] * 2u; }
                }
#pragma unroll
                for (int i = 0; i < 2; ++i) { w0[i] = last ? nvA0[i] : vA0[i]; w1[i] = last ? nvA1[i] : vA1[i]; }
            } else {
#pragma unroll
                for (int i = 0; i < 2; ++i) { w0[i] = vA0[i]; w1[i] = vA0[i]; }
            }
            if constexpr (SP2) {
            PG8_LDB(B0, 0, 0); PG8_LDB(B1, 0, 1); PG8_SCHED; PG8_LDA(At, 0, 0); PG8_STAGE(PG8_SA(1, 1), a1 + ahs, vA1);
            PG8_WAIT_V(8); PG8_WAIT_L(0); PG8_BAR; PG8_MMA(0, 0, At, B0); PG8_MMA(0, 1, At, B1); PG8_BAR; PG8_SCHED;
            if (!hf) PG8_LDA(At, 0, 1); PG8_STAGE(PG8_SB(0, 0), b2, voffB); PG8_STAGE(PG8_SB(0, 1), b2 + hstep, voffB); PG8_STAGE(PG8_SA(0, 0), a2, w0);
            PG8_WAIT_V(8); PG8_WAIT_L(0); PG8_BAR; if (!hf) { PG8_MMA(1, 0, At, B0); PG8_MMA(1, 1, At, B1); } PG8_BAR; PG8_SCHED;
            PG8_LDB(B0, 1, 0); PG8_LDB(B1, 1, 1); PG8_SCHED; PG8_LDA(At, 1, 0); PG8_STAGE(PG8_SA(0, 1), a2 + ahs, w1);
            PG8_WAIT_V(8); PG8_WAIT_L(0); PG8_BAR; PG8_MMA(0, 0, At, B0); PG8_MMA(0, 1, At, B1); PG8_BAR; PG8_SCHED;
            if (!hf) PG8_LDA(At, 1, 1); PG8_STAGE(PG8_SB(1, 0), b3, voffB); PG8_STAGE(PG8_SB(1, 1), b3 + hstep, voffB); PG8_STAGE(PG8_SA(1, 0), a3, w0);
            PG8_WAIT_V(8); PG8_WAIT_L(0); PG8_BAR; if (!hf) { PG8_MMA(1, 0, At, B0); PG8_MMA(1, 1, At, B1); } PG8_BAR; PG8_SCHED;
            } else {
            PG8_LDB(B0, 0, 0); PG8_SCHED; PG8_LDA(At, 0, 0); PG8_STAGE(PG8_SA(1, 1), a1 + ahs, vA1);
            PG8_WAIT_L(8); PG8_BAR; PG8_WAIT_L(0); PG8_MMA(0, 0, At, B0); PG8_BAR; PG8_SCHED;
            PG8_LDB(B1, 0, 1); PG8_STAGE(PG8_SB(0, 0), b2, voffB);
            PG8_BAR; PG8_WAIT_L(0); PG8_MMA(0, 1, At, B1); PG8_BAR;
            PG8_LDA(At, 0, 1); PG8_STAGE(PG8_SA(0, 0), a2, w0);
            PG8_BAR; PG8_WAIT_L(0); PG8_MMA(1, 0, At, B0); PG8_BAR; PG8_SCHED;
            PG8_STAGE(PG8_SB(0, 1), b2 + hstep, voffB);
            PG8_WAIT_V(6); PG8_BAR; PG8_MMA(1, 1, At, B1); PG8_BAR;
            PG8_LDB(B0, 1, 0); PG8_SCHED; PG8_LDA(At, 1, 0); PG8_STAGE(PG8_SA(0, 1), a2 + ahs, w1);
            PG8_WAIT_L(8); PG8_BAR; PG8_WAIT_L(0); PG8_MMA(0, 0, At, B0); PG8_BAR; PG8_SCHED;
            PG8_LDB(B1, 1, 1); PG8_STAGE(PG8_SB(1, 0), b3, voffB);
            PG8_BAR; PG8_WAIT_L(0); PG8_MMA(0, 1, At, B1); PG8_BAR;
            PG8_LDA(At, 1, 1); PG8_STAGE(PG8_SA(1, 0), a3, w0);
            PG8_BAR; PG8_WAIT_L(0); PG8_MMA(1, 0, At, B0); PG8_BAR; PG8_SCHED;
            PG8_STAGE(PG8_SB(1, 1), b3 + hstep, voffB);
            PG8_WAIT_V(6); PG8_BAR; PG8_MMA(1, 1, At, B1); PG8_BAR;
            }
        }
        typename Sched::Pre pre_; S.pre(ui, pre_);
        if constexpr (ALIGN_EPI) { if (wr == 0) PG8_BAR; }
        E(acc, cur, wr, wc, fr, fq); S.done(cur); S.post(ui, pre_);
        if (!has_next) break;
#pragma unroll
        for (int a = 0; a < 2; ++a)
#pragma unroll
            for (int b = 0; b < 2; ++b)
#pragma unroll
                for (int m = 0; m < 4; ++m)
#pragma unroll
                    for (int n = 0; n < 2; ++n) acc[a][b][m][n] = (f32x4){0.f, 0.f, 0.f, 0.f};
        cur = nxt; cA = nA; cB = nB; ++ui;
        if constexpr (GATHER) {
#pragma unroll
            for (int i = 0; i < 2; ++i) { vA0[i] = nvA0[i]; vA1[i] = nvA1[i]; }
        }
        if constexpr (ALIGN_EPI) { if (wr == 1) PG8_BAR; }
    }
    PG8_WAIT_V(0);
    if constexpr (!ALIGN_EPI) { if (wr == 0) PG8_BAR; }
    PG8_BAR;
#undef PG8_SA
#undef PG8_SB
#undef PG8_STAGE
#undef PG8_LDA
#undef PG8_LDB
#undef PG8_MMA
#undef PG8_WAIT_V
#undef PG8_WAIT_L
#undef PG8_BAR
#undef PG8_SCHED
}

__device__ __forceinline__ u32x4 pack8(const f32x4 v0, const f32x4 v1) { u32x4 w; w.x = cvt_pk_bf16(v0[0], v0[1]); w.y = cvt_pk_bf16(v0[2], v0[3]); w.z = cvt_pk_bf16(v1[0], v1[1]); w.w = cvt_pk_bf16(v1[2], v1[3]); return w; }
__device__ __forceinline__ void unpack8(const u32x4 w, f32x4& v0, f32x4& v1) {
    v0[0] = __uint_as_float(w.x << 16); v0[1] = __uint_as_float(w.x & 0xffff0000u); v0[2] = __uint_as_float(w.y << 16); v0[3] = __uint_as_float(w.y & 0xffff0000u);
    v1[0] = __uint_as_float(w.z << 16); v1[1] = __uint_as_float(w.z & 0xffff0000u); v1[2] = __uint_as_float(w.w << 16); v1[3] = __uint_as_float(w.w & 0xffff0000u); }

struct Epi1 {
    static constexpr bool PERM = true;
    bf16 *Zl, *GA, *UB, *V; float* VPART;
    __device__ __forceinline__ void operator()(const f32x4 (&acc)[2][2][4][2], const Unit& u, int wr, int wc, int fr, int fq) const {
        const int row0 = u.pm * BM + wr * 64 + fr, pn = u.pn;
        if (pn < 4) {
            const int col0 = pn * 256 + wc * 32 + 8 * fq;
#pragma unroll
            for (int ai = 0; ai < 2; ++ai)
#pragma unroll
                for (int m = 0; m < 4; ++m) { bf16* rowp = Zl + (size_t)(row0 + ai * HALF + m * 16) * D + col0;
#pragma unroll
                    for (int bj = 0; bj < 2; ++bj) *(u32x4*)(rowp + bj * HALF) = pack8(acc[ai][bj][m][0], acc[ai][bj][m][1]); }
        } else if (pn < 20) {
            bf16* O = pn < 12 ? GA : UB; const int uu = pn < 12 ? pn - 4 : pn - 12; const int col0 = uu * 128 + wc * 32 + 8 * fq;
#pragma unroll
            for (int ai = 0; ai < 2; ++ai)
#pragma unroll
                for (int m = 0; m < 4; ++m) { f32x4 v[2];
#pragma unroll
                    for (int n = 0; n < 2; ++n) v[n] = acc[ai][0][m][n] * vrcp(vgelu_den(acc[ai][0][m][n]) * vsigm_den(acc[ai][1][m][n]));
                    *(u32x4*)(O + (size_t)(row0 + ai * HALF + m * 16) * D + col0) = pack8(v[0], v[1]); }
        } else {
            const int col0 = (pn - 20) * 256 + wc * 32 + 8 * fq;
#pragma unroll
            for (int ai = 0; ai < 2; ++ai)
#pragma unroll
                for (int m = 0; m < 4; ++m) { const int row = row0 + ai * HALF + m * 16; f32x4 s1v = {0.f, 0.f, 0.f, 0.f}, s2v = {0.f, 0.f, 0.f, 0.f};
#pragma unroll
                    for (int bj = 0; bj < 2; ++bj) { f32x4 v[2];
#pragma unroll
                        for (int n = 0; n < 2; ++n) { v[n] = acc[ai][bj][m][n] * vrcp(vgelu_den(acc[ai][bj][m][n])); s1v += v[n]; s2v += v[n] * v[n]; }
                        *(u32x4*)(V + (size_t)row * D + col0 + bj * HALF) = pack8(v[0], v[1]); }
                    float s1 = hsum4(s1v), s2 = hsum4(s2v);
                    s1 += __shfl_xor(s1, 16); s1 += __shfl_xor(s1, 32); s2 += __shfl_xor(s2, 16); s2 += __shfl_xor(s2, 32);
                    if (fq == 0) *(f32x2*)(VPART + (size_t)row * 32 + ((pn - 20) * 4 + wc) * 2) = (f32x2){s1, s2}; }
        }
    }
};
struct EpiPlain {
    static constexpr bool PERM = true;
    bf16* O;
    __device__ __forceinline__ void operator()(const f32x4 (&acc)[2][2][4][2], const Unit& u, int wr, int wc, int fr, int fq) const {
        const int row0 = u.pm * BM + wr * 64 + fr, col0 = u.pn * 256 + wc * 32 + 8 * fq;
#pragma unroll
        for (int ai = 0; ai < 2; ++ai)
#pragma unroll
            for (int m = 0; m < 4; ++m) { bf16* rowp = O + (size_t)(row0 + ai * HALF + m * 16) * D + col0;
#pragma unroll
                for (int bj = 0; bj < 2; ++bj) *(u32x4*)(rowp + bj * HALF) = pack8(acc[ai][bj][m][0], acc[ai][bj][m][1]); }
    }
};
struct Epi2 {
    static constexpr bool PERM = true;
    const bf16* XN; const float* RI0; const float* GINV; bf16* X1b; float* SS1;
    __device__ __forceinline__ void operator()(const f32x4 (&acc)[2][2][4][2], const Unit& u, int wr, int wc, int fr, int fq) const {
        const int row0 = u.pm * BM + wr * 64 + fr, col0 = u.pn * 256 + wc * 32 + 8 * fq;
#pragma unroll
        for (int ai = 0; ai < 2; ++ai)
#pragma unroll
            for (int m = 0; m < 4; ++m) { const int row = row0 + ai * HALF + m * 16; float ss = 0.f; const float ri = RI0[row];
#pragma unroll
                for (int bj = 0; bj < 2; ++bj) { f32x4 x0, x1; unpack8(*(const u32x4*)(XN + (size_t)row * D + col0 + bj * HALF), x0, x1);
                    const f32x4 g0 = *(const f32x4*)(GINV + col0 + bj * HALF), g1 = *(const f32x4*)(GINV + col0 + bj * HALF + 4);
                    const f32x4 v0 = acc[ai][bj][m][0] + x0 * ri * g0, v1 = acc[ai][bj][m][1] + x1 * ri * g1;
                    ss += hsum4(v0 * v0 + v1 * v1);
                    *(u32x4*)(X1b + (size_t)row * D + col0 + bj * HALF) = pack8(v0, v1); }
                ss += __shfl_xor(ss, 16); ss += __shfl_xor(ss, 32);
                if (fq == 0) SS1[(size_t)row * 16 + u.pn * 4 + wc] = ss; }
    }
};
struct EpiPle {
    static constexpr bool PERM = true;
    const bf16* X2b; const bf16* PU; const float* RSTD2; bf16* X3; float* SS3;
    __device__ __forceinline__ void operator()(const f32x4 (&acc)[2][2][4][2], const Unit& u, int wr, int wc, int fr, int fq) const {
        const int row0 = u.pm * BM + wr * 64 + fr, col0 = u.pn * 256 + wc * 32 + 8 * fq;
#pragma unroll
        for (int ai = 0; ai < 2; ++ai)
#pragma unroll
            for (int m = 0; m < 4; ++m) { const int row = row0 + ai * HALF + m * 16; float ss = 0.f; const float r2n = RSTD2[row] * (-1.4426950409f);
#pragma unroll
                for (int bj = 0; bj < 2; ++bj) { const size_t o = (size_t)row * D + col0 + bj * HALF;
                    f32x4 x0, x1, p0, p1; unpack8(*(const u32x4*)(X2b + o), x0, x1); unpack8(*(const u32x4*)(PU + o), p0, p1);
                    const f32x4 v0 = x0 + vrcp(1.f + vexp2(acc[ai][bj][m][0] * r2n)) * p0, v1 = x1 + vrcp(1.f + vexp2(acc[ai][bj][m][1] * r2n)) * p1;
                    ss += hsum4(v0 * v0 + v1 * v1);
                    *(u32x4*)(X3 + o) = pack8(v0, v1); }
                ss += __shfl_xor(ss, 16); ss += __shfl_xor(ss, 32);
                if (fq == 0) SS3[(size_t)row * 16 + u.pn * 4 + wc] = ss; }
    }
};

struct EpiPleFinal {
    static constexpr bool PERM = true;
    const bf16* X2b; const bf16* PU; const float* RSTD2; const float* fn; float* out; float* XCH; unsigned* cnt; LAS float* xl; int wave;
    __device__ __forceinline__ void operator()(f32x4 (&acc)[2][2][4][2], const Unit& u, int wr, int wc, int fr, int fq) const {
        const int tid = wave * 64 + lane_id();
        const int rl0 = wr * 64 + fr, col0 = u.pn * 256 + wc * 32 + 8 * fq;
#pragma unroll
        for (int ai = 0; ai < 2; ++ai)
#pragma unroll
            for (int m = 0; m < 4; ++m) { const int rl = rl0 + ai * HALF + m * 16, row = u.pm * BM + rl; float ss = 0.f; const float r2n = RSTD2[row] * (-1.4426950409f);
#pragma unroll
                for (int bj = 0; bj < 2; ++bj) { const size_t o = (size_t)row * D + col0 + bj * HALF;
                    f32x4 x0, x1, p0, p1; unpack8(*(const u32x4*)(X2b + o), x0, x1); unpack8(*(const u32x4*)(PU + o), p0, p1);
                    const f32x4 v0 = x0 + vrcp(1.f + vexp2(acc[ai][bj][m][0] * r2n)) * p0, v1 = x1 + vrcp(1.f + vexp2(acc[ai][bj][m][1] * r2n)) * p1;
                    ss += hsum4(v0 * v0 + v1 * v1);
                    acc[ai][bj][m][0] = v0; acc[ai][bj][m][1] = v1; }
                ss += __shfl_xor(ss, 16); ss += __shfl_xor(ss, 32);
                if (fq == 0) xl[rl * 4 + wc] = ss; }
        __syncthreads();
        if (tid < 256) { const f32x4 p = *(const LAS f32x4*)(xl + tid * 4);
            __hip_atomic_store(XCH + (size_t)(u.pm * BM + tid) * 4 + u.pn, (p[0] + p[1]) + (p[2] + p[3]), __ATOMIC_RELAXED, __HIP_MEMORY_SCOPE_AGENT); }
        asm volatile("s_waitcnt vmcnt(0)" ::: "memory");
        if (tid < 256 && (tid & 63) == 0) __hip_atomic_fetch_add(cnt + 64 * u.pm, 1u, __ATOMIC_RELAXED, __HIP_MEMORY_SCOPE_AGENT);
        if (tid < 64) { unsigned sp = 0;
            while ((unsigned)__builtin_amdgcn_readfirstlane(__hip_atomic_load(cnt + 64 * u.pm, __ATOMIC_RELAXED, __HIP_MEMORY_SCOPE_AGENT)) < 16u) { if (++sp > (1u << 22)) break; __builtin_amdgcn_s_sleep(1); } }
        __syncthreads();
        if (tid < 256) { const float* xs = XCH + (size_t)(u.pm * BM + tid) * 4; float tot = 0.f;
#pragma unroll
            for (int q = 0; q < 4; ++q) tot += __hip_atomic_load(xs + q, __ATOMIC_RELAXED, __HIP_MEMORY_SCOPE_AGENT);
            xl[1024 + tid] = rsqrtf(tot * (1.f / D) + EPS); }
        __syncthreads();
#pragma unroll
        for (int ai = 0; ai < 2; ++ai)
#pragma unroll
            for (int m = 0; m < 4; ++m) { const int rl = rl0 + ai * HALF + m * 16; const float rs = xl[1024 + rl]; float* op = out + (size_t)(u.pm * BM + rl) * D + col0;
#pragma unroll
                for (int bj = 0; bj < 2; ++bj) { const f32x4 f0 = *(const f32x4*)(fn + col0 + bj * HALF), f1 = *(const f32x4*)(fn + col0 + bj * HALF + 4);
                    *(f32x4*)(op + bj * HALF) = acc[ai][bj][m][0] * rs * f0; *(f32x4*)(op + bj * HALF + 4) = acc[ai][bj][m][1] * rs * f1; } }
    }
};

template <int MODE> struct MoeOrder {
    const LAS int* tab; const int* LIST; unsigned* dcnt;
    __device__ __forceinline__ bool next(int i, Unit& u) const {
        const int n = __builtin_amdgcn_readfirstlane(tab[0]); if (i >= n) return false;
        const LAS int* p = tab + 4 + 8 * i;
        u.pm = __builtin_amdgcn_readfirstlane(p[0]); u.pn = __builtin_amdgcn_readfirstlane(p[1]); u.e = __builtin_amdgcn_readfirstlane(p[2]);
        u.tile = __builtin_amdgcn_readfirstlane(p[3]); u.cnt = __builtin_amdgcn_readfirstlane(p[4]); return true;
    }
    __device__ __forceinline__ unsigned row_off(const Unit& u, int r) const { int idx = u.tile * 256 + r; idx = idx < u.cnt ? idx : u.cnt - 1; const int pair = LIST[u.e * 16384 + idx]; return (unsigned)(pair >> 1) * 2048u; }
    __device__ __forceinline__ void a_ready(const Unit&) const {}
    struct Pre {}; __device__ __forceinline__ void pre(int, Pre&) const {}
    __device__ __forceinline__ void post(int, Pre&) const {}
    __device__ __forceinline__ bool half(const Unit& u) const { return MODE == 1 && (u.cnt - u.tile * 256) <= 128; }
    __device__ __forceinline__ void done(const Unit& u) const {
        if constexpr (MODE == 1) {
            asm volatile("s_waitcnt vmcnt(0)" ::: "memory");
            if (lane_id() == 0) __hip_atomic_fetch_add(dcnt + 64 * u.pm, 1u, __ATOMIC_RELAXED, __HIP_MEMORY_SCOPE_AGENT);
        }
    }
};
__device__ __forceinline__ void store16_sc1(void* p, u32x4 v) { asm volatile("global_store_dwordx4 %0, %1, off sc1\n\ts_nop 1" :: "v"(p), "v"(v) : "memory"); }
struct EpiMoe1 {
    static constexpr bool PERM = true;
    bf16* H; const float* LISTR;
    __device__ __forceinline__ void operator()(const f32x4 (&acc)[2][2][4][2], const Unit& u, int wr, int wc, int fr, int fq) const {
        const int col0 = (u.pn & 1) * 128 + wc * 32 + 8 * fq;
#pragma unroll
        for (int ai = 0; ai < 2; ++ai)
#pragma unroll
            for (int m = 0; m < 4; ++m) { const int r = ai * HALF + wr * 64 + m * 16 + fr; int idx = u.tile * 256 + r; idx = idx < u.cnt ? idx : u.cnt - 1;
                const float rs = LISTR[u.e * 16384 + idx]; f32x4 v[2];
#pragma unroll
                for (int n = 0; n < 2; ++n) { const f32x4 a1 = acc[ai][0][m][n] * rs, a3 = acc[ai][1][m][n] * rs; v[n] = a1 * a3 * vrcp(vsigm_den(a1)); }
                store16_sc1(H + (size_t)(u.pm * 256 + r) * 256 + col0, pack8(v[0], v[1])); }
    }
};
struct EpiMoe2 {
    static constexpr bool PERM = true;
    bf16* Y; const int* LIST; const float* LISTG;
    __device__ __forceinline__ void operator()(const f32x4 (&acc)[2][2][4][2], const Unit& u, int wr, int wc, int fr, int fq) const {
        const int col0 = (u.pn & 3) * 256 + wc * 32 + 8 * fq;
        int pr[2][4]; float gt[2][4];
#pragma unroll
        for (int ai = 0; ai < 2; ++ai)
#pragma unroll
            for (int m = 0; m < 4; ++m) { int idx = u.tile * 256 + ai * HALF + wr * 64 + m * 16 + fr; idx = idx < u.cnt ? idx : u.cnt - 1; pr[ai][m] = LIST[u.e * 16384 + idx]; gt[ai][m] = LISTG[u.e * 16384 + idx]; }
#pragma unroll
        for (int ai = 0; ai < 2; ++ai)
#pragma unroll
            for (int m = 0; m < 4; ++m) { const int idx = u.tile * 256 + ai * HALF + wr * 64 + m * 16 + fr;
                if (idx < u.cnt) { const float g = gt[ai][m]; bf16* yp = Y + (size_t)pr[ai][m] * D + col0;
#pragma unroll
                    for (int bj = 0; bj < 2; ++bj) *(u32x4*)(yp + bj * HALF) = pack8(acc[ai][bj][m][0] * g, acc[ai][bj][m][1] * g); } }
    }
};
}

constexpr int NWAVES = 8;
constexpr int RING_BYTES = 131072, LDSCTL_OFF = 139264, MISC_OFF = LDSCTL_OFF + 320, TAB_OFF = LDSCTL_OFF + 512, LDS_BYTES = 147456;
constexpr size_t WS_WLRU = 8 * MiB + 512 * 1024;
constexpr size_t WS_WSGU = 8 * MiB + 768 * 1024;
constexpr size_t WS_WR = 9 * MiB;
constexpr size_t WS_WUP = 9 * MiB + 512 * 1024;
constexpr size_t WS_WIN = 10 * MiB;
constexpr size_t WS_WOUT = 22 * MiB;
constexpr size_t WS_WG = 24 * MiB;
constexpr size_t WS_W13 = 26 * MiB;
constexpr size_t WS_W2 = 58 * MiB;
constexpr size_t WS_PB = 234 * MiB;
constexpr size_t WS_RSTD1 = 242 * MiB;
constexpr size_t WS_RSTD0 = 242 * MiB + 128 * 1024;
constexpr size_t WS_GINV = 242 * MiB + 256 * 1024;
constexpr size_t WS_SPL8 = 242 * MiB + 512 * 1024;
constexpr size_t WS_XCH = 243 * MiB;
constexpr size_t WS_LISTG = 244 * MiB;
constexpr size_t WS_LISTR = 246 * MiB;
constexpr size_t WS_MEGA_END = 248 * MiB;
constexpr int CW_BAR = 4096;
constexpr int CW_DONE1 = 131072;
constexpr int CW_MIX = 147456;
constexpr int CW_PANEL = 65536;

typedef GAS unsigned gu32;
#define RLX_AGENT __ATOMIC_RELAXED, __HIP_MEMORY_SCOPE_AGENT
#define LDS_WAIT() asm volatile("s_waitcnt lgkmcnt(0)" ::: "memory")
#define VM_WAIT() asm volatile("s_waitcnt vmcnt(0)" ::: "memory")

#define XB_TMO      128
#define XB_XCNT(j)  (256  + 64 * (j))
#define XB_XSUB(j)  (1280 + 64 * (j))
#define XB_XGEN(j)  (2304 + 64 * (j))
#define XB_TOP      3328
#define XB_TOPGEN   3392
#define XCD_BAR_WORDS 3456
#define XB_SPIN_CAP (1u << 18)
__device__ __forceinline__ unsigned xb_ld(unsigned* p)              { return __hip_atomic_load(p, __ATOMIC_RELAXED, __HIP_MEMORY_SCOPE_AGENT); }
__device__ __forceinline__ unsigned xb_add(unsigned* p, unsigned v) { return __hip_atomic_fetch_add(p, v, __ATOMIC_RELAXED, __HIP_MEMORY_SCOPE_AGENT); }
__device__ __forceinline__ unsigned xb_xcc_id() { return (unsigned)__builtin_amdgcn_s_getreg((3 << 11) | 20) & 0xFu; }
#define XB_SPIN(cond, bar) do { unsigned _sp = 0; while (cond) { __builtin_amdgcn_s_sleep(1); \
    if ((++_sp & 255u) == 0u) { if (xb_ld(&(bar)[XB_TMO])) break; if (_sp > XB_SPIN_CAP) { atomicAdd(&(bar)[XB_TMO], 1u); break; } } } } while (0)
struct XcdBarrier { unsigned* bar; unsigned x; volatile LAS unsigned* st; int wave; };
__device__ __forceinline__ XcdBarrier xcd_barrier_post(unsigned* bar, volatile LAS unsigned* st, int wave) {
    XcdBarrier b; b.bar = bar; b.x = xb_xcc_id(); b.st = st; b.wave = wave;
    if (wave == 0 && pg8::lane_id() == 0) (void)xb_add(&bar[XB_XCNT(b.x)], 1u);
    return b;
}
__device__ __forceinline__ void xcd_barrier_complete(unsigned* bar, unsigned x, unsigned& nloc, unsigned& nx) {
    const unsigned G = gridDim.x * gridDim.y * gridDim.z;
    unsigned sum, cnt, mine, sp = 0u;
    for (;;) {
        sum = 0u; cnt = 0u; mine = 0u;
#pragma unroll
        for (unsigned j = 0; j < 16; ++j) { const unsigned c = xb_ld(&bar[XB_XCNT(j)]); sum += c; cnt += (c > 0u) ? 1u : 0u; mine = (j == x) ? c : mine; }
        if (sum == G) break;
        __builtin_amdgcn_s_sleep(1);
        if ((++sp & 255u) == 0u) { if (xb_ld(&bar[XB_TMO])) break; if (sp > XB_SPIN_CAP) { atomicAdd(&bar[XB_TMO], 1u); break; } }
    }
    nloc = mine > 0u ? mine : 1u; nx = cnt > 0u ? cnt : 1u;
}
__device__ __forceinline__ void xcd_barrier(const XcdBarrier& b) {
    asm volatile("s_waitcnt vmcnt(0)" ::: "memory");
    __syncthreads();
    if (b.wave == 0 && pg8::lane_id() == 0) {
        unsigned* bar = b.bar;
        __builtin_amdgcn_s_waitcnt(0);
        unsigned nloc = b.st[0], nx = b.st[1];
        if (nloc == 0u) { xcd_barrier_complete(bar, b.x, nloc, nx); b.st[0] = nloc; b.st[1] = nx; }
        const unsigned old = xb_add(&bar[XB_XSUB(b.x)], 1u);
        const unsigned gen = old / nloc;
        if (old + 1u == (gen + 1u) * nloc) {
            __builtin_amdgcn_fence(__ATOMIC_RELEASE, "agent");
            asm volatile("s_waitcnt vmcnt(0)" ::: "memory");
            const unsigned og = xb_add(&bar[XB_TOP], 1u);
            const unsigned tg = og / nx;
            if (og + 1u == (tg + 1u) * nx) xb_add(&bar[XB_TOPGEN], 1u);
            else XB_SPIN(xb_ld(&bar[XB_TOPGEN]) == tg, bar);
            __builtin_amdgcn_fence(__ATOMIC_ACQUIRE, "agent");
            xb_add(&bar[XB_XGEN(b.x)], 1u);
            asm volatile("s_waitcnt vmcnt(0)" ::: "memory");
        } else {
            XB_SPIN(xb_ld(&bar[XB_XGEN(b.x)]) == gen, bar);
            __builtin_amdgcn_fence(__ATOMIC_ACQUIRE, "agent");
            asm volatile("s_waitcnt vmcnt(0)" ::: "memory");
        }
    }
    __syncthreads();
}

__device__ __forceinline__ unsigned pk2(float lo, float hi) { return (unsigned)f2bf(lo) | ((unsigned)f2bf(hi) << 16); }

struct TrItem { pg8::f32x4 v[8]; };
template <bool NT = false> __device__ __forceinline__ void tr_load(TrItem& t, const float* __restrict__ W, int ldn, int k0, int n_src0, int lane) {
    const int kb = lane >> 3, n4 = lane & 7;
    const float* src = W + (size_t)(k0 + 8 * kb) * ldn + n_src0 + 4 * n4;
#pragma unroll
    for (int q = 0; q < 8; ++q) t.v[q] = NT ? __builtin_nontemporal_load((const pg8::f32x4*)(src + (size_t)q * ldn)) : *(const pg8::f32x4*)(src + (size_t)q * ldn);
}
template <bool NT = false> __device__ __forceinline__ void tr_store(TrItem& t, int k0, bf16* __restrict__ WT, int Kd, int drow0, const float* __restrict__ gk, int lane) {
    const int kb = lane >> 3, n4 = lane & 7;
    if (gk) { const pg8::f32x4 g0 = *(const pg8::f32x4*)(gk + k0 + 8 * kb), g1 = *(const pg8::f32x4*)(gk + k0 + 8 * kb + 4);
#pragma unroll
        for (int q = 0; q < 8; ++q) t.v[q] = t.v[q] * (q < 4 ? g0[q & 3] : g1[q & 3]); }
#pragma unroll
    for (int i = 0; i < 4; ++i) { pg8::u32x4 o; o.x = pk2(t.v[0][i], t.v[1][i]); o.y = pk2(t.v[2][i], t.v[3][i]); o.z = pk2(t.v[4][i], t.v[5][i]); o.w = pk2(t.v[6][i], t.v[7][i]);
        if (NT) __builtin_nontemporal_store(o, (pg8::u32x4*)(WT + (size_t)(drow0 + 4 * n4 + i) * Kd + k0 + 8 * kb)); else *(pg8::u32x4*)(WT + (size_t)(drow0 + 4 * n4 + i) * Kd + k0 + 8 * kb) = o; }
}
__device__ __forceinline__ void p0_transpose_item(const float* __restrict__ W, int ldn, int k0, int n_src0, bf16* __restrict__ WT, int Kd, int drow0, const float* __restrict__ gk, LAS float*, int lane) {
    TrItem t; tr_load<true>(t, W, ldn, k0, n_src0, lane); tr_store(t, k0, WT, Kd, drow0, gk, lane);
}
__device__ __forceinline__ int win_dest_row(int n) {
    const int grp = n >> 10, j = n & 1023;
    switch (grp) {
        case 0: return j;
        case 1: return 1024 + (j >> 7) * 256 + (j & 127);
        case 2: return 3072 + (j >> 7) * 256 + (j & 127);
        case 3: return 5120 + j;
        case 4: return 1024 + (j >> 7) * 256 + 128 + (j & 127);
        default: return 3072 + (j >> 7) * 256 + 128 + (j & 127);
    }
}


struct DefW { const float* const* in; unsigned char* ws; };
constexpr int DF_OUT = 8 * 32, DF_E13 = 32 * 2 * 64, DF_E2 = 32 * 64, DF_G = 8 * 32, DF_UP = 2 * 32, DF_N = DF_OUT + DF_E13 + DF_E2 + DF_G + DF_UP;
struct DefDesc { const float* W; const float* gk; bf16* WT; int ldn, k0, n0, Kd, drow; };
__device__ __forceinline__ DefDesc deferred_desc(const DefW& w, int it) {
    int r = it; DefDesc d;
    if (r < DF_OUT) { const int kb = r / 16, np = r % 16; d = DefDesc{w.in[15], nullptr, (bf16*)(w.ws + WS_WOUT), 1024, kb * 64, np * 64, 1024, np * 64}; return d; } r -= DF_OUT;
    if (r < DF_E13) { const int e = r / 128, which = (r / 64) & 1, q = r % 64, kb = q / 4, np = q % 4;
        const int f0 = np * 64, drow = e * 512 + (f0 >> 7) * 256 + which * 128 + (f0 & 127);
        d = DefDesc{w.in[which ? 22 : 21] + (size_t)e * 1024 * 256, w.in[16], (bf16*)(w.ws + WS_W13), 256, kb * 64, f0, 1024, drow}; return d; } r -= DF_E13;
    if (r < DF_E2) { const int e = r / 64, q = r % 64, kb = q / 16, np = q % 16;
        d = DefDesc{w.in[23] + (size_t)e * 256 * 1024, nullptr, (bf16*)(w.ws + WS_W2), 1024, kb * 64, np * 64, 256, e * 1024 + np * 64}; return d; } r -= DF_E2;
    if (r < DF_G) { const int kb = r / 16, np = r % 16; d = DefDesc{w.in[25], w.in[24], (bf16*)(w.ws + WS_WG), 1024, kb * 64, np * 64, 1024, np * 64}; return d; } r -= DF_G;
    { const int kb = r / 16, np = r % 16; d = DefDesc{w.in[26], nullptr, (bf16*)(w.ws + WS_WUP), 1024, kb * 64, np * 64, 256, np * 64}; return d; }
}
struct Gemm1Order : pg8::StaticOrder {
    DefW w; int wave; int gi;
    struct Pre {}; __device__ __forceinline__ void pre(int, Pre&) const {}
    __device__ __forceinline__ void post(int ui, Pre&) const {
        if (ui != gi) return;
        const int lane = pg8::lane_id(), slot = c * 8 + wave, nslot = G * 8;
        for (int it = slot; it < DF_N; it += nslot) { const DefDesc d = deferred_desc(w, it); TrItem t0, t1;
            tr_load<true>(t0, d.W, d.ldn, d.k0, d.n0, lane); tr_load<true>(t1, d.W, d.ldn, d.k0, d.n0 + 32, lane);
            tr_store<true>(t0, d.k0, d.WT, d.Kd, d.drow, d.gk, lane); tr_store<true>(t1, d.k0, d.WT, d.Kd, d.drow + 32, d.gk, lane); }
        const pg8::f32x4* psrc = (const pg8::f32x4*)w.in[1]; unsigned long long* pdst = (unsigned long long*)(w.ws + WS_PB);
        for (int ch = slot; ch < 8192; ch += 4 * nslot) {
            pg8::f32x4 pv[8]; size_t io[4];
#pragma unroll
            for (int c = 0; c < 4; ++c) { const int chc = ch + c * nslot < 8192 ? ch + c * nslot : ch; io[c] = (size_t)chc * 128 + lane; pv[2 * c] = __builtin_nontemporal_load(psrc + io[c]); pv[2 * c + 1] = __builtin_nontemporal_load(psrc + io[c] + 64); }
#pragma unroll
            for (int c = 0; c < 4; ++c) {
                __builtin_nontemporal_store((unsigned long long)pk2(pv[2 * c].x, pv[2 * c].y) | ((unsigned long long)pk2(pv[2 * c].z, pv[2 * c].w) << 32), pdst + io[c]);
                __builtin_nontemporal_store((unsigned long long)pk2(pv[2 * c + 1].x, pv[2 * c + 1].y) | ((unsigned long long)pk2(pv[2 * c + 1].z, pv[2 * c + 1].w) << 32), pdst + io[c] + 64); } }
    }
};

constexpr int MY_VT = 0, MY_XA = 32768, MY_SP = 67584, MY_WS = 102400, MY_ST = 135168, MY_RS = 272;
__device__ __forceinline__ float bflo(unsigned u) { return __uint_as_float(u << 16); }
__device__ __forceinline__ float bfhi(unsigned u) { return __uint_as_float(u & 0xffff0000u); }
template <int N> __device__ __forceinline__ float row_shr(float ident, float v) {
    return __builtin_bit_cast(float, __builtin_amdgcn_update_dpp(__builtin_bit_cast(int, ident), __builtin_bit_cast(int, v), 0x110 + N, 0xf, 0xf, false)); }
#define MX_DPP_STEP(N) \
    "v_fmac_f32_dpp %4, %4, %0 row_shr:" #N " row_mask:0xf bank_mask:0xf\n\tv_fmac_f32_dpp %5, %5, %1 row_shr:" #N " row_mask:0xf bank_mask:0xf\n\t" \
    "v_fmac_f32_dpp %6, %6, %2 row_shr:" #N " row_mask:0xf bank_mask:0xf\n\tv_fmac_f32_dpp %7, %7, %3 row_shr:" #N " row_mask:0xf bank_mask:0xf\n\t" \
    "v_mul_f32_dpp %0, %0, %0 row_shr:" #N " row_mask:0xf bank_mask:0xf\n\tv_mul_f32_dpp %1, %1, %1 row_shr:" #N " row_mask:0xf bank_mask:0xf\n\t" \
    "v_mul_f32_dpp %2, %2, %2 row_shr:" #N " row_mask:0xf bank_mask:0xf\n\tv_mul_f32_dpp %3, %3, %3 row_shr:" #N " row_mask:0xf bank_mask:0xf\n\t"
__device__ __forceinline__ void scan16x4(pg8::f32x4& A, pg8::f32x4& U) { using pg8::f32x4;
    float a0 = A[0], a1 = A[1], a2 = A[2], a3 = A[3], u0 = U[0], u1 = U[1], u2 = U[2], u3 = U[3];
    asm("s_nop 1\n\t" MX_DPP_STEP(1) MX_DPP_STEP(2) MX_DPP_STEP(4) MX_DPP_STEP(8) "s_nop 0"
        : "+v"(a0), "+v"(a1), "+v"(a2), "+v"(a3), "+v"(u0), "+v"(u1), "+v"(u2), "+v"(u3));
    A = (f32x4){a0, a1, a2, a3}; U = (f32x4){u0, u1, u2, u3};
}
__device__ __forceinline__ void mixer_phase(LAS unsigned char* lds, const int vcu, const int G, const int tid, const int lane, const int wave,
                                            const bf16* __restrict__ Zl, const bf16* __restrict__ GA, const bf16* __restrict__ UB, const bf16* __restrict__ V, const float* __restrict__ VPART,
                                            unsigned long long* AGG, bf16* __restrict__ MG, unsigned* mixc, const bf16* __restrict__ WLRU, const bf16* __restrict__ WSGU, const float* __restrict__ SPL8, const float* const* in) {
    using namespace pg8;
    constexpr int RS = MY_RS;
    constexpr float L2E = 1.4426950409f;
    const int fr = lane & 15, grp = lane >> 4, cp = tid & 63, tg = wave;
    const int pr = lane & 3, sch = lane >> 2, srow = 8 * sch + 2 * pr;
    LAS float* ST = (LAS float*)(lds + MY_ST);
    int gprev = -1;
    f32x2 cw0, cw1, cw2, cw3, ccb;
    u32x4 zqa, zqb, zqc, zqd, zqe, vv00, vv01, vv10, vv11;
#define MX_ZR(k) ((k) < 4 ? zqa[(k) & 3] : (k) < 8 ? zqb[(k) & 3] : (k) < 12 ? zqc[(k) & 3] : (k) < 16 ? zqd[(k) & 3] : zqe[(k) & 3])
#define MX_SETZR(k, v) do { if ((k) < 4) zqa[(k) & 3] = (v); else if ((k) < 8) zqb[(k) & 3] = (v); else if ((k) < 12) zqc[(k) & 3] = (v); else if ((k) < 16) zqd[(k) & 3] = (v); else zqe[(k) & 3] = (v); } while (0)
#define MX_PREFETCH(uu) do { const int ck_ = (uu) >> 3, g_ = (uu) & 7, t0_ = ck_ * 128, c0_ = g_ * 128; const bool first_ = (ck_ & 15) == 0; \
        const unsigned zo_ = ((unsigned)(t0_ + 16 * tg) * D + c0_ + 2 * cp) * 2u; \
        _Pragma("unroll") for (int k = 0; k < 19; ++k) { unsigned zv_ = 0u; if (!(k < 3 && first_ && tg == 0)) zv_ = *(const unsigned*)((const char*)Zl + (zo_ + (unsigned)((k - 3) * D * 2))); MX_SETZR(k, zv_); } \
        { const unsigned vo_ = ((unsigned)(t0_ + srow) * D + c0_ + 16 * wave) * 2u; vv00 = *(const u32x4*)((const char*)V + vo_); vv01 = *(const u32x4*)((const char*)V + (vo_ + D * 2)); vv10 = *(const u32x4*)((const char*)V + (vo_ + 16)); vv11 = *(const u32x4*)((const char*)V + (vo_ + D * 2 + 16)); } \
        } while (0)
    zqe = (u32x4){0u, 0u, 0u, 0u};
#define MX_STATS_LOAD(uu, q0, q1) do { const unsigned vpo_ = ((unsigned)(((uu) >> 3) * 128 + (tid >> 2)) * 32 + (tid & 3) * 8) * 4u; q0 = *(const f32x4*)((const char*)VPART + vpo_); q1 = *(const f32x4*)((const char*)VPART + (vpo_ + 16)); } while (0)
#define MX_STATS_WRITE(q0, q1) do { float s1 = (q0[0] + q0[2]) + (q1[0] + q1[2]), s2 = (q0[1] + q0[3]) + (q1[1] + q1[3]); \
        s1 += __shfl_xor(s1, 1); s1 += __shfl_xor(s1, 2); s2 += __shfl_xor(s2, 1); s2 += __shfl_xor(s2, 2); \
        if ((tid & 3) == 0) { const float mean = s1 * (1.f / 1024.f); float var = s2 * (1.f / 1024.f) - mean * mean; var = var < 0.f ? 0.f : var; ST[tid >> 2] = mean; ST[128 + (tid >> 2)] = rsqrtf(var + EPS); } } while (0)
    int u = vcu;
    if (u < 1024) { MX_PREFETCH(u); f32x4 q0, q1; MX_STATS_LOAD(u, q0, q1); MX_STATS_WRITE(q0, q1); }
    for (; u < 1024; u += G) {
        const int ck = u >> 3, g = u & 7, t0 = ck * 128, c0 = g * 128, j = ck & 15;
        const int cch = c0 + 16 * wave + 4 * grp;
        if (g != gprev) {
            gprev = g;
#pragma unroll
            for (int it = 0; it < 4; ++it) { const int idx = it * 512 + tid, row = idx >> 4, ch = idx & 15;
                *(LAS u32x4*)(lds + MY_WS + row * 256 + ((ch ^ (row & 15)) << 4)) = *(const u32x4*)(WSGU + ((size_t)(g * 128 + row)) * 128 + ch * 8); }
            const int cc = c0 + 2 * cp;
            cw0 = *(const f32x2*)(in[4] + cc); cw1 = *(const f32x2*)(in[4] + 1024 + cc); cw2 = *(const f32x2*)(in[4] + 2048 + cc); cw3 = *(const f32x2*)(in[4] + 3072 + cc); ccb = *(const f32x2*)(in[5] + cc);
        }
        const int hblk = 2 * g + (wave >> 2), jj0 = (16 * wave) & 63;
        const bf16x8 bw00 = *(const bf16x8*)(WLRU + ((size_t)((0 * 16 + hblk) * 64 + jj0 + fr)) * 64 + 0 * 32 + 8 * grp), bw01 = *(const bf16x8*)(WLRU + ((size_t)((0 * 16 + hblk) * 64 + jj0 + fr)) * 64 + 1 * 32 + 8 * grp);
        const bf16x8 bw10 = *(const bf16x8*)(WLRU + ((size_t)((1 * 16 + hblk) * 64 + jj0 + fr)) * 64 + 0 * 32 + 8 * grp), bw11 = *(const bf16x8*)(WLRU + ((size_t)((1 * 16 + hblk) * 64 + jj0 + fr)) * 64 + 1 * 32 + 8 * grp);
        const f32x4 nba = *(const f32x4*)(in[7] + cch) * (-L2E), nbi = *(const f32x4*)(in[9] + cch) * (-L2E), ksp = *(const f32x4*)(SPL8 + cch);
        {
#pragma unroll
            for (int i = 0; i < 16; ++i) {
                const unsigned z0 = MX_ZR(i), z1 = MX_ZR(i + 1), z2 = MX_ZR(i + 2), z3 = MX_ZR(i + 3);
                const f32x2 xv = ccb + cw0 * (f32x2){bflo(z0), bfhi(z0)} + cw1 * (f32x2){bflo(z1), bfhi(z1)} + cw2 * (f32x2){bflo(z2), bfhi(z2)} + cw3 * (f32x2){bflo(z3), bfhi(z3)};
                *(LAS unsigned*)(lds + MY_XA + (16 * tg + i) * RS + 4 * cp) = cvt_pk_bf16(xv.x, xv.y);
            }
        }
        __syncthreads();
        {
            const float mua = ST[srow], rsa = ST[128 + srow], mub = ST[srow + 1], rsb = ST[128 + srow + 1];
#pragma unroll
            for (int ci = 0; ci < 2; ++ci) { const int chunk = 2 * wave + ci, cbase = c0 + 8 * chunk;
                f32x4 a0, a1, b0, b1; unpack8(ci ? vv10 : vv00, a0, a1); unpack8(ci ? vv11 : vv01, b0, b1);
                const f32x4 g0 = *(const f32x4*)(in[11] + cbase), g1 = *(const f32x4*)(in[11] + cbase + 4), l0 = *(const f32x4*)(in[12] + cbase), l1 = *(const f32x4*)(in[12] + cbase + 4);
                a0 = (a0 - mua) * rsa * g0 + l0; a1 = (a1 - mua) * rsa * g1 + l1; b0 = (b0 - mub) * rsb * g0 + l0; b1 = (b1 - mub) * rsb * g1 + l1;
#pragma unroll
                for (int i = 0; i < 8; ++i) { const int cl = 8 * chunk + i; const float va = i < 4 ? a0[i & 3] : a1[i & 3], vb = i < 4 ? b0[i & 3] : b1[i & 3];
                    *(LAS unsigned*)(lds + MY_VT + cl * 256 + ((sch ^ (cl & 15)) << 4) + 4 * pr) = cvt_pk_bf16(va, vb); }
            }
        }
        f32x4 R[8], I[8];
#pragma unroll
        for (int mt = 0; mt < 8; ++mt) { R[mt] = (f32x4){0.f, 0.f, 0.f, 0.f}; I[mt] = (f32x4){0.f, 0.f, 0.f, 0.f};
#pragma unroll
            for (int ks = 0; ks < 2; ++ks) { const bf16x8 a = *(const LAS bf16x8*)(lds + MY_XA + (mt * 16 + fr) * RS + ((wave >> 2) * 64 + ks * 32 + 8 * grp) * 2);
                R[mt] = __builtin_amdgcn_mfma_f32_16x16x32_bf16(ks ? bw01 : bw00, a, R[mt], 0, 0, 0); I[mt] = __builtin_amdgcn_mfma_f32_16x16x32_bf16(ks ? bw11 : bw10, a, I[mt], 0, 0, 0); } }
#pragma unroll
        for (int mt = 0; mt < 8; ++mt) {
            const u32x2 xw = *(const LAS u32x2*)(lds + MY_XA + (mt * 16 + fr) * RS + (16 * wave + 4 * grp) * 2);
            const f32x4 xa4 = {bflo(xw.x), bfhi(xw.x), bflo(xw.y), bfhi(xw.y)};
            const f32x4 t1 = R[mt] * (-L2E) + nba, t2 = I[mt] * (-L2E) + nbi;
            const f32x4 d1 = 1.f + vexp2(t1), d2 = 1.f + vexp2(t2), inv = vrcp(d1 * d2);
            const f32x4 rr = d2 * inv, ii = d1 * inv, la = rr * ksp;
            const f32x4 w = la * (1.f + la * (0.5f + la * (0.16666667f + la * (0.041666667f + la * 0.0083333333f))));
            f32x4 av = 1.f + w;
            const f32x4 om = -w * (2.f + w);
            f32x4 uv;
#pragma unroll
            for (int r = 0; r < 4; ++r) uv[r] = __builtin_amdgcn_sqrtf(om[r]);
            uv = uv * ii * xa4;
            scan16x4(av, uv); R[mt] = av; I[mt] = uv;
        }
        {
            f32x4 Pc = {1.f, 1.f, 1.f, 1.f}, Hc = {0.f, 0.f, 0.f, 0.f};
#pragma unroll
            for (int mt = 0; mt < 8; ++mt) { Hc = Hc * R[mt] + I[mt]; Pc = Pc * R[mt]; }
            if (fr == 15) {
#pragma unroll
                for (int r = 0; r < 4; ++r) __hip_atomic_store(AGG + (size_t)ck * 1024 + cch + r, ((unsigned long long)__float_as_uint(Hc[r]) << 32) | (unsigned long long)__float_as_uint(Pc[r]), __ATOMIC_RELAXED, __HIP_MEMORY_SCOPE_AGENT);
            }
        }
        __syncthreads();
        if (u + G < 1024) MX_PREFETCH(u + G);
        unsigned long long ag0 = 0x000000003f800000ull, ag1 = 0x000000003f800000ull, ag2 = 0x000000003f800000ull, ag3 = 0x000000003f800000ull;
        if (j > 0 && fr < j) { const unsigned long long* ap = AGG + (size_t)(ck - j + fr) * 1024 + cch;
            ag0 = __hip_atomic_load(ap, __ATOMIC_RELAXED, __HIP_MEMORY_SCOPE_AGENT); ag1 = __hip_atomic_load(ap + 1, __ATOMIC_RELAXED, __HIP_MEMORY_SCOPE_AGENT);
            ag2 = __hip_atomic_load(ap + 2, __ATOMIC_RELAXED, __HIP_MEMORY_SCOPE_AGENT); ag3 = __hip_atomic_load(ap + 3, __ATOMIC_RELAXED, __HIP_MEMORY_SCOPE_AGENT); }
        {
            bf16x8 q[4];
#pragma unroll
            for (int ks = 0; ks < 4; ++ks) q[ks] = *(const LAS bf16x8*)(lds + MY_VT + (16 * wave + fr) * 256 + (((ks * 4 + grp) ^ fr) << 4));
#pragma unroll
            for (int mt = 0; mt < 8; ++mt) { f32x4 Sx = {0.f, 0.f, 0.f, 0.f};
#pragma unroll
                for (int ks = 0; ks <= mt / 2; ++ks) { const bf16x8 p = *(const LAS bf16x8*)(lds + MY_WS + (mt * 16 + fr) * 256 + (((ks * 4 + grp) ^ fr) << 4));
                    Sx = __builtin_amdgcn_mfma_f32_16x16x32_bf16(q[ks], p, Sx, 0, 0, 0); }
                *(LAS u32x2*)(lds + MY_SP + (mt * 16 + fr) * RS + (16 * wave + 4 * grp) * 2) = (u32x2){cvt_pk_bf16_cv(Sx[0], Sx[1]), cvt_pk_bf16_cv(Sx[2], Sx[3])}; }
        }
        {
            f32x4 hc0 = {0.f, 0.f, 0.f, 0.f};
            if (j > 0) {
                f32x4 lp, lh; unsigned spin = 0;
                for (;;) {
                    lp[0] = __uint_as_float((unsigned)ag0); lh[0] = __uint_as_float((unsigned)(ag0 >> 32)); lp[1] = __uint_as_float((unsigned)ag1); lh[1] = __uint_as_float((unsigned)(ag1 >> 32));
                    lp[2] = __uint_as_float((unsigned)ag2); lh[2] = __uint_as_float((unsigned)(ag2 >> 32)); lp[3] = __uint_as_float((unsigned)ag3); lh[3] = __uint_as_float((unsigned)(ag3 >> 32));
                    const bool ok = (lp[0] != 0.f) && (lp[1] != 0.f) && (lp[2] != 0.f) && (lp[3] != 0.f);
                    if (__all(ok)) break;
                    if (++spin > (1u << 22)) break;
                    __builtin_amdgcn_s_sleep(1);
                    if (fr < j) { const unsigned long long* ap = AGG + (size_t)(ck - j + fr) * 1024 + cch;
                        ag0 = __hip_atomic_load(ap, __ATOMIC_RELAXED, __HIP_MEMORY_SCOPE_AGENT); ag1 = __hip_atomic_load(ap + 1, __ATOMIC_RELAXED, __HIP_MEMORY_SCOPE_AGENT);
                        ag2 = __hip_atomic_load(ap + 2, __ATOMIC_RELAXED, __HIP_MEMORY_SCOPE_AGENT); ag3 = __hip_atomic_load(ap + 3, __ATOMIC_RELAXED, __HIP_MEMORY_SCOPE_AGENT); } }
                scan16x4(lp, lh);
#pragma unroll
                for (int r = 0; r < 4; ++r) hc0[r] = __shfl(lh[r], (lane & 48) | 15);
            }
            f32x4 s = hc0;
#pragma unroll
            for (int mt = 0; mt < 8; ++mt) { f32x4 hb;
#pragma unroll
                for (int r = 0; r < 4; ++r) hb[r] = __shfl(s[r], (lane & 48) | 15);
                s = R[mt] * s + I[mt];
                const f32x4 hv = I[mt] + R[mt] * hb;
                *(LAS u32x2*)(lds + MY_XA + (mt * 16 + fr) * RS + (16 * wave + 4 * grp) * 2) = (u32x2){cvt_pk_bf16(hv[0], hv[1]), cvt_pk_bf16(hv[2], hv[3])}; }
        }
        u32x4 ga[4], ub[4]; float bsr[4]; f32x4 nq0 = {0.f, 0.f, 0.f, 0.f}, nq1 = {0.f, 0.f, 0.f, 0.f};
        if (u + G < 1024) MX_STATS_LOAD(u + G, nq0, nq1);
#pragma unroll
        for (int it = 0; it < 4; ++it) { const int idx = it * 512 + tid, row = idx >> 4, ch = idx & 15; const unsigned o = ((unsigned)(t0 + row) * D + c0 + ch * 8) * 2u; ga[it] = *(const u32x4*)((const char*)GA + o); ub[it] = *(const u32x4*)((const char*)UB + o); bsr[it] = in[14][g * 128 + row]; }
        __syncthreads();
#pragma unroll
        for (int it = 0; it < 4; ++it) { const int idx = it * 512 + tid, row = idx >> 4, ch = idx & 15;
            f32x4 g0, g1, u0, u1, h0, h1, s0, s1; unpack8(ga[it], g0, g1); unpack8(ub[it], u0, u1);
            unpack8(*(const LAS u32x4*)(lds + MY_XA + row * RS + ch * 16), h0, h1); unpack8(*(const LAS u32x4*)(lds + MY_SP + row * RS + ch * 16), s0, s1);
            store16_sc1((char*)MG + ((unsigned)(t0 + row) * D + c0 + ch * 8) * 2u, pack8(g0 * h0 + u0 * (s0 + bsr[it]), g1 * h1 + u1 * (s1 + bsr[it]))); }
        if (u + G < 1024) MX_STATS_WRITE(nq0, nq1);
        asm volatile("s_waitcnt vmcnt(0)" ::: "memory");
        if (lane == 0) __hip_atomic_fetch_add(mixc + 64 * (ck >> 1), 1u, __ATOMIC_RELAXED, __HIP_MEMORY_SCOPE_AGENT);
        __syncthreads();
    }
#undef MX_PREFETCH
#undef MX_STATS_LOAD
#undef MX_STATS_WRITE
#undef MX_ZR
#undef MX_SETZR
}

__device__ __forceinline__ void build_moe_units(LAS int* tab1, LAS int* tab2, LAS int* tab3, const int* CNT, int vcu, int G, int wave, LAS int* flags) {
    const int tid = wave * 64 + pg8::lane_id();
    int NT = 0, my_e = 0, my_tile = 0, my_cnt = 0, my_rt = 0;
    for (int e = 0; e < 32; ++e) { const int cnt = CNT[e]; const int ntl = (cnt + 255) >> 8;
        if (tid >= NT && tid < NT + ntl) { my_e = e; my_tile = tid - NT; my_cnt = cnt; my_rt = tid; }
        NT += ntl; }
    const bool have = tid < NT;
    const bool heavy = have && (my_cnt - my_tile * 256) > 128;
    flags[tid] = heavy ? 1 : 0;
    __syncthreads();
    int hb = 0, NH = 0;
    for (int i = 0; i < NT; ++i) { const int f = flags[i]; NH += f; hb += (i < tid) ? f : 0; }
    const int slot = heavy ? hb : NH + (tid - hb);
    const int U1 = 2 * NT, U2 = 4 * NT; int nlate = (U1 > G && U1 < 2 * G) ? U1 - G : 0; if (G - nlate < 64) nlate = 0;
    const int Ge = G - nlate, c2 = vcu - nlate, ssplit = nlate ? G / 2 : NT, Lsplit = 4 * ssplit;
    const int n1 = vcu < U1 ? (U1 - 1 - vcu) / G + 1 : 0;
    const int tot2 = (c2 >= 0 && c2 < U2) ? (U2 - 1 - c2) / Ge + 1 : 0;
    int n2 = (c2 >= 0 && c2 < Lsplit) ? (Lsplit - 1 - c2) / Ge + 1 : 0; n2 = n2 < tot2 ? n2 : tot2;
    const int n3 = tot2 - n2;
    if (tid == 0) { tab1[0] = n1 < 12 ? n1 : 12; tab2[0] = n2 < 12 ? n2 : 12; tab3[0] = n3 < 12 ? n3 : 12; }
    if (have) {
#pragma unroll
        for (int q = 0; q < 2; ++q) { const int L = 2 * slot + q; if (L % G == vcu && L / G < 12) { LAS int* p = tab1 + 4 + 8 * (L / G); p[0] = my_rt; p[1] = my_e * 2 + q; p[2] = my_e; p[3] = my_tile; p[4] = my_cnt; } }
        if (c2 >= 0) {
#pragma unroll
            for (int q = 0; q < 4; ++q) { const int L2 = 4 * slot + q; if (L2 % Ge == c2) { const int k = L2 / Ge; const bool early = slot < ssplit; const int idx = early ? k : k - n2;
                if (idx >= 0 && idx < 12) { LAS int* p = (early ? tab2 : tab3) + 4 + 8 * idx; p[0] = my_rt; p[1] = my_e * 4 + q; p[2] = my_e; p[3] = my_tile; p[4] = my_cnt; } } }
        }
    }
    __syncthreads();
}
__device__ __forceinline__ void moe_wait_tiles(const LAS int* tab, unsigned* dcnt, int wave) {
    if (wave == 0) {
        const int n = __builtin_amdgcn_readfirstlane(tab[0]);
        for (int i = 0; i < n; ++i) { const int rt = __builtin_amdgcn_readfirstlane(tab[4 + 8 * i]); unsigned sp = 0;
            while ((unsigned)__builtin_amdgcn_readfirstlane(__hip_atomic_load(dcnt + 64 * rt, __ATOMIC_RELAXED, __HIP_MEMORY_SCOPE_AGENT)) < 16u) { if (++sp > (1u << 22)) break; __builtin_amdgcn_s_sleep(2); } }
        __builtin_amdgcn_fence(__ATOMIC_ACQUIRE, "agent");
        asm volatile("s_waitcnt vmcnt(0)" ::: "memory");
    }
    __syncthreads();
}

struct Args { const float* in[28]; float* out; unsigned char* ws; int ph_lo, ph_hi, li, pad; };

__global__ void __launch_bounds__(NWAVES * 64, 2) mega_fwd(Args args) {
    extern __shared__ __attribute__((aligned(16))) unsigned char lds_raw[];
    LAS unsigned char* lds = (LAS unsigned char*)lds_raw;
    volatile LAS unsigned* MISC = (volatile LAS unsigned*)(lds + MISC_OFF);
    const int tid0 = threadIdx.x, wave = __builtin_amdgcn_readfirstlane(tid0 >> 6);
#define PHASE_IDS() int lane = pg8::lane_id(); asm volatile("" : "+v"(lane)); const int tid = wave * 64 + lane; (void)tid
    const int G = gridDim.x;
    const int vcu = (G % 8 == 0) ? ((int)blockIdx.x % 8) * (G / 8) + (int)blockIdx.x / 8 : (int)blockIdx.x;
    unsigned char* ws = args.ws;
    unsigned* ctl = (unsigned*)(ws + WS_CTL);
    for (int u = tid0; u < (LDS_BYTES - LDSCTL_OFF) / 4; u += NWAVES * 64) ((LAS unsigned*)(lds + LDSCTL_OFF))[u] = 0u;
    __syncthreads();
    XcdBarrier bar = xcd_barrier_post(ctl + CW_BAR + args.li * XCD_BAR_WORDS, MISC + 8, wave);
    const int lo = args.ph_lo, hi = args.ph_hi;
#define IN(k) (lo <= (k) && (k) < hi)
#define BOTH(k) (IN(k) && IN((k) + 1))
    const float* const* in = args.in;
    bf16 *XN = (bf16*)(ws + WS_A0), *MG = (bf16*)args.out, *X2b = (bf16*)(ws + WS_A0);
    float *RSTD0 = (float*)(ws + WS_RSTD0), *GINV = (float*)(ws + WS_GINV);
    bf16 *Zl = (bf16*)(ws + WS_A1), *X1b = (bf16*)args.out + (size_t)T * D;
    bf16 *GA = (bf16*)(ws + WS_A2), *UB = (bf16*)(ws + WS_A3), *V = (bf16*)(ws + WS_A4);
    bf16 *X3 = (bf16*)(ws + WS_A1);
    bf16 *PU = (bf16*)(ws + WS_A2);
    bf16 *Pb = (bf16*)(ws + WS_PB);
    bf16 *WinT = (bf16*)(ws + WS_WIN), *WoutT = (bf16*)(ws + WS_WOUT), *WgT = (bf16*)(ws + WS_WG), *W13T = (bf16*)(ws + WS_W13), *W2T = (bf16*)(ws + WS_W2), *WupT = (bf16*)(ws + WS_WUP);
    float *VPART = (float*)(ws + WS_VPART), *SS1 = (float*)(ws + WS_SS1), *SS3 = (float*)(ws + WS_SS3), *RSTD2 = (float*)(ws + WS_RSTD2), *RSTD1 = (float*)(ws + WS_RSTD1), *LISTG = (float*)(ws + WS_LISTG), *LISTR = (float*)(ws + WS_LISTR);
    int *CNT = (int*)(ws + WS_CTL), *LIST = (int*)(ws + WS_LIST), *TOKE = (int*)(ws + WS_TOKE);
    bf16 *Hb = (bf16*)(ws + WS_A2), *Yb = (bf16*)(ws + WS_A3), *WrT = (bf16*)(ws + WS_WR), *WLRU = (bf16*)(ws + WS_WLRU), *WSGU = (bf16*)(ws + WS_WSGU);
    unsigned long long* AGGQ = (unsigned long long*)(ws + WS_AGG); float* SPL8 = (float*)(ws + WS_SPL8);

    if (IN(0)) {
        PHASE_IDS();
        LAS float* scr = (LAS float*)(lds + wave * 16384);
        const bool tab_fast = (G * 512 == 131072);
        float tf_lru = 0.f, tf_sgu = 0.f, tf10 = 0.f, tf2 = 1.f, tfr = 0.f;
        if (tab_fast) {
            const int i = vcu * 512 + tid, gate = i >> 16, h = (i >> 12) & 15, j = (i >> 6) & 63, ii = i & 63;
            const float f_lru = (gate ? in[8] : in[6])[(h * 64 + ii) * 64 + j], f_sgu = in[13][i];
            const int i10 = i < 1024 ? i : 0; const float f10 = in[10][i10], f2 = in[2][i10];
            const int n = (i >> 10) & 63, k = i & 1023; const float fa = in[17][k * 4 + (n < 4 ? n : 0)], fb = in[19][k * 32 + ((n >= 4 && n < 36) ? n - 4 : 0)], fk = in[16][k];
            tf_lru = f_lru; tf_sgu = f_sgu; tf10 = f10; tf2 = f2; tfr = n < 4 ? fa * fk : (n < 36 ? fb * fk : 0.f);
        }
        const int gw = vcu * NWAVES + wave, NGW = G * NWAVES;
        for (int it = gw; it < 16 * 192; it += NGW) { const int kb = it / 192, nb = it % 192; p0_transpose_item(in[3], 6144, kb * 64, nb * 32, WinT, 1024, win_dest_row(nb * 32), nullptr, scr, lane); }
        if (tab_fast) { const int i = vcu * 512 + tid, t = (i >> 7) & 127, s_ = i & 127;
            WLRU[i] = f2bf(tf_lru); WSGU[i] = s_ <= t ? f2bf(tf_sgu) : (bf16)0;
            if (i < 1024) { SPL8[i] = -8.f * log1pf(expf(-tf10)); GINV[i] = 1.f / tf2; }
            if (i < 64 * 1024) WrT[i] = f2bf(tfr); }
        for (int m = gw; m < T; m += 2 * NGW) {
            const int m2 = m + NGW < T ? m + NGW : m;
            const pg8::f32x4* xr = (const pg8::f32x4*)(in[0] + (size_t)m * D) + lane; const pg8::f32x4* xr2 = (const pg8::f32x4*)(in[0] + (size_t)m2 * D) + lane; const pg8::f32x4* gr = (const pg8::f32x4*)in[2] + lane;
            pg8::f32x4 v[4], w[4]; float s = 0.f, s2 = 0.f;
#pragma unroll
            for (int j = 0; j < 4; ++j) { v[j] = __builtin_nontemporal_load(xr + 64 * j); w[j] = __builtin_nontemporal_load(xr2 + 64 * j); }
#pragma unroll
            for (int j = 0; j < 4; ++j) { s += (v[j].x * v[j].x + v[j].y * v[j].y) + (v[j].z * v[j].z + v[j].w * v[j].w); s2 += (w[j].x * w[j].x + w[j].y * w[j].y) + (w[j].z * w[j].z + w[j].w * w[j].w); }
            const float rstd = rsqrtf(wave_sum(s) * (1.f / D) + EPS), rstd2 = rsqrtf(wave_sum(s2) * (1.f / D) + EPS);
            if (lane == 0) { RSTD0[m] = 1.f / rstd; RSTD0[m2] = 1.f / rstd2; }
            unsigned long long* o8 = (unsigned long long*)(XN + (size_t)m * D) + lane; unsigned long long* o82 = (unsigned long long*)(XN + (size_t)m2 * D) + lane;
#pragma unroll
            for (int j = 0; j < 4; ++j) { const pg8::f32x4 gg = gr[64 * j];
                o8[64 * j] = (unsigned long long)pk2(v[j].x * rstd * gg.x, v[j].y * rstd * gg.y) | ((unsigned long long)pk2(v[j].z * rstd * gg.z, v[j].w * rstd * gg.w) << 32);
                o82[64 * j] = (unsigned long long)pk2(w[j].x * rstd2 * gg.x, w[j].y * rstd2 * gg.y) | ((unsigned long long)pk2(w[j].z * rstd2 * gg.z, w[j].w * rstd2 * gg.w) << 32); }
        }
        if (!tab_fast) {
        for (int i = vcu * 512 + tid; i < 2 * 16 * 64 * 64; i += G * 512) { const int gate = i >> 16, h = (i >> 12) & 15, j = (i >> 6) & 63, ii = i & 63;
            WLRU[i] = f2bf(in[gate ? 8 : 6][(h * 64 + ii) * 64 + j]); }
        for (int i = vcu * 512 + tid; i < 8 * 128 * 128; i += G * 512) { const int t = (i >> 7) & 127, s = i & 127; WSGU[i] = s <= t ? f2bf(in[13][i]) : (bf16)0; }
        for (int i = vcu * 512 + tid; i < 1024; i += G * 512) { SPL8[i] = -8.f * log1pf(expf(-in[10][i])); GINV[i] = 1.f / in[2][i]; }
        for (int i = vcu * 512 + tid; i < 64 * 1024; i += G * 512) { const int n = i >> 10, k = i & 1023; float v = 0.f;
            if (n < 4) v = in[17][k * 4 + n] * in[16][k]; else if (n < 36) v = in[19][k * 32 + (n - 4)] * in[16][k];
            WrT[i] = f2bf(v); }
        }
        if (BOTH(0)) xcd_barrier(bar);
    }
    if (IN(1)) {
        { pg8::Gemm g{XN, WinT, 1024}; Gemm1Order S; S.init(T, 6144, G, (int)blockIdx.x);
          S.wave = wave; { const int upw = (64 * 24) / G > 0 ? (64 * 24) / G : 1; S.gi = (int)blockIdx.x % upw; } S.w = DefW{args.in, ws};
          pg8::Epi1 E{Zl, GA, UB, V, VPART};
          pg8::gemm_phase<pg8::Epi1, Gemm1Order, true, true, false>(lds, g, S, E, wave); }
        if (BOTH(1)) xcd_barrier(bar);
    }

    if (IN(3)) {
        PHASE_IDS();
        mixer_phase(lds, vcu, G, tid, lane, wave, Zl, GA, UB, V, VPART, AGGQ, MG, ctl + CW_MIX, WLRU, WSGU, SPL8, in);
    }
    if (IN(4)) {
        pg8::Gemm g{MG, WoutT, 1024}; pg8::StaticOrder S; S.init(T, 1024, G, (int)blockIdx.x);
        pg8::Epi2 E{XN, RSTD0, GINV, X1b, SS1};
        if (BOTH(3)) {
            if (wave == 0) { pg8::Unit u0;
                for (int i = 0; S.next(i, u0); ++i) { unsigned sp = 0;
                    while ((unsigned)__builtin_amdgcn_readfirstlane(__hip_atomic_load(ctl + CW_MIX + 64 * u0.pm, __ATOMIC_RELAXED, __HIP_MEMORY_SCOPE_AGENT)) < 128u) { if (++sp > (1u << 22)) break; __builtin_amdgcn_s_sleep(2); } }
                __builtin_amdgcn_fence(__ATOMIC_ACQUIRE, "agent");
                asm volatile("s_waitcnt vmcnt(0)" ::: "memory"); }
            __syncthreads();
        }
        pg8::gemm_phase<pg8::Epi2, pg8::StaticOrder, true, true, false>(lds, g, S, E, wave);
        if (BOTH(4)) xcd_barrier(bar);
    }

    if (IN(5)) {
        PHASE_IDS();
        constexpr int LS = 52;
        LAS float* sP = (LAS float*)lds;
        LAS float* sL = (LAS float*)(lds + 8 * 64 * LS * 4);
        LAS int* sCnt = (LAS int*)(lds + 9 * 64 * LS * 4); LAS int* sBase = sCnt + 32;
        const int fr = lane & 15, grp = lane >> 4;
        for (int tile = vcu; tile < T / 64; tile += G) {
            const int tok0 = tile * 64;
            if (tid < 32) sCnt[tid] = 0;
            pg8::bf16x8 a[4][4], b[3][4];
#pragma unroll
            for (int mt = 0; mt < 4; ++mt)
#pragma unroll
                for (int ks = 0; ks < 4; ++ks) a[mt][ks] = *(const pg8::bf16x8*)(X1b + (size_t)(tok0 + 16 * mt + fr) * D + wave * 128 + ks * 32 + 8 * grp);
#pragma unroll
            for (int nt = 0; nt < 3; ++nt)
#pragma unroll
                for (int ks = 0; ks < 4; ++ks) b[nt][ks] = *(const pg8::bf16x8*)(WrT + (size_t)(16 * nt + fr) * D + wave * 128 + ks * 32 + 8 * grp);
            pg8::f32x4 q0 = {0.f, 0.f, 0.f, 0.f}, q1 = q0, q2 = q0, q3 = q0;
            if (tid < 64) { const float* sp = SS1 + (size_t)(tok0 + tid) * 16; q0 = *(const pg8::f32x4*)sp; q1 = *(const pg8::f32x4*)(sp + 4); q2 = *(const pg8::f32x4*)(sp + 8); q3 = *(const pg8::f32x4*)(sp + 12); }
#pragma unroll
            for (int mt = 0; mt < 4; ++mt)
#pragma unroll
                for (int nt = 0; nt < 3; ++nt) { pg8::f32x4 acc = {0.f, 0.f, 0.f, 0.f};
#pragma unroll
                    for (int ks = 0; ks < 4; ++ks) acc = __builtin_amdgcn_mfma_f32_16x16x32_bf16(a[mt][ks], b[nt][ks], acc, 0, 0, 0);
#pragma unroll
                    for (int r = 0; r < 4; ++r) sP[(wave * 64 + 16 * mt + 4 * grp + r) * LS + 16 * nt + fr] = acc[r]; }
            __syncthreads();
            { const int tk = tid >> 3, c0 = (tid & 7) * 6;
#pragma unroll
              for (int c = 0; c < 6; ++c) { float sum = 0.f;
#pragma unroll
                  for (int w = 0; w < 8; ++w) sum += sP[(w * 64 + tk) * LS + c0 + c];
                  sL[tk * LS + c0 + c] = sum; } }
            __syncthreads();
            int e1 = 0, e2 = 0, r1 = 0, r2 = 0; float g1 = 0.f, g2 = 0.f, rstd = 0.f;
            if (tid < 64) {
                const int t = tok0 + tid;
                const pg8::f32x4 qs = (q0 + q1) + (q2 + q3);
                const float ss = (qs[0] + qs[1]) + (qs[2] + qs[3]);
                rstd = rsqrtf(ss * (1.f / D) + EPS);
                const LAS float* l = sL + tid * LS;
                float gl[4];
#pragma unroll
                for (int q = 0; q < 4; ++q) gl[q] = rstd * l[q] + in[18][q];
                float mx = gl[0]; int gi = 0;
#pragma unroll
                for (int q = 1; q < 4; ++q) if (gl[q] > mx) { mx = gl[q]; gi = q; }
                float den = 0.f;
#pragma unroll
                for (int q = 0; q < 4; ++q) den += expf(gl[q] - mx);
                const float gtop = 1.f / den;
                float m1 = -3.0e38f, m2 = -3.0e38f; int i1 = 0, i2 = 0;
                for (int j = 0; j < 8; ++j) { const float v = rstd * l[4 + gi * 8 + j] + in[20][gi * 8 + j];
                    if (v > m1) { m2 = m1; i2 = i1; m1 = v; i1 = j; } else if (v > m2) { m2 = v; i2 = j; } }
                const float p2 = expf(m2 - m1);
                g1 = gtop / (1.f + p2); g2 = gtop * p2 / (1.f + p2);
                e1 = gi * 8 + i1; e2 = gi * 8 + i2;
                r1 = __hip_atomic_fetch_add(&sCnt[e1], 1, __ATOMIC_RELAXED, __HIP_MEMORY_SCOPE_WORKGROUP); r2 = __hip_atomic_fetch_add(&sCnt[e2], 1, __ATOMIC_RELAXED, __HIP_MEMORY_SCOPE_WORKGROUP);
            }
            __syncthreads();
            if (tid < 32) { const int c = sCnt[tid]; sBase[tid] = c ? atomicAdd(&CNT[tid], c) : 0; }
            __syncthreads();
            if (tid < 64) { const int t = tok0 + tid, p1 = e1 * 16384 + sBase[e1] + r1, p2 = e2 * 16384 + sBase[e2] + r2;
                LIST[p1] = t * 2; LIST[p2] = t * 2 + 1; LISTG[p1] = g1; LISTG[p2] = g2; LISTR[p1] = rstd; LISTR[p2] = rstd; }
            __syncthreads();
        }
        if (BOTH(5)) xcd_barrier(bar);
    }
    if (IN(6)) {
        LAS int* tab1 = (LAS int*)(lds + TAB_OFF); LAS int* tab2 = (LAS int*)(lds + TAB_OFF + 512); LAS int* tab3 = (LAS int*)(lds + TAB_OFF + 1024);
        build_moe_units(tab1, tab2, tab3, CNT, vcu, G, wave, (LAS int*)lds);
        unsigned* dcnt = ctl + CW_DONE1;
        { pg8::Gemm g{X1b, W13T, 1024}; pg8::MoeOrder<1> S{tab1, LIST, dcnt};
          pg8::EpiMoe1 E{Hb, LISTR};
          pg8::gemm_phase<pg8::EpiMoe1, pg8::MoeOrder<1>, true, true, true>(lds, g, S, E, wave); }
        pg8::Gemm g2{Hb, W2T, 256}; pg8::EpiMoe2 E2{Yb, LIST, LISTG};
        moe_wait_tiles(tab2, dcnt, wave);
        { pg8::MoeOrder<0> S{tab2, LIST, dcnt}; pg8::gemm_phase<pg8::EpiMoe2, pg8::MoeOrder<0>, true, true, false>(lds, g2, S, E2, wave); }
        moe_wait_tiles(tab3, dcnt, wave);
        { pg8::MoeOrder<0> S{tab3, LIST, dcnt}; pg8::gemm_phase<pg8::EpiMoe2, pg8::MoeOrder<0>, true, true, false>(lds, g2, S, E2, wave); }
        if (BOTH(6)) xcd_barrier(bar);
    }
    if (IN(8)) {
        const bool split = (G % 16 == 0);
        const int q8 = (int)blockIdx.x >> 3, x8 = (int)blockIdx.x & 7;
        const bool do_gemm = !split || (q8 & 1), do_comb = !split || !(q8 & 1);
        if (do_comb) {
            PHASE_IDS();
            const int NGW = (split ? G / 2 : G) * NWAVES, gw = (split ? (q8 >> 1) * 8 + x8 : vcu) * NWAVES + wave;
            for (int row = gw; row < T; row += 2 * NGW) {
                const int row2 = row + NGW; const bool two = row2 < T; const int rb = two ? row2 : row;
                pg8::u32x4 la[2][2], lb[2][2], lc[2][2];
#pragma unroll
                for (int rr = 0; rr < 2; ++rr)
#pragma unroll
                    for (int hh = 0; hh < 2; ++hh) { const int r = rr ? rb : row;
                        la[rr][hh] = __builtin_nontemporal_load((const pg8::u32x4*)(X1b + (size_t)r * D + hh * 512 + lane * 8));
                        lb[rr][hh] = __builtin_nontemporal_load((const pg8::u32x4*)(Yb + (size_t)r * 2 * D + hh * 512 + lane * 8));
                        lc[rr][hh] = __builtin_nontemporal_load((const pg8::u32x4*)(Yb + ((size_t)r * 2 + 1) * D + hh * 512 + lane * 8)); }
#pragma unroll
                for (int rr = 0; rr < 2; ++rr) { const int r = rr ? rb : row; float ss = 0.f;
#pragma unroll
                    for (int hh = 0; hh < 2; ++hh) { pg8::f32x4 a0, a1, b0, b1, c0, c1; pg8::unpack8(la[rr][hh], a0, a1); pg8::unpack8(lb[rr][hh], b0, b1); pg8::unpack8(lc[rr][hh], c0, c1);
                        a0 = a0 + b0 + c0; a1 = a1 + b1 + c1;
                        ss += pg8::hsum4(a0 * a0 + a1 * a1);
                        if (rr == 0 || two) *(pg8::u32x4*)(X2b + (size_t)r * D + hh * 512 + lane * 8) = pg8::pack8(a0, a1); }
                    ss = wave_sum(ss);
                    if (lane == 0 && (rr == 0 || two)) RSTD2[r] = rsqrtf(ss * (1.f / D) + EPS); }
            }
        }
        if (do_gemm) {
            pg8::Gemm g{Pb, WupT, 256}; pg8::StaticOrder S; S.init(T, 1024, split ? G / 2 : G, split ? (q8 >> 1) * 8 + x8 : (int)blockIdx.x);
            pg8::EpiPlain E{PU};
            pg8::gemm_phase<pg8::EpiPlain, pg8::StaticOrder, true, true, false>(lds, g, S, E, wave);
        }
        if (BOTH(8)) xcd_barrier(bar);
    }
    const bool fuse_final = (G == 256);
    if (IN(9)) {
        pg8::Gemm g{X2b, WgT, 1024}; pg8::StaticOrder S; S.init(T, 1024, G, (int)blockIdx.x);
        if (fuse_final) {
            pg8::EpiPleFinal E{X2b, PU, RSTD2, in[27], args.out, (float*)(ws + WS_XCH), ctl + CW_PANEL, (LAS float*)(lds + RING_BYTES), wave};
            pg8::gemm_phase<pg8::EpiPleFinal, pg8::StaticOrder, true, true, false>(lds, g, S, E, wave);
        } else {
            pg8::EpiPle E{X2b, PU, RSTD2, X3, SS3};
            pg8::gemm_phase<pg8::EpiPle, pg8::StaticOrder, true, true, false>(lds, g, S, E, wave);
            if (BOTH(9)) xcd_barrier(bar);
        }
    }

    if (IN(10) && !fuse_final) {
        PHASE_IDS();
        const int gw = vcu * NWAVES + wave, NGW = G * NWAVES;
        for (int row = gw; row < T; row += NGW) { float ss = 0.f;
            if (lane < 16) ss = SS3[(size_t)row * 16 + lane];
            ss = wave_sum(ss);
            const float rstd = rsqrtf(ss * (1.f / D) + EPS);
#pragma unroll
            for (int hh = 0; hh < 2; ++hh) { const size_t o = (size_t)row * D + hh * 512 + lane * 8; pg8::f32x4 a0, a1; pg8::unpack8(*(const pg8::u32x4*)(X3 + o), a0, a1);
                const pg8::f32x4 f0 = *(const pg8::f32x4*)(in[27] + hh * 512 + lane * 8), f1 = *(const pg8::f32x4*)(in[27] + hh * 512 + lane * 8 + 4);
                *(pg8::f32x4*)(args.out + o) = a0 * rstd * f0; *(pg8::f32x4*)(args.out + o + 4) = a1 * rstd * f1; } }
    }
#undef IN
#undef BOTH
#undef PHASE_IDS
}

static int mega_grid() {
    static int grid = 0;
    if (grid == 0) {
        int dev = 0, cus = 0;
        if (hipGetDevice(&dev) != hipSuccess || hipDeviceGetAttribute(&cus, hipDeviceAttributeMultiprocessorCount, dev) != hipSuccess) { fprintf(stderr, "mega: device query failed\n"); grid = -1; return grid; }
        if (hipFuncSetAttribute((const void*)mega_fwd, hipFuncAttributeMaxDynamicSharedMemorySize, LDS_BYTES) != hipSuccess) { fprintf(stderr, "mega: hipFuncSetAttribute failed\n"); grid = -1; return grid; }
        (void)hipGetLastError();
        grid = cus;
    }
    return grid;
}
static void launch_mega(void* const* d_in, void* d_out, void* d_ws, int lo, int hi, int li, hipStream_t stream) {
    const int grid = mega_grid(); if (grid <= 0) return;
    Args a{};
    for (int i = 0; i < 28; ++i) a.in[i] = (const float*)d_in[i];
    a.out = (float*)d_out; a.ws = (unsigned char*)d_ws; a.ph_lo = lo; a.ph_hi = hi; a.li = li; a.pad = 0;
    hipLaunchKernelGGL(mega_fwd, dim3(grid), dim3(NWAVES * 64), LDS_BYTES, stream, a);
}

extern "C" void kernel_launch(void* const* d_in, const int* in_sizes, int n_in, void* d_out, int out_size, void* d_ws, size_t ws_size, hipStream_t stream) {
    if (n_in != 28 || in_sizes[0] != T * D || out_size != T * D || ws_size < WS_MEGA_END) { fprintf(stderr, "kernel_launch: unexpected shapes (n_in %d, ws %zu)\n", n_in, ws_size); return; }
    (void)hipMemsetAsync(d_ws, 0, 2 * MiB, stream);
    launch_mega(d_in, d_out, d_ws, 0, 11, 0, stream);
}
```

```cpp
#include <hip/hip_runtime.h>
#include <stdint.h>
#include <cstdio>

typedef unsigned short bf16;
constexpr int T = 16384, D = 1024, SEQ = 2048;
constexpr float EPS = 1e-6f;
constexpr size_t MiB = 1u << 20;
constexpr size_t WS_CTL = 0;
constexpr size_t WS_VPART = 2 * MiB;
constexpr size_t WS_SS1 = 4 * MiB;
constexpr size_t WS_SS3 = 5 * MiB;
constexpr size_t WS_AGG = 1 * MiB;
constexpr size_t WS_LIST = 6 * MiB;
constexpr size_t WS_TOKE = 8 * MiB;
constexpr size_t WS_TOKG = 8 * MiB + 128 * 1024;
constexpr size_t WS_RSTD2 = 8 * MiB + 256 * 1024;
constexpr size_t WS_A0 = 74 * MiB;
constexpr size_t WS_A1 = 106 * MiB;
constexpr size_t WS_A2 = 138 * MiB;
constexpr size_t WS_A3 = 170 * MiB;
constexpr size_t WS_A4 = 202 * MiB;
constexpr size_t WS_END = 234 * MiB;

__device__ __forceinline__ float bf2f(bf16 b) { return __uint_as_float(((unsigned)b) << 16); }
__device__ __forceinline__ bf16 f2bf(float f) { unsigned u = __float_as_uint(f); u += 0x7fffu + ((u >> 16) & 1u); return (bf16)(u >> 16); }
__device__ __forceinline__ float sigm(float x) { return 1.f / (1.f + expf(-x)); }
__device__ __forceinline__ float gelu_t(float x) { const float u = 0.7978845608028654f * (x + 0.044715f * x * x * x); return 0.5f * x * (1.f + tanhf(u)); }
__device__ __forceinline__ float wave_sum(float v) {
#pragma unroll
    for (int o = 1; o < 64; o <<= 1) v += __shfl_xor(v, o);
    return v;
}

#define LAS __attribute__((address_space(3)))
#define GAS __attribute__((address_space(1)))
namespace pg8 {
typedef short bf16x8 __attribute__((ext_vector_type(8)));
typedef float f32x4 __attribute__((ext_vector_type(4)));
typedef float f32x2 __attribute__((ext_vector_type(2)));
typedef unsigned u32x4 __attribute__((ext_vector_type(4)));
typedef unsigned u32x2 __attribute__((ext_vector_type(2)));
typedef int i32x4 __attribute__((ext_vector_type(4)));
typedef int i32x8 __attribute__((ext_vector_type(8)));
constexpr int BM = 256, BK = 64, HALF = 128, HTB = HALF * BK * 2, STAGE_BYTES = 8 * HTB, NXCD = 8, WGM = 8;

__host__ __device__ __forceinline__ int lds_byte(int r, int c) { const int st = (r >> 4) * 2 + (c >> 5), rr = r & 15, cc = c & 31, ob = rr * 64 + cc * 2; return st * 1024 + (ob ^ (((ob >> 9) & 1) << 5)); }
__host__ __device__ __forceinline__ void stage_rc(int b, int& R, int& C) { const int st = b / 1024, sb = b % 1024, swz = sb ^ (((sb >> 9) & 1) << 5); R = (st >> 1) * 16 + swz / 64; C = (st & 1) * 32 + (swz % 64) / 2; }
__host__ __device__ __forceinline__ int perm32(int rho) { const int n = rho >> 4, i = rho & 15; return 8 * (i >> 2) + 4 * n + (i & 3); }

__device__ __forceinline__ int lane_id() { int l; asm volatile("v_mbcnt_lo_u32_b32 %0, -1, 0\n\tv_mbcnt_hi_u32_b32 %0, -1, %0" : "=v"(l)); return l; }
struct Unit { int pm, pn, e, tile, cnt; };
struct Gemm { const bf16* A; const bf16* Bt; int K; };

struct StaticOrder {
    int nM, nN, nwg, G, c;
    __device__ void init(int M, int N, int G_, int c_) { nM = M / BM; nN = N / BM; nwg = nM * nN; G = G_; c = c_; }
    __device__ bool next(int i, Unit& u) const {
        const long L = (long)i * G + c; if (L >= nwg) return false;
        int wgid = (int)L; { const int q = nwg / NXCD, r = nwg % NXCD, xcd = wgid % NXCD, off = wgid / NXCD; wgid = (xcd < r ? xcd * (q + 1) : r * (q + 1) + (xcd - r) * q) + off; }
        const int nig = WGM * nN, gid = wgid / nig, fm = gid * WGM, gsz = (nM - fm) < WGM ? (nM - fm) : WGM;
        u.pm = fm + ((wgid % nig) % gsz); u.pn = (wgid % nig) / gsz; u.e = 0; u.tile = 0; u.cnt = 0; return true;
    }
    __device__ __forceinline__ unsigned row_off(const Unit&, int) const { return 0u; }
    __device__ __forceinline__ void a_ready(const Unit&) const {}
    __device__ __forceinline__ void done(const Unit&) const {}
    struct Pre {}; __device__ __forceinline__ void pre(int, Pre&) const {}
    __device__ __forceinline__ void post(int, Pre&) const {}
    __device__ __forceinline__ bool half(const Unit&) const { return false; }
};

__device__ __forceinline__ unsigned cvt_pk_bf16(float lo, float hi) { unsigned r; asm volatile("v_cvt_pk_bf16_f32 %0, %1, %2" : "=v"(r) : "v"(lo), "v"(hi)); return r; }
typedef __bf16 bf16x2_t __attribute__((ext_vector_type(2)));
__device__ __forceinline__ unsigned cvt_pk_bf16_cv(float lo, float hi) { const f32x2 v = {lo, hi}; const bf16x2_t b = __builtin_convertvector(v, bf16x2_t); return __builtin_bit_cast(unsigned, b); }
__device__ __forceinline__ float fsigm(float x) { return __builtin_amdgcn_rcpf(1.0f + __builtin_amdgcn_exp2f(-1.4426950409f * x)); }
__device__ __forceinline__ float fgelu(float x) { const float u = x + 0.044715f * x * x * x; return x * __builtin_amdgcn_rcpf(1.0f + __builtin_amdgcn_exp2f(-2.3022082f * u)); }
__device__ __forceinline__ f32x4 vexp2(const f32x4 t) { f32x4 e;
#pragma unroll
    for (int i = 0; i < 4; ++i) e[i] = __builtin_amdgcn_exp2f(t[i]);
    return e; }
__device__ __forceinline__ f32x4 vrcp(const f32x4 t) { f32x4 e;
#pragma unroll
    for (int i = 0; i < 4; ++i) e[i] = __builtin_amdgcn_rcpf(t[i]);
    return e; }
__device__ __forceinline__ f32x4 vgelu_den(const f32x4 x) { return 1.f + vexp2(x * (x * x * (-0.10294324f) + (-2.3022082f))); }
__device__ __forceinline__ f32x4 vsigm_den(const f32x4 x) { return 1.f + vexp2(x * (-1.4426950409f)); }
__device__ __forceinline__ float hsum4(const f32x4 v) { return (v[0] + v[1]) + (v[2] + v[3]); }

__device__ __forceinline__ i32x8 cat8(const bf16x8 lo, const bf16x8 hi) { const i32x4 a = __builtin_bit_cast(i32x4, lo), b = __builtin_bit_cast(i32x4, hi); return __builtin_shufflevector(a, b, 0, 1, 2, 3, 4, 5, 6, 7); }
template <class Epi, class Sched, bool ALIGN_EPI, bool SP2, bool GATHER, bool FP8 = false>
__device__ __forceinline__ void gemm_phase(LAS unsigned char* lds, const Gemm g, const Sched& S, const Epi& E, const int wave_) {
    int lane = lane_id(); asm volatile("" : "+v"(lane));
    const int wid = wave_, tid = wid * 64 + lane, wr = wid >> 2, wc = wid & 3, fr = lane & 15, fq = lane >> 4;
    int K_ = g.K; if constexpr (FP8) asm volatile("" : "+s"(K_));
    const int K = K_, nt = K / BK;
    int sR[2], sC[2];
    unsigned voffB[2], vA0[2], vA1[2], nvA0[2], nvA1[2];
#pragma unroll
    for (int i = 0; i < 2; ++i) { stage_rc(tid * 16 + i * 8192, sR[i], sC[i]); const int Rb = Epi::PERM ? ((sR[i] & ~31) + perm32(sR[i] & 31)) : sR[i];
        voffB[i] = (unsigned)(Rb * K + sC[i]) * 2u; vA0[i] = (unsigned)(sR[i] * K + sC[i]) * 2u; vA1[i] = vA0[i]; nvA0[i] = vA0[i]; nvA1[i] = vA0[i]; }
    const size_t kstep = (size_t)(BK * 2);
    const size_t hstep = (size_t)HALF * K * 2;
    const size_t tstep = 2 * hstep;
    const size_t ahs = GATHER ? 0 : hstep;
    const unsigned ldsw = (unsigned)wid * 1024u;
    const int aoff = lds_byte(wr * 64 + fr, fq * 8), boff = lds_byte(wc * 32 + fr, fq * 8);
#define PG8_SA(b, h) (((b) * 2 + (h)) * HTB)
#define PG8_SB(b, h) ((4 + (b) * 2 + (h)) * HTB)
#define PG8_STAGE(bufoff, gbase, voff) do { _Pragma("unroll") for (int _i = 0; _i < 2; ++_i) \
        __builtin_amdgcn_global_load_lds((const unsigned*)((const char*)(gbase) + (voff)[_i]), (LAS unsigned*)(lds + (bufoff) + ldsw + _i * 8192), 16, 0, 0); } while (0)
#define PG8_LDA(dst, b, h) do { if constexpr (FP8) { _Pragma("unroll") for (int m = 0; m < 4; ++m) dst##q[m] = cat8(*(const LAS bf16x8*)(lds + PG8_SA(b, h) + aoff + m * 2048), *(const LAS bf16x8*)(lds + PG8_SA(b, h) + aoff + m * 2048 + 1024)); } \
        else { _Pragma("unroll") for (int m = 0; m < 4; ++m) _Pragma("unroll") for (int k = 0; k < 2; ++k) dst[m][k] = *(const LAS bf16x8*)(lds + PG8_SA(b, h) + aoff + m * 2048 + k * 1024); } } while (0)
#define PG8_LDB(dst, b, h) do { if constexpr (FP8) { _Pragma("unroll") for (int n = 0; n < 2; ++n) dst##q[n] = cat8(*(const LAS bf16x8*)(lds + PG8_SB(b, h) + boff + n * 2048), *(const LAS bf16x8*)(lds + PG8_SB(b, h) + boff + n * 2048 + 1024)); } \
        else { _Pragma("unroll") for (int n = 0; n < 2; ++n) _Pragma("unroll") for (int k = 0; k < 2; ++k) dst[n][k] = *(const LAS bf16x8*)(lds + PG8_SB(b, h) + boff + n * 2048 + k * 1024); } } while (0)
#define PG8_MMA(ai, bj, At, Bt) do { __builtin_amdgcn_s_setprio(1); \
        if constexpr (FP8) { _Pragma("unroll") for (int m = 0; m < 4; ++m) _Pragma("unroll") for (int n = 0; n < 2; ++n) \
            asm volatile("v_mfma_scale_f32_16x16x128_f8f6f4 %0, %1, %2, %0, %3, %3 op_sel_hi:[0,0,0]" : "+v"(acc[ai][bj][m][n]) : "v"(Bt##q[n]), "v"(At##q[m]), "v"(mxs)); } \
        else { _Pragma("unroll") for (int m = 0; m < 4; ++m) _Pragma("unroll") for (int n = 0; n < 2; ++n) _Pragma("unroll") for (int k = 0; k < 2; ++k) \
            acc[ai][bj][m][n] = __builtin_amdgcn_mfma_f32_16x16x32_bf16(Bt[n][k], At[m][k], acc[ai][bj][m][n], 0, 0, 0); } \
        __builtin_amdgcn_s_setprio(0); } while (0)
#define PG8_WAIT_V(n) asm volatile("s_waitcnt vmcnt(" #n ")" ::: "memory")
#define PG8_WAIT_L(n) asm volatile("s_waitcnt lgkmcnt(" #n ")" ::: "memory")
#define PG8_BAR __builtin_amdgcn_s_barrier()
#define PG8_SCHED __builtin_amdgcn_sched_barrier(0)
    Unit cur, nxt; int ui = 0;
    if (!S.next(0, cur)) return;
    f32x4 acc[2][2][4][2];
#pragma unroll
    for (int a = 0; a < 2; ++a)
#pragma unroll
        for (int b = 0; b < 2; ++b)
#pragma unroll
            for (int m = 0; m < 4; ++m)
#pragma unroll
                for (int n = 0; n < 2; ++n) acc[a][b][m][n] = (f32x4){0.f, 0.f, 0.f, 0.f};
    int mxs = 0x7F7F7F7F; if constexpr (FP8) asm volatile("" : "+v"(mxs));
    bf16x8 At[4][2], B0[2][2], B1[2][2]; i32x8 Atq[4], B0q[2], B1q[2];
    const char* cA = GATHER ? (const char*)g.A : (const char*)g.A + (size_t)cur.pm * tstep; const char* cB = (const char*)g.Bt + (size_t)cur.pn * tstep;
    if constexpr (GATHER) {
#pragma unroll
        for (int i = 0; i < 2; ++i) { vA0[i] = S.row_off(cur, sR[i]) + (unsigned)sC[i] * 2u; vA1[i] = S.row_off(cur, HALF + sR[i]) + (unsigned)sC[i] * 2u; nvA0[i] = vA0[i]; nvA1[i] = vA1[i]; }
    }
    S.a_ready(cur);
    if constexpr (SP2) {
        PG8_STAGE(PG8_SB(0, 0), cB, voffB); PG8_STAGE(PG8_SB(0, 1), cB + hstep, voffB); PG8_STAGE(PG8_SA(0, 0), cA, vA0); PG8_STAGE(PG8_SA(0, 1), cA + ahs, vA1);
        if (wr == 1) PG8_BAR;
        PG8_WAIT_V(2); PG8_BAR;
        PG8_STAGE(PG8_SB(1, 0), cB + kstep, voffB); PG8_STAGE(PG8_SA(1, 0), cA + kstep, vA0); PG8_STAGE(PG8_SB(1, 1), cB + hstep + kstep, voffB);
        PG8_WAIT_V(6); PG8_BAR;
    } else {
        PG8_STAGE(PG8_SB(0, 0), cB, voffB); PG8_STAGE(PG8_SA(0, 0), cA, vA0); PG8_STAGE(PG8_SB(0, 1), cB + hstep, voffB); PG8_STAGE(PG8_SA(0, 1), cA + ahs, vA1);
        if (wr == 1) PG8_BAR;
        PG8_WAIT_V(4); PG8_BAR;
        PG8_STAGE(PG8_SB(1, 0), cB + kstep, voffB); PG8_STAGE(PG8_SA(1, 0), cA + kstep, vA0); PG8_STAGE(PG8_SB(1, 1), cB + hstep + kstep, voffB);
        PG8_WAIT_V(6); PG8_BAR;
    }
    for (;;) {
        const bool has_next = S.next(ui + 1, nxt);
        const char* nA = has_next ? (GATHER ? (const char*)g.A : (const char*)g.A + (size_t)nxt.pm * tstep) : cA; const char* nB = has_next ? (const char*)g.Bt + (size_t)nxt.pn * tstep : cB;
        const bool hf = S.half(cur);
        for (int t = 0; t < nt; t += 2) {
            const bool last = (t == nt - 2);
            const char* a1 = cA + (size_t)(t + 1) * kstep;
            const char* a2 = last ? nA : cA + (size_t)(t + 2) * kstep; const char* b2 = last ? nB : cB + (size_t)(t + 2) * kstep;
            const char* a3 = a2 + kstep; const char* b3 = b2 + kstep;
            if (last && has_next) S.a_ready(nxt);
            unsigned w0[2], w1[2];
            if constexpr (GATHER) {
                if (last && has_next) {
#pragma unroll
                    for (int i = 0; i < 2; ++i) { nvA0[i] = S.row_off(nxt, sR[i]) + (unsigned)sC[i] * 2u; nvA1[i] = S.row_off(nxt, HALF + sR[i]) + (unsigned)sC[i] * 2u; }
                }
#pragma unroll
                for (int i = 0; i < 2; ++i) { w0[i] = last ? nvA0[i] : vA0[i]; w1[i] = last ? nvA1[i] : vA1[i]; }
            } else {
#pragma unroll
                for (int i = 0; i < 2; ++i) { w0[i] = vA0[i]; w1[i] = vA0[i]; }
            }
            if constexpr (SP2) {
            PG8_LDB(B0, 0, 0); PG8_LDB(B1, 0, 1); PG8_SCHED; PG8_LDA(At, 0, 0); PG8_STAGE(PG8_SA(1, 1), a1 + ahs, vA1);
            PG8_WAIT_V(8); PG8_WAIT_L(0); PG8_BAR; PG8_MMA(0, 0, At, B0); PG8_MMA(0, 1, At, B1); PG8_BAR; PG8_SCHED;
            if (!hf) PG8_LDA(At, 0, 1); PG8_STAGE(PG8_SB(0, 0), b2, voffB); PG8_STAGE(PG8_SB(0, 1), b2 + hstep, voffB); PG8_STAGE(PG8_SA(0, 0), a2, w0);
            PG8_WAIT_V(8); PG8_WAIT_L(0); PG8_BAR; if (!hf) { PG8_MMA(1, 0, At, B0); PG8_MMA(1, 1, At, B1); } PG8_BAR; PG8_SCHED;
            PG8_LDB(B0, 1, 0); PG8_LDB(B1, 1, 1); PG8_SCHED; PG8_LDA(At, 1, 0); PG8_STAGE(PG8_SA(0, 1), a2 + ahs, w1);
            PG8_WAIT_V(8); PG8_WAIT_L(0); PG8_BAR; PG8_MMA(0, 0, At, B0); PG8_MMA(0, 1, At, B1); PG8_BAR; PG8_SCHED;
            if (!hf) PG8_LDA(At, 1, 1); PG8_STAGE(PG8_SB(1, 0), b3, voffB); PG8_STAGE(PG8_SB(1, 1), b3 + hstep, voffB); PG8_STAGE(PG8_SA(1, 0), a3, w0);
            PG8_WAIT_V(8); PG8_WAIT_L(0); PG8_BAR; if (!hf) { PG8_MMA(1, 0, At, B0); PG8_MMA(1, 1, At, B1); } PG8_BAR; PG8_SCHED;
            } else {
            PG8_LDB(B0, 0, 0); PG8_SCHED; PG8_LDA(At, 0, 0); PG8_STAGE(PG8_SA(1, 1), a1 + ahs, vA1);
            PG8_WAIT_L(8); PG8_BAR; PG8_WAIT_L(0); PG8_MMA(0, 0, At, B0); PG8_BAR; PG8_SCHED;
            PG8_LDB(B1, 0, 1); PG8_STAGE(PG8_SB(0, 0), b2, voffB);
            PG8_BAR; PG8_WAIT_L(0); PG8_MMA(0, 1, At, B1); PG8_BAR;
            PG8_LDA(At, 0, 1); PG8_STAGE(PG8_SA(0, 0), a2, w0);
            PG8_BAR; PG8_WAIT_L(0); PG8_MMA(1, 0, At, B0); PG8_BAR; PG8_SCHED;
            PG8_STAGE(PG8_SB(0, 1), b2 + hstep, voffB);
            PG8_WAIT_V(6); PG8_BAR; PG8_MMA(1, 1, At, B1); PG8_BAR;
            PG8_LDB(B0, 1, 0); PG8_SCHED; PG8_LDA(At, 1, 0); PG8_STAGE(PG8_SA(0, 1), a2 + ahs, w1);
            PG8_WAIT_L(8); PG8_BAR; PG8_WAIT_L(0); PG8_MMA(0, 0, At, B0); PG8_BAR; PG8_SCHED;
            PG8_LDB(B1, 1, 1); PG8_STAGE(PG8_SB(1, 0), b3, voffB);
            PG8_BAR; PG8_WAIT_L(0); PG8_MMA(0, 1, At, B1); PG8_BAR;
            PG8_LDA(At, 1, 1); PG8_STAGE(PG8_SA(1, 0), a3, w0);
            PG8_BAR; PG8_WAIT_L(0); PG8_MMA(1, 0, At, B0); PG8_BAR; PG8_SCHED;
            PG8_STAGE(PG8_SB(1, 1), b3 + hstep, voffB);
            PG8_WAIT_V(6); PG8_BAR; PG8_MMA(1, 1, At, B1); PG8_BAR;
            }
        }
        if constexpr (FP8) asm volatile("s_nop 15\n\ts_nop 15" ::: "memory");
        typename Sched::Pre pre_; S.pre(ui, pre_);
        if constexpr (ALIGN_EPI) { if (wr == 0) PG8_BAR; }
        E(acc, cur, wr, wc, fr, fq); S.done(cur); S.post(ui, pre_);
        if (!has_next) break;
#pragma unroll
        for (int a = 0; a < 2; ++a)
#pragma unroll
            for (int b = 0; b < 2; ++b)
#pragma unroll
                for (int m = 0; m < 4; ++m)
#pragma unroll
                    for (int n = 0; n < 2; ++n) acc[a][b][m][n] = (f32x4){0.f, 0.f, 0.f, 0.f};
        cur = nxt; cA = nA; cB = nB; ++ui;
        if constexpr (GATHER) {
#pragma unroll
            for (int i = 0; i < 2; ++i) { vA0[i] = nvA0[i]; vA1[i] = nvA1[i]; }
        }
        if constexpr (ALIGN_EPI) { if (wr == 1) PG8_BAR; }
    }
    PG8_WAIT_V(0);
    if constexpr (!ALIGN_EPI) { if (wr == 0) PG8_BAR; }
    PG8_BAR;
#undef PG8_SA
#undef PG8_SB
#undef PG8_STAGE
#undef PG8_LDA
#undef PG8_LDB
#undef PG8_MMA
#undef PG8_WAIT_V
#undef PG8_WAIT_L
#undef PG8_BAR
#undef PG8_SCHED
}

__device__ __forceinline__ u32x4 pack8(const f32x4 v0, const f32x4 v1) { u32x4 w; w.x = cvt_pk_bf16(v0[0], v0[1]); w.y = cvt_pk_bf16(v0[2], v0[3]); w.z = cvt_pk_bf16(v1[0], v1[1]); w.w = cvt_pk_bf16(v1[2], v1[3]); return w; }
__device__ __forceinline__ u32x2 pack8_fp8(const f32x4 v0, const f32x4 v1) { int lo = __builtin_amdgcn_cvt_pk_fp8_f32(v0[0], v0[1], 0, false); lo = __builtin_amdgcn_cvt_pk_fp8_f32(v0[2], v0[3], lo, true);
    int hi = __builtin_amdgcn_cvt_pk_fp8_f32(v1[0], v1[1], 0, false); hi = __builtin_amdgcn_cvt_pk_fp8_f32(v1[2], v1[3], hi, true); return (u32x2){(unsigned)lo, (unsigned)hi}; }
__device__ __forceinline__ void unpack8(const u32x4 w, f32x4& v0, f32x4& v1) {
    v0[0] = __uint_as_float(w.x << 16); v0[1] = __uint_as_float(w.x & 0xffff0000u); v0[2] = __uint_as_float(w.y << 16); v0[3] = __uint_as_float(w.y & 0xffff0000u);
    v1[0] = __uint_as_float(w.z << 16); v1[1] = __uint_as_float(w.z & 0xffff0000u); v1[2] = __uint_as_float(w.w << 16); v1[3] = __uint_as_float(w.w & 0xffff0000u); }

struct Epi1 {
    static constexpr bool PERM = true;
    bf16 *Zl, *GA, *UB, *V; float* VPART;
    __device__ __forceinline__ void operator()(const f32x4 (&acc)[2][2][4][2], const Unit& u, int wr, int wc, int fr, int fq) const {
        const int row0 = u.pm * BM + wr * 64 + fr, pn = u.pn;
        if (pn < 4) {
            const int col0 = pn * 256 + wc * 32 + 8 * fq;
#pragma unroll
            for (int ai = 0; ai < 2; ++ai)
#pragma unroll
                for (int m = 0; m < 4; ++m) { bf16* rowp = Zl + (size_t)(row0 + ai * HALF + m * 16) * D + col0;
#pragma unroll
                    for (int bj = 0; bj < 2; ++bj) *(u32x4*)(rowp + bj * HALF) = pack8(acc[ai][bj][m][0], acc[ai][bj][m][1]); }
        } else if (pn < 20) {
            bf16* O = pn < 12 ? GA : UB; const int uu = pn < 12 ? pn - 4 : pn - 12; const int col0 = uu * 128 + wc * 32 + 8 * fq;
#pragma unroll
            for (int ai = 0; ai < 2; ++ai)
#pragma unroll
                for (int m = 0; m < 4; ++m) { f32x4 v[2];
#pragma unroll
                    for (int n = 0; n < 2; ++n) v[n] = acc[ai][0][m][n] * vrcp(vgelu_den(acc[ai][0][m][n]) * vsigm_den(acc[ai][1][m][n]));
                    *(u32x4*)(O + (size_t)(row0 + ai * HALF + m * 16) * D + col0) = pack8(v[0], v[1]); }
        } else {
            const int col0 = (pn - 20) * 256 + wc * 32 + 8 * fq;
#pragma unroll
            for (int ai = 0; ai < 2; ++ai)
#pragma unroll
                for (int m = 0; m < 4; ++m) { const int row = row0 + ai * HALF + m * 16; f32x4 s1v = {0.f, 0.f, 0.f, 0.f}, s2v = {0.f, 0.f, 0.f, 0.f};
#pragma unroll
                    for (int bj = 0; bj < 2; ++bj) { f32x4 v[2];
#pragma unroll
                        for (int n = 0; n < 2; ++n) { v[n] = acc[ai][bj][m][n] * vrcp(vgelu_den(acc[ai][bj][m][n])); s1v += v[n]; s2v += v[n] * v[n]; }
                        *(u32x4*)(V + (size_t)row * D + col0 + bj * HALF) = pack8(v[0], v[1]); }
                    float s1 = hsum4(s1v), s2 = hsum4(s2v);
                    s1 += __shfl_xor(s1, 16); s1 += __shfl_xor(s1, 32); s2 += __shfl_xor(s2, 16); s2 += __shfl_xor(s2, 32);
                    if (fq == 0) *(f32x2*)(VPART + (size_t)row * 32 + ((pn - 20) * 4 + wc) * 2) = (f32x2){s1, s2}; }
        }
    }
};
struct EpiPlain {
    static constexpr bool PERM = true;
    bf16* O;
    __device__ __forceinline__ void operator()(const f32x4 (&acc)[2][2][4][2], const Unit& u, int wr, int wc, int fr, int fq) const {
        const int row0 = u.pm * BM + wr * 64 + fr, col0 = u.pn * 256 + wc * 32 + 8 * fq;
#pragma unroll
        for (int ai = 0; ai < 2; ++ai)
#pragma unroll
            for (int m = 0; m < 4; ++m) { bf16* rowp = O + (size_t)(row0 + ai * HALF + m * 16) * D + col0;
#pragma unroll
                for (int bj = 0; bj < 2; ++bj) *(u32x4*)(rowp + bj * HALF) = pack8(acc[ai][bj][m][0], acc[ai][bj][m][1]); }
    }
};
struct Epi2 {
    static constexpr bool PERM = true;
    const bf16* XN; const float* RI0; const float* GINV; bf16* X1b; float* SS1;
    __device__ __forceinline__ void operator()(const f32x4 (&acc)[2][2][4][2], const Unit& u, int wr, int wc, int fr, int fq) const {
        const int row0 = u.pm * BM + wr * 64 + fr, col0 = u.pn * 256 + wc * 32 + 8 * fq;
#pragma unroll
        for (int ai = 0; ai < 2; ++ai)
#pragma unroll
            for (int m = 0; m < 4; ++m) { const int row = row0 + ai * HALF + m * 16; float ss = 0.f; const float ri = RI0[row];
#pragma unroll
                for (int bj = 0; bj < 2; ++bj) { f32x4 x0, x1; unpack8(*(const u32x4*)(XN + (size_t)row * D + col0 + bj * HALF), x0, x1);
                    const f32x4 g0 = *(const f32x4*)(GINV + col0 + bj * HALF), g1 = *(const f32x4*)(GINV + col0 + bj * HALF + 4);
                    const f32x4 v0 = acc[ai][bj][m][0] + x0 * ri * g0, v1 = acc[ai][bj][m][1] + x1 * ri * g1;
                    ss += hsum4(v0 * v0 + v1 * v1);
                    *(u32x4*)(X1b + (size_t)row * D + col0 + bj * HALF) = pack8(v0, v1); }
                ss += __shfl_xor(ss, 16); ss += __shfl_xor(ss, 32);
                if (fq == 0) SS1[(size_t)row * 16 + u.pn * 4 + wc] = ss; }
    }
};
struct EpiPle {
    static constexpr bool PERM = true; static constexpr float WSC = 1.f / 32.f;
    const bf16* X2b; const bf16* PU; const float* RSTD2; bf16* X3; float* SS3;
    __device__ __forceinline__ void operator()(const f32x4 (&acc)[2][2][4][2], const Unit& u, int wr, int wc, int fr, int fq) const {
        const int row0 = u.pm * BM + wr * 64 + fr, col0 = u.pn * 256 + wc * 32 + 8 * fq;
#pragma unroll
        for (int ai = 0; ai < 2; ++ai)
#pragma unroll
            for (int m = 0; m < 4; ++m) { const int row = row0 + ai * HALF + m * 16; float ss = 0.f; const float r2n = RSTD2[row] * (-1.4426950409f * WSC);
#pragma unroll
                for (int bj = 0; bj < 2; ++bj) { const size_t o = (size_t)row * D + col0 + bj * HALF;
                    f32x4 x0, x1, p0, p1; unpack8(*(const u32x4*)(X2b + o), x0, x1); unpack8(*(const u32x4*)(PU + o), p0, p1);
                    const f32x4 v0 = x0 + vrcp(1.f + vexp2(acc[ai][bj][m][0] * r2n)) * p0, v1 = x1 + vrcp(1.f + vexp2(acc[ai][bj][m][1] * r2n)) * p1;
                    ss += hsum4(v0 * v0 + v1 * v1);
                    *(u32x4*)(X3 + o) = pack8(v0, v1); }
                ss += __shfl_xor(ss, 16); ss += __shfl_xor(ss, 32);
                if (fq == 0) SS3[(size_t)row * 16 + u.pn * 4 + wc] = ss; }
    }
};

struct EpiPleFinal {
    static constexpr bool PERM = true; static constexpr float WSC = 1.f / 32.f;
    const bf16* X2b; const bf16* PU; const float* RSTD2; const float* fn; float* out; float* XCH; unsigned* cnt; LAS float* xl; int wave;
    __device__ __forceinline__ void operator()(f32x4 (&acc)[2][2][4][2], const Unit& u, int wr, int wc, int fr, int fq) const {
        const int tid = wave * 64 + lane_id();
        const int rl0 = wr * 64 + fr, col0 = u.pn * 256 + wc * 32 + 8 * fq;
#pragma unroll
        for (int ai = 0; ai < 2; ++ai)
#pragma unroll
            for (int m = 0; m < 4; ++m) { const int rl = rl0 + ai * HALF + m * 16, row = u.pm * BM + rl; float ss = 0.f; const float r2n = RSTD2[row] * (-1.4426950409f * WSC);
#pragma unroll
                for (int bj = 0; bj < 2; ++bj) { const size_t o = (size_t)row * D + col0 + bj * HALF;
                    f32x4 x0, x1, p0, p1; unpack8(*(const u32x4*)(X2b + o), x0, x1); unpack8(*(const u32x4*)(PU + o), p0, p1);
                    const f32x4 v0 = x0 + vrcp(1.f + vexp2(acc[ai][bj][m][0] * r2n)) * p0, v1 = x1 + vrcp(1.f + vexp2(acc[ai][bj][m][1] * r2n)) * p1;
                    ss += hsum4(v0 * v0 + v1 * v1);
                    acc[ai][bj][m][0] = v0; acc[ai][bj][m][1] = v1; }
                ss += __shfl_xor(ss, 16); ss += __shfl_xor(ss, 32);
                if (fq == 0) xl[rl * 4 + wc] = ss; }
        __syncthreads();
        if (tid < 256) { const f32x4 p = *(const LAS f32x4*)(xl + tid * 4);
            __hip_atomic_store(XCH + (size_t)(u.pm * BM + tid) * 4 + u.pn, (p[0] + p[1]) + (p[2] + p[3]), __ATOMIC_RELAXED, __HIP_MEMORY_SCOPE_AGENT); }
        asm volatile("s_waitcnt vmcnt(0)" ::: "memory");
        if (tid < 256 && (tid & 63) == 0) __hip_atomic_fetch_add(cnt + 64 * u.pm, 1u, __ATOMIC_RELAXED, __HIP_MEMORY_SCOPE_AGENT);
        if (tid < 64) { unsigned sp = 0;
            while ((unsigned)__builtin_amdgcn_readfirstlane(__hip_atomic_load(cnt + 64 * u.pm, __ATOMIC_RELAXED, __HIP_MEMORY_SCOPE_AGENT)) < 16u) { if (++sp > (1u << 22)) break; __builtin_amdgcn_s_sleep(1); } }
        __syncthreads();
        if (tid < 256) { const float* xs = XCH + (size_t)(u.pm * BM + tid) * 4; float tot = 0.f;
#pragma unroll
            for (int q = 0; q < 4; ++q) tot += __hip_atomic_load(xs + q, __ATOMIC_RELAXED, __HIP_MEMORY_SCOPE_AGENT);
            xl[1024 + tid] = rsqrtf(tot * (1.f / D) + EPS); }
        __syncthreads();
#pragma unroll
        for (int ai = 0; ai < 2; ++ai)
#pragma unroll
            for (int m = 0; m < 4; ++m) { const int rl = rl0 + ai * HALF + m * 16; const float rs = xl[1024 + rl]; float* op = out + (size_t)(u.pm * BM + rl) * D + col0;
#pragma unroll
                for (int bj = 0; bj < 2; ++bj) { const f32x4 f0 = *(const f32x4*)(fn + col0 + bj * HALF), f1 = *(const f32x4*)(fn + col0 + bj * HALF + 4);
                    *(f32x4*)(op + bj * HALF) = acc[ai][bj][m][0] * rs * f0; *(f32x4*)(op + bj * HALF + 4) = acc[ai][bj][m][1] * rs * f1; } }
    }
};

template <int MODE> struct MoeOrder {
    const LAS int* tab; const int* LIST; unsigned* dcnt;
    __device__ __forceinline__ bool next(int i, Unit& u) const {
        const int n = __builtin_amdgcn_readfirstlane(tab[0]); if (i >= n) return false;
        const LAS int* p = tab + 4 + 8 * i;
        u.pm = __builtin_amdgcn_readfirstlane(p[0]); u.pn = __builtin_amdgcn_readfirstlane(p[1]); u.e = __builtin_amdgcn_readfirstlane(p[2]);
        u.tile = __builtin_amdgcn_readfirstlane(p[3]); u.cnt = __builtin_amdgcn_readfirstlane(p[4]); return true;
    }
    __device__ __forceinline__ unsigned row_off(const Unit& u, int r) const { int idx = u.tile * 256 + r; idx = idx < u.cnt ? idx : u.cnt - 1; const int pair = LIST[u.e * 16384 + idx]; return (unsigned)(pair >> 1) * 2048u; }
    __device__ __forceinline__ void a_ready(const Unit&) const {}
    struct Pre {}; __device__ __forceinline__ void pre(int, Pre&) const {}
    __device__ __forceinline__ void post(int, Pre&) const {}
    __device__ __forceinline__ bool half(const Unit& u) const { return MODE == 1 && (u.cnt - u.tile * 256) <= 128; }
    __device__ __forceinline__ void done(const Unit& u) const {
        if constexpr (MODE == 1) {
            asm volatile("s_waitcnt vmcnt(0)" ::: "memory");
            if (lane_id() == 0) __hip_atomic_fetch_add(dcnt + 64 * u.pm, 1u, __ATOMIC_RELAXED, __HIP_MEMORY_SCOPE_AGENT);
        }
    }
};
__device__ __forceinline__ void store16_sc1(void* p, u32x4 v) { asm volatile("global_store_dwordx4 %0, %1, off sc1\n\ts_nop 1" :: "v"(p), "v"(v) : "memory"); }
struct EpiMoe1 {
    static constexpr bool PERM = true;
    bf16* H; const float* LISTR;
    __device__ __forceinline__ void operator()(const f32x4 (&acc)[2][2][4][2], const Unit& u, int wr, int wc, int fr, int fq) const {
        const int col0 = (u.pn & 1) * 128 + wc * 32 + 8 * fq;
#pragma unroll
        for (int ai = 0; ai < 2; ++ai)
#pragma unroll
            for (int m = 0; m < 4; ++m) { const int r = ai * HALF + wr * 64 + m * 16 + fr; int idx = u.tile * 256 + r; idx = idx < u.cnt ? idx : u.cnt - 1;
                const float rs = LISTR[u.e * 16384 + idx]; f32x4 v[2];
#pragma unroll
                for (int n = 0; n < 2; ++n) { const f32x4 a1 = acc[ai][0][m][n] * rs, a3 = acc[ai][1][m][n] * rs; v[n] = a1 * a3 * vrcp(vsigm_den(a1)); }
                store16_sc1(H + (size_t)(u.pm * 256 + r) * 256 + col0, pack8(v[0], v[1])); }
    }
};
struct EpiMoe2 {
    static constexpr bool PERM = true;
    bf16* Y; const int* LIST; const float* LISTG;
    __device__ __forceinline__ void operator()(const f32x4 (&acc)[2][2][4][2], const Unit& u, int wr, int wc, int fr, int fq) const {
        const int col0 = (u.pn & 3) * 256 + wc * 32 + 8 * fq;
        int pr[2][4]; float gt[2][4];
#pragma unroll
        for (int ai = 0; ai < 2; ++ai)
#pragma unroll
            for (int m = 0; m < 4; ++m) { int idx = u.tile * 256 + ai * HALF + wr * 64 + m * 16 + fr; idx = idx < u.cnt ? idx : u.cnt - 1; pr[ai][m] = LIST[u.e * 16384 + idx]; gt[ai][m] = LISTG[u.e * 16384 + idx]; }
#pragma unroll
        for (int ai = 0; ai < 2; ++ai)
#pragma unroll
            for (int m = 0; m < 4; ++m) { const int idx = u.tile * 256 + ai * HALF + wr * 64 + m * 16 + fr;
                if (idx < u.cnt) { const float g = gt[ai][m]; bf16* yp = Y + (size_t)pr[ai][m] * D + col0;
#pragma unroll
                    for (int bj = 0; bj < 2; ++bj) *(u32x4*)(yp + bj * HALF) = pack8(acc[ai][bj][m][0] * g, acc[ai][bj][m][1] * g); } }
    }
};
}

constexpr int NWAVES = 8;
constexpr int RING_BYTES = 131072, LDSCTL_OFF = 139264, MISC_OFF = LDSCTL_OFF + 320, TAB_OFF = LDSCTL_OFF + 512, LDS_BYTES = 147456;
constexpr size_t WS_WLRU = 8 * MiB + 512 * 1024;
constexpr size_t WS_WSGU = 8 * MiB + 768 * 1024;
constexpr size_t WS_WR = 9 * MiB;
constexpr size_t WS_WUP = 9 * MiB + 512 * 1024;
constexpr size_t WS_WIN = 10 * MiB;
constexpr size_t WS_WOUT = 22 * MiB;
constexpr size_t WS_WG = 24 * MiB;
constexpr size_t WS_W13 = 26 * MiB;
constexpr size_t WS_W2 = 58 * MiB;
constexpr size_t WS_PB = 234 * MiB;
constexpr size_t WS_RSTD1 = 242 * MiB;
constexpr size_t WS_RSTD0 = 242 * MiB + 128 * 1024;
constexpr size_t WS_GINV = 242 * MiB + 256 * 1024;
constexpr size_t WS_SPL8 = 242 * MiB + 512 * 1024;
constexpr size_t WS_XCH = 243 * MiB;
constexpr size_t WS_LISTG = 244 * MiB;
constexpr size_t WS_LISTR = 246 * MiB;
constexpr size_t WS_MEGA_END = 248 * MiB;
constexpr int CW_BAR = 4096;
constexpr int CW_DONE1 = 131072;
constexpr int CW_MIX = 147456;
constexpr int CW_PANEL = 65536;

typedef GAS unsigned gu32;
#define RLX_AGENT __ATOMIC_RELAXED, __HIP_MEMORY_SCOPE_AGENT
#define LDS_WAIT() asm volatile("s_waitcnt lgkmcnt(0)" ::: "memory")
#define VM_WAIT() asm volatile("s_waitcnt vmcnt(0)" ::: "memory")

#define XB_TMO      128
#define XB_XCNT(j)  (256  + 64 * (j))
#define XB_XSUB(j)  (1280 + 64 * (j))
#define XB_XGEN(j)  (2304 + 64 * (j))
#define XB_TOP      3328
#define XB_TOPGEN   3392
#define XCD_BAR_WORDS 3456
#define XB_SPIN_CAP (1u << 18)
__device__ __forceinline__ unsigned xb_ld(unsigned* p)              { return __hip_atomic_load(p, __ATOMIC_RELAXED, __HIP_MEMORY_SCOPE_AGENT); }
__device__ __forceinline__ unsigned xb_add(unsigned* p, unsigned v) { return __hip_atomic_fetch_add(p, v, __ATOMIC_RELAXED, __HIP_MEMORY_SCOPE_AGENT); }
__device__ __forceinline__ unsigned xb_xcc_id() { return (unsigned)__builtin_amdgcn_s_getreg((3 << 11) | 20) & 0xFu; }
#define XB_SPIN(cond, bar) do { unsigned _sp = 0; while (cond) { __builtin_amdgcn_s_sleep(1); \
    if ((++_sp & 255u) == 0u) { if (xb_ld(&(bar)[XB_TMO])) break; if (_sp > XB_SPIN_CAP) { atomicAdd(&(bar)[XB_TMO], 1u); break; } } } } while (0)
struct XcdBarrier { unsigned* bar; unsigned x; volatile LAS unsigned* st; int wave; };
__device__ __forceinline__ XcdBarrier xcd_barrier_post(unsigned* bar, volatile LAS unsigned* st, int wave) {
    XcdBarrier b; b.bar = bar; b.x = xb_xcc_id(); b.st = st; b.wave = wave;
    if (wave == 0 && pg8::lane_id() == 0) (void)xb_add(&bar[XB_XCNT(b.x)], 1u);
    return b;
}
__device__ __forceinline__ void xcd_barrier_complete(unsigned* bar, unsigned x, unsigned& nloc, unsigned& nx) {
    const unsigned G = gridDim.x * gridDim.y * gridDim.z;
    unsigned sum, cnt, mine, sp = 0u;
    for (;;) {
        sum = 0u; cnt = 0u; mine = 0u;
#pragma unroll
        for (unsigned j = 0; j < 16; ++j) { const unsigned c = xb_ld(&bar[XB_XCNT(j)]); sum += c; cnt += (c > 0u) ? 1u : 0u; mine = (j == x) ? c : mine; }
        if (sum == G) break;
        __builtin_amdgcn_s_sleep(1);
        if ((++sp & 255u) == 0u) { if (xb_ld(&bar[XB_TMO])) break; if (sp > XB_SPIN_CAP) { atomicAdd(&bar[XB_TMO], 1u); break; } }
    }
    nloc = mine > 0u ? mine : 1u; nx = cnt > 0u ? cnt : 1u;
}
__device__ __forceinline__ void xcd_barrier(const XcdBarrier& b) {
    asm volatile("s_waitcnt vmcnt(0)" ::: "memory");
    __syncthreads();
    if (b.wave == 0 && pg8::lane_id() == 0) {
        unsigned* bar = b.bar;
        __builtin_amdgcn_s_waitcnt(0);
        unsigned nloc = b.st[0], nx = b.st[1];
        if (nloc == 0u) { xcd_barrier_complete(bar, b.x, nloc, nx); b.st[0] = nloc; b.st[1] = nx; }
        const unsigned old = xb_add(&bar[XB_XSUB(b.x)], 1u);
        const unsigned gen = old / nloc;
        if (old + 1u == (gen + 1u) * nloc) {
            __builtin_amdgcn_fence(__ATOMIC_RELEASE, "agent");
            asm volatile("s_waitcnt vmcnt(0)" ::: "memory");
            const unsigned og = xb_add(&bar[XB_TOP], 1u);
            const unsigned tg = og / nx;
            if (og + 1u == (tg + 1u) * nx) xb_add(&bar[XB_TOPGEN], 1u);
            else XB_SPIN(xb_ld(&bar[XB_TOPGEN]) == tg, bar);
            __builtin_amdgcn_fence(__ATOMIC_ACQUIRE, "agent");
            xb_add(&bar[XB_XGEN(b.x)], 1u);
            asm volatile("s_waitcnt vmcnt(0)" ::: "memory");
        } else {
            XB_SPIN(xb_ld(&bar[XB_XGEN(b.x)]) == gen, bar);
            __builtin_amdgcn_fence(__ATOMIC_ACQUIRE, "agent");
            asm volatile("s_waitcnt vmcnt(0)" ::: "memory");
        }
    }
    __syncthreads();
}

__device__ __forceinline__ unsigned pk2(float lo, float hi) { return (unsigned)f2bf(lo) | ((unsigned)f2bf(hi) << 16); }

struct TrItem { pg8::f32x4 v[8]; };
template <bool NT = false> __device__ __forceinline__ void tr_load(TrItem& t, const float* __restrict__ W, int ldn, int k0, int n_src0, int lane) {
    const int kb = lane >> 3, n4 = lane & 7;
    const float* src = W + (size_t)(k0 + 8 * kb) * ldn + n_src0 + 4 * n4;
#pragma unroll
    for (int q = 0; q < 8; ++q) t.v[q] = NT ? __builtin_nontemporal_load((const pg8::f32x4*)(src + (size_t)q * ldn)) : *(const pg8::f32x4*)(src + (size_t)q * ldn);
}
template <bool NT = false> __device__ __forceinline__ void tr_store(TrItem& t, int k0, bf16* __restrict__ WT, int Kd, int drow0, const float* __restrict__ gk, int lane) {
    const int kb = lane >> 3, n4 = lane & 7;
    if (gk) { const pg8::f32x4 g0 = *(const pg8::f32x4*)(gk + k0 + 8 * kb), g1 = *(const pg8::f32x4*)(gk + k0 + 8 * kb + 4);
#pragma unroll
        for (int q = 0; q < 8; ++q) t.v[q] = t.v[q] * (q < 4 ? g0[q & 3] : g1[q & 3]); }
#pragma unroll
    for (int i = 0; i < 4; ++i) { pg8::u32x4 o; o.x = pk2(t.v[0][i], t.v[1][i]); o.y = pk2(t.v[2][i], t.v[3][i]); o.z = pk2(t.v[4][i], t.v[5][i]); o.w = pk2(t.v[6][i], t.v[7][i]);
        if (NT) __builtin_nontemporal_store(o, (pg8::u32x4*)(WT + (size_t)(drow0 + 4 * n4 + i) * Kd + k0 + 8 * kb)); else *(pg8::u32x4*)(WT + (size_t)(drow0 + 4 * n4 + i) * Kd + k0 + 8 * kb) = o; }
}
__device__ __forceinline__ void tr_store_fp8(TrItem& t, int k0, unsigned char* __restrict__ W8, int Kd, int drow0, const float* __restrict__ gk, float wscale, int lane) {
    const int kb = lane >> 3, n4 = lane & 7;
    pg8::f32x4 g0 = {wscale, wscale, wscale, wscale}, g1 = g0;
    if (gk) { g0 = *(const pg8::f32x4*)(gk + k0 + 8 * kb) * wscale; g1 = *(const pg8::f32x4*)(gk + k0 + 8 * kb + 4) * wscale; }
#pragma unroll
    for (int i = 0; i < 4; ++i) { const pg8::f32x4 a = {t.v[0][i] * g0[0], t.v[1][i] * g0[1], t.v[2][i] * g0[2], t.v[3][i] * g0[3]}, b = {t.v[4][i] * g1[0], t.v[5][i] * g1[1], t.v[6][i] * g1[2], t.v[7][i] * g1[3]};
        *(pg8::u32x2*)(W8 + (size_t)(drow0 + 4 * n4 + i) * Kd + k0 + 8 * kb) = pg8::pack8_fp8(a, b); }
}
__device__ __forceinline__ void p0_transpose_item(const float* __restrict__ W, int ldn, int k0, int n_src0, bf16* __restrict__ WT, int Kd, int drow0, const float* __restrict__ gk, LAS float*, int lane) {
    TrItem t; tr_load<true>(t, W, ldn, k0, n_src0, lane); tr_store(t, k0, WT, Kd, drow0, gk, lane);
}
__device__ __forceinline__ int win_dest_row(int n) {
    const int grp = n >> 10, j = n & 1023;
    switch (grp) {
        case 0: return j;
        case 1: return 1024 + (j >> 7) * 256 + (j & 127);
        case 2: return 3072 + (j >> 7) * 256 + (j & 127);
        case 3: return 5120 + j;
        case 4: return 1024 + (j >> 7) * 256 + 128 + (j & 127);
        default: return 3072 + (j >> 7) * 256 + 128 + (j & 127);
    }
}


struct DefW { const float* const* in; unsigned char* ws; };
constexpr int DF_OUT = 8 * 32, DF_E13 = 32 * 2 * 64, DF_E2 = 32 * 64, DF_G = 8 * 32, DF_UP = 2 * 32, DF_N = DF_OUT + DF_E13 + DF_E2 + DF_G + DF_UP;
struct DefDesc { const float* W; const float* gk; bf16* WT; int ldn, k0, n0, Kd, drow; };
__device__ __forceinline__ DefDesc deferred_desc(const DefW& w, int it) {
    int r = it; DefDesc d;
    if (r < DF_OUT) { const int kb = r / 16, np = r % 16; d = DefDesc{w.in[15], nullptr, (bf16*)(w.ws + WS_WOUT), 1024, kb * 64, np * 64, 1024, np * 64}; return d; } r -= DF_OUT;
    if (r < DF_E13) { const int e = r / 128, which = (r / 64) & 1, q = r % 64, kb = q / 4, np = q % 4;
        const int f0 = np * 64, drow = e * 512 + (f0 >> 7) * 256 + which * 128 + (f0 & 127);
        d = DefDesc{w.in[which ? 22 : 21] + (size_t)e * 1024 * 256, w.in[16], (bf16*)(w.ws + WS_W13), 256, kb * 64, f0, 1024, drow}; return d; } r -= DF_E13;
    if (r < DF_E2) { const int e = r / 64, q = r % 64, kb = q / 16, np = q % 16;
        d = DefDesc{w.in[23] + (size_t)e * 256 * 1024, nullptr, (bf16*)(w.ws + WS_W2), 1024, kb * 64, np * 64, 256, e * 1024 + np * 64}; return d; } r -= DF_E2;
    if (r < DF_G) { const int kb = r / 16, np = r % 16; d = DefDesc{w.in[25], w.in[24], (bf16*)(w.ws + WS_WG), 1024, kb * 64, np * 64, 1024, np * 64}; return d; } r -= DF_G;
    { const int kb = r / 16, np = r % 16; d = DefDesc{w.in[26], nullptr, (bf16*)(w.ws + WS_WUP), 1024, kb * 64, np * 64, 256, np * 64}; return d; }
}
struct Gemm1Order : pg8::StaticOrder {
    DefW w; int wave; int gi;
    struct Pre {}; __device__ __forceinline__ void pre(int, Pre&) const {}
    __device__ __forceinline__ void post(int ui, Pre&) const {
        if (ui != gi) return;
        const int lane = pg8::lane_id(), slot = c * 8 + wave, nslot = G * 8;
        for (int it = slot; it < DF_N; it += nslot) { const DefDesc d = deferred_desc(w, it); TrItem t0, t1;
            tr_load<true>(t0, d.W, d.ldn, d.k0, d.n0, lane); tr_load<true>(t1, d.W, d.ldn, d.k0, d.n0 + 32, lane);
            if (it >= DF_OUT + DF_E13 + DF_E2 && it < DF_OUT + DF_E13 + DF_E2 + DF_G) {
                tr_store_fp8(t0, d.k0, (unsigned char*)d.WT, 1024, d.drow, d.gk, 32.f, lane); tr_store_fp8(t1, d.k0, (unsigned char*)d.WT, 1024, d.drow + 32, d.gk, 32.f, lane);
            } else { tr_store<true>(t0, d.k0, d.WT, d.Kd, d.drow, d.gk, lane); tr_store<true>(t1, d.k0, d.WT, d.Kd, d.drow + 32, d.gk, lane); } }
        const pg8::f32x4* psrc = (const pg8::f32x4*)w.in[1]; unsigned long long* pdst = (unsigned long long*)(w.ws + WS_PB);
        for (int ch = slot; ch < 8192; ch += nslot) { const size_t i0 = (size_t)ch * 128 + lane; const pg8::f32x4 v0 = __builtin_nontemporal_load(psrc + i0), v1 = __builtin_nontemporal_load(psrc + i0 + 64);
            __builtin_nontemporal_store((unsigned long long)pk2(v0.x, v0.y) | ((unsigned long long)pk2(v0.z, v0.w) << 32), pdst + i0); __builtin_nontemporal_store((unsigned long long)pk2(v1.x, v1.y) | ((unsigned long long)pk2(v1.z, v1.w) << 32), pdst + i0 + 64); }
    }
};

constexpr int MY_VT = 0, MY_XA = 32768, MY_SP = 67584, MY_WS = 102400, MY_ST = 135168, MY_RS = 272;
__device__ __forceinline__ float bflo(unsigned u) { return __uint_as_float(u << 16); }
__device__ __forceinline__ float bfhi(unsigned u) { return __uint_as_float(u & 0xffff0000u); }
template <int N> __device__ __forceinline__ float row_shr(float ident, float v) {
    return __builtin_bit_cast(float, __builtin_amdgcn_update_dpp(__builtin_bit_cast(int, ident), __builtin_bit_cast(int, v), 0x110 + N, 0xf, 0xf, false)); }
#define MX_DPP_STEP(N) \
    "v_fmac_f32_dpp %4, %4, %0 row_shr:" #N " row_mask:0xf bank_mask:0xf\n\tv_fmac_f32_dpp %5, %5, %1 row_shr:" #N " row_mask:0xf bank_mask:0xf\n\t" \
    "v_fmac_f32_dpp %6, %6, %2 row_shr:" #N " row_mask:0xf bank_mask:0xf\n\tv_fmac_f32_dpp %7, %7, %3 row_shr:" #N " row_mask:0xf bank_mask:0xf\n\t" \
    "v_mul_f32_dpp %0, %0, %0 row_shr:" #N " row_mask:0xf bank_mask:0xf\n\tv_mul_f32_dpp %1, %1, %1 row_shr:" #N " row_mask:0xf bank_mask:0xf\n\t" \
    "v_mul_f32_dpp %2, %2, %2 row_shr:" #N " row_mask:0xf bank_mask:0xf\n\tv_mul_f32_dpp %3, %3, %3 row_shr:" #N " row_mask:0xf bank_mask:0xf\n\t"
__device__ __forceinline__ void scan16x4(pg8::f32x4& A, pg8::f32x4& U) { using pg8::f32x4;
    float a0 = A[0], a1 = A[1], a2 = A[2], a3 = A[3], u0 = U[0], u1 = U[1], u2 = U[2], u3 = U[3];
    asm("s_nop 1\n\t" MX_DPP_STEP(1) MX_DPP_STEP(2) MX_DPP_STEP(4) MX_DPP_STEP(8) "s_nop 0"
        : "+v"(a0), "+v"(a1), "+v"(a2), "+v"(a3), "+v"(u0), "+v"(u1), "+v"(u2), "+v"(u3));
    A = (f32x4){a0, a1, a2, a3}; U = (f32x4){u0, u1, u2, u3};
}
__device__ __forceinline__ void mixer_phase(LAS unsigned char* lds, const int vcu, const int G, const int tid, const int lane, const int wave,
                                            const bf16* __restrict__ Zl, const bf16* __restrict__ GA, const bf16* __restrict__ UB, const bf16* __restrict__ V, const float* __restrict__ VPART,
                                            unsigned long long* AGG, bf16* __restrict__ MG, unsigned* mixc, const bf16* __restrict__ WLRU, const bf16* __restrict__ WSGU, const float* __restrict__ SPL8, const float* const* in) {
    using namespace pg8;
    constexpr int RS = MY_RS;
    constexpr float L2E = 1.4426950409f;
    const int fr = lane & 15, grp = lane >> 4, cp = tid & 63, tg = wave;
    const int pr = lane & 3, sch = lane >> 2, srow = 8 * sch + 2 * pr;
    LAS float* ST = (LAS float*)(lds + MY_ST);
    int gprev = -1;
    f32x2 cw0, cw1, cw2, cw3, ccb;
    u32x4 zqa, zqb, zqc, zqd, zqe, vv00, vv01, vv10, vv11;
#define MX_ZR(k) ((k) < 4 ? zqa[(k) & 3] : (k) < 8 ? zqb[(k) & 3] : (k) < 12 ? zqc[(k) & 3] : (k) < 16 ? zqd[(k) & 3] : zqe[(k) & 3])
#define MX_SETZR(k, v) do { if ((k) < 4) zqa[(k) & 3] = (v); else if ((k) < 8) zqb[(k) & 3] = (v); else if ((k) < 12) zqc[(k) & 3] = (v); else if ((k) < 16) zqd[(k) & 3] = (v); else zqe[(k) & 3] = (v); } while (0)
#define MX_PREFETCH(uu) do { const int ck_ = (uu) >> 3, g_ = (uu) & 7, t0_ = ck_ * 128, c0_ = g_ * 128; const bool first_ = (ck_ & 15) == 0; \
        const unsigned zo_ = ((unsigned)(t0_ + 16 * tg) * D + c0_ + 2 * cp) * 2u; \
        _Pragma("unroll") for (int k = 0; k < 19; ++k) { unsigned zv_ = 0u; if (!(k < 3 && first_ && tg == 0)) zv_ = *(const unsigned*)((const char*)Zl + (zo_ + (unsigned)((k - 3) * D * 2))); MX_SETZR(k, zv_); } \
        { const unsigned vo_ = ((unsigned)(t0_ + srow) * D + c0_ + 16 * wave) * 2u; vv00 = *(const u32x4*)((const char*)V + vo_); vv01 = *(const u32x4*)((const char*)V + (vo_ + D * 2)); vv10 = *(const u32x4*)((const char*)V + (vo_ + 16)); vv11 = *(const u32x4*)((const char*)V + (vo_ + D * 2 + 16)); } \
        } while (0)
    zqe = (u32x4){0u, 0u, 0u, 0u};
#define MX_STATS_LOAD(uu, q0, q1) do { const unsigned vpo_ = ((unsigned)(((uu) >> 3) * 128 + (tid >> 2)) * 32 + (tid & 3) * 8) * 4u; q0 = *(const f32x4*)((const char*)VPART + vpo_); q1 = *(const f32x4*)((const char*)VPART + (vpo_ + 16)); } while (0)
#define MX_STATS_WRITE(q0, q1) do { float s1 = (q0[0] + q0[2]) + (q1[0] + q1[2]), s2 = (q0[1] + q0[3]) + (q1[1] + q1[3]); \
        s1 += __shfl_xor(s1, 1); s1 += __shfl_xor(s1, 2); s2 += __shfl_xor(s2, 1); s2 += __shfl_xor(s2, 2); \
        if ((tid & 3) == 0) { const float mean = s1 * (1.f / 1024.f); float var = s2 * (1.f / 1024.f) - mean * mean; var = var < 0.f ? 0.f : var; ST[tid >> 2] = mean; ST[128 + (tid >> 2)] = rsqrtf(var + EPS); } } while (0)
    int u = vcu;
    if (u < 1024) { MX_PREFETCH(u); f32x4 q0, q1; MX_STATS_LOAD(u, q0, q1); MX_STATS_WRITE(q0, q1); }
    for (; u < 1024; u += G) {
        const int ck = u >> 3, g = u & 7, t0 = ck * 128, c0 = g * 128, j = ck & 15;
        const int cch = c0 + 16 * wave + 4 * grp;
        if (g != gprev) {
            gprev = g;
#pragma unroll
            for (int it = 0; it < 4; ++it) { const int idx = it * 512 + tid, row = idx >> 4, ch = idx & 15;
                *(LAS u32x4*)(lds + MY_WS + row * 256 + ((ch ^ (row & 15)) << 4)) = *(const u32x4*)(WSGU + ((size_t)(g * 128 + row)) * 128 + ch * 8); }
            const int cc = c0 + 2 * cp;
            cw0 = *(const f32x2*)(in[4] + cc); cw1 = *(const f32x2*)(in[4] + 1024 + cc); cw2 = *(const f32x2*)(in[4] + 2048 + cc); cw3 = *(const f32x2*)(in[4] + 3072 + cc); ccb = *(const f32x2*)(in[5] + cc);
        }
        const int hblk = 2 * g + (wave >> 2), jj0 = (16 * wave) & 63;
        const bf16x8 bw00 = *(const bf16x8*)(WLRU + ((size_t)((0 * 16 + hblk) * 64 + jj0 + fr)) * 64 + 0 * 32 + 8 * grp), bw01 = *(const bf16x8*)(WLRU + ((size_t)((0 * 16 + hblk) * 64 + jj0 + fr)) * 64 + 1 * 32 + 8 * grp);
        const bf16x8 bw10 = *(const bf16x8*)(WLRU + ((size_t)((1 * 16 + hblk) * 64 + jj0 + fr)) * 64 + 0 * 32 + 8 * grp), bw11 = *(const bf16x8*)(WLRU + ((size_t)((1 * 16 + hblk) * 64 + jj0 + fr)) * 64 + 1 * 32 + 8 * grp);
        const f32x4 nba = *(const f32x4*)(in[7] + cch) * (-L2E), nbi = *(const f32x4*)(in[9] + cch) * (-L2E), ksp = *(const f32x4*)(SPL8 + cch);
        {
#pragma unroll
            for (int i = 0; i < 16; ++i) {
                const unsigned z0 = MX_ZR(i), z1 = MX_ZR(i + 1), z2 = MX_ZR(i + 2), z3 = MX_ZR(i + 3);
                const f32x2 xv = ccb + cw0 * (f32x2){bflo(z0), bfhi(z0)} + cw1 * (f32x2){bflo(z1), bfhi(z1)} + cw2 * (f32x2){bflo(z2), bfhi(z2)} + cw3 * (f32x2){bflo(z3), bfhi(z3)};
                *(LAS unsigned*)(lds + MY_XA + (16 * tg + i) * RS + 4 * cp) = cvt_pk_bf16(xv.x, xv.y);
            }
        }
        __syncthreads();
        {
            const float mua = ST[srow], rsa = ST[128 + srow], mub = ST[srow + 1], rsb = ST[128 + srow + 1];
#pragma unroll
            for (int ci = 0; ci < 2; ++ci) { const int chunk = 2 * wave + ci, cbase = c0 + 8 * chunk;
                f32x4 a0, a1, b0, b1; unpack8(ci ? vv10 : vv00, a0, a1); unpack8(ci ? vv11 : vv01, b0, b1);
                const f32x4 g0 = *(const f32x4*)(in[11] + cbase), g1 = *(const f32x4*)(in[11] + cbase + 4), l0 = *(const f32x4*)(in[12] + cbase), l1 = *(const f32x4*)(in[12] + cbase + 4);
                a0 = (a0 - mua) * rsa * g0 + l0; a1 = (a1 - mua) * rsa * g1 + l1; b0 = (b0 - mub) * rsb * g0 + l0; b1 = (b1 - mub) * rsb * g1 + l1;
#pragma unroll
                for (int i = 0; i < 8; ++i) { const int cl = 8 * chunk + i; const float va = i < 4 ? a0[i & 3] : a1[i & 3], vb = i < 4 ? b0[i & 3] : b1[i & 3];
                    *(LAS unsigned*)(lds + MY_VT + cl * 256 + ((sch ^ (cl & 15)) << 4) + 4 * pr) = cvt_pk_bf16(va, vb); }
            }
        }
        f32x4 R[8], I[8];
#pragma unroll
        for (int mt = 0; mt < 8; ++mt) { R[mt] = (f32x4){0.f, 0.f, 0.f, 0.f}; I[mt] = (f32x4){0.f, 0.f, 0.f, 0.f};
#pragma unroll
            for (int ks = 0; ks < 2; ++ks) { const bf16x8 a = *(const LAS bf16x8*)(lds + MY_XA + (mt * 16 + fr) * RS + ((wave >> 2) * 64 + ks * 32 + 8 * grp) * 2);
                R[mt] = __builtin_amdgcn_mfma_f32_16x16x32_bf16(ks ? bw01 : bw00, a, R[mt], 0, 0, 0); I[mt] = __builtin_amdgcn_mfma_f32_16x16x32_bf16(ks ? bw11 : bw10, a, I[mt], 0, 0, 0); } }
#pragma unroll
        for (int mt = 0; mt < 8; ++mt) {
            const u32x2 xw = *(const LAS u32x2*)(lds + MY_XA + (mt * 16 + fr) * RS + (16 * wave + 4 * grp) * 2);
            const f32x4 xa4 = {bflo(xw.x), bfhi(xw.x), bflo(xw.y), bfhi(xw.y)};
            const f32x4 t1 = R[mt] * (-L2E) + nba, t2 = I[mt] * (-L2E) + nbi;
            f32x4 d1, d2, inv;
#pragma unroll
            for (int r = 0; r < 4; ++r) { d1[r] = 1.f + __builtin_amdgcn_exp2f(t1[r]); d2[r] = 1.f + __builtin_amdgcn_exp2f(t2[r]); }
            const f32x4 dd = d1 * d2;
#pragma unroll
            for (int r = 0; r < 4; ++r) inv[r] = __builtin_amdgcn_rcpf(dd[r]);
            const f32x4 rr = d2 * inv, ii = d1 * inv, la = rr * ksp;
            const f32x4 w = la * (1.f + la * (0.5f + la * (0.16666667f + la * (0.041666667f + la * 0.0083333333f))));
            f32x4 av = 1.f + w;
            const f32x4 om = -w * (2.f + w);
            f32x4 uv;
#pragma unroll
            for (int r = 0; r < 4; ++r) uv[r] = __builtin_amdgcn_sqrtf(om[r]);
            uv = uv * ii * xa4;
            scan16x4(av, uv); R[mt] = av; I[mt] = uv;
        }
        {
            f32x4 Pc = {1.f, 1.f, 1.f, 1.f}, Hc = {0.f, 0.f, 0.f, 0.f};
#pragma unroll
            for (int mt = 0; mt < 8; ++mt) { Hc = Hc * R[mt] + I[mt]; Pc = Pc * R[mt]; }
            if (fr == 15) {
#pragma unroll
                for (int r = 0; r < 4; ++r) __hip_atomic_store(AGG + (size_t)ck * 1024 + cch + r, ((unsigned long long)__float_as_uint(Hc[r]) << 32) | (unsigned long long)__float_as_uint(Pc[r]), __ATOMIC_RELAXED, __HIP_MEMORY_SCOPE_AGENT);
            }
        }
        __syncthreads();
        if (u + G < 1024) MX_PREFETCH(u + G);
        unsigned long long ag0 = 0x000000003f800000ull, ag1 = 0x000000003f800000ull, ag2 = 0x000000003f800000ull, ag3 = 0x000000003f800000ull;
        if (j > 0 && fr < j) { const unsigned long long* ap = AGG + (size_t)(ck - j + fr) * 1024 + cch;
            ag0 = __hip_atomic_load(ap, __ATOMIC_RELAXED, __HIP_MEMORY_SCOPE_AGENT); ag1 = __hip_atomic_load(ap + 1, __ATOMIC_RELAXED, __HIP_MEMORY_SCOPE_AGENT);
            ag2 = __hip_atomic_load(ap + 2, __ATOMIC_RELAXED, __HIP_MEMORY_SCOPE_AGENT); ag3 = __hip_atomic_load(ap + 3, __ATOMIC_RELAXED, __HIP_MEMORY_SCOPE_AGENT); }
        {
            bf16x8 q[4];
#pragma unroll
            for (int ks = 0; ks < 4; ++ks) q[ks] = *(const LAS bf16x8*)(lds + MY_VT + (16 * wave + fr) * 256 + (((ks * 4 + grp) ^ fr) << 4));
#pragma unroll
            for (int mt = 0; mt < 8; ++mt) { f32x4 Sx = {0.f, 0.f, 0.f, 0.f};
#pragma unroll
                for (int ks = 0; ks <= mt / 2; ++ks) { const bf16x8 p = *(const LAS bf16x8*)(lds + MY_WS + (mt * 16 + fr) * 256 + (((ks * 4 + grp) ^ fr) << 4));
                    Sx = __builtin_amdgcn_mfma_f32_16x16x32_bf16(q[ks], p, Sx, 0, 0, 0); }
                *(LAS u32x2*)(lds + MY_SP + (mt * 16 + fr) * RS + (16 * wave + 4 * grp) * 2) = (u32x2){cvt_pk_bf16_cv(Sx[0], Sx[1]), cvt_pk_bf16_cv(Sx[2], Sx[3])}; }
        }
        {
            f32x4 hc0 = {0.f, 0.f, 0.f, 0.f};
            if (j > 0) {
                f32x4 lp, lh; unsigned spin = 0;
                for (;;) {
                    lp[0] = __uint_as_float((unsigned)ag0); lh[0] = __uint_as_float((unsigned)(ag0 >> 32)); lp[1] = __uint_as_float((unsigned)ag1); lh[1] = __uint_as_float((unsigned)(ag1 >> 32));
                    lp[2] = __uint_as_float((unsigned)ag2); lh[2] = __uint_as_float((unsigned)(ag2 >> 32)); lp[3] = __uint_as_float((unsigned)ag3); lh[3] = __uint_as_float((unsigned)(ag3 >> 32));
                    const bool ok = (lp[0] != 0.f) && (lp[1] != 0.f) && (lp[2] != 0.f) && (lp[3] != 0.f);
                    if (__all(ok)) break;
                    if (++spin > (1u << 22)) break;
                    __builtin_amdgcn_s_sleep(1);
                    if (fr < j) { const unsigned long long* ap = AGG + (size_t)(ck - j + fr) * 1024 + cch;
                        ag0 = __hip_atomic_load(ap, __ATOMIC_RELAXED, __HIP_MEMORY_SCOPE_AGENT); ag1 = __hip_atomic_load(ap + 1, __ATOMIC_RELAXED, __HIP_MEMORY_SCOPE_AGENT);
                        ag2 = __hip_atomic_load(ap + 2, __ATOMIC_RELAXED, __HIP_MEMORY_SCOPE_AGENT); ag3 = __hip_atomic_load(ap + 3, __ATOMIC_RELAXED, __HIP_MEMORY_SCOPE_AGENT); } }
                scan16x4(lp, lh);
#pragma unroll
                for (int r = 0; r < 4; ++r) hc0[r] = __shfl(lh[r], (lane & 48) | 15);
            }
            f32x4 s = hc0;
#pragma unroll
            for (int mt = 0; mt < 8; ++mt) { f32x4 hb;
#pragma unroll
                for (int r = 0; r < 4; ++r) hb[r] = __shfl(s[r], (lane & 48) | 15);
                s = R[mt] * s + I[mt];
                const f32x4 hv = I[mt] + R[mt] * hb;
                *(LAS u32x2*)(lds + MY_XA + (mt * 16 + fr) * RS + (16 * wave + 4 * grp) * 2) = (u32x2){cvt_pk_bf16(hv[0], hv[1]), cvt_pk_bf16(hv[2], hv[3])}; }
        }
        u32x4 ga[4], ub[4]; float bsr[4]; f32x4 nq0 = {0.f, 0.f, 0.f, 0.f}, nq1 = {0.f, 0.f, 0.f, 0.f};
        if (u + G < 1024) MX_STATS_LOAD(u + G, nq0, nq1);
#pragma unroll
        for (int it = 0; it < 4; ++it) { const int idx = it * 512 + tid, row = idx >> 4, ch = idx & 15; const unsigned o = ((unsigned)(t0 + row) * D + c0 + ch * 8) * 2u; ga[it] = *(const u32x4*)((const char*)GA + o); ub[it] = *(const u32x4*)((const char*)UB + o); bsr[it] = in[14][g * 128 + row]; }
        __syncthreads();
#pragma unroll
        for (int it = 0; it < 4; ++it) { const int idx = it * 512 + tid, row = idx >> 4, ch = idx & 15;
            f32x4 g0, g1, u0, u1, h0, h1, s0, s1; unpack8(ga[it], g0, g1); unpack8(ub[it], u0, u1);
            unpack8(*(const LAS u32x4*)(lds + MY_XA + row * RS + ch * 16), h0, h1); unpack8(*(const LAS u32x4*)(lds + MY_SP + row * RS + ch * 16), s0, s1);
            store16_sc1((char*)MG + ((unsigned)(t0 + row) * D + c0 + ch * 8) * 2u, pack8(g0 * h0 + u0 * (s0 + bsr[it]), g1 * h1 + u1 * (s1 + bsr[it]))); }
        if (u + G < 1024) MX_STATS_WRITE(nq0, nq1);
        asm volatile("s_waitcnt vmcnt(0)" ::: "memory");
        if (lane == 0) __hip_atomic_fetch_add(mixc + 64 * (ck >> 1), 1u, __ATOMIC_RELAXED, __HIP_MEMORY_SCOPE_AGENT);
        __syncthreads();
    }
#undef MX_PREFETCH
#undef MX_STATS_LOAD
#undef MX_STATS_WRITE
#undef MX_ZR
#undef MX_SETZR
}

__device__ __forceinline__ void build_moe_units(LAS int* tab1, LAS int* tab2, LAS int* tab3, const int* CNT, int vcu, int G, int wave, LAS int* flags) {
    const int tid = wave * 64 + pg8::lane_id();
    int NT = 0, my_e = 0, my_tile = 0, my_cnt = 0, my_rt = 0;
    for (int e = 0; e < 32; ++e) { const int cnt = CNT[e]; const int ntl = (cnt + 255) >> 8;
        if (tid >= NT && tid < NT + ntl) { my_e = e; my_tile = tid - NT; my_cnt = cnt; my_rt = tid; }
        NT += ntl; }
    const bool have = tid < NT;
    const bool heavy = have && (my_cnt - my_tile * 256) > 128;
    flags[tid] = heavy ? 1 : 0;
    __syncthreads();
    int hb = 0, NH = 0;
    for (int i = 0; i < NT; ++i) { const int f = flags[i]; NH += f; hb += (i < tid) ? f : 0; }
    const int slot = heavy ? hb : NH + (tid - hb);
    const int U1 = 2 * NT, U2 = 4 * NT; int nlate = (U1 > G && U1 < 2 * G) ? U1 - G : 0; if (G - nlate < 64) nlate = 0;
    const int Ge = G - nlate, c2 = vcu - nlate, ssplit = nlate ? G / 2 : NT, Lsplit = 4 * ssplit;
    const int n1 = vcu < U1 ? (U1 - 1 - vcu) / G + 1 : 0;
    const int tot2 = (c2 >= 0 && c2 < U2) ? (U2 - 1 - c2) / Ge + 1 : 0;
    int n2 = (c2 >= 0 && c2 < Lsplit) ? (Lsplit - 1 - c2) / Ge + 1 : 0; n2 = n2 < tot2 ? n2 : tot2;
    const int n3 = tot2 - n2;
    if (tid == 0) { tab1[0] = n1 < 12 ? n1 : 12; tab2[0] = n2 < 12 ? n2 : 12; tab3[0] = n3 < 12 ? n3 : 12; }
    if (have) {
#pragma unroll
        for (int q = 0; q < 2; ++q) { const int L = 2 * slot + q; if (L % G == vcu && L / G < 12) { LAS int* p = tab1 + 4 + 8 * (L / G); p[0] = my_rt; p[1] = my_e * 2 + q; p[2] = my_e; p[3] = my_tile; p[4] = my_cnt; } }
        if (c2 >= 0) {
#pragma unroll
            for (int q = 0; q < 4; ++q) { const int L2 = 4 * slot + q; if (L2 % Ge == c2) { const int k = L2 / Ge; const bool early = slot < ssplit; const int idx = early ? k : k - n2;
                if (idx >= 0 && idx < 12) { LAS int* p = (early ? tab2 : tab3) + 4 + 8 * idx; p[0] = my_rt; p[1] = my_e * 4 + q; p[2] = my_e; p[3] = my_tile; p[4] = my_cnt; } } }
        }
    }
    __syncthreads();
}
__device__ __forceinline__ void moe_wait_tiles(const LAS int* tab, unsigned* dcnt, int wave) {
    if (wave == 0) {
        const int n = __builtin_amdgcn_readfirstlane(tab[0]);
        for (int i = 0; i < n; ++i) { const int rt = __builtin_amdgcn_readfirstlane(tab[4 + 8 * i]); unsigned sp = 0;
            while ((unsigned)__builtin_amdgcn_readfirstlane(__hip_atomic_load(dcnt + 64 * rt, __ATOMIC_RELAXED, __HIP_MEMORY_SCOPE_AGENT)) < 16u) { if (++sp > (1u << 22)) break; __builtin_amdgcn_s_sleep(2); } }
        __builtin_amdgcn_fence(__ATOMIC_ACQUIRE, "agent");
        asm volatile("s_waitcnt vmcnt(0)" ::: "memory");
    }
    __syncthreads();
}

struct Args { const float* in[28]; float* out; unsigned char* ws; int ph_lo, ph_hi, li, pad; };

__global__ void __launch_bounds__(NWAVES * 64, 2) mega_fwd(Args args) {
    extern __shared__ __attribute__((aligned(16))) unsigned char lds_raw[];
    LAS unsigned char* lds = (LAS unsigned char*)lds_raw;
    volatile LAS unsigned* MISC = (volatile LAS unsigned*)(lds + MISC_OFF);
    const int tid0 = threadIdx.x, wave = __builtin_amdgcn_readfirstlane(tid0 >> 6);
#define PHASE_IDS() int lane = pg8::lane_id(); asm volatile("" : "+v"(lane)); const int tid = wave * 64 + lane; (void)tid
    const int G = gridDim.x;
    const int vcu = (G % 8 == 0) ? ((int)blockIdx.x % 8) * (G / 8) + (int)blockIdx.x / 8 : (int)blockIdx.x;
    unsigned char* ws = args.ws;
    unsigned* ctl = (unsigned*)(ws + WS_CTL);
    for (int u = tid0; u < (LDS_BYTES - LDSCTL_OFF) / 4; u += NWAVES * 64) ((LAS unsigned*)(lds + LDSCTL_OFF))[u] = 0u;
    __syncthreads();
    XcdBarrier bar = xcd_barrier_post(ctl + CW_BAR + args.li * XCD_BAR_WORDS, MISC + 8, wave);
    const int lo = args.ph_lo, hi = args.ph_hi;
#define IN(k) (lo <= (k) && (k) < hi)
#define BOTH(k) (IN(k) && IN((k) + 1))
    const float* const* in = args.in;
    bf16 *XN = (bf16*)(ws + WS_A0), *MG = (bf16*)args.out, *X2b = (bf16*)(ws + WS_A0);
    float *RSTD0 = (float*)(ws + WS_RSTD0), *GINV = (float*)(ws + WS_GINV);
    bf16 *Zl = (bf16*)(ws + WS_A1), *X1b = (bf16*)args.out + (size_t)T * D;
    bf16 *GA = (bf16*)(ws + WS_A2), *UB = (bf16*)(ws + WS_A3), *V = (bf16*)(ws + WS_A4);
    bf16 *X3 = (bf16*)(ws + WS_A3);
    unsigned char* X2q = ws + WS_A1;
    bf16 *PU = (bf16*)(ws + WS_A2);
    bf16 *Pb = (bf16*)(ws + WS_PB);
    bf16 *WinT = (bf16*)(ws + WS_WIN), *WoutT = (bf16*)(ws + WS_WOUT), *WgT = (bf16*)(ws + WS_WG), *W13T = (bf16*)(ws + WS_W13), *W2T = (bf16*)(ws + WS_W2), *WupT = (bf16*)(ws + WS_WUP);
    float *VPART = (float*)(ws + WS_VPART), *SS1 = (float*)(ws + WS_SS1), *SS3 = (float*)(ws + WS_SS3), *RSTD2 = (float*)(ws + WS_RSTD2), *RSTD1 = (float*)(ws + WS_RSTD1), *LISTG = (float*)(ws + WS_LISTG), *LISTR = (float*)(ws + WS_LISTR);
    int *CNT = (int*)(ws + WS_CTL), *LIST = (int*)(ws + WS_LIST), *TOKE = (int*)(ws + WS_TOKE);
    bf16 *Hb = (bf16*)(ws + WS_A2), *Yb = (bf16*)(ws + WS_A3), *WrT = (bf16*)(ws + WS_WR), *WLRU = (bf16*)(ws + WS_WLRU), *WSGU = (bf16*)(ws + WS_WSGU);
    unsigned long long* AGGQ = (unsigned long long*)(ws + WS_AGG); float* SPL8 = (float*)(ws + WS_SPL8);

    if (IN(0)) {
        PHASE_IDS();
        LAS float* scr = (LAS float*)(lds + wave * 16384);
        const bool tab_fast = (G * 512 == 131072);
        float tf_lru = 0.f, tf_sgu = 0.f, tf10 = 0.f, tf2 = 1.f, tfr = 0.f;
        if (tab_fast) {
            const int i = vcu * 512 + tid, gate = i >> 16, h = (i >> 12) & 15, j = (i >> 6) & 63, ii = i & 63;
            const float f_lru = (gate ? in[8] : in[6])[(h * 64 + ii) * 64 + j], f_sgu = in[13][i];
            const int i10 = i < 1024 ? i : 0; const float f10 = in[10][i10], f2 = in[2][i10];
            const int n = (i >> 10) & 63, k = i & 1023; const float fa = in[17][k * 4 + (n < 4 ? n : 0)], fb = in[19][k * 32 + ((n >= 4 && n < 36) ? n - 4 : 0)], fk = in[16][k];
            tf_lru = f_lru; tf_sgu = f_sgu; tf10 = f10; tf2 = f2; tfr = n < 4 ? fa * fk : (n < 36 ? fb * fk : 0.f);
        }
        const int gw = vcu * NWAVES + wave, NGW = G * NWAVES;
        for (int it = gw; it < 16 * 192; it += NGW) { const int kb = it / 192, nb = it % 192; p0_transpose_item(in[3], 6144, kb * 64, nb * 32, WinT, 1024, win_dest_row(nb * 32), nullptr, scr, lane); }
        if (tab_fast) { const int i = vcu * 512 + tid, t = (i >> 7) & 127, s_ = i & 127;
            WLRU[i] = f2bf(tf_lru); WSGU[i] = s_ <= t ? f2bf(tf_sgu) : (bf16)0;
            if (i < 1024) { SPL8[i] = -8.f * log1pf(expf(-tf10)); GINV[i] = 1.f / tf2; }
            if (i < 64 * 1024) WrT[i] = f2bf(tfr); }
        for (int m = gw; m < T; m += 2 * NGW) {
            const int m2 = m + NGW < T ? m + NGW : m;
            const pg8::f32x4* xr = (const pg8::f32x4*)(in[0] + (size_t)m * D) + lane; const pg8::f32x4* xr2 = (const pg8::f32x4*)(in[0] + (size_t)m2 * D) + lane; const pg8::f32x4* gr = (const pg8::f32x4*)in[2] + lane;
            pg8::f32x4 v[4], w[4]; float s = 0.f, s2 = 0.f;
#pragma unroll
            for (int j = 0; j < 4; ++j) { v[j] = __builtin_nontemporal_load(xr + 64 * j); w[j] = __builtin_nontemporal_load(xr2 + 64 * j); }
#pragma unroll
            for (int j = 0; j < 4; ++j) { s += (v[j].x * v[j].x + v[j].y * v[j].y) + (v[j].z * v[j].z + v[j].w * v[j].w); s2 += (w[j].x * w[j].x + w[j].y * w[j].y) + (w[j].z * w[j].z + w[j].w * w[j].w); }
            const float rstd = rsqrtf(wave_sum(s) * (1.f / D) + EPS), rstd2 = rsqrtf(wave_sum(s2) * (1.f / D) + EPS);
            if (lane == 0) { RSTD0[m] = 1.f / rstd; RSTD0[m2] = 1.f / rstd2; }
            unsigned long long* o8 = (unsigned long long*)(XN + (size_t)m * D) + lane; unsigned long long* o82 = (unsigned long long*)(XN + (size_t)m2 * D) + lane;
#pragma unroll
            for (int j = 0; j < 4; ++j) { const pg8::f32x4 gg = gr[64 * j];
                o8[64 * j] = (unsigned long long)pk2(v[j].x * rstd * gg.x, v[j].y * rstd * gg.y) | ((unsigned long long)pk2(v[j].z * rstd * gg.z, v[j].w * rstd * gg.w) << 32);
                o82[64 * j] = (unsigned long long)pk2(w[j].x * rstd2 * gg.x, w[j].y * rstd2 * gg.y) | ((unsigned long long)pk2(w[j].z * rstd2 * gg.z, w[j].w * rstd2 * gg.w) << 32); }
        }
        if (!tab_fast) {
        for (int i = vcu * 512 + tid; i < 2 * 16 * 64 * 64; i += G * 512) { const int gate = i >> 16, h = (i >> 12) & 15, j = (i >> 6) & 63, ii = i & 63;
            WLRU[i] = f2bf(in[gate ? 8 : 6][(h * 64 + ii) * 64 + j]); }
        for (int i = vcu * 512 + tid; i < 8 * 128 * 128; i += G * 512) { const int t = (i >> 7) & 127, s = i & 127; WSGU[i] = s <= t ? f2bf(in[13][i]) : (bf16)0; }
        for (int i = vcu * 512 + tid; i < 1024; i += G * 512) { SPL8[i] = -8.f * log1pf(expf(-in[10][i])); GINV[i] = 1.f / in[2][i]; }
        for (int i = vcu * 512 + tid; i < 64 * 1024; i += G * 512) { const int n = i >> 10, k = i & 1023; float v = 0.f;
            if (n < 4) v = in[17][k * 4 + n] * in[16][k]; else if (n < 36) v = in[19][k * 32 + (n - 4)] * in[16][k];
            WrT[i] = f2bf(v); }
        }
        if (BOTH(0)) xcd_barrier(bar);
    }
    if (IN(1)) {
        { pg8::Gemm g{XN, WinT, 1024}; Gemm1Order S; S.init(T, 6144, G, (int)blockIdx.x);
          S.wave = wave; { const int upw = (64 * 24) / G > 0 ? (64 * 24) / G : 1; S.gi = (int)blockIdx.x % upw; } S.w = DefW{args.in, ws};
          pg8::Epi1 E{Zl, GA, UB, V, VPART};
          pg8::gemm_phase<pg8::Epi1, Gemm1Order, true, true, false>(lds, g, S, E, wave); }
        if (BOTH(1)) xcd_barrier(bar);
    }

    if (IN(3)) {
        PHASE_IDS();
        mixer_phase(lds, vcu, G, tid, lane, wave, Zl, GA, UB, V, VPART, AGGQ, MG, ctl + CW_MIX, WLRU, WSGU, SPL8, in);
    }
    if (IN(4)) {
        pg8::Gemm g{MG, WoutT, 1024}; pg8::StaticOrder S; S.init(T, 1024, G, (int)blockIdx.x);
        pg8::Epi2 E{XN, RSTD0, GINV, X1b, SS1};
        if (BOTH(3)) {
            if (wave == 0) { pg8::Unit u0;
                for (int i = 0; S.next(i, u0); ++i) { unsigned sp = 0;
                    while ((unsigned)__builtin_amdgcn_readfirstlane(__hip_atomic_load(ctl + CW_MIX + 64 * u0.pm, __ATOMIC_RELAXED, __HIP_MEMORY_SCOPE_AGENT)) < 128u) { if (++sp > (1u << 22)) break; __builtin_amdgcn_s_sleep(2); } }
                __builtin_amdgcn_fence(__ATOMIC_ACQUIRE, "agent");
                asm volatile("s_waitcnt vmcnt(0)" ::: "memory"); }
            __syncthreads();
        }
        pg8::gemm_phase<pg8::Epi2, pg8::StaticOrder, true, true, false>(lds, g, S, E, wave);
        if (BOTH(4)) xcd_barrier(bar);
    }

    if (IN(5)) {
        PHASE_IDS();
        constexpr int LS = 52;
        LAS float* sP = (LAS float*)lds;
        LAS float* sL = (LAS float*)(lds + 8 * 64 * LS * 4);
        LAS int* sCnt = (LAS int*)(lds + 9 * 64 * LS * 4); LAS int* sBase = sCnt + 32;
        const int fr = lane & 15, grp = lane >> 4;
        for (int tile = vcu; tile < T / 64; tile += G) {
            const int tok0 = tile * 64;
            if (tid < 32) sCnt[tid] = 0;
            pg8::bf16x8 a[4][4], b[3][4];
#pragma unroll
            for (int mt = 0; mt < 4; ++mt)
#pragma unroll
                for (int ks = 0; ks < 4; ++ks) a[mt][ks] = *(const pg8::bf16x8*)(X1b + (size_t)(tok0 + 16 * mt + fr) * D + wave * 128 + ks * 32 + 8 * grp);
#pragma unroll
            for (int nt = 0; nt < 3; ++nt)
#pragma unroll
                for (int ks = 0; ks < 4; ++ks) b[nt][ks] = *(const pg8::bf16x8*)(WrT + (size_t)(16 * nt + fr) * D + wave * 128 + ks * 32 + 8 * grp);
            pg8::f32x4 q0 = {0.f, 0.f, 0.f, 0.f}, q1 = q0, q2 = q0, q3 = q0;
            if (tid < 64) { const float* sp = SS1 + (size_t)(tok0 + tid) * 16; q0 = *(const pg8::f32x4*)sp; q1 = *(const pg8::f32x4*)(sp + 4); q2 = *(const pg8::f32x4*)(sp + 8); q3 = *(const pg8::f32x4*)(sp + 12); }
#pragma unroll
            for (int mt = 0; mt < 4; ++mt)
#pragma unroll
                for (int nt = 0; nt < 3; ++nt) { pg8::f32x4 acc = {0.f, 0.f, 0.f, 0.f};
#pragma unroll
                    for (int ks = 0; ks < 4; ++ks) acc = __builtin_amdgcn_mfma_f32_16x16x32_bf16(a[mt][ks], b[nt][ks], acc, 0, 0, 0);
#pragma unroll
                    for (int r = 0; r < 4; ++r) sP[(wave * 64 + 16 * mt + 4 * grp + r) * LS + 16 * nt + fr] = acc[r]; }
            __syncthreads();
            { const int tk = tid >> 3, c0 = (tid & 7) * 6;
#pragma unroll
              for (int c = 0; c < 6; ++c) { float sum = 0.f;
#pragma unroll
                  for (int w = 0; w < 8; ++w) sum += sP[(w * 64 + tk) * LS + c0 + c];
                  sL[tk * LS + c0 + c] = sum; } }
            __syncthreads();
            int e1 = 0, e2 = 0, r1 = 0, r2 = 0; float g1 = 0.f, g2 = 0.f, rstd = 0.f;
            if (tid < 64) {
                const int t = tok0 + tid;
                const pg8::f32x4 qs = (q0 + q1) + (q2 + q3);
                const float ss = (qs[0] + qs[1]) + (qs[2] + qs[3]);
                rstd = rsqrtf(ss * (1.f / D) + EPS);
                const LAS float* l = sL + tid * LS;
                float gl[4];
#pragma unroll
                for (int q = 0; q < 4; ++q) gl[q] = rstd * l[q] + in[18][q];
                float mx = gl[0]; int gi = 0;
#pragma unroll
                for (int q = 1; q < 4; ++q) if (gl[q] > mx) { mx = gl[q]; gi = q; }
                float den = 0.f;
#pragma unroll
                for (int q = 0; q < 4; ++q) den += expf(gl[q] - mx);
                const float gtop = 1.f / den;
                float m1 = -3.0e38f, m2 = -3.0e38f; int i1 = 0, i2 = 0;
                for (int j = 0; j < 8; ++j) { const float v = rstd * l[4 + gi * 8 + j] + in[20][gi * 8 + j];
                    if (v > m1) { m2 = m1; i2 = i1; m1 = v; i1 = j; } else if (v > m2) { m2 = v; i2 = j; } }
                const float p2 = expf(m2 - m1);
                g1 = gtop / (1.f + p2); g2 = gtop * p2 / (1.f + p2);
                e1 = gi * 8 + i1; e2 = gi * 8 + i2;
                r1 = __hip_atomic_fetch_add(&sCnt[e1], 1, __ATOMIC_RELAXED, __HIP_MEMORY_SCOPE_WORKGROUP); r2 = __hip_atomic_fetch_add(&sCnt[e2], 1, __ATOMIC_RELAXED, __HIP_MEMORY_SCOPE_WORKGROUP);
            }
            __syncthreads();
            if (tid < 32) { const int c = sCnt[tid]; sBase[tid] = c ? atomicAdd(&CNT[tid], c) : 0; }
            __syncthreads();
            if (tid < 64) { const int t = tok0 + tid, p1 = e1 * 16384 + sBase[e1] + r1, p2 = e2 * 16384 + sBase[e2] + r2;
                LIST[p1] = t * 2; LIST[p2] = t * 2 + 1; LISTG[p1] = g1; LISTG[p2] = g2; LISTR[p1] = rstd; LISTR[p2] = rstd; }
            __syncthreads();
        }
        if (BOTH(5)) xcd_barrier(bar);
    }
    if (IN(6)) {
        LAS int* tab1 = (LAS int*)(lds + TAB_OFF); LAS int* tab2 = (LAS int*)(lds + TAB_OFF + 512); LAS int* tab3 = (LAS int*)(lds + TAB_OFF + 1024);
        build_moe_units(tab1, tab2, tab3, CNT, vcu, G, wave, (LAS int*)lds);
        unsigned* dcnt = ctl + CW_DONE1;
        { pg8::Gemm g{X1b, W13T, 1024}; pg8::MoeOrder<1> S{tab1, LIST, dcnt};
          pg8::EpiMoe1 E{Hb, LISTR};
          pg8::gemm_phase<pg8::EpiMoe1, pg8::MoeOrder<1>, true, true, true>(lds, g, S, E, wave); }
        pg8::Gemm g2{Hb, W2T, 256}; pg8::EpiMoe2 E2{Yb, LIST, LISTG};
        moe_wait_tiles(tab2, dcnt, wave);
        { pg8::MoeOrder<0> S{tab2, LIST, dcnt}; pg8::gemm_phase<pg8::EpiMoe2, pg8::MoeOrder<0>, true, true, false>(lds, g2, S, E2, wave); }
        moe_wait_tiles(tab3, dcnt, wave);
        { pg8::MoeOrder<0> S{tab3, LIST, dcnt}; pg8::gemm_phase<pg8::EpiMoe2, pg8::MoeOrder<0>, true, true, false>(lds, g2, S, E2, wave); }
        if (BOTH(6)) xcd_barrier(bar);
    }
    if (IN(8)) {
        const bool split = (G % 16 == 0);
        const int q8 = (int)blockIdx.x >> 3, x8 = (int)blockIdx.x & 7;
        const bool do_gemm = !split || (q8 & 1), do_comb = !split || !(q8 & 1);
        if (do_comb) {
            PHASE_IDS();
            const int NGW = (split ? G / 2 : G) * NWAVES, gw = (split ? (q8 >> 1) * 8 + x8 : vcu) * NWAVES + wave;
            for (int row = gw; row < T; row += 2 * NGW) {
                const int row2 = row + NGW; const bool two = row2 < T; const int rb = two ? row2 : row;
                pg8::u32x4 la[2][2], lb[2][2], lc[2][2];
#pragma unroll
                for (int rr = 0; rr < 2; ++rr)
#pragma unroll
                    for (int hh = 0; hh < 2; ++hh) { const int r = rr ? rb : row;
                        la[rr][hh] = __builtin_nontemporal_load((const pg8::u32x4*)(X1b + (size_t)r * D + hh * 512 + lane * 8));
                        lb[rr][hh] = __builtin_nontemporal_load((const pg8::u32x4*)(Yb + (size_t)r * 2 * D + hh * 512 + lane * 8));
                        lc[rr][hh] = __builtin_nontemporal_load((const pg8::u32x4*)(Yb + ((size_t)r * 2 + 1) * D + hh * 512 + lane * 8)); }
#pragma unroll
                for (int rr = 0; rr < 2; ++rr) { const int r = rr ? rb : row; float ss = 0.f;
#pragma unroll
                    for (int hh = 0; hh < 2; ++hh) { pg8::f32x4 a0, a1, b0, b1, c0, c1; pg8::unpack8(la[rr][hh], a0, a1); pg8::unpack8(lb[rr][hh], b0, b1); pg8::unpack8(lc[rr][hh], c0, c1);
                        a0 = a0 + b0 + c0; a1 = a1 + b1 + c1;
                        ss += pg8::hsum4(a0 * a0 + a1 * a1);
                        if (rr == 0 || two) { *(pg8::u32x4*)(X2b + (size_t)r * D + hh * 512 + lane * 8) = pg8::pack8(a0, a1); *(pg8::u32x2*)(X2q + (size_t)r * D + hh * 512 + lane * 8) = pg8::pack8_fp8(a0, a1); } }
                    ss = wave_sum(ss);
                    if (lane == 0 && (rr == 0 || two)) RSTD2[r] = rsqrtf(ss * (1.f / D) + EPS); }
            }
        }
        if (do_gemm) {
            pg8::Gemm g{Pb, WupT, 256}; pg8::StaticOrder S; S.init(T, 1024, split ? G / 2 : G, split ? (q8 >> 1) * 8 + x8 : (int)blockIdx.x);
            pg8::EpiPlain E{PU};
            pg8::gemm_phase<pg8::EpiPlain, pg8::StaticOrder, true, true, false>(lds, g, S, E, wave);
        }
        if (BOTH(8)) xcd_barrier(bar);
    }
    const bool fuse_final = (G == 256);
    if (IN(9)) {
        pg8::Gemm g{(const bf16*)X2q, WgT, 512}; pg8::StaticOrder S; S.init(T, 1024, G, (int)blockIdx.x);
        if (fuse_final) {
            pg8::EpiPleFinal E{X2b, PU, RSTD2, in[27], args.out, (float*)(ws + WS_XCH), ctl + CW_PANEL, (LAS float*)(lds + RING_BYTES), wave};
            pg8::gemm_phase<pg8::EpiPleFinal, pg8::StaticOrder, true, true, false, true>(lds, g, S, E, wave);
        } else {
            pg8::EpiPle E{X2b, PU, RSTD2, X3, SS3};
            pg8::gemm_phase<pg8::EpiPle, pg8::StaticOrder, true, true, false, true>(lds, g, S, E, wave);
            if (BOTH(9)) xcd_barrier(bar);
        }
    }

    if (IN(10) && !fuse_final) {
        PHASE_IDS();
        const int gw = vcu * NWAVES + wave, NGW = G * NWAVES;
        for (int row = gw; row < T; row += NGW) { float ss = 0.f;
            if (lane < 16) ss = SS3[(size_t)row * 16 + lane];
            ss = wave_sum(ss);
            const float rstd = rsqrtf(ss * (1.f / D) + EPS);
#pragma unroll
            for (int hh = 0; hh < 2; ++hh) { const size_t o = (size_t)row * D + hh * 512 + lane * 8; pg8::f32x4 a0, a1; pg8::unpack8(*(const pg8::u32x4*)(X3 + o), a0, a1);
                const pg8::f32x4 f0 = *(const pg8::f32x4*)(in[27] + hh * 512 + lane * 8), f1 = *(const pg8::f32x4*)(in[27] + hh * 512 + lane * 8 + 4);
                *(pg8::f32x4*)(args.out + o) = a0 * rstd * f0; *(pg8::f32x4*)(args.out + o + 4) = a1 * rstd * f1; } }
    }
#undef IN
#undef BOTH
#undef PHASE_IDS
}

static int mega_grid() {
    static int grid = 0;
    if (grid == 0) {
        int dev = 0, cus = 0;
        if (hipGetDevice(&dev) != hipSuccess || hipDeviceGetAttribute(&cus, hipDeviceAttributeMultiprocessorCount, dev) != hipSuccess) { fprintf(stderr, "mega: device query failed\n"); grid = -1; return grid; }
        if (hipFuncSetAttribute((const void*)mega_fwd, hipFuncAttributeMaxDynamicSharedMemorySize, LDS_BYTES) != hipSuccess) { fprintf(stderr, "mega: hipFuncSetAttribute failed\n"); grid = -1; return grid; }
        (void)hipGetLastError();
        grid = cus;
    }
    return grid;
}
static void launch_mega(void* const* d_in, void* d_out, void* d_ws, int lo, int hi, int li, hipStream_t stream) {
    const int grid = mega_grid(); if (grid <= 0) return;
    Args a{};
    for (int i = 0; i < 28; ++i) a.in[i] = (const float*)d_in[i];
    a.out = (float*)d_out; a.ws = (unsigned char*)d_ws; a.ph_lo = lo; a.ph_hi = hi; a.li = li; a.pad = 0;
    hipLaunchKernelGGL(mega_fwd, dim3(grid), dim3(NWAVES * 64), LDS_BYTES, stream, a);
}

extern "C" void kernel_launch(void* const* d_in, const int* in_sizes, int n_in, void* d_out, int out_size, void* d_ws, size_t ws_size, hipStream_t stream) {
    if (n_in != 28 || in_sizes[0] != T * D || out_size != T * D || ws_size < WS_MEGA_END) { fprintf(stderr, "kernel_launch: unexpected shapes (n_in %d, ws %zu)\n", n_in, ws_size); return; }
    (void)hipMemsetAsync(d_ws, 0, 2 * MiB, stream);
    launch_mega(d_in, d_out, d_ws, 0, 11, 0, stream);
}
```

```cpp
#include <hip/hip_runtime.h>
#include <stdint.h>
#include <cstdio>

typedef unsigned short bf16;
constexpr int T = 16384, D = 1024, SEQ = 2048;
constexpr float EPS = 1e-6f;
constexpr size_t MiB = 1u << 20;
constexpr size_t WS_CTL = 0;
constexpr size_t WS_VPART = 2 * MiB;
constexpr size_t WS_SS1 = 4 * MiB;
constexpr size_t WS_SS3 = 5 * MiB;
constexpr size_t WS_AGG = 1 * MiB;
constexpr size_t WS_LIST = 6 * MiB;
constexpr size_t WS_TOKE = 8 * MiB;
constexpr size_t WS_TOKG = 8 * MiB + 128 * 1024;
constexpr size_t WS_RSTD2 = 8 * MiB + 256 * 1024;
constexpr size_t WS_A0 = 74 * MiB;
constexpr size_t WS_A1 = 106 * MiB;
constexpr size_t WS_A2 = 138 * MiB;
constexpr size_t WS_A3 = 170 * MiB;
constexpr size_t WS_A4 = 202 * MiB;
constexpr size_t WS_END = 234 * MiB;

__device__ __forceinline__ float bf2f(bf16 b) { return __uint_as_float(((unsigned)b) << 16); }
__device__ __forceinline__ bf16 f2bf(float f) { unsigned u = __float_as_uint(f); u += 0x7fffu + ((u >> 16) & 1u); return (bf16)(u >> 16); }
__device__ __forceinline__ float sigm(float x) { return 1.f / (1.f + expf(-x)); }
__device__ __forceinline__ float gelu_t(float x) { const float u = 0.7978845608028654f * (x + 0.044715f * x * x * x); return 0.5f * x * (1.f + tanhf(u)); }
__device__ __forceinline__ float wave_sum(float v) {
#pragma unroll
    for (int o = 1; o < 64; o <<= 1) v += __shfl_xor(v, o);
    return v;
}

#define LAS __attribute__((address_space(3)))
#define GAS __attribute__((address_space(1)))
namespace pg8 {
typedef short bf16x8 __attribute__((ext_vector_type(8)));
typedef float f32x4 __attribute__((ext_vector_type(4)));
typedef float f32x2 __attribute__((ext_vector_type(2)));
typedef unsigned u32x4 __attribute__((ext_vector_type(4)));
typedef unsigned u32x2 __attribute__((ext_vector_type(2)));
typedef int i32x4 __attribute__((ext_vector_type(4)));
typedef int i32x8 __attribute__((ext_vector_type(8)));
constexpr int BM = 256, BK = 64, HALF = 128, HTB = HALF * BK * 2, STAGE_BYTES = 8 * HTB, NXCD = 8, WGM = 8;

__host__ __device__ __forceinline__ int lds_byte(int r, int c) { const int st = (r >> 4) * 2 + (c >> 5), rr = r & 15, cc = c & 31, ob = rr * 64 + cc * 2; return st * 1024 + (ob ^ (((ob >> 9) & 1) << 5)); }
__host__ __device__ __forceinline__ void stage_rc(int b, int& R, int& C) { const int st = b / 1024, sb = b % 1024, swz = sb ^ (((sb >> 9) & 1) << 5); R = (st >> 1) * 16 + swz / 64; C = (st & 1) * 32 + (swz % 64) / 2; }
__host__ __device__ __forceinline__ int perm32(int rho) { const int n = rho >> 4, i = rho & 15; return 8 * (i >> 2) + 4 * n + (i & 3); }

__device__ __forceinline__ int lane_id() { int l; asm volatile("v_mbcnt_lo_u32_b32 %0, -1, 0\n\tv_mbcnt_hi_u32_b32 %0, -1, %0" : "=v"(l)); return l; }
struct Unit { int pm, pn, e, tile, cnt; };
struct Gemm { const bf16* A; const bf16* Bt; int K; };

struct StaticOrder {
    int nM, nN, nwg, G, c;
    __device__ void init(int M, int N, int G_, int c_) { nM = M / BM; nN = N / BM; nwg = nM * nN; G = G_; c = c_; }
    __device__ bool next(int i, Unit& u) const {
        const long L = (long)i * G + c; if (L >= nwg) return false;
        int wgid = (int)L; { const int q = nwg / NXCD, r = nwg % NXCD, xcd = wgid % NXCD, off = wgid / NXCD; wgid = (xcd < r ? xcd * (q + 1) : r * (q + 1) + (xcd - r) * q) + off; }
        const int nig = WGM * nN, gid = wgid / nig, fm = gid * WGM, gsz = (nM - fm) < WGM ? (nM - fm) : WGM;
        u.pm = fm + ((wgid % nig) % gsz); u.pn = (wgid % nig) / gsz; u.e = 0; u.tile = 0; u.cnt = 0; return true;
    }
    __device__ __forceinline__ unsigned row_off(const Unit&, int) const { return 0u; }
    __device__ __forceinline__ void a_ready(const Unit&) const {}
    __device__ __forceinline__ void done(const Unit&) const {}
    struct Pre {}; __device__ __forceinline__ void pre(int, Pre&) const {}
    __device__ __forceinline__ void post(int, Pre&) const {}
    __device__ __forceinline__ bool half(const Unit&) const { return false; }
};

__device__ __forceinline__ unsigned cvt_pk_bf16(float lo, float hi) { unsigned r; asm volatile("v_cvt_pk_bf16_f32 %0, %1, %2" : "=v"(r) : "v"(lo), "v"(hi)); return r; }
typedef __bf16 bf16x2_t __attribute__((ext_vector_type(2)));
__device__ __forceinline__ unsigned cvt_pk_bf16_cv(float lo, float hi) { const f32x2 v = {lo, hi}; const bf16x2_t b = __builtin_convertvector(v, bf16x2_t); return __builtin_bit_cast(unsigned, b); }
__device__ __forceinline__ float fsigm(float x) { return __builtin_amdgcn_rcpf(1.0f + __builtin_amdgcn_exp2f(-1.4426950409f * x)); }
__device__ __forceinline__ float fgelu(float x) { const float u = x + 0.044715f * x * x * x; return x * __builtin_amdgcn_rcpf(1.0f + __builtin_amdgcn_exp2f(-2.3022082f * u)); }
__device__ __forceinline__ f32x4 vexp2(const f32x4 t) { f32x4 e;
#pragma unroll
    for (int i = 0; i < 4; ++i) e[i] = __builtin_amdgcn_exp2f(t[i]);
    return e; }
__device__ __forceinline__ f32x4 vrcp(const f32x4 t) { f32x4 e;
#pragma unroll
    for (int i = 0; i < 4; ++i) e[i] = __builtin_amdgcn_rcpf(t[i]);
    return e; }
__device__ __forceinline__ f32x4 vgelu_den(const f32x4 x) { return 1.f + vexp2(x * (x * x * (-0.10294324f) + (-2.3022082f))); }
__device__ __forceinline__ f32x4 vsigm_den(const f32x4 x) { return 1.f + vexp2(x * (-1.4426950409f)); }
__device__ __forceinline__ float hsum4(const f32x4 v) { return (v[0] + v[1]) + (v[2] + v[3]); }

__device__ __forceinline__ i32x8 cat8(const bf16x8 lo, const bf16x8 hi) { const i32x4 a = __builtin_bit_cast(i32x4, lo), b = __builtin_bit_cast(i32x4, hi); return __builtin_shufflevector(a, b, 0, 1, 2, 3, 4, 5, 6, 7); }
template <class Epi, class Sched, bool ALIGN_EPI, bool SP2, bool GATHER, bool FP8 = false>
__device__ __forceinline__ void gemm_phase(LAS unsigned char* lds, const Gemm g, const Sched& S, const Epi& E, const int wave_) {
    int lane = lane_id(); asm volatile("" : "+v"(lane));
    const int wid = wave_, tid = wid * 64 + lane, wr = wid >> 2, wc = wid & 3, fr = lane & 15, fq = lane >> 4;
    int K_ = g.K; if constexpr (FP8) asm volatile("" : "+s"(K_));
    const int K = K_, nt = K / BK;
    int sR[2], sC[2];
    unsigned voffB[2], vA0[2], vA1[2], nvA0[2], nvA1[2];
#pragma unroll
    for (int i = 0; i < 2; ++i) { stage_rc(tid * 16 + i * 8192, sR[i], sC[i]); const int Rb = Epi::PERM ? ((sR[i] & ~31) + perm32(sR[i] & 31)) : sR[i];
        voffB[i] = (unsigned)(Rb * K + sC[i]) * 2u; vA0[i] = (unsigned)(sR[i] * K + sC[i]) * 2u; vA1[i] = vA0[i]; nvA0[i] = vA0[i]; nvA1[i] = vA0[i]; }
    const size_t kstep = (size_t)(BK * 2);
    const size_t hstep = (size_t)HALF * K * 2;
    const size_t tstep = 2 * hstep;
    const size_t ahs = GATHER ? 0 : hstep;
    const unsigned ldsw = (unsigned)wid * 1024u;
    const int aoff = lds_byte(wr * 64 + fr, fq * 8), boff = lds_byte(wc * 32 + fr, fq * 8);
#define PG8_SA(b, h) (((b) * 2 + (h)) * HTB)
#define PG8_SB(b, h) ((4 + (b) * 2 + (h)) * HTB)
#define PG8_STAGE(bufoff, gbase, voff) do { _Pragma("unroll") for (int _i = 0; _i < 2; ++_i) \
        __builtin_amdgcn_global_load_lds((const unsigned*)((const char*)(gbase) + (voff)[_i]), (LAS unsigned*)(lds + (bufoff) + ldsw + _i * 8192), 16, 0, 0); } while (0)
#define PG8_LDA(dst, b, h) do { if constexpr (FP8) { _Pragma("unroll") for (int m = 0; m < 4; ++m) dst##q[m] = cat8(*(const LAS bf16x8*)(lds + PG8_SA(b, h) + aoff + m * 2048), *(const LAS bf16x8*)(lds + PG8_SA(b, h) + aoff + m * 2048 + 1024)); } \
        else { _Pragma("unroll") for (int m = 0; m < 4; ++m) _Pragma("unroll") for (int k = 0; k < 2; ++k) dst[m][k] = *(const LAS bf16x8*)(lds + PG8_SA(b, h) + aoff + m * 2048 + k * 1024); } } while (0)
#define PG8_LDB(dst, b, h) do { if constexpr (FP8) { _Pragma("unroll") for (int n = 0; n < 2; ++n) dst##q[n] = cat8(*(const LAS bf16x8*)(lds + PG8_SB(b, h) + boff + n * 2048), *(const LAS bf16x8*)(lds + PG8_SB(b, h) + boff + n * 2048 + 1024)); } \
        else { _Pragma("unroll") for (int n = 0; n < 2; ++n) _Pragma("unroll") for (int k = 0; k < 2; ++k) dst[n][k] = *(const LAS bf16x8*)(lds + PG8_SB(b, h) + boff + n * 2048 + k * 1024); } } while (0)
#define PG8_MMA(ai, bj, At, Bt) do { __builtin_amdgcn_s_setprio(1); \
        if constexpr (FP8) { _Pragma("unroll") for (int m = 0; m < 4; ++m) _Pragma("unroll") for (int n = 0; n < 2; ++n) \
            asm volatile("v_mfma_scale_f32_16x16x128_f8f6f4 %0, %1, %2, %0, %3, %3 op_sel_hi:[0,0,0]" : "+v"(acc[ai][bj][m][n]) : "v"(Bt##q[n]), "v"(At##q[m]), "v"(mxs)); } \
        else { _Pragma("unroll") for (int m = 0; m < 4; ++m) _Pragma("unroll") for (int n = 0; n < 2; ++n) _Pragma("unroll") for (int k = 0; k < 2; ++k) \
            acc[ai][bj][m][n] = __builtin_amdgcn_mfma_f32_16x16x32_bf16(Bt[n][k], At[m][k], acc[ai][bj][m][n], 0, 0, 0); } \
        __builtin_amdgcn_s_setprio(0); } while (0)
#define PG8_WAIT_V(n) asm volatile("s_waitcnt vmcnt(" #n ")" ::: "memory")
#define PG8_WAIT_L(n) asm volatile("s_waitcnt lgkmcnt(" #n ")" ::: "memory")
#define PG8_BAR __builtin_amdgcn_s_barrier()
#define PG8_SCHED __builtin_amdgcn_sched_barrier(0)
    Unit cur, nxt; int ui = 0;
    if (!S.next(0, cur)) return;
    f32x4 acc[2][2][4][2];
#pragma unroll
    for (int a = 0; a < 2; ++a)
#pragma unroll
        for (int b = 0; b < 2; ++b)
#pragma unroll
            for (int m = 0; m < 4; ++m)
#pragma unroll
                for (int n = 0; n < 2; ++n) acc[a][b][m][n] = (f32x4){0.f, 0.f, 0.f, 0.f};
    int mxs = 0x7F7F7F7F; if constexpr (FP8) asm volatile("" : "+v"(mxs));
    bf16x8 At[4][2], B0[2][2], B1[2][2]; i32x8 Atq[4], B0q[2], B1q[2];
    const char* cA = GATHER ? (const char*)g.A : (const char*)g.A + (size_t)cur.pm * tstep; const char* cB = (const char*)g.Bt + (size_t)cur.pn * tstep;
    if constexpr (GATHER) {
#pragma unroll
        for (int i = 0; i < 2; ++i) { vA0[i] = S.row_off(cur, sR[i]) + (unsigned)sC[i] * 2u; vA1[i] = S.row_off(cur, HALF + sR[i]) + (unsigned)sC[i] * 2u; nvA0[i] = vA0[i]; nvA1[i] = vA1[i]; }
    }
    S.a_ready(cur);
    if constexpr (SP2) {
        PG8_STAGE(PG8_SB(0, 0), cB, voffB); PG8_STAGE(PG8_SB(0, 1), cB + hstep, voffB); PG8_STAGE(PG8_SA(0, 0), cA, vA0); PG8_STAGE(PG8_SA(0, 1), cA + ahs, vA1);
        if (wr == 1) PG8_BAR;
        PG8_WAIT_V(2); PG8_BAR;
        PG8_STAGE(PG8_SB(1, 0), cB + kstep, voffB); PG8_STAGE(PG8_SA(1, 0), cA + kstep, vA0); PG8_STAGE(PG8_SB(1, 1), cB + hstep + kstep, voffB);
        PG8_WAIT_V(6); PG8_BAR;
    } else {
        PG8_STAGE(PG8_SB(0, 0), cB, voffB); PG8_STAGE(PG8_SA(0, 0), cA, vA0); PG8_STAGE(PG8_SB(0, 1), cB + hstep, voffB); PG8_STAGE(PG8_SA(0, 1), cA + ahs, vA1);
        if (wr == 1) PG8_BAR;
        PG8_WAIT_V(4); PG8_BAR;
        PG8_STAGE(PG8_SB(1, 0), cB + kstep, voffB); PG8_STAGE(PG8_SA(1, 0), cA + kstep, vA0); PG8_STAGE(PG8_SB(1, 1), cB + hstep + kstep, voffB);
        PG8_WAIT_V(6); PG8_BAR;
    }
    for (;;) {
        const bool has_next = S.next(ui + 1, nxt);
        const char* nA = has_next ? (GATHER ? (const char*)g.A : (const char*)g.A + (size_t)nxt.pm * tstep) : cA; const char* nB = has_next ? (const char*)g.Bt + (size_t)nxt.pn * tstep : cB;
        const bool hf = S.half(cur);
        for (int t = 0; t < nt; t += 2) {
            const bool last = (t == nt - 2);
            const char* a1 = cA + (size_t)(t + 1) * kstep;
            const char* a2 = last ? nA : cA + (size_t)(t + 2) * kstep; const char* b2 = last ? nB : cB + (size_t)(t + 2) * kstep;
            const char* a3 = a2 + kstep; const char* b3 = b2 + kstep;
            if (last && has_next) S.a_ready(nxt);
            unsigned w0[2], w1[2];
            if constexpr (GATHER) {
                if (last && has_next) {
#pragma unroll
                    for (int i = 0; i < 2; ++i) { nvA0[i] = S.row_off(nxt, sR[i]) + (unsigned)sC[i] * 2u; nvA1[i] = S.row_off(nxt, HALF + sR[i]) + (unsigned)sC[i] * 2u; }
                }
#pragma unroll
                for (int i = 0; i < 2; ++i) { w0[i] = last ? nvA0[i] : vA0[i]; w1[i] = last ? nvA1[i] : vA1[i]; }
            } else {
#pragma unroll
                for (int i = 0; i < 2; ++i) { w0[i] = vA0[i]; w1[i] = vA0[i]; }
            }
            if constexpr (SP2) {
            PG8_LDB(B0, 0, 0); PG8_LDB(B1, 0, 1); PG8_SCHED; PG8_LDA(At, 0, 0); PG8_STAGE(PG8_SA(1, 1), a1 + ahs, vA1);
            PG8_WAIT_V(8); PG8_WAIT_L(0); PG8_BAR; PG8_MMA(0, 0, At, B0); PG8_MMA(0, 1, At, B1); PG8_BAR; PG8_SCHED;
            if (!hf) PG8_LDA(At, 0, 1); PG8_STAGE(PG8_SB(0, 0), b2, voffB); PG8_STAGE(PG8_SB(0, 1), b2 + hstep, voffB); PG8_STAGE(PG8_SA(0, 0), a2, w0);
            PG8_WAIT_V(8); PG8_WAIT_L(0); PG8_BAR; if (!hf) { PG8_MMA(1, 0, At, B0); PG8_MMA(1, 1, At, B1); } PG8_BAR; PG8_SCHED;
            PG8_LDB(B0, 1, 0); PG8_LDB(B1, 1, 1); PG8_SCHED; PG8_LDA(At, 1, 0); PG8_STAGE(PG8_SA(0, 1), a2 + ahs, w1);
            PG8_WAIT_V(8); PG8_WAIT_L(0); PG8_BAR; PG8_MMA(0, 0, At, B0); PG8_MMA(0, 1, At, B1); PG8_BAR; PG8_SCHED;
            if (!hf) PG8_LDA(At, 1, 1); PG8_STAGE(PG8_SB(1, 0), b3, voffB); PG8_STAGE(PG8_SB(1, 1), b3 + hstep, voffB); PG8_STAGE(PG8_SA(1, 0), a3, w0);
            PG8_WAIT_V(8); PG8_WAIT_L(0); PG8_BAR; if (!hf) { PG8_MMA(1, 0, At, B0); PG8_MMA(1, 1, At, B1); } PG8_BAR; PG8_SCHED;
            } else {
            PG8_LDB(B0, 0, 0); PG8_SCHED; PG8_LDA(At, 0, 0); PG8_STAGE(PG8_SA(1, 1), a1 + ahs, vA1);
            PG8_WAIT_L(8); PG8_BAR; PG8_WAIT_L(0); PG8_MMA(0, 0, At, B0); PG8_BAR; PG8_SCHED;
            PG8_LDB(B1, 0, 1); PG8_STAGE(PG8_SB(0, 0), b2, voffB);
            PG8_BAR; PG8_WAIT_L(0); PG8_MMA(0, 1, At, B1); PG8_BAR;
            PG8_LDA(At, 0, 1); PG8_STAGE(PG8_SA(0, 0), a2, w0);
            PG8_BAR; PG8_WAIT_L(0); PG8_MMA(1, 0, At, B0); PG8_BAR; PG8_SCHED;
            PG8_STAGE(PG8_SB(0, 1), b2 + hstep, voffB);
            PG8_WAIT_V(6); PG8_BAR; PG8_MMA(1, 1, At, B1); PG8_BAR;
            PG8_LDB(B0, 1, 0); PG8_SCHED; PG8_LDA(At, 1, 0); PG8_STAGE(PG8_SA(0, 1), a2 + ahs, w1);
            PG8_WAIT_L(8); PG8_BAR; PG8_WAIT_L(0); PG8_MMA(0, 0, At, B0); PG8_BAR; PG8_SCHED;
            PG8_LDB(B1, 1, 1); PG8_STAGE(PG8_SB(1, 0), b3, voffB);
            PG8_BAR; PG8_WAIT_L(0); PG8_MMA(0, 1, At, B1); PG8_BAR;
            PG8_LDA(At, 1, 1); PG8_STAGE(PG8_SA(1, 0), a3, w0);
            PG8_BAR; PG8_WAIT_L(0); PG8_MMA(1, 0, At, B0); PG8_BAR; PG8_SCHED;
            PG8_STAGE(PG8_SB(1, 1), b3 + hstep, voffB);
            PG8_WAIT_V(6); PG8_BAR; PG8_MMA(1, 1, At, B1); PG8_BAR;
            }
        }
        if constexpr (FP8) asm volatile("s_nop 15\n\ts_nop 15" ::: "memory");
        typename Sched::Pre pre_; S.pre(ui, pre_);
        if constexpr (ALIGN_EPI) { if (wr == 0) PG8_BAR; }
        E(acc, cur, wr, wc, fr, fq); S.done(cur); S.post(ui, pre_);
        if (!has_next) break;
#pragma unroll
        for (int a = 0; a < 2; ++a)
#pragma unroll
            for (int b = 0; b < 2; ++b)
#pragma unroll
                for (int m = 0; m < 4; ++m)
#pragma unroll
                    for (int n = 0; n < 2; ++n) acc[a][b][m][n] = (f32x4){0.f, 0.f, 0.f, 0.f};
        cur = nxt; cA = nA; cB = nB; ++ui;
        if constexpr (GATHER) {
#pragma unroll
            for (int i = 0; i < 2; ++i) { vA0[i] = nvA0[i]; vA1[i] = nvA1[i]; }
        }
        if constexpr (ALIGN_EPI) { if (wr == 1) PG8_BAR; }
    }
    PG8_WAIT_V(0);
    if constexpr (!ALIGN_EPI) { if (wr == 0) PG8_BAR; }
    PG8_BAR;
#undef PG8_SA
#undef PG8_SB
#undef PG8_STAGE
#undef PG8_LDA
#undef PG8_LDB
#undef PG8_MMA
#undef PG8_WAIT_V
#undef PG8_WAIT_L
#undef PG8_BAR
#undef PG8_SCHED
}

__device__ __forceinline__ u32x4 pack8(const f32x4 v0, const f32x4 v1) { u32x4 w; w.x = cvt_pk_bf16(v0[0], v0[1]); w.y = cvt_pk_bf16(v0[2], v0[3]); w.z = cvt_pk_bf16(v1[0], v1[1]); w.w = cvt_pk_bf16(v1[2], v1[3]); return w; }
__device__ __forceinline__ u32x2 pack8_fp8(const f32x4 v0, const f32x4 v1) { int lo = __builtin_amdgcn_cvt_pk_fp8_f32(v0[0], v0[1], 0, false); lo = __builtin_amdgcn_cvt_pk_fp8_f32(v0[2], v0[3], lo, true);
    int hi = __builtin_amdgcn_cvt_pk_fp8_f32(v1[0], v1[1], 0, false); hi = __builtin_amdgcn_cvt_pk_fp8_f32(v1[2], v1[3], hi, true); return (u32x2){(unsigned)lo, (unsigned)hi}; }
__device__ __forceinline__ void unpack8(const u32x4 w, f32x4& v0, f32x4& v1) {
    v0[0] = __uint_as_float(w.x << 16); v0[1] = __uint_as_float(w.x & 0xffff0000u); v0[2] = __uint_as_float(w.y << 16); v0[3] = __uint_as_float(w.y & 0xffff0000u);
    v1[0] = __uint_as_float(w.z << 16); v1[1] = __uint_as_float(w.z & 0xffff0000u); v1[2] = __uint_as_float(w.w << 16); v1[3] = __uint_as_float(w.w & 0xffff0000u); }

struct Epi1 {
    static constexpr bool PERM = true;
    bf16 *Zl, *GA, *UB, *V; float* VPART;
    __device__ __forceinline__ void operator()(const f32x4 (&acc)[2][2][4][2], const Unit& u, int wr, int wc, int fr, int fq) const {
        const int row0 = u.pm * BM + wr * 64 + fr, pn = u.pn;
        if (pn < 4) {
            const int col0 = pn * 256 + wc * 32 + 8 * fq;
#pragma unroll
            for (int ai = 0; ai < 2; ++ai)
#pragma unroll
                for (int m = 0; m < 4; ++m) { bf16* rowp = Zl + (size_t)(row0 + ai * HALF + m * 16) * D + col0;
#pragma unroll
                    for (int bj = 0; bj < 2; ++bj) *(u32x4*)(rowp + bj * HALF) = pack8(acc[ai][bj][m][0], acc[ai][bj][m][1]); }
        } else if (pn < 20) {
            bf16* O = pn < 12 ? GA : UB; const int uu = pn < 12 ? pn - 4 : pn - 12; const int col0 = uu * 128 + wc * 32 + 8 * fq;
#pragma unroll
            for (int ai = 0; ai < 2; ++ai)
#pragma unroll
                for (int m = 0; m < 4; ++m) { f32x4 v[2];
#pragma unroll
                    for (int n = 0; n < 2; ++n) v[n] = acc[ai][0][m][n] * vrcp(vgelu_den(acc[ai][0][m][n]) * vsigm_den(acc[ai][1][m][n]));
                    *(u32x4*)(O + (size_t)(row0 + ai * HALF + m * 16) * D + col0) = pack8(v[0], v[1]); }
        } else {
            const int col0 = (pn - 20) * 256 + wc * 32 + 8 * fq;
#pragma unroll
            for (int ai = 0; ai < 2; ++ai)
#pragma unroll
                for (int m = 0; m < 4; ++m) { const int row = row0 + ai * HALF + m * 16; f32x4 s1v = {0.f, 0.f, 0.f, 0.f}, s2v = {0.f, 0.f, 0.f, 0.f};
#pragma unroll
                    for (int bj = 0; bj < 2; ++bj) { f32x4 v[2];
#pragma unroll
                        for (int n = 0; n < 2; ++n) { v[n] = acc[ai][bj][m][n] * vrcp(vgelu_den(acc[ai][bj][m][n])); s1v += v[n]; s2v += v[n] * v[n]; }
                        *(u32x4*)(V + (size_t)row * D + col0 + bj * HALF) = pack8(v[0], v[1]); }
                    float s1 = hsum4(s1v), s2 = hsum4(s2v);
                    s1 += __shfl_xor(s1, 16); s1 += __shfl_xor(s1, 32); s2 += __shfl_xor(s2, 16); s2 += __shfl_xor(s2, 32);
                    if (fq == 0) *(f32x2*)(VPART + (size_t)row * 32 + ((pn - 20) * 4 + wc) * 2) = (f32x2){s1, s2}; }
        }
    }
};
struct EpiPlain {
    static constexpr bool PERM = true;
    bf16* O;
    __device__ __forceinline__ void operator()(const f32x4 (&acc)[2][2][4][2], const Unit& u, int wr, int wc, int fr, int fq) const {
        const int row0 = u.pm * BM + wr * 64 + fr, col0 = u.pn * 256 + wc * 32 + 8 * fq;
#pragma unroll
        for (int ai = 0; ai < 2; ++ai)
#pragma unroll
            for (int m = 0; m < 4; ++m) { bf16* rowp = O + (size_t)(row0 + ai * HALF + m * 16) * D + col0;
#pragma unroll
                for (int bj = 0; bj < 2; ++bj) *(u32x4*)(rowp + bj * HALF) = pack8(acc[ai][bj][m][0], acc[ai][bj][m][1]); }
    }
};
struct Epi2 {
    static constexpr bool PERM = true;
    const bf16* XN; const float* RI0; const float* GINV; bf16* X1b; float* SS1;
    __device__ __forceinline__ void operator()(const f32x4 (&acc)[2][2][4][2], const Unit& u, int wr, int wc, int fr, int fq) const {
        const int row0 = u.pm * BM + wr * 64 + fr, col0 = u.pn * 256 + wc * 32 + 8 * fq;
#pragma unroll
        for (int ai = 0; ai < 2; ++ai)
#pragma unroll
            for (int m = 0; m < 4; ++m) { const int row = row0 + ai * HALF + m * 16; float ss = 0.f; const float ri = RI0[row];
#pragma unroll
                for (int bj = 0; bj < 2; ++bj) { f32x4 x0, x1; unpack8(*(const u32x4*)(XN + (size_t)row * D + col0 + bj * HALF), x0, x1);
                    const f32x4 g0 = *(const f32x4*)(GINV + col0 + bj * HALF), g1 = *(const f32x4*)(GINV + col0 + bj * HALF + 4);
                    const f32x4 v0 = acc[ai][bj][m][0] + x0 * ri * g0, v1 = acc[ai][bj][m][1] + x1 * ri * g1;
                    ss += hsum4(v0 * v0 + v1 * v1);
                    *(u32x4*)(X1b + (size_t)row * D + col0 + bj * HALF) = pack8(v0, v1); }
                ss += __shfl_xor(ss, 16); ss += __shfl_xor(ss, 32);
                if (fq == 0) SS1[(size_t)row * 16 + u.pn * 4 + wc] = ss; }
    }
};
struct EpiPle {
    static constexpr bool PERM = true; static constexpr float WSC = 1.f / 32.f;
    const bf16* X2b; const bf16* PU; const float* RSTD2; bf16* X3; float* SS3;
    __device__ __forceinline__ void operator()(const f32x4 (&acc)[2][2][4][2], const Unit& u, int wr, int wc, int fr, int fq) const {
        const int row0 = u.pm * BM + wr * 64 + fr, col0 = u.pn * 256 + wc * 32 + 8 * fq;
#pragma unroll
        for (int ai = 0; ai < 2; ++ai)
#pragma unroll
            for (int m = 0; m < 4; ++m) { const int row = row0 + ai * HALF + m * 16; float ss = 0.f; const float r2n = RSTD2[row] * (-1.4426950409f * WSC);
#pragma unroll
                for (int bj = 0; bj < 2; ++bj) { const size_t o = (size_t)row * D + col0 + bj * HALF;
                    f32x4 x0, x1, p0, p1; unpack8(*(const u32x4*)(X2b + o), x0, x1); unpack8(*(const u32x4*)(PU + o), p0, p1);
                    const f32x4 v0 = x0 + vrcp(1.f + vexp2(acc[ai][bj][m][0] * r2n)) * p0, v1 = x1 + vrcp(1.f + vexp2(acc[ai][bj][m][1] * r2n)) * p1;
                    ss += hsum4(v0 * v0 + v1 * v1);
                    *(u32x4*)(X3 + o) = pack8(v0, v1); }
                ss += __shfl_xor(ss, 16); ss += __shfl_xor(ss, 32);
                if (fq == 0) SS3[(size_t)row * 16 + u.pn * 4 + wc] = ss; }
    }
};

struct EpiPleFinal {
    static constexpr bool PERM = true; static constexpr float WSC = 1.f / 32.f;
    const bf16* X2b; const bf16* PU; const float* RSTD2; const float* fn; float* out; float* XCH; unsigned* cnt; LAS float* xl; int wave;
    __device__ __forceinline__ void operator()(f32x4 (&acc)[2][2][4][2], const Unit& u, int wr, int wc, int fr, int fq) const {
        const int tid = wave * 64 + lane_id();
        const int rl0 = wr * 64 + fr, col0 = u.pn * 256 + wc * 32 + 8 * fq;
#pragma unroll
        for (int ai = 0; ai < 2; ++ai)
#pragma unroll
            for (int m = 0; m < 4; ++m) { const int rl = rl0 + ai * HALF + m * 16, row = u.pm * BM + rl; float ss = 0.f; const float r2n = RSTD2[row] * (-1.4426950409f * WSC);
#pragma unroll
                for (int bj = 0; bj < 2; ++bj) { const size_t o = (size_t)row * D + col0 + bj * HALF;
                    f32x4 x0, x1, p0, p1; unpack8(*(const u32x4*)(X2b + o), x0, x1); unpack8(*(const u32x4*)(PU + o), p0, p1);
                    const f32x4 v0 = x0 + vrcp(1.f + vexp2(acc[ai][bj][m][0] * r2n)) * p0, v1 = x1 + vrcp(1.f + vexp2(acc[ai][bj][m][1] * r2n)) * p1;
                    ss += hsum4(v0 * v0 + v1 * v1);
                    acc[ai][bj][m][0] = v0; acc[ai][bj][m][1] = v1; }
                ss += __shfl_xor(ss, 16); ss += __shfl_xor(ss, 32);
                if (fq == 0) xl[rl * 4 + wc] = ss; }
        __syncthreads();
        if (tid < 256) { const f32x4 p = *(const LAS f32x4*)(xl + tid * 4);
            __hip_atomic_store(XCH + (size_t)(u.pm * BM + tid) * 4 + u.pn, (p[0] + p[1]) + (p[2] + p[3]), __ATOMIC_RELAXED, __HIP_MEMORY_SCOPE_AGENT); }
        asm volatile("s_waitcnt vmcnt(0)" ::: "memory");
        if (tid < 256 && (tid & 63) == 0) __hip_atomic_fetch_add(cnt + 64 * u.pm, 1u, __ATOMIC_RELAXED, __HIP_MEMORY_SCOPE_AGENT);
        if (tid < 64) { unsigned sp = 0;
            while ((unsigned)__builtin_amdgcn_readfirstlane(__hip_atomic_load(cnt + 64 * u.pm, __ATOMIC_RELAXED, __HIP_MEMORY_SCOPE_AGENT)) < 16u) { if (++sp > (1u << 22)) break; __builtin_amdgcn_s_sleep(1); } }
        __syncthreads();
        if (tid < 256) { const float* xs = XCH + (size_t)(u.pm * BM + tid) * 4; float tot = 0.f;
#pragma unroll
            for (int q = 0; q < 4; ++q) tot += __hip_atomic_load(xs + q, __ATOMIC_RELAXED, __HIP_MEMORY_SCOPE_AGENT);
            xl[1024 + tid] = rsqrtf(tot * (1.f / D) + EPS); }
        __syncthreads();
#pragma unroll
        for (int ai = 0; ai < 2; ++ai)
#pragma unroll
            for (int m = 0; m < 4; ++m) { const int rl = rl0 + ai * HALF + m * 16; const float rs = xl[1024 + rl]; float* op = out + (size_t)(u.pm * BM + rl) * D + col0;
#pragma unroll
                for (int bj = 0; bj < 2; ++bj) { const f32x4 f0 = *(const f32x4*)(fn + col0 + bj * HALF), f1 = *(const f32x4*)(fn + col0 + bj * HALF + 4);
                    *(f32x4*)(op + bj * HALF) = acc[ai][bj][m][0] * rs * f0; *(f32x4*)(op + bj * HALF + 4) = acc[ai][bj][m][1] * rs * f1; } }
    }
};

template <int MODE> struct MoeOrder {
    const LAS int* tab; const int* LIST; unsigned* dcnt; unsigned rowb;
    __device__ __forceinline__ bool next(int i, Unit& u) const {
        const int n = __builtin_amdgcn_readfirstlane(tab[0]); if (i >= n) return false;
        const LAS int* p = tab + 4 + 8 * i;
        u.pm = __builtin_amdgcn_readfirstlane(p[0]); u.pn = __builtin_amdgcn_readfirstlane(p[1]); u.e = __builtin_amdgcn_readfirstlane(p[2]);
        u.tile = __builtin_amdgcn_readfirstlane(p[3]); u.cnt = __builtin_amdgcn_readfirstlane(p[4]); return true;
    }
    __device__ __forceinline__ unsigned row_off(const Unit& u, int r) const { int idx = u.tile * 256 + r; idx = idx < u.cnt ? idx : u.cnt - 1; const int pair = LIST[u.e * 16384 + idx]; return (unsigned)(pair >> 1) * rowb; }
    __device__ __forceinline__ void a_ready(const Unit&) const {}
    struct Pre {}; __device__ __forceinline__ void pre(int, Pre&) const {}
    __device__ __forceinline__ void post(int, Pre&) const {}
    __device__ __forceinline__ bool half(const Unit& u) const { return MODE == 1 && (u.cnt - u.tile * 256) <= 128; }
    __device__ __forceinline__ void done(const Unit& u) const {
        if constexpr (MODE == 1) {
            asm volatile("s_waitcnt vmcnt(0)" ::: "memory");
            if (lane_id() == 0) __hip_atomic_fetch_add(dcnt + 64 * u.pm, 1u, __ATOMIC_RELAXED, __HIP_MEMORY_SCOPE_AGENT);
        }
    }
};
__device__ __forceinline__ void store16_sc1(void* p, u32x4 v) { asm volatile("global_store_dwordx4 %0, %1, off sc1\n\ts_nop 1" :: "v"(p), "v"(v) : "memory"); }
struct EpiMoe1 {
    static constexpr bool PERM = true;
    bf16* H; const float* LISTR;
    __device__ __forceinline__ void operator()(const f32x4 (&acc)[2][2][4][2], const Unit& u, int wr, int wc, int fr, int fq) const {
        const int col0 = (u.pn & 1) * 128 + wc * 32 + 8 * fq;
#pragma unroll
        for (int ai = 0; ai < 2; ++ai)
#pragma unroll
            for (int m = 0; m < 4; ++m) { const int r = ai * HALF + wr * 64 + m * 16 + fr; int idx = u.tile * 256 + r; idx = idx < u.cnt ? idx : u.cnt - 1;
                const float rs = LISTR[u.e * 16384 + idx] * (1.f / 32.f); f32x4 v[2];
#pragma unroll
                for (int n = 0; n < 2; ++n) { const f32x4 a1 = acc[ai][0][m][n] * rs, a3 = acc[ai][1][m][n] * rs; v[n] = a1 * a3 * vrcp(vsigm_den(a1)); }
                store16_sc1(H + (size_t)(u.pm * 256 + r) * 256 + col0, pack8(v[0], v[1])); }
    }
};
struct EpiMoe2 {
    static constexpr bool PERM = true;
    bf16* Y; const int* LIST; const float* LISTG;
    __device__ __forceinline__ void operator()(const f32x4 (&acc)[2][2][4][2], const Unit& u, int wr, int wc, int fr, int fq) const {
        const int col0 = (u.pn & 3) * 256 + wc * 32 + 8 * fq;
        int pr[2][4]; float gt[2][4];
#pragma unroll
        for (int ai = 0; ai < 2; ++ai)
#pragma unroll
            for (int m = 0; m < 4; ++m) { int idx = u.tile * 256 + ai * HALF + wr * 64 + m * 16 + fr; idx = idx < u.cnt ? idx : u.cnt - 1; pr[ai][m] = LIST[u.e * 16384 + idx]; gt[ai][m] = LISTG[u.e * 16384 + idx]; }
#pragma unroll
        for (int ai = 0; ai < 2; ++ai)
#pragma unroll
            for (int m = 0; m < 4; ++m) { const int idx = u.tile * 256 + ai * HALF + wr * 64 + m * 16 + fr;
                if (idx < u.cnt) { const float g = gt[ai][m]; bf16* yp = Y + (size_t)pr[ai][m] * D + col0;
#pragma unroll
                    for (int bj = 0; bj < 2; ++bj) *(u32x4*)(yp + bj * HALF) = pack8(acc[ai][bj][m][0] * g, acc[ai][bj][m][1] * g); } }
    }
};
}

constexpr int NWAVES = 8;
constexpr int RING_BYTES = 131072, LDSCTL_OFF = 139264, MISC_OFF = LDSCTL_OFF + 320, TAB_OFF = LDSCTL_OFF + 512, LDS_BYTES = 147456;
constexpr size_t WS_WLRU = 8 * MiB + 512 * 1024;
constexpr size_t WS_WSGU = 8 * MiB + 768 * 1024;
constexpr size_t WS_WR = 9 * MiB;
constexpr size_t WS_WUP = 9 * MiB + 512 * 1024;
constexpr size_t WS_WIN = 10 * MiB;
constexpr size_t WS_WOUT = 22 * MiB;
constexpr size_t WS_WG = 24 * MiB;
constexpr size_t WS_W13 = 26 * MiB;
constexpr size_t WS_W2 = 58 * MiB;
constexpr size_t WS_PB = 234 * MiB;
constexpr size_t WS_RSTD1 = 242 * MiB;
constexpr size_t WS_RSTD0 = 242 * MiB + 128 * 1024;
constexpr size_t WS_GINV = 242 * MiB + 256 * 1024;
constexpr size_t WS_SPL8 = 242 * MiB + 512 * 1024;
constexpr size_t WS_XCH = 243 * MiB;
constexpr size_t WS_LISTG = 244 * MiB;
constexpr size_t WS_LISTR = 246 * MiB;
constexpr size_t WS_MEGA_END = 248 * MiB;
constexpr int CW_BAR = 4096;
constexpr int CW_DONE1 = 131072;
constexpr int CW_MIX = 147456;
constexpr int CW_PANEL = 65536;

typedef GAS unsigned gu32;
#define RLX_AGENT __ATOMIC_RELAXED, __HIP_MEMORY_SCOPE_AGENT
#define LDS_WAIT() asm volatile("s_waitcnt lgkmcnt(0)" ::: "memory")
#define VM_WAIT() asm volatile("s_waitcnt vmcnt(0)" ::: "memory")

#define XB_TMO      128
#define XB_XCNT(j)  (256  + 64 * (j))
#define XB_XSUB(j)  (1280 + 64 * (j))
#define XB_XGEN(j)  (2304 + 64 * (j))
#define XB_TOP      3328
#define XB_TOPGEN   3392
#define XCD_BAR_WORDS 3456
#define XB_SPIN_CAP (1u << 18)
__device__ __forceinline__ unsigned xb_ld(unsigned* p)              { return __hip_atomic_load(p, __ATOMIC_RELAXED, __HIP_MEMORY_SCOPE_AGENT); }
__device__ __forceinline__ unsigned xb_add(unsigned* p, unsigned v) { return __hip_atomic_fetch_add(p, v, __ATOMIC_RELAXED, __HIP_MEMORY_SCOPE_AGENT); }
__device__ __forceinline__ unsigned xb_xcc_id() { return (unsigned)__builtin_amdgcn_s_getreg((3 << 11) | 20) & 0xFu; }
#define XB_SPIN(cond, bar) do { unsigned _sp = 0; while (cond) { __builtin_amdgcn_s_sleep(1); \
    if ((++_sp & 255u) == 0u) { if (xb_ld(&(bar)[XB_TMO])) break; if (_sp > XB_SPIN_CAP) { atomicAdd(&(bar)[XB_TMO], 1u); break; } } } } while (0)
struct XcdBarrier { unsigned* bar; unsigned x; volatile LAS unsigned* st; int wave; };
__device__ __forceinline__ XcdBarrier xcd_barrier_post(unsigned* bar, volatile LAS unsigned* st, int wave) {
    XcdBarrier b; b.bar = bar; b.x = xb_xcc_id(); b.st = st; b.wave = wave;
    if (wave == 0 && pg8::lane_id() == 0) (void)xb_add(&bar[XB_XCNT(b.x)], 1u);
    return b;
}
__device__ __forceinline__ void xcd_barrier_complete(unsigned* bar, unsigned x, unsigned& nloc, unsigned& nx) {
    const unsigned G = gridDim.x * gridDim.y * gridDim.z;
    unsigned sum, cnt, mine, sp = 0u;
    for (;;) {
        sum = 0u; cnt = 0u; mine = 0u;
#pragma unroll
        for (unsigned j = 0; j < 16; ++j) { const unsigned c = xb_ld(&bar[XB_XCNT(j)]); sum += c; cnt += (c > 0u) ? 1u : 0u; mine = (j == x) ? c : mine; }
        if (sum == G) break;
        __builtin_amdgcn_s_sleep(1);
        if ((++sp & 255u) == 0u) { if (xb_ld(&bar[XB_TMO])) break; if (sp > XB_SPIN_CAP) { atomicAdd(&bar[XB_TMO], 1u); break; } }
    }
    nloc = mine > 0u ? mine : 1u; nx = cnt > 0u ? cnt : 1u;
}
__device__ __forceinline__ void xcd_barrier(const XcdBarrier& b) {
    asm volatile("s_waitcnt vmcnt(0)" ::: "memory");
    __syncthreads();
    if (b.wave == 0 && pg8::lane_id() == 0) {
        unsigned* bar = b.bar;
        __builtin_amdgcn_s_waitcnt(0);
        unsigned nloc = b.st[0], nx = b.st[1];
        if (nloc == 0u) { xcd_barrier_complete(bar, b.x, nloc, nx); b.st[0] = nloc; b.st[1] = nx; }
        const unsigned old = xb_add(&bar[XB_XSUB(b.x)], 1u);
        const unsigned gen = old / nloc;
        if (old + 1u == (gen + 1u) * nloc) {
            __builtin_amdgcn_fence(__ATOMIC_RELEASE, "agent");
            asm volatile("s_waitcnt vmcnt(0)" ::: "memory");
            const unsigned og = xb_add(&bar[XB_TOP], 1u);
            const unsigned tg = og / nx;
            if (og + 1u == (tg + 1u) * nx) xb_add(&bar[XB_TOPGEN], 1u);
            else XB_SPIN(xb_ld(&bar[XB_TOPGEN]) == tg, bar);
            __builtin_amdgcn_fence(__ATOMIC_ACQUIRE, "agent");
            xb_add(&bar[XB_XGEN(b.x)], 1u);
            asm volatile("s_waitcnt vmcnt(0)" ::: "memory");
        } else {
            XB_SPIN(xb_ld(&bar[XB_XGEN(b.x)]) == gen, bar);
            __builtin_amdgcn_fence(__ATOMIC_ACQUIRE, "agent");
            asm volatile("s_waitcnt vmcnt(0)" ::: "memory");
        }
    }
    __syncthreads();
}

__device__ __forceinline__ unsigned pk2(float lo, float hi) { return (unsigned)f2bf(lo) | ((unsigned)f2bf(hi) << 16); }

struct TrItem { pg8::f32x4 v[8]; };
template <bool NT = false> __device__ __forceinline__ void tr_load(TrItem& t, const float* __restrict__ W, int ldn, int k0, int n_src0, int lane) {
    const int kb = lane >> 3, n4 = lane & 7;
    const float* src = W + (size_t)(k0 + 8 * kb) * ldn + n_src0 + 4 * n4;
#pragma unroll
    for (int q = 0; q < 8; ++q) t.v[q] = NT ? __builtin_nontemporal_load((const pg8::f32x4*)(src + (size_t)q * ldn)) : *(const pg8::f32x4*)(src + (size_t)q * ldn);
}
template <bool NT = false> __device__ __forceinline__ void tr_store(TrItem& t, int k0, bf16* __restrict__ WT, int Kd, int drow0, const float* __restrict__ gk, int lane) {
    const int kb = lane >> 3, n4 = lane & 7;
    if (gk) { const pg8::f32x4 g0 = *(const pg8::f32x4*)(gk + k0 + 8 * kb), g1 = *(const pg8::f32x4*)(gk + k0 + 8 * kb + 4);
#pragma unroll
        for (int q = 0; q < 8; ++q) t.v[q] = t.v[q] * (q < 4 ? g0[q & 3] : g1[q & 3]); }
#pragma unroll
    for (int i = 0; i < 4; ++i) { pg8::u32x4 o; o.x = pk2(t.v[0][i], t.v[1][i]); o.y = pk2(t.v[2][i], t.v[3][i]); o.z = pk2(t.v[4][i], t.v[5][i]); o.w = pk2(t.v[6][i], t.v[7][i]);
        if (NT) __builtin_nontemporal_store(o, (pg8::u32x4*)(WT + (size_t)(drow0 + 4 * n4 + i) * Kd + k0 + 8 * kb)); else *(pg8::u32x4*)(WT + (size_t)(drow0 + 4 * n4 + i) * Kd + k0 + 8 * kb) = o; }
}
__device__ __forceinline__ void tr_store_fp8(TrItem& t, int k0, unsigned char* __restrict__ W8, int Kd, int drow0, const float* __restrict__ gk, float wscale, int lane) {
    const int kb = lane >> 3, n4 = lane & 7;
    pg8::f32x4 g0 = {wscale, wscale, wscale, wscale}, g1 = g0;
    if (gk) { g0 = *(const pg8::f32x4*)(gk + k0 + 8 * kb) * wscale; g1 = *(const pg8::f32x4*)(gk + k0 + 8 * kb + 4) * wscale; }
#pragma unroll
    for (int i = 0; i < 4; ++i) { const pg8::f32x4 a = {t.v[0][i] * g0[0], t.v[1][i] * g0[1], t.v[2][i] * g0[2], t.v[3][i] * g0[3]}, b = {t.v[4][i] * g1[0], t.v[5][i] * g1[1], t.v[6][i] * g1[2], t.v[7][i] * g1[3]};
        *(pg8::u32x2*)(W8 + (size_t)(drow0 + 4 * n4 + i) * Kd + k0 + 8 * kb) = pg8::pack8_fp8(a, b); }
}
__device__ __forceinline__ void p0_transpose_item(const float* __restrict__ W, int ldn, int k0, int n_src0, bf16* __restrict__ WT, int Kd, int drow0, const float* __restrict__ gk, LAS float*, int lane) {
    TrItem t; tr_load<true>(t, W, ldn, k0, n_src0, lane); tr_store(t, k0, WT, Kd, drow0, gk, lane);
}
__device__ __forceinline__ int win_dest_row(int n) {
    const int grp = n >> 10, j = n & 1023;
    switch (grp) {
        case 0: return j;
        case 1: return 1024 + (j >> 7) * 256 + (j & 127);
        case 2: return 3072 + (j >> 7) * 256 + (j & 127);
        case 3: return 5120 + j;
        case 4: return 1024 + (j >> 7) * 256 + 128 + (j & 127);
        default: return 3072 + (j >> 7) * 256 + 128 + (j & 127);
    }
}


struct DefW { const float* const* in; unsigned char* ws; };
constexpr int DF_OUT = 8 * 32, DF_E13 = 32 * 2 * 64, DF_E2 = 32 * 64, DF_G = 8 * 32, DF_UP = 2 * 32, DF_N = DF_OUT + DF_E13 + DF_E2 + DF_G + DF_UP;
struct DefDesc { const float* W; const float* gk; bf16* WT; int ldn, k0, n0, Kd, drow; };
__device__ __forceinline__ DefDesc deferred_desc(const DefW& w, int it) {
    int r = it; DefDesc d;
    if (r < DF_OUT) { const int kb = r / 16, np = r % 16; d = DefDesc{w.in[15], nullptr, (bf16*)(w.ws + WS_WOUT), 1024, kb * 64, np * 64, 1024, np * 64}; return d; } r -= DF_OUT;
    if (r < DF_E13) { const int e = r / 128, which = (r / 64) & 1, q = r % 64, kb = q / 4, np = q % 4;
        const int f0 = np * 64, drow = e * 512 + (f0 >> 7) * 256 + which * 128 + (f0 & 127);
        d = DefDesc{w.in[which ? 22 : 21] + (size_t)e * 1024 * 256, w.in[16], (bf16*)(w.ws + WS_W13), 256, kb * 64, f0, 1024, drow}; return d; } r -= DF_E13;
    if (r < DF_E2) { const int e = r / 64, q = r % 64, kb = q / 16, np = q % 16;
        d = DefDesc{w.in[23] + (size_t)e * 256 * 1024, nullptr, (bf16*)(w.ws + WS_W2), 1024, kb * 64, np * 64, 256, e * 1024 + np * 64}; return d; } r -= DF_E2;
    if (r < DF_G) { const int kb = r / 16, np = r % 16; d = DefDesc{w.in[25], w.in[24], (bf16*)(w.ws + WS_WG), 1024, kb * 64, np * 64, 1024, np * 64}; return d; } r -= DF_G;
    { const int kb = r / 16, np = r % 16; d = DefDesc{w.in[26], nullptr, (bf16*)(w.ws + WS_WUP), 1024, kb * 64, np * 64, 256, np * 64}; return d; }
}
struct Gemm1Order : pg8::StaticOrder {
    DefW w; int wave; int gi;
    struct Pre {}; __device__ __forceinline__ void pre(int, Pre&) const {}
    __device__ __forceinline__ void post(int ui, Pre&) const {
        if (ui != gi) return;
        const int lane = pg8::lane_id(), slot = c * 8 + wave, nslot = G * 8;
        for (int it = slot; it < DF_N; it += nslot) { const DefDesc d = deferred_desc(w, it); TrItem t0, t1;
            tr_load<true>(t0, d.W, d.ldn, d.k0, d.n0, lane); tr_load<true>(t1, d.W, d.ldn, d.k0, d.n0 + 32, lane);
            if ((it >= DF_OUT && it < DF_OUT + DF_E13) || (it >= DF_OUT + DF_E13 + DF_E2 && it < DF_OUT + DF_E13 + DF_E2 + DF_G)) {
                tr_store_fp8(t0, d.k0, (unsigned char*)d.WT, 1024, d.drow, d.gk, 32.f, lane); tr_store_fp8(t1, d.k0, (unsigned char*)d.WT, 1024, d.drow + 32, d.gk, 32.f, lane);
            } else { tr_store<true>(t0, d.k0, d.WT, d.Kd, d.drow, d.gk, lane); tr_store<true>(t1, d.k0, d.WT, d.Kd, d.drow + 32, d.gk, lane); } }
        const pg8::f32x4* psrc = (const pg8::f32x4*)w.in[1]; unsigned long long* pdst = (unsigned long long*)(w.ws + WS_PB);
        for (int ch = slot; ch < 8192; ch += nslot) { const size_t i0 = (size_t)ch * 128 + lane; const pg8::f32x4 v0 = __builtin_nontemporal_load(psrc + i0), v1 = __builtin_nontemporal_load(psrc + i0 + 64);
            __builtin_nontemporal_store((unsigned long long)pk2(v0.x, v0.y) | ((unsigned long long)pk2(v0.z, v0.w) << 32), pdst + i0); __builtin_nontemporal_store((unsigned long long)pk2(v1.x, v1.y) | ((unsigned long long)pk2(v1.z, v1.w) << 32), pdst + i0 + 64); }
    }
};

constexpr int MY_VT = 0, MY_XA = 32768, MY_SP = 67584, MY_WS = 102400, MY_ST = 135168, MY_RS = 272;
__device__ __forceinline__ float bflo(unsigned u) { return __uint_as_float(u << 16); }
__device__ __forceinline__ float bfhi(unsigned u) { return __uint_as_float(u & 0xffff0000u); }
template <int N> __device__ __forceinline__ float row_shr(float ident, float v) {
    return __builtin_bit_cast(float, __builtin_amdgcn_update_dpp(__builtin_bit_cast(int, ident), __builtin_bit_cast(int, v), 0x110 + N, 0xf, 0xf, false)); }
#define MX_DPP_STEP(N) \
    "v_fmac_f32_dpp %4, %4, %0 row_shr:" #N " row_mask:0xf bank_mask:0xf\n\tv_fmac_f32_dpp %5, %5, %1 row_shr:" #N " row_mask:0xf bank_mask:0xf\n\t" \
    "v_fmac_f32_dpp %6, %6, %2 row_shr:" #N " row_mask:0xf bank_mask:0xf\n\tv_fmac_f32_dpp %7, %7, %3 row_shr:" #N " row_mask:0xf bank_mask:0xf\n\t" \
    "v_mul_f32_dpp %0, %0, %0 row_shr:" #N " row_mask:0xf bank_mask:0xf\n\tv_mul_f32_dpp %1, %1, %1 row_shr:" #N " row_mask:0xf bank_mask:0xf\n\t" \
    "v_mul_f32_dpp %2, %2, %2 row_shr:" #N " row_mask:0xf bank_mask:0xf\n\tv_mul_f32_dpp %3, %3, %3 row_shr:" #N " row_mask:0xf bank_mask:0xf\n\t"
__device__ __forceinline__ void scan16x4(pg8::f32x4& A, pg8::f32x4& U) { using pg8::f32x4;
    float a0 = A[0], a1 = A[1], a2 = A[2], a3 = A[3], u0 = U[0], u1 = U[1], u2 = U[2], u3 = U[3];
    asm("s_nop 1\n\t" MX_DPP_STEP(1) MX_DPP_STEP(2) MX_DPP_STEP(4) MX_DPP_STEP(8) "s_nop 0"
        : "+v"(a0), "+v"(a1), "+v"(a2), "+v"(a3), "+v"(u0), "+v"(u1), "+v"(u2), "+v"(u3));
    A = (f32x4){a0, a1, a2, a3}; U = (f32x4){u0, u1, u2, u3};
}
__device__ __forceinline__ void mixer_phase(LAS unsigned char* lds, const int vcu, const int G, const int tid, const int lane, const int wave,
                                            const bf16* __restrict__ Zl, const bf16* __restrict__ GA, const bf16* __restrict__ UB, const bf16* __restrict__ V, const float* __restrict__ VPART,
                                            unsigned long long* AGG, bf16* __restrict__ MG, unsigned* mixc, const bf16* __restrict__ WLRU, const bf16* __restrict__ WSGU, const float* __restrict__ SPL8, const float* const* in) {
    using namespace pg8;
    constexpr int RS = MY_RS;
    constexpr float L2E = 1.4426950409f;
    const int fr = lane & 15, grp = lane >> 4, cp = tid & 63, tg = wave;
    const int pr = lane & 3, sch = lane >> 2, srow = 8 * sch + 2 * pr;
    LAS float* ST = (LAS float*)(lds + MY_ST);
    int gprev = -1;
    f32x2 cw0, cw1, cw2, cw3, ccb;
    u32x4 zqa, zqb, zqc, zqd, zqe, vv00, vv01, vv10, vv11;
#define MX_ZR(k) ((k) < 4 ? zqa[(k) & 3] : (k) < 8 ? zqb[(k) & 3] : (k) < 12 ? zqc[(k) & 3] : (k) < 16 ? zqd[(k) & 3] : zqe[(k) & 3])
#define MX_SETZR(k, v) do { if ((k) < 4) zqa[(k) & 3] = (v); else if ((k) < 8) zqb[(k) & 3] = (v); else if ((k) < 12) zqc[(k) & 3] = (v); else if ((k) < 16) zqd[(k) & 3] = (v); else zqe[(k) & 3] = (v); } while (0)
#define MX_PREFETCH(uu) do { const int ck_ = (uu) >> 3, g_ = (uu) & 7, t0_ = ck_ * 128, c0_ = g_ * 128; const bool first_ = (ck_ & 15) == 0; \
        const unsigned zo_ = ((unsigned)(t0_ + 16 * tg) * D + c0_ + 2 * cp) * 2u; \
        _Pragma("unroll") for (int k = 0; k < 19; ++k) { unsigned zv_ = 0u; if (!(k < 3 && first_ && tg == 0)) zv_ = *(const unsigned*)((const char*)Zl + (zo_ + (unsigned)((k - 3) * D * 2))); MX_SETZR(k, zv_); } \
        { const unsigned vo_ = ((unsigned)(t0_ + srow) * D + c0_ + 16 * wave) * 2u; vv00 = *(const u32x4*)((const char*)V + vo_); vv01 = *(const u32x4*)((const char*)V + (vo_ + D * 2)); vv10 = *(const u32x4*)((const char*)V + (vo_ + 16)); vv11 = *(const u32x4*)((const char*)V + (vo_ + D * 2 + 16)); } \
        } while (0)
    zqe = (u32x4){0u, 0u, 0u, 0u};
#define MX_STATS_LOAD(uu, q0, q1) do { const unsigned vpo_ = ((unsigned)(((uu) >> 3) * 128 + (tid >> 2)) * 32 + (tid & 3) * 8) * 4u; q0 = *(const f32x4*)((const char*)VPART + vpo_); q1 = *(const f32x4*)((const char*)VPART + (vpo_ + 16)); } while (0)
#define MX_STATS_WRITE(q0, q1) do { float s1 = (q0[0] + q0[2]) + (q1[0] + q1[2]), s2 = (q0[1] + q0[3]) + (q1[1] + q1[3]); \
        s1 += __shfl_xor(s1, 1); s1 += __shfl_xor(s1, 2); s2 += __shfl_xor(s2, 1); s2 += __shfl_xor(s2, 2); \
        if ((tid & 3) == 0) { const float mean = s1 * (1.f / 1024.f); float var = s2 * (1.f / 1024.f) - mean * mean; var = var < 0.f ? 0.f : var; ST[tid >> 2] = mean; ST[128 + (tid >> 2)] = rsqrtf(var + EPS); } } while (0)
    int u = vcu;
    if (u < 1024) { MX_PREFETCH(u); f32x4 q0, q1; MX_STATS_LOAD(u, q0, q1); MX_STATS_WRITE(q0, q1); }
    for (; u < 1024; u += G) {
        const int ck = u >> 3, g = u & 7, t0 = ck * 128, c0 = g * 128, j = ck & 15;
        const int cch = c0 + 16 * wave + 4 * grp;
        if (g != gprev) {
            gprev = g;
#pragma unroll
            for (int it = 0; it < 4; ++it) { const int idx = it * 512 + tid, row = idx >> 4, ch = idx & 15;
                *(LAS u32x4*)(lds + MY_WS + row * 256 + ((ch ^ (row & 15)) << 4)) = *(const u32x4*)(WSGU + ((size_t)(g * 128 + row)) * 128 + ch * 8); }
            const int cc = c0 + 2 * cp;
            cw0 = *(const f32x2*)(in[4] + cc); cw1 = *(const f32x2*)(in[4] + 1024 + cc); cw2 = *(const f32x2*)(in[4] + 2048 + cc); cw3 = *(const f32x2*)(in[4] + 3072 + cc); ccb = *(const f32x2*)(in[5] + cc);
        }
        const int hblk = 2 * g + (wave >> 2), jj0 = (16 * wave) & 63;
        const bf16x8 bw00 = *(const bf16x8*)(WLRU + ((size_t)((0 * 16 + hblk) * 64 + jj0 + fr)) * 64 + 0 * 32 + 8 * grp), bw01 = *(const bf16x8*)(WLRU + ((size_t)((0 * 16 + hblk) * 64 + jj0 + fr)) * 64 + 1 * 32 + 8 * grp);
        const bf16x8 bw10 = *(const bf16x8*)(WLRU + ((size_t)((1 * 16 + hblk) * 64 + jj0 + fr)) * 64 + 0 * 32 + 8 * grp), bw11 = *(const bf16x8*)(WLRU + ((size_t)((1 * 16 + hblk) * 64 + jj0 + fr)) * 64 + 1 * 32 + 8 * grp);
        const f32x4 nba = *(const f32x4*)(in[7] + cch) * (-L2E), nbi = *(const f32x4*)(in[9] + cch) * (-L2E), ksp = *(const f32x4*)(SPL8 + cch);
        {
#pragma unroll
            for (int i = 0; i < 16; ++i) {
                const unsigned z0 = MX_ZR(i), z1 = MX_ZR(i + 1), z2 = MX_ZR(i + 2), z3 = MX_ZR(i + 3);
                const f32x2 xv = ccb + cw0 * (f32x2){bflo(z0), bfhi(z0)} + cw1 * (f32x2){bflo(z1), bfhi(z1)} + cw2 * (f32x2){bflo(z2), bfhi(z2)} + cw3 * (f32x2){bflo(z3), bfhi(z3)};
                *(LAS unsigned*)(lds + MY_XA + (16 * tg + i) * RS + 4 * cp) = cvt_pk_bf16(xv.x, xv.y);
            }
        }
        __syncthreads();
        {
            const float mua = ST[srow], rsa = ST[128 + srow], mub = ST[srow + 1], rsb = ST[128 + srow + 1];
#pragma unroll
            for (int ci = 0; ci < 2; ++ci) { const int chunk = 2 * wave + ci, cbase = c0 + 8 * chunk;
                f32x4 a0, a1, b0, b1; unpack8(ci ? vv10 : vv00, a0, a1); unpack8(ci ? vv11 : vv01, b0, b1);
                const f32x4 g0 = *(const f32x4*)(in[11] + cbase), g1 = *(const f32x4*)(in[11] + cbase + 4), l0 = *(const f32x4*)(in[12] + cbase), l1 = *(const f32x4*)(in[12] + cbase + 4);
                a0 = (a0 - mua) * rsa * g0 + l0; a1 = (a1 - mua) * rsa * g1 + l1; b0 = (b0 - mub) * rsb * g0 + l0; b1 = (b1 - mub) * rsb * g1 + l1;
#pragma unroll
                for (int i = 0; i < 8; ++i) { const int cl = 8 * chunk + i; const float va = i < 4 ? a0[i & 3] : a1[i & 3], vb = i < 4 ? b0[i & 3] : b1[i & 3];
                    *(LAS unsigned*)(lds + MY_VT + cl * 256 + ((sch ^ (cl & 15)) << 4) + 4 * pr) = cvt_pk_bf16(va, vb); }
            }
        }
        f32x4 R[8], I[8];
#pragma unroll
        for (int mt = 0; mt < 8; ++mt) { R[mt] = (f32x4){0.f, 0.f, 0.f, 0.f}; I[mt] = (f32x4){0.f, 0.f, 0.f, 0.f};
#pragma unroll
            for (int ks = 0; ks < 2; ++ks) { const bf16x8 a = *(const LAS bf16x8*)(lds + MY_XA + (mt * 16 + fr) * RS + ((wave >> 2) * 64 + ks * 32 + 8 * grp) * 2);
                R[mt] = __builtin_amdgcn_mfma_f32_16x16x32_bf16(ks ? bw01 : bw00, a, R[mt], 0, 0, 0); I[mt] = __builtin_amdgcn_mfma_f32_16x16x32_bf16(ks ? bw11 : bw10, a, I[mt], 0, 0, 0); } }
#pragma unroll
        for (int mt = 0; mt < 8; ++mt) {
            const u32x2 xw = *(const LAS u32x2*)(lds + MY_XA + (mt * 16 + fr) * RS + (16 * wave + 4 * grp) * 2);
            const f32x4 xa4 = {bflo(xw.x), bfhi(xw.x), bflo(xw.y), bfhi(xw.y)};
            const f32x4 t1 = R[mt] * (-L2E) + nba, t2 = I[mt] * (-L2E) + nbi;
            f32x4 d1, d2, inv;
#pragma unroll
            for (int r = 0; r < 4; ++r) { d1[r] = 1.f + __builtin_amdgcn_exp2f(t1[r]); d2[r] = 1.f + __builtin_amdgcn_exp2f(t2[r]); }
            const f32x4 dd = d1 * d2;
#pragma unroll
            for (int r = 0; r < 4; ++r) inv[r] = __builtin_amdgcn_rcpf(dd[r]);
            const f32x4 rr = d2 * inv, ii = d1 * inv, la = rr * ksp;
            const f32x4 w = la * (1.f + la * (0.5f + la * (0.16666667f + la * (0.041666667f + la * 0.0083333333f))));
            f32x4 av = 1.f + w;
            const f32x4 om = -w * (2.f + w);
            f32x4 uv;
#pragma unroll
            for (int r = 0; r < 4; ++r) uv[r] = __builtin_amdgcn_sqrtf(om[r]);
            uv = uv * ii * xa4;
            scan16x4(av, uv); R[mt] = av; I[mt] = uv;
        }
        {
            f32x4 Pc = {1.f, 1.f, 1.f, 1.f}, Hc = {0.f, 0.f, 0.f, 0.f};
#pragma unroll
            for (int mt = 0; mt < 8; ++mt) { Hc = Hc * R[mt] + I[mt]; Pc = Pc * R[mt]; }
            if (fr == 15) {
#pragma unroll
                for (int r = 0; r < 4; ++r) __hip_atomic_store(AGG + (size_t)ck * 1024 + cch + r, ((unsigned long long)__float_as_uint(Hc[r]) << 32) | (unsigned long long)__float_as_uint(Pc[r]), __ATOMIC_RELAXED, __HIP_MEMORY_SCOPE_AGENT);
            }
        }
        __syncthreads();
        if (u + G < 1024) MX_PREFETCH(u + G);
        unsigned long long ag0 = 0x000000003f800000ull, ag1 = 0x000000003f800000ull, ag2 = 0x000000003f800000ull, ag3 = 0x000000003f800000ull;
        if (j > 0 && fr < j) { const unsigned long long* ap = AGG + (size_t)(ck - j + fr) * 1024 + cch;
            ag0 = __hip_atomic_load(ap, __ATOMIC_RELAXED, __HIP_MEMORY_SCOPE_AGENT); ag1 = __hip_atomic_load(ap + 1, __ATOMIC_RELAXED, __HIP_MEMORY_SCOPE_AGENT);
            ag2 = __hip_atomic_load(ap + 2, __ATOMIC_RELAXED, __HIP_MEMORY_SCOPE_AGENT); ag3 = __hip_atomic_load(ap + 3, __ATOMIC_RELAXED, __HIP_MEMORY_SCOPE_AGENT); }
        {
            bf16x8 q[4];
#pragma unroll
            for (int ks = 0; ks < 4; ++ks) q[ks] = *(const LAS bf16x8*)(lds + MY_VT + (16 * wave + fr) * 256 + (((ks * 4 + grp) ^ fr) << 4));
#pragma unroll
            for (int mt = 0; mt < 8; ++mt) { f32x4 Sx = {0.f, 0.f, 0.f, 0.f};
#pragma unroll
                for (int ks = 0; ks <= mt / 2; ++ks) { const bf16x8 p = *(const LAS bf16x8*)(lds + MY_WS + (mt * 16 + fr) * 256 + (((ks * 4 + grp) ^ fr) << 4));
                    Sx = __builtin_amdgcn_mfma_f32_16x16x32_bf16(q[ks], p, Sx, 0, 0, 0); }
                *(LAS u32x2*)(lds + MY_SP + (mt * 16 + fr) * RS + (16 * wave + 4 * grp) * 2) = (u32x2){cvt_pk_bf16_cv(Sx[0], Sx[1]), cvt_pk_bf16_cv(Sx[2], Sx[3])}; }
        }
        {
            f32x4 hc0 = {0.f, 0.f, 0.f, 0.f};
            if (j > 0) {
                f32x4 lp, lh; unsigned spin = 0;
                for (;;) {
                    lp[0] = __uint_as_float((unsigned)ag0); lh[0] = __uint_as_float((unsigned)(ag0 >> 32)); lp[1] = __uint_as_float((unsigned)ag1); lh[1] = __uint_as_float((unsigned)(ag1 >> 32));
                    lp[2] = __uint_as_float((unsigned)ag2); lh[2] = __uint_as_float((unsigned)(ag2 >> 32)); lp[3] = __uint_as_float((unsigned)ag3); lh[3] = __uint_as_float((unsigned)(ag3 >> 32));
                    const bool ok = (lp[0] != 0.f) && (lp[1] != 0.f) && (lp[2] != 0.f) && (lp[3] != 0.f);
                    if (__all(ok)) break;
                    if (++spin > (1u << 22)) break;
                    __builtin_amdgcn_s_sleep(1);
                    if (fr < j) { const unsigned long long* ap = AGG + (size_t)(ck - j + fr) * 1024 + cch;
                        ag0 = __hip_atomic_load(ap, __ATOMIC_RELAXED, __HIP_MEMORY_SCOPE_AGENT); ag1 = __hip_atomic_load(ap + 1, __ATOMIC_RELAXED, __HIP_MEMORY_SCOPE_AGENT);
                        ag2 = __hip_atomic_load(ap + 2, __ATOMIC_RELAXED, __HIP_MEMORY_SCOPE_AGENT); ag3 = __hip_atomic_load(ap + 3, __ATOMIC_RELAXED, __HIP_MEMORY_SCOPE_AGENT); } }
                scan16x4(lp, lh);
#pragma unroll
                for (int r = 0; r < 4; ++r) hc0[r] = __shfl(lh[r], (lane & 48) | 15);
            }
            f32x4 s = hc0;
#pragma unroll
            for (int mt = 0; mt < 8; ++mt) { f32x4 hb;
#pragma unroll
                for (int r = 0; r < 4; ++r) hb[r] = __shfl(s[r], (lane & 48) | 15);
                s = R[mt] * s + I[mt];
                const f32x4 hv = I[mt] + R[mt] * hb;
                *(LAS u32x2*)(lds + MY_XA + (mt * 16 + fr) * RS + (16 * wave + 4 * grp) * 2) = (u32x2){cvt_pk_bf16(hv[0], hv[1]), cvt_pk_bf16(hv[2], hv[3])}; }
        }
        u32x4 ga[4], ub[4]; float bsr[4]; f32x4 nq0 = {0.f, 0.f, 0.f, 0.f}, nq1 = {0.f, 0.f, 0.f, 0.f};
        if (u + G < 1024) MX_STATS_LOAD(u + G, nq0, nq1);
#pragma unroll
        for (int it = 0; it < 4; ++it) { const int idx = it * 512 + tid, row = idx >> 4, ch = idx & 15; const unsigned o = ((unsigned)(t0 + row) * D + c0 + ch * 8) * 2u; ga[it] = *(const u32x4*)((const char*)GA + o); ub[it] = *(const u32x4*)((const char*)UB + o); bsr[it] = in[14][g * 128 + row]; }
        __syncthreads();
#pragma unroll
        for (int it = 0; it < 4; ++it) { const int idx = it * 512 + tid, row = idx >> 4, ch = idx & 15;
            f32x4 g0, g1, u0, u1, h0, h1, s0, s1; unpack8(ga[it], g0, g1); unpack8(ub[it], u0, u1);
            unpack8(*(const LAS u32x4*)(lds + MY_XA + row * RS + ch * 16), h0, h1); unpack8(*(const LAS u32x4*)(lds + MY_SP + row * RS + ch * 16), s0, s1);
            store16_sc1((char*)MG + ((unsigned)(t0 + row) * D + c0 + ch * 8) * 2u, pack8(g0 * h0 + u0 * (s0 + bsr[it]), g1 * h1 + u1 * (s1 + bsr[it]))); }
        if (u + G < 1024) MX_STATS_WRITE(nq0, nq1);
        asm volatile("s_waitcnt vmcnt(0)" ::: "memory");
        if (lane == 0) __hip_atomic_fetch_add(mixc + 64 * (ck >> 1), 1u, __ATOMIC_RELAXED, __HIP_MEMORY_SCOPE_AGENT);
        __syncthreads();
    }
#undef MX_PREFETCH
#undef MX_STATS_LOAD
#undef MX_STATS_WRITE
#undef MX_ZR
#undef MX_SETZR
}

__device__ __forceinline__ void build_moe_units(LAS int* tab1, LAS int* tab2, LAS int* tab3, const int* CNT, int vcu, int G, int wave, LAS int* flags) {
    const int tid = wave * 64 + pg8::lane_id();
    int NT = 0, my_e = 0, my_tile = 0, my_cnt = 0, my_rt = 0;
    for (int e = 0; e < 32; ++e) { const int cnt = CNT[e]; const int ntl = (cnt + 255) >> 8;
        if (tid >= NT && tid < NT + ntl) { my_e = e; my_tile = tid - NT; my_cnt = cnt; my_rt = tid; }
        NT += ntl; }
    const bool have = tid < NT;
    const bool heavy = have && (my_cnt - my_tile * 256) > 128;
    flags[tid] = heavy ? 1 : 0;
    __syncthreads();
    int hb = 0, NH = 0;
    for (int i = 0; i < NT; ++i) { const int f = flags[i]; NH += f; hb += (i < tid) ? f : 0; }
    const int slot = heavy ? hb : NH + (tid - hb);
    const int U1 = 2 * NT, U2 = 4 * NT; int nlate = (U1 > G && U1 < 2 * G) ? U1 - G : 0; if (G - nlate < 64) nlate = 0;
    const int Ge = G - nlate, c2 = vcu - nlate, ssplit = nlate ? G / 2 : NT, Lsplit = 4 * ssplit;
    const int n1 = vcu < U1 ? (U1 - 1 - vcu) / G + 1 : 0;
    const int tot2 = (c2 >= 0 && c2 < U2) ? (U2 - 1 - c2) / Ge + 1 : 0;
    int n2 = (c2 >= 0 && c2 < Lsplit) ? (Lsplit - 1 - c2) / Ge + 1 : 0; n2 = n2 < tot2 ? n2 : tot2;
    const int n3 = tot2 - n2;
    if (tid == 0) { tab1[0] = n1 < 12 ? n1 : 12; tab2[0] = n2 < 12 ? n2 : 12; tab3[0] = n3 < 12 ? n3 : 12; }
    if (have) {
#pragma unroll
        for (int q = 0; q < 2; ++q) { const int L = 2 * slot + q; if (L % G == vcu && L / G < 12) { LAS int* p = tab1 + 4 + 8 * (L / G); p[0] = my_rt; p[1] = my_e * 2 + q; p[2] = my_e; p[3] = my_tile; p[4] = my_cnt; } }
        if (c2 >= 0) {
#pragma unroll
            for (int q = 0; q < 4; ++q) { const int L2 = 4 * slot + q; if (L2 % Ge == c2) { const int k = L2 / Ge; const bool early = slot < ssplit; const int idx = early ? k : k - n2;
                if (idx >= 0 && idx < 12) { LAS int* p = (early ? tab2 : tab3) + 4 + 8 * idx; p[0] = my_rt; p[1] = my_e * 4 + q; p[2] = my_e; p[3] = my_tile; p[4] = my_cnt; } } }
        }
    }
    __syncthreads();
}
__device__ __forceinline__ void moe_wait_tiles(const LAS int* tab, unsigned* dcnt, int wave) {
    if (wave == 0) {
        const int n = __builtin_amdgcn_readfirstlane(tab[0]);
        for (int i = 0; i < n; ++i) { const int rt = __builtin_amdgcn_readfirstlane(tab[4 + 8 * i]); unsigned sp = 0;
            while ((unsigned)__builtin_amdgcn_readfirstlane(__hip_atomic_load(dcnt + 64 * rt, __ATOMIC_RELAXED, __HIP_MEMORY_SCOPE_AGENT)) < 16u) { if (++sp > (1u << 22)) break; __builtin_amdgcn_s_sleep(2); } }
        __builtin_amdgcn_fence(__ATOMIC_ACQUIRE, "agent");
        asm volatile("s_waitcnt vmcnt(0)" ::: "memory");
    }
    __syncthreads();
}

struct Args { const float* in[28]; float* out; unsigned char* ws; int ph_lo, ph_hi, li, pad; };

__global__ void __launch_bounds__(NWAVES * 64, 2) mega_fwd(Args args) {
    extern __shared__ __attribute__((aligned(16))) unsigned char lds_raw[];
    LAS unsigned char* lds = (LAS unsigned char*)lds_raw;
    volatile LAS unsigned* MISC = (volatile LAS unsigned*)(lds + MISC_OFF);
    const int tid0 = threadIdx.x, wave = __builtin_amdgcn_readfirstlane(tid0 >> 6);
#define PHASE_IDS() int lane = pg8::lane_id(); asm volatile("" : "+v"(lane)); const int tid = wave * 64 + lane; (void)tid
    const int G = gridDim.x;
    const int vcu = (G % 8 == 0) ? ((int)blockIdx.x % 8) * (G / 8) + (int)blockIdx.x / 8 : (int)blockIdx.x;
    unsigned char* ws = args.ws;
    unsigned* ctl = (unsigned*)(ws + WS_CTL);
    for (int u = tid0; u < (LDS_BYTES - LDSCTL_OFF) / 4; u += NWAVES * 64) ((LAS unsigned*)(lds + LDSCTL_OFF))[u] = 0u;
    __syncthreads();
    XcdBarrier bar = xcd_barrier_post(ctl + CW_BAR + args.li * XCD_BAR_WORDS, MISC + 8, wave);
    const int lo = args.ph_lo, hi = args.ph_hi;
#define IN(k) (lo <= (k) && (k) < hi)
#define BOTH(k) (IN(k) && IN((k) + 1))
    const float* const* in = args.in;
    bf16 *XN = (bf16*)(ws + WS_A0), *MG = (bf16*)args.out, *X2b = (bf16*)(ws + WS_A0);
    float *RSTD0 = (float*)(ws + WS_RSTD0), *GINV = (float*)(ws + WS_GINV);
    bf16 *Zl = (bf16*)(ws + WS_A1), *X1b = (bf16*)args.out + (size_t)T * D;
    bf16 *GA = (bf16*)(ws + WS_A2), *UB = (bf16*)(ws + WS_A3), *V = (bf16*)(ws + WS_A4);
    bf16 *X3 = (bf16*)(ws + WS_A3);
    unsigned char* X1q = ws + WS_A1 + 16 * MiB;
    unsigned char* X2q = ws + WS_A1;
    bf16 *PU = (bf16*)(ws + WS_A2);
    bf16 *Pb = (bf16*)(ws + WS_PB);
    bf16 *WinT = (bf16*)(ws + WS_WIN), *WoutT = (bf16*)(ws + WS_WOUT), *WgT = (bf16*)(ws + WS_WG), *W13T = (bf16*)(ws + WS_W13), *W2T = (bf16*)(ws + WS_W2), *WupT = (bf16*)(ws + WS_WUP);
    float *VPART = (float*)(ws + WS_VPART), *SS1 = (float*)(ws + WS_SS1), *SS3 = (float*)(ws + WS_SS3), *RSTD2 = (float*)(ws + WS_RSTD2), *RSTD1 = (float*)(ws + WS_RSTD1), *LISTG = (float*)(ws + WS_LISTG), *LISTR = (float*)(ws + WS_LISTR);
    int *CNT = (int*)(ws + WS_CTL), *LIST = (int*)(ws + WS_LIST), *TOKE = (int*)(ws + WS_TOKE);
    bf16 *Hb = (bf16*)(ws + WS_A2), *Yb = (bf16*)(ws + WS_A3), *WrT = (bf16*)(ws + WS_WR), *WLRU = (bf16*)(ws + WS_WLRU), *WSGU = (bf16*)(ws + WS_WSGU);
    unsigned long long* AGGQ = (unsigned long long*)(ws + WS_AGG); float* SPL8 = (float*)(ws + WS_SPL8);

    if (IN(0)) {
        PHASE_IDS();
        LAS float* scr = (LAS float*)(lds + wave * 16384);
        const bool tab_fast = (G * 512 == 131072);
        float tf_lru = 0.f, tf_sgu = 0.f, tf10 = 0.f, tf2 = 1.f, tfr = 0.f;
        if (tab_fast) {
            const int i = vcu * 512 + tid, gate = i >> 16, h = (i >> 12) & 15, j = (i >> 6) & 63, ii = i & 63;
            const float f_lru = (gate ? in[8] : in[6])[(h * 64 + ii) * 64 + j], f_sgu = in[13][i];
            const int i10 = i < 1024 ? i : 0; const float f10 = in[10][i10], f2 = in[2][i10];
            const int n = (i >> 10) & 63, k = i & 1023; const float fa = in[17][k * 4 + (n < 4 ? n : 0)], fb = in[19][k * 32 + ((n >= 4 && n < 36) ? n - 4 : 0)], fk = in[16][k];
            tf_lru = f_lru; tf_sgu = f_sgu; tf10 = f10; tf2 = f2; tfr = n < 4 ? fa * fk : (n < 36 ? fb * fk : 0.f);
        }
        const int gw = vcu * NWAVES + wave, NGW = G * NWAVES;
        for (int it = gw; it < 16 * 192; it += NGW) { const int kb = it / 192, nb = it % 192; p0_transpose_item(in[3], 6144, kb * 64, nb * 32, WinT, 1024, win_dest_row(nb * 32), nullptr, scr, lane); }
        if (tab_fast) { const int i = vcu * 512 + tid, t = (i >> 7) & 127, s_ = i & 127;
            WLRU[i] = f2bf(tf_lru); WSGU[i] = s_ <= t ? f2bf(tf_sgu) : (bf16)0;
            if (i < 1024) { SPL8[i] = -8.f * log1pf(expf(-tf10)); GINV[i] = 1.f / tf2; }
            if (i < 64 * 1024) WrT[i] = f2bf(tfr); }
        for (int m = gw; m < T; m += 2 * NGW) {
            const int m2 = m + NGW < T ? m + NGW : m;
            const pg8::f32x4* xr = (const pg8::f32x4*)(in[0] + (size_t)m * D) + lane; const pg8::f32x4* xr2 = (const pg8::f32x4*)(in[0] + (size_t)m2 * D) + lane; const pg8::f32x4* gr = (const pg8::f32x4*)in[2] + lane;
            pg8::f32x4 v[4], w[4]; float s = 0.f, s2 = 0.f;
#pragma unroll
            for (int j = 0; j < 4; ++j) { v[j] = __builtin_nontemporal_load(xr + 64 * j); w[j] = __builtin_nontemporal_load(xr2 + 64 * j); }
#pragma unroll
            for (int j = 0; j < 4; ++j) { s += (v[j].x * v[j].x + v[j].y * v[j].y) + (v[j].z * v[j].z + v[j].w * v[j].w); s2 += (w[j].x * w[j].x + w[j].y * w[j].y) + (w[j].z * w[j].z + w[j].w * w[j].w); }
            const float rstd = rsqrtf(wave_sum(s) * (1.f / D) + EPS), rstd2 = rsqrtf(wave_sum(s2) * (1.f / D) + EPS);
            if (lane == 0) { RSTD0[m] = 1.f / rstd; RSTD0[m2] = 1.f / rstd2; }
            unsigned long long* o8 = (unsigned long long*)(XN + (size_t)m * D) + lane; unsigned long long* o82 = (unsigned long long*)(XN + (size_t)m2 * D) + lane;
#pragma unroll
            for (int j = 0; j < 4; ++j) { const pg8::f32x4 gg = gr[64 * j];
                o8[64 * j] = (unsigned long long)pk2(v[j].x * rstd * gg.x, v[j].y * rstd * gg.y) | ((unsigned long long)pk2(v[j].z * rstd * gg.z, v[j].w * rstd * gg.w) << 32);
                o82[64 * j] = (unsigned long long)pk2(w[j].x * rstd2 * gg.x, w[j].y * rstd2 * gg.y) | ((unsigned long long)pk2(w[j].z * rstd2 * gg.z, w[j].w * rstd2 * gg.w) << 32); }
        }
        if (!tab_fast) {
        for (int i = vcu * 512 + tid; i < 2 * 16 * 64 * 64; i += G * 512) { const int gate = i >> 16, h = (i >> 12) & 15, j = (i >> 6) & 63, ii = i & 63;
            WLRU[i] = f2bf(in[gate ? 8 : 6][(h * 64 + ii) * 64 + j]); }
        for (int i = vcu * 512 + tid; i < 8 * 128 * 128; i += G * 512) { const int t = (i >> 7) & 127, s = i & 127; WSGU[i] = s <= t ? f2bf(in[13][i]) : (bf16)0; }
        for (int i = vcu * 512 + tid; i < 1024; i += G * 512) { SPL8[i] = -8.f * log1pf(expf(-in[10][i])); GINV[i] = 1.f / in[2][i]; }
        for (int i = vcu * 512 + tid; i < 64 * 1024; i += G * 512) { const int n = i >> 10, k = i & 1023; float v = 0.f;
            if (n < 4) v = in[17][k * 4 + n] * in[16][k]; else if (n < 36) v = in[19][k * 32 + (n - 4)] * in[16][k];
            WrT[i] = f2bf(v); }
        }
        if (BOTH(0)) xcd_barrier(bar);
    }
    if (IN(1)) {
        { pg8::Gemm g{XN, WinT, 1024}; Gemm1Order S; S.init(T, 6144, G, (int)blockIdx.x);
          S.wave = wave; { const int upw = (64 * 24) / G > 0 ? (64 * 24) / G : 1; S.gi = (int)blockIdx.x % upw; } S.w = DefW{args.in, ws};
          pg8::Epi1 E{Zl, GA, UB, V, VPART};
          pg8::gemm_phase<pg8::Epi1, Gemm1Order, true, true, false>(lds, g, S, E, wave); }
        if (BOTH(1)) xcd_barrier(bar);
    }

    if (IN(3)) {
        PHASE_IDS();
        mixer_phase(lds, vcu, G, tid, lane, wave, Zl, GA, UB, V, VPART, AGGQ, MG, ctl + CW_MIX, WLRU, WSGU, SPL8, in);
    }
    if (IN(4)) {
        pg8::Gemm g{MG, WoutT, 1024}; pg8::StaticOrder S; S.init(T, 1024, G, (int)blockIdx.x);
        pg8::Epi2 E{XN, RSTD0, GINV, X1b, SS1};
        if (BOTH(3)) {
            if (wave == 0) { pg8::Unit u0;
                for (int i = 0; S.next(i, u0); ++i) { unsigned sp = 0;
                    while ((unsigned)__builtin_amdgcn_readfirstlane(__hip_atomic_load(ctl + CW_MIX + 64 * u0.pm, __ATOMIC_RELAXED, __HIP_MEMORY_SCOPE_AGENT)) < 128u) { if (++sp > (1u << 22)) break; __builtin_amdgcn_s_sleep(2); } }
                __builtin_amdgcn_fence(__ATOMIC_ACQUIRE, "agent");
                asm volatile("s_waitcnt vmcnt(0)" ::: "memory"); }
            __syncthreads();
        }
        pg8::gemm_phase<pg8::Epi2, pg8::StaticOrder, true, true, false>(lds, g, S, E, wave);
        if (BOTH(4)) xcd_barrier(bar);
    }

    if (IN(5)) {
        PHASE_IDS();
        constexpr int LS = 52;
        LAS float* sP = (LAS float*)lds;
        LAS float* sL = (LAS float*)(lds + 8 * 64 * LS * 4);
        LAS int* sCnt = (LAS int*)(lds + 9 * 64 * LS * 4); LAS int* sBase = sCnt + 32;
        const int fr = lane & 15, grp = lane >> 4;
        for (int tile = vcu; tile < T / 64; tile += G) {
            const int tok0 = tile * 64;
            if (tid < 32) sCnt[tid] = 0;
            pg8::bf16x8 a[4][4], b[3][4];
#pragma unroll
            for (int mt = 0; mt < 4; ++mt)
#pragma unroll
                for (int ks = 0; ks < 4; ++ks) a[mt][ks] = *(const pg8::bf16x8*)(X1b + (size_t)(tok0 + 16 * mt + fr) * D + wave * 128 + ks * 32 + 8 * grp);
#pragma unroll
            for (int nt = 0; nt < 3; ++nt)
#pragma unroll
                for (int ks = 0; ks < 4; ++ks) b[nt][ks] = *(const pg8::bf16x8*)(WrT + (size_t)(16 * nt + fr) * D + wave * 128 + ks * 32 + 8 * grp);
            pg8::f32x4 q0 = {0.f, 0.f, 0.f, 0.f}, q1 = q0, q2 = q0, q3 = q0;
#pragma unroll
            for (int mt = 0; mt < 4; ++mt)
#pragma unroll
                for (int ks = 0; ks < 4; ++ks) { pg8::f32x4 e0, e1; pg8::unpack8(__builtin_bit_cast(pg8::u32x4, a[mt][ks]), e0, e1);
                    *(pg8::u32x2*)(X1q + (size_t)(tok0 + 16 * mt + fr) * D + wave * 128 + ks * 32 + 8 * grp) = pg8::pack8_fp8(e0, e1); }
            if (tid < 64) { const float* sp = SS1 + (size_t)(tok0 + tid) * 16; q0 = *(const pg8::f32x4*)sp; q1 = *(const pg8::f32x4*)(sp + 4); q2 = *(const pg8::f32x4*)(sp + 8); q3 = *(const pg8::f32x4*)(sp + 12); }
#pragma unroll
            for (int mt = 0; mt < 4; ++mt)
#pragma unroll
                for (int nt = 0; nt < 3; ++nt) { pg8::f32x4 acc = {0.f, 0.f, 0.f, 0.f};
#pragma unroll
                    for (int ks = 0; ks < 4; ++ks) acc = __builtin_amdgcn_mfma_f32_16x16x32_bf16(a[mt][ks], b[nt][ks], acc, 0, 0, 0);
#pragma unroll
                    for (int r = 0; r < 4; ++r) sP[(wave * 64 + 16 * mt + 4 * grp + r) * LS + 16 * nt + fr] = acc[r]; }
            __syncthreads();
            { const int tk = tid >> 3, c0 = (tid & 7) * 6;
#pragma unroll
              for (int c = 0; c < 6; ++c) { float sum = 0.f;
#pragma unroll
                  for (int w = 0; w < 8; ++w) sum += sP[(w * 64 + tk) * LS + c0 + c];
                  sL[tk * LS + c0 + c] = sum; } }
            __syncthreads();
            int e1 = 0, e2 = 0, r1 = 0, r2 = 0; float g1 = 0.f, g2 = 0.f, rstd = 0.f;
            if (tid < 64) {
                const int t = tok0 + tid;
                const pg8::f32x4 qs = (q0 + q1) + (q2 + q3);
                const float ss = (qs[0] + qs[1]) + (qs[2] + qs[3]);
                rstd = rsqrtf(ss * (1.f / D) + EPS);
                const LAS float* l = sL + tid * LS;
                float gl[4];
#pragma unroll
                for (int q = 0; q < 4; ++q) gl[q] = rstd * l[q] + in[18][q];
                float mx = gl[0]; int gi = 0;
#pragma unroll
                for (int q = 1; q < 4; ++q) if (gl[q] > mx) { mx = gl[q]; gi = q; }
                float den = 0.f;
#pragma unroll
                for (int q = 0; q < 4; ++q) den += expf(gl[q] - mx);
                const float gtop = 1.f / den;
                float m1 = -3.0e38f, m2 = -3.0e38f; int i1 = 0, i2 = 0;
                for (int j = 0; j < 8; ++j) { const float v = rstd * l[4 + gi * 8 + j] + in[20][gi * 8 + j];
                    if (v > m1) { m2 = m1; i2 = i1; m1 = v; i1 = j; } else if (v > m2) { m2 = v; i2 = j; } }
                const float p2 = expf(m2 - m1);
                g1 = gtop / (1.f + p2); g2 = gtop * p2 / (1.f + p2);
                e1 = gi * 8 + i1; e2 = gi * 8 + i2;
                r1 = __hip_atomic_fetch_add(&sCnt[e1], 1, __ATOMIC_RELAXED, __HIP_MEMORY_SCOPE_WORKGROUP); r2 = __hip_atomic_fetch_add(&sCnt[e2], 1, __ATOMIC_RELAXED, __HIP_MEMORY_SCOPE_WORKGROUP);
            }
            __syncthreads();
            if (tid < 32) { const int c = sCnt[tid]; sBase[tid] = c ? atomicAdd(&CNT[tid], c) : 0; }
            __syncthreads();
            if (tid < 64) { const int t = tok0 + tid, p1 = e1 * 16384 + sBase[e1] + r1, p2 = e2 * 16384 + sBase[e2] + r2;
                LIST[p1] = t * 2; LIST[p2] = t * 2 + 1; LISTG[p1] = g1; LISTG[p2] = g2; LISTR[p1] = rstd; LISTR[p2] = rstd; }
            __syncthreads();
        }
        if (BOTH(5)) xcd_barrier(bar);
    }
    if (IN(6)) {
        LAS int* tab1 = (LAS int*)(lds + TAB_OFF); LAS int* tab2 = (LAS int*)(lds + TAB_OFF + 512); LAS int* tab3 = (LAS int*)(lds + TAB_OFF + 1024);
        build_moe_units(tab1, tab2, tab3, CNT, vcu, G, wave, (LAS int*)lds);
        unsigned* dcnt = ctl + CW_DONE1;
        { pg8::Gemm g{(const bf16*)X1q, W13T, 512}; pg8::MoeOrder<1> S{tab1, LIST, dcnt, 1024u};
          pg8::EpiMoe1 E{Hb, LISTR};
          pg8::gemm_phase<pg8::EpiMoe1, pg8::MoeOrder<1>, true, true, true, true>(lds, g, S, E, wave); }
        pg8::Gemm g2{Hb, W2T, 256}; pg8::EpiMoe2 E2{Yb, LIST, LISTG};
        moe_wait_tiles(tab2, dcnt, wave);
        { pg8::MoeOrder<0> S{tab2, LIST, dcnt, 2048u}; pg8::gemm_phase<pg8::EpiMoe2, pg8::MoeOrder<0>, true, true, false>(lds, g2, S, E2, wave); }
        moe_wait_tiles(tab3, dcnt, wave);
        { pg8::MoeOrder<0> S{tab3, LIST, dcnt, 2048u}; pg8::gemm_phase<pg8::EpiMoe2, pg8::MoeOrder<0>, true, true, false>(lds, g2, S, E2, wave); }
        if (BOTH(6)) xcd_barrier(bar);
    }
    if (IN(8)) {
        const bool split = (G % 16 == 0);
        const int q8 = (int)blockIdx.x >> 3, x8 = (int)blockIdx.x & 7;
        const bool do_gemm = !split || (q8 & 1), do_comb = !split || !(q8 & 1);
        if (do_comb) {
            PHASE_IDS();
            const int NGW = (split ? G / 2 : G) * NWAVES, gw = (split ? (q8 >> 1) * 8 + x8 : vcu) * NWAVES + wave;
            for (int row = gw; row < T; row += 2 * NGW) {
                const int row2 = row + NGW; const bool two = row2 < T; const int rb = two ? row2 : row;
                pg8::u32x4 la[2][2], lb[2][2], lc[2][2];
#pragma unroll
                for (int rr = 0; rr < 2; ++rr)
#pragma unroll
                    for (int hh = 0; hh < 2; ++hh) { const int r = rr ? rb : row;
                        la[rr][hh] = __builtin_nontemporal_load((const pg8::u32x4*)(X1b + (size_t)r * D + hh * 512 + lane * 8));
                        lb[rr][hh] = __builtin_nontemporal_load((const pg8::u32x4*)(Yb + (size_t)r * 2 * D + hh * 512 + lane * 8));
                        lc[rr][hh] = __builtin_nontemporal_load((const pg8::u32x4*)(Yb + ((size_t)r * 2 + 1) * D + hh * 512 + lane * 8)); }
#pragma unroll
                for (int rr = 0; rr < 2; ++rr) { const int r = rr ? rb : row; float ss = 0.f;
#pragma unroll
                    for (int hh = 0; hh < 2; ++hh) { pg8::f32x4 a0, a1, b0, b1, c0, c1; pg8::unpack8(la[rr][hh], a0, a1); pg8::unpack8(lb[rr][hh], b0, b1); pg8::unpack8(lc[rr][hh], c0, c1);
                        a0 = a0 + b0 + c0; a1 = a1 + b1 + c1;
                        ss += pg8::hsum4(a0 * a0 + a1 * a1);
                        if (rr == 0 || two) { *(pg8::u32x4*)(X2b + (size_t)r * D + hh * 512 + lane * 8) = pg8::pack8(a0, a1); *(pg8::u32x2*)(X2q + (size_t)r * D + hh * 512 + lane * 8) = pg8::pack8_fp8(a0, a1); } }
                    ss = wave_sum(ss);
                    if (lane == 0 && (rr == 0 || two)) RSTD2[r] = rsqrtf(ss * (1.f / D) + EPS); }
            }
        }
        if (do_gemm) {
            pg8::Gemm g{Pb, WupT, 256}; pg8::StaticOrder S; S.init(T, 1024, split ? G / 2 : G, split ? (q8 >> 1) * 8 + x8 : (int)blockIdx.x);
            pg8::EpiPlain E{PU};
            pg8::gemm_phase<pg8::EpiPlain, pg8::StaticOrder, true, true, false>(lds, g, S, E, wave);
        }
        if (BOTH(8)) xcd_barrier(bar);
    }
    const bool fuse_final = (G == 256);
    if (IN(9)) {
        pg8::Gemm g{(const bf16*)X2q, WgT, 512}; pg8::StaticOrder S; S.init(T, 1024, G, (int)blockIdx.x);
        if (fuse_final) {
            pg8::EpiPleFinal E{X2b, PU, RSTD2, in[27], args.out, (float*)(ws + WS_XCH), ctl + CW_PANEL, (LAS float*)(lds + RING_BYTES), wave};
            pg8::gemm_phase<pg8::EpiPleFinal, pg8::StaticOrder, true, true, false, true>(lds, g, S, E, wave);
        } else {
            pg8::EpiPle E{X2b, PU, RSTD2, X3, SS3};
            pg8::gemm_phase<pg8::EpiPle, pg8::StaticOrder, true, true, false, true>(lds, g, S, E, wave);
            if (BOTH(9)) xcd_barrier(bar);
        }
    }

    if (IN(10) && !fuse_final) {
        PHASE_IDS();
        const int gw = vcu * NWAVES + wave, NGW = G * NWAVES;
        for (int row = gw; row < T; row += NGW) { float ss = 0.f;
            if (lane < 16) ss = SS3[(size_t)row * 16 + lane];
            ss = wave_sum(ss);
            const float rstd = rsqrtf(ss * (1.f / D) + EPS);
#pragma unroll
            for (int hh = 0; hh < 2; ++hh) { const size_t o = (size_t)row * D + hh * 512 + lane * 8; pg8::f32x4 a0, a1; pg8::unpack8(*(const pg8::u32x4*)(X3 + o), a0, a1);
                const pg8::f32x4 f0 = *(const pg8::f32x4*)(in[27] + hh * 512 + lane * 8), f1 = *(const pg8::f32x4*)(in[27] + hh * 512 + lane * 8 + 4);
                *(pg8::f32x4*)(args.out + o) = a0 * rstd * f0; *(pg8::f32x4*)(args.out + o + 4) = a1 * rstd * f1; } }
    }
#undef IN
#undef BOTH
#undef PHASE_IDS
}

static int mega_grid() {
    static int grid = 0;
    if (grid == 0) {
        int dev = 0, cus = 0;
        if (hipGetDevice(&dev) != hipSuccess || hipDeviceGetAttribute(&cus, hipDeviceAttributeMultiprocessorCount, dev) != hipSuccess) { fprintf(stderr, "mega: device query failed\n"); grid = -1; return grid; }
        if (hipFuncSetAttribute((const void*)mega_fwd, hipFuncAttributeMaxDynamicSharedMemorySize, LDS_BYTES) != hipSuccess) { fprintf(stderr, "mega: hipFuncSetAttribute failed\n"); grid = -1; return grid; }
        (void)hipGetLastError();
        grid = cus;
    }
    return grid;
}
static void launch_mega(void* const* d_in, void* d_out, void* d_ws, int lo, int hi, int li, hipStream_t stream) {
    const int grid = mega_grid(); if (grid <= 0) return;
    Args a{};
    for (int i = 0; i < 28; ++i) a.in[i] = (const float*)d_in[i];
    a.out = (float*)d_out; a.ws = (unsigned char*)d_ws; a.ph_lo = lo; a.ph_hi = hi; a.li = li; a.pad = 0;
    hipLaunchKernelGGL(mega_fwd, dim3(grid), dim3(NWAVES * 64), LDS_BYTES, stream, a);
}

extern "C" void kernel_launch(void* const* d_in, const int* in_sizes, int n_in, void* d_out, int out_size, void* d_ws, size_t ws_size, hipStream_t stream) {
    if (n_in != 28 || in_sizes[0] != T * D || out_size != T * D || ws_size < WS_MEGA_END) { fprintf(stderr, "kernel_launch: unexpected shapes (n_in %d, ws %zu)\n", n_in, ws_size); return; }
    (void)hipMemsetAsync(d_ws, 0, 2 * MiB, stream);
    launch_mega(d_in, d_out, d_ws, 0, 11, 0, stream);
}
```

```cpp
#include <hip/hip_runtime.h>
#include <stdint.h>
#include <cstdio>

typedef unsigned short bf16;
constexpr int T = 16384, D = 1024, SEQ = 2048;
constexpr float EPS = 1e-6f;
constexpr size_t MiB = 1u << 20;
constexpr size_t WS_CTL = 0;
constexpr size_t WS_VPART = 2 * MiB;
constexpr size_t WS_SS1 = 4 * MiB;
constexpr size_t WS_SS3 = 5 * MiB;
constexpr size_t WS_AGG = 1 * MiB;
constexpr size_t WS_LIST = 6 * MiB;
constexpr size_t WS_TOKE = 8 * MiB;
constexpr size_t WS_TOKG = 8 * MiB + 128 * 1024;
constexpr size_t WS_RSTD2 = 8 * MiB + 256 * 1024;
constexpr size_t WS_A0 = 74 * MiB;
constexpr size_t WS_A1 = 106 * MiB;
constexpr size_t WS_A2 = 138 * MiB;
constexpr size_t WS_A3 = 170 * MiB;
constexpr size_t WS_A4 = 202 * MiB;
constexpr size_t WS_END = 234 * MiB;

__device__ __forceinline__ float bf2f(bf16 b) { return __uint_as_float(((unsigned)b) << 16); }
__device__ __forceinline__ bf16 f2bf(float f) { unsigned u = __float_as_uint(f); u += 0x7fffu + ((u >> 16) & 1u); return (bf16)(u >> 16); }
__device__ __forceinline__ float sigm(float x) { return 1.f / (1.f + expf(-x)); }
__device__ __forceinline__ float gelu_t(float x) { const float u = 0.7978845608028654f * (x + 0.044715f * x * x * x); return 0.5f * x * (1.f + tanhf(u)); }
__device__ __forceinline__ float wave_sum(float v) {
#pragma unroll
    for (int o = 1; o < 64; o <<= 1) v += __shfl_xor(v, o);
    return v;
}

#define LAS __attribute__((address_space(3)))
#define GAS __attribute__((address_space(1)))
namespace pg8 {
typedef short bf16x8 __attribute__((ext_vector_type(8)));
typedef float f32x4 __attribute__((ext_vector_type(4)));
typedef float f32x2 __attribute__((ext_vector_type(2)));
typedef unsigned u32x4 __attribute__((ext_vector_type(4)));
typedef unsigned u32x2 __attribute__((ext_vector_type(2)));
typedef int i32x4 __attribute__((ext_vector_type(4)));
typedef int i32x8 __attribute__((ext_vector_type(8)));
constexpr int BM = 256, BK = 64, HALF = 128, HTB = HALF * BK * 2, STAGE_BYTES = 8 * HTB, NXCD = 8, WGM = 8;

__host__ __device__ __forceinline__ int lds_byte(int r, int c) { const int st = (r >> 4) * 2 + (c >> 5), rr = r & 15, cc = c & 31, ob = rr * 64 + cc * 2; return st * 1024 + (ob ^ (((ob >> 9) & 1) << 5)); }
__host__ __device__ __forceinline__ void stage_rc(int b, int& R, int& C) { const int st = b / 1024, sb = b % 1024, swz = sb ^ (((sb >> 9) & 1) << 5); R = (st >> 1) * 16 + swz / 64; C = (st & 1) * 32 + (swz % 64) / 2; }
__host__ __device__ __forceinline__ int perm32(int rho) { const int n = rho >> 4, i = rho & 15; return 8 * (i >> 2) + 4 * n + (i & 3); }

__device__ __forceinline__ int lane_id() { int l; asm volatile("v_mbcnt_lo_u32_b32 %0, -1, 0\n\tv_mbcnt_hi_u32_b32 %0, -1, %0" : "=v"(l)); return l; }
struct Unit { int pm, pn, e, tile, cnt; };
struct Gemm { const bf16* A; const bf16* Bt; int K; };

struct StaticOrder {
    int nM, nN, nwg, G, c;
    __device__ void init(int M, int N, int G_, int c_) { nM = M / BM; nN = N / BM; nwg = nM * nN; G = G_; c = c_; }
    __device__ bool next(int i, Unit& u) const {
        const long L = (long)i * G + c; if (L >= nwg) return false;
        int wgid = (int)L; { const int q = nwg / NXCD, r = nwg % NXCD, xcd = wgid % NXCD, off = wgid / NXCD; wgid = (xcd < r ? xcd * (q + 1) : r * (q + 1) + (xcd - r) * q) + off; }
        const int nig = WGM * nN, gid = wgid / nig, fm = gid * WGM, gsz = (nM - fm) < WGM ? (nM - fm) : WGM;
        u.pm = fm + ((wgid % nig) % gsz); u.pn = (wgid % nig) / gsz; u.e = 0; u.tile = 0; u.cnt = 0; return true;
    }
    __device__ __forceinline__ unsigned row_off(const Unit&, int) const { return 0u; }
    __device__ __forceinline__ void a_ready(const Unit&) const {}
    __device__ __forceinline__ void done(const Unit&) const {}
    struct Pre {}; __device__ __forceinline__ void pre(int, Pre&) const {}
    __device__ __forceinline__ void post(int, Pre&) const {}
    __device__ __forceinline__ bool half(const Unit&) const { return false; }
};

__device__ __forceinline__ unsigned cvt_pk_bf16(float lo, float hi) { unsigned r; asm volatile("v_cvt_pk_bf16_f32 %0, %1, %2" : "=v"(r) : "v"(lo), "v"(hi)); return r; }
typedef __bf16 bf16x2_t __attribute__((ext_vector_type(2)));
__device__ __forceinline__ unsigned cvt_pk_bf16_cv(float lo, float hi) { const f32x2 v = {lo, hi}; const bf16x2_t b = __builtin_convertvector(v, bf16x2_t); return __builtin_bit_cast(unsigned, b); }
__device__ __forceinline__ float fsigm(float x) { return __builtin_amdgcn_rcpf(1.0f + __builtin_amdgcn_exp2f(-1.4426950409f * x)); }
__device__ __forceinline__ float fgelu(float x) { const float u = x + 0.044715f * x * x * x; return x * __builtin_amdgcn_rcpf(1.0f + __builtin_amdgcn_exp2f(-2.3022082f * u)); }
__device__ __forceinline__ f32x4 vexp2(const f32x4 t) { f32x4 e;
#pragma unroll
    for (int i = 0; i < 4; ++i) e[i] = __builtin_amdgcn_exp2f(t[i]);
    return e; }
__device__ __forceinline__ f32x4 vrcp(const f32x4 t) { f32x4 e;
#pragma unroll
    for (int i = 0; i < 4; ++i) e[i] = __builtin_amdgcn_rcpf(t[i]);
    return e; }
__device__ __forceinline__ f32x4 vgelu_den(const f32x4 x) { return 1.f + vexp2(x * (x * x * (-0.10294324f) + (-2.3022082f))); }
__device__ __forceinline__ f32x4 vsigm_den(const f32x4 x) { return 1.f + vexp2(x * (-1.4426950409f)); }
__device__ __forceinline__ float hsum4(const f32x4 v) { return (v[0] + v[1]) + (v[2] + v[3]); }

__device__ __forceinline__ i32x8 cat8(const bf16x8 lo, const bf16x8 hi) { const i32x4 a = __builtin_bit_cast(i32x4, lo), b = __builtin_bit_cast(i32x4, hi); return __builtin_shufflevector(a, b, 0, 1, 2, 3, 4, 5, 6, 7); }
template <class Epi, class Sched, bool ALIGN_EPI, bool SP2, bool GATHER, bool FP8 = false>
__device__ __forceinline__ void gemm_phase(LAS unsigned char* lds, const Gemm g, const Sched& S, const Epi& E, const int wave_) {
    int lane = lane_id(); asm volatile("" : "+v"(lane));
    const int wid = wave_, tid = wid * 64 + lane, wr = wid >> 2, wc = wid & 3, fr = lane & 15, fq = lane >> 4;
    int K_ = g.K; if constexpr (FP8) asm volatile("" : "+s"(K_));
    const int K = K_, nt = K / BK;
    int sR[2], sC[2];
    unsigned voffB[2], vA0[2], vA1[2], nvA0[2], nvA1[2];
#pragma unroll
    for (int i = 0; i < 2; ++i) { stage_rc(tid * 16 + i * 8192, sR[i], sC[i]); const int Rb = Epi::PERM ? ((sR[i] & ~31) + perm32(sR[i] & 31)) : sR[i];
        voffB[i] = (unsigned)(Rb * K + sC[i]) * 2u; vA0[i] = (unsigned)(sR[i] * K + sC[i]) * 2u; vA1[i] = vA0[i]; nvA0[i] = vA0[i]; nvA1[i] = vA0[i]; }
    const size_t kstep = (size_t)(BK * 2);
    const size_t hstep = (size_t)HALF * K * 2;
    const size_t tstep = 2 * hstep;
    const size_t ahs = GATHER ? 0 : hstep;
    const unsigned ldsw = (unsigned)wid * 1024u;
    const int aoff = lds_byte(wr * 64 + fr, fq * 8), boff = lds_byte(wc * 32 + fr, fq * 8);
#define PG8_SA(b, h) (((b) * 2 + (h)) * HTB)
#define PG8_SB(b, h) ((4 + (b) * 2 + (h)) * HTB)
#define PG8_STAGE(bufoff, gbase, voff) do { _Pragma("unroll") for (int _i = 0; _i < 2; ++_i) \
        __builtin_amdgcn_global_load_lds((const unsigned*)((const char*)(gbase) + (voff)[_i]), (LAS unsigned*)(lds + (bufoff) + ldsw + _i * 8192), 16, 0, 0); } while (0)
#define PG8_LDA(dst, b, h) do { if constexpr (FP8) { _Pragma("unroll") for (int m = 0; m < 4; ++m) dst##q[m] = cat8(*(const LAS bf16x8*)(lds + PG8_SA(b, h) + aoff + m * 2048), *(const LAS bf16x8*)(lds + PG8_SA(b, h) + aoff + m * 2048 + 1024)); } \
        else { _Pragma("unroll") for (int m = 0; m < 4; ++m) _Pragma("unroll") for (int k = 0; k < 2; ++k) dst[m][k] = *(const LAS bf16x8*)(lds + PG8_SA(b, h) + aoff + m * 2048 + k * 1024); } } while (0)
#define PG8_LDB(dst, b, h) do { if constexpr (FP8) { _Pragma("unroll") for (int n = 0; n < 2; ++n) dst##q[n] = cat8(*(const LAS bf16x8*)(lds + PG8_SB(b, h) + boff + n * 2048), *(const LAS bf16x8*)(lds + PG8_SB(b, h) + boff + n * 2048 + 1024)); } \
        else { _Pragma("unroll") for (int n = 0; n < 2; ++n) _Pragma("unroll") for (int k = 0; k < 2; ++k) dst[n][k] = *(const LAS bf16x8*)(lds + PG8_SB(b, h) + boff + n * 2048 + k * 1024); } } while (0)
#define PG8_MMA(ai, bj, At, Bt) do { __builtin_amdgcn_s_setprio(1); \
        if constexpr (FP8) { _Pragma("unroll") for (int m = 0; m < 4; ++m) _Pragma("unroll") for (int n = 0; n < 2; ++n) \
            asm volatile("v_mfma_scale_f32_16x16x128_f8f6f4 %0, %1, %2, %0, %3, %3 op_sel_hi:[0,0,0]" : "+v"(acc[ai][bj][m][n]) : "v"(Bt##q[n]), "v"(At##q[m]), "v"(mxs)); } \
        else { _Pragma("unroll") for (int m = 0; m < 4; ++m) _Pragma("unroll") for (int n = 0; n < 2; ++n) _Pragma("unroll") for (int k = 0; k < 2; ++k) \
            acc[ai][bj][m][n] = __builtin_amdgcn_mfma_f32_16x16x32_bf16(Bt[n][k], At[m][k], acc[ai][bj][m][n], 0, 0, 0); } \
        __builtin_amdgcn_s_setprio(0); } while (0)
#define PG8_WAIT_V(n) asm volatile("s_waitcnt vmcnt(" #n ")" ::: "memory")
#define PG8_WAIT_L(n) asm volatile("s_waitcnt lgkmcnt(" #n ")" ::: "memory")
#define PG8_BAR __builtin_amdgcn_s_barrier()
#define PG8_SCHED __builtin_amdgcn_sched_barrier(0)
    Unit cur, nxt; int ui = 0;
    if (!S.next(0, cur)) return;
    f32x4 acc[2][2][4][2];
#pragma unroll
    for (int a = 0; a < 2; ++a)
#pragma unroll
        for (int b = 0; b < 2; ++b)
#pragma unroll
            for (int m = 0; m < 4; ++m)
#pragma unroll
                for (int n = 0; n < 2; ++n) acc[a][b][m][n] = (f32x4){0.f, 0.f, 0.f, 0.f};
    int mxs = 0x7F7F7F7F; if constexpr (FP8) asm volatile("" : "+v"(mxs));
    bf16x8 At[4][2], B0[2][2], B1[2][2]; i32x8 Atq[4], B0q[2], B1q[2];
    const char* cA = GATHER ? (const char*)g.A : (const char*)g.A + (size_t)cur.pm * tstep; const char* cB = (const char*)g.Bt + (size_t)cur.pn * tstep;
    if constexpr (GATHER) {
#pragma unroll
        for (int i = 0; i < 2; ++i) { vA0[i] = S.row_off(cur, sR[i]) + (unsigned)sC[i] * 2u; vA1[i] = S.row_off(cur, HALF + sR[i]) + (unsigned)sC[i] * 2u; nvA0[i] = vA0[i]; nvA1[i] = vA1[i]; }
    }
    S.a_ready(cur);
    if constexpr (SP2) {
        PG8_STAGE(PG8_SB(0, 0), cB, voffB); PG8_STAGE(PG8_SB(0, 1), cB + hstep, voffB); PG8_STAGE(PG8_SA(0, 0), cA, vA0); PG8_STAGE(PG8_SA(0, 1), cA + ahs, vA1);
        if (wr == 1) PG8_BAR;
        PG8_WAIT_V(2); PG8_BAR;
        PG8_STAGE(PG8_SB(1, 0), cB + kstep, voffB); PG8_STAGE(PG8_SA(1, 0), cA + kstep, vA0); PG8_STAGE(PG8_SB(1, 1), cB + hstep + kstep, voffB);
        PG8_WAIT_V(6); PG8_BAR;
    } else {
        PG8_STAGE(PG8_SB(0, 0), cB, voffB); PG8_STAGE(PG8_SA(0, 0), cA, vA0); PG8_STAGE(PG8_SB(0, 1), cB + hstep, voffB); PG8_STAGE(PG8_SA(0, 1), cA + ahs, vA1);
        if (wr == 1) PG8_BAR;
        PG8_WAIT_V(4); PG8_BAR;
        PG8_STAGE(PG8_SB(1, 0), cB + kstep, voffB); PG8_STAGE(PG8_SA(1, 0), cA + kstep, vA0); PG8_STAGE(PG8_SB(1, 1), cB + hstep + kstep, voffB);
        PG8_WAIT_V(6); PG8_BAR;
    }
    for (;;) {
        const bool has_next = S.next(ui + 1, nxt);
        const char* nA = has_next ? (GATHER ? (const char*)g.A : (const char*)g.A + (size_t)nxt.pm * tstep) : cA; const char* nB = has_next ? (const char*)g.Bt + (size_t)nxt.pn * tstep : cB;
        const bool hf = S.half(cur);
        for (int t = 0; t < nt; t += 2) {
            const bool last = (t == nt - 2);
            const char* a1 = cA + (size_t)(t + 1) * kstep;
            const char* a2 = last ? nA : cA + (size_t)(t + 2) * kstep; const char* b2 = last ? nB : cB + (size_t)(t + 2) * kstep;
            const char* a3 = a2 + kstep; const char* b3 = b2 + kstep;
            if (last && has_next) S.a_ready(nxt);
            unsigned w0[2], w1[2];
            if constexpr (GATHER) {
                if (last && has_next) {
#pragma unroll
                    for (int i = 0; i < 2; ++i) { nvA0[i] = S.row_off(nxt, sR[i]) + (unsigned)sC[i] * 2u; nvA1[i] = S.row_off(nxt, HALF + sR[i]) + (unsigned)sC[i] * 2u; }
                }
#pragma unroll
                for (int i = 0; i < 2; ++i) { w0[i] = last ? nvA0[i] : vA0[i]; w1[i] = last ? nvA1[i] : vA1[i]; }
            } else {
#pragma unroll
                for (int i = 0; i < 2; ++i) { w0[i] = vA0[i]; w1[i] = vA0[i]; }
            }
            if constexpr (SP2) {
            PG8_LDB(B0, 0, 0); PG8_LDB(B1, 0, 1); PG8_SCHED; PG8_LDA(At, 0, 0); PG8_STAGE(PG8_SA(1, 1), a1 + ahs, vA1);
            PG8_WAIT_V(8); PG8_WAIT_L(0); PG8_BAR; PG8_MMA(0, 0, At, B0); PG8_MMA(0, 1, At, B1); PG8_BAR; PG8_SCHED;
            if (!hf) PG8_LDA(At, 0, 1); PG8_STAGE(PG8_SB(0, 0), b2, voffB); PG8_STAGE(PG8_SB(0, 1), b2 + hstep, voffB); PG8_STAGE(PG8_SA(0, 0), a2, w0);
            PG8_WAIT_V(8); PG8_WAIT_L(0); PG8_BAR; if (!hf) { PG8_MMA(1, 0, At, B0); PG8_MMA(1, 1, At, B1); } PG8_BAR; PG8_SCHED;
            PG8_LDB(B0, 1, 0); PG8_LDB(B1, 1, 1); PG8_SCHED; PG8_LDA(At, 1, 0); PG8_STAGE(PG8_SA(0, 1), a2 + ahs, w1);
            PG8_WAIT_V(8); PG8_WAIT_L(0); PG8_BAR; PG8_MMA(0, 0, At, B0); PG8_MMA(0, 1, At, B1); PG8_BAR; PG8_SCHED;
            if (!hf) PG8_LDA(At, 1, 1); PG8_STAGE(PG8_SB(1, 0), b3, voffB); PG8_STAGE(PG8_SB(1, 1), b3 + hstep, voffB); PG8_STAGE(PG8_SA(1, 0), a3, w0);
            PG8_WAIT_V(8); PG8_WAIT_L(0); PG8_BAR; if (!hf) { PG8_MMA(1, 0, At, B0); PG8_MMA(1, 1, At, B1); } PG8_BAR; PG8_SCHED;
            } else {
            PG8_LDB(B0, 0, 0); PG8_SCHED; PG8_LDA(At, 0, 0); PG8_STAGE(PG8_SA(1, 1), a1 + ahs, vA1);
            PG8_WAIT_L(8); PG8_BAR; PG8_WAIT_L(0); PG8_MMA(0, 0, At, B0); PG8_BAR; PG8_SCHED;
            PG8_LDB(B1, 0, 1); PG8_STAGE(PG8_SB(0, 0), b2, voffB);
            PG8_BAR; PG8_WAIT_L(0); PG8_MMA(0, 1, At, B1); PG8_BAR;
            PG8_LDA(At, 0, 1); PG8_STAGE(PG8_SA(0, 0), a2, w0);
            PG8_BAR; PG8_WAIT_L(0); PG8_MMA(1, 0, At, B0); PG8_BAR; PG8_SCHED;
            PG8_STAGE(PG8_SB(0, 1), b2 + hstep, voffB);
            PG8_WAIT_V(6); PG8_BAR; PG8_MMA(1, 1, At, B1); PG8_BAR;
            PG8_LDB(B0, 1, 0); PG8_SCHED; PG8_LDA(At, 1, 0); PG8_STAGE(PG8_SA(0, 1), a2 + ahs, w1);
            PG8_WAIT_L(8); PG8_BAR; PG8_WAIT_L(0); PG8_MMA(0, 0, At, B0); PG8_BAR; PG8_SCHED;
            PG8_LDB(B1, 1, 1); PG8_STAGE(PG8_SB(1, 0), b3, voffB);
            PG8_BAR; PG8_WAIT_L(0); PG8_MMA(0, 1, At, B1); PG8_BAR;
            PG8_LDA(At, 1, 1); PG8_STAGE(PG8_SA(1, 0), a3, w0);
            PG8_BAR; PG8_WAIT_L(0); PG8_MMA(1, 0, At, B0); PG8_BAR; PG8_SCHED;
            PG8_STAGE(PG8_SB(1, 1), b3 + hstep, voffB);
            PG8_WAIT_V(6); PG8_BAR; PG8_MMA(1, 1, At, B1); PG8_BAR;
            }
        }
        if constexpr (FP8) asm volatile("s_nop 15\n\ts_nop 15" ::: "memory");
        typename Sched::Pre pre_; S.pre(ui, pre_);
        if constexpr (ALIGN_EPI) { if (wr == 0) PG8_BAR; }
        E(acc, cur, wr, wc, fr, fq); S.done(cur); S.post(ui, pre_);
        if (!has_next) break;
#pragma unroll
        for (int a = 0; a < 2; ++a)
#pragma unroll
            for (int b = 0; b < 2; ++b)
#pragma unroll
                for (int m = 0; m < 4; ++m)
#pragma unroll
                    for (int n = 0; n < 2; ++n) acc[a][b][m][n] = (f32x4){0.f, 0.f, 0.f, 0.f};
        cur = nxt; cA = nA; cB = nB; ++ui;
        if constexpr (GATHER) {
#pragma unroll
            for (int i = 0; i < 2; ++i) { vA0[i] = nvA0[i]; vA1[i] = nvA1[i]; }
        }
        if constexpr (ALIGN_EPI) { if (wr == 1) PG8_BAR; }
    }
    PG8_WAIT_V(0);
    if constexpr (!ALIGN_EPI) { if (wr == 0) PG8_BAR; }
    PG8_BAR;
#undef PG8_SA
#undef PG8_SB
#undef PG8_STAGE
#undef PG8_LDA
#undef PG8_LDB
#undef PG8_MMA
#undef PG8_WAIT_V
#undef PG8_WAIT_L
#undef PG8_BAR
#undef PG8_SCHED
}

__device__ __forceinline__ u32x4 pack8(const f32x4 v0, const f32x4 v1) { u32x4 w; w.x = cvt_pk_bf16(v0[0], v0[1]); w.y = cvt_pk_bf16(v0[2], v0[3]); w.z = cvt_pk_bf16(v1[0], v1[1]); w.w = cvt_pk_bf16(v1[2], v1[3]); return w; }
__device__ __forceinline__ u32x2 pack8_fp8(const f32x4 v0, const f32x4 v1) { int lo = __builtin_amdgcn_cvt_pk_fp8_f32(v0[0], v0[1], 0, false); lo = __builtin_amdgcn_cvt_pk_fp8_f32(v0[2], v0[3], lo, true);
    int hi = __builtin_amdgcn_cvt_pk_fp8_f32(v1[0], v1[1], 0, false); hi = __builtin_amdgcn_cvt_pk_fp8_f32(v1[2], v1[3], hi, true); return (u32x2){(unsigned)lo, (unsigned)hi}; }
__device__ __forceinline__ void unpack8(const u32x4 w, f32x4& v0, f32x4& v1) {
    v0[0] = __uint_as_float(w.x << 16); v0[1] = __uint_as_float(w.x & 0xffff0000u); v0[2] = __uint_as_float(w.y << 16); v0[3] = __uint_as_float(w.y & 0xffff0000u);
    v1[0] = __uint_as_float(w.z << 16); v1[1] = __uint_as_float(w.z & 0xffff0000u); v1[2] = __uint_as_float(w.w << 16); v1[3] = __uint_as_float(w.w & 0xffff0000u); }

struct Epi1 {
    static constexpr bool PERM = true;
    bf16 *Zl, *GA, *UB, *V; float* VPART;
    __device__ __forceinline__ void operator()(const f32x4 (&acc)[2][2][4][2], const Unit& u, int wr, int wc, int fr, int fq) const {
        const int row0 = u.pm * BM + wr * 64 + fr, pn = u.pn;
        if (pn < 4) {
            const int col0 = pn * 256 + wc * 32 + 8 * fq;
#pragma unroll
            for (int ai = 0; ai < 2; ++ai)
#pragma unroll
                for (int m = 0; m < 4; ++m) { bf16* rowp = Zl + (size_t)(row0 + ai * HALF + m * 16) * D + col0;
#pragma unroll
                    for (int bj = 0; bj < 2; ++bj) *(u32x4*)(rowp + bj * HALF) = pack8(acc[ai][bj][m][0], acc[ai][bj][m][1]); }
        } else if (pn < 20) {
            bf16* O = pn < 12 ? GA : UB; const int uu = pn < 12 ? pn - 4 : pn - 12; const int col0 = uu * 128 + wc * 32 + 8 * fq;
#pragma unroll
            for (int ai = 0; ai < 2; ++ai)
#pragma unroll
                for (int m = 0; m < 4; ++m) { f32x4 v[2];
#pragma unroll
                    for (int n = 0; n < 2; ++n) v[n] = acc[ai][0][m][n] * vrcp(vgelu_den(acc[ai][0][m][n]) * vsigm_den(acc[ai][1][m][n]));
                    *(u32x4*)(O + (size_t)(row0 + ai * HALF + m * 16) * D + col0) = pack8(v[0], v[1]); }
        } else {
            const int col0 = (pn - 20) * 256 + wc * 32 + 8 * fq;
#pragma unroll
            for (int ai = 0; ai < 2; ++ai)
#pragma unroll
                for (int m = 0; m < 4; ++m) { const int row = row0 + ai * HALF + m * 16; f32x4 s1v = {0.f, 0.f, 0.f, 0.f}, s2v = {0.f, 0.f, 0.f, 0.f};
#pragma unroll
                    for (int bj = 0; bj < 2; ++bj) { f32x4 v[2];
#pragma unroll
                        for (int n = 0; n < 2; ++n) { v[n] = acc[ai][bj][m][n] * vrcp(vgelu_den(acc[ai][bj][m][n])); s1v += v[n]; s2v += v[n] * v[n]; }
                        *(u32x4*)(V + (size_t)row * D + col0 + bj * HALF) = pack8(v[0], v[1]); }
                    float s1 = hsum4(s1v), s2 = hsum4(s2v);
                    s1 += __shfl_xor(s1, 16); s1 += __shfl_xor(s1, 32); s2 += __shfl_xor(s2, 16); s2 += __shfl_xor(s2, 32);
                    if (fq == 0) *(f32x2*)(VPART + (size_t)row * 32 + ((pn - 20) * 4 + wc) * 2) = (f32x2){s1, s2}; }
        }
    }
};
struct EpiPlain {
    static constexpr bool PERM = true;
    bf16* O;
    __device__ __forceinline__ void operator()(const f32x4 (&acc)[2][2][4][2], const Unit& u, int wr, int wc, int fr, int fq) const {
        const int row0 = u.pm * BM + wr * 64 + fr, col0 = u.pn * 256 + wc * 32 + 8 * fq;
#pragma unroll
        for (int ai = 0; ai < 2; ++ai)
#pragma unroll
            for (int m = 0; m < 4; ++m) { bf16* rowp = O + (size_t)(row0 + ai * HALF + m * 16) * D + col0;
#pragma unroll
                for (int bj = 0; bj < 2; ++bj) *(u32x4*)(rowp + bj * HALF) = pack8(acc[ai][bj][m][0], acc[ai][bj][m][1]); }
    }
};
struct Epi2 {
    static constexpr bool PERM = true;
    const bf16* XN; const float* RI0; const float* GINV; bf16* X1b; float* SS1;
    __device__ __forceinline__ void operator()(const f32x4 (&acc)[2][2][4][2], const Unit& u, int wr, int wc, int fr, int fq) const {
        const int row0 = u.pm * BM + wr * 64 + fr, col0 = u.pn * 256 + wc * 32 + 8 * fq;
#pragma unroll
        for (int ai = 0; ai < 2; ++ai)
#pragma unroll
            for (int m = 0; m < 4; ++m) { const int row = row0 + ai * HALF + m * 16; float ss = 0.f; const float ri = RI0[row];
#pragma unroll
                for (int bj = 0; bj < 2; ++bj) { f32x4 x0, x1; unpack8(*(const u32x4*)(XN + (size_t)row * D + col0 + bj * HALF), x0, x1);
                    const f32x4 g0 = *(const f32x4*)(GINV + col0 + bj * HALF), g1 = *(const f32x4*)(GINV + col0 + bj * HALF + 4);
                    const f32x4 v0 = acc[ai][bj][m][0] + x0 * ri * g0, v1 = acc[ai][bj][m][1] + x1 * ri * g1;
                    ss += hsum4(v0 * v0 + v1 * v1);
                    *(u32x4*)(X1b + (size_t)row * D + col0 + bj * HALF) = pack8(v0, v1); }
                ss += __shfl_xor(ss, 16); ss += __shfl_xor(ss, 32);
                if (fq == 0) SS1[(size_t)row * 16 + u.pn * 4 + wc] = ss; }
    }
};
struct EpiPle {
    static constexpr bool PERM = true; static constexpr float WSC = 1.f / 32.f;
    const bf16* X2b; const bf16* PU; const float* RSTD2; bf16* X3; float* SS3;
    __device__ __forceinline__ void operator()(const f32x4 (&acc)[2][2][4][2], const Unit& u, int wr, int wc, int fr, int fq) const {
        const int row0 = u.pm * BM + wr * 64 + fr, col0 = u.pn * 256 + wc * 32 + 8 * fq;
#pragma unroll
        for (int ai = 0; ai < 2; ++ai)
#pragma unroll
            for (int m = 0; m < 4; ++m) { const int row = row0 + ai * HALF + m * 16; float ss = 0.f; const float r2n = RSTD2[row] * (-1.4426950409f * WSC);
#pragma unroll
                for (int bj = 0; bj < 2; ++bj) { const size_t o = (size_t)row * D + col0 + bj * HALF;
                    f32x4 x0, x1, p0, p1; unpack8(*(const u32x4*)(X2b + o), x0, x1); unpack8(*(const u32x4*)(PU + o), p0, p1);
                    const f32x4 v0 = x0 + vrcp(1.f + vexp2(acc[ai][bj][m][0] * r2n)) * p0, v1 = x1 + vrcp(1.f + vexp2(acc[ai][bj][m][1] * r2n)) * p1;
                    ss += hsum4(v0 * v0 + v1 * v1);
                    *(u32x4*)(X3 + o) = pack8(v0, v1); }
                ss += __shfl_xor(ss, 16); ss += __shfl_xor(ss, 32);
                if (fq == 0) SS3[(size_t)row * 16 + u.pn * 4 + wc] = ss; }
    }
};

struct EpiPleFinal {
    static constexpr bool PERM = true; static constexpr float WSC = 1.f / 32.f;
    const bf16* X2b; const bf16* PU; const float* RSTD2; const float* fn; float* out; float* XCH; unsigned* cnt; LAS float* xl; int wave;
    __device__ __forceinline__ void operator()(f32x4 (&acc)[2][2][4][2], const Unit& u, int wr, int wc, int fr, int fq) const {
        const int tid = wave * 64 + lane_id();
        const int rl0 = wr * 64 + fr, col0 = u.pn * 256 + wc * 32 + 8 * fq;
#pragma unroll
        for (int ai = 0; ai < 2; ++ai)
#pragma unroll
            for (int m = 0; m < 4; ++m) { const int rl = rl0 + ai * HALF + m * 16, row = u.pm * BM + rl; float ss = 0.f; const float r2n = RSTD2[row] * (-1.4426950409f * WSC);
#pragma unroll
                for (int bj = 0; bj < 2; ++bj) { const size_t o = (size_t)row * D + col0 + bj * HALF;
                    f32x4 x0, x1, p0, p1; unpack8(*(const u32x4*)(X2b + o), x0, x1); unpack8(*(const u32x4*)(PU + o), p0, p1);
                    const f32x4 v0 = x0 + vrcp(1.f + vexp2(acc[ai][bj][m][0] * r2n)) * p0, v1 = x1 + vrcp(1.f + vexp2(acc[ai][bj][m][1] * r2n)) * p1;
                    ss += hsum4(v0 * v0 + v1 * v1);
                    acc[ai][bj][m][0] = v0; acc[ai][bj][m][1] = v1; }
                ss += __shfl_xor(ss, 16); ss += __shfl_xor(ss, 32);
                if (fq == 0) xl[rl * 4 + wc] = ss; }
        __syncthreads();
        if (tid < 256) { const f32x4 p = *(const LAS f32x4*)(xl + tid * 4);
            __hip_atomic_store(XCH + (size_t)(u.pm * BM + tid) * 4 + u.pn, (p[0] + p[1]) + (p[2] + p[3]), __ATOMIC_RELAXED, __HIP_MEMORY_SCOPE_AGENT); }
        asm volatile("s_waitcnt vmcnt(0)" ::: "memory");
        if (tid < 256 && (tid & 63) == 0) __hip_atomic_fetch_add(cnt + 64 * u.pm, 1u, __ATOMIC_RELAXED, __HIP_MEMORY_SCOPE_AGENT);
        if (tid < 64) { unsigned sp = 0;
            while ((unsigned)__builtin_amdgcn_readfirstlane(__hip_atomic_load(cnt + 64 * u.pm, __ATOMIC_RELAXED, __HIP_MEMORY_SCOPE_AGENT)) < 16u) { if (++sp > (1u << 22)) break; __builtin_amdgcn_s_sleep(1); } }
        __syncthreads();
        if (tid < 256) { const float* xs = XCH + (size_t)(u.pm * BM + tid) * 4; float tot = 0.f;
#pragma unroll
            for (int q = 0; q < 4; ++q) tot += __hip_atomic_load(xs + q, __ATOMIC_RELAXED, __HIP_MEMORY_SCOPE_AGENT);
            xl[1024 + tid] = rsqrtf(tot * (1.f / D) + EPS); }
        __syncthreads();
#pragma unroll
        for (int ai = 0; ai < 2; ++ai)
#pragma unroll
            for (int m = 0; m < 4; ++m) { const int rl = rl0 + ai * HALF + m * 16; const float rs = xl[1024 + rl]; float* op = out + (size_t)(u.pm * BM + rl) * D + col0;
#pragma unroll
                for (int bj = 0; bj < 2; ++bj) { const f32x4 f0 = *(const f32x4*)(fn + col0 + bj * HALF), f1 = *(const f32x4*)(fn + col0 + bj * HALF + 4);
                    *(f32x4*)(op + bj * HALF) = acc[ai][bj][m][0] * rs * f0; *(f32x4*)(op + bj * HALF + 4) = acc[ai][bj][m][1] * rs * f1; } }
    }
};

template <int MODE> struct MoeOrder {
    const LAS int* tab; const int* LIST; unsigned* dcnt; unsigned rowb;
    __device__ __forceinline__ bool next(int i, Unit& u) const {
        const int n = __builtin_amdgcn_readfirstlane(tab[0]); if (i >= n) return false;
        const LAS int* p = tab + 4 + 8 * i;
        u.pm = __builtin_amdgcn_readfirstlane(p[0]); u.pn = __builtin_amdgcn_readfirstlane(p[1]); u.e = __builtin_amdgcn_readfirstlane(p[2]);
        u.tile = __builtin_amdgcn_readfirstlane(p[3]); u.cnt = __builtin_amdgcn_readfirstlane(p[4]); return true;
    }
    __device__ __forceinline__ unsigned row_off(const Unit& u, int r) const { int idx = u.tile * 256 + r; idx = idx < u.cnt ? idx : u.cnt - 1; const int pair = LIST[u.e * 16384 + idx]; return (unsigned)(pair >> 1) * rowb; }
    __device__ __forceinline__ void a_ready(const Unit&) const {}
    struct Pre {}; __device__ __forceinline__ void pre(int, Pre&) const {}
    __device__ __forceinline__ void post(int, Pre&) const {}
    __device__ __forceinline__ bool half(const Unit& u) const { return MODE == 1 && (u.cnt - u.tile * 256) <= 128; }
    __device__ __forceinline__ void done(const Unit& u) const {
        if constexpr (MODE == 1) {
            asm volatile("s_waitcnt vmcnt(0)" ::: "memory");
            if (lane_id() == 0) __hip_atomic_fetch_add(dcnt + 64 * u.pm, 1u, __ATOMIC_RELAXED, __HIP_MEMORY_SCOPE_AGENT);
        }
    }
};
__device__ __forceinline__ void store16_sc1(void* p, u32x4 v) { asm volatile("global_store_dwordx4 %0, %1, off sc1\n\ts_nop 1" :: "v"(p), "v"(v) : "memory"); }
__device__ __forceinline__ void store8_sc1(void* p, u32x2 v) { asm volatile("global_store_dwordx2 %0, %1, off sc1\n\ts_nop 1" :: "v"(p), "v"(v) : "memory"); }
struct EpiMoe1 {
    static constexpr bool PERM = true;
    unsigned char* H; const float* LISTR;
    __device__ __forceinline__ void operator()(const f32x4 (&acc)[2][2][4][2], const Unit& u, int wr, int wc, int fr, int fq) const {
        const int col0 = (u.pn & 1) * 128 + wc * 32 + 8 * fq;
#pragma unroll
        for (int ai = 0; ai < 2; ++ai)
#pragma unroll
            for (int m = 0; m < 4; ++m) { const int r = ai * HALF + wr * 64 + m * 16 + fr; int idx = u.tile * 256 + r; idx = idx < u.cnt ? idx : u.cnt - 1;
                const float rs = LISTR[u.e * 16384 + idx] * (1.f / 32.f); f32x4 v[2];
#pragma unroll
                for (int n = 0; n < 2; ++n) { const f32x4 a1 = acc[ai][0][m][n] * rs, a3 = acc[ai][1][m][n] * rs; v[n] = a1 * a3 * vrcp(vsigm_den(a1)); }
                store8_sc1(H + (size_t)(u.pm * 256 + r) * 256 + col0, pack8_fp8(v[0], v[1])); }
    }
};
struct EpiMoe2 {
    static constexpr bool PERM = true;
    bf16* Y; const int* LIST; const float* LISTG;
    __device__ __forceinline__ void operator()(const f32x4 (&acc)[2][2][4][2], const Unit& u, int wr, int wc, int fr, int fq) const {
        const int col0 = (u.pn & 3) * 256 + wc * 32 + 8 * fq;
        int pr[2][4]; float gt[2][4];
#pragma unroll
        for (int ai = 0; ai < 2; ++ai)
#pragma unroll
            for (int m = 0; m < 4; ++m) { int idx = u.tile * 256 + ai * HALF + wr * 64 + m * 16 + fr; idx = idx < u.cnt ? idx : u.cnt - 1; pr[ai][m] = LIST[u.e * 16384 + idx]; gt[ai][m] = LISTG[u.e * 16384 + idx]; }
#pragma unroll
        for (int ai = 0; ai < 2; ++ai)
#pragma unroll
            for (int m = 0; m < 4; ++m) { const int idx = u.tile * 256 + ai * HALF + wr * 64 + m * 16 + fr;
                if (idx < u.cnt) { const float g = gt[ai][m] * (1.f / 16.f); bf16* yp = Y + (size_t)pr[ai][m] * D + col0;
#pragma unroll
                    for (int bj = 0; bj < 2; ++bj) *(u32x4*)(yp + bj * HALF) = pack8(acc[ai][bj][m][0] * g, acc[ai][bj][m][1] * g); } }
    }
};
}

constexpr int NWAVES = 8;
constexpr int RING_BYTES = 131072, LDSCTL_OFF = 139264, MISC_OFF = LDSCTL_OFF + 320, TAB_OFF = LDSCTL_OFF + 512, LDS_BYTES = 147456;
constexpr size_t WS_WLRU = 8 * MiB + 512 * 1024;
constexpr size_t WS_WSGU = 8 * MiB + 768 * 1024;
constexpr size_t WS_WR = 9 * MiB;
constexpr size_t WS_WUP = 9 * MiB + 512 * 1024;
constexpr size_t WS_WIN = 10 * MiB;
constexpr size_t WS_WOUT = 22 * MiB;
constexpr size_t WS_WG = 24 * MiB;
constexpr size_t WS_W13 = 26 * MiB;
constexpr size_t WS_W2 = 58 * MiB;
constexpr size_t WS_PB = 234 * MiB;
constexpr size_t WS_RSTD1 = 242 * MiB;
constexpr size_t WS_RSTD0 = 242 * MiB + 128 * 1024;
constexpr size_t WS_GINV = 242 * MiB + 256 * 1024;
constexpr size_t WS_SPL8 = 242 * MiB + 512 * 1024;
constexpr size_t WS_XCH = 243 * MiB;
constexpr size_t WS_LISTG = 244 * MiB;
constexpr size_t WS_LISTR = 246 * MiB;
constexpr size_t WS_MEGA_END = 248 * MiB;
constexpr int CW_BAR = 4096;
constexpr int CW_DONE1 = 131072;
constexpr int CW_MIX = 147456;
constexpr int CW_PANEL = 65536;

typedef GAS unsigned gu32;
#define RLX_AGENT __ATOMIC_RELAXED, __HIP_MEMORY_SCOPE_AGENT
#define LDS_WAIT() asm volatile("s_waitcnt lgkmcnt(0)" ::: "memory")
#define VM_WAIT() asm volatile("s_waitcnt vmcnt(0)" ::: "memory")

#define XB_TMO      128
#define XB_XCNT(j)  (256  + 64 * (j))
#define XB_XSUB(j)  (1280 + 64 * (j))
#define XB_XGEN(j)  (2304 + 64 * (j))
#define XB_TOP      3328
#define XB_TOPGEN   3392
#define XCD_BAR_WORDS 3456
#define XB_SPIN_CAP (1u << 18)
__device__ __forceinline__ unsigned xb_ld(unsigned* p)              { return __hip_atomic_load(p, __ATOMIC_RELAXED, __HIP_MEMORY_SCOPE_AGENT); }
__device__ __forceinline__ unsigned xb_add(unsigned* p, unsigned v) { return __hip_atomic_fetch_add(p, v, __ATOMIC_RELAXED, __HIP_MEMORY_SCOPE_AGENT); }
__device__ __forceinline__ unsigned xb_xcc_id() { return (unsigned)__builtin_amdgcn_s_getreg((3 << 11) | 20) & 0xFu; }
#define XB_SPIN(cond, bar) do { unsigned _sp = 0; while (cond) { __builtin_amdgcn_s_sleep(1); \
    if ((++_sp & 255u) == 0u) { if (xb_ld(&(bar)[XB_TMO])) break; if (_sp > XB_SPIN_CAP) { atomicAdd(&(bar)[XB_TMO], 1u); break; } } } } while (0)
struct XcdBarrier { unsigned* bar; unsigned x; volatile LAS unsigned* st; int wave; };
__device__ __forceinline__ XcdBarrier xcd_barrier_post(unsigned* bar, volatile LAS unsigned* st, int wave) {
    XcdBarrier b; b.bar = bar; b.x = xb_xcc_id(); b.st = st; b.wave = wave;
    if (wave == 0 && pg8::lane_id() == 0) (void)xb_add(&bar[XB_XCNT(b.x)], 1u);
    return b;
}
__device__ __forceinline__ void xcd_barrier_complete(unsigned* bar, unsigned x, unsigned& nloc, unsigned& nx) {
    const unsigned G = gridDim.x * gridDim.y * gridDim.z;
    unsigned sum, cnt, mine, sp = 0u;
    for (;;) {
        sum = 0u; cnt = 0u; mine = 0u;
#pragma unroll
        for (unsigned j = 0; j < 16; ++j) { const unsigned c = xb_ld(&bar[XB_XCNT(j)]); sum += c; cnt += (c > 0u) ? 1u : 0u; mine = (j == x) ? c : mine; }
        if (sum == G) break;
        __builtin_amdgcn_s_sleep(1);
        if ((++sp & 255u) == 0u) { if (xb_ld(&bar[XB_TMO])) break; if (sp > XB_SPIN_CAP) { atomicAdd(&bar[XB_TMO], 1u); break; } }
    }
    nloc = mine > 0u ? mine : 1u; nx = cnt > 0u ? cnt : 1u;
}
__device__ __forceinline__ void xcd_barrier(const XcdBarrier& b) {
    asm volatile("s_waitcnt vmcnt(0)" ::: "memory");
    __syncthreads();
    if (b.wave == 0 && pg8::lane_id() == 0) {
        unsigned* bar = b.bar;
        __builtin_amdgcn_s_waitcnt(0);
        unsigned nloc = b.st[0], nx = b.st[1];
        if (nloc == 0u) { xcd_barrier_complete(bar, b.x, nloc, nx); b.st[0] = nloc; b.st[1] = nx; }
        const unsigned old = xb_add(&bar[XB_XSUB(b.x)], 1u);
        const unsigned gen = old / nloc;
        if (old + 1u == (gen + 1u) * nloc) {
            __builtin_amdgcn_fence(__ATOMIC_RELEASE, "agent");
            asm volatile("s_waitcnt vmcnt(0)" ::: "memory");
            const unsigned og = xb_add(&bar[XB_TOP], 1u);
            const unsigned tg = og / nx;
            if (og + 1u == (tg + 1u) * nx) xb_add(&bar[XB_TOPGEN], 1u);
            else XB_SPIN(xb_ld(&bar[XB_TOPGEN]) == tg, bar);
            __builtin_amdgcn_fence(__ATOMIC_ACQUIRE, "agent");
            xb_add(&bar[XB_XGEN(b.x)], 1u);
            asm volatile("s_waitcnt vmcnt(0)" ::: "memory");
        } else {
            XB_SPIN(xb_ld(&bar[XB_XGEN(b.x)]) == gen, bar);
            __builtin_amdgcn_fence(__ATOMIC_ACQUIRE, "agent");
            asm volatile("s_waitcnt vmcnt(0)" ::: "memory");
        }
    }
    __syncthreads();
}

__device__ __forceinline__ unsigned pk2(float lo, float hi) { return (unsigned)f2bf(lo) | ((unsigned)f2bf(hi) << 16); }

struct TrItem { pg8::f32x4 v[8]; };
template <bool NT = false> __device__ __forceinline__ void tr_load(TrItem& t, const float* __restrict__ W, int ldn, int k0, int n_src0, int lane) {
    const int kb = lane >> 3, n4 = lane & 7;
    const float* src = W + (size_t)(k0 + 8 * kb) * ldn + n_src0 + 4 * n4;
#pragma unroll
    for (int q = 0; q < 8; ++q) t.v[q] = NT ? __builtin_nontemporal_load((const pg8::f32x4*)(src + (size_t)q * ldn)) : *(const pg8::f32x4*)(src + (size_t)q * ldn);
}
template <bool NT = false> __device__ __forceinline__ void tr_store(TrItem& t, int k0, bf16* __restrict__ WT, int Kd, int drow0, const float* __restrict__ gk, int lane) {
    const int kb = lane >> 3, n4 = lane & 7;
    if (gk) { const pg8::f32x4 g0 = *(const pg8::f32x4*)(gk + k0 + 8 * kb), g1 = *(const pg8::f32x4*)(gk + k0 + 8 * kb + 4);
#pragma unroll
        for (int q = 0; q < 8; ++q) t.v[q] = t.v[q] * (q < 4 ? g0[q & 3] : g1[q & 3]); }
#pragma unroll
    for (int i = 0; i < 4; ++i) { pg8::u32x4 o; o.x = pk2(t.v[0][i], t.v[1][i]); o.y = pk2(t.v[2][i], t.v[3][i]); o.z = pk2(t.v[4][i], t.v[5][i]); o.w = pk2(t.v[6][i], t.v[7][i]);
        if (NT) __builtin_nontemporal_store(o, (pg8::u32x4*)(WT + (size_t)(drow0 + 4 * n4 + i) * Kd + k0 + 8 * kb)); else *(pg8::u32x4*)(WT + (size_t)(drow0 + 4 * n4 + i) * Kd + k0 + 8 * kb) = o; }
}
__device__ __forceinline__ void tr_store_fp8(TrItem& t, int k0, unsigned char* __restrict__ W8, int Kd, int drow0, const float* __restrict__ gk, float wscale, int lane) {
    const int kb = lane >> 3, n4 = lane & 7;
    pg8::f32x4 g0 = {wscale, wscale, wscale, wscale}, g1 = g0;
    if (gk) { g0 = *(const pg8::f32x4*)(gk + k0 + 8 * kb) * wscale; g1 = *(const pg8::f32x4*)(gk + k0 + 8 * kb + 4) * wscale; }
#pragma unroll
    for (int i = 0; i < 4; ++i) { const pg8::f32x4 a = {t.v[0][i] * g0[0], t.v[1][i] * g0[1], t.v[2][i] * g0[2], t.v[3][i] * g0[3]}, b = {t.v[4][i] * g1[0], t.v[5][i] * g1[1], t.v[6][i] * g1[2], t.v[7][i] * g1[3]};
        *(pg8::u32x2*)(W8 + (size_t)(drow0 + 4 * n4 + i) * Kd + k0 + 8 * kb) = pg8::pack8_fp8(a, b); }
}
__device__ __forceinline__ void p0_transpose_item(const float* __restrict__ W, int ldn, int k0, int n_src0, bf16* __restrict__ WT, int Kd, int drow0, const float* __restrict__ gk, LAS float*, int lane) {
    TrItem t; tr_load<true>(t, W, ldn, k0, n_src0, lane); tr_store(t, k0, WT, Kd, drow0, gk, lane);
}
__device__ __forceinline__ int win_dest_row(int n) {
    const int grp = n >> 10, j = n & 1023;
    switch (grp) {
        case 0: return j;
        case 1: return 1024 + (j >> 7) * 256 + (j & 127);
        case 2: return 3072 + (j >> 7) * 256 + (j & 127);
        case 3: return 5120 + j;
        case 4: return 1024 + (j >> 7) * 256 + 128 + (j & 127);
        default: return 3072 + (j >> 7) * 256 + 128 + (j & 127);
    }
}


struct DefW { const float* const* in; unsigned char* ws; };
constexpr int DF_OUT = 8 * 32, DF_E13 = 32 * 2 * 64, DF_E2 = 32 * 64, DF_G = 8 * 32, DF_UP = 2 * 32, DF_N = DF_OUT + DF_E13 + DF_E2 + DF_G + DF_UP;
struct DefDesc { const float* W; const float* gk; bf16* WT; int ldn, k0, n0, Kd, drow; };
__device__ __forceinline__ DefDesc deferred_desc(const DefW& w, int it) {
    int r = it; DefDesc d;
    if (r < DF_OUT) { const int kb = r / 16, np = r % 16; d = DefDesc{w.in[15], nullptr, (bf16*)(w.ws + WS_WOUT), 1024, kb * 64, np * 64, 1024, np * 64}; return d; } r -= DF_OUT;
    if (r < DF_E13) { const int e = r / 128, which = (r / 64) & 1, q = r % 64, kb = q / 4, np = q % 4;
        const int f0 = np * 64, drow = e * 512 + (f0 >> 7) * 256 + which * 128 + (f0 & 127);
        d = DefDesc{w.in[which ? 22 : 21] + (size_t)e * 1024 * 256, w.in[16], (bf16*)(w.ws + WS_W13), 256, kb * 64, f0, 1024, drow}; return d; } r -= DF_E13;
    if (r < DF_E2) { const int e = r / 64, q = r % 64, kb = q / 16, np = q % 16;
        d = DefDesc{w.in[23] + (size_t)e * 256 * 1024, nullptr, (bf16*)(w.ws + WS_W2), 1024, kb * 64, np * 64, 256, e * 1024 + np * 64}; return d; } r -= DF_E2;
    if (r < DF_G) { const int kb = r / 16, np = r % 16; d = DefDesc{w.in[25], w.in[24], (bf16*)(w.ws + WS_WG), 1024, kb * 64, np * 64, 1024, np * 64}; return d; } r -= DF_G;
    { const int kb = r / 16, np = r % 16; d = DefDesc{w.in[26], nullptr, (bf16*)(w.ws + WS_WUP), 1024, kb * 64, np * 64, 256, np * 64}; return d; }
}
struct Gemm1Order : pg8::StaticOrder {
    DefW w; int wave; int gi;
    struct Pre {}; __device__ __forceinline__ void pre(int, Pre&) const {}
    __device__ __forceinline__ void post(int ui, Pre&) const {
        if (ui != gi) return;
        const int lane = pg8::lane_id(), slot = c * 8 + wave, nslot = G * 8;
        for (int it = slot; it < DF_N; it += nslot) { const DefDesc d = deferred_desc(w, it); TrItem t0, t1;
            tr_load<true>(t0, d.W, d.ldn, d.k0, d.n0, lane); tr_load<true>(t1, d.W, d.ldn, d.k0, d.n0 + 32, lane);
            if ((it >= DF_OUT && it < DF_OUT + DF_E13) || (it >= DF_OUT + DF_E13 + DF_E2 && it < DF_OUT + DF_E13 + DF_E2 + DF_G)) {
                tr_store_fp8(t0, d.k0, (unsigned char*)d.WT, 1024, d.drow, d.gk, 32.f, lane); tr_store_fp8(t1, d.k0, (unsigned char*)d.WT, 1024, d.drow + 32, d.gk, 32.f, lane);
            } else if (it >= DF_OUT + DF_E13 && it < DF_OUT + DF_E13 + DF_E2) {
                tr_store_fp8(t0, d.k0, (unsigned char*)d.WT, 256, d.drow, nullptr, 16.f, lane); tr_store_fp8(t1, d.k0, (unsigned char*)d.WT, 256, d.drow + 32, nullptr, 16.f, lane);
            } else { tr_store<true>(t0, d.k0, d.WT, d.Kd, d.drow, d.gk, lane); tr_store<true>(t1, d.k0, d.WT, d.Kd, d.drow + 32, d.gk, lane); } }
        const pg8::f32x4* psrc = (const pg8::f32x4*)w.in[1]; unsigned long long* pdst = (unsigned long long*)(w.ws + WS_PB);
        for (int ch = slot; ch < 8192; ch += nslot) { const size_t i0 = (size_t)ch * 128 + lane; const pg8::f32x4 v0 = __builtin_nontemporal_load(psrc + i0), v1 = __builtin_nontemporal_load(psrc + i0 + 64);
            __builtin_nontemporal_store((unsigned long long)pk2(v0.x, v0.y) | ((unsigned long long)pk2(v0.z, v0.w) << 32), pdst + i0); __builtin_nontemporal_store((unsigned long long)pk2(v1.x, v1.y) | ((unsigned long long)pk2(v1.z, v1.w) << 32), pdst + i0 + 64); }
    }
};

constexpr int MY_VT = 0, MY_XA = 32768, MY_SP = 67584, MY_WS = 102400, MY_ST = 135168, MY_RS = 272;
__device__ __forceinline__ float bflo(unsigned u) { return __uint_as_float(u << 16); }
__device__ __forceinline__ float bfhi(unsigned u) { return __uint_as_float(u & 0xffff0000u); }
template <int N> __device__ __forceinline__ float row_shr(float ident, float v) {
    return __builtin_bit_cast(float, __builtin_amdgcn_update_dpp(__builtin_bit_cast(int, ident), __builtin_bit_cast(int, v), 0x110 + N, 0xf, 0xf, false)); }
#define MX_DPP_STEP(N) \
    "v_fmac_f32_dpp %4, %4, %0 row_shr:" #N " row_mask:0xf bank_mask:0xf\n\tv_fmac_f32_dpp %5, %5, %1 row_shr:" #N " row_mask:0xf bank_mask:0xf\n\t" \
    "v_fmac_f32_dpp %6, %6, %2 row_shr:" #N " row_mask:0xf bank_mask:0xf\n\tv_fmac_f32_dpp %7, %7, %3 row_shr:" #N " row_mask:0xf bank_mask:0xf\n\t" \
    "v_mul_f32_dpp %0, %0, %0 row_shr:" #N " row_mask:0xf bank_mask:0xf\n\tv_mul_f32_dpp %1, %1, %1 row_shr:" #N " row_mask:0xf bank_mask:0xf\n\t" \
    "v_mul_f32_dpp %2, %2, %2 row_shr:" #N " row_mask:0xf bank_mask:0xf\n\tv_mul_f32_dpp %3, %3, %3 row_shr:" #N " row_mask:0xf bank_mask:0xf\n\t"
__device__ __forceinline__ void scan16x4(pg8::f32x4& A, pg8::f32x4& U) { using pg8::f32x4;
    float a0 = A[0], a1 = A[1], a2 = A[2], a3 = A[3], u0 = U[0], u1 = U[1], u2 = U[2], u3 = U[3];
    asm("s_nop 1\n\t" MX_DPP_STEP(1) MX_DPP_STEP(2) MX_DPP_STEP(4) MX_DPP_STEP(8) "s_nop 0"
        : "+v"(a0), "+v"(a1), "+v"(a2), "+v"(a3), "+v"(u0), "+v"(u1), "+v"(u2), "+v"(u3));
    A = (f32x4){a0, a1, a2, a3}; U = (f32x4){u0, u1, u2, u3};
}
__device__ __forceinline__ void mixer_phase(LAS unsigned char* lds, const int vcu, const int G, const int tid, const int lane, const int wave,
                                            const bf16* __restrict__ Zl, const bf16* __restrict__ GA, const bf16* __restrict__ UB, const bf16* __restrict__ V, const float* __restrict__ VPART,
                                            unsigned long long* AGG, bf16* __restrict__ MG, unsigned* mixc, const bf16* __restrict__ WLRU, const bf16* __restrict__ WSGU, const float* __restrict__ SPL8, const float* const* in) {
    using namespace pg8;
    constexpr int RS = MY_RS;
    constexpr float L2E = 1.4426950409f;
    const int fr = lane & 15, grp = lane >> 4, cp = tid & 63, tg = wave;
    const int pr = lane & 3, sch = lane >> 2, srow = 8 * sch + 2 * pr;
    LAS float* ST = (LAS float*)(lds + MY_ST);
    int gprev = -1;
    f32x2 cw0, cw1, cw2, cw3, ccb;
    u32x4 zqa, zqb, zqc, zqd, zqe, vv00, vv01, vv10, vv11;
#define MX_ZR(k) ((k) < 4 ? zqa[(k) & 3] : (k) < 8 ? zqb[(k) & 3] : (k) < 12 ? zqc[(k) & 3] : (k) < 16 ? zqd[(k) & 3] : zqe[(k) & 3])
#define MX_SETZR(k, v) do { if ((k) < 4) zqa[(k) & 3] = (v); else if ((k) < 8) zqb[(k) & 3] = (v); else if ((k) < 12) zqc[(k) & 3] = (v); else if ((k) < 16) zqd[(k) & 3] = (v); else zqe[(k) & 3] = (v); } while (0)
#define MX_PREFETCH(uu) do { const int ck_ = (uu) >> 3, g_ = (uu) & 7, t0_ = ck_ * 128, c0_ = g_ * 128; const bool first_ = (ck_ & 15) == 0; \
        const unsigned zo_ = ((unsigned)(t0_ + 16 * tg) * D + c0_ + 2 * cp) * 2u; \
        _Pragma("unroll") for (int k = 0; k < 19; ++k) { unsigned zv_ = 0u; if (!(k < 3 && first_ && tg == 0)) zv_ = *(const unsigned*)((const char*)Zl + (zo_ + (unsigned)((k - 3) * D * 2))); MX_SETZR(k, zv_); } \
        { const unsigned vo_ = ((unsigned)(t0_ + srow) * D + c0_ + 16 * wave) * 2u; vv00 = *(const u32x4*)((const char*)V + vo_); vv01 = *(const u32x4*)((const char*)V + (vo_ + D * 2)); vv10 = *(const u32x4*)((const char*)V + (vo_ + 16)); vv11 = *(const u32x4*)((const char*)V + (vo_ + D * 2 + 16)); } \
        } while (0)
    zqe = (u32x4){0u, 0u, 0u, 0u};
#define MX_STATS_LOAD(uu, q0, q1) do { const unsigned vpo_ = ((unsigned)(((uu) >> 3) * 128 + (tid >> 2)) * 32 + (tid & 3) * 8) * 4u; q0 = *(const f32x4*)((const char*)VPART + vpo_); q1 = *(const f32x4*)((const char*)VPART + (vpo_ + 16)); } while (0)
#define MX_STATS_WRITE(q0, q1) do { float s1 = (q0[0] + q0[2]) + (q1[0] + q1[2]), s2 = (q0[1] + q0[3]) + (q1[1] + q1[3]); \
        s1 += __shfl_xor(s1, 1); s1 += __shfl_xor(s1, 2); s2 += __shfl_xor(s2, 1); s2 += __shfl_xor(s2, 2); \
        if ((tid & 3) == 0) { const float mean = s1 * (1.f / 1024.f); float var = s2 * (1.f / 1024.f) - mean * mean; var = var < 0.f ? 0.f : var; ST[tid >> 2] = mean; ST[128 + (tid >> 2)] = rsqrtf(var + EPS); } } while (0)
    int u = vcu;
    if (u < 1024) { MX_PREFETCH(u); f32x4 q0, q1; MX_STATS_LOAD(u, q0, q1); MX_STATS_WRITE(q0, q1); }
    for (; u < 1024; u += G) {
        const int ck = u >> 3, g = u & 7, t0 = ck * 128, c0 = g * 128, j = ck & 15;
        const int cch = c0 + 16 * wave + 4 * grp;
        if (g != gprev) {
            gprev = g;
#pragma unroll
            for (int it = 0; it < 4; ++it) { const int idx = it * 512 + tid, row = idx >> 4, ch = idx & 15;
                *(LAS u32x4*)(lds + MY_WS + row * 256 + ((ch ^ (row & 15)) << 4)) = *(const u32x4*)(WSGU + ((size_t)(g * 128 + row)) * 128 + ch * 8); }
            const int cc = c0 + 2 * cp;
            cw0 = *(const f32x2*)(in[4] + cc); cw1 = *(const f32x2*)(in[4] + 1024 + cc); cw2 = *(const f32x2*)(in[4] + 2048 + cc); cw3 = *(const f32x2*)(in[4] + 3072 + cc); ccb = *(const f32x2*)(in[5] + cc);
        }
        const int hblk = 2 * g + (wave >> 2), jj0 = (16 * wave) & 63;
        const bf16x8 bw00 = *(const bf16x8*)(WLRU + ((size_t)((0 * 16 + hblk) * 64 + jj0 + fr)) * 64 + 0 * 32 + 8 * grp), bw01 = *(const bf16x8*)(WLRU + ((size_t)((0 * 16 + hblk) * 64 + jj0 + fr)) * 64 + 1 * 32 + 8 * grp);
        const bf16x8 bw10 = *(const bf16x8*)(WLRU + ((size_t)((1 * 16 + hblk) * 64 + jj0 + fr)) * 64 + 0 * 32 + 8 * grp), bw11 = *(const bf16x8*)(WLRU + ((size_t)((1 * 16 + hblk) * 64 + jj0 + fr)) * 64 + 1 * 32 + 8 * grp);
        const f32x4 nba = *(const f32x4*)(in[7] + cch) * (-L2E), nbi = *(const f32x4*)(in[9] + cch) * (-L2E), ksp = *(const f32x4*)(SPL8 + cch);
        {
#pragma unroll
            for (int i = 0; i < 16; ++i) {
                const unsigned z0 = MX_ZR(i), z1 = MX_ZR(i + 1), z2 = MX_ZR(i + 2), z3 = MX_ZR(i + 3);
                const f32x2 xv = ccb + cw0 * (f32x2){bflo(z0), bfhi(z0)} + cw1 * (f32x2){bflo(z1), bfhi(z1)} + cw2 * (f32x2){bflo(z2), bfhi(z2)} + cw3 * (f32x2){bflo(z3), bfhi(z3)};
                *(LAS unsigned*)(lds + MY_XA + (16 * tg + i) * RS + 4 * cp) = cvt_pk_bf16(xv.x, xv.y);
            }
        }
        __syncthreads();
        {
            const float mua = ST[srow], rsa = ST[128 + srow], mub = ST[srow + 1], rsb = ST[128 + srow + 1];
#pragma unroll
            for (int ci = 0; ci < 2; ++ci) { const int chunk = 2 * wave + ci, cbase = c0 + 8 * chunk;
                f32x4 a0, a1, b0, b1; unpack8(ci ? vv10 : vv00, a0, a1); unpack8(ci ? vv11 : vv01, b0, b1);
                const f32x4 g0 = *(const f32x4*)(in[11] + cbase), g1 = *(const f32x4*)(in[11] + cbase + 4), l0 = *(const f32x4*)(in[12] + cbase), l1 = *(const f32x4*)(in[12] + cbase + 4);
                a0 = (a0 - mua) * rsa * g0 + l0; a1 = (a1 - mua) * rsa * g1 + l1; b0 = (b0 - mub) * rsb * g0 + l0; b1 = (b1 - mub) * rsb * g1 + l1;
#pragma unroll
                for (int i = 0; i < 8; ++i) { const int cl = 8 * chunk + i; const float va = i < 4 ? a0[i & 3] : a1[i & 3], vb = i < 4 ? b0[i & 3] : b1[i & 3];
                    *(LAS unsigned*)(lds + MY_VT + cl * 256 + ((sch ^ (cl & 15)) << 4) + 4 * pr) = cvt_pk_bf16(va, vb); }
            }
        }
        f32x4 R[8], I[8];
#pragma unroll
        for (int mt = 0; mt < 8; ++mt) { R[mt] = (f32x4){0.f, 0.f, 0.f, 0.f}; I[mt] = (f32x4){0.f, 0.f, 0.f, 0.f};
#pragma unroll
            for (int ks = 0; ks < 2; ++ks) { const bf16x8 a = *(const LAS bf16x8*)(lds + MY_XA + (mt * 16 + fr) * RS + ((wave >> 2) * 64 + ks * 32 + 8 * grp) * 2);
                R[mt] = __builtin_amdgcn_mfma_f32_16x16x32_bf16(ks ? bw01 : bw00, a, R[mt], 0, 0, 0); I[mt] = __builtin_amdgcn_mfma_f32_16x16x32_bf16(ks ? bw11 : bw10, a, I[mt], 0, 0, 0); } }
#pragma unroll
        for (int mt = 0; mt < 8; ++mt) {
            const u32x2 xw = *(const LAS u32x2*)(lds + MY_XA + (mt * 16 + fr) * RS + (16 * wave + 4 * grp) * 2);
            const f32x4 xa4 = {bflo(xw.x), bfhi(xw.x), bflo(xw.y), bfhi(xw.y)};
            const f32x4 t1 = R[mt] * (-L2E) + nba, t2 = I[mt] * (-L2E) + nbi;
            f32x4 d1, d2, inv;
#pragma unroll
            for (int r = 0; r < 4; ++r) { d1[r] = 1.f + __builtin_amdgcn_exp2f(t1[r]); d2[r] = 1.f + __builtin_amdgcn_exp2f(t2[r]); }
            const f32x4 dd = d1 * d2;
#pragma unroll
            for (int r = 0; r < 4; ++r) inv[r] = __builtin_amdgcn_rcpf(dd[r]);
            const f32x4 rr = d2 * inv, ii = d1 * inv, la = rr * ksp;
            const f32x4 w = la * (1.f + la * (0.5f + la * (0.16666667f + la * (0.041666667f + la * 0.0083333333f))));
            f32x4 av = 1.f + w;
            const f32x4 om = -w * (2.f + w);
            f32x4 uv;
#pragma unroll
            for (int r = 0; r < 4; ++r) uv[r] = __builtin_amdgcn_sqrtf(om[r]);
            uv = uv * ii * xa4;
            scan16x4(av, uv); R[mt] = av; I[mt] = uv;
        }
        {
            f32x4 Pc = {1.f, 1.f, 1.f, 1.f}, Hc = {0.f, 0.f, 0.f, 0.f};
#pragma unroll
            for (int mt = 0; mt < 8; ++mt) { Hc = Hc * R[mt] + I[mt]; Pc = Pc * R[mt]; }
            if (fr == 15) {
#pragma unroll
                for (int r = 0; r < 4; ++r) __hip_atomic_store(AGG + (size_t)ck * 1024 + cch + r, ((unsigned long long)__float_as_uint(Hc[r]) << 32) | (unsigned long long)__float_as_uint(Pc[r]), __ATOMIC_RELAXED, __HIP_MEMORY_SCOPE_AGENT);
            }
        }
        __syncthreads();
        if (u + G < 1024) MX_PREFETCH(u + G);
        unsigned long long ag0 = 0x000000003f800000ull, ag1 = 0x000000003f800000ull, ag2 = 0x000000003f800000ull, ag3 = 0x000000003f800000ull;
        if (j > 0 && fr < j) { const unsigned long long* ap = AGG + (size_t)(ck - j + fr) * 1024 + cch;
            ag0 = __hip_atomic_load(ap, __ATOMIC_RELAXED, __HIP_MEMORY_SCOPE_AGENT); ag1 = __hip_atomic_load(ap + 1, __ATOMIC_RELAXED, __HIP_MEMORY_SCOPE_AGENT);
            ag2 = __hip_atomic_load(ap + 2, __ATOMIC_RELAXED, __HIP_MEMORY_SCOPE_AGENT); ag3 = __hip_atomic_load(ap + 3, __ATOMIC_RELAXED, __HIP_MEMORY_SCOPE_AGENT); }
        {
            bf16x8 q[4];
#pragma unroll
            for (int ks = 0; ks < 4; ++ks) q[ks] = *(const LAS bf16x8*)(lds + MY_VT + (16 * wave + fr) * 256 + (((ks * 4 + grp) ^ fr) << 4));
#pragma unroll
            for (int mt = 0; mt < 8; ++mt) { f32x4 Sx = {0.f, 0.f, 0.f, 0.f};
#pragma unroll
                for (int ks = 0; ks <= mt / 2; ++ks) { const bf16x8 p = *(const LAS bf16x8*)(lds + MY_WS + (mt * 16 + fr) * 256 + (((ks * 4 + grp) ^ fr) << 4));
                    Sx = __builtin_amdgcn_mfma_f32_16x16x32_bf16(q[ks], p, Sx, 0, 0, 0); }
                *(LAS u32x2*)(lds + MY_SP + (mt * 16 + fr) * RS + (16 * wave + 4 * grp) * 2) = (u32x2){cvt_pk_bf16_cv(Sx[0], Sx[1]), cvt_pk_bf16_cv(Sx[2], Sx[3])}; }
        }
        {
            f32x4 hc0 = {0.f, 0.f, 0.f, 0.f};
            if (j > 0) {
                f32x4 lp, lh; unsigned spin = 0;
                for (;;) {
                    lp[0] = __uint_as_float((unsigned)ag0); lh[0] = __uint_as_float((unsigned)(ag0 >> 32)); lp[1] = __uint_as_float((unsigned)ag1); lh[1] = __uint_as_float((unsigned)(ag1 >> 32));
                    lp[2] = __uint_as_float((unsigned)ag2); lh[2] = __uint_as_float((unsigned)(ag2 >> 32)); lp[3] = __uint_as_float((unsigned)ag3); lh[3] = __uint_as_float((unsigned)(ag3 >> 32));
                    const bool ok = (lp[0] != 0.f) && (lp[1] != 0.f) && (lp[2] != 0.f) && (lp[3] != 0.f);
                    if (__all(ok)) break;
                    if (++spin > (1u << 22)) break;
                    __builtin_amdgcn_s_sleep(1);
                    if (fr < j) { const unsigned long long* ap = AGG + (size_t)(ck - j + fr) * 1024 + cch;
                        ag0 = __hip_atomic_load(ap, __ATOMIC_RELAXED, __HIP_MEMORY_SCOPE_AGENT); ag1 = __hip_atomic_load(ap + 1, __ATOMIC_RELAXED, __HIP_MEMORY_SCOPE_AGENT);
                        ag2 = __hip_atomic_load(ap + 2, __ATOMIC_RELAXED, __HIP_MEMORY_SCOPE_AGENT); ag3 = __hip_atomic_load(ap + 3, __ATOMIC_RELAXED, __HIP_MEMORY_SCOPE_AGENT); } }
                scan16x4(lp, lh);
#pragma unroll
                for (int r = 0; r < 4; ++r) hc0[r] = __shfl(lh[r], (lane & 48) | 15);
            }
            f32x4 s = hc0;
#pragma unroll
            for (int mt = 0; mt < 8; ++mt) { f32x4 hb;
#pragma unroll
                for (int r = 0; r < 4; ++r) hb[r] = __shfl(s[r], (lane & 48) | 15);
                s = R[mt] * s + I[mt];
                const f32x4 hv = I[mt] + R[mt] * hb;
                *(LAS u32x2*)(lds + MY_XA + (mt * 16 + fr) * RS + (16 * wave + 4 * grp) * 2) = (u32x2){cvt_pk_bf16(hv[0], hv[1]), cvt_pk_bf16(hv[2], hv[3])}; }
        }
        u32x4 ga[4], ub[4]; float bsr[4]; f32x4 nq0 = {0.f, 0.f, 0.f, 0.f}, nq1 = {0.f, 0.f, 0.f, 0.f};
        if (u + G < 1024) MX_STATS_LOAD(u + G, nq0, nq1);
#pragma unroll
        for (int it = 0; it < 4; ++it) { const int idx = it * 512 + tid, row = idx >> 4, ch = idx & 15; const unsigned o = ((unsigned)(t0 + row) * D + c0 + ch * 8) * 2u; ga[it] = *(const u32x4*)((const char*)GA + o); ub[it] = *(const u32x4*)((const char*)UB + o); bsr[it] = in[14][g * 128 + row]; }
        __syncthreads();
#pragma unroll
        for (int it = 0; it < 4; ++it) { const int idx = it * 512 + tid, row = idx >> 4, ch = idx & 15;
            f32x4 g0, g1, u0, u1, h0, h1, s0, s1; unpack8(ga[it], g0, g1); unpack8(ub[it], u0, u1);
            unpack8(*(const LAS u32x4*)(lds + MY_XA + row * RS + ch * 16), h0, h1); unpack8(*(const LAS u32x4*)(lds + MY_SP + row * RS + ch * 16), s0, s1);
            store16_sc1((char*)MG + ((unsigned)(t0 + row) * D + c0 + ch * 8) * 2u, pack8(g0 * h0 + u0 * (s0 + bsr[it]), g1 * h1 + u1 * (s1 + bsr[it]))); }
        if (u + G < 1024) MX_STATS_WRITE(nq0, nq1);
        asm volatile("s_waitcnt vmcnt(0)" ::: "memory");
        if (lane == 0) __hip_atomic_fetch_add(mixc + 64 * (ck >> 1), 1u, __ATOMIC_RELAXED, __HIP_MEMORY_SCOPE_AGENT);
        __syncthreads();
    }
#undef MX_PREFETCH
#undef MX_STATS_LOAD
#undef MX_STATS_WRITE
#undef MX_ZR
#undef MX_SETZR
}

__device__ __forceinline__ void build_moe_units(LAS int* tab1, LAS int* tab2, LAS int* tab3, const int* CNT, int vcu, int G, int wave, LAS int* flags) {
    const int tid = wave * 64 + pg8::lane_id();
    int NT = 0, my_e = 0, my_tile = 0, my_cnt = 0, my_rt = 0;
    for (int e = 0; e < 32; ++e) { const int cnt = CNT[e]; const int ntl = (cnt + 255) >> 8;
        if (tid >= NT && tid < NT + ntl) { my_e = e; my_tile = tid - NT; my_cnt = cnt; my_rt = tid; }
        NT += ntl; }
    const bool have = tid < NT;
    const bool heavy = have && (my_cnt - my_tile * 256) > 128;
    flags[tid] = heavy ? 1 : 0;
    __syncthreads();
    int hb = 0, NH = 0;
    for (int i = 0; i < NT; ++i) { const int f = flags[i]; NH += f; hb += (i < tid) ? f : 0; }
    const int slot = heavy ? hb : NH + (tid - hb);
    const int U1 = 2 * NT, U2 = 4 * NT; int nlate = (U1 > G && U1 < 2 * G) ? U1 - G : 0; if (G - nlate < 64) nlate = 0;
    const int Ge = G - nlate, c2 = vcu - nlate, ssplit = nlate ? G / 2 : NT, Lsplit = 4 * ssplit;
    const int n1 = vcu < U1 ? (U1 - 1 - vcu) / G + 1 : 0;
    const int tot2 = (c2 >= 0 && c2 < U2) ? (U2 - 1 - c2) / Ge + 1 : 0;
    int n2 = (c2 >= 0 && c2 < Lsplit) ? (Lsplit - 1 - c2) / Ge + 1 : 0; n2 = n2 < tot2 ? n2 : tot2;
    const int n3 = tot2 - n2;
    if (tid == 0) { tab1[0] = n1 < 12 ? n1 : 12; tab2[0] = n2 < 12 ? n2 : 12; tab3[0] = n3 < 12 ? n3 : 12; }
    if (have) {
#pragma unroll
        for (int q = 0; q < 2; ++q) { const int L = 2 * slot + q; if (L % G == vcu && L / G < 12) { LAS int* p = tab1 + 4 + 8 * (L / G); p[0] = my_rt; p[1] = my_e * 2 + q; p[2] = my_e; p[3] = my_tile; p[4] = my_cnt; } }
        if (c2 >= 0) {
#pragma unroll
            for (int q = 0; q < 4; ++q) { const int L2 = 4 * slot + q; if (L2 % Ge == c2) { const int k = L2 / Ge; const bool early = slot < ssplit; const int idx = early ? k : k - n2;
                if (idx >= 0 && idx < 12) { LAS int* p = (early ? tab2 : tab3) + 4 + 8 * idx; p[0] = my_rt; p[1] = my_e * 4 + q; p[2] = my_e; p[3] = my_tile; p[4] = my_cnt; } } }
        }
    }
    __syncthreads();
}
__device__ __forceinline__ void moe_wait_tiles(const LAS int* tab, unsigned* dcnt, int wave) {
    if (wave == 0) {
        const int n = __builtin_amdgcn_readfirstlane(tab[0]);
        for (int i = 0; i < n; ++i) { const int rt = __builtin_amdgcn_readfirstlane(tab[4 + 8 * i]); unsigned sp = 0;
            while ((unsigned)__builtin_amdgcn_readfirstlane(__hip_atomic_load(dcnt + 64 * rt, __ATOMIC_RELAXED, __HIP_MEMORY_SCOPE_AGENT)) < 16u) { if (++sp > (1u << 22)) break; __builtin_amdgcn_s_sleep(2); } }
        __builtin_amdgcn_fence(__ATOMIC_ACQUIRE, "agent");
        asm volatile("s_waitcnt vmcnt(0)" ::: "memory");
    }
    __syncthreads();
}

struct Args { const float* in[28]; float* out; unsigned char* ws; int ph_lo, ph_hi, li, pad; };

__global__ void __launch_bounds__(NWAVES * 64, 2) mega_fwd(Args args) {
    extern __shared__ __attribute__((aligned(16))) unsigned char lds_raw[];
    LAS unsigned char* lds = (LAS unsigned char*)lds_raw;
    volatile LAS unsigned* MISC = (volatile LAS unsigned*)(lds + MISC_OFF);
    const int tid0 = threadIdx.x, wave = __builtin_amdgcn_readfirstlane(tid0 >> 6);
#define PHASE_IDS() int lane = pg8::lane_id(); asm volatile("" : "+v"(lane)); const int tid = wave * 64 + lane; (void)tid
    const int G = gridDim.x;
    const int vcu = (G % 8 == 0) ? ((int)blockIdx.x % 8) * (G / 8) + (int)blockIdx.x / 8 : (int)blockIdx.x;
    unsigned char* ws = args.ws;
    unsigned* ctl = (unsigned*)(ws + WS_CTL);
    for (int u = tid0; u < (LDS_BYTES - LDSCTL_OFF) / 4; u += NWAVES * 64) ((LAS unsigned*)(lds + LDSCTL_OFF))[u] = 0u;
    __syncthreads();
    XcdBarrier bar = xcd_barrier_post(ctl + CW_BAR + args.li * XCD_BAR_WORDS, MISC + 8, wave);
    const int lo = args.ph_lo, hi = args.ph_hi;
#define IN(k) (lo <= (k) && (k) < hi)
#define BOTH(k) (IN(k) && IN((k) + 1))
    const float* const* in = args.in;
    bf16 *XN = (bf16*)(ws + WS_A0), *MG = (bf16*)args.out, *X2b = (bf16*)(ws + WS_A0);
    float *RSTD0 = (float*)(ws + WS_RSTD0), *GINV = (float*)(ws + WS_GINV);
    bf16 *Zl = (bf16*)(ws + WS_A1), *X1b = (bf16*)args.out + (size_t)T * D;
    bf16 *GA = (bf16*)(ws + WS_A2), *UB = (bf16*)(ws + WS_A3), *V = (bf16*)(ws + WS_A4);
    bf16 *X3 = (bf16*)(ws + WS_A3);
    unsigned char* X1q = ws + WS_A1 + 16 * MiB;
    unsigned char* X2q = ws + WS_A1;
    bf16 *PU = (bf16*)(ws + WS_A2);
    bf16 *Pb = (bf16*)(ws + WS_PB);
    bf16 *WinT = (bf16*)(ws + WS_WIN), *WoutT = (bf16*)(ws + WS_WOUT), *WgT = (bf16*)(ws + WS_WG), *W13T = (bf16*)(ws + WS_W13), *W2T = (bf16*)(ws + WS_W2), *WupT = (bf16*)(ws + WS_WUP);
    float *VPART = (float*)(ws + WS_VPART), *SS1 = (float*)(ws + WS_SS1), *SS3 = (float*)(ws + WS_SS3), *RSTD2 = (float*)(ws + WS_RSTD2), *RSTD1 = (float*)(ws + WS_RSTD1), *LISTG = (float*)(ws + WS_LISTG), *LISTR = (float*)(ws + WS_LISTR);
    int *CNT = (int*)(ws + WS_CTL), *LIST = (int*)(ws + WS_LIST), *TOKE = (int*)(ws + WS_TOKE);
    bf16 *Hb = (bf16*)(ws + WS_A2), *Yb = (bf16*)(ws + WS_A3), *WrT = (bf16*)(ws + WS_WR), *WLRU = (bf16*)(ws + WS_WLRU), *WSGU = (bf16*)(ws + WS_WSGU);
    unsigned long long* AGGQ = (unsigned long long*)(ws + WS_AGG); float* SPL8 = (float*)(ws + WS_SPL8);

    if (IN(0)) {
        PHASE_IDS();
        LAS float* scr = (LAS float*)(lds + wave * 16384);
        const bool tab_fast = (G * 512 == 131072);
        float tf_lru = 0.f, tf_sgu = 0.f, tf10 = 0.f, tf2 = 1.f, tfr = 0.f;
        if (tab_fast) {
            const int i = vcu * 512 + tid, gate = i >> 16, h = (i >> 12) & 15, j = (i >> 6) & 63, ii = i & 63;
            const float f_lru = (gate ? in[8] : in[6])[(h * 64 + ii) * 64 + j], f_sgu = in[13][i];
            const int i10 = i < 1024 ? i : 0; const float f10 = in[10][i10], f2 = in[2][i10];
            const int n = (i >> 10) & 63, k = i & 1023; const float fa = in[17][k * 4 + (n < 4 ? n : 0)], fb = in[19][k * 32 + ((n >= 4 && n < 36) ? n - 4 : 0)], fk = in[16][k];
            tf_lru = f_lru; tf_sgu = f_sgu; tf10 = f10; tf2 = f2; tfr = n < 4 ? fa * fk : (n < 36 ? fb * fk : 0.f);
        }
        const int gw = vcu * NWAVES + wave, NGW = G * NWAVES;
        for (int it = gw; it < 16 * 192; it += NGW) { const int kb = it / 192, nb = it % 192; p0_transpose_item(in[3], 6144, kb * 64, nb * 32, WinT, 1024, win_dest_row(nb * 32), nullptr, scr, lane); }
        if (tab_fast) { const int i = vcu * 512 + tid, t = (i >> 7) & 127, s_ = i & 127;
            WLRU[i] = f2bf(tf_lru); WSGU[i] = s_ <= t ? f2bf(tf_sgu) : (bf16)0;
            if (i < 1024) { SPL8[i] = -8.f * log1pf(expf(-tf10)); GINV[i] = 1.f / tf2; }
            if (i < 64 * 1024) WrT[i] = f2bf(tfr); }
        for (int m = gw; m < T; m += 2 * NGW) {
            const int m2 = m + NGW < T ? m + NGW : m;
            const pg8::f32x4* xr = (const pg8::f32x4*)(in[0] + (size_t)m * D) + lane; const pg8::f32x4* xr2 = (const pg8::f32x4*)(in[0] + (size_t)m2 * D) + lane; const pg8::f32x4* gr = (const pg8::f32x4*)in[2] + lane;
            pg8::f32x4 v[4], w[4]; float s = 0.f, s2 = 0.f;
#pragma unroll
            for (int j = 0; j < 4; ++j) { v[j] = __builtin_nontemporal_load(xr + 64 * j); w[j] = __builtin_nontemporal_load(xr2 + 64 * j); }
#pragma unroll
            for (int j = 0; j < 4; ++j) { s += (v[j].x * v[j].x + v[j].y * v[j].y) + (v[j].z * v[j].z + v[j].w * v[j].w); s2 += (w[j].x * w[j].x + w[j].y * w[j].y) + (w[j].z * w[j].z + w[j].w * w[j].w); }
            const float rstd = rsqrtf(wave_sum(s) * (1.f / D) + EPS), rstd2 = rsqrtf(wave_sum(s2) * (1.f / D) + EPS);
            if (lane == 0) { RSTD0[m] = 1.f / rstd; RSTD0[m2] = 1.f / rstd2; }
            unsigned long long* o8 = (unsigned long long*)(XN + (size_t)m * D) + lane; unsigned long long* o82 = (unsigned long long*)(XN + (size_t)m2 * D) + lane;
#pragma unroll
            for (int j = 0; j < 4; ++j) { const pg8::f32x4 gg = gr[64 * j];
                o8[64 * j] = (unsigned long long)pk2(v[j].x * rstd * gg.x, v[j].y * rstd * gg.y) | ((unsigned long long)pk2(v[j].z * rstd * gg.z, v[j].w * rstd * gg.w) << 32);
                o82[64 * j] = (unsigned long long)pk2(w[j].x * rstd2 * gg.x, w[j].y * rstd2 * gg.y) | ((unsigned long long)pk2(w[j].z * rstd2 * gg.z, w[j].w * rstd2 * gg.w) << 32); }
        }
        if (!tab_fast) {
        for (int i = vcu * 512 + tid; i < 2 * 16 * 64 * 64; i += G * 512) { const int gate = i >> 16, h = (i >> 12) & 15, j = (i >> 6) & 63, ii = i & 63;
            WLRU[i] = f2bf(in[gate ? 8 : 6][(h * 64 + ii) * 64 + j]); }
        for (int i = vcu * 512 + tid; i < 8 * 128 * 128; i += G * 512) { const int t = (i >> 7) & 127, s = i & 127; WSGU[i] = s <= t ? f2bf(in[13][i]) : (bf16)0; }
        for (int i = vcu * 512 + tid; i < 1024; i += G * 512) { SPL8[i] = -8.f * log1pf(expf(-in[10][i])); GINV[i] = 1.f / in[2][i]; }
        for (int i = vcu * 512 + tid; i < 64 * 1024; i += G * 512) { const int n = i >> 10, k = i & 1023; float v = 0.f;
            if (n < 4) v = in[17][k * 4 + n] * in[16][k]; else if (n < 36) v = in[19][k * 32 + (n - 4)] * in[16][k];
            WrT[i] = f2bf(v); }
        }
        if (BOTH(0)) xcd_barrier(bar);
    }
    if (IN(1)) {
        { pg8::Gemm g{XN, WinT, 1024}; Gemm1Order S; S.init(T, 6144, G, (int)blockIdx.x);
          S.wave = wave; { const int upw = (64 * 24) / G > 0 ? (64 * 24) / G : 1; S.gi = (int)blockIdx.x % upw; } S.w = DefW{args.in, ws};
          pg8::Epi1 E{Zl, GA, UB, V, VPART};
          pg8::gemm_phase<pg8::Epi1, Gemm1Order, true, true, false>(lds, g, S, E, wave); }
        if (BOTH(1)) xcd_barrier(bar);
    }

    if (IN(3)) {
        PHASE_IDS();
        mixer_phase(lds, vcu, G, tid, lane, wave, Zl, GA, UB, V, VPART, AGGQ, MG, ctl + CW_MIX, WLRU, WSGU, SPL8, in);
    }
    if (IN(4)) {
        pg8::Gemm g{MG, WoutT, 1024}; pg8::StaticOrder S; S.init(T, 1024, G, (int)blockIdx.x);
        pg8::Epi2 E{XN, RSTD0, GINV, X1b, SS1};
        if (BOTH(3)) {
            if (wave == 0) { pg8::Unit u0;
                for (int i = 0; S.next(i, u0); ++i) { unsigned sp = 0;
                    while ((unsigned)__builtin_amdgcn_readfirstlane(__hip_atomic_load(ctl + CW_MIX + 64 * u0.pm, __ATOMIC_RELAXED, __HIP_MEMORY_SCOPE_AGENT)) < 128u) { if (++sp > (1u << 22)) break; __builtin_amdgcn_s_sleep(2); } }
                __builtin_amdgcn_fence(__ATOMIC_ACQUIRE, "agent");
                asm volatile("s_waitcnt vmcnt(0)" ::: "memory"); }
            __syncthreads();
        }
        pg8::gemm_phase<pg8::Epi2, pg8::StaticOrder, true, true, false>(lds, g, S, E, wave);
        if (BOTH(4)) xcd_barrier(bar);
    }

    if (IN(5)) {
        PHASE_IDS();
        constexpr int LS = 52;
        LAS float* sP = (LAS float*)lds;
        LAS float* sL = (LAS float*)(lds + 8 * 64 * LS * 4);
        LAS int* sCnt = (LAS int*)(lds + 9 * 64 * LS * 4); LAS int* sBase = sCnt + 32;
        const int fr = lane & 15, grp = lane >> 4;
        for (int tile = vcu; tile < T / 64; tile += G) {
            const int tok0 = tile * 64;
            if (tid < 32) sCnt[tid] = 0;
            pg8::bf16x8 a[4][4], b[3][4];
#pragma unroll
            for (int mt = 0; mt < 4; ++mt)
#pragma unroll
                for (int ks = 0; ks < 4; ++ks) a[mt][ks] = *(const pg8::bf16x8*)(X1b + (size_t)(tok0 + 16 * mt + fr) * D + wave * 128 + ks * 32 + 8 * grp);
#pragma unroll
            for (int nt = 0; nt < 3; ++nt)
#pragma unroll
                for (int ks = 0; ks < 4; ++ks) b[nt][ks] = *(const pg8::bf16x8*)(WrT + (size_t)(16 * nt + fr) * D + wave * 128 + ks * 32 + 8 * grp);
            pg8::f32x4 q0 = {0.f, 0.f, 0.f, 0.f}, q1 = q0, q2 = q0, q3 = q0;
#pragma unroll
            for (int mt = 0; mt < 4; ++mt)
#pragma unroll
                for (int ks = 0; ks < 4; ++ks) { pg8::f32x4 e0, e1; pg8::unpack8(__builtin_bit_cast(pg8::u32x4, a[mt][ks]), e0, e1);
                    *(pg8::u32x2*)(X1q + (size_t)(tok0 + 16 * mt + fr) * D + wave * 128 + ks * 32 + 8 * grp) = pg8::pack8_fp8(e0, e1); }
            if (tid < 64) { const float* sp = SS1 + (size_t)(tok0 + tid) * 16; q0 = *(const pg8::f32x4*)sp; q1 = *(const pg8::f32x4*)(sp + 4); q2 = *(const pg8::f32x4*)(sp + 8); q3 = *(const pg8::f32x4*)(sp + 12); }
#pragma unroll
            for (int mt = 0; mt < 4; ++mt)
#pragma unroll
                for (int nt = 0; nt < 3; ++nt) { pg8::f32x4 acc = {0.f, 0.f, 0.f, 0.f};
#pragma unroll
                    for (int ks = 0; ks < 4; ++ks) acc = __builtin_amdgcn_mfma_f32_16x16x32_bf16(a[mt][ks], b[nt][ks], acc, 0, 0, 0);
#pragma unroll
                    for (int r = 0; r < 4; ++r) sP[(wave * 64 + 16 * mt + 4 * grp + r) * LS + 16 * nt + fr] = acc[r]; }
            __syncthreads();
            { const int tk = tid >> 3, c0 = (tid & 7) * 6;
#pragma unroll
              for (int c = 0; c < 6; ++c) { float sum = 0.f;
#pragma unroll
                  for (int w = 0; w < 8; ++w) sum += sP[(w * 64 + tk) * LS + c0 + c];
                  sL[tk * LS + c0 + c] = sum; } }
            __syncthreads();
            int e1 = 0, e2 = 0, r1 = 0, r2 = 0; float g1 = 0.f, g2 = 0.f, rstd = 0.f;
            if (tid < 64) {
                const int t = tok0 + tid;
                const pg8::f32x4 qs = (q0 + q1) + (q2 + q3);
                const float ss = (qs[0] + qs[1]) + (qs[2] + qs[3]);
                rstd = rsqrtf(ss * (1.f / D) + EPS);
                const LAS float* l = sL + tid * LS;
                float gl[4];
#pragma unroll
                for (int q = 0; q < 4; ++q) gl[q] = rstd * l[q] + in[18][q];
                float mx = gl[0]; int gi = 0;
#pragma unroll
                for (int q = 1; q < 4; ++q) if (gl[q] > mx) { mx = gl[q]; gi = q; }
                float den = 0.f;
#pragma unroll
                for (int q = 0; q < 4; ++q) den += expf(gl[q] - mx);
                const float gtop = 1.f / den;
                float m1 = -3.0e38f, m2 = -3.0e38f; int i1 = 0, i2 = 0;
                for (int j = 0; j < 8; ++j) { const float v = rstd * l[4 + gi * 8 + j] + in[20][gi * 8 + j];
                    if (v > m1) { m2 = m1; i2 = i1; m1 = v; i1 = j; } else if (v > m2) { m2 = v; i2 = j; } }
                const float p2 = expf(m2 - m1);
                g1 = gtop / (1.f + p2); g2 = gtop * p2 / (1.f + p2);
                e1 = gi * 8 + i1; e2 = gi * 8 + i2;
                r1 = __hip_atomic_fetch_add(&sCnt[e1], 1, __ATOMIC_RELAXED, __HIP_MEMORY_SCOPE_WORKGROUP); r2 = __hip_atomic_fetch_add(&sCnt[e2], 1, __ATOMIC_RELAXED, __HIP_MEMORY_SCOPE_WORKGROUP);
            }
            __syncthreads();
            if (tid < 32) { const int c = sCnt[tid]; sBase[tid] = c ? atomicAdd(&CNT[tid], c) : 0; }
            __syncthreads();
            if (tid < 64) { const int t = tok0 + tid, p1 = e1 * 16384 + sBase[e1] + r1, p2 = e2 * 16384 + sBase[e2] + r2;
                LIST[p1] = t * 2; LIST[p2] = t * 2 + 1; LISTG[p1] = g1; LISTG[p2] = g2; LISTR[p1] = rstd; LISTR[p2] = rstd; }
            __syncthreads();
        }
        if (BOTH(5)) xcd_barrier(bar);
    }
    if (IN(6)) {
        LAS int* tab1 = (LAS int*)(lds + TAB_OFF); LAS int* tab2 = (LAS int*)(lds + TAB_OFF + 512); LAS int* tab3 = (LAS int*)(lds + TAB_OFF + 1024);
        build_moe_units(tab1, tab2, tab3, CNT, vcu, G, wave, (LAS int*)lds);
        unsigned* dcnt = ctl + CW_DONE1;
        { pg8::Gemm g{(const bf16*)X1q, W13T, 512}; pg8::MoeOrder<1> S{tab1, LIST, dcnt, 1024u};
          pg8::EpiMoe1 E{(unsigned char*)Hb, LISTR};
          pg8::gemm_phase<pg8::EpiMoe1, pg8::MoeOrder<1>, true, true, true, true>(lds, g, S, E, wave); }
        pg8::Gemm g2{Hb, W2T, 128}; pg8::EpiMoe2 E2{Yb, LIST, LISTG};
        moe_wait_tiles(tab2, dcnt, wave);
        { pg8::MoeOrder<0> S{tab2, LIST, dcnt, 2048u}; pg8::gemm_phase<pg8::EpiMoe2, pg8::MoeOrder<0>, true, true, false, true>(lds, g2, S, E2, wave); }
        moe_wait_tiles(tab3, dcnt, wave);
        { pg8::MoeOrder<0> S{tab3, LIST, dcnt, 2048u}; pg8::gemm_phase<pg8::EpiMoe2, pg8::MoeOrder<0>, true, true, false, true>(lds, g2, S, E2, wave); }
        if (BOTH(6)) xcd_barrier(bar);
    }
    if (IN(8)) {
        const bool split = (G % 16 == 0);
        const int q8 = (int)blockIdx.x >> 3, x8 = (int)blockIdx.x & 7;
        const bool do_gemm = !split || (q8 & 1), do_comb = !split || !(q8 & 1);
        if (do_comb) {
            PHASE_IDS();
            const int NGW = (split ? G / 2 : G) * NWAVES, gw = (split ? (q8 >> 1) * 8 + x8 : vcu) * NWAVES + wave;
            for (int row = gw; row < T; row += 2 * NGW) {
                const int row2 = row + NGW; const bool two = row2 < T; const int rb = two ? row2 : row;
                pg8::u32x4 la[2][2], lb[2][2], lc[2][2];
#pragma unroll
                for (int rr = 0; rr < 2; ++rr)
#pragma unroll
                    for (int hh = 0; hh < 2; ++hh) { const int r = rr ? rb : row;
                        la[rr][hh] = __builtin_nontemporal_load((const pg8::u32x4*)(X1b + (size_t)r * D + hh * 512 + lane * 8));
                        lb[rr][hh] = __builtin_nontemporal_load((const pg8::u32x4*)(Yb + (size_t)r * 2 * D + hh * 512 + lane * 8));
                        lc[rr][hh] = __builtin_nontemporal_load((const pg8::u32x4*)(Yb + ((size_t)r * 2 + 1) * D + hh * 512 + lane * 8)); }
#pragma unroll
                for (int rr = 0; rr < 2; ++rr) { const int r = rr ? rb : row; float ss = 0.f;
#pragma unroll
                    for (int hh = 0; hh < 2; ++hh) { pg8::f32x4 a0, a1, b0, b1, c0, c1; pg8::unpack8(la[rr][hh], a0, a1); pg8::unpack8(lb[rr][hh], b0, b1); pg8::unpack8(lc[rr][hh], c0, c1);
                        a0 = a0 + b0 + c0; a1 = a1 + b1 + c1;
                        ss += pg8::hsum4(a0 * a0 + a1 * a1);
                        if (rr == 0 || two) { *(pg8::u32x4*)(X2b + (size_t)r * D + hh * 512 + lane * 8) = pg8::pack8(a0, a1); *(pg8::u32x2*)(X2q + (size_t)r * D + hh * 512 + lane * 8) = pg8::pack8_fp8(a0, a1); } }
                    ss = wave_sum(ss);
                    if (lane == 0 && (rr == 0 || two)) RSTD2[r] = rsqrtf(ss * (1.f / D) + EPS); }
            }
        }
        if (do_gemm) {
            pg8::Gemm g{Pb, WupT, 256}; pg8::StaticOrder S; S.init(T, 1024, split ? G / 2 : G, split ? (q8 >> 1) * 8 + x8 : (int)blockIdx.x);
            pg8::EpiPlain E{PU};
            pg8::gemm_phase<pg8::EpiPlain, pg8::StaticOrder, true, true, false>(lds, g, S, E, wave);
        }
        if (BOTH(8)) xcd_barrier(bar);
    }
    const bool fuse_final = (G == 256);
    if (IN(9)) {
        pg8::Gemm g{(const bf16*)X2q, WgT, 512}; pg8::StaticOrder S; S.init(T, 1024, G, (int)blockIdx.x);
        if (fuse_final) {
            pg8::EpiPleFinal E{X2b, PU, RSTD2, in[27], args.out, (float*)(ws + WS_XCH), ctl + CW_PANEL, (LAS float*)(lds + RING_BYTES), wave};
            pg8::gemm_phase<pg8::EpiPleFinal, pg8::StaticOrder, true, true, false, true>(lds, g, S, E, wave);
        } else {
            pg8::EpiPle E{X2b, PU, RSTD2, X3, SS3};
            pg8::gemm_phase<pg8::EpiPle, pg8::StaticOrder, true, true, false, true>(lds, g, S, E, wave);
            if (BOTH(9)) xcd_barrier(bar);
        }
    }

    if (IN(10) && !fuse_final) {
        PHASE_IDS();
        const int gw = vcu * NWAVES + wave, NGW = G * NWAVES;
        for (int row = gw; row < T; row += NGW) { float ss = 0.f;
            if (lane < 16) ss = SS3[(size_t)row * 16 + lane];
            ss = wave_sum(ss);
            const float rstd = rsqrtf(ss * (1.f / D) + EPS);
#pragma unroll
            for (int hh = 0; hh < 2; ++hh) { const size_t o = (size_t)row * D + hh * 512 + lane * 8; pg8::f32x4 a0, a1; pg8::unpack8(*(const pg8::u32x4*)(X3 + o), a0, a1);
                const pg8::f32x4 f0 = *(const pg8::f32x4*)(in[27] + hh * 512 + lane * 8), f1 = *(const pg8::f32x4*)(in[27] + hh * 512 + lane * 8 + 4);
                *(pg8::f32x4*)(args.out + o) = a0 * rstd * f0; *(pg8::f32x4*)(args.out + o + 4) = a1 * rstd * f1; } }
    }
#undef IN
#undef BOTH
#undef PHASE_IDS
}

static int mega_grid() {
    static int grid = 0;
    if (grid == 0) {
        int dev = 0, cus = 0;
        if (hipGetDevice(&dev) != hipSuccess || hipDeviceGetAttribute(&cus, hipDeviceAttributeMultiprocessorCount, dev) != hipSuccess) { fprintf(stderr, "mega: device query failed\n"); grid = -1; return grid; }
        if (hipFuncSetAttribute((const void*)mega_fwd, hipFuncAttributeMaxDynamicSharedMemorySize, LDS_BYTES) != hipSuccess) { fprintf(stderr, "mega: hipFuncSetAttribute failed\n"); grid = -1; return grid; }
        (void)hipGetLastError();
        grid = cus;
    }
    return grid;
}
static void launch_mega(void* const* d_in, void* d_out, void* d_ws, int lo, int hi, int li, hipStream_t stream) {
    const int grid = mega_grid(); if (grid <= 0) return;
    Args a{};
    for (int i = 0; i < 28; ++i) a.in[i] = (const float*)d_in[i];
    a.out = (float*)d_out; a.ws = (unsigned char*)d_ws; a.ph_lo = lo; a.ph_hi = hi; a.li = li; a.pad = 0;
    hipLaunchKernelGGL(mega_fwd, dim3(grid), dim3(NWAVES * 64), LDS_BYTES, stream, a);
}

extern "C" void kernel_launch(void* const* d_in, const int* in_sizes, int n_in, void* d_out, int out_size, void* d_ws, size_t ws_size, hipStream_t stream) {
    if (n_in != 28 || in_sizes[0] != T * D || out_size != T * D || ws_size < WS_MEGA_END) { fprintf(stderr, "kernel_launch: unexpected shapes (n_in %d, ws %zu)\n", n_in, ws_size); return; }
    (void)hipMemsetAsync(d_ws, 0, 2 * MiB, stream);
    launch_mega(d_in, d_out, d_ws, 0, 11, 0, stream);
}
```

```cpp
#include <hip/hip_runtime.h>
#include <stdint.h>
#include <cstdio>

typedef unsigned short bf16;
constexpr int T = 16384, D = 1024, SEQ = 2048;
constexpr float EPS = 1e-6f;
constexpr size_t MiB = 1u << 20;
constexpr size_t WS_CTL = 0;
constexpr size_t WS_VPART = 2 * MiB;
constexpr size_t WS_SS1 = 4 * MiB;
constexpr size_t WS_SS3 = 5 * MiB;
constexpr size_t WS_AGG = 1 * MiB;
constexpr size_t WS_LIST = 6 * MiB;
constexpr size_t WS_TOKE = 8 * MiB;
constexpr size_t WS_TOKG = 8 * MiB + 128 * 1024;
constexpr size_t WS_RSTD2 = 8 * MiB + 256 * 1024;
constexpr size_t WS_A0 = 74 * MiB;
constexpr size_t WS_A1 = 106 * MiB;
constexpr size_t WS_A2 = 138 * MiB;
constexpr size_t WS_A3 = 170 * MiB;
constexpr size_t WS_A4 = 202 * MiB;
constexpr size_t WS_END = 234 * MiB;

__device__ __forceinline__ float bf2f(bf16 b) { return __uint_as_float(((unsigned)b) << 16); }
__device__ __forceinline__ bf16 f2bf(float f) { unsigned u = __float_as_uint(f); u += 0x7fffu + ((u >> 16) & 1u); return (bf16)(u >> 16); }
__device__ __forceinline__ float sigm(float x) { return 1.f / (1.f + expf(-x)); }
__device__ __forceinline__ float gelu_t(float x) { const float u = 0.7978845608028654f * (x + 0.044715f * x * x * x); return 0.5f * x * (1.f + tanhf(u)); }
__device__ __forceinline__ float wave_sum(float v) {
#pragma unroll
    for (int o = 1; o < 64; o <<= 1) v += __shfl_xor(v, o);
    return v;
}

#define LAS __attribute__((address_space(3)))
#define GAS __attribute__((address_space(1)))
namespace pg8 {
typedef short bf16x8 __attribute__((ext_vector_type(8)));
typedef float f32x4 __attribute__((ext_vector_type(4)));
typedef float f32x2 __attribute__((ext_vector_type(2)));
typedef unsigned u32x4 __attribute__((ext_vector_type(4)));
typedef unsigned u32x2 __attribute__((ext_vector_type(2)));
typedef int i32x4 __attribute__((ext_vector_type(4)));
typedef int i32x8 __attribute__((ext_vector_type(8)));
constexpr int BM = 256, BK = 64, HALF = 128, HTB = HALF * BK * 2, STAGE_BYTES = 8 * HTB, NXCD = 8, WGM = 8;

__host__ __device__ __forceinline__ int lds_byte(int r, int c) { const int st = (r >> 4) * 2 + (c >> 5), rr = r & 15, cc = c & 31, ob = rr * 64 + cc * 2; return st * 1024 + (ob ^ (((ob >> 9) & 1) << 5)); }
__host__ __device__ __forceinline__ void stage_rc(int b, int& R, int& C) { const int st = b / 1024, sb = b % 1024, swz = sb ^ (((sb >> 9) & 1) << 5); R = (st >> 1) * 16 + swz / 64; C = (st & 1) * 32 + (swz % 64) / 2; }
__host__ __device__ __forceinline__ int perm32(int rho) { const int n = rho >> 4, i = rho & 15; return 8 * (i >> 2) + 4 * n + (i & 3); }

__device__ __forceinline__ int lane_id() { int l; asm volatile("v_mbcnt_lo_u32_b32 %0, -1, 0\n\tv_mbcnt_hi_u32_b32 %0, -1, %0" : "=v"(l)); return l; }
struct Unit { int pm, pn, e, tile, cnt; };
struct Gemm { const bf16* A; const bf16* Bt; int K; };

struct StaticOrder {
    int nM, nN, nwg, G, c;
    __device__ void init(int M, int N, int G_, int c_) { nM = M / BM; nN = N / BM; nwg = nM * nN; G = G_; c = c_; }
    __device__ bool next(int i, Unit& u) const {
        const long L = (long)i * G + c; if (L >= nwg) return false;
        int wgid = (int)L; { const int q = nwg / NXCD, r = nwg % NXCD, xcd = wgid % NXCD, off = wgid / NXCD; wgid = (xcd < r ? xcd * (q + 1) : r * (q + 1) + (xcd - r) * q) + off; }
        const int nig = WGM * nN, gid = wgid / nig, fm = gid * WGM, gsz = (nM - fm) < WGM ? (nM - fm) : WGM;
        u.pm = fm + ((wgid % nig) % gsz); u.pn = (wgid % nig) / gsz; u.e = 0; u.tile = 0; u.cnt = 0; return true;
    }
    __device__ __forceinline__ unsigned row_off(const Unit&, int) const { return 0u; }
    __device__ __forceinline__ void a_ready(const Unit&) const {}
    __device__ __forceinline__ void done(const Unit&) const {}
    struct Pre {}; __device__ __forceinline__ void pre(int, Pre&) const {}
    __device__ __forceinline__ void post(int, Pre&) const {}
    __device__ __forceinline__ bool half(const Unit&) const { return false; }
};

__device__ __forceinline__ unsigned cvt_pk_bf16(float lo, float hi) { unsigned r; asm volatile("v_cvt_pk_bf16_f32 %0, %1, %2" : "=v"(r) : "v"(lo), "v"(hi)); return r; }
typedef __bf16 bf16x2_t __attribute__((ext_vector_type(2)));
__device__ __forceinline__ unsigned cvt_pk_bf16_cv(float lo, float hi) { const f32x2 v = {lo, hi}; const bf16x2_t b = __builtin_convertvector(v, bf16x2_t); return __builtin_bit_cast(unsigned, b); }
__device__ __forceinline__ float fsigm(float x) { return __builtin_amdgcn_rcpf(1.0f + __builtin_amdgcn_exp2f(-1.4426950409f * x)); }
__device__ __forceinline__ float fgelu(float x) { const float u = x + 0.044715f * x * x * x; return x * __builtin_amdgcn_rcpf(1.0f + __builtin_amdgcn_exp2f(-2.3022082f * u)); }
__device__ __forceinline__ f32x4 vexp2(const f32x4 t) { f32x4 e;
#pragma unroll
    for (int i = 0; i < 4; ++i) e[i] = __builtin_amdgcn_exp2f(t[i]);
    return e; }
__device__ __forceinline__ f32x4 vrcp(const f32x4 t) { f32x4 e;
#pragma unroll
    for (int i = 0; i < 4; ++i) e[i] = __builtin_amdgcn_rcpf(t[i]);
    return e; }
__device__ __forceinline__ f32x4 vgelu_den(const f32x4 x) { return 1.f + vexp2(x * (x * x * (-0.10294324f) + (-2.3022082f))); }
__device__ __forceinline__ f32x4 vsigm_den(const f32x4 x) { return 1.f + vexp2(x * (-1.4426950409f)); }
__device__ __forceinline__ float hsum4(const f32x4 v) { return (v[0] + v[1]) + (v[2] + v[3]); }

__device__ __forceinline__ i32x8 cat8(const bf16x8 lo, const bf16x8 hi) { const i32x4 a = __builtin_bit_cast(i32x4, lo), b = __builtin_bit_cast(i32x4, hi); return __builtin_shufflevector(a, b, 0, 1, 2, 3, 4, 5, 6, 7); }
template <class Epi, class Sched, bool ALIGN_EPI, bool SP2, bool GATHER, bool FP8 = false>
__device__ __forceinline__ void gemm_phase(LAS unsigned char* lds, const Gemm g, const Sched& S, const Epi& E, const int wave_) {
    int lane = lane_id(); asm volatile("" : "+v"(lane));
    const int wid = wave_, tid = wid * 64 + lane, wr = wid >> 2, wc = wid & 3, fr = lane & 15, fq = lane >> 4;
    int K_ = g.K; if constexpr (FP8) asm volatile("" : "+s"(K_));
    const int K = K_, nt = K / BK;
    int sR[2], sC[2];
    unsigned voffB[2], vA0[2], vA1[2], nvA0[2], nvA1[2];
#pragma unroll
    for (int i = 0; i < 2; ++i) { stage_rc(tid * 16 + i * 8192, sR[i], sC[i]); const int Rb = Epi::PERM ? ((sR[i] & ~31) + perm32(sR[i] & 31)) : sR[i];
        voffB[i] = (unsigned)(Rb * K + sC[i]) * 2u; vA0[i] = (unsigned)(sR[i] * K + sC[i]) * 2u; vA1[i] = vA0[i]; nvA0[i] = vA0[i]; nvA1[i] = vA0[i]; }
    const size_t kstep = (size_t)(BK * 2);
    const size_t hstep = (size_t)HALF * K * 2;
    const size_t tstep = 2 * hstep;
    const size_t ahs = GATHER ? 0 : hstep;
    const unsigned ldsw = (unsigned)wid * 1024u;
    const int aoff = lds_byte(wr * 64 + fr, fq * 8), boff = lds_byte(wc * 32 + fr, fq * 8);
#define PG8_SA(b, h) (((b) * 2 + (h)) * HTB)
#define PG8_SB(b, h) ((4 + (b) * 2 + (h)) * HTB)
#define PG8_STAGE(bufoff, gbase, voff) do { _Pragma("unroll") for (int _i = 0; _i < 2; ++_i) \
        __builtin_amdgcn_global_load_lds((const unsigned*)((const char*)(gbase) + (voff)[_i]), (LAS unsigned*)(lds + (bufoff) + ldsw + _i * 8192), 16, 0, 0); } while (0)
#define PG8_LDA(dst, b, h) do { if constexpr (FP8) { _Pragma("unroll") for (int m = 0; m < 4; ++m) dst##q[m] = cat8(*(const LAS bf16x8*)(lds + PG8_SA(b, h) + aoff + m * 2048), *(const LAS bf16x8*)(lds + PG8_SA(b, h) + aoff + m * 2048 + 1024)); } \
        else { _Pragma("unroll") for (int m = 0; m < 4; ++m) _Pragma("unroll") for (int k = 0; k < 2; ++k) dst[m][k] = *(const LAS bf16x8*)(lds + PG8_SA(b, h) + aoff + m * 2048 + k * 1024); } } while (0)
#define PG8_LDB(dst, b, h) do { if constexpr (FP8) { _Pragma("unroll") for (int n = 0; n < 2; ++n) dst##q[n] = cat8(*(const LAS bf16x8*)(lds + PG8_SB(b, h) + boff + n * 2048), *(const LAS bf16x8*)(lds + PG8_SB(b, h) + boff + n * 2048 + 1024)); } \
        else { _Pragma("unroll") for (int n = 0; n < 2; ++n) _Pragma("unroll") for (int k = 0; k < 2; ++k) dst[n][k] = *(const LAS bf16x8*)(lds + PG8_SB(b, h) + boff + n * 2048 + k * 1024); } } while (0)
#define PG8_MMA(ai, bj, At, Bt) do { __builtin_amdgcn_s_setprio(1); \
        if constexpr (FP8) { _Pragma("unroll") for (int m = 0; m < 4; ++m) _Pragma("unroll") for (int n = 0; n < 2; ++n) \
            asm volatile("v_mfma_scale_f32_16x16x128_f8f6f4 %0, %1, %2, %0, %3, %3 op_sel_hi:[0,0,0]" : "+v"(acc[ai][bj][m][n]) : "v"(Bt##q[n]), "v"(At##q[m]), "v"(mxs)); } \
        else { _Pragma("unroll") for (int m = 0; m < 4; ++m) _Pragma("unroll") for (int n = 0; n < 2; ++n) _Pragma("unroll") for (int k = 0; k < 2; ++k) \
            acc[ai][bj][m][n] = __builtin_amdgcn_mfma_f32_16x16x32_bf16(Bt[n][k], At[m][k], acc[ai][bj][m][n], 0, 0, 0); } \
        __builtin_amdgcn_s_setprio(0); } while (0)
#define PG8_WAIT_V(n) asm volatile("s_waitcnt vmcnt(" #n ")" ::: "memory")
#define PG8_WAIT_L(n) asm volatile("s_waitcnt lgkmcnt(" #n ")" ::: "memory")
#define PG8_BAR __builtin_amdgcn_s_barrier()
#define PG8_SCHED __builtin_amdgcn_sched_barrier(0)
    Unit cur, nxt; int ui = 0;
    if (!S.next(0, cur)) return;
    f32x4 acc[2][2][4][2];
#pragma unroll
    for (int a = 0; a < 2; ++a)
#pragma unroll
        for (int b = 0; b < 2; ++b)
#pragma unroll
            for (int m = 0; m < 4; ++m)
#pragma unroll
                for (int n = 0; n < 2; ++n) acc[a][b][m][n] = (f32x4){0.f, 0.f, 0.f, 0.f};
    int mxs = 0x7F7F7F7F; if constexpr (FP8) asm volatile("" : "+v"(mxs));
    bf16x8 At[4][2], B0[2][2], B1[2][2]; i32x8 Atq[4], B0q[2], B1q[2];
    const char* cA = GATHER ? (const char*)g.A : (const char*)g.A + (size_t)cur.pm * tstep; const char* cB = (const char*)g.Bt + (size_t)cur.pn * tstep;
    if constexpr (GATHER) {
#pragma unroll
        for (int i = 0; i < 2; ++i) { vA0[i] = S.row_off(cur, sR[i]) + (unsigned)sC[i] * 2u; vA1[i] = S.row_off(cur, HALF + sR[i]) + (unsigned)sC[i] * 2u; nvA0[i] = vA0[i]; nvA1[i] = vA1[i]; }
    }
    S.a_ready(cur);
    if constexpr (SP2) {
        PG8_STAGE(PG8_SB(0, 0), cB, voffB); PG8_STAGE(PG8_SB(0, 1), cB + hstep, voffB); PG8_STAGE(PG8_SA(0, 0), cA, vA0); PG8_STAGE(PG8_SA(0, 1), cA + ahs, vA1);
        if (wr == 1) PG8_BAR;
        PG8_WAIT_V(2); PG8_BAR;
        PG8_STAGE(PG8_SB(1, 0), cB + kstep, voffB); PG8_STAGE(PG8_SA(1, 0), cA + kstep, vA0); PG8_STAGE(PG8_SB(1, 1), cB + hstep + kstep, voffB);
        PG8_WAIT_V(6); PG8_BAR;
    } else {
        PG8_STAGE(PG8_SB(0, 0), cB, voffB); PG8_STAGE(PG8_SA(0, 0), cA, vA0); PG8_STAGE(PG8_SB(0, 1), cB + hstep, voffB); PG8_STAGE(PG8_SA(0, 1), cA + ahs, vA1);
        if (wr == 1) PG8_BAR;
        PG8_WAIT_V(4); PG8_BAR;
        PG8_STAGE(PG8_SB(1, 0), cB + kstep, voffB); PG8_STAGE(PG8_SA(1, 0), cA + kstep, vA0); PG8_STAGE(PG8_SB(1, 1), cB + hstep + kstep, voffB);
        PG8_WAIT_V(6); PG8_BAR;
    }
    for (;;) {
        const bool has_next = S.next(ui + 1, nxt);
        const char* nA = has_next ? (GATHER ? (const char*)g.A : (const char*)g.A + (size_t)nxt.pm * tstep) : cA; const char* nB = has_next ? (const char*)g.Bt + (size_t)nxt.pn * tstep : cB;
        const bool hf = S.half(cur);
        for (int t = 0; t < nt; t += 2) {
            const bool last = (t == nt - 2);
            const char* a1 = cA + (size_t)(t + 1) * kstep;
            const char* a2 = last ? nA : cA + (size_t)(t + 2) * kstep; const char* b2 = last ? nB : cB + (size_t)(t + 2) * kstep;
            const char* a3 = a2 + kstep; const char* b3 = b2 + kstep;
            if (last && has_next) S.a_ready(nxt);
            unsigned w0[2], w1[2];
            if constexpr (GATHER) {
                if (last && has_next) {
#pragma unroll
                    for (int i = 0; i < 2; ++i) { nvA0[i] = S.row_off(nxt, sR[i]) + (unsigned)sC[i] * 2u; nvA1[i] = S.row_off(nxt, HALF + sR[i]) + (unsigned)sC[i] * 2u; }
                }
#pragma unroll
                for (int i = 0; i < 2; ++i) { w0[i] = last ? nvA0[i] : vA0[i]; w1[i] = last ? nvA1[i] : vA1[i]; }
            } else {
#pragma unroll
                for (int i = 0; i < 2; ++i) { w0[i] = vA0[i]; w1[i] = vA0[i]; }
            }
            if constexpr (SP2) {
            PG8_LDB(B0, 0, 0); PG8_LDB(B1, 0, 1); PG8_SCHED; PG8_LDA(At, 0, 0); PG8_STAGE(PG8_SA(1, 1), a1 + ahs, vA1);
            PG8_WAIT_V(8); PG8_WAIT_L(0); PG8_BAR; PG8_MMA(0, 0, At, B0); PG8_MMA(0, 1, At, B1); PG8_BAR; PG8_SCHED;
            if (!hf) PG8_LDA(At, 0, 1); PG8_STAGE(PG8_SB(0, 0), b2, voffB); PG8_STAGE(PG8_SB(0, 1), b2 + hstep, voffB); PG8_STAGE(PG8_SA(0, 0), a2, w0);
            PG8_WAIT_V(8); PG8_WAIT_L(0); PG8_BAR; if (!hf) { PG8_MMA(1, 0, At, B0); PG8_MMA(1, 1, At, B1); } PG8_BAR; PG8_SCHED;
            PG8_LDB(B0, 1, 0); PG8_LDB(B1, 1, 1); PG8_SCHED; PG8_LDA(At, 1, 0); PG8_STAGE(PG8_SA(0, 1), a2 + ahs, w1);
            PG8_WAIT_V(8); PG8_WAIT_L(0); PG8_BAR; PG8_MMA(0, 0, At, B0); PG8_MMA(0, 1, At, B1); PG8_BAR; PG8_SCHED;
            if (!hf) PG8_LDA(At, 1, 1); PG8_STAGE(PG8_SB(1, 0), b3, voffB); PG8_STAGE(PG8_SB(1, 1), b3 + hstep, voffB); PG8_STAGE(PG8_SA(1, 0), a3, w0);
            PG8_WAIT_V(8); PG8_WAIT_L(0); PG8_BAR; if (!hf) { PG8_MMA(1, 0, At, B0); PG8_MMA(1, 1, At, B1); } PG8_BAR; PG8_SCHED;
            } else {
            PG8_LDB(B0, 0, 0); PG8_SCHED; PG8_LDA(At, 0, 0); PG8_STAGE(PG8_SA(1, 1), a1 + ahs, vA1);
            PG8_WAIT_L(8); PG8_BAR; PG8_WAIT_L(0); PG8_MMA(0, 0, At, B0); PG8_BAR; PG8_SCHED;
            PG8_LDB(B1, 0, 1); PG8_STAGE(PG8_SB(0, 0), b2, voffB);
            PG8_BAR; PG8_WAIT_L(0); PG8_MMA(0, 1, At, B1); PG8_BAR;
            PG8_LDA(At, 0, 1); PG8_STAGE(PG8_SA(0, 0), a2, w0);
            PG8_BAR; PG8_WAIT_L(0); PG8_MMA(1, 0, At, B0); PG8_BAR; PG8_SCHED;
            PG8_STAGE(PG8_SB(0, 1), b2 + hstep, voffB);
            PG8_WAIT_V(6); PG8_BAR; PG8_MMA(1, 1, At, B1); PG8_BAR;
            PG8_LDB(B0, 1, 0); PG8_SCHED; PG8_LDA(At, 1, 0); PG8_STAGE(PG8_SA(0, 1), a2 + ahs, w1);
            PG8_WAIT_L(8); PG8_BAR; PG8_WAIT_L(0); PG8_MMA(0, 0, At, B0); PG8_BAR; PG8_SCHED;
            PG8_LDB(B1, 1, 1); PG8_STAGE(PG8_SB(1, 0), b3, voffB);
            PG8_BAR; PG8_WAIT_L(0); PG8_MMA(0, 1, At, B1); PG8_BAR;
            PG8_LDA(At, 1, 1); PG8_STAGE(PG8_SA(1, 0), a3, w0);
            PG8_BAR; PG8_WAIT_L(0); PG8_MMA(1, 0, At, B0); PG8_BAR; PG8_SCHED;
            PG8_STAGE(PG8_SB(1, 1), b3 + hstep, voffB);
            PG8_WAIT_V(6); PG8_BAR; PG8_MMA(1, 1, At, B1); PG8_BAR;
            }
        }
        if constexpr (FP8) asm volatile("s_nop 15\n\ts_nop 15" ::: "memory");
        typename Sched::Pre pre_; S.pre(ui, pre_);
        if constexpr (ALIGN_EPI) { if (wr == 0) PG8_BAR; }
        E(acc, cur, wr, wc, fr, fq); S.done(cur); S.post(ui, pre_);
        if (!has_next) break;
#pragma unroll
        for (int a = 0; a < 2; ++a)
#pragma unroll
            for (int b = 0; b < 2; ++b)
#pragma unroll
                for (int m = 0; m < 4; ++m)
#pragma unroll
                    for (int n = 0; n < 2; ++n) acc[a][b][m][n] = (f32x4){0.f, 0.f, 0.f, 0.f};
        cur = nxt; cA = nA; cB = nB; ++ui;
        if constexpr (GATHER) {
#pragma unroll
            for (int i = 0; i < 2; ++i) { vA0[i] = nvA0[i]; vA1[i] = nvA1[i]; }
        }
        if constexpr (ALIGN_EPI) { if (wr == 1) PG8_BAR; }
    }
    PG8_WAIT_V(0);
    if constexpr (!ALIGN_EPI) { if (wr == 0) PG8_BAR; }
    PG8_BAR;
#undef PG8_SA
#undef PG8_SB
#undef PG8_STAGE
#undef PG8_LDA
#undef PG8_LDB
#undef PG8_MMA
#undef PG8_WAIT_V
#undef PG8_WAIT_L
#undef PG8_BAR
#undef PG8_SCHED
}

__device__ __forceinline__ u32x4 pack8(const f32x4 v0, const f32x4 v1) { u32x4 w; w.x = cvt_pk_bf16(v0[0], v0[1]); w.y = cvt_pk_bf16(v0[2], v0[3]); w.z = cvt_pk_bf16(v1[0], v1[1]); w.w = cvt_pk_bf16(v1[2], v1[3]); return w; }
__device__ __forceinline__ u32x2 pack8_fp8(const f32x4 v0, const f32x4 v1) { int lo = __builtin_amdgcn_cvt_pk_fp8_f32(v0[0], v0[1], 0, false); lo = __builtin_amdgcn_cvt_pk_fp8_f32(v0[2], v0[3], lo, true);
    int hi = __builtin_amdgcn_cvt_pk_fp8_f32(v1[0], v1[1], 0, false); hi = __builtin_amdgcn_cvt_pk_fp8_f32(v1[2], v1[3], hi, true); return (u32x2){(unsigned)lo, (unsigned)hi}; }
__device__ __forceinline__ void unpack8_fp8(const u32x2 w, f32x4& v0, f32x4& v1) { const f32x2 a = __builtin_amdgcn_cvt_pk_f32_fp8((int)w.x, false), b = __builtin_amdgcn_cvt_pk_f32_fp8((int)w.x, true),
        c = __builtin_amdgcn_cvt_pk_f32_fp8((int)w.y, false), d = __builtin_amdgcn_cvt_pk_f32_fp8((int)w.y, true); v0 = (f32x4){a.x, a.y, b.x, b.y}; v1 = (f32x4){c.x, c.y, d.x, d.y}; }
__device__ __forceinline__ void unpack8(const u32x4 w, f32x4& v0, f32x4& v1) {
    v0[0] = __uint_as_float(w.x << 16); v0[1] = __uint_as_float(w.x & 0xffff0000u); v0[2] = __uint_as_float(w.y << 16); v0[3] = __uint_as_float(w.y & 0xffff0000u);
    v1[0] = __uint_as_float(w.z << 16); v1[1] = __uint_as_float(w.z & 0xffff0000u); v1[2] = __uint_as_float(w.w << 16); v1[3] = __uint_as_float(w.w & 0xffff0000u); }

struct Epi1 {
    static constexpr bool PERM = true;
    bf16 *Zl, *GA, *UB, *V; float* VPART;
    __device__ __forceinline__ void operator()(const f32x4 (&acc)[2][2][4][2], const Unit& u, int wr, int wc, int fr, int fq) const {
        const int row0 = u.pm * BM + wr * 64 + fr, pn = u.pn;
        if (pn < 4) {
            const int col0 = pn * 256 + wc * 32 + 8 * fq;
#pragma unroll
            for (int ai = 0; ai < 2; ++ai)
#pragma unroll
                for (int m = 0; m < 4; ++m) { bf16* rowp = Zl + (size_t)(row0 + ai * HALF + m * 16) * D + col0;
#pragma unroll
                    for (int bj = 0; bj < 2; ++bj) *(u32x4*)(rowp + bj * HALF) = pack8(acc[ai][bj][m][0], acc[ai][bj][m][1]); }
        } else if (pn < 20) {
            bf16* O = pn < 12 ? GA : UB; const int uu = pn < 12 ? pn - 4 : pn - 12; const int col0 = uu * 128 + wc * 32 + 8 * fq;
#pragma unroll
            for (int ai = 0; ai < 2; ++ai)
#pragma unroll
                for (int m = 0; m < 4; ++m) { f32x4 v[2];
#pragma unroll
                    for (int n = 0; n < 2; ++n) v[n] = acc[ai][0][m][n] * vrcp(vgelu_den(acc[ai][0][m][n]) * vsigm_den(acc[ai][1][m][n]));
                    *(u32x4*)(O + (size_t)(row0 + ai * HALF + m * 16) * D + col0) = pack8(v[0], v[1]); }
        } else {
            const int col0 = (pn - 20) * 256 + wc * 32 + 8 * fq;
#pragma unroll
            for (int ai = 0; ai < 2; ++ai)
#pragma unroll
                for (int m = 0; m < 4; ++m) { const int row = row0 + ai * HALF + m * 16; f32x4 s1v = {0.f, 0.f, 0.f, 0.f}, s2v = {0.f, 0.f, 0.f, 0.f};
#pragma unroll
                    for (int bj = 0; bj < 2; ++bj) { f32x4 v[2];
#pragma unroll
                        for (int n = 0; n < 2; ++n) { v[n] = acc[ai][bj][m][n] * vrcp(vgelu_den(acc[ai][bj][m][n])); s1v += v[n]; s2v += v[n] * v[n]; }
                        *(u32x4*)(V + (size_t)row * D + col0 + bj * HALF) = pack8(v[0], v[1]); }
                    float s1 = hsum4(s1v), s2 = hsum4(s2v);
                    s1 += __shfl_xor(s1, 16); s1 += __shfl_xor(s1, 32); s2 += __shfl_xor(s2, 16); s2 += __shfl_xor(s2, 32);
                    if (fq == 0) *(f32x2*)(VPART + (size_t)row * 32 + ((pn - 20) * 4 + wc) * 2) = (f32x2){s1, s2}; }
        }
    }
};
struct EpiPlain {
    static constexpr bool PERM = true;
    bf16* O;
    __device__ __forceinline__ void operator()(const f32x4 (&acc)[2][2][4][2], const Unit& u, int wr, int wc, int fr, int fq) const {
        const int row0 = u.pm * BM + wr * 64 + fr, col0 = u.pn * 256 + wc * 32 + 8 * fq;
#pragma unroll
        for (int ai = 0; ai < 2; ++ai)
#pragma unroll
            for (int m = 0; m < 4; ++m) { bf16* rowp = O + (size_t)(row0 + ai * HALF + m * 16) * D + col0;
#pragma unroll
                for (int bj = 0; bj < 2; ++bj) *(u32x4*)(rowp + bj * HALF) = pack8(acc[ai][bj][m][0], acc[ai][bj][m][1]); }
    }
};
struct Epi2 {
    static constexpr bool PERM = true;
    const bf16* XN; const float* RI0; const float* GINV; bf16* X1b; float* SS1;
    __device__ __forceinline__ void operator()(const f32x4 (&acc)[2][2][4][2], const Unit& u, int wr, int wc, int fr, int fq) const {
        const int row0 = u.pm * BM + wr * 64 + fr, col0 = u.pn * 256 + wc * 32 + 8 * fq;
#pragma unroll
        for (int ai = 0; ai < 2; ++ai)
#pragma unroll
            for (int m = 0; m < 4; ++m) { const int row = row0 + ai * HALF + m * 16; float ss = 0.f; const float ri = RI0[row];
#pragma unroll
                for (int bj = 0; bj < 2; ++bj) { f32x4 x0, x1; unpack8(*(const u32x4*)(XN + (size_t)row * D + col0 + bj * HALF), x0, x1);
                    const f32x4 g0 = *(const f32x4*)(GINV + col0 + bj * HALF), g1 = *(const f32x4*)(GINV + col0 + bj * HALF + 4);
                    const f32x4 v0 = acc[ai][bj][m][0] + x0 * ri * g0, v1 = acc[ai][bj][m][1] + x1 * ri * g1;
                    ss += hsum4(v0 * v0 + v1 * v1);
                    *(u32x4*)(X1b + (size_t)row * D + col0 + bj * HALF) = pack8(v0, v1); }
                ss += __shfl_xor(ss, 16); ss += __shfl_xor(ss, 32);
                if (fq == 0) SS1[(size_t)row * 16 + u.pn * 4 + wc] = ss; }
    }
};
struct EpiPle {
    static constexpr bool PERM = true; static constexpr float WSC = 1.f / 32.f;
    const bf16* X2b; const bf16* PU; const float* RSTD2; bf16* X3; float* SS3;
    __device__ __forceinline__ void operator()(const f32x4 (&acc)[2][2][4][2], const Unit& u, int wr, int wc, int fr, int fq) const {
        const int row0 = u.pm * BM + wr * 64 + fr, col0 = u.pn * 256 + wc * 32 + 8 * fq;
#pragma unroll
        for (int ai = 0; ai < 2; ++ai)
#pragma unroll
            for (int m = 0; m < 4; ++m) { const int row = row0 + ai * HALF + m * 16; float ss = 0.f; const float r2n = RSTD2[row] * (-1.4426950409f * WSC);
#pragma unroll
                for (int bj = 0; bj < 2; ++bj) { const size_t o = (size_t)row * D + col0 + bj * HALF;
                    f32x4 x0, x1, p0, p1; unpack8(*(const u32x4*)(X2b + o), x0, x1); unpack8(*(const u32x4*)(PU + o), p0, p1);
                    const f32x4 v0 = x0 + vrcp(1.f + vexp2(acc[ai][bj][m][0] * r2n)) * p0, v1 = x1 + vrcp(1.f + vexp2(acc[ai][bj][m][1] * r2n)) * p1;
                    ss += hsum4(v0 * v0 + v1 * v1);
                    *(u32x4*)(X3 + o) = pack8(v0, v1); }
                ss += __shfl_xor(ss, 16); ss += __shfl_xor(ss, 32);
                if (fq == 0) SS3[(size_t)row * 16 + u.pn * 4 + wc] = ss; }
    }
};

struct EpiPleFinal {
    static constexpr bool PERM = true; static constexpr float WSC = 1.f / 32.f;
    const bf16* X2b; const bf16* PU; const float* RSTD2; const float* fn; float* out; float* XCH; unsigned* cnt; LAS float* xl; int wave;
    __device__ __forceinline__ void operator()(f32x4 (&acc)[2][2][4][2], const Unit& u, int wr, int wc, int fr, int fq) const {
        const int tid = wave * 64 + lane_id();
        const int rl0 = wr * 64 + fr, col0 = u.pn * 256 + wc * 32 + 8 * fq;
#pragma unroll
        for (int ai = 0; ai < 2; ++ai)
#pragma unroll
            for (int m = 0; m < 4; ++m) { const int rl = rl0 + ai * HALF + m * 16, row = u.pm * BM + rl; float ss = 0.f; const float r2n = RSTD2[row] * (-1.4426950409f * WSC);
#pragma unroll
                for (int bj = 0; bj < 2; ++bj) { const size_t o = (size_t)row * D + col0 + bj * HALF;
                    f32x4 x0, x1, p0, p1; unpack8(*(const u32x4*)(X2b + o), x0, x1); unpack8(*(const u32x4*)(PU + o), p0, p1);
                    const f32x4 v0 = x0 + vrcp(1.f + vexp2(acc[ai][bj][m][0] * r2n)) * p0, v1 = x1 + vrcp(1.f + vexp2(acc[ai][bj][m][1] * r2n)) * p1;
                    ss += hsum4(v0 * v0 + v1 * v1);
                    acc[ai][bj][m][0] = v0; acc[ai][bj][m][1] = v1; }
                ss += __shfl_xor(ss, 16); ss += __shfl_xor(ss, 32);
                if (fq == 0) xl[rl * 4 + wc] = ss; }
        __syncthreads();
        if (tid < 256) { const f32x4 p = *(const LAS f32x4*)(xl + tid * 4);
            __hip_atomic_store(XCH + (size_t)(u.pm * BM + tid) * 4 + u.pn, (p[0] + p[1]) + (p[2] + p[3]), __ATOMIC_RELAXED, __HIP_MEMORY_SCOPE_AGENT); }
        asm volatile("s_waitcnt vmcnt(0)" ::: "memory");
        if (tid < 256 && (tid & 63) == 0) __hip_atomic_fetch_add(cnt + 64 * u.pm, 1u, __ATOMIC_RELAXED, __HIP_MEMORY_SCOPE_AGENT);
        if (tid < 64) { unsigned sp = 0;
            while ((unsigned)__builtin_amdgcn_readfirstlane(__hip_atomic_load(cnt + 64 * u.pm, __ATOMIC_RELAXED, __HIP_MEMORY_SCOPE_AGENT)) < 16u) { if (++sp > (1u << 22)) break; __builtin_amdgcn_s_sleep(1); } }
        __syncthreads();
        if (tid < 256) { const float* xs = XCH + (size_t)(u.pm * BM + tid) * 4; float tot = 0.f;
#pragma unroll
            for (int q = 0; q < 4; ++q) tot += __hip_atomic_load(xs + q, __ATOMIC_RELAXED, __HIP_MEMORY_SCOPE_AGENT);
            xl[1024 + tid] = rsqrtf(tot * (1.f / D) + EPS); }
        __syncthreads();
#pragma unroll
        for (int ai = 0; ai < 2; ++ai)
#pragma unroll
            for (int m = 0; m < 4; ++m) { const int rl = rl0 + ai * HALF + m * 16; const float rs = xl[1024 + rl]; float* op = out + (size_t)(u.pm * BM + rl) * D + col0;
#pragma unroll
                for (int bj = 0; bj < 2; ++bj) { const f32x4 f0 = *(const f32x4*)(fn + col0 + bj * HALF), f1 = *(const f32x4*)(fn + col0 + bj * HALF + 4);
                    *(f32x4*)(op + bj * HALF) = acc[ai][bj][m][0] * rs * f0; *(f32x4*)(op + bj * HALF + 4) = acc[ai][bj][m][1] * rs * f1; } }
    }
};

template <int MODE> struct MoeOrder {
    const LAS int* tab; const int* LIST; unsigned* dcnt; unsigned rowb;
    __device__ __forceinline__ bool next(int i, Unit& u) const {
        const int n = __builtin_amdgcn_readfirstlane(tab[0]); if (i >= n) return false;
        const LAS int* p = tab + 4 + 8 * i;
        u.pm = __builtin_amdgcn_readfirstlane(p[0]); u.pn = __builtin_amdgcn_readfirstlane(p[1]); u.e = __builtin_amdgcn_readfirstlane(p[2]);
        u.tile = __builtin_amdgcn_readfirstlane(p[3]); u.cnt = __builtin_amdgcn_readfirstlane(p[4]); return true;
    }
    __device__ __forceinline__ unsigned row_off(const Unit& u, int r) const { int idx = u.tile * 256 + r; idx = idx < u.cnt ? idx : u.cnt - 1; const int pair = LIST[u.e * 16384 + idx]; return (unsigned)(pair >> 1) * rowb; }
    __device__ __forceinline__ void a_ready(const Unit&) const {}
    struct Pre {}; __device__ __forceinline__ void pre(int, Pre&) const {}
    __device__ __forceinline__ void post(int, Pre&) const {}
    __device__ __forceinline__ bool half(const Unit& u) const { return MODE == 1 && (u.cnt - u.tile * 256) <= 128; }
    __device__ __forceinline__ void done(const Unit& u) const {
        if constexpr (MODE == 1) {
            asm volatile("s_waitcnt vmcnt(0)" ::: "memory");
            if (lane_id() == 0) __hip_atomic_fetch_add(dcnt + 64 * u.pm, 1u, __ATOMIC_RELAXED, __HIP_MEMORY_SCOPE_AGENT);
        }
    }
};
__device__ __forceinline__ void store16_sc1(void* p, u32x4 v) { asm volatile("global_store_dwordx4 %0, %1, off sc1\n\ts_nop 1" :: "v"(p), "v"(v) : "memory"); }
__device__ __forceinline__ void store8_sc1(void* p, u32x2 v) { asm volatile("global_store_dwordx2 %0, %1, off sc1\n\ts_nop 1" :: "v"(p), "v"(v) : "memory"); }
struct EpiMoe1 {
    static constexpr bool PERM = true;
    unsigned char* H; const float* LISTR;
    __device__ __forceinline__ void operator()(const f32x4 (&acc)[2][2][4][2], const Unit& u, int wr, int wc, int fr, int fq) const {
        const int col0 = (u.pn & 1) * 128 + wc * 32 + 8 * fq;
#pragma unroll
        for (int ai = 0; ai < 2; ++ai)
#pragma unroll
            for (int m = 0; m < 4; ++m) { const int r = ai * HALF + wr * 64 + m * 16 + fr; int idx = u.tile * 256 + r; idx = idx < u.cnt ? idx : u.cnt - 1;
                const float rs = LISTR[u.e * 16384 + idx] * (1.f / 32.f); f32x4 v[2];
#pragma unroll
                for (int n = 0; n < 2; ++n) { const f32x4 a1 = acc[ai][0][m][n] * rs, a3 = acc[ai][1][m][n] * rs; v[n] = a1 * a3 * vrcp(vsigm_den(a1)); }
                store8_sc1(H + (size_t)(u.pm * 256 + r) * 256 + col0, pack8_fp8(v[0], v[1])); }
    }
};
struct EpiMoe2 {
    static constexpr bool PERM = true;
    unsigned char* Y; const int* LIST; const float* LISTG;
    __device__ __forceinline__ void operator()(const f32x4 (&acc)[2][2][4][2], const Unit& u, int wr, int wc, int fr, int fq) const {
        const int col0 = (u.pn & 3) * 256 + wc * 32 + 8 * fq;
        int pr[2][4]; float gt[2][4];
#pragma unroll
        for (int ai = 0; ai < 2; ++ai)
#pragma unroll
            for (int m = 0; m < 4; ++m) { int idx = u.tile * 256 + ai * HALF + wr * 64 + m * 16 + fr; idx = idx < u.cnt ? idx : u.cnt - 1; pr[ai][m] = LIST[u.e * 16384 + idx]; gt[ai][m] = LISTG[u.e * 16384 + idx]; }
#pragma unroll
        for (int ai = 0; ai < 2; ++ai)
#pragma unroll
            for (int m = 0; m < 4; ++m) { const int idx = u.tile * 256 + ai * HALF + wr * 64 + m * 16 + fr;
                if (idx < u.cnt) { const float g = gt[ai][m]; unsigned char* yp = Y + (size_t)pr[ai][m] * D + col0;
#pragma unroll
                    for (int bj = 0; bj < 2; ++bj) *(u32x2*)(yp + bj * HALF) = pack8_fp8(acc[ai][bj][m][0] * g, acc[ai][bj][m][1] * g); } }
    }
};
}

constexpr int NWAVES = 8;
constexpr int RING_BYTES = 131072, LDSCTL_OFF = 139264, MISC_OFF = LDSCTL_OFF + 320, TAB_OFF = LDSCTL_OFF + 512, LDS_BYTES = 147456;
constexpr size_t WS_WLRU = 8 * MiB + 512 * 1024;
constexpr size_t WS_WSGU = 8 * MiB + 768 * 1024;
constexpr size_t WS_WR = 9 * MiB;
constexpr size_t WS_WUP = 9 * MiB + 512 * 1024;
constexpr size_t WS_WIN = 10 * MiB;
constexpr size_t WS_WOUT = 22 * MiB;
constexpr size_t WS_WG = 24 * MiB;
constexpr size_t WS_W13 = 26 * MiB;
constexpr size_t WS_W2 = 58 * MiB;
constexpr size_t WS_PB = 234 * MiB;
constexpr size_t WS_RSTD1 = 242 * MiB;
constexpr size_t WS_RSTD0 = 242 * MiB + 128 * 1024;
constexpr size_t WS_GINV = 242 * MiB + 256 * 1024;
constexpr size_t WS_SPL8 = 242 * MiB + 512 * 1024;
constexpr size_t WS_XCH = 243 * MiB;
constexpr size_t WS_LISTG = 244 * MiB;
constexpr size_t WS_LISTR = 246 * MiB;
constexpr size_t WS_MEGA_END = 248 * MiB;
constexpr int CW_BAR = 4096;
constexpr int CW_DONE1 = 131072;
constexpr int CW_MIX = 147456;
constexpr int CW_PANEL = 65536;

typedef GAS unsigned gu32;
#define RLX_AGENT __ATOMIC_RELAXED, __HIP_MEMORY_SCOPE_AGENT
#define LDS_WAIT() asm volatile("s_waitcnt lgkmcnt(0)" ::: "memory")
#define VM_WAIT() asm volatile("s_waitcnt vmcnt(0)" ::: "memory")

#define XB_TMO      128
#define XB_XCNT(j)  (256  + 64 * (j))
#define XB_XSUB(j)  (1280 + 64 * (j))
#define XB_XGEN(j)  (2304 + 64 * (j))
#define XB_TOP      3328
#define XB_TOPGEN   3392
#define XCD_BAR_WORDS 3456
#define XB_SPIN_CAP (1u << 18)
__device__ __forceinline__ unsigned xb_ld(unsigned* p)              { return __hip_atomic_load(p, __ATOMIC_RELAXED, __HIP_MEMORY_SCOPE_AGENT); }
__device__ __forceinline__ unsigned xb_add(unsigned* p, unsigned v) { return __hip_atomic_fetch_add(p, v, __ATOMIC_RELAXED, __HIP_MEMORY_SCOPE_AGENT); }
__device__ __forceinline__ unsigned xb_xcc_id() { return (unsigned)__builtin_amdgcn_s_getreg((3 << 11) | 20) & 0xFu; }
#define XB_SPIN(cond, bar) do { unsigned _sp = 0; while (cond) { __builtin_amdgcn_s_sleep(1); \
    if ((++_sp & 255u) == 0u) { if (xb_ld(&(bar)[XB_TMO])) break; if (_sp > XB_SPIN_CAP) { atomicAdd(&(bar)[XB_TMO], 1u); break; } } } } while (0)
struct XcdBarrier { unsigned* bar; unsigned x; volatile LAS unsigned* st; int wave; };
__device__ __forceinline__ XcdBarrier xcd_barrier_post(unsigned* bar, volatile LAS unsigned* st, int wave) {
    XcdBarrier b; b.bar = bar; b.x = xb_xcc_id(); b.st = st; b.wave = wave;
    if (wave == 0 && pg8::lane_id() == 0) (void)xb_add(&bar[XB_XCNT(b.x)], 1u);
    return b;
}
__device__ __forceinline__ void xcd_barrier_complete(unsigned* bar, unsigned x, unsigned& nloc, unsigned& nx) {
    const unsigned G = gridDim.x * gridDim.y * gridDim.z;
    unsigned sum, cnt, mine, sp = 0u;
    for (;;) {
        sum = 0u; cnt = 0u; mine = 0u;
#pragma unroll
        for (unsigned j = 0; j < 16; ++j) { const unsigned c = xb_ld(&bar[XB_XCNT(j)]); sum += c; cnt += (c > 0u) ? 1u : 0u; mine = (j == x) ? c : mine; }
        if (sum == G) break;
        __builtin_amdgcn_s_sleep(1);
        if ((++sp & 255u) == 0u) { if (xb_ld(&bar[XB_TMO])) break; if (sp > XB_SPIN_CAP) { atomicAdd(&bar[XB_TMO], 1u); break; } }
    }
    nloc = mine > 0u ? mine : 1u; nx = cnt > 0u ? cnt : 1u;
}
__device__ __forceinline__ void xcd_barrier(const XcdBarrier& b) {
    asm volatile("s_waitcnt vmcnt(0)" ::: "memory");
    __syncthreads();
    if (b.wave == 0 && pg8::lane_id() == 0) {
        unsigned* bar = b.bar;
        __builtin_amdgcn_s_waitcnt(0);
        unsigned nloc = b.st[0], nx = b.st[1];
        if (nloc == 0u) { xcd_barrier_complete(bar, b.x, nloc, nx); b.st[0] = nloc; b.st[1] = nx; }
        const unsigned old = xb_add(&bar[XB_XSUB(b.x)], 1u);
        const unsigned gen = old / nloc;
        if (old + 1u == (gen + 1u) * nloc) {
            __builtin_amdgcn_fence(__ATOMIC_RELEASE, "agent");
            asm volatile("s_waitcnt vmcnt(0)" ::: "memory");
            const unsigned og = xb_add(&bar[XB_TOP], 1u);
            const unsigned tg = og / nx;
            if (og + 1u == (tg + 1u) * nx) xb_add(&bar[XB_TOPGEN], 1u);
            else XB_SPIN(xb_ld(&bar[XB_TOPGEN]) == tg, bar);
            __builtin_amdgcn_fence(__ATOMIC_ACQUIRE, "agent");
            xb_add(&bar[XB_XGEN(b.x)], 1u);
            asm volatile("s_waitcnt vmcnt(0)" ::: "memory");
        } else {
            XB_SPIN(xb_ld(&bar[XB_XGEN(b.x)]) == gen, bar);
            __builtin_amdgcn_fence(__ATOMIC_ACQUIRE, "agent");
            asm volatile("s_waitcnt vmcnt(0)" ::: "memory");
        }
    }
    __syncthreads();
}

__device__ __forceinline__ unsigned pk2(float lo, float hi) { return (unsigned)f2bf(lo) | ((unsigned)f2bf(hi) << 16); }

struct TrItem { pg8::f32x4 v[8]; };
template <bool NT = false> __device__ __forceinline__ void tr_load(TrItem& t, const float* __restrict__ W, int ldn, int k0, int n_src0, int lane) {
    const int kb = lane >> 3, n4 = lane & 7;
    const float* src = W + (size_t)(k0 + 8 * kb) * ldn + n_src0 + 4 * n4;
#pragma unroll
    for (int q = 0; q < 8; ++q) t.v[q] = NT ? __builtin_nontemporal_load((const pg8::f32x4*)(src + (size_t)q * ldn)) : *(const pg8::f32x4*)(src + (size_t)q * ldn);
}
template <bool NT = false> __device__ __forceinline__ void tr_store(TrItem& t, int k0, bf16* __restrict__ WT, int Kd, int drow0, const float* __restrict__ gk, int lane) {
    const int kb = lane >> 3, n4 = lane & 7;
    if (gk) { const pg8::f32x4 g0 = *(const pg8::f32x4*)(gk + k0 + 8 * kb), g1 = *(const pg8::f32x4*)(gk + k0 + 8 * kb + 4);
#pragma unroll
        for (int q = 0; q < 8; ++q) t.v[q] = t.v[q] * (q < 4 ? g0[q & 3] : g1[q & 3]); }
#pragma unroll
    for (int i = 0; i < 4; ++i) { pg8::u32x4 o; o.x = pk2(t.v[0][i], t.v[1][i]); o.y = pk2(t.v[2][i], t.v[3][i]); o.z = pk2(t.v[4][i], t.v[5][i]); o.w = pk2(t.v[6][i], t.v[7][i]);
        if (NT) __builtin_nontemporal_store(o, (pg8::u32x4*)(WT + (size_t)(drow0 + 4 * n4 + i) * Kd + k0 + 8 * kb)); else *(pg8::u32x4*)(WT + (size_t)(drow0 + 4 * n4 + i) * Kd + k0 + 8 * kb) = o; }
}
__device__ __forceinline__ void tr_store_fp8(TrItem& t, int k0, unsigned char* __restrict__ W8, int Kd, int drow0, const float* __restrict__ gk, float wscale, int lane) {
    const int kb = lane >> 3, n4 = lane & 7;
    pg8::f32x4 g0 = {wscale, wscale, wscale, wscale}, g1 = g0;
    if (gk) { g0 = *(const pg8::f32x4*)(gk + k0 + 8 * kb) * wscale; g1 = *(const pg8::f32x4*)(gk + k0 + 8 * kb + 4) * wscale; }
#pragma unroll
    for (int i = 0; i < 4; ++i) { const pg8::f32x4 a = {t.v[0][i] * g0[0], t.v[1][i] * g0[1], t.v[2][i] * g0[2], t.v[3][i] * g0[3]}, b = {t.v[4][i] * g1[0], t.v[5][i] * g1[1], t.v[6][i] * g1[2], t.v[7][i] * g1[3]};
        *(pg8::u32x2*)(W8 + (size_t)(drow0 + 4 * n4 + i) * Kd + k0 + 8 * kb) = pg8::pack8_fp8(a, b); }
}
__device__ __forceinline__ void p0_transpose_item(const float* __restrict__ W, int ldn, int k0, int n_src0, bf16* __restrict__ WT, int Kd, int drow0, const float* __restrict__ gk, LAS float*, int lane) {
    TrItem t; tr_load<true>(t, W, ldn, k0, n_src0, lane); tr_store(t, k0, WT, Kd, drow0, gk, lane);
}
__device__ __forceinline__ int win_dest_row(int n) {
    const int grp = n >> 10, j = n & 1023;
    switch (grp) {
        case 0: return j;
        case 1: return 1024 + (j >> 7) * 256 + (j & 127);
        case 2: return 3072 + (j >> 7) * 256 + (j & 127);
        case 3: return 5120 + j;
        case 4: return 1024 + (j >> 7) * 256 + 128 + (j & 127);
        default: return 3072 + (j >> 7) * 256 + 128 + (j & 127);
    }
}


struct DefW { const float* const* in; unsigned char* ws; };
constexpr int DF_OUT = 8 * 32, DF_E13 = 32 * 2 * 64, DF_E2 = 32 * 64, DF_G = 8 * 32, DF_UP = 2 * 32, DF_N = DF_OUT + DF_E13 + DF_E2 + DF_G + DF_UP;
struct DefDesc { const float* W; const float* gk; bf16* WT; int ldn, k0, n0, Kd, drow; };
__device__ __forceinline__ DefDesc deferred_desc(const DefW& w, int it) {
    int r = it; DefDesc d;
    if (r < DF_OUT) { const int kb = r / 16, np = r % 16; d = DefDesc{w.in[15], nullptr, (bf16*)(w.ws + WS_WOUT), 1024, kb * 64, np * 64, 1024, np * 64}; return d; } r -= DF_OUT;
    if (r < DF_E13) { const int e = r / 128, which = (r / 64) & 1, q = r % 64, kb = q / 4, np = q % 4;
        const int f0 = np * 64, drow = e * 512 + (f0 >> 7) * 256 + which * 128 + (f0 & 127);
        d = DefDesc{w.in[which ? 22 : 21] + (size_t)e * 1024 * 256, w.in[16], (bf16*)(w.ws + WS_W13), 256, kb * 64, f0, 1024, drow}; return d; } r -= DF_E13;
    if (r < DF_E2) { const int e = r / 64, q = r % 64, kb = q / 16, np = q % 16;
        d = DefDesc{w.in[23] + (size_t)e * 256 * 1024, nullptr, (bf16*)(w.ws + WS_W2), 1024, kb * 64, np * 64, 256, e * 1024 + np * 64}; return d; } r -= DF_E2;
    if (r < DF_G) { const int kb = r / 16, np = r % 16; d = DefDesc{w.in[25], w.in[24], (bf16*)(w.ws + WS_WG), 1024, kb * 64, np * 64, 1024, np * 64}; return d; } r -= DF_G;
    { const int kb = r / 16, np = r % 16; d = DefDesc{w.in[26], nullptr, (bf16*)(w.ws + WS_WUP), 1024, kb * 64, np * 64, 256, np * 64}; return d; }
}
struct Gemm1Order : pg8::StaticOrder {
    DefW w; int wave; int gi;
    struct Pre {}; __device__ __forceinline__ void pre(int, Pre&) const {}
    __device__ __forceinline__ void post(int ui, Pre&) const {
        if (ui != gi) return;
        const int lane = pg8::lane_id(), slot = c * 8 + wave, nslot = G * 8;
        for (int it = slot; it < DF_N; it += nslot) { const DefDesc d = deferred_desc(w, it); TrItem t0, t1;
            tr_load<true>(t0, d.W, d.ldn, d.k0, d.n0, lane); tr_load<true>(t1, d.W, d.ldn, d.k0, d.n0 + 32, lane);
            if ((it >= DF_OUT && it < DF_OUT + DF_E13) || (it >= DF_OUT + DF_E13 + DF_E2 && it < DF_OUT + DF_E13 + DF_E2 + DF_G)) {
                tr_store_fp8(t0, d.k0, (unsigned char*)d.WT, 1024, d.drow, d.gk, 32.f, lane); tr_store_fp8(t1, d.k0, (unsigned char*)d.WT, 1024, d.drow + 32, d.gk, 32.f, lane);
            } else if (it >= DF_OUT + DF_E13 && it < DF_OUT + DF_E13 + DF_E2) {
                tr_store_fp8(t0, d.k0, (unsigned char*)d.WT, 256, d.drow, nullptr, 16.f, lane); tr_store_fp8(t1, d.k0, (unsigned char*)d.WT, 256, d.drow + 32, nullptr, 16.f, lane);
            } else { tr_store<true>(t0, d.k0, d.WT, d.Kd, d.drow, d.gk, lane); tr_store<true>(t1, d.k0, d.WT, d.Kd, d.drow + 32, d.gk, lane); } }
        const pg8::f32x4* psrc = (const pg8::f32x4*)w.in[1]; unsigned long long* pdst = (unsigned long long*)(w.ws + WS_PB);
        for (int ch = slot; ch < 8192; ch += nslot) { const size_t i0 = (size_t)ch * 128 + lane; const pg8::f32x4 v0 = __builtin_nontemporal_load(psrc + i0), v1 = __builtin_nontemporal_load(psrc + i0 + 64);
            __builtin_nontemporal_store((unsigned long long)pk2(v0.x, v0.y) | ((unsigned long long)pk2(v0.z, v0.w) << 32), pdst + i0); __builtin_nontemporal_store((unsigned long long)pk2(v1.x, v1.y) | ((unsigned long long)pk2(v1.z, v1.w) << 32), pdst + i0 + 64); }
    }
};

constexpr int MY_VT = 0, MY_XA = 32768, MY_SP = 67584, MY_WS = 102400, MY_ST = 135168, MY_RS = 272;
__device__ __forceinline__ float bflo(unsigned u) { return __uint_as_float(u << 16); }
__device__ __forceinline__ float bfhi(unsigned u) { return __uint_as_float(u & 0xffff0000u); }
template <int N> __device__ __forceinline__ float row_shr(float ident, float v) {
    return __builtin_bit_cast(float, __builtin_amdgcn_update_dpp(__builtin_bit_cast(int, ident), __builtin_bit_cast(int, v), 0x110 + N, 0xf, 0xf, false)); }
#define MX_DPP_STEP(N) \
    "v_fmac_f32_dpp %4, %4, %0 row_shr:" #N " row_mask:0xf bank_mask:0xf\n\tv_fmac_f32_dpp %5, %5, %1 row_shr:" #N " row_mask:0xf bank_mask:0xf\n\t" \
    "v_fmac_f32_dpp %6, %6, %2 row_shr:" #N " row_mask:0xf bank_mask:0xf\n\tv_fmac_f32_dpp %7, %7, %3 row_shr:" #N " row_mask:0xf bank_mask:0xf\n\t" \
    "v_mul_f32_dpp %0, %0, %0 row_shr:" #N " row_mask:0xf bank_mask:0xf\n\tv_mul_f32_dpp %1, %1, %1 row_shr:" #N " row_mask:0xf bank_mask:0xf\n\t" \
    "v_mul_f32_dpp %2, %2, %2 row_shr:" #N " row_mask:0xf bank_mask:0xf\n\tv_mul_f32_dpp %3, %3, %3 row_shr:" #N " row_mask:0xf bank_mask:0xf\n\t"
__device__ __forceinline__ void scan16x4(pg8::f32x4& A, pg8::f32x4& U) { using pg8::f32x4;
    float a0 = A[0], a1 = A[1], a2 = A[2], a3 = A[3], u0 = U[0], u1 = U[1], u2 = U[2], u3 = U[3];
    asm("s_nop 1\n\t" MX_DPP_STEP(1) MX_DPP_STEP(2) MX_DPP_STEP(4) MX_DPP_STEP(8) "s_nop 0"
        : "+v"(a0), "+v"(a1), "+v"(a2), "+v"(a3), "+v"(u0), "+v"(u1), "+v"(u2), "+v"(u3));
    A = (f32x4){a0, a1, a2, a3}; U = (f32x4){u0, u1, u2, u3};
}
__device__ __forceinline__ void mixer_phase(LAS unsigned char* lds, const int vcu, const int G, const int tid, const int lane, const int wave,
                                            const bf16* __restrict__ Zl, const bf16* __restrict__ GA, const bf16* __restrict__ UB, const bf16* __restrict__ V, const float* __restrict__ VPART,
                                            unsigned long long* AGG, bf16* __restrict__ MG, unsigned* mixc, const bf16* __restrict__ WLRU, const bf16* __restrict__ WSGU, const float* __restrict__ SPL8, const float* const* in) {
    using namespace pg8;
    constexpr int RS = MY_RS;
    constexpr float L2E = 1.4426950409f;
    const int fr = lane & 15, grp = lane >> 4, cp = tid & 63, tg = wave;
    const int pr = lane & 3, sch = lane >> 2, srow = 8 * sch + 2 * pr;
    LAS float* ST = (LAS float*)(lds + MY_ST);
    int gprev = -1;
    f32x2 cw0, cw1, cw2, cw3, ccb;
    u32x4 zqa, zqb, zqc, zqd, zqe, vv00, vv01, vv10, vv11;
#define MX_ZR(k) ((k) < 4 ? zqa[(k) & 3] : (k) < 8 ? zqb[(k) & 3] : (k) < 12 ? zqc[(k) & 3] : (k) < 16 ? zqd[(k) & 3] : zqe[(k) & 3])
#define MX_SETZR(k, v) do { if ((k) < 4) zqa[(k) & 3] = (v); else if ((k) < 8) zqb[(k) & 3] = (v); else if ((k) < 12) zqc[(k) & 3] = (v); else if ((k) < 16) zqd[(k) & 3] = (v); else zqe[(k) & 3] = (v); } while (0)
#define MX_PREFETCH(uu) do { const int ck_ = (uu) >> 3, g_ = (uu) & 7, t0_ = ck_ * 128, c0_ = g_ * 128; const bool first_ = (ck_ & 15) == 0; \
        const unsigned zo_ = ((unsigned)(t0_ + 16 * tg) * D + c0_ + 2 * cp) * 2u; \
        _Pragma("unroll") for (int k = 0; k < 19; ++k) { unsigned zv_ = 0u; if (!(k < 3 && first_ && tg == 0)) zv_ = *(const unsigned*)((const char*)Zl + (zo_ + (unsigned)((k - 3) * D * 2))); MX_SETZR(k, zv_); } \
        { const unsigned vo_ = ((unsigned)(t0_ + srow) * D + c0_ + 16 * wave) * 2u; vv00 = *(const u32x4*)((const char*)V + vo_); vv01 = *(const u32x4*)((const char*)V + (vo_ + D * 2)); vv10 = *(const u32x4*)((const char*)V + (vo_ + 16)); vv11 = *(const u32x4*)((const char*)V + (vo_ + D * 2 + 16)); } \
        } while (0)
    zqe = (u32x4){0u, 0u, 0u, 0u};
#define MX_STATS_LOAD(uu, q0, q1) do { const unsigned vpo_ = ((unsigned)(((uu) >> 3) * 128 + (tid >> 2)) * 32 + (tid & 3) * 8) * 4u; q0 = *(const f32x4*)((const char*)VPART + vpo_); q1 = *(const f32x4*)((const char*)VPART + (vpo_ + 16)); } while (0)
#define MX_STATS_WRITE(q0, q1) do { float s1 = (q0[0] + q0[2]) + (q1[0] + q1[2]), s2 = (q0[1] + q0[3]) + (q1[1] + q1[3]); \
        s1 += __shfl_xor(s1, 1); s1 += __shfl_xor(s1, 2); s2 += __shfl_xor(s2, 1); s2 += __shfl_xor(s2, 2); \
        if ((tid & 3) == 0) { const float mean = s1 * (1.f / 1024.f); float var = s2 * (1.f / 1024.f) - mean * mean; var = var < 0.f ? 0.f : var; ST[tid >> 2] = mean; ST[128 + (tid >> 2)] = rsqrtf(var + EPS); } } while (0)
    int u = vcu;
    if (u < 1024) { MX_PREFETCH(u); f32x4 q0, q1; MX_STATS_LOAD(u, q0, q1); MX_STATS_WRITE(q0, q1); }
    for (; u < 1024; u += G) {
        const int ck = u >> 3, g = u & 7, t0 = ck * 128, c0 = g * 128, j = ck & 15;
        const int cch = c0 + 16 * wave + 4 * grp;
        if (g != gprev) {
            gprev = g;
#pragma unroll
            for (int it = 0; it < 4; ++it) { const int idx = it * 512 + tid, row = idx >> 4, ch = idx & 15;
                *(LAS u32x4*)(lds + MY_WS + row * 256 + ((ch ^ (row & 15)) << 4)) = *(const u32x4*)(WSGU + ((size_t)(g * 128 + row)) * 128 + ch * 8); }
            const int cc = c0 + 2 * cp;
            cw0 = *(const f32x2*)(in[4] + cc); cw1 = *(const f32x2*)(in[4] + 1024 + cc); cw2 = *(const f32x2*)(in[4] + 2048 + cc); cw3 = *(const f32x2*)(in[4] + 3072 + cc); ccb = *(const f32x2*)(in[5] + cc);
        }
        const int hblk = 2 * g + (wave >> 2), jj0 = (16 * wave) & 63;
        const bf16x8 bw00 = *(const bf16x8*)(WLRU + ((size_t)((0 * 16 + hblk) * 64 + jj0 + fr)) * 64 + 0 * 32 + 8 * grp), bw01 = *(const bf16x8*)(WLRU + ((size_t)((0 * 16 + hblk) * 64 + jj0 + fr)) * 64 + 1 * 32 + 8 * grp);
        const bf16x8 bw10 = *(const bf16x8*)(WLRU + ((size_t)((1 * 16 + hblk) * 64 + jj0 + fr)) * 64 + 0 * 32 + 8 * grp), bw11 = *(const bf16x8*)(WLRU + ((size_t)((1 * 16 + hblk) * 64 + jj0 + fr)) * 64 + 1 * 32 + 8 * grp);
        const f32x4 nba = *(const f32x4*)(in[7] + cch) * (-L2E), nbi = *(const f32x4*)(in[9] + cch) * (-L2E), ksp = *(const f32x4*)(SPL8 + cch);
        {
#pragma unroll
            for (int i = 0; i < 16; ++i) {
                const unsigned z0 = MX_ZR(i), z1 = MX_ZR(i + 1), z2 = MX_ZR(i + 2), z3 = MX_ZR(i + 3);
                const f32x2 xv = ccb + cw0 * (f32x2){bflo(z0), bfhi(z0)} + cw1 * (f32x2){bflo(z1), bfhi(z1)} + cw2 * (f32x2){bflo(z2), bfhi(z2)} + cw3 * (f32x2){bflo(z3), bfhi(z3)};
                *(LAS unsigned*)(lds + MY_XA + (16 * tg + i) * RS + 4 * cp) = cvt_pk_bf16(xv.x, xv.y);
            }
        }
        __syncthreads();
        {
            const float mua = ST[srow], rsa = ST[128 + srow], mub = ST[srow + 1], rsb = ST[128 + srow + 1];
#pragma unroll
            for (int ci = 0; ci < 2; ++ci) { const int chunk = 2 * wave + ci, cbase = c0 + 8 * chunk;
                f32x4 a0, a1, b0, b1; unpack8(ci ? vv10 : vv00, a0, a1); unpack8(ci ? vv11 : vv01, b0, b1);
                const f32x4 g0 = *(const f32x4*)(in[11] + cbase), g1 = *(const f32x4*)(in[11] + cbase + 4), l0 = *(const f32x4*)(in[12] + cbase), l1 = *(const f32x4*)(in[12] + cbase + 4);
                a0 = (a0 - mua) * rsa * g0 + l0; a1 = (a1 - mua) * rsa * g1 + l1; b0 = (b0 - mub) * rsb * g0 + l0; b1 = (b1 - mub) * rsb * g1 + l1;
#pragma unroll
                for (int i = 0; i < 8; ++i) { const int cl = 8 * chunk + i; const float va = i < 4 ? a0[i & 3] : a1[i & 3], vb = i < 4 ? b0[i & 3] : b1[i & 3];
                    *(LAS unsigned*)(lds + MY_VT + cl * 256 + ((sch ^ (cl & 15)) << 4) + 4 * pr) = cvt_pk_bf16(va, vb); }
            }
        }
        f32x4 R[8], I[8];
#pragma unroll
        for (int mt = 0; mt < 8; ++mt) { R[mt] = (f32x4){0.f, 0.f, 0.f, 0.f}; I[mt] = (f32x4){0.f, 0.f, 0.f, 0.f};
#pragma unroll
            for (int ks = 0; ks < 2; ++ks) { const bf16x8 a = *(const LAS bf16x8*)(lds + MY_XA + (mt * 16 + fr) * RS + ((wave >> 2) * 64 + ks * 32 + 8 * grp) * 2);
                R[mt] = __builtin_amdgcn_mfma_f32_16x16x32_bf16(ks ? bw01 : bw00, a, R[mt], 0, 0, 0); I[mt] = __builtin_amdgcn_mfma_f32_16x16x32_bf16(ks ? bw11 : bw10, a, I[mt], 0, 0, 0); } }
#pragma unroll
        for (int mt = 0; mt < 8; ++mt) {
            const u32x2 xw = *(const LAS u32x2*)(lds + MY_XA + (mt * 16 + fr) * RS + (16 * wave + 4 * grp) * 2);
            const f32x4 xa4 = {bflo(xw.x), bfhi(xw.x), bflo(xw.y), bfhi(xw.y)};
            const f32x4 t1 = R[mt] * (-L2E) + nba, t2 = I[mt] * (-L2E) + nbi;
            f32x4 d1, d2, inv;
#pragma unroll
            for (int r = 0; r < 4; ++r) { d1[r] = 1.f + __builtin_amdgcn_exp2f(t1[r]); d2[r] = 1.f + __builtin_amdgcn_exp2f(t2[r]); }
            const f32x4 dd = d1 * d2;
#pragma unroll
            for (int r = 0; r < 4; ++r) inv[r] = __builtin_amdgcn_rcpf(dd[r]);
            const f32x4 rr = d2 * inv, ii = d1 * inv, la = rr * ksp;
            const f32x4 w = la * (1.f + la * (0.5f + la * (0.16666667f + la * (0.041666667f + la * 0.0083333333f))));
            f32x4 av = 1.f + w;
            const f32x4 om = -w * (2.f + w);
            f32x4 uv;
#pragma unroll
            for (int r = 0; r < 4; ++r) uv[r] = __builtin_amdgcn_sqrtf(om[r]);
            uv = uv * ii * xa4;
            scan16x4(av, uv); R[mt] = av; I[mt] = uv;
        }
        {
            f32x4 Pc = {1.f, 1.f, 1.f, 1.f}, Hc = {0.f, 0.f, 0.f, 0.f};
#pragma unroll
            for (int mt = 0; mt < 8; ++mt) { Hc = Hc * R[mt] + I[mt]; Pc = Pc * R[mt]; }
            if (fr == 15) {
#pragma unroll
                for (int r = 0; r < 4; ++r) __hip_atomic_store(AGG + (size_t)ck * 1024 + cch + r, ((unsigned long long)__float_as_uint(Hc[r]) << 32) | (unsigned long long)__float_as_uint(Pc[r]), __ATOMIC_RELAXED, __HIP_MEMORY_SCOPE_AGENT);
            }
        }
        __syncthreads();
        if (u + G < 1024) MX_PREFETCH(u + G);
        unsigned long long ag0 = 0x000000003f800000ull, ag1 = 0x000000003f800000ull, ag2 = 0x000000003f800000ull, ag3 = 0x000000003f800000ull;
        if (j > 0 && fr < j) { const unsigned long long* ap = AGG + (size_t)(ck - j + fr) * 1024 + cch;
            ag0 = __hip_atomic_load(ap, __ATOMIC_RELAXED, __HIP_MEMORY_SCOPE_AGENT); ag1 = __hip_atomic_load(ap + 1, __ATOMIC_RELAXED, __HIP_MEMORY_SCOPE_AGENT);
            ag2 = __hip_atomic_load(ap + 2, __ATOMIC_RELAXED, __HIP_MEMORY_SCOPE_AGENT); ag3 = __hip_atomic_load(ap + 3, __ATOMIC_RELAXED, __HIP_MEMORY_SCOPE_AGENT); }
        {
            bf16x8 q[4];
#pragma unroll
            for (int ks = 0; ks < 4; ++ks) q[ks] = *(const LAS bf16x8*)(lds + MY_VT + (16 * wave + fr) * 256 + (((ks * 4 + grp) ^ fr) << 4));
#pragma unroll
            for (int mt = 0; mt < 8; ++mt) { f32x4 Sx = {0.f, 0.f, 0.f, 0.f};
#pragma unroll
                for (int ks = 0; ks <= mt / 2; ++ks) { const bf16x8 p = *(const LAS bf16x8*)(lds + MY_WS + (mt * 16 + fr) * 256 + (((ks * 4 + grp) ^ fr) << 4));
                    Sx = __builtin_amdgcn_mfma_f32_16x16x32_bf16(q[ks], p, Sx, 0, 0, 0); }
                *(LAS u32x2*)(lds + MY_SP + (mt * 16 + fr) * RS + (16 * wave + 4 * grp) * 2) = (u32x2){cvt_pk_bf16_cv(Sx[0], Sx[1]), cvt_pk_bf16_cv(Sx[2], Sx[3])}; }
        }
        {
            f32x4 hc0 = {0.f, 0.f, 0.f, 0.f};
            if (j > 0) {
                f32x4 lp, lh; unsigned spin = 0;
                for (;;) {
                    lp[0] = __uint_as_float((unsigned)ag0); lh[0] = __uint_as_float((unsigned)(ag0 >> 32)); lp[1] = __uint_as_float((unsigned)ag1); lh[1] = __uint_as_float((unsigned)(ag1 >> 32));
                    lp[2] = __uint_as_float((unsigned)ag2); lh[2] = __uint_as_float((unsigned)(ag2 >> 32)); lp[3] = __uint_as_float((unsigned)ag3); lh[3] = __uint_as_float((unsigned)(ag3 >> 32));
                    const bool ok = (lp[0] != 0.f) && (lp[1] != 0.f) && (lp[2] != 0.f) && (lp[3] != 0.f);
                    if (__all(ok)) break;
                    if (++spin > (1u << 22)) break;
                    __builtin_amdgcn_s_sleep(1);
                    if (fr < j) { const unsigned long long* ap = AGG + (size_t)(ck - j + fr) * 1024 + cch;
                        ag0 = __hip_atomic_load(ap, __ATOMIC_RELAXED, __HIP_MEMORY_SCOPE_AGENT); ag1 = __hip_atomic_load(ap + 1, __ATOMIC_RELAXED, __HIP_MEMORY_SCOPE_AGENT);
                        ag2 = __hip_atomic_load(ap + 2, __ATOMIC_RELAXED, __HIP_MEMORY_SCOPE_AGENT); ag3 = __hip_atomic_load(ap + 3, __ATOMIC_RELAXED, __HIP_MEMORY_SCOPE_AGENT); } }
                scan16x4(lp, lh);
#pragma unroll
                for (int r = 0; r < 4; ++r) hc0[r] = __shfl(lh[r], (lane & 48) | 15);
            }
            f32x4 s = hc0;
#pragma unroll
            for (int mt = 0; mt < 8; ++mt) { f32x4 hb;
#pragma unroll
                for (int r = 0; r < 4; ++r) hb[r] = __shfl(s[r], (lane & 48) | 15);
                s = R[mt] * s + I[mt];
                const f32x4 hv = I[mt] + R[mt] * hb;
                *(LAS u32x2*)(lds + MY_XA + (mt * 16 + fr) * RS + (16 * wave + 4 * grp) * 2) = (u32x2){cvt_pk_bf16(hv[0], hv[1]), cvt_pk_bf16(hv[2], hv[3])}; }
        }
        u32x4 ga[4], ub[4]; float bsr[4]; f32x4 nq0 = {0.f, 0.f, 0.f, 0.f}, nq1 = {0.f, 0.f, 0.f, 0.f};
        if (u + G < 1024) MX_STATS_LOAD(u + G, nq0, nq1);
#pragma unroll
        for (int it = 0; it < 4; ++it) { const int idx = it * 512 + tid, row = idx >> 4, ch = idx & 15; const unsigned o = ((unsigned)(t0 + row) * D + c0 + ch * 8) * 2u; ga[it] = *(const u32x4*)((const char*)GA + o); ub[it] = *(const u32x4*)((const char*)UB + o); bsr[it] = in[14][g * 128 + row]; }
        __syncthreads();
#pragma unroll
        for (int it = 0; it < 4; ++it) { const int idx = it * 512 + tid, row = idx >> 4, ch = idx & 15;
            f32x4 g0, g1, u0, u1, h0, h1, s0, s1; unpack8(ga[it], g0, g1); unpack8(ub[it], u0, u1);
            unpack8(*(const LAS u32x4*)(lds + MY_XA + row * RS + ch * 16), h0, h1); unpack8(*(const LAS u32x4*)(lds + MY_SP + row * RS + ch * 16), s0, s1);
            store16_sc1((char*)MG + ((unsigned)(t0 + row) * D + c0 + ch * 8) * 2u, pack8(g0 * h0 + u0 * (s0 + bsr[it]), g1 * h1 + u1 * (s1 + bsr[it]))); }
        if (u + G < 1024) MX_STATS_WRITE(nq0, nq1);
        asm volatile("s_waitcnt vmcnt(0)" ::: "memory");
        if (lane == 0) __hip_atomic_fetch_add(mixc + 64 * (ck >> 1), 1u, __ATOMIC_RELAXED, __HIP_MEMORY_SCOPE_AGENT);
        __syncthreads();
    }
#undef MX_PREFETCH
#undef MX_STATS_LOAD
#undef MX_STATS_WRITE
#undef MX_ZR
#undef MX_SETZR
}

__device__ __forceinline__ void build_moe_units(LAS int* tab1, LAS int* tab2, LAS int* tab3, const int* CNT, int vcu, int G, int wave, LAS int* flags) {
    const int tid = wave * 64 + pg8::lane_id();
    int NT = 0, my_e = 0, my_tile = 0, my_cnt = 0, my_rt = 0;
    for (int e = 0; e < 32; ++e) { const int cnt = CNT[e]; const int ntl = (cnt + 255) >> 8;
        if (tid >= NT && tid < NT + ntl) { my_e = e; my_tile = tid - NT; my_cnt = cnt; my_rt = tid; }
        NT += ntl; }
    const bool have = tid < NT;
    const bool heavy = have && (my_cnt - my_tile * 256) > 128;
    flags[tid] = heavy ? 1 : 0;
    __syncthreads();
    int hb = 0, NH = 0;
    for (int i = 0; i < NT; ++i) { const int f = flags[i]; NH += f; hb += (i < tid) ? f : 0; }
    const int slot = heavy ? hb : NH + (tid - hb);
    const int U1 = 2 * NT, U2 = 4 * NT; int nlate = (U1 > G && U1 < 2 * G) ? U1 - G : 0; if (G - nlate < 64) nlate = 0;
    const int Ge = G - nlate, c2 = vcu - nlate, ssplit = nlate ? G / 2 : NT, Lsplit = 4 * ssplit;
    const int n1 = vcu < U1 ? (U1 - 1 - vcu) / G + 1 : 0;
    const int tot2 = (c2 >= 0 && c2 < U2) ? (U2 - 1 - c2) / Ge + 1 : 0;
    int n2 = (c2 >= 0 && c2 < Lsplit) ? (Lsplit - 1 - c2) / Ge + 1 : 0; n2 = n2 < tot2 ? n2 : tot2;
    const int n3 = tot2 - n2;
    if (tid == 0) { tab1[0] = n1 < 12 ? n1 : 12; tab2[0] = n2 < 12 ? n2 : 12; tab3[0] = n3 < 12 ? n3 : 12; }
    if (have) {
#pragma unroll
        for (int q = 0; q < 2; ++q) { const int L = 2 * slot + q; if (L % G == vcu && L / G < 12) { LAS int* p = tab1 + 4 + 8 * (L / G); p[0] = my_rt; p[1] = my_e * 2 + q; p[2] = my_e; p[3] = my_tile; p[4] = my_cnt; } }
        if (c2 >= 0) {
#pragma unroll
            for (int q = 0; q < 4; ++q) { const int L2 = 4 * slot + q; if (L2 % Ge == c2) { const int k = L2 / Ge; const bool early = slot < ssplit; const int idx = early ? k : k - n2;
                if (idx >= 0 && idx < 12) { LAS int* p = (early ? tab2 : tab3) + 4 + 8 * idx; p[0] = my_rt; p[1] = my_e * 4 + q; p[2] = my_e; p[3] = my_tile; p[4] = my_cnt; } } }
        }
    }
    __syncthreads();
}
__device__ __forceinline__ void moe_wait_tiles(const LAS int* tab, unsigned* dcnt, int wave) {
    if (wave == 0) {
        const int n = __builtin_amdgcn_readfirstlane(tab[0]);
        for (int i = 0; i < n; ++i) { const int rt = __builtin_amdgcn_readfirstlane(tab[4 + 8 * i]); unsigned sp = 0;
            while ((unsigned)__builtin_amdgcn_readfirstlane(__hip_atomic_load(dcnt + 64 * rt, __ATOMIC_RELAXED, __HIP_MEMORY_SCOPE_AGENT)) < 16u) { if (++sp > (1u << 22)) break; __builtin_amdgcn_s_sleep(2); } }
        __builtin_amdgcn_fence(__ATOMIC_ACQUIRE, "agent");
        asm volatile("s_waitcnt vmcnt(0)" ::: "memory");
    }
    __syncthreads();
}

struct Args { const float* in[28]; float* out; unsigned char* ws; int ph_lo, ph_hi, li, pad; };

__global__ void __launch_bounds__(NWAVES * 64, 2) mega_fwd(Args args) {
    extern __shared__ __attribute__((aligned(16))) unsigned char lds_raw[];
    LAS unsigned char* lds = (LAS unsigned char*)lds_raw;
    volatile LAS unsigned* MISC = (volatile LAS unsigned*)(lds + MISC_OFF);
    const int tid0 = threadIdx.x, wave = __builtin_amdgcn_readfirstlane(tid0 >> 6);
#define PHASE_IDS() int lane = pg8::lane_id(); asm volatile("" : "+v"(lane)); const int tid = wave * 64 + lane; (void)tid
    const int G = gridDim.x;
    const int vcu = (G % 8 == 0) ? ((int)blockIdx.x % 8) * (G / 8) + (int)blockIdx.x / 8 : (int)blockIdx.x;
    unsigned char* ws = args.ws;
    unsigned* ctl = (unsigned*)(ws + WS_CTL);
    for (int u = tid0; u < (LDS_BYTES - LDSCTL_OFF) / 4; u += NWAVES * 64) ((LAS unsigned*)(lds + LDSCTL_OFF))[u] = 0u;
    __syncthreads();
    XcdBarrier bar = xcd_barrier_post(ctl + CW_BAR + args.li * XCD_BAR_WORDS, MISC + 8, wave);
    const int lo = args.ph_lo, hi = args.ph_hi;
#define IN(k) (lo <= (k) && (k) < hi)
#define BOTH(k) (IN(k) && IN((k) + 1))
    const float* const* in = args.in;
    bf16 *XN = (bf16*)(ws + WS_A0), *MG = (bf16*)args.out, *X2b = (bf16*)(ws + WS_A0);
    float *RSTD0 = (float*)(ws + WS_RSTD0), *GINV = (float*)(ws + WS_GINV);
    bf16 *Zl = (bf16*)(ws + WS_A1), *X1b = (bf16*)args.out + (size_t)T * D;
    bf16 *GA = (bf16*)(ws + WS_A2), *UB = (bf16*)(ws + WS_A3), *V = (bf16*)(ws + WS_A4);
    bf16 *X3 = (bf16*)(ws + WS_A3);
    unsigned char* X1q = ws + WS_A1 + 16 * MiB;
    unsigned char* X2q = ws + WS_A1;
    bf16 *PU = (bf16*)(ws + WS_A2);
    bf16 *Pb = (bf16*)(ws + WS_PB);
    bf16 *WinT = (bf16*)(ws + WS_WIN), *WoutT = (bf16*)(ws + WS_WOUT), *WgT = (bf16*)(ws + WS_WG), *W13T = (bf16*)(ws + WS_W13), *W2T = (bf16*)(ws + WS_W2), *WupT = (bf16*)(ws + WS_WUP);
    float *VPART = (float*)(ws + WS_VPART), *SS1 = (float*)(ws + WS_SS1), *SS3 = (float*)(ws + WS_SS3), *RSTD2 = (float*)(ws + WS_RSTD2), *RSTD1 = (float*)(ws + WS_RSTD1), *LISTG = (float*)(ws + WS_LISTG), *LISTR = (float*)(ws + WS_LISTR);
    int *CNT = (int*)(ws + WS_CTL), *LIST = (int*)(ws + WS_LIST), *TOKE = (int*)(ws + WS_TOKE);
    bf16 *Hb = (bf16*)(ws + WS_A2), *Yb = (bf16*)(ws + WS_A3), *WrT = (bf16*)(ws + WS_WR), *WLRU = (bf16*)(ws + WS_WLRU), *WSGU = (bf16*)(ws + WS_WSGU);
    unsigned long long* AGGQ = (unsigned long long*)(ws + WS_AGG); float* SPL8 = (float*)(ws + WS_SPL8);

    if (IN(0)) {
        PHASE_IDS();
        LAS float* scr = (LAS float*)(lds + wave * 16384);
        const bool tab_fast = (G * 512 == 131072);
        float tf_lru = 0.f, tf_sgu = 0.f, tf10 = 0.f, tf2 = 1.f, tfr = 0.f;
        if (tab_fast) {
            const int i = vcu * 512 + tid, gate = i >> 16, h = (i >> 12) & 15, j = (i >> 6) & 63, ii = i & 63;
            const float f_lru = (gate ? in[8] : in[6])[(h * 64 + ii) * 64 + j], f_sgu = in[13][i];
            const int i10 = i < 1024 ? i : 0; const float f10 = in[10][i10], f2 = in[2][i10];
            const int n = (i >> 10) & 63, k = i & 1023; const float fa = in[17][k * 4 + (n < 4 ? n : 0)], fb = in[19][k * 32 + ((n >= 4 && n < 36) ? n - 4 : 0)], fk = in[16][k];
            tf_lru = f_lru; tf_sgu = f_sgu; tf10 = f10; tf2 = f2; tfr = n < 4 ? fa * fk : (n < 36 ? fb * fk : 0.f);
        }
        const int gw = vcu * NWAVES + wave, NGW = G * NWAVES;
        for (int it = gw; it < 16 * 192; it += NGW) { const int kb = it / 192, nb = it % 192; p0_transpose_item(in[3], 6144, kb * 64, nb * 32, WinT, 1024, win_dest_row(nb * 32), nullptr, scr, lane); }
        if (tab_fast) { const int i = vcu * 512 + tid, t = (i >> 7) & 127, s_ = i & 127;
            WLRU[i] = f2bf(tf_lru); WSGU[i] = s_ <= t ? f2bf(tf_sgu) : (bf16)0;
            if (i < 1024) { SPL8[i] = -8.f * log1pf(expf(-tf10)); GINV[i] = 1.f / tf2; }
            if (i < 64 * 1024) WrT[i] = f2bf(tfr); }
        for (int m = gw; m < T; m += 2 * NGW) {
            const int m2 = m + NGW < T ? m + NGW : m;
            const pg8::f32x4* xr = (const pg8::f32x4*)(in[0] + (size_t)m * D) + lane; const pg8::f32x4* xr2 = (const pg8::f32x4*)(in[0] + (size_t)m2 * D) + lane; const pg8::f32x4* gr = (const pg8::f32x4*)in[2] + lane;
            pg8::f32x4 v[4], w[4]; float s = 0.f, s2 = 0.f;
#pragma unroll
            for (int j = 0; j < 4; ++j) { v[j] = __builtin_nontemporal_load(xr + 64 * j); w[j] = __builtin_nontemporal_load(xr2 + 64 * j); }
#pragma unroll
            for (int j = 0; j < 4; ++j) { s += (v[j].x * v[j].x + v[j].y * v[j].y) + (v[j].z * v[j].z + v[j].w * v[j].w); s2 += (w[j].x * w[j].x + w[j].y * w[j].y) + (w[j].z * w[j].z + w[j].w * w[j].w); }
            const float rstd = rsqrtf(wave_sum(s) * (1.f / D) + EPS), rstd2 = rsqrtf(wave_sum(s2) * (1.f / D) + EPS);
            if (lane == 0) { RSTD0[m] = 1.f / rstd; RSTD0[m2] = 1.f / rstd2; }
            unsigned long long* o8 = (unsigned long long*)(XN + (size_t)m * D) + lane; unsigned long long* o82 = (unsigned long long*)(XN + (size_t)m2 * D) + lane;
#pragma unroll
            for (int j = 0; j < 4; ++j) { const pg8::f32x4 gg = gr[64 * j];
                o8[64 * j] = (unsigned long long)pk2(v[j].x * rstd * gg.x, v[j].y * rstd * gg.y) | ((unsigned long long)pk2(v[j].z * rstd * gg.z, v[j].w * rstd * gg.w) << 32);
                o82[64 * j] = (unsigned long long)pk2(w[j].x * rstd2 * gg.x, w[j].y * rstd2 * gg.y) | ((unsigned long long)pk2(w[j].z * rstd2 * gg.z, w[j].w * rstd2 * gg.w) << 32); }
        }
        if (!tab_fast) {
        for (int i = vcu * 512 + tid; i < 2 * 16 * 64 * 64; i += G * 512) { const int gate = i >> 16, h = (i >> 12) & 15, j = (i >> 6) & 63, ii = i & 63;
            WLRU[i] = f2bf(in[gate ? 8 : 6][(h * 64 + ii) * 64 + j]); }
        for (int i = vcu * 512 + tid; i < 8 * 128 * 128; i += G * 512) { const int t = (i >> 7) & 127, s = i & 127; WSGU[i] = s <= t ? f2bf(in[13][i]) : (bf16)0; }
        for (int i = vcu * 512 + tid; i < 1024; i += G * 512) { SPL8[i] = -8.f * log1pf(expf(-in[10][i])); GINV[i] = 1.f / in[2][i]; }
        for (int i = vcu * 512 + tid; i < 64 * 1024; i += G * 512) { const int n = i >> 10, k = i & 1023; float v = 0.f;
            if (n < 4) v = in[17][k * 4 + n] * in[16][k]; else if (n < 36) v = in[19][k * 32 + (n - 4)] * in[16][k];
            WrT[i] = f2bf(v); }
        }
        if (BOTH(0)) xcd_barrier(bar);
    }
    if (IN(1)) {
        { pg8::Gemm g{XN, WinT, 1024}; Gemm1Order S; S.init(T, 6144, G, (int)blockIdx.x);
          S.wave = wave; { const int upw = (64 * 24) / G > 0 ? (64 * 24) / G : 1; S.gi = (int)blockIdx.x % upw; } S.w = DefW{args.in, ws};
          pg8::Epi1 E{Zl, GA, UB, V, VPART};
          pg8::gemm_phase<pg8::Epi1, Gemm1Order, true, true, false>(lds, g, S, E, wave); }
        if (BOTH(1)) xcd_barrier(bar);
    }

    if (IN(3)) {
        PHASE_IDS();
        mixer_phase(lds, vcu, G, tid, lane, wave, Zl, GA, UB, V, VPART, AGGQ, MG, ctl + CW_MIX, WLRU, WSGU, SPL8, in);
    }
    if (IN(4)) {
        pg8::Gemm g{MG, WoutT, 1024}; pg8::StaticOrder S; S.init(T, 1024, G, (int)blockIdx.x);
        pg8::Epi2 E{XN, RSTD0, GINV, X1b, SS1};
        if (BOTH(3)) {
            if (wave == 0) { pg8::Unit u0;
                for (int i = 0; S.next(i, u0); ++i) { unsigned sp = 0;
                    while ((unsigned)__builtin_amdgcn_readfirstlane(__hip_atomic_load(ctl + CW_MIX + 64 * u0.pm, __ATOMIC_RELAXED, __HIP_MEMORY_SCOPE_AGENT)) < 128u) { if (++sp > (1u << 22)) break; __builtin_amdgcn_s_sleep(2); } }
                __builtin_amdgcn_fence(__ATOMIC_ACQUIRE, "agent");
                asm volatile("s_waitcnt vmcnt(0)" ::: "memory"); }
            __syncthreads();
        }
        pg8::gemm_phase<pg8::Epi2, pg8::StaticOrder, true, true, false>(lds, g, S, E, wave);
        if (BOTH(4)) xcd_barrier(bar);
    }

    if (IN(5)) {
        PHASE_IDS();
        constexpr int LS = 52;
        LAS float* sP = (LAS float*)lds;
        LAS float* sL = (LAS float*)(lds + 8 * 64 * LS * 4);
        LAS int* sCnt = (LAS int*)(lds + 9 * 64 * LS * 4); LAS int* sBase = sCnt + 32;
        const int fr = lane & 15, grp = lane >> 4;
        for (int tile = vcu; tile < T / 64; tile += G) {
            const int tok0 = tile * 64;
            if (tid < 32) sCnt[tid] = 0;
            pg8::bf16x8 a[4][4], b[3][4];
#pragma unroll
            for (int mt = 0; mt < 4; ++mt)
#pragma unroll
                for (int ks = 0; ks < 4; ++ks) a[mt][ks] = *(const pg8::bf16x8*)(X1b + (size_t)(tok0 + 16 * mt + fr) * D + wave * 128 + ks * 32 + 8 * grp);
#pragma unroll
            for (int nt = 0; nt < 3; ++nt)
#pragma unroll
                for (int ks = 0; ks < 4; ++ks) b[nt][ks] = *(const pg8::bf16x8*)(WrT + (size_t)(16 * nt + fr) * D + wave * 128 + ks * 32 + 8 * grp);
            pg8::f32x4 q0 = {0.f, 0.f, 0.f, 0.f}, q1 = q0, q2 = q0, q3 = q0;
#pragma unroll
            for (int mt = 0; mt < 4; ++mt)
#pragma unroll
                for (int ks = 0; ks < 4; ++ks) { pg8::f32x4 e0, e1; pg8::unpack8(__builtin_bit_cast(pg8::u32x4, a[mt][ks]), e0, e1);
                    *(pg8::u32x2*)(X1q + (size_t)(tok0 + 16 * mt + fr) * D + wave * 128 + ks * 32 + 8 * grp) = pg8::pack8_fp8(e0, e1); }
            if (tid < 64) { const float* sp = SS1 + (size_t)(tok0 + tid) * 16; q0 = *(const pg8::f32x4*)sp; q1 = *(const pg8::f32x4*)(sp + 4); q2 = *(const pg8::f32x4*)(sp + 8); q3 = *(const pg8::f32x4*)(sp + 12); }
#pragma unroll
            for (int mt = 0; mt < 4; ++mt)
#pragma unroll
                for (int nt = 0; nt < 3; ++nt) { pg8::f32x4 acc = {0.f, 0.f, 0.f, 0.f};
#pragma unroll
                    for (int ks = 0; ks < 4; ++ks) acc = __builtin_amdgcn_mfma_f32_16x16x32_bf16(a[mt][ks], b[nt][ks], acc, 0, 0, 0);
#pragma unroll
                    for (int r = 0; r < 4; ++r) sP[(wave * 64 + 16 * mt + 4 * grp + r) * LS + 16 * nt + fr] = acc[r]; }
            __syncthreads();
            { const int tk = tid >> 3, c0 = (tid & 7) * 6;
#pragma unroll
              for (int c = 0; c < 6; ++c) { float sum = 0.f;
#pragma unroll
                  for (int w = 0; w < 8; ++w) sum += sP[(w * 64 + tk) * LS + c0 + c];
                  sL[tk * LS + c0 + c] = sum; } }
            __syncthreads();
            int e1 = 0, e2 = 0, r1 = 0, r2 = 0; float g1 = 0.f, g2 = 0.f, rstd = 0.f;
            if (tid < 64) {
                const int t = tok0 + tid;
                const pg8::f32x4 qs = (q0 + q1) + (q2 + q3);
                const float ss = (qs[0] + qs[1]) + (qs[2] + qs[3]);
                rstd = rsqrtf(ss * (1.f / D) + EPS);
                const LAS float* l = sL + tid * LS;
                float gl[4];
#pragma unroll
                for (int q = 0; q < 4; ++q) gl[q] = rstd * l[q] + in[18][q];
                float mx = gl[0]; int gi = 0;
#pragma unroll
                for (int q = 1; q < 4; ++q) if (gl[q] > mx) { mx = gl[q]; gi = q; }
                float den = 0.f;
#pragma unroll
                for (int q = 0; q < 4; ++q) den += expf(gl[q] - mx);
                const float gtop = 1.f / den;
                float m1 = -3.0e38f, m2 = -3.0e38f; int i1 = 0, i2 = 0;
                for (int j = 0; j < 8; ++j) { const float v = rstd * l[4 + gi * 8 + j] + in[20][gi * 8 + j];
                    if (v > m1) { m2 = m1; i2 = i1; m1 = v; i1 = j; } else if (v > m2) { m2 = v; i2 = j; } }
                const float p2 = expf(m2 - m1);
                g1 = gtop / (1.f + p2); g2 = gtop * p2 / (1.f + p2);
                e1 = gi * 8 + i1; e2 = gi * 8 + i2;
                r1 = __hip_atomic_fetch_add(&sCnt[e1], 1, __ATOMIC_RELAXED, __HIP_MEMORY_SCOPE_WORKGROUP); r2 = __hip_atomic_fetch_add(&sCnt[e2], 1, __ATOMIC_RELAXED, __HIP_MEMORY_SCOPE_WORKGROUP);
            }
            __syncthreads();
            if (tid < 32) { const int c = sCnt[tid]; sBase[tid] = c ? atomicAdd(&CNT[tid], c) : 0; }
            __syncthreads();
            if (tid < 64) { const int t = tok0 + tid, p1 = e1 * 16384 + sBase[e1] + r1, p2 = e2 * 16384 + sBase[e2] + r2;
                LIST[p1] = t * 2; LIST[p2] = t * 2 + 1; LISTG[p1] = g1; LISTG[p2] = g2; LISTR[p1] = rstd; LISTR[p2] = rstd; }
            __syncthreads();
        }
        if (BOTH(5)) xcd_barrier(bar);
    }
    if (IN(6)) {
        LAS int* tab1 = (LAS int*)(lds + TAB_OFF); LAS int* tab2 = (LAS int*)(lds + TAB_OFF + 512); LAS int* tab3 = (LAS int*)(lds + TAB_OFF + 1024);
        build_moe_units(tab1, tab2, tab3, CNT, vcu, G, wave, (LAS int*)lds);
        unsigned* dcnt = ctl + CW_DONE1;
        { pg8::Gemm g{(const bf16*)X1q, W13T, 512}; pg8::MoeOrder<1> S{tab1, LIST, dcnt, 1024u};
          pg8::EpiMoe1 E{(unsigned char*)Hb, LISTR};
          pg8::gemm_phase<pg8::EpiMoe1, pg8::MoeOrder<1>, true, true, true, true>(lds, g, S, E, wave); }
        pg8::Gemm g2{Hb, W2T, 128}; pg8::EpiMoe2 E2{(unsigned char*)Yb, LIST, LISTG};
        moe_wait_tiles(tab2, dcnt, wave);
        { pg8::MoeOrder<0> S{tab2, LIST, dcnt, 2048u}; pg8::gemm_phase<pg8::EpiMoe2, pg8::MoeOrder<0>, true, true, false, true>(lds, g2, S, E2, wave); }
        moe_wait_tiles(tab3, dcnt, wave);
        { pg8::MoeOrder<0> S{tab3, LIST, dcnt, 2048u}; pg8::gemm_phase<pg8::EpiMoe2, pg8::MoeOrder<0>, true, true, false, true>(lds, g2, S, E2, wave); }
        if (BOTH(6)) xcd_barrier(bar);
    }
    if (IN(8)) {
        const bool split = (G % 16 == 0);
        const int q8 = (int)blockIdx.x >> 3, x8 = (int)blockIdx.x & 7;
        const bool do_gemm = !split || (q8 & 1), do_comb = !split || !(q8 & 1);
        if (do_comb) {
            PHASE_IDS();
            const int NGW = (split ? G / 2 : G) * NWAVES, gw = (split ? (q8 >> 1) * 8 + x8 : vcu) * NWAVES + wave;
            for (int row = gw; row < T; row += 2 * NGW) {
                const int row2 = row + NGW; const bool two = row2 < T; const int rb = two ? row2 : row;
                pg8::u32x4 la[2][2]; pg8::u32x2 lb[2][2], lc[2][2];
#pragma unroll
                for (int rr = 0; rr < 2; ++rr)
#pragma unroll
                    for (int hh = 0; hh < 2; ++hh) { const int r = rr ? rb : row;
                        la[rr][hh] = __builtin_nontemporal_load((const pg8::u32x4*)(X1b + (size_t)r * D + hh * 512 + lane * 8));
                        lb[rr][hh] = __builtin_nontemporal_load((const pg8::u32x2*)((const unsigned char*)Yb + (size_t)r * 2 * D + hh * 512 + lane * 8));
                        lc[rr][hh] = __builtin_nontemporal_load((const pg8::u32x2*)((const unsigned char*)Yb + ((size_t)r * 2 + 1) * D + hh * 512 + lane * 8)); }
#pragma unroll
                for (int rr = 0; rr < 2; ++rr) { const int r = rr ? rb : row; float ss = 0.f;
#pragma unroll
                    for (int hh = 0; hh < 2; ++hh) { pg8::f32x4 a0, a1, b0, b1, c0, c1; pg8::unpack8(la[rr][hh], a0, a1); pg8::unpack8_fp8(lb[rr][hh], b0, b1); pg8::unpack8_fp8(lc[rr][hh], c0, c1);
                        a0 = a0 + (b0 + c0) * (1.f / 16.f); a1 = a1 + (b1 + c1) * (1.f / 16.f);
                        ss += pg8::hsum4(a0 * a0 + a1 * a1);
                        if (rr == 0 || two) { *(pg8::u32x4*)(X2b + (size_t)r * D + hh * 512 + lane * 8) = pg8::pack8(a0, a1); *(pg8::u32x2*)(X2q + (size_t)r * D + hh * 512 + lane * 8) = pg8::pack8_fp8(a0, a1); } }
                    ss = wave_sum(ss);
                    if (lane == 0 && (rr == 0 || two)) RSTD2[r] = rsqrtf(ss * (1.f / D) + EPS); }
            }
        }
        if (do_gemm) {
            pg8::Gemm g{Pb, WupT, 256}; pg8::StaticOrder S; S.init(T, 1024, split ? G / 2 : G, split ? (q8 >> 1) * 8 + x8 : (int)blockIdx.x);
            pg8::EpiPlain E{PU};
            pg8::gemm_phase<pg8::EpiPlain, pg8::StaticOrder, true, true, false>(lds, g, S, E, wave);
        }
        if (BOTH(8)) xcd_barrier(bar);
    }
    const bool fuse_final = (G == 256);
    if (IN(9)) {
        pg8::Gemm g{(const bf16*)X2q, WgT, 512}; pg8::StaticOrder S; S.init(T, 1024, G, (int)blockIdx.x);
        if (fuse_final) {
            pg8::EpiPleFinal E{X2b, PU, RSTD2, in[27], args.out, (float*)(ws + WS_XCH), ctl + CW_PANEL, (LAS float*)(lds + RING_BYTES), wave};
            pg8::gemm_phase<pg8::EpiPleFinal, pg8::StaticOrder, true, true, false, true>(lds, g, S, E, wave);
        } else {
            pg8::EpiPle E{X2b, PU, RSTD2, X3, SS3};
            pg8::gemm_phase<pg8::EpiPle, pg8::StaticOrder, true, true, false, true>(lds, g, S, E, wave);
            if (BOTH(9)) xcd_barrier(bar);
        }
    }

    if (IN(10) && !fuse_final) {
        PHASE_IDS();
        const int gw = vcu * NWAVES + wave, NGW = G * NWAVES;
        for (int row = gw; row < T; row += NGW) { float ss = 0.f;
            if (lane < 16) ss = SS3[(size_t)row * 16 + lane];
            ss = wave_sum(ss);
            const float rstd = rsqrtf(ss * (1.f / D) + EPS);
#pragma unroll
            for (int hh = 0; hh < 2; ++hh) { const size_t o = (size_t)row * D + hh * 512 + lane * 8; pg8::f32x4 a0, a1; pg8::unpack8(*(const pg8::u32x4*)(X3 + o), a0, a1);
                const pg8::f32x4 f0 = *(const pg8::f32x4*)(in[27] + hh * 512 + lane * 8), f1 = *(const pg8::f32x4*)(in[27] + hh * 512 + lane * 8 + 4);
                *(pg8::f32x4*)(args.out + o) = a0 * rstd * f0; *(pg8::f32x4*)(args.out + o + 4) = a1 * rstd * f1; } }
    }
#undef IN
#undef BOTH
#undef PHASE_IDS
}

static int mega_grid() {
    static int grid = 0;
    if (grid == 0) {
        int dev = 0, cus = 0;
        if (hipGetDevice(&dev) != hipSuccess || hipDeviceGetAttribute(&cus, hipDeviceAttributeMultiprocessorCount, dev) != hipSuccess) { fprintf(stderr, "mega: device query failed\n"); grid = -1; return grid; }
        if (hipFuncSetAttribute((const void*)mega_fwd, hipFuncAttributeMaxDynamicSharedMemorySize, LDS_BYTES) != hipSuccess) { fprintf(stderr, "mega: hipFuncSetAttribute failed\n"); grid = -1; return grid; }
        (void)hipGetLastError();
        grid = cus;
    }
    return grid;
}
static void launch_mega(void* const* d_in, void* d_out, void* d_ws, int lo, int hi, int li, hipStream_t stream) {
    const int grid = mega_grid(); if (grid <= 0) return;
    Args a{};
    for (int i = 0; i < 28; ++i) a.in[i] = (const float*)d_in[i];
    a.out = (float*)d_out; a.ws = (unsigned char*)d_ws; a.ph_lo = lo; a.ph_hi = hi; a.li = li; a.pad = 0;
    hipLaunchKernelGGL(mega_fwd, dim3(grid), dim3(NWAVES * 64), LDS_BYTES, stream, a);
}

extern "C" void kernel_launch(void* const* d_in, const int* in_sizes, int n_in, void* d_out, int out_size, void* d_ws, size_t ws_size, hipStream_t stream) {
    if (n_in != 28 || in_sizes[0] != T * D || out_size != T * D || ws_size < WS_MEGA_END) { fprintf(stderr, "kernel_launch: unexpected shapes (n_in %d, ws %zu)\n", n_in, ws_size); return; }
    (void)hipMemsetAsync(d_ws, 0, 2 * MiB, stream);
    launch_mega(d_in, d_out, d_ws, 0, 11, 0, stream);
}
```

```cpp
#include <hip/hip_runtime.h>
#include <stdint.h>
#include <cstdio>

typedef unsigned short bf16;
constexpr int T = 16384, D = 1024, SEQ = 2048;
constexpr float EPS = 1e-6f;
constexpr size_t MiB = 1u << 20;
constexpr size_t WS_CTL = 0;
constexpr size_t WS_VPART = 2 * MiB;
constexpr size_t WS_SS1 = 4 * MiB;
constexpr size_t WS_SS3 = 5 * MiB;
constexpr size_t WS_AGG = 1 * MiB;
constexpr size_t WS_LIST = 6 * MiB;
constexpr size_t WS_TOKE = 8 * MiB;
constexpr size_t WS_TOKG = 8 * MiB + 128 * 1024;
constexpr size_t WS_RSTD2 = 8 * MiB + 256 * 1024;
constexpr size_t WS_A0 = 74 * MiB;
constexpr size_t WS_A1 = 106 * MiB;
constexpr size_t WS_A2 = 138 * MiB;
constexpr size_t WS_A3 = 170 * MiB;
constexpr size_t WS_A4 = 202 * MiB;
constexpr size_t WS_END = 234 * MiB;

__device__ __forceinline__ float bf2f(bf16 b) { return __uint_as_float(((unsigned)b) << 16); }
__device__ __forceinline__ bf16 f2bf(float f) { unsigned u = __float_as_uint(f); u += 0x7fffu + ((u >> 16) & 1u); return (bf16)(u >> 16); }
__device__ __forceinline__ float sigm(float x) { return 1.f / (1.f + expf(-x)); }
__device__ __forceinline__ float gelu_t(float x) { const float u = 0.7978845608028654f * (x + 0.044715f * x * x * x); return 0.5f * x * (1.f + tanhf(u)); }
__device__ __forceinline__ float wave_max(float v) {
#pragma unroll
    for (int o = 32; o > 0; o >>= 1) v = fmaxf(v, __shfl_xor(v, o));
    return v; }
__device__ __forceinline__ unsigned pack4_i8(float a, float b, float c, float d) {
    const int ia = (int)__builtin_rintf(a), ib = (int)__builtin_rintf(b), ic = (int)__builtin_rintf(c), id = (int)__builtin_rintf(d);
    return ((unsigned)ia & 255u) | (((unsigned)ib & 255u) << 8) | (((unsigned)ic & 255u) << 16) | ((unsigned)id << 24); }
__device__ __forceinline__ float wave_sum(float v) {
#pragma unroll
    for (int o = 1; o < 64; o <<= 1) v += __shfl_xor(v, o);
    return v;
}

#define LAS __attribute__((address_space(3)))
#define GAS __attribute__((address_space(1)))
namespace pg8 {
typedef short bf16x8 __attribute__((ext_vector_type(8)));
typedef float f32x4 __attribute__((ext_vector_type(4)));
typedef float f32x2 __attribute__((ext_vector_type(2)));
typedef unsigned u32x4 __attribute__((ext_vector_type(4)));
typedef unsigned u32x2 __attribute__((ext_vector_type(2)));
typedef int i32x4 __attribute__((ext_vector_type(4)));
typedef int i32x8 __attribute__((ext_vector_type(8)));
constexpr int BM = 256, BK = 64, HALF = 128, HTB = HALF * BK * 2, STAGE_BYTES = 8 * HTB, NXCD = 8, WGM = 8;

__host__ __device__ __forceinline__ int lds_byte(int r, int c) { const int st = (r >> 4) * 2 + (c >> 5), rr = r & 15, cc = c & 31, ob = rr * 64 + cc * 2; return st * 1024 + (ob ^ (((ob >> 9) & 1) << 5)); }
__host__ __device__ __forceinline__ void stage_rc(int b, int& R, int& C) { const int st = b / 1024, sb = b % 1024, swz = sb ^ (((sb >> 9) & 1) << 5); R = (st >> 1) * 16 + swz / 64; C = (st & 1) * 32 + (swz % 64) / 2; }
__host__ __device__ __forceinline__ int perm32(int rho) { const int n = rho >> 4, i = rho & 15; return 8 * (i >> 2) + 4 * n + (i & 3); }

__device__ __forceinline__ int lane_id() { int l; asm volatile("v_mbcnt_lo_u32_b32 %0, -1, 0\n\tv_mbcnt_hi_u32_b32 %0, -1, %0" : "=v"(l)); return l; }
struct Unit { int pm, pn, e, tile, cnt; };
struct Gemm { const bf16* A; const bf16* Bt; int K; };

struct StaticOrder {
    int nM, nN, nwg, G, c;
    __device__ void init(int M, int N, int G_, int c_) { nM = M / BM; nN = N / BM; nwg = nM * nN; G = G_; c = c_; }
    __device__ bool next(int i, Unit& u) const {
        const long L = (long)i * G + c; if (L >= nwg) return false;
        int wgid = (int)L; { const int q = nwg / NXCD, r = nwg % NXCD, xcd = wgid % NXCD, off = wgid / NXCD; wgid = (xcd < r ? xcd * (q + 1) : r * (q + 1) + (xcd - r) * q) + off; }
        const int nig = WGM * nN, gid = wgid / nig, fm = gid * WGM, gsz = (nM - fm) < WGM ? (nM - fm) : WGM;
        u.pm = fm + ((wgid % nig) % gsz); u.pn = (wgid % nig) / gsz; u.e = 0; u.tile = 0; u.cnt = 0; return true;
    }
    __device__ __forceinline__ unsigned row_off(const Unit&, int) const { return 0u; }
    __device__ __forceinline__ void a_ready(const Unit&) const {}
    __device__ __forceinline__ void done(const Unit&) const {}
    struct Pre {}; __device__ __forceinline__ void pre(int, Pre&) const {}
    __device__ __forceinline__ void post(int, Pre&) const {}
    __device__ __forceinline__ bool half(const Unit&) const { return false; }
};

__device__ __forceinline__ unsigned cvt_pk_bf16(float lo, float hi) { unsigned r; asm volatile("v_cvt_pk_bf16_f32 %0, %1, %2" : "=v"(r) : "v"(lo), "v"(hi)); return r; }
typedef __bf16 bf16x2_t __attribute__((ext_vector_type(2)));
__device__ __forceinline__ unsigned cvt_pk_bf16_cv(float lo, float hi) { const f32x2 v = {lo, hi}; const bf16x2_t b = __builtin_convertvector(v, bf16x2_t); return __builtin_bit_cast(unsigned, b); }
__device__ __forceinline__ float fsigm(float x) { return __builtin_amdgcn_rcpf(1.0f + __builtin_amdgcn_exp2f(-1.4426950409f * x)); }
__device__ __forceinline__ float fgelu(float x) { const float u = x + 0.044715f * x * x * x; return x * __builtin_amdgcn_rcpf(1.0f + __builtin_amdgcn_exp2f(-2.3022082f * u)); }
__device__ __forceinline__ f32x4 vexp2(const f32x4 t) { f32x4 e;
#pragma unroll
    for (int i = 0; i < 4; ++i) e[i] = __builtin_amdgcn_exp2f(t[i]);
    return e; }
__device__ __forceinline__ f32x4 vrcp(const f32x4 t) { f32x4 e;
#pragma unroll
    for (int i = 0; i < 4; ++i) e[i] = __builtin_amdgcn_rcpf(t[i]);
    return e; }
__device__ __forceinline__ f32x4 vgelu_den(const f32x4 x) { return 1.f + vexp2(x * (x * x * (-0.10294324f) + (-2.3022082f))); }
__device__ __forceinline__ f32x4 vsigm_den(const f32x4 x) { return 1.f + vexp2(x * (-1.4426950409f)); }
__device__ __forceinline__ float hsum4(const f32x4 v) { return (v[0] + v[1]) + (v[2] + v[3]); }

__device__ __forceinline__ i32x8 cat8(const bf16x8 lo, const bf16x8 hi) { const i32x4 a = __builtin_bit_cast(i32x4, lo), b = __builtin_bit_cast(i32x4, hi); return __builtin_shufflevector(a, b, 0, 1, 2, 3, 4, 5, 6, 7); }
template <class Epi, class Sched, bool ALIGN_EPI, bool SP2, bool GATHER, int QM = 0>
__device__ __forceinline__ void gemm_phase(LAS unsigned char* lds, const Gemm g, const Sched& S, const Epi& E, const int wave_) {
    int lane = lane_id(); asm volatile("" : "+v"(lane));
    const int wid = wave_, tid = wid * 64 + lane, wr = wid >> 2, wc = wid & 3, fr = lane & 15, fq = lane >> 4;
    constexpr bool FP8 = (QM == 1);
    int K_ = g.K; if constexpr (QM != 0) asm volatile("" : "+s"(K_));
    const int K = K_, nt = K / BK;
    int sR[2], sC[2];
    unsigned voffB[2], vA0[2], vA1[2], nvA0[2], nvA1[2];
#pragma unroll
    for (int i = 0; i < 2; ++i) { stage_rc(tid * 16 + i * 8192, sR[i], sC[i]); const int Rb = Epi::PERM ? ((sR[i] & ~31) + perm32(sR[i] & 31)) : sR[i];
        voffB[i] = (unsigned)(Rb * K + sC[i]) * 2u; vA0[i] = (unsigned)(sR[i] * K + sC[i]) * 2u; vA1[i] = vA0[i]; nvA0[i] = vA0[i]; nvA1[i] = vA0[i]; }
    const size_t kstep = (size_t)(BK * 2);
    const size_t hstep = (size_t)HALF * K * 2;
    const size_t tstep = 2 * hstep;
    const size_t ahs = GATHER ? 0 : hstep;
    const unsigned ldsw = (unsigned)wid * 1024u;
    const int aoff = lds_byte(wr * 64 + fr, fq * 8), boff = lds_byte(wc * 32 + fr, fq * 8);
#define PG8_SA(b, h) (((b) * 2 + (h)) * HTB)
#define PG8_SB(b, h) ((4 + (b) * 2 + (h)) * HTB)
#define PG8_STAGE(bufoff, gbase, voff) do { _Pragma("unroll") for (int _i = 0; _i < 2; ++_i) \
        __builtin_amdgcn_global_load_lds((const unsigned*)((const char*)(gbase) + (voff)[_i]), (LAS unsigned*)(lds + (bufoff) + ldsw + _i * 8192), 16, 0, 0); } while (0)
#define PG8_LDA(dst, b, h) do { if constexpr (FP8) { _Pragma("unroll") for (int m = 0; m < 4; ++m) dst##q[m] = cat8(*(const LAS bf16x8*)(lds + PG8_SA(b, h) + aoff + m * 2048), *(const LAS bf16x8*)(lds + PG8_SA(b, h) + aoff + m * 2048 + 1024)); } \
        else { _Pragma("unroll") for (int m = 0; m < 4; ++m) _Pragma("unroll") for (int k = 0; k < 2; ++k) dst[m][k] = *(const LAS bf16x8*)(lds + PG8_SA(b, h) + aoff + m * 2048 + k * 1024); } } while (0)
#define PG8_LDB(dst, b, h) do { if constexpr (FP8) { _Pragma("unroll") for (int n = 0; n < 2; ++n) dst##q[n] = cat8(*(const LAS bf16x8*)(lds + PG8_SB(b, h) + boff + n * 2048), *(const LAS bf16x8*)(lds + PG8_SB(b, h) + boff + n * 2048 + 1024)); } \
        else { _Pragma("unroll") for (int n = 0; n < 2; ++n) _Pragma("unroll") for (int k = 0; k < 2; ++k) dst[n][k] = *(const LAS bf16x8*)(lds + PG8_SB(b, h) + boff + n * 2048 + k * 1024); } } while (0)
#define PG8_MMA(ai, bj, At, Bt) do { __builtin_amdgcn_s_setprio(1); \
        if constexpr (FP8) { _Pragma("unroll") for (int m = 0; m < 4; ++m) _Pragma("unroll") for (int n = 0; n < 2; ++n) \
            asm volatile("v_mfma_scale_f32_16x16x128_f8f6f4 %0, %1, %2, %0, %3, %3 op_sel_hi:[0,0,0]" : "+v"(acc[ai][bj][m][n]) : "v"(Bt##q[n]), "v"(At##q[m]), "v"(mxs)); } \
        else if constexpr (QM == 2) { _Pragma("unroll") for (int m = 0; m < 4; ++m) _Pragma("unroll") for (int n = 0; n < 2; ++n) _Pragma("unroll") for (int k = 0; k < 2; ++k) \
            acc[ai][bj][m][n] = __builtin_bit_cast(f32x4, __builtin_amdgcn_mfma_i32_16x16x64_i8(__builtin_bit_cast(i32x4, Bt[n][k]), __builtin_bit_cast(i32x4, At[m][k]), __builtin_bit_cast(i32x4, acc[ai][bj][m][n]), 0, 0, 0)); } \
        else { _Pragma("unroll") for (int m = 0; m < 4; ++m) _Pragma("unroll") for (int n = 0; n < 2; ++n) _Pragma("unroll") for (int k = 0; k < 2; ++k) \
            acc[ai][bj][m][n] = __builtin_amdgcn_mfma_f32_16x16x32_bf16(Bt[n][k], At[m][k], acc[ai][bj][m][n], 0, 0, 0); } \
        __builtin_amdgcn_s_setprio(0); } while (0)
#define PG8_WAIT_V(n) asm volatile("s_waitcnt vmcnt(" #n ")" ::: "memory")
#define PG8_WAIT_L(n) asm volatile("s_waitcnt lgkmcnt(" #n ")" ::: "memory")
#define PG8_BAR __builtin_amdgcn_s_barrier()
#define PG8_SCHED __builtin_amdgcn_sched_barrier(0)
    Unit cur, nxt; int ui = 0;
    if (!S.next(0, cur)) return;
    f32x4 acc[2][2][4][2];
#pragma unroll
    for (int a = 0; a < 2; ++a)
#pragma unroll
        for (int b = 0; b < 2; ++b)
#pragma unroll
            for (int m = 0; m < 4; ++m)
#pragma unroll
                for (int n = 0; n < 2; ++n) acc[a][b][m][n] = (f32x4){0.f, 0.f, 0.f, 0.f};
    int mxs = 0x7F7F7F7F; if constexpr (FP8) asm volatile("" : "+v"(mxs));
    bf16x8 At[4][2], B0[2][2], B1[2][2]; i32x8 Atq[4], B0q[2], B1q[2];
    const char* cA = GATHER ? (const char*)g.A : (const char*)g.A + (size_t)cur.pm * tstep; const char* cB = (const char*)g.Bt + (size_t)cur.pn * tstep;
    if constexpr (GATHER) {
#pragma unroll
        for (int i = 0; i < 2; ++i) { vA0[i] = S.row_off(cur, sR[i]) + (unsigned)sC[i] * 2u; vA1[i] = S.row_off(cur, HALF + sR[i]) + (unsigned)sC[i] * 2u; nvA0[i] = vA0[i]; nvA1[i] = vA1[i]; }
    }
    S.a_ready(cur);
    if constexpr (SP2) {
        PG8_STAGE(PG8_SB(0, 0), cB, voffB); PG8_STAGE(PG8_SB(0, 1), cB + hstep, voffB); PG8_STAGE(PG8_SA(0, 0), cA, vA0); PG8_STAGE(PG8_SA(0, 1), cA + ahs, vA1);
        if (wr == 1) PG8_BAR;
        PG8_WAIT_V(2); PG8_BAR;
        PG8_STAGE(PG8_SB(1, 0), cB + kstep, voffB); PG8_STAGE(PG8_SA(1, 0), cA + kstep, vA0); PG8_STAGE(PG8_SB(1, 1), cB + hstep + kstep, voffB);
        PG8_WAIT_V(6); PG8_BAR;
    } else {
        PG8_STAGE(PG8_SB(0, 0), cB, voffB); PG8_STAGE(PG8_SA(0, 0), cA, vA0); PG8_STAGE(PG8_SB(0, 1), cB + hstep, voffB); PG8_STAGE(PG8_SA(0, 1), cA + ahs, vA1);
        if (wr == 1) PG8_BAR;
        PG8_WAIT_V(4); PG8_BAR;
        PG8_STAGE(PG8_SB(1, 0), cB + kstep, voffB); PG8_STAGE(PG8_SA(1, 0), cA + kstep, vA0); PG8_STAGE(PG8_SB(1, 1), cB + hstep + kstep, voffB);
        PG8_WAIT_V(6); PG8_BAR;
    }
    for (;;) {
        const bool has_next = S.next(ui + 1, nxt);
        const char* nA = has_next ? (GATHER ? (const char*)g.A : (const char*)g.A + (size_t)nxt.pm * tstep) : cA; const char* nB = has_next ? (const char*)g.Bt + (size_t)nxt.pn * tstep : cB;
        const bool hf = S.half(cur);
        for (int t = 0; t < nt; t += 2) {
            const bool last = (t == nt - 2);
            const char* a1 = cA + (size_t)(t + 1) * kstep;
            const char* a2 = last ? nA : cA + (size_t)(t + 2) * kstep; const char* b2 = last ? nB : cB + (size_t)(t + 2) * kstep;
            const char* a3 = a2 + kstep; const char* b3 = b2 + kstep;
            if (last && has_next) S.a_ready(nxt);
            unsigned w0[2], w1[2];
            if constexpr (GATHER) {
                if (last && has_next) {
#pragma unroll
                    for (int i = 0; i < 2; ++i) { nvA0[i] = S.row_off(nxt, sR[i]) + (unsigned)sC[i] * 2u; nvA1[i] = S.row_off(nxt, HALF + sR[i]) + (unsigned)sC[i] * 2u; }
                }
#pragma unroll
                for (int i = 0; i < 2; ++i) { w0[i] = last ? nvA0[i] : vA0[i]; w1[i] = last ? nvA1[i] : vA1[i]; }
            } else {
#pragma unroll
                for (int i = 0; i < 2; ++i) { w0[i] = vA0[i]; w1[i] = vA0[i]; }
            }
            if constexpr (SP2) {
            PG8_LDB(B0, 0, 0); PG8_LDB(B1, 0, 1); PG8_SCHED; PG8_LDA(At, 0, 0); PG8_STAGE(PG8_SA(1, 1), a1 + ahs, vA1);
            PG8_WAIT_V(8); PG8_WAIT_L(0); PG8_BAR; PG8_MMA(0, 0, At, B0); PG8_MMA(0, 1, At, B1); PG8_BAR; PG8_SCHED;
            if (!hf) PG8_LDA(At, 0, 1); PG8_STAGE(PG8_SB(0, 0), b2, voffB); PG8_STAGE(PG8_SB(0, 1), b2 + hstep, voffB); PG8_STAGE(PG8_SA(0, 0), a2, w0);
            PG8_WAIT_V(8); PG8_WAIT_L(0); PG8_BAR; if (!hf) { PG8_MMA(1, 0, At, B0); PG8_MMA(1, 1, At, B1); } PG8_BAR; PG8_SCHED;
            PG8_LDB(B0, 1, 0); PG8_LDB(B1, 1, 1); PG8_SCHED; PG8_LDA(At, 1, 0); PG8_STAGE(PG8_SA(0, 1), a2 + ahs, w1);
            PG8_WAIT_V(8); PG8_WAIT_L(0); PG8_BAR; PG8_MMA(0, 0, At, B0); PG8_MMA(0, 1, At, B1); PG8_BAR; PG8_SCHED;
            if (!hf) PG8_LDA(At, 1, 1); PG8_STAGE(PG8_SB(1, 0), b3, voffB); PG8_STAGE(PG8_SB(1, 1), b3 + hstep, voffB); PG8_STAGE(PG8_SA(1, 0), a3, w0);
            PG8_WAIT_V(8); PG8_WAIT_L(0); PG8_BAR; if (!hf) { PG8_MMA(1, 0, At, B0); PG8_MMA(1, 1, At, B1); } PG8_BAR; PG8_SCHED;
            } else {
            PG8_LDB(B0, 0, 0); PG8_SCHED; PG8_LDA(At, 0, 0); PG8_STAGE(PG8_SA(1, 1), a1 + ahs, vA1);
            PG8_WAIT_L(8); PG8_BAR; PG8_WAIT_L(0); PG8_MMA(0, 0, At, B0); PG8_BAR; PG8_SCHED;
            PG8_LDB(B1, 0, 1); PG8_STAGE(PG8_SB(0, 0), b2, voffB);
            PG8_BAR; PG8_WAIT_L(0); PG8_MMA(0, 1, At, B1); PG8_BAR;
            PG8_LDA(At, 0, 1); PG8_STAGE(PG8_SA(0, 0), a2, w0);
            PG8_BAR; PG8_WAIT_L(0); PG8_MMA(1, 0, At, B0); PG8_BAR; PG8_SCHED;
            PG8_STAGE(PG8_SB(0, 1), b2 + hstep, voffB);
            PG8_WAIT_V(6); PG8_BAR; PG8_MMA(1, 1, At, B1); PG8_BAR;
            PG8_LDB(B0, 1, 0); PG8_SCHED; PG8_LDA(At, 1, 0); PG8_STAGE(PG8_SA(0, 1), a2 + ahs, w1);
            PG8_WAIT_L(8); PG8_BAR; PG8_WAIT_L(0); PG8_MMA(0, 0, At, B0); PG8_BAR; PG8_SCHED;
            PG8_LDB(B1, 1, 1); PG8_STAGE(PG8_SB(1, 0), b3, voffB);
            PG8_BAR; PG8_WAIT_L(0); PG8_MMA(0, 1, At, B1); PG8_BAR;
            PG8_LDA(At, 1, 1); PG8_STAGE(PG8_SA(1, 0), a3, w0);
            PG8_BAR; PG8_WAIT_L(0); PG8_MMA(1, 0, At, B0); PG8_BAR; PG8_SCHED;
            PG8_STAGE(PG8_SB(1, 1), b3 + hstep, voffB);
            PG8_WAIT_V(6); PG8_BAR; PG8_MMA(1, 1, At, B1); PG8_BAR;
            }
        }
        if constexpr (FP8) asm volatile("s_nop 15\n\ts_nop 15" ::: "memory");
        typename Sched::Pre pre_; S.pre(ui, pre_);
        if constexpr (ALIGN_EPI) { if (wr == 0) PG8_BAR; }
        E(acc, cur, wr, wc, fr, fq); S.done(cur); S.post(ui, pre_);
        if (!has_next) break;
#pragma unroll
        for (int a = 0; a < 2; ++a)
#pragma unroll
            for (int b = 0; b < 2; ++b)
#pragma unroll
                for (int m = 0; m < 4; ++m)
#pragma unroll
                    for (int n = 0; n < 2; ++n) acc[a][b][m][n] = (f32x4){0.f, 0.f, 0.f, 0.f};
        cur = nxt; cA = nA; cB = nB; ++ui;
        if constexpr (GATHER) {
#pragma unroll
            for (int i = 0; i < 2; ++i) { vA0[i] = nvA0[i]; vA1[i] = nvA1[i]; }
        }
        if constexpr (ALIGN_EPI) { if (wr == 1) PG8_BAR; }
    }
    PG8_WAIT_V(0);
    if constexpr (!ALIGN_EPI) { if (wr == 0) PG8_BAR; }
    PG8_BAR;
#undef PG8_SA
#undef PG8_SB
#undef PG8_STAGE
#undef PG8_LDA
#undef PG8_LDB
#undef PG8_MMA
#undef PG8_WAIT_V
#undef PG8_WAIT_L
#undef PG8_BAR
#undef PG8_SCHED
}

__device__ __forceinline__ u32x4 pack8(const f32x4 v0, const f32x4 v1) { u32x4 w; w.x = cvt_pk_bf16(v0[0], v0[1]); w.y = cvt_pk_bf16(v0[2], v0[3]); w.z = cvt_pk_bf16(v1[0], v1[1]); w.w = cvt_pk_bf16(v1[2], v1[3]); return w; }
__device__ __forceinline__ u32x2 pack8_fp8(const f32x4 v0, const f32x4 v1) { int lo = __builtin_amdgcn_cvt_pk_fp8_f32(v0[0], v0[1], 0, false); lo = __builtin_amdgcn_cvt_pk_fp8_f32(v0[2], v0[3], lo, true);
    int hi = __builtin_amdgcn_cvt_pk_fp8_f32(v1[0], v1[1], 0, false); hi = __builtin_amdgcn_cvt_pk_fp8_f32(v1[2], v1[3], hi, true); return (u32x2){(unsigned)lo, (unsigned)hi}; }
__device__ __forceinline__ void unpack8_fp8(const u32x2 w, f32x4& v0, f32x4& v1) { const f32x2 a = __builtin_amdgcn_cvt_pk_f32_fp8((int)w.x, false), b = __builtin_amdgcn_cvt_pk_f32_fp8((int)w.x, true),
        c = __builtin_amdgcn_cvt_pk_f32_fp8((int)w.y, false), d = __builtin_amdgcn_cvt_pk_f32_fp8((int)w.y, true); v0 = (f32x4){a.x, a.y, b.x, b.y}; v1 = (f32x4){c.x, c.y, d.x, d.y}; }
__device__ __forceinline__ void unpack8(const u32x4 w, f32x4& v0, f32x4& v1) {
    v0[0] = __uint_as_float(w.x << 16); v0[1] = __uint_as_float(w.x & 0xffff0000u); v0[2] = __uint_as_float(w.y << 16); v0[3] = __uint_as_float(w.y & 0xffff0000u);
    v1[0] = __uint_as_float(w.z << 16); v1[1] = __uint_as_float(w.z & 0xffff0000u); v1[2] = __uint_as_float(w.w << 16); v1[3] = __uint_as_float(w.w & 0xffff0000u); }

struct Epi1 {
    static constexpr bool PERM = true;
    bf16 *Zl, *GA, *UB, *V; float* VPART; const float* SA; const float* SB;
    static __device__ __forceinline__ f32x4 dq(const f32x4 a, const f32x4 s) { return __builtin_convertvector(__builtin_bit_cast(i32x4, a), f32x4) * s; }
    __device__ __forceinline__ void operator()(const f32x4 (&acc)[2][2][4][2], const Unit& u, int wr, int wc, int fr, int fq) const {
        const int row0 = u.pm * BM + wr * 64 + fr, pn = u.pn;
        const float* sbp = SB + pn * 256 + wc * 32 + 8 * fq;
        const f32x4 sb00 = *(const f32x4*)sbp, sb01 = *(const f32x4*)(sbp + 4), sb10 = *(const f32x4*)(sbp + HALF), sb11 = *(const f32x4*)(sbp + HALF + 4);
        if (pn < 4) {
            const int col0 = pn * 256 + wc * 32 + 8 * fq;
#pragma unroll
            for (int ai = 0; ai < 2; ++ai)
#pragma unroll
                for (int m = 0; m < 4; ++m) { bf16* rowp = Zl + (size_t)(row0 + ai * HALF + m * 16) * D + col0; const float sa = SA[row0 + ai * HALF + m * 16];
#pragma unroll
                    for (int bj = 0; bj < 2; ++bj) *(u32x4*)(rowp + bj * HALF) = pack8(dq(acc[ai][bj][m][0], (bj ? sb10 : sb00) * sa), dq(acc[ai][bj][m][1], (bj ? sb11 : sb01) * sa)); }
        } else if (pn < 20) {
            bf16* O = pn < 12 ? GA : UB; const int uu = pn < 12 ? pn - 4 : pn - 12; const int col0 = uu * 128 + wc * 32 + 8 * fq;
#pragma unroll
            for (int ai = 0; ai < 2; ++ai)
#pragma unroll
                for (int m = 0; m < 4; ++m) { f32x4 v[2]; const float sa = SA[row0 + ai * HALF + m * 16];
#pragma unroll
                    for (int n = 0; n < 2; ++n) { const f32x4 za = dq(acc[ai][0][m][n], (n ? sb01 : sb00) * sa), zb = dq(acc[ai][1][m][n], (n ? sb11 : sb10) * sa); v[n] = za * vrcp(vgelu_den(za) * vsigm_den(zb)); }
                    *(u32x4*)(O + (size_t)(row0 + ai * HALF + m * 16) * D + col0) = pack8(v[0], v[1]); }
        } else {
            const int col0 = (pn - 20) * 256 + wc * 32 + 8 * fq;
#pragma unroll
            for (int ai = 0; ai < 2; ++ai)
#pragma unroll
                for (int m = 0; m < 4; ++m) { const int row = row0 + ai * HALF + m * 16; f32x4 s1v = {0.f, 0.f, 0.f, 0.f}, s2v = {0.f, 0.f, 0.f, 0.f}; const float sa = SA[row];
#pragma unroll
                    for (int bj = 0; bj < 2; ++bj) { f32x4 v[2];
#pragma unroll
                        for (int n = 0; n < 2; ++n) { const f32x4 z = dq(acc[ai][bj][m][n], (bj ? (n ? sb11 : sb10) : (n ? sb01 : sb00)) * sa); v[n] = z * vrcp(vgelu_den(z)); s1v += v[n]; s2v += v[n] * v[n]; }
                        *(u32x4*)(V + (size_t)row * D + col0 + bj * HALF) = pack8(v[0], v[1]); }
                    float s1 = hsum4(s1v), s2 = hsum4(s2v);
                    s1 += __shfl_xor(s1, 16); s1 += __shfl_xor(s1, 32); s2 += __shfl_xor(s2, 16); s2 += __shfl_xor(s2, 32);
                    if (fq == 0) *(f32x2*)(VPART + (size_t)row * 32 + ((pn - 20) * 4 + wc) * 2) = (f32x2){s1, s2}; }
        }
    }
};
struct EpiPlain {
    static constexpr bool PERM = true;
    bf16* O;
    __device__ __forceinline__ void operator()(const f32x4 (&acc)[2][2][4][2], const Unit& u, int wr, int wc, int fr, int fq) const {
        const int row0 = u.pm * BM + wr * 64 + fr, col0 = u.pn * 256 + wc * 32 + 8 * fq;
#pragma unroll
        for (int ai = 0; ai < 2; ++ai)
#pragma unroll
            for (int m = 0; m < 4; ++m) { bf16* rowp = O + (size_t)(row0 + ai * HALF + m * 16) * D + col0;
#pragma unroll
                for (int bj = 0; bj < 2; ++bj) *(u32x4*)(rowp + bj * HALF) = pack8(acc[ai][bj][m][0], acc[ai][bj][m][1]); }
    }
};
struct Epi2 {
    static constexpr bool PERM = true;
    const bf16* XN; const float* RI0; const float* GINV; bf16* X1b; float* SS1;
    __device__ __forceinline__ void operator()(const f32x4 (&acc)[2][2][4][2], const Unit& u, int wr, int wc, int fr, int fq) const {
        const int row0 = u.pm * BM + wr * 64 + fr, col0 = u.pn * 256 + wc * 32 + 8 * fq;
#pragma unroll
        for (int ai = 0; ai < 2; ++ai)
#pragma unroll
            for (int m = 0; m < 4; ++m) { const int row = row0 + ai * HALF + m * 16; float ss = 0.f; const float ri = RI0[row];
#pragma unroll
                for (int bj = 0; bj < 2; ++bj) { f32x4 x0, x1; unpack8(*(const u32x4*)(XN + (size_t)row * D + col0 + bj * HALF), x0, x1);
                    const f32x4 g0 = *(const f32x4*)(GINV + col0 + bj * HALF), g1 = *(const f32x4*)(GINV + col0 + bj * HALF + 4);
                    const f32x4 v0 = acc[ai][bj][m][0] + x0 * ri * g0, v1 = acc[ai][bj][m][1] + x1 * ri * g1;
                    ss += hsum4(v0 * v0 + v1 * v1);
                    *(u32x4*)(X1b + (size_t)row * D + col0 + bj * HALF) = pack8(v0, v1); }
                ss += __shfl_xor(ss, 16); ss += __shfl_xor(ss, 32);
                if (fq == 0) SS1[(size_t)row * 16 + u.pn * 4 + wc] = ss; }
    }
};
struct EpiPle {
    static constexpr bool PERM = true; static constexpr float WSC = 1.f / 32.f;
    const bf16* X2b; const bf16* PU; const float* RSTD2; bf16* X3; float* SS3;
    __device__ __forceinline__ void operator()(const f32x4 (&acc)[2][2][4][2], const Unit& u, int wr, int wc, int fr, int fq) const {
        const int row0 = u.pm * BM + wr * 64 + fr, col0 = u.pn * 256 + wc * 32 + 8 * fq;
#pragma unroll
        for (int ai = 0; ai < 2; ++ai)
#pragma unroll
            for (int m = 0; m < 4; ++m) { const int row = row0 + ai * HALF + m * 16; float ss = 0.f; const float r2n = RSTD2[row] * (-1.4426950409f * WSC);
#pragma unroll
                for (int bj = 0; bj < 2; ++bj) { const size_t o = (size_t)row * D + col0 + bj * HALF;
                    f32x4 x0, x1, p0, p1; unpack8(*(const u32x4*)(X2b + o), x0, x1); unpack8(*(const u32x4*)(PU + o), p0, p1);
                    const f32x4 v0 = x0 + vrcp(1.f + vexp2(acc[ai][bj][m][0] * r2n)) * p0, v1 = x1 + vrcp(1.f + vexp2(acc[ai][bj][m][1] * r2n)) * p1;
                    ss += hsum4(v0 * v0 + v1 * v1);
                    *(u32x4*)(X3 + o) = pack8(v0, v1); }
                ss += __shfl_xor(ss, 16); ss += __shfl_xor(ss, 32);
                if (fq == 0) SS3[(size_t)row * 16 + u.pn * 4 + wc] = ss; }
    }
};

struct EpiPleFinal {
    static constexpr bool PERM = true; static constexpr float WSC = 1.f / 32.f;
    const bf16* X2b; const bf16* PU; const float* RSTD2; const float* fn; float* out; float* XCH; unsigned* cnt; LAS float* xl; int wave;
    __device__ __forceinline__ void operator()(f32x4 (&acc)[2][2][4][2], const Unit& u, int wr, int wc, int fr, int fq) const {
        const int tid = wave * 64 + lane_id();
        const int rl0 = wr * 64 + fr, col0 = u.pn * 256 + wc * 32 + 8 * fq;
#pragma unroll
        for (int ai = 0; ai < 2; ++ai)
#pragma unroll
            for (int m = 0; m < 4; ++m) { const int rl = rl0 + ai * HALF + m * 16, row = u.pm * BM + rl; float ss = 0.f; const float r2n = RSTD2[row] * (-1.4426950409f * WSC);
#pragma unroll
                for (int bj = 0; bj < 2; ++bj) { const size_t o = (size_t)row * D + col0 + bj * HALF;
                    f32x4 x0, x1, p0, p1; unpack8(*(const u32x4*)(X2b + o), x0, x1); unpack8(*(const u32x4*)(PU + o), p0, p1);
                    const f32x4 v0 = x0 + vrcp(1.f + vexp2(acc[ai][bj][m][0] * r2n)) * p0, v1 = x1 + vrcp(1.f + vexp2(acc[ai][bj][m][1] * r2n)) * p1;
                    ss += hsum4(v0 * v0 + v1 * v1);
                    acc[ai][bj][m][0] = v0; acc[ai][bj][m][1] = v1; }
                ss += __shfl_xor(ss, 16); ss += __shfl_xor(ss, 32);
                if (fq == 0) xl[rl * 4 + wc] = ss; }
        __syncthreads();
        if (tid < 256) { const f32x4 p = *(const LAS f32x4*)(xl + tid * 4);
            __hip_atomic_store(XCH + (size_t)(u.pm * BM + tid) * 4 + u.pn, (p[0] + p[1]) + (p[2] + p[3]), __ATOMIC_RELAXED, __HIP_MEMORY_SCOPE_AGENT); }
        asm volatile("s_waitcnt vmcnt(0)" ::: "memory");
        if (tid < 256 && (tid & 63) == 0) __hip_atomic_fetch_add(cnt + 64 * u.pm, 1u, __ATOMIC_RELAXED, __HIP_MEMORY_SCOPE_AGENT);
        if (tid < 64) { unsigned sp = 0;
            while ((unsigned)__builtin_amdgcn_readfirstlane(__hip_atomic_load(cnt + 64 * u.pm, __ATOMIC_RELAXED, __HIP_MEMORY_SCOPE_AGENT)) < 16u) { if (++sp > (1u << 22)) break; __builtin_amdgcn_s_sleep(1); } }
        __syncthreads();
        if (tid < 256) { const float* xs = XCH + (size_t)(u.pm * BM + tid) * 4; float tot = 0.f;
#pragma unroll
            for (int q = 0; q < 4; ++q) tot += __hip_atomic_load(xs + q, __ATOMIC_RELAXED, __HIP_MEMORY_SCOPE_AGENT);
            xl[1024 + tid] = rsqrtf(tot * (1.f / D) + EPS); }
        __syncthreads();
#pragma unroll
        for (int ai = 0; ai < 2; ++ai)
#pragma unroll
            for (int m = 0; m < 4; ++m) { const int rl = rl0 + ai * HALF + m * 16; const float rs = xl[1024 + rl]; float* op = out + (size_t)(u.pm * BM + rl) * D + col0;
#pragma unroll
                for (int bj = 0; bj < 2; ++bj) { const f32x4 f0 = *(const f32x4*)(fn + col0 + bj * HALF), f1 = *(const f32x4*)(fn + col0 + bj * HALF + 4);
                    *(f32x4*)(op + bj * HALF) = acc[ai][bj][m][0] * rs * f0; *(f32x4*)(op + bj * HALF + 4) = acc[ai][bj][m][1] * rs * f1; } }
    }
};

template <int MODE> struct MoeOrder {
    const LAS int* tab; const int* LIST; unsigned* dcnt; unsigned rowb;
    __device__ __forceinline__ bool next(int i, Unit& u) const {
        const int n = __builtin_amdgcn_readfirstlane(tab[0]); if (i >= n) return false;
        const LAS int* p = tab + 4 + 8 * i;
        u.pm = __builtin_amdgcn_readfirstlane(p[0]); u.pn = __builtin_amdgcn_readfirstlane(p[1]); u.e = __builtin_amdgcn_readfirstlane(p[2]);
        u.tile = __builtin_amdgcn_readfirstlane(p[3]); u.cnt = __builtin_amdgcn_readfirstlane(p[4]); return true;
    }
    __device__ __forceinline__ unsigned row_off(const Unit& u, int r) const { int idx = u.tile * 256 + r; idx = idx < u.cnt ? idx : u.cnt - 1; const int pair = LIST[u.e * 16384 + idx]; return (unsigned)(pair >> 1) * rowb; }
    __device__ __forceinline__ void a_ready(const Unit&) const {}
    struct Pre {}; __device__ __forceinline__ void pre(int, Pre&) const {}
    __device__ __forceinline__ void post(int, Pre&) const {}
    __device__ __forceinline__ bool half(const Unit& u) const { return MODE == 1 && (u.cnt - u.tile * 256) <= 128; }
    __device__ __forceinline__ void done(const Unit& u) const {
        if constexpr (MODE == 1) {
            asm volatile("s_waitcnt vmcnt(0)" ::: "memory");
            if (lane_id() == 0) __hip_atomic_fetch_add(dcnt + 64 * u.pm, 1u, __ATOMIC_RELAXED, __HIP_MEMORY_SCOPE_AGENT);
        }
    }
};
__device__ __forceinline__ void store16_sc1(void* p, u32x4 v) { asm volatile("global_store_dwordx4 %0, %1, off sc1\n\ts_nop 1" :: "v"(p), "v"(v) : "memory"); }
__device__ __forceinline__ void store8_sc1(void* p, u32x2 v) { asm volatile("global_store_dwordx2 %0, %1, off sc1\n\ts_nop 1" :: "v"(p), "v"(v) : "memory"); }
struct EpiMoe1 {
    static constexpr bool PERM = true;
    unsigned char* H; const float* LISTR;
    __device__ __forceinline__ void operator()(const f32x4 (&acc)[2][2][4][2], const Unit& u, int wr, int wc, int fr, int fq) const {
        const int col0 = (u.pn & 1) * 128 + wc * 32 + 8 * fq;
#pragma unroll
        for (int ai = 0; ai < 2; ++ai)
#pragma unroll
            for (int m = 0; m < 4; ++m) { const int r = ai * HALF + wr * 64 + m * 16 + fr; int idx = u.tile * 256 + r; idx = idx < u.cnt ? idx : u.cnt - 1;
                const float rs = LISTR[u.e * 16384 + idx] * (1.f / 32.f); f32x4 v[2];
#pragma unroll
                for (int n = 0; n < 2; ++n) { const f32x4 a1 = acc[ai][0][m][n] * rs, a3 = acc[ai][1][m][n] * rs; v[n] = a1 * a3 * vrcp(vsigm_den(a1)); }
                store8_sc1(H + (size_t)(u.pm * 256 + r) * 256 + col0, pack8_fp8(v[0], v[1])); }
    }
};
struct EpiMoe2 {
    static constexpr bool PERM = true;
    unsigned char* Y; const int* LIST; const float* LISTG;
    __device__ __forceinline__ void operator()(const f32x4 (&acc)[2][2][4][2], const Unit& u, int wr, int wc, int fr, int fq) const {
        const int col0 = (u.pn & 3) * 256 + wc * 32 + 8 * fq;
        int pr[2][4]; float gt[2][4];
#pragma unroll
        for (int ai = 0; ai < 2; ++ai)
#pragma unroll
            for (int m = 0; m < 4; ++m) { int idx = u.tile * 256 + ai * HALF + wr * 64 + m * 16 + fr; idx = idx < u.cnt ? idx : u.cnt - 1; pr[ai][m] = LIST[u.e * 16384 + idx]; gt[ai][m] = LISTG[u.e * 16384 + idx]; }
#pragma unroll
        for (int ai = 0; ai < 2; ++ai)
#pragma unroll
            for (int m = 0; m < 4; ++m) { const int idx = u.tile * 256 + ai * HALF + wr * 64 + m * 16 + fr;
                if (idx < u.cnt) { const float g = gt[ai][m]; unsigned char* yp = Y + (size_t)pr[ai][m] * D + col0;
#pragma unroll
                    for (int bj = 0; bj < 2; ++bj) *(u32x2*)(yp + bj * HALF) = pack8_fp8(acc[ai][bj][m][0] * g, acc[ai][bj][m][1] * g); } }
    }
};
}

constexpr int NWAVES = 8;
constexpr int RING_BYTES = 131072, LDSCTL_OFF = 139264, MISC_OFF = LDSCTL_OFF + 320, TAB_OFF = LDSCTL_OFF + 512, LDS_BYTES = 147456;
constexpr size_t WS_WLRU = 8 * MiB + 512 * 1024;
constexpr size_t WS_WSGU = 8 * MiB + 768 * 1024;
constexpr size_t WS_WR = 9 * MiB;
constexpr size_t WS_WUP = 9 * MiB + 512 * 1024;
constexpr size_t WS_WIN = 10 * MiB;
constexpr size_t WS_WOUT = 22 * MiB;
constexpr size_t WS_WG = 24 * MiB;
constexpr size_t WS_W13 = 26 * MiB;
constexpr size_t WS_W2 = 58 * MiB;
constexpr size_t WS_PB = 234 * MiB;
constexpr size_t WS_RSTD1 = 242 * MiB;
constexpr size_t WS_RSTD0 = 242 * MiB + 128 * 1024;
constexpr size_t WS_GINV = 242 * MiB + 256 * 1024;
constexpr size_t WS_SPL8 = 242 * MiB + 512 * 1024;
constexpr size_t WS_SB = 243 * MiB + 512 * 1024;
constexpr size_t WS_XCH = 243 * MiB;
constexpr size_t WS_LISTG = 244 * MiB;
constexpr size_t WS_LISTR = 246 * MiB;
constexpr size_t WS_MEGA_END = 248 * MiB;
constexpr int CW_BAR = 4096;
constexpr int CW_DONE1 = 131072;
constexpr int CW_MIX = 147456;
constexpr int CW_PANEL = 65536;

typedef GAS unsigned gu32;
#define RLX_AGENT __ATOMIC_RELAXED, __HIP_MEMORY_SCOPE_AGENT
#define LDS_WAIT() asm volatile("s_waitcnt lgkmcnt(0)" ::: "memory")
#define VM_WAIT() asm volatile("s_waitcnt vmcnt(0)" ::: "memory")

#define XB_TMO      128
#define XB_XCNT(j)  (256  + 64 * (j))
#define XB_XSUB(j)  (1280 + 64 * (j))
#define XB_XGEN(j)  (2304 + 64 * (j))
#define XB_TOP      3328
#define XB_TOPGEN   3392
#define XCD_BAR_WORDS 3456
#define XB_SPIN_CAP (1u << 18)
__device__ __forceinline__ unsigned xb_ld(unsigned* p)              { return __hip_atomic_load(p, __ATOMIC_RELAXED, __HIP_MEMORY_SCOPE_AGENT); }
__device__ __forceinline__ unsigned xb_add(unsigned* p, unsigned v) { return __hip_atomic_fetch_add(p, v, __ATOMIC_RELAXED, __HIP_MEMORY_SCOPE_AGENT); }
__device__ __forceinline__ unsigned xb_xcc_id() { return (unsigned)__builtin_amdgcn_s_getreg((3 << 11) | 20) & 0xFu; }
#define XB_SPIN(cond, bar) do { unsigned _sp = 0; while (cond) { __builtin_amdgcn_s_sleep(1); \
    if ((++_sp & 255u) == 0u) { if (xb_ld(&(bar)[XB_TMO])) break; if (_sp > XB_SPIN_CAP) { atomicAdd(&(bar)[XB_TMO], 1u); break; } } } } while (0)
struct XcdBarrier { unsigned* bar; unsigned x; volatile LAS unsigned* st; int wave; };
__device__ __forceinline__ XcdBarrier xcd_barrier_post(unsigned* bar, volatile LAS unsigned* st, int wave) {
    XcdBarrier b; b.bar = bar; b.x = xb_xcc_id(); b.st = st; b.wave = wave;
    if (wave == 0 && pg8::lane_id() == 0) (void)xb_add(&bar[XB_XCNT(b.x)], 1u);
    return b;
}
__device__ __forceinline__ void xcd_barrier_complete(unsigned* bar, unsigned x, unsigned& nloc, unsigned& nx) {
    const unsigned G = gridDim.x * gridDim.y * gridDim.z;
    unsigned sum, cnt, mine, sp = 0u;
    for (;;) {
        sum = 0u; cnt = 0u; mine = 0u;
#pragma unroll
        for (unsigned j = 0; j < 16; ++j) { const unsigned c = xb_ld(&bar[XB_XCNT(j)]); sum += c; cnt += (c > 0u) ? 1u : 0u; mine = (j == x) ? c : mine; }
        if (sum == G) break;
        __builtin_amdgcn_s_sleep(1);
        if ((++sp & 255u) == 0u) { if (xb_ld(&bar[XB_TMO])) break; if (sp > XB_SPIN_CAP) { atomicAdd(&bar[XB_TMO], 1u); break; } }
    }
    nloc = mine > 0u ? mine : 1u; nx = cnt > 0u ? cnt : 1u;
}
__device__ __forceinline__ void xcd_barrier(const XcdBarrier& b) {
    asm volatile("s_waitcnt vmcnt(0)" ::: "memory");
    __syncthreads();
    if (b.wave == 0 && pg8::lane_id() == 0) {
        unsigned* bar = b.bar;
        __builtin_amdgcn_s_waitcnt(0);
        unsigned nloc = b.st[0], nx = b.st[1];
        if (nloc == 0u) { xcd_barrier_complete(bar, b.x, nloc, nx); b.st[0] = nloc; b.st[1] = nx; }
        const unsigned old = xb_add(&bar[XB_XSUB(b.x)], 1u);
        const unsigned gen = old / nloc;
        if (old + 1u == (gen + 1u) * nloc) {
            __builtin_amdgcn_fence(__ATOMIC_RELEASE, "agent");
            asm volatile("s_waitcnt vmcnt(0)" ::: "memory");
            const unsigned og = xb_add(&bar[XB_TOP], 1u);
            const unsigned tg = og / nx;
            if (og + 1u == (tg + 1u) * nx) xb_add(&bar[XB_TOPGEN], 1u);
            else XB_SPIN(xb_ld(&bar[XB_TOPGEN]) == tg, bar);
            __builtin_amdgcn_fence(__ATOMIC_ACQUIRE, "agent");
            xb_add(&bar[XB_XGEN(b.x)], 1u);
            asm volatile("s_waitcnt vmcnt(0)" ::: "memory");
        } else {
            XB_SPIN(xb_ld(&bar[XB_XGEN(b.x)]) == gen, bar);
            __builtin_amdgcn_fence(__ATOMIC_ACQUIRE, "agent");
            asm volatile("s_waitcnt vmcnt(0)" ::: "memory");
        }
    }
    __syncthreads();
}

__device__ __forceinline__ unsigned pk2(float lo, float hi) { return (unsigned)f2bf(lo) | ((unsigned)f2bf(hi) << 16); }

struct TrItem { pg8::f32x4 v[8]; };
template <bool NT = false> __device__ __forceinline__ void tr_load(TrItem& t, const float* __restrict__ W, int ldn, int k0, int n_src0, int lane) {
    const int kb = lane >> 3, n4 = lane & 7;
    const float* src = W + (size_t)(k0 + 8 * kb) * ldn + n_src0 + 4 * n4;
#pragma unroll
    for (int q = 0; q < 8; ++q) t.v[q] = NT ? __builtin_nontemporal_load((const pg8::f32x4*)(src + (size_t)q * ldn)) : *(const pg8::f32x4*)(src + (size_t)q * ldn);
}
template <bool NT = false> __device__ __forceinline__ void tr_store(TrItem& t, int k0, bf16* __restrict__ WT, int Kd, int drow0, const float* __restrict__ gk, int lane) {
    const int kb = lane >> 3, n4 = lane & 7;
    if (gk) { const pg8::f32x4 g0 = *(const pg8::f32x4*)(gk + k0 + 8 * kb), g1 = *(const pg8::f32x4*)(gk + k0 + 8 * kb + 4);
#pragma unroll
        for (int q = 0; q < 8; ++q) t.v[q] = t.v[q] * (q < 4 ? g0[q & 3] : g1[q & 3]); }
#pragma unroll
    for (int i = 0; i < 4; ++i) { pg8::u32x4 o; o.x = pk2(t.v[0][i], t.v[1][i]); o.y = pk2(t.v[2][i], t.v[3][i]); o.z = pk2(t.v[4][i], t.v[5][i]); o.w = pk2(t.v[6][i], t.v[7][i]);
        if (NT) __builtin_nontemporal_store(o, (pg8::u32x4*)(WT + (size_t)(drow0 + 4 * n4 + i) * Kd + k0 + 8 * kb)); else *(pg8::u32x4*)(WT + (size_t)(drow0 + 4 * n4 + i) * Kd + k0 + 8 * kb) = o; }
}
__device__ __forceinline__ void tr_store_fp8(TrItem& t, int k0, unsigned char* __restrict__ W8, int Kd, int drow0, const float* __restrict__ gk, float wscale, int lane) {
    const int kb = lane >> 3, n4 = lane & 7;
    pg8::f32x4 g0 = {wscale, wscale, wscale, wscale}, g1 = g0;
    if (gk) { g0 = *(const pg8::f32x4*)(gk + k0 + 8 * kb) * wscale; g1 = *(const pg8::f32x4*)(gk + k0 + 8 * kb + 4) * wscale; }
#pragma unroll
    for (int i = 0; i < 4; ++i) { const pg8::f32x4 a = {t.v[0][i] * g0[0], t.v[1][i] * g0[1], t.v[2][i] * g0[2], t.v[3][i] * g0[3]}, b = {t.v[4][i] * g1[0], t.v[5][i] * g1[1], t.v[6][i] * g1[2], t.v[7][i] * g1[3]};
        *(pg8::u32x2*)(W8 + (size_t)(drow0 + 4 * n4 + i) * Kd + k0 + 8 * kb) = pg8::pack8_fp8(a, b); }
}
__device__ __forceinline__ void p0_transpose_item(const float* __restrict__ W, int ldn, int k0, int n_src0, bf16* __restrict__ WT, int Kd, int drow0, const float* __restrict__ gk, LAS float*, int lane) {
    TrItem t; tr_load<true>(t, W, ldn, k0, n_src0, lane); tr_store(t, k0, WT, Kd, drow0, gk, lane);
}
__device__ __forceinline__ int win_dest_row(int n) {
    const int grp = n >> 10, j = n & 1023;
    switch (grp) {
        case 0: return j;
        case 1: return 1024 + (j >> 7) * 256 + (j & 127);
        case 2: return 3072 + (j >> 7) * 256 + (j & 127);
        case 3: return 5120 + j;
        case 4: return 1024 + (j >> 7) * 256 + 128 + (j & 127);
        default: return 3072 + (j >> 7) * 256 + 128 + (j & 127);
    }
}


struct DefW { const float* const* in; unsigned char* ws; };
constexpr int DF_OUT = 8 * 32, DF_E13 = 32 * 2 * 64, DF_E2 = 32 * 64, DF_G = 8 * 32, DF_UP = 2 * 32, DF_N = DF_OUT + DF_E13 + DF_E2 + DF_G + DF_UP;
struct DefDesc { const float* W; const float* gk; bf16* WT; int ldn, k0, n0, Kd, drow; };
__device__ __forceinline__ DefDesc deferred_desc(const DefW& w, int it) {
    int r = it; DefDesc d;
    if (r < DF_OUT) { const int kb = r / 16, np = r % 16; d = DefDesc{w.in[15], nullptr, (bf16*)(w.ws + WS_WOUT), 1024, kb * 64, np * 64, 1024, np * 64}; return d; } r -= DF_OUT;
    if (r < DF_E13) { const int e = r / 128, which = (r / 64) & 1, q = r % 64, kb = q / 4, np = q % 4;
        const int f0 = np * 64, drow = e * 512 + (f0 >> 7) * 256 + which * 128 + (f0 & 127);
        d = DefDesc{w.in[which ? 22 : 21] + (size_t)e * 1024 * 256, w.in[16], (bf16*)(w.ws + WS_W13), 256, kb * 64, f0, 1024, drow}; return d; } r -= DF_E13;
    if (r < DF_E2) { const int e = r / 64, q = r % 64, kb = q / 16, np = q % 16;
        d = DefDesc{w.in[23] + (size_t)e * 256 * 1024, nullptr, (bf16*)(w.ws + WS_W2), 1024, kb * 64, np * 64, 256, e * 1024 + np * 64}; return d; } r -= DF_E2;
    if (r < DF_G) { const int kb = r / 16, np = r % 16; d = DefDesc{w.in[25], w.in[24], (bf16*)(w.ws + WS_WG), 1024, kb * 64, np * 64, 1024, np * 64}; return d; } r -= DF_G;
    { const int kb = r / 16, np = r % 16; d = DefDesc{w.in[26], nullptr, (bf16*)(w.ws + WS_WUP), 1024, kb * 64, np * 64, 256, np * 64}; return d; }
}
struct Gemm1Order : pg8::StaticOrder {
    DefW w; int wave; int gi;
    struct Pre {}; __device__ __forceinline__ void pre(int, Pre&) const {}
    __device__ __forceinline__ void post(int ui, Pre&) const {
        if (ui != gi) return;
        const int lane = pg8::lane_id(), slot = c * 8 + wave, nslot = G * 8;
        for (int it = slot; it < DF_N; it += nslot) { const DefDesc d = deferred_desc(w, it); TrItem t0, t1;
            tr_load<true>(t0, d.W, d.ldn, d.k0, d.n0, lane); tr_load<true>(t1, d.W, d.ldn, d.k0, d.n0 + 32, lane);
            if ((it >= DF_OUT && it < DF_OUT + DF_E13) || (it >= DF_OUT + DF_E13 + DF_E2 && it < DF_OUT + DF_E13 + DF_E2 + DF_G)) {
                tr_store_fp8(t0, d.k0, (unsigned char*)d.WT, 1024, d.drow, d.gk, 32.f, lane); tr_store_fp8(t1, d.k0, (unsigned char*)d.WT, 1024, d.drow + 32, d.gk, 32.f, lane);
            } else if (it >= DF_OUT + DF_E13 && it < DF_OUT + DF_E13 + DF_E2) {
                tr_store_fp8(t0, d.k0, (unsigned char*)d.WT, 256, d.drow, nullptr, 16.f, lane); tr_store_fp8(t1, d.k0, (unsigned char*)d.WT, 256, d.drow + 32, nullptr, 16.f, lane);
            } else { tr_store<true>(t0, d.k0, d.WT, d.Kd, d.drow, d.gk, lane); tr_store<true>(t1, d.k0, d.WT, d.Kd, d.drow + 32, d.gk, lane); } }
        const pg8::f32x4* psrc = (const pg8::f32x4*)w.in[1]; unsigned long long* pdst = (unsigned long long*)(w.ws + WS_PB);
        for (int ch = slot; ch < 8192; ch += nslot) { const size_t i0 = (size_t)ch * 128 + lane; const pg8::f32x4 v0 = __builtin_nontemporal_load(psrc + i0), v1 = __builtin_nontemporal_load(psrc + i0 + 64);
            __builtin_nontemporal_store((unsigned long long)pk2(v0.x, v0.y) | ((unsigned long long)pk2(v0.z, v0.w) << 32), pdst + i0); __builtin_nontemporal_store((unsigned long long)pk2(v1.x, v1.y) | ((unsigned long long)pk2(v1.z, v1.w) << 32), pdst + i0 + 64); }
    }
};

constexpr int MY_VT = 0, MY_XA = 32768, MY_SP = 67584, MY_WS = 102400, MY_ST = 135168, MY_RS = 272;
__device__ __forceinline__ float bflo(unsigned u) { return __uint_as_float(u << 16); }
__device__ __forceinline__ float bfhi(unsigned u) { return __uint_as_float(u & 0xffff0000u); }
template <int N> __device__ __forceinline__ float row_shr(float ident, float v) {
    return __builtin_bit_cast(float, __builtin_amdgcn_update_dpp(__builtin_bit_cast(int, ident), __builtin_bit_cast(int, v), 0x110 + N, 0xf, 0xf, false)); }
#define MX_DPP_STEP(N) \
    "v_fmac_f32_dpp %4, %4, %0 row_shr:" #N " row_mask:0xf bank_mask:0xf\n\tv_fmac_f32_dpp %5, %5, %1 row_shr:" #N " row_mask:0xf bank_mask:0xf\n\t" \
    "v_fmac_f32_dpp %6, %6, %2 row_shr:" #N " row_mask:0xf bank_mask:0xf\n\tv_fmac_f32_dpp %7, %7, %3 row_shr:" #N " row_mask:0xf bank_mask:0xf\n\t" \
    "v_mul_f32_dpp %0, %0, %0 row_shr:" #N " row_mask:0xf bank_mask:0xf\n\tv_mul_f32_dpp %1, %1, %1 row_shr:" #N " row_mask:0xf bank_mask:0xf\n\t" \
    "v_mul_f32_dpp %2, %2, %2 row_shr:" #N " row_mask:0xf bank_mask:0xf\n\tv_mul_f32_dpp %3, %3, %3 row_shr:" #N " row_mask:0xf bank_mask:0xf\n\t"
__device__ __forceinline__ void scan16x4(pg8::f32x4& A, pg8::f32x4& U) { using pg8::f32x4;
    float a0 = A[0], a1 = A[1], a2 = A[2], a3 = A[3], u0 = U[0], u1 = U[1], u2 = U[2], u3 = U[3];
    asm("s_nop 1\n\t" MX_DPP_STEP(1) MX_DPP_STEP(2) MX_DPP_STEP(4) MX_DPP_STEP(8) "s_nop 0"
        : "+v"(a0), "+v"(a1), "+v"(a2), "+v"(a3), "+v"(u0), "+v"(u1), "+v"(u2), "+v"(u3));
    A = (f32x4){a0, a1, a2, a3}; U = (f32x4){u0, u1, u2, u3};
}
__device__ __forceinline__ void mixer_phase(LAS unsigned char* lds, const int vcu, const int G, const int tid, const int lane, const int wave,
                                            const bf16* __restrict__ Zl, const bf16* __restrict__ GA, const bf16* __restrict__ UB, const bf16* __restrict__ V, const float* __restrict__ VPART,
                                            unsigned long long* AGG, bf16* __restrict__ MG, unsigned* mixc, const bf16* __restrict__ WLRU, const bf16* __restrict__ WSGU, const float* __restrict__ SPL8, const float* const* in) {
    using namespace pg8;
    constexpr int RS = MY_RS;
    constexpr float L2E = 1.4426950409f;
    const int fr = lane & 15, grp = lane >> 4, cp = tid & 63, tg = wave;
    const int pr = lane & 3, sch = lane >> 2, srow = 8 * sch + 2 * pr;
    LAS float* ST = (LAS float*)(lds + MY_ST);
    int gprev = -1;
    f32x2 cw0, cw1, cw2, cw3, ccb;
    u32x4 zqa, zqb, zqc, zqd, zqe, vv00, vv01, vv10, vv11;
#define MX_ZR(k) ((k) < 4 ? zqa[(k) & 3] : (k) < 8 ? zqb[(k) & 3] : (k) < 12 ? zqc[(k) & 3] : (k) < 16 ? zqd[(k) & 3] : zqe[(k) & 3])
#define MX_SETZR(k, v) do { if ((k) < 4) zqa[(k) & 3] = (v); else if ((k) < 8) zqb[(k) & 3] = (v); else if ((k) < 12) zqc[(k) & 3] = (v); else if ((k) < 16) zqd[(k) & 3] = (v); else zqe[(k) & 3] = (v); } while (0)
#define MX_PREFETCH(uu) do { const int ck_ = (uu) >> 3, g_ = (uu) & 7, t0_ = ck_ * 128, c0_ = g_ * 128; const bool first_ = (ck_ & 15) == 0; \
        const unsigned zo_ = ((unsigned)(t0_ + 16 * tg) * D + c0_ + 2 * cp) * 2u; \
        _Pragma("unroll") for (int k = 0; k < 19; ++k) { unsigned zv_ = 0u; if (!(k < 3 && first_ && tg == 0)) zv_ = *(const unsigned*)((const char*)Zl + (zo_ + (unsigned)((k - 3) * D * 2))); MX_SETZR(k, zv_); } \
        { const unsigned vo_ = ((unsigned)(t0_ + srow) * D + c0_ + 16 * wave) * 2u; vv00 = *(const u32x4*)((const char*)V + vo_); vv01 = *(const u32x4*)((const char*)V + (vo_ + D * 2)); vv10 = *(const u32x4*)((const char*)V + (vo_ + 16)); vv11 = *(const u32x4*)((const char*)V + (vo_ + D * 2 + 16)); } \
        } while (0)
    zqe = (u32x4){0u, 0u, 0u, 0u};
#define MX_STATS_LOAD(uu, q0, q1) do { const unsigned vpo_ = ((unsigned)(((uu) >> 3) * 128 + (tid >> 2)) * 32 + (tid & 3) * 8) * 4u; q0 = *(const f32x4*)((const char*)VPART + vpo_); q1 = *(const f32x4*)((const char*)VPART + (vpo_ + 16)); } while (0)
#define MX_STATS_WRITE(q0, q1) do { float s1 = (q0[0] + q0[2]) + (q1[0] + q1[2]), s2 = (q0[1] + q0[3]) + (q1[1] + q1[3]); \
        s1 += __shfl_xor(s1, 1); s1 += __shfl_xor(s1, 2); s2 += __shfl_xor(s2, 1); s2 += __shfl_xor(s2, 2); \
        if ((tid & 3) == 0) { const float mean = s1 * (1.f / 1024.f); float var = s2 * (1.f / 1024.f) - mean * mean; var = var < 0.f ? 0.f : var; ST[tid >> 2] = mean; ST[128 + (tid >> 2)] = rsqrtf(var + EPS); } } while (0)
    int u = vcu;
    if (u < 1024) { MX_PREFETCH(u); f32x4 q0, q1; MX_STATS_LOAD(u, q0, q1); MX_STATS_WRITE(q0, q1); }
    for (; u < 1024; u += G) {
        const int ck = u >> 3, g = u & 7, t0 = ck * 128, c0 = g * 128, j = ck & 15;
        const int cch = c0 + 16 * wave + 4 * grp;
        if (g != gprev) {
            gprev = g;
#pragma unroll
            for (int it = 0; it < 4; ++it) { const int idx = it * 512 + tid, row = idx >> 4, ch = idx & 15;
                *(LAS u32x4*)(lds + MY_WS + row * 256 + ((ch ^ (row & 15)) << 4)) = *(const u32x4*)(WSGU + ((size_t)(g * 128 + row)) * 128 + ch * 8); }
            const int cc = c0 + 2 * cp;
            cw0 = *(const f32x2*)(in[4] + cc); cw1 = *(const f32x2*)(in[4] + 1024 + cc); cw2 = *(const f32x2*)(in[4] + 2048 + cc); cw3 = *(const f32x2*)(in[4] + 3072 + cc); ccb = *(const f32x2*)(in[5] + cc);
        }
        const int hblk = 2 * g + (wave >> 2), jj0 = (16 * wave) & 63;
        const bf16x8 bw00 = *(const bf16x8*)(WLRU + ((size_t)((0 * 16 + hblk) * 64 + jj0 + fr)) * 64 + 0 * 32 + 8 * grp), bw01 = *(const bf16x8*)(WLRU + ((size_t)((0 * 16 + hblk) * 64 + jj0 + fr)) * 64 + 1 * 32 + 8 * grp);
        const bf16x8 bw10 = *(const bf16x8*)(WLRU + ((size_t)((1 * 16 + hblk) * 64 + jj0 + fr)) * 64 + 0 * 32 + 8 * grp), bw11 = *(const bf16x8*)(WLRU + ((size_t)((1 * 16 + hblk) * 64 + jj0 + fr)) * 64 + 1 * 32 + 8 * grp);
        const f32x4 nba = *(const f32x4*)(in[7] + cch) * (-L2E), nbi = *(const f32x4*)(in[9] + cch) * (-L2E), ksp = *(const f32x4*)(SPL8 + cch);
        {
#pragma unroll
            for (int i = 0; i < 16; ++i) {
                const unsigned z0 = MX_ZR(i), z1 = MX_ZR(i + 1), z2 = MX_ZR(i + 2), z3 = MX_ZR(i + 3);
                const f32x2 xv = ccb + cw0 * (f32x2){bflo(z0), bfhi(z0)} + cw1 * (f32x2){bflo(z1), bfhi(z1)} + cw2 * (f32x2){bflo(z2), bfhi(z2)} + cw3 * (f32x2){bflo(z3), bfhi(z3)};
                *(LAS unsigned*)(lds + MY_XA + (16 * tg + i) * RS + 4 * cp) = cvt_pk_bf16(xv.x, xv.y);
            }
        }
        __syncthreads();
        {
            const float mua = ST[srow], rsa = ST[128 + srow], mub = ST[srow + 1], rsb = ST[128 + srow + 1];
#pragma unroll
            for (int ci = 0; ci < 2; ++ci) { const int chunk = 2 * wave + ci, cbase = c0 + 8 * chunk;
                f32x4 a0, a1, b0, b1; unpack8(ci ? vv10 : vv00, a0, a1); unpack8(ci ? vv11 : vv01, b0, b1);
                const f32x4 g0 = *(const f32x4*)(in[11] + cbase), g1 = *(const f32x4*)(in[11] + cbase + 4), l0 = *(const f32x4*)(in[12] + cbase), l1 = *(const f32x4*)(in[12] + cbase + 4);
                a0 = (a0 - mua) * rsa * g0 + l0; a1 = (a1 - mua) * rsa * g1 + l1; b0 = (b0 - mub) * rsb * g0 + l0; b1 = (b1 - mub) * rsb * g1 + l1;
#pragma unroll
                for (int i = 0; i < 8; ++i) { const int cl = 8 * chunk + i; const float va = i < 4 ? a0[i & 3] : a1[i & 3], vb = i < 4 ? b0[i & 3] : b1[i & 3];
                    *(LAS unsigned*)(lds + MY_VT + cl * 256 + ((sch ^ (cl & 15)) << 4) + 4 * pr) = cvt_pk_bf16(va, vb); }
            }
        }
        f32x4 R[8], I[8];
#pragma unroll
        for (int mt = 0; mt < 8; ++mt) { R[mt] = (f32x4){0.f, 0.f, 0.f, 0.f}; I[mt] = (f32x4){0.f, 0.f, 0.f, 0.f};
#pragma unroll
            for (int ks = 0; ks < 2; ++ks) { const bf16x8 a = *(const LAS bf16x8*)(lds + MY_XA + (mt * 16 + fr) * RS + ((wave >> 2) * 64 + ks * 32 + 8 * grp) * 2);
                R[mt] = __builtin_amdgcn_mfma_f32_16x16x32_bf16(ks ? bw01 : bw00, a, R[mt], 0, 0, 0); I[mt] = __builtin_amdgcn_mfma_f32_16x16x32_bf16(ks ? bw11 : bw10, a, I[mt], 0, 0, 0); } }
#pragma unroll
        for (int mt = 0; mt < 8; ++mt) {
            const u32x2 xw = *(const LAS u32x2*)(lds + MY_XA + (mt * 16 + fr) * RS + (16 * wave + 4 * grp) * 2);
            const f32x4 xa4 = {bflo(xw.x), bfhi(xw.x), bflo(xw.y), bfhi(xw.y)};
            const f32x4 t1 = R[mt] * (-L2E) + nba, t2 = I[mt] * (-L2E) + nbi;
            f32x4 d1, d2, inv;
#pragma unroll
            for (int r = 0; r < 4; ++r) { d1[r] = 1.f + __builtin_amdgcn_exp2f(t1[r]); d2[r] = 1.f + __builtin_amdgcn_exp2f(t2[r]); }
            const f32x4 dd = d1 * d2;
#pragma unroll
            for (int r = 0; r < 4; ++r) inv[r] = __builtin_amdgcn_rcpf(dd[r]);
            const f32x4 rr = d2 * inv, ii = d1 * inv, la = rr * ksp;
            const f32x4 w = la * (1.f + la * (0.5f + la * (0.16666667f + la * (0.041666667f + la * 0.0083333333f))));
            f32x4 av = 1.f + w;
            const f32x4 om = -w * (2.f + w);
            f32x4 uv;
#pragma unroll
            for (int r = 0; r < 4; ++r) uv[r] = __builtin_amdgcn_sqrtf(om[r]);
            uv = uv * ii * xa4;
            scan16x4(av, uv); R[mt] = av; I[mt] = uv;
        }
        {
            f32x4 Pc = {1.f, 1.f, 1.f, 1.f}, Hc = {0.f, 0.f, 0.f, 0.f};
#pragma unroll
            for (int mt = 0; mt < 8; ++mt) { Hc = Hc * R[mt] + I[mt]; Pc = Pc * R[mt]; }
            if (fr == 15) {
#pragma unroll
                for (int r = 0; r < 4; ++r) __hip_atomic_store(AGG + (size_t)ck * 1024 + cch + r, ((unsigned long long)__float_as_uint(Hc[r]) << 32) | (unsigned long long)__float_as_uint(Pc[r]), __ATOMIC_RELAXED, __HIP_MEMORY_SCOPE_AGENT);
            }
        }
        __syncthreads();
        if (u + G < 1024) MX_PREFETCH(u + G);
        unsigned long long ag0 = 0x000000003f800000ull, ag1 = 0x000000003f800000ull, ag2 = 0x000000003f800000ull, ag3 = 0x000000003f800000ull;
        if (j > 0 && fr < j) { const unsigned long long* ap = AGG + (size_t)(ck - j + fr) * 1024 + cch;
            ag0 = __hip_atomic_load(ap, __ATOMIC_RELAXED, __HIP_MEMORY_SCOPE_AGENT); ag1 = __hip_atomic_load(ap + 1, __ATOMIC_RELAXED, __HIP_MEMORY_SCOPE_AGENT);
            ag2 = __hip_atomic_load(ap + 2, __ATOMIC_RELAXED, __HIP_MEMORY_SCOPE_AGENT); ag3 = __hip_atomic_load(ap + 3, __ATOMIC_RELAXED, __HIP_MEMORY_SCOPE_AGENT); }
        {
            bf16x8 q[4];
#pragma unroll
            for (int ks = 0; ks < 4; ++ks) q[ks] = *(const LAS bf16x8*)(lds + MY_VT + (16 * wave + fr) * 256 + (((ks * 4 + grp) ^ fr) << 4));
#pragma unroll
            for (int mt = 0; mt < 8; ++mt) { f32x4 Sx = {0.f, 0.f, 0.f, 0.f};
#pragma unroll
                for (int ks = 0; ks <= mt / 2; ++ks) { const bf16x8 p = *(const LAS bf16x8*)(lds + MY_WS + (mt * 16 + fr) * 256 + (((ks * 4 + grp) ^ fr) << 4));
                    Sx = __builtin_amdgcn_mfma_f32_16x16x32_bf16(q[ks], p, Sx, 0, 0, 0); }
                *(LAS u32x2*)(lds + MY_SP + (mt * 16 + fr) * RS + (16 * wave + 4 * grp) * 2) = (u32x2){cvt_pk_bf16_cv(Sx[0], Sx[1]), cvt_pk_bf16_cv(Sx[2], Sx[3])}; }
        }
        {
            f32x4 hc0 = {0.f, 0.f, 0.f, 0.f};
            if (j > 0) {
                f32x4 lp, lh; unsigned spin = 0;
                for (;;) {
                    lp[0] = __uint_as_float((unsigned)ag0); lh[0] = __uint_as_float((unsigned)(ag0 >> 32)); lp[1] = __uint_as_float((unsigned)ag1); lh[1] = __uint_as_float((unsigned)(ag1 >> 32));
                    lp[2] = __uint_as_float((unsigned)ag2); lh[2] = __uint_as_float((unsigned)(ag2 >> 32)); lp[3] = __uint_as_float((unsigned)ag3); lh[3] = __uint_as_float((unsigned)(ag3 >> 32));
                    const bool ok = (lp[0] != 0.f) && (lp[1] != 0.f) && (lp[2] != 0.f) && (lp[3] != 0.f);
                    if (__all(ok)) break;
                    if (++spin > (1u << 22)) break;
                    __builtin_amdgcn_s_sleep(1);
                    if (fr < j) { const unsigned long long* ap = AGG + (size_t)(ck - j + fr) * 1024 + cch;
                        ag0 = __hip_atomic_load(ap, __ATOMIC_RELAXED, __HIP_MEMORY_SCOPE_AGENT); ag1 = __hip_atomic_load(ap + 1, __ATOMIC_RELAXED, __HIP_MEMORY_SCOPE_AGENT);
                        ag2 = __hip_atomic_load(ap + 2, __ATOMIC_RELAXED, __HIP_MEMORY_SCOPE_AGENT); ag3 = __hip_atomic_load(ap + 3, __ATOMIC_RELAXED, __HIP_MEMORY_SCOPE_AGENT); } }
                scan16x4(lp, lh);
#pragma unroll
                for (int r = 0; r < 4; ++r) hc0[r] = __shfl(lh[r], (lane & 48) | 15);
            }
            f32x4 s = hc0;
#pragma unroll
            for (int mt = 0; mt < 8; ++mt) { f32x4 hb;
#pragma unroll
                for (int r = 0; r < 4; ++r) hb[r] = __shfl(s[r], (lane & 48) | 15);
                s = R[mt] * s + I[mt];
                const f32x4 hv = I[mt] + R[mt] * hb;
                *(LAS u32x2*)(lds + MY_XA + (mt * 16 + fr) * RS + (16 * wave + 4 * grp) * 2) = (u32x2){cvt_pk_bf16(hv[0], hv[1]), cvt_pk_bf16(hv[2], hv[3])}; }
        }
        u32x4 ga[4], ub[4]; float bsr[4]; f32x4 nq0 = {0.f, 0.f, 0.f, 0.f}, nq1 = {0.f, 0.f, 0.f, 0.f};
        if (u + G < 1024) MX_STATS_LOAD(u + G, nq0, nq1);
#pragma unroll
        for (int it = 0; it < 4; ++it) { const int idx = it * 512 + tid, row = idx >> 4, ch = idx & 15; const unsigned o = ((unsigned)(t0 + row) * D + c0 + ch * 8) * 2u; ga[it] = *(const u32x4*)((const char*)GA + o); ub[it] = *(const u32x4*)((const char*)UB + o); bsr[it] = in[14][g * 128 + row]; }
        __syncthreads();
#pragma unroll
        for (int it = 0; it < 4; ++it) { const int idx = it * 512 + tid, row = idx >> 4, ch = idx & 15;
            f32x4 g0, g1, u0, u1, h0, h1, s0, s1; unpack8(ga[it], g0, g1); unpack8(ub[it], u0, u1);
            unpack8(*(const LAS u32x4*)(lds + MY_XA + row * RS + ch * 16), h0, h1); unpack8(*(const LAS u32x4*)(lds + MY_SP + row * RS + ch * 16), s0, s1);
            store16_sc1((char*)MG + ((unsigned)(t0 + row) * D + c0 + ch * 8) * 2u, pack8(g0 * h0 + u0 * (s0 + bsr[it]), g1 * h1 + u1 * (s1 + bsr[it]))); }
        if (u + G < 1024) MX_STATS_WRITE(nq0, nq1);
        asm volatile("s_waitcnt vmcnt(0)" ::: "memory");
        if (lane == 0) __hip_atomic_fetch_add(mixc + 64 * (ck >> 1), 1u, __ATOMIC_RELAXED, __HIP_MEMORY_SCOPE_AGENT);
        __syncthreads();
    }
#undef MX_PREFETCH
#undef MX_STATS_LOAD
#undef MX_STATS_WRITE
#undef MX_ZR
#undef MX_SETZR
}

__device__ __forceinline__ void build_moe_units(LAS int* tab1, LAS int* tab2, LAS int* tab3, const int* CNT, int vcu, int G, int wave, LAS int* flags) {
    const int tid = wave * 64 + pg8::lane_id();
    int NT = 0, my_e = 0, my_tile = 0, my_cnt = 0, my_rt = 0;
    for (int e = 0; e < 32; ++e) { const int cnt = CNT[e]; const int ntl = (cnt + 255) >> 8;
        if (tid >= NT && tid < NT + ntl) { my_e = e; my_tile = tid - NT; my_cnt = cnt; my_rt = tid; }
        NT += ntl; }
    const bool have = tid < NT;
    const bool heavy = have && (my_cnt - my_tile * 256) > 128;
    flags[tid] = heavy ? 1 : 0;
    __syncthreads();
    int hb = 0, NH = 0;
    for (int i = 0; i < NT; ++i) { const int f = flags[i]; NH += f; hb += (i < tid) ? f : 0; }
    const int slot = heavy ? hb : NH + (tid - hb);
    const int U1 = 2 * NT, U2 = 4 * NT; int nlate = (U1 > G && U1 < 2 * G) ? U1 - G : 0; if (G - nlate < 64) nlate = 0;
    const int Ge = G - nlate, c2 = vcu - nlate, ssplit = nlate ? G / 2 : NT, Lsplit = 4 * ssplit;
    const int n1 = vcu < U1 ? (U1 - 1 - vcu) / G + 1 : 0;
    const int tot2 = (c2 >= 0 && c2 < U2) ? (U2 - 1 - c2) / Ge + 1 : 0;
    int n2 = (c2 >= 0 && c2 < Lsplit) ? (Lsplit - 1 - c2) / Ge + 1 : 0; n2 = n2 < tot2 ? n2 : tot2;
    const int n3 = tot2 - n2;
    if (tid == 0) { tab1[0] = n1 < 12 ? n1 : 12; tab2[0] = n2 < 12 ? n2 : 12; tab3[0] = n3 < 12 ? n3 : 12; }
    if (have) {
#pragma unroll
        for (int q = 0; q < 2; ++q) { const int L = 2 * slot + q; if (L % G == vcu && L / G < 12) { LAS int* p = tab1 + 4 + 8 * (L / G); p[0] = my_rt; p[1] = my_e * 2 + q; p[2] = my_e; p[3] = my_tile; p[4] = my_cnt; } }
        if (c2 >= 0) {
#pragma unroll
            for (int q = 0; q < 4; ++q) { const int L2 = 4 * slot + q; if (L2 % Ge == c2) { const int k = L2 / Ge; const bool early = slot < ssplit; const int idx = early ? k : k - n2;
                if (idx >= 0 && idx < 12) { LAS int* p = (early ? tab2 : tab3) + 4 + 8 * idx; p[0] = my_rt; p[1] = my_e * 4 + q; p[2] = my_e; p[3] = my_tile; p[4] = my_cnt; } } }
        }
    }
    __syncthreads();
}
__device__ __forceinline__ void moe_wait_tiles(const LAS int* tab, unsigned* dcnt, int wave) {
    if (wave == 0) {
        const int n = __builtin_amdgcn_readfirstlane(tab[0]);
        for (int i = 0; i < n; ++i) { const int rt = __builtin_amdgcn_readfirstlane(tab[4 + 8 * i]); unsigned sp = 0;
            while ((unsigned)__builtin_amdgcn_readfirstlane(__hip_atomic_load(dcnt + 64 * rt, __ATOMIC_RELAXED, __HIP_MEMORY_SCOPE_AGENT)) < 16u) { if (++sp > (1u << 22)) break; __builtin_amdgcn_s_sleep(2); } }
        __builtin_amdgcn_fence(__ATOMIC_ACQUIRE, "agent");
        asm volatile("s_waitcnt vmcnt(0)" ::: "memory");
    }
    __syncthreads();
}

struct Args { const float* in[28]; float* out; unsigned char* ws; int ph_lo, ph_hi, li, pad; };

__global__ void __launch_bounds__(NWAVES * 64, 2) mega_fwd(Args args) {
    extern __shared__ __attribute__((aligned(16))) unsigned char lds_raw[];
    LAS unsigned char* lds = (LAS unsigned char*)lds_raw;
    volatile LAS unsigned* MISC = (volatile LAS unsigned*)(lds + MISC_OFF);
    const int tid0 = threadIdx.x, wave = __builtin_amdgcn_readfirstlane(tid0 >> 6);
#define PHASE_IDS() int lane = pg8::lane_id(); asm volatile("" : "+v"(lane)); const int tid = wave * 64 + lane; (void)tid
    const int G = gridDim.x;
    const int vcu = (G % 8 == 0) ? ((int)blockIdx.x % 8) * (G / 8) + (int)blockIdx.x / 8 : (int)blockIdx.x;
    unsigned char* ws = args.ws;
    unsigned* ctl = (unsigned*)(ws + WS_CTL);
    for (int u = tid0; u < (LDS_BYTES - LDSCTL_OFF) / 4; u += NWAVES * 64) ((LAS unsigned*)(lds + LDSCTL_OFF))[u] = 0u;
    __syncthreads();
    XcdBarrier bar = xcd_barrier_post(ctl + CW_BAR + args.li * XCD_BAR_WORDS, MISC + 8, wave);
    const int lo = args.ph_lo, hi = args.ph_hi;
#define IN(k) (lo <= (k) && (k) < hi)
#define BOTH(k) (IN(k) && IN((k) + 1))
    const float* const* in = args.in;
    bf16 *XN = (bf16*)(ws + WS_A0), *MG = (bf16*)args.out, *X2b = (bf16*)(ws + WS_A0);
    float *RSTD0 = (float*)(ws + WS_RSTD0), *GINV = (float*)(ws + WS_GINV), *SA = (float*)(ws + WS_RSTD1), *SB = (float*)(ws + WS_SB);
    signed char* XNi = (signed char*)args.out;
    signed char* WinTi = (signed char*)(ws + WS_WIN);
    bf16 *Zl = (bf16*)(ws + WS_A1), *X1b = (bf16*)args.out + (size_t)T * D;
    bf16 *GA = (bf16*)(ws + WS_A2), *UB = (bf16*)(ws + WS_A3), *V = (bf16*)(ws + WS_A4);
    bf16 *X3 = (bf16*)(ws + WS_A3);
    unsigned char* X1q = ws + WS_A1 + 16 * MiB;
    unsigned char* X2q = ws + WS_A1;
    bf16 *PU = (bf16*)(ws + WS_A2);
    bf16 *Pb = (bf16*)(ws + WS_PB);
    bf16 *WinT = (bf16*)(ws + WS_WIN), *WoutT = (bf16*)(ws + WS_WOUT), *WgT = (bf16*)(ws + WS_WG), *W13T = (bf16*)(ws + WS_W13), *W2T = (bf16*)(ws + WS_W2), *WupT = (bf16*)(ws + WS_WUP);
    float *VPART = (float*)(ws + WS_VPART), *SS1 = (float*)(ws + WS_SS1), *SS3 = (float*)(ws + WS_SS3), *RSTD2 = (float*)(ws + WS_RSTD2), *RSTD1 = (float*)(ws + WS_RSTD1), *LISTG = (float*)(ws + WS_LISTG), *LISTR = (float*)(ws + WS_LISTR);
    int *CNT = (int*)(ws + WS_CTL), *LIST = (int*)(ws + WS_LIST), *TOKE = (int*)(ws + WS_TOKE);
    bf16 *Hb = (bf16*)(ws + WS_A2), *Yb = (bf16*)(ws + WS_A3), *WrT = (bf16*)(ws + WS_WR), *WLRU = (bf16*)(ws + WS_WLRU), *WSGU = (bf16*)(ws + WS_WSGU);
    unsigned long long* AGGQ = (unsigned long long*)(ws + WS_AGG); float* SPL8 = (float*)(ws + WS_SPL8);

    if (IN(0)) {
        PHASE_IDS();
        LAS float* scr0 = (LAS float*)lds;
        const bool tab_fast = (G * 512 == 131072);
        float tf_lru = 0.f, tf_sgu = 0.f, tf10 = 0.f, tf2 = 1.f, tfr = 0.f;
        if (tab_fast) {
            const int i = vcu * 512 + tid, gate = i >> 16, h = (i >> 12) & 15, j = (i >> 6) & 63, ii = i & 63;
            const float f_lru = (gate ? in[8] : in[6])[(h * 64 + ii) * 64 + j], f_sgu = in[13][i];
            const int i10 = i < 1024 ? i : 0; const float f10 = in[10][i10], f2 = in[2][i10];
            const int n = (i >> 10) & 63, k = i & 1023; const float fa = in[17][k * 4 + (n < 4 ? n : 0)], fb = in[19][k * 32 + ((n >= 4 && n < 36) ? n - 4 : 0)], fk = in[16][k];
            tf_lru = f_lru; tf_sgu = f_sgu; tf10 = f10; tf2 = f2; tfr = n < 4 ? fa * fk : (n < 36 ? fb * fk : 0.f);
        }
        const int gw = vcu * NWAVES + wave, NGW = G * NWAVES;
        for (int cb = vcu; cb < 192; cb += G) {
            const int kb8 = lane >> 3, n4 = lane & 7, dr0 = win_dest_row(cb * 32);
            TrItem t0, t1; tr_load<true>(t0, in[3], 6144, 128 * wave, cb * 32, lane); tr_load<true>(t1, in[3], 6144, 128 * wave + 64, cb * 32, lane);
            pg8::f32x4 cm = {0.f, 0.f, 0.f, 0.f};
#pragma unroll
            for (int q = 0; q < 8; ++q)
#pragma unroll
                for (int i = 0; i < 4; ++i) cm[i] = fmaxf(cm[i], fmaxf(fabsf(t0.v[q][i]), fabsf(t1.v[q][i])));
#pragma unroll
            for (int i = 0; i < 4; ++i) { cm[i] = fmaxf(cm[i], __shfl_xor(cm[i], 8)); cm[i] = fmaxf(cm[i], __shfl_xor(cm[i], 16)); cm[i] = fmaxf(cm[i], __shfl_xor(cm[i], 32)); }
            if (kb8 == 0) *(LAS pg8::f32x4*)(scr0 + wave * 32 + 4 * n4) = cm;
            __syncthreads();
#pragma unroll
            for (int w8 = 0; w8 < 8; ++w8) { const pg8::f32x4 o = *(const LAS pg8::f32x4*)(scr0 + w8 * 32 + 4 * n4);
#pragma unroll
                for (int i = 0; i < 4; ++i) cm[i] = fmaxf(cm[i], o[i]); }
            pg8::f32x4 qs;
#pragma unroll
            for (int i = 0; i < 4; ++i) { cm[i] = fmaxf(cm[i], 1.0e-30f); qs[i] = 127.f / cm[i]; }
            if (wave == 0 && kb8 == 0) *(pg8::f32x4*)(SB + dr0 + 4 * n4) = cm * (1.f / 127.f);
#pragma unroll
            for (int i = 0; i < 4; ++i) { const float q_ = qs[i]; signed char* dst = WinTi + (size_t)(dr0 + 4 * n4 + i) * 1024 + 128 * wave + 8 * kb8;
                *(pg8::u32x2*)dst = (pg8::u32x2){pack4_i8(t0.v[0][i] * q_, t0.v[1][i] * q_, t0.v[2][i] * q_, t0.v[3][i] * q_), pack4_i8(t0.v[4][i] * q_, t0.v[5][i] * q_, t0.v[6][i] * q_, t0.v[7][i] * q_)};
                *(pg8::u32x2*)(dst + 64) = (pg8::u32x2){pack4_i8(t1.v[0][i] * q_, t1.v[1][i] * q_, t1.v[2][i] * q_, t1.v[3][i] * q_), pack4_i8(t1.v[4][i] * q_, t1.v[5][i] * q_, t1.v[6][i] * q_, t1.v[7][i] * q_)}; }
            __syncthreads();
        }
        if (tab_fast) { const int i = vcu * 512 + tid, t = (i >> 7) & 127, s_ = i & 127;
            WLRU[i] = f2bf(tf_lru); WSGU[i] = s_ <= t ? f2bf(tf_sgu) : (bf16)0;
            if (i < 1024) { SPL8[i] = -8.f * log1pf(expf(-tf10)); GINV[i] = 1.f / tf2; }
            if (i < 64 * 1024) WrT[i] = f2bf(tfr); }
        for (int m = gw; m < T; m += 2 * NGW) {
            const int m2 = m + NGW < T ? m + NGW : m;
            const pg8::f32x4* xr = (const pg8::f32x4*)(in[0] + (size_t)m * D) + lane; const pg8::f32x4* xr2 = (const pg8::f32x4*)(in[0] + (size_t)m2 * D) + lane; const pg8::f32x4* gr = (const pg8::f32x4*)in[2] + lane;
            pg8::f32x4 v[4], w[4]; float s = 0.f, s2 = 0.f;
#pragma unroll
            for (int j = 0; j < 4; ++j) { v[j] = __builtin_nontemporal_load(xr + 64 * j); w[j] = __builtin_nontemporal_load(xr2 + 64 * j); }
#pragma unroll
            for (int j = 0; j < 4; ++j) { s += (v[j].x * v[j].x + v[j].y * v[j].y) + (v[j].z * v[j].z + v[j].w * v[j].w); s2 += (w[j].x * w[j].x + w[j].y * w[j].y) + (w[j].z * w[j].z + w[j].w * w[j].w); }
            const float rstd = rsqrtf(wave_sum(s) * (1.f / D) + EPS), rstd2 = rsqrtf(wave_sum(s2) * (1.f / D) + EPS);
            if (lane == 0) { RSTD0[m] = 1.f / rstd; RSTD0[m2] = 1.f / rstd2; }
            unsigned long long* o8 = (unsigned long long*)(XN + (size_t)m * D) + lane; unsigned long long* o82 = (unsigned long long*)(XN + (size_t)m2 * D) + lane;
            float mx = 0.f, mx2 = 0.f;
#pragma unroll
            for (int j = 0; j < 4; ++j) { const pg8::f32x4 gg = gr[64 * j]; v[j] = v[j] * rstd * gg; w[j] = w[j] * rstd2 * gg;
                mx = fmaxf(fmaxf(mx, fmaxf(fabsf(v[j].x), fabsf(v[j].y))), fmaxf(fabsf(v[j].z), fabsf(v[j].w))); mx2 = fmaxf(fmaxf(mx2, fmaxf(fabsf(w[j].x), fabsf(w[j].y))), fmaxf(fabsf(w[j].z), fabsf(w[j].w)));
                o8[64 * j] = (unsigned long long)pk2(v[j].x, v[j].y) | ((unsigned long long)pk2(v[j].z, v[j].w) << 32);
                o82[64 * j] = (unsigned long long)pk2(w[j].x, w[j].y) | ((unsigned long long)pk2(w[j].z, w[j].w) << 32); }
            mx = fmaxf(wave_max(mx), 1.0e-30f); mx2 = fmaxf(wave_max(mx2), 1.0e-30f);
            const float qi = 127.f / mx, qi2 = 127.f / mx2;
            if (lane == 0) { SA[m] = mx * (1.f / 127.f); SA[m2] = mx2 * (1.f / 127.f); }
            unsigned* i8 = (unsigned*)(XNi + (size_t)m * D) + lane; unsigned* i82 = (unsigned*)(XNi + (size_t)m2 * D) + lane;
#pragma unroll
            for (int j = 0; j < 4; ++j) { i8[64 * j] = pack4_i8(v[j].x * qi, v[j].y * qi, v[j].z * qi, v[j].w * qi); i82[64 * j] = pack4_i8(w[j].x * qi2, w[j].y * qi2, w[j].z * qi2, w[j].w * qi2); }
        }
        if (!tab_fast) {
        for (int i = vcu * 512 + tid; i < 2 * 16 * 64 * 64; i += G * 512) { const int gate = i >> 16, h = (i >> 12) & 15, j = (i >> 6) & 63, ii = i & 63;
            WLRU[i] = f2bf(in[gate ? 8 : 6][(h * 64 + ii) * 64 + j]); }
        for (int i = vcu * 512 + tid; i < 8 * 128 * 128; i += G * 512) { const int t = (i >> 7) & 127, s = i & 127; WSGU[i] = s <= t ? f2bf(in[13][i]) : (bf16)0; }
        for (int i = vcu * 512 + tid; i < 1024; i += G * 512) { SPL8[i] = -8.f * log1pf(expf(-in[10][i])); GINV[i] = 1.f / in[2][i]; }
        for (int i = vcu * 512 + tid; i < 64 * 1024; i += G * 512) { const int n = i >> 10, k = i & 1023; float v = 0.f;
            if (n < 4) v = in[17][k * 4 + n] * in[16][k]; else if (n < 36) v = in[19][k * 32 + (n - 4)] * in[16][k];
            WrT[i] = f2bf(v); }
        }
        if (BOTH(0)) xcd_barrier(bar);
    }
    if (IN(1)) {
        { pg8::Gemm g{(const bf16*)XNi, (const bf16*)WinTi, 512}; Gemm1Order S;   S.init(T, 6144, G, (int)blockIdx.x);
          S.wave = wave; { const int upw = (64 * 24) / G > 0 ? (64 * 24) / G : 1; S.gi = (int)blockIdx.x % upw; } S.w = DefW{args.in, ws};
          pg8::Epi1 E{Zl, GA, UB, V, VPART, SA, SB};
          pg8::gemm_phase<pg8::Epi1, Gemm1Order, true, true, false, 2>(lds, g, S, E, wave); }
        if (BOTH(1)) xcd_barrier(bar);
    }

    if (IN(3)) {
        PHASE_IDS();
        mixer_phase(lds, vcu, G, tid, lane, wave, Zl, GA, UB, V, VPART, AGGQ, MG, ctl + CW_MIX, WLRU, WSGU, SPL8, in);
    }
    if (IN(4)) {
        pg8::Gemm g{MG, WoutT, 1024}; pg8::StaticOrder S; S.init(T, 1024, G, (int)blockIdx.x);
        pg8::Epi2 E{XN, RSTD0, GINV, X1b, SS1};
        if (BOTH(3)) {
            if (wave == 0) { pg8::Unit u0;
                for (int i = 0; S.next(i, u0); ++i) { unsigned sp = 0;
                    while ((unsigned)__builtin_amdgcn_readfirstlane(__hip_atomic_load(ctl + CW_MIX + 64 * u0.pm, __ATOMIC_RELAXED, __HIP_MEMORY_SCOPE_AGENT)) < 128u) { if (++sp > (1u << 22)) break; __builtin_amdgcn_s_sleep(2); } }
                __builtin_amdgcn_fence(__ATOMIC_ACQUIRE, "agent");
                asm volatile("s_waitcnt vmcnt(0)" ::: "memory"); }
            __syncthreads();
        }
        pg8::gemm_phase<pg8::Epi2, pg8::StaticOrder, true, true, false>(lds, g, S, E, wave);
        if (BOTH(4)) xcd_barrier(bar);
    }

    if (IN(5)) {
        PHASE_IDS();
        constexpr int LS = 52;
        LAS float* sP = (LAS float*)lds;
        LAS float* sL = (LAS float*)(lds + 8 * 64 * LS * 4);
        LAS int* sCnt = (LAS int*)(lds + 9 * 64 * LS * 4); LAS int* sBase = sCnt + 32;
        const int fr = lane & 15, grp = lane >> 4;
        for (int tile = vcu; tile < T / 64; tile += G) {
            const int tok0 = tile * 64;
            if (tid < 32) sCnt[tid] = 0;
            pg8::bf16x8 a[4][4], b[3][4];
#pragma unroll
            for (int mt = 0; mt < 4; ++mt)
#pragma unroll
                for (int ks = 0; ks < 4; ++ks) a[mt][ks] = *(const pg8::bf16x8*)(X1b + (size_t)(tok0 + 16 * mt + fr) * D + wave * 128 + ks * 32 + 8 * grp);
#pragma unroll
            for (int nt = 0; nt < 3; ++nt)
#pragma unroll
                for (int ks = 0; ks < 4; ++ks) b[nt][ks] = *(const pg8::bf16x8*)(WrT + (size_t)(16 * nt + fr) * D + wave * 128 + ks * 32 + 8 * grp);
            pg8::f32x4 q0 = {0.f, 0.f, 0.f, 0.f}, q1 = q0, q2 = q0, q3 = q0;
#pragma unroll
            for (int mt = 0; mt < 4; ++mt)
#pragma unroll
                for (int ks = 0; ks < 4; ++ks) { pg8::f32x4 e0, e1; pg8::unpack8(__builtin_bit_cast(pg8::u32x4, a[mt][ks]), e0, e1);
                    *(pg8::u32x2*)(X1q + (size_t)(tok0 + 16 * mt + fr) * D + wave * 128 + ks * 32 + 8 * grp) = pg8::pack8_fp8(e0, e1); }
            if (tid < 64) { const float* sp = SS1 + (size_t)(tok0 + tid) * 16; q0 = *(const pg8::f32x4*)sp; q1 = *(const pg8::f32x4*)(sp + 4); q2 = *(const pg8::f32x4*)(sp + 8); q3 = *(const pg8::f32x4*)(sp + 12); }
#pragma unroll
            for (int mt = 0; mt < 4; ++mt)
#pragma unroll
                for (int nt = 0; nt < 3; ++nt) { pg8::f32x4 acc = {0.f, 0.f, 0.f, 0.f};
#pragma unroll
                    for (int ks = 0; ks < 4; ++ks) acc = __builtin_amdgcn_mfma_f32_16x16x32_bf16(a[mt][ks], b[nt][ks], acc, 0, 0, 0);
#pragma unroll
                    for (int r = 0; r < 4; ++r) sP[(wave * 64 + 16 * mt + 4 * grp + r) * LS + 16 * nt + fr] = acc[r]; }
            __syncthreads();
            { const int tk = tid >> 3, c0 = (tid & 7) * 6;
#pragma unroll
              for (int c = 0; c < 6; ++c) { float sum = 0.f;
#pragma unroll
                  for (int w = 0; w < 8; ++w) sum += sP[(w * 64 + tk) * LS + c0 + c];
                  sL[tk * LS + c0 + c] = sum; } }
            __syncthreads();
            int e1 = 0, e2 = 0, r1 = 0, r2 = 0; float g1 = 0.f, g2 = 0.f, rstd = 0.f;
            if (tid < 64) {
                const int t = tok0 + tid;
                const pg8::f32x4 qs = (q0 + q1) + (q2 + q3);
                const float ss = (qs[0] + qs[1]) + (qs[2] + qs[3]);
                rstd = rsqrtf(ss * (1.f / D) + EPS);
                const LAS float* l = sL + tid * LS;
                float gl[4];
#pragma unroll
                for (int q = 0; q < 4; ++q) gl[q] = rstd * l[q] + in[18][q];
                float mx = gl[0]; int gi = 0;
#pragma unroll
                for (int q = 1; q < 4; ++q) if (gl[q] > mx) { mx = gl[q]; gi = q; }
                float den = 0.f;
#pragma unroll
                for (int q = 0; q < 4; ++q) den += expf(gl[q] - mx);
                const float gtop = 1.f / den;
                float m1 = -3.0e38f, m2 = -3.0e38f; int i1 = 0, i2 = 0;
                for (int j = 0; j < 8; ++j) { const float v = rstd * l[4 + gi * 8 + j] + in[20][gi * 8 + j];
                    if (v > m1) { m2 = m1; i2 = i1; m1 = v; i1 = j; } else if (v > m2) { m2 = v; i2 = j; } }
                const float p2 = expf(m2 - m1);
                g1 = gtop / (1.f + p2); g2 = gtop * p2 / (1.f + p2);
                e1 = gi * 8 + i1; e2 = gi * 8 + i2;
                r1 = __hip_atomic_fetch_add(&sCnt[e1], 1, __ATOMIC_RELAXED, __HIP_MEMORY_SCOPE_WORKGROUP); r2 = __hip_atomic_fetch_add(&sCnt[e2], 1, __ATOMIC_RELAXED, __HIP_MEMORY_SCOPE_WORKGROUP);
            }
            __syncthreads();
            if (tid < 32) { const int c = sCnt[tid]; sBase[tid] = c ? atomicAdd(&CNT[tid], c) : 0; }
            __syncthreads();
            if (tid < 64) { const int t = tok0 + tid, p1 = e1 * 16384 + sBase[e1] + r1, p2 = e2 * 16384 + sBase[e2] + r2;
                LIST[p1] = t * 2; LIST[p2] = t * 2 + 1; LISTG[p1] = g1; LISTG[p2] = g2; LISTR[p1] = rstd; LISTR[p2] = rstd; }
            __syncthreads();
        }
        if (BOTH(5)) xcd_barrier(bar);
    }
    if (IN(6)) {
        LAS int* tab1 = (LAS int*)(lds + TAB_OFF); LAS int* tab2 = (LAS int*)(lds + TAB_OFF + 512); LAS int* tab3 = (LAS int*)(lds + TAB_OFF + 1024);
        build_moe_units(tab1, tab2, tab3, CNT, vcu, G, wave, (LAS int*)lds);
        unsigned* dcnt = ctl + CW_DONE1;
        { pg8::Gemm g{(const bf16*)X1q, W13T, 512}; pg8::MoeOrder<1> S{tab1, LIST, dcnt, 1024u};
          pg8::EpiMoe1 E{(unsigned char*)Hb, LISTR};
          pg8::gemm_phase<pg8::EpiMoe1, pg8::MoeOrder<1>, true, true, true, 1>(lds, g, S, E, wave); }
        pg8::Gemm g2{Hb, W2T, 128}; pg8::EpiMoe2 E2{(unsigned char*)Yb, LIST, LISTG};
        moe_wait_tiles(tab2, dcnt, wave);
        { pg8::MoeOrder<0> S{tab2, LIST, dcnt, 2048u}; pg8::gemm_phase<pg8::EpiMoe2, pg8::MoeOrder<0>, true, true, false, 1>(lds, g2, S, E2, wave); }
        moe_wait_tiles(tab3, dcnt, wave);
        { pg8::MoeOrder<0> S{tab3, LIST, dcnt, 2048u}; pg8::gemm_phase<pg8::EpiMoe2, pg8::MoeOrder<0>, true, true, false, 1>(lds, g2, S, E2, wave); }
        if (BOTH(6)) xcd_barrier(bar);
    }
    if (IN(8)) {
        const bool split = (G % 16 == 0);
        const int q8 = (int)blockIdx.x >> 3, x8 = (int)blockIdx.x & 7;
        const bool do_gemm = !split || (q8 & 1), do_comb = !split || !(q8 & 1);
        if (do_comb) {
            PHASE_IDS();
            const int NGW = (split ? G / 2 : G) * NWAVES, gw = (split ? (q8 >> 1) * 8 + x8 : vcu) * NWAVES + wave;
            for (int row = gw; row < T; row += 2 * NGW) {
                const int row2 = row + NGW; const bool two = row2 < T; const int rb = two ? row2 : row;
                pg8::u32x4 la[2][2]; pg8::u32x2 lb[2][2], lc[2][2];
#pragma unroll
                for (int rr = 0; rr < 2; ++rr)
#pragma unroll
                    for (int hh = 0; hh < 2; ++hh) { const int r = rr ? rb : row;
                        la[rr][hh] = __builtin_nontemporal_load((const pg8::u32x4*)(X1b + (size_t)r * D + hh * 512 + lane * 8));
                        lb[rr][hh] = __builtin_nontemporal_load((const pg8::u32x2*)((const unsigned char*)Yb + (size_t)r * 2 * D + hh * 512 + lane * 8));
                        lc[rr][hh] = __builtin_nontemporal_load((const pg8::u32x2*)((const unsigned char*)Yb + ((size_t)r * 2 + 1) * D + hh * 512 + lane * 8)); }
#pragma unroll
                for (int rr = 0; rr < 2; ++rr) { const int r = rr ? rb : row; float ss = 0.f;
#pragma unroll
                    for (int hh = 0; hh < 2; ++hh) { pg8::f32x4 a0, a1, b0, b1, c0, c1; pg8::unpack8(la[rr][hh], a0, a1); pg8::unpack8_fp8(lb[rr][hh], b0, b1); pg8::unpack8_fp8(lc[rr][hh], c0, c1);
                        a0 = a0 + (b0 + c0) * (1.f / 16.f); a1 = a1 + (b1 + c1) * (1.f / 16.f);
                        ss += pg8::hsum4(a0 * a0 + a1 * a1);
                        if (rr == 0 || two) { *(pg8::u32x4*)(X2b + (size_t)r * D + hh * 512 + lane * 8) = pg8::pack8(a0, a1); *(pg8::u32x2*)(X2q + (size_t)r * D + hh * 512 + lane * 8) = pg8::pack8_fp8(a0, a1); } }
                    ss = wave_sum(ss);
                    if (lane == 0 && (rr == 0 || two)) RSTD2[r] = rsqrtf(ss * (1.f / D) + EPS); }
            }
        }
        if (do_gemm) {
            pg8::Gemm g{Pb, WupT, 256}; pg8::StaticOrder S; S.init(T, 1024, split ? G / 2 : G, split ? (q8 >> 1) * 8 + x8 : (int)blockIdx.x);
            pg8::EpiPlain E{PU};
            pg8::gemm_phase<pg8::EpiPlain, pg8::StaticOrder, true, true, false>(lds, g, S, E, wave);
        }
        if (BOTH(8)) xcd_barrier(bar);
    }
    const bool fuse_final = (G == 256);
    if (IN(9)) {
        pg8::Gemm g{(const bf16*)X2q, WgT, 512}; pg8::StaticOrder S; S.init(T, 1024, G, (int)blockIdx.x);
        if (fuse_final) {
            pg8::EpiPleFinal E{X2b, PU, RSTD2, in[27], args.out, (float*)(ws + WS_XCH), ctl + CW_PANEL, (LAS float*)(lds + RING_BYTES), wave};
            pg8::gemm_phase<pg8::EpiPleFinal, pg8::StaticOrder, true, true, false, 1>(lds, g, S, E, wave);
        } else {
            pg8::EpiPle E{X2b, PU, RSTD2, X3, SS3};
            pg8::gemm_phase<pg8::EpiPle, pg8::StaticOrder, true, true, false, 1>(lds, g, S, E, wave);
            if (BOTH(9)) xcd_barrier(bar);
        }
    }

    if (IN(10) && !fuse_final) {
        PHASE_IDS();
        const int gw = vcu * NWAVES + wave, NGW = G * NWAVES;
        for (int row = gw; row < T; row += NGW) { float ss = 0.f;
            if (lane < 16) ss = SS3[(size_t)row * 16 + lane];
            ss = wave_sum(ss);
            const float rstd = rsqrtf(ss * (1.f / D) + EPS);
#pragma unroll
            for (int hh = 0; hh < 2; ++hh) { const size_t o = (size_t)row * D + hh * 512 + lane * 8; pg8::f32x4 a0, a1; pg8::unpack8(*(const pg8::u32x4*)(X3 + o), a0, a1);
                const pg8::f32x4 f0 = *(const pg8::f32x4*)(in[27] + hh * 512 + lane * 8), f1 = *(const pg8::f32x4*)(in[27] + hh * 512 + lane * 8 + 4);
                *(pg8::f32x4*)(args.out + o) = a0 * rstd * f0; *(pg8::f32x4*)(args.out + o + 4) = a1 * rstd * f1; } }
    }
#undef IN
#undef BOTH
#undef PHASE_IDS
}

static int mega_grid() {
    static int grid = 0;
    if (grid == 0) {
        int dev = 0, cus = 0;
        if (hipGetDevice(&dev) != hipSuccess || hipDeviceGetAttribute(&cus, hipDeviceAttributeMultiprocessorCount, dev) != hipSuccess) { fprintf(stderr, "mega: device query failed\n"); grid = -1; return grid; }
        if (hipFuncSetAttribute((const void*)mega_fwd, hipFuncAttributeMaxDynamicSharedMemorySize, LDS_BYTES) != hipSuccess) { fprintf(stderr, "mega: hipFuncSetAttribute failed\n"); grid = -1; return grid; }
        (void)hipGetLastError();
        grid = cus;
    }
    return grid;
}
static void launch_mega(void* const* d_in, void* d_out, void* d_ws, int lo, int hi, int li, hipStream_t stream) {
    const int grid = mega_grid(); if (grid <= 0) return;
    Args a{};
    for (int i = 0; i < 28; ++i) a.in[i] = (const float*)d_in[i];
    a.out = (float*)d_out; a.ws = (unsigned char*)d_ws; a.ph_lo = lo; a.ph_hi = hi; a.li = li; a.pad = 0;
    hipLaunchKernelGGL(mega_fwd, dim3(grid), dim3(NWAVES * 64), LDS_BYTES, stream, a);
}

extern "C" void kernel_launch(void* const* d_in, const int* in_sizes, int n_in, void* d_out, int out_size, void* d_ws, size_t ws_size, hipStream_t stream) {
    if (n_in != 28 || in_sizes[0] != T * D || out_size != T * D || ws_size < WS_MEGA_END) { fprintf(stderr, "kernel_launch: unexpected shapes (n_in %d, ws %zu)\n", n_in, ws_size); return; }
    (void)hipMemsetAsync(d_ws, 0, 2 * MiB, stream);
    launch_mega(d_in, d_out, d_ws, 0, 11, 0, stream);
}
```

```cpp
#include <hip/hip_runtime.h>
#include <stdint.h>
#include <cstdio>

typedef unsigned short bf16;
constexpr int T = 16384, D = 1024, SEQ = 2048;
constexpr float EPS = 1e-6f;
constexpr size_t MiB = 1u << 20;
constexpr size_t WS_CTL = 0;
constexpr size_t WS_VPART = 2 * MiB;
constexpr size_t WS_SS1 = 4 * MiB;
constexpr size_t WS_SS3 = 5 * MiB;
constexpr size_t WS_AGG = 1 * MiB;
constexpr size_t WS_LIST = 6 * MiB;
constexpr size_t WS_TOKE = 8 * MiB;
constexpr size_t WS_TOKG = 8 * MiB + 128 * 1024;
constexpr size_t WS_RSTD2 = 8 * MiB + 256 * 1024;
constexpr size_t WS_A0 = 74 * MiB;
constexpr size_t WS_A1 = 106 * MiB;
constexpr size_t WS_A2 = 138 * MiB;
constexpr size_t WS_A3 = 170 * MiB;
constexpr size_t WS_A4 = 202 * MiB;
constexpr size_t WS_END = 234 * MiB;

__device__ __forceinline__ float bf2f(bf16 b) { return __uint_as_float(((unsigned)b) << 16); }
__device__ __forceinline__ bf16 f2bf(float f) { unsigned u = __float_as_uint(f); u += 0x7fffu + ((u >> 16) & 1u); return (bf16)(u >> 16); }
__device__ __forceinline__ float sigm(float x) { return 1.f / (1.f + expf(-x)); }
__device__ __forceinline__ float gelu_t(float x) { const float u = 0.7978845608028654f * (x + 0.044715f * x * x * x); return 0.5f * x * (1.f + tanhf(u)); }
__device__ __forceinline__ float wave_max(float v) {
#pragma unroll
    for (int o = 32; o > 0; o >>= 1) v = fmaxf(v, __shfl_xor(v, o));
    return v; }
__device__ __forceinline__ unsigned pack4_i8(float a, float b, float c, float d) {
    const int ia = (int)__builtin_rintf(a), ib = (int)__builtin_rintf(b), ic = (int)__builtin_rintf(c), id = (int)__builtin_rintf(d);
    return ((unsigned)ia & 255u) | (((unsigned)ib & 255u) << 8) | (((unsigned)ic & 255u) << 16) | ((unsigned)id << 24); }
__device__ __forceinline__ float wave_sum(float v) {
#pragma unroll
    for (int o = 1; o < 64; o <<= 1) v += __shfl_xor(v, o);
    return v;
}

#define LAS __attribute__((address_space(3)))
#define GAS __attribute__((address_space(1)))
namespace pg8 {
typedef short bf16x8 __attribute__((ext_vector_type(8)));
typedef float f32x4 __attribute__((ext_vector_type(4)));
typedef float f32x2 __attribute__((ext_vector_type(2)));
typedef unsigned u32x4 __attribute__((ext_vector_type(4)));
typedef unsigned u32x2 __attribute__((ext_vector_type(2)));
typedef int i32x4 __attribute__((ext_vector_type(4)));
typedef int i32x8 __attribute__((ext_vector_type(8)));
constexpr int BM = 256, BK = 64, HALF = 128, HTB = HALF * BK * 2, STAGE_BYTES = 8 * HTB, NXCD = 8, WGM = 8;

__host__ __device__ __forceinline__ int lds_byte(int r, int c) { const int st = (r >> 4) * 2 + (c >> 5), rr = r & 15, cc = c & 31, ob = rr * 64 + cc * 2; return st * 1024 + (ob ^ (((ob >> 9) & 1) << 5)); }
__host__ __device__ __forceinline__ void stage_rc(int b, int& R, int& C) { const int st = b / 1024, sb = b % 1024, swz = sb ^ (((sb >> 9) & 1) << 5); R = (st >> 1) * 16 + swz / 64; C = (st & 1) * 32 + (swz % 64) / 2; }
__host__ __device__ __forceinline__ int perm32(int rho) { const int n = rho >> 4, i = rho & 15; return 8 * (i >> 2) + 4 * n + (i & 3); }

__device__ __forceinline__ int lane_id() { int l; asm volatile("v_mbcnt_lo_u32_b32 %0, -1, 0\n\tv_mbcnt_hi_u32_b32 %0, -1, %0" : "=v"(l)); return l; }
struct Unit { int pm, pn, e, tile, cnt, par; };
struct Gemm { const bf16* A; const bf16* Bt; int K; int lda = 0; };

struct StaticOrder {
    int nM, nN, nwg, G, c;
    __device__ __forceinline__ void init(int M, int N, int G_, int c_) { nM = M / BM; nN = N / BM; nwg = nM * nN; G = G_; c = c_; }
    __device__ __forceinline__ bool next(int i, Unit& u) const {
        const long L = (long)i * G + c; if (L >= nwg) return false;
        int wgid = (int)L; { const int q = nwg / NXCD, r = nwg % NXCD, xcd = wgid % NXCD, off = wgid / NXCD; wgid = (xcd < r ? xcd * (q + 1) : r * (q + 1) + (xcd - r) * q) + off; }
        const int nig = WGM * nN, gid = wgid / nig, fm = gid * WGM, gsz = (nM - fm) < WGM ? (nM - fm) : WGM;
        u.pm = fm + ((wgid % nig) % gsz); u.pn = (wgid % nig) / gsz; u.e = 0; u.tile = 0; u.cnt = 0; return true;
    }
    __device__ __forceinline__ unsigned row_off(const Unit&, int) const { return 0u; }
    __device__ __forceinline__ void a_ready(const Unit&) const {}
    __device__ __forceinline__ void done(const Unit&) const {}
    struct Pre {}; __device__ __forceinline__ void pre(int, Pre&) const {}
    __device__ __forceinline__ void post(int, Pre&) const {}
    __device__ __forceinline__ bool half(const Unit&) const { return false; }
};

__device__ __forceinline__ unsigned cvt_pk_bf16(float lo, float hi) { unsigned r; asm volatile("v_cvt_pk_bf16_f32 %0, %1, %2" : "=v"(r) : "v"(lo), "v"(hi)); return r; }
typedef __bf16 bf16x2_t __attribute__((ext_vector_type(2)));
__device__ __forceinline__ unsigned cvt_pk_bf16_cv(float lo, float hi) { const f32x2 v = {lo, hi}; const bf16x2_t b = __builtin_convertvector(v, bf16x2_t); return __builtin_bit_cast(unsigned, b); }
__device__ __forceinline__ float fsigm(float x) { return __builtin_amdgcn_rcpf(1.0f + __builtin_amdgcn_exp2f(-1.4426950409f * x)); }
__device__ __forceinline__ float fgelu(float x) { const float u = x + 0.044715f * x * x * x; return x * __builtin_amdgcn_rcpf(1.0f + __builtin_amdgcn_exp2f(-2.3022082f * u)); }
__device__ __forceinline__ f32x4 vexp2(const f32x4 t) { f32x4 e;
#pragma unroll
    for (int i = 0; i < 4; ++i) e[i] = __builtin_amdgcn_exp2f(t[i]);
    return e; }
__device__ __forceinline__ f32x4 vrcp(const f32x4 t) { f32x4 e;
#pragma unroll
    for (int i = 0; i < 4; ++i) e[i] = __builtin_amdgcn_rcpf(t[i]);
    return e; }
__device__ __forceinline__ f32x4 vgelu_den(const f32x4 x) { return 1.f + vexp2(x * (x * x * (-0.10294324f) + (-2.3022082f))); }
__device__ __forceinline__ f32x4 vsigm_den(const f32x4 x) { return 1.f + vexp2(x * (-1.4426950409f)); }
__device__ __forceinline__ float hsum4(const f32x4 v) { return (v[0] + v[1]) + (v[2] + v[3]); }

__device__ __forceinline__ i32x8 cat8(const bf16x8 lo, const bf16x8 hi) { const i32x4 a = __builtin_bit_cast(i32x4, lo), b = __builtin_bit_cast(i32x4, hi); return __builtin_shufflevector(a, b, 0, 1, 2, 3, 4, 5, 6, 7); }
template <class E> struct epi_stage { static constexpr bool v = false; };
template <class E> struct epi_init { static constexpr bool v = false; };
template <class Epi, class Sched, bool ALIGN_EPI, bool SP2, bool GATHER, int QM = 0>
__device__ __forceinline__ void gemm_phase(LAS unsigned char* lds, const Gemm g, const Sched& S, const Epi& E, const int wave_) {
    int lane = lane_id(); asm volatile("" : "+v"(lane));
    const int wid = wave_, tid = wid * 64 + lane, wr = wid >> 2, wc = wid & 3, fr = lane & 15, fq = lane >> 4;
    constexpr bool FP8 = (QM == 1);
    int K_ = g.K; if constexpr (QM != 0) asm volatile("" : "+s"(K_));
    const int K = K_, nt = K / BK, LDA = g.lda ? g.lda : K;
    int sR[2], sC[2];
    unsigned voffB[2], vA0[2], vA1[2], nvA0[2], nvA1[2];
#pragma unroll
    for (int i = 0; i < 2; ++i) { stage_rc(tid * 16 + i * 8192, sR[i], sC[i]); const int Rb = Epi::PERM ? ((sR[i] & ~31) + perm32(sR[i] & 31)) : sR[i];
        voffB[i] = (unsigned)(Rb * K + sC[i]) * 2u; vA0[i] = (unsigned)(sR[i] * LDA + sC[i]) * 2u; vA1[i] = vA0[i]; nvA0[i] = vA0[i]; nvA1[i] = vA0[i]; }
    const size_t kstep = (size_t)(BK * 2);
    const size_t hstep = (size_t)HALF * K * 2;
    const size_t tstep = 2 * hstep;
    const size_t ahstep = (size_t)HALF * LDA * 2, atstep = 2 * ahstep;
    const size_t ahs = GATHER ? 0 : ahstep;
    const unsigned ldsw = (unsigned)wid * 1024u;
    const int aoff = lds_byte(wr * 64 + fr, fq * 8), boff = lds_byte(wc * 32 + fr, fq * 8);
#define PG8_SA(b, h) (((b) * 2 + (h)) * HTB)
#define PG8_SB(b, h) ((4 + (b) * 2 + (h)) * HTB)
#define PG8_STAGE(bufoff, gbase, voff) do { _Pragma("unroll") for (int _i = 0; _i < 2; ++_i) \
        __builtin_amdgcn_global_load_lds((const unsigned*)((const char*)(gbase) + (voff)[_i]), (LAS unsigned*)(lds + (bufoff) + ldsw + _i * 8192), 16, 0, 0); } while (0)
#define PG8_LDA(dst, b, h) do { if constexpr (FP8) { _Pragma("unroll") for (int m = 0; m < 4; ++m) dst##q[m] = cat8(*(const LAS bf16x8*)(lds + PG8_SA(b, h) + aoff + m * 2048), *(const LAS bf16x8*)(lds + PG8_SA(b, h) + aoff + m * 2048 + 1024)); } \
        else { _Pragma("unroll") for (int m = 0; m < 4; ++m) _Pragma("unroll") for (int k = 0; k < 2; ++k) dst[m][k] = *(const LAS bf16x8*)(lds + PG8_SA(b, h) + aoff + m * 2048 + k * 1024); } } while (0)
#define PG8_LDB(dst, b, h) do { if constexpr (FP8) { _Pragma("unroll") for (int n = 0; n < 2; ++n) dst##q[n] = cat8(*(const LAS bf16x8*)(lds + PG8_SB(b, h) + boff + n * 2048), *(const LAS bf16x8*)(lds + PG8_SB(b, h) + boff + n * 2048 + 1024)); } \
        else { _Pragma("unroll") for (int n = 0; n < 2; ++n) _Pragma("unroll") for (int k = 0; k < 2; ++k) dst[n][k] = *(const LAS bf16x8*)(lds + PG8_SB(b, h) + boff + n * 2048 + k * 1024); } } while (0)
#define PG8_MMA(ai, bj, At, Bt) do { __builtin_amdgcn_s_setprio(1); \
        if constexpr (FP8) { _Pragma("unroll") for (int m = 0; m < 4; ++m) _Pragma("unroll") for (int n = 0; n < 2; ++n) \
            asm volatile("v_mfma_scale_f32_16x16x128_f8f6f4 %0, %1, %2, %0, %3, %3 op_sel_hi:[0,0,0]" : "+v"(acc[ai][bj][m][n]) : "v"(Bt##q[n]), "v"(At##q[m]), "v"(mxs)); } \
        else if constexpr (QM == 2) { _Pragma("unroll") for (int m = 0; m < 4; ++m) _Pragma("unroll") for (int n = 0; n < 2; ++n) _Pragma("unroll") for (int k = 0; k < 2; ++k) \
            acc[ai][bj][m][n] = __builtin_bit_cast(f32x4, __builtin_amdgcn_mfma_i32_16x16x64_i8(__builtin_bit_cast(i32x4, Bt[n][k]), __builtin_bit_cast(i32x4, At[m][k]), __builtin_bit_cast(i32x4, acc[ai][bj][m][n]), 0, 0, 0)); } \
        else { _Pragma("unroll") for (int m = 0; m < 4; ++m) _Pragma("unroll") for (int n = 0; n < 2; ++n) _Pragma("unroll") for (int k = 0; k < 2; ++k) \
            acc[ai][bj][m][n] = __builtin_amdgcn_mfma_f32_16x16x32_bf16(Bt[n][k], At[m][k], acc[ai][bj][m][n], 0, 0, 0); } \
        __builtin_amdgcn_s_setprio(0); } while (0)
#define PG8_WAIT_V(n) asm volatile("s_waitcnt vmcnt(" #n ")" ::: "memory")
#define PG8_WAIT_L(n) asm volatile("s_waitcnt lgkmcnt(" #n ")" ::: "memory")
#define PG8_BAR __builtin_amdgcn_s_barrier()
#define PG8_SCHED __builtin_amdgcn_sched_barrier(0)
    Unit cur, nxt; int ui = 0;
    if (!S.next(0, cur)) return;
    cur.par = 0;
    f32x4 acc[2][2][4][2];
#pragma unroll
    for (int a = 0; a < 2; ++a)
#pragma unroll
        for (int b = 0; b < 2; ++b)
#pragma unroll
            for (int m = 0; m < 4; ++m)
#pragma unroll
                for (int n = 0; n < 2; ++n) acc[a][b][m][n] = (f32x4){0.f, 0.f, 0.f, 0.f};
    if constexpr (epi_init<Epi>::v) E.init(acc, cur, wr, wc, fr, fq);
    int mxs = 0x7F7F7F7F; if constexpr (FP8) asm volatile("" : "+v"(mxs));
    bf16x8 At[4][2], B0[2][2], B1[2][2]; i32x8 Atq[4], B0q[2], B1q[2];
    const char* cA = GATHER ? (const char*)g.A : (const char*)g.A + (size_t)cur.pm * atstep; const char* cB = (const char*)g.Bt + (size_t)cur.pn * tstep;
    if constexpr (GATHER) {
#pragma unroll
        for (int i = 0; i < 2; ++i) { vA0[i] = S.row_off(cur, sR[i]) + (unsigned)sC[i] * 2u; vA1[i] = S.row_off(cur, HALF + sR[i]) + (unsigned)sC[i] * 2u; nvA0[i] = vA0[i]; nvA1[i] = vA1[i]; }
    }
    S.a_ready(cur);
    if constexpr (SP2) {
        PG8_STAGE(PG8_SB(0, 0), cB, voffB); PG8_STAGE(PG8_SB(0, 1), cB + hstep, voffB); PG8_STAGE(PG8_SA(0, 0), cA, vA0); PG8_STAGE(PG8_SA(0, 1), cA + ahs, vA1);
        if (wr == 1) PG8_BAR;
        PG8_WAIT_V(2); PG8_BAR;
        PG8_STAGE(PG8_SB(1, 0), cB + kstep, voffB); PG8_STAGE(PG8_SA(1, 0), cA + kstep, vA0); PG8_STAGE(PG8_SB(1, 1), cB + hstep + kstep, voffB);
        PG8_WAIT_V(6); PG8_BAR;
    } else {
        PG8_STAGE(PG8_SB(0, 0), cB, voffB); PG8_STAGE(PG8_SA(0, 0), cA, vA0); PG8_STAGE(PG8_SB(0, 1), cB + hstep, voffB); PG8_STAGE(PG8_SA(0, 1), cA + ahs, vA1);
        if (wr == 1) PG8_BAR;
        PG8_WAIT_V(4); PG8_BAR;
        PG8_STAGE(PG8_SB(1, 0), cB + kstep, voffB); PG8_STAGE(PG8_SA(1, 0), cA + kstep, vA0); PG8_STAGE(PG8_SB(1, 1), cB + hstep + kstep, voffB);
        PG8_WAIT_V(6); PG8_BAR;
    }
    for (;;) {
        const bool has_next = S.next(ui + 1, nxt); nxt.par = (ui + 1) & 1;
        const char* nA = has_next ? (GATHER ? (const char*)g.A : (const char*)g.A + (size_t)nxt.pm * atstep) : cA; const char* nB = has_next ? (const char*)g.Bt + (size_t)nxt.pn * tstep : cB;
        const bool hf = S.half(cur);
        for (int t = 0; t < nt; t += 2) {
            const bool last = (t == nt - 2);
            const char* a1 = cA + (size_t)(t + 1) * kstep;
            const char* a2 = last ? nA : cA + (size_t)(t + 2) * kstep; const char* b2 = last ? nB : cB + (size_t)(t + 2) * kstep;
            const char* a3 = a2 + kstep; const char* b3 = b2 + kstep;
            if constexpr (epi_stage<Epi>::v) { if (last) E.stage(cur, lds, wid); }
            if (last && has_next) S.a_ready(nxt);
            unsigned w0[2], w1[2];
            if constexpr (GATHER) {
                if (last && has_next) {
#pragma unroll
                    for (int i = 0; i < 2; ++i) { nvA0[i] = S.row_off(nxt, sR[i]) + (unsigned)sC[i] * 2u; nvA1[i] = S.row_off(nxt, HALF + sR[i]) + (unsigned)sC[i] * 2u; }
                }
#pragma unroll
                for (int i = 0; i < 2; ++i) { w0[i] = last ? nvA0[i] : vA0[i]; w1[i] = last ? nvA1[i] : vA1[i]; }
            } else {
#pragma unroll
                for (int i = 0; i < 2; ++i) { w0[i] = vA0[i]; w1[i] = vA0[i]; }
            }
            if constexpr (SP2) {
            PG8_LDB(B0, 0, 0); PG8_LDB(B1, 0, 1); PG8_SCHED; PG8_LDA(At, 0, 0); PG8_STAGE(PG8_SA(1, 1), a1 + ahs, vA1);
            PG8_WAIT_V(8); PG8_WAIT_L(0); PG8_BAR; PG8_MMA(0, 0, At, B0); PG8_MMA(0, 1, At, B1); PG8_BAR; PG8_SCHED;
            if (!hf) PG8_LDA(At, 0, 1); PG8_STAGE(PG8_SB(0, 0), b2, voffB); PG8_STAGE(PG8_SB(0, 1), b2 + hstep, voffB); PG8_STAGE(PG8_SA(0, 0), a2, w0);
            PG8_WAIT_V(8); PG8_WAIT_L(0); PG8_BAR; if (!hf) { PG8_MMA(1, 0, At, B0); PG8_MMA(1, 1, At, B1); } PG8_BAR; PG8_SCHED;
            PG8_LDB(B0, 1, 0); PG8_LDB(B1, 1, 1); PG8_SCHED; PG8_LDA(At, 1, 0); PG8_STAGE(PG8_SA(0, 1), a2 + ahs, w1);
            PG8_WAIT_V(8); PG8_WAIT_L(0); PG8_BAR; PG8_MMA(0, 0, At, B0); PG8_MMA(0, 1, At, B1); PG8_BAR; PG8_SCHED;
            if (!hf) PG8_LDA(At, 1, 1); PG8_STAGE(PG8_SB(1, 0), b3, voffB); PG8_STAGE(PG8_SB(1, 1), b3 + hstep, voffB); PG8_STAGE(PG8_SA(1, 0), a3, w0);
            PG8_WAIT_V(8); PG8_WAIT_L(0); PG8_BAR; if (!hf) { PG8_MMA(1, 0, At, B0); PG8_MMA(1, 1, At, B1); } PG8_BAR; PG8_SCHED;
            } else {
            PG8_LDB(B0, 0, 0); PG8_SCHED; PG8_LDA(At, 0, 0); PG8_STAGE(PG8_SA(1, 1), a1 + ahs, vA1);
            PG8_WAIT_L(8); PG8_BAR; PG8_WAIT_L(0); PG8_MMA(0, 0, At, B0); PG8_BAR; PG8_SCHED;
            PG8_LDB(B1, 0, 1); PG8_STAGE(PG8_SB(0, 0), b2, voffB);
            PG8_BAR; PG8_WAIT_L(0); PG8_MMA(0, 1, At, B1); PG8_BAR;
            PG8_LDA(At, 0, 1); PG8_STAGE(PG8_SA(0, 0), a2, w0);
            PG8_BAR; PG8_WAIT_L(0); PG8_MMA(1, 0, At, B0); PG8_BAR; PG8_SCHED;
            PG8_STAGE(PG8_SB(0, 1), b2 + hstep, voffB);
            PG8_WAIT_V(6); PG8_BAR; PG8_MMA(1, 1, At, B1); PG8_BAR;
            PG8_LDB(B0, 1, 0); PG8_SCHED; PG8_LDA(At, 1, 0); PG8_STAGE(PG8_SA(0, 1), a2 + ahs, w1);
            PG8_WAIT_L(8); PG8_BAR; PG8_WAIT_L(0); PG8_MMA(0, 0, At, B0); PG8_BAR; PG8_SCHED;
            PG8_LDB(B1, 1, 1); PG8_STAGE(PG8_SB(1, 0), b3, voffB);
            PG8_BAR; PG8_WAIT_L(0); PG8_MMA(0, 1, At, B1); PG8_BAR;
            PG8_LDA(At, 1, 1); PG8_STAGE(PG8_SA(1, 0), a3, w0);
            PG8_BAR; PG8_WAIT_L(0); PG8_MMA(1, 0, At, B0); PG8_BAR; PG8_SCHED;
            PG8_STAGE(PG8_SB(1, 1), b3 + hstep, voffB);
            PG8_WAIT_V(6); PG8_BAR; PG8_MMA(1, 1, At, B1); PG8_BAR;
            }
        }
        if constexpr (FP8) asm volatile("s_nop 15\n\ts_nop 15" ::: "memory");
        typename Sched::Pre pre_; S.pre(ui, pre_);
        if constexpr (ALIGN_EPI) { if (wr == 0) PG8_BAR; }
        E(acc, cur, wr, wc, fr, fq); S.done(cur); S.post(ui, pre_);
        if (!has_next) break;
#pragma unroll
        for (int a = 0; a < 2; ++a)
#pragma unroll
            for (int b = 0; b < 2; ++b)
#pragma unroll
                for (int m = 0; m < 4; ++m)
#pragma unroll
                    for (int n = 0; n < 2; ++n) acc[a][b][m][n] = (f32x4){0.f, 0.f, 0.f, 0.f};
        cur = nxt; cA = nA; cB = nB; ++ui;
        if constexpr (GATHER) {
#pragma unroll
            for (int i = 0; i < 2; ++i) { vA0[i] = nvA0[i]; vA1[i] = nvA1[i]; }
        }
        if constexpr (ALIGN_EPI) { if (wr == 1) PG8_BAR; }
    }
    PG8_WAIT_V(0);
    if constexpr (!ALIGN_EPI) { if (wr == 0) PG8_BAR; }
    PG8_BAR;
#undef PG8_SA
#undef PG8_SB
#undef PG8_STAGE
#undef PG8_LDA
#undef PG8_LDB
#undef PG8_MMA
#undef PG8_WAIT_V
#undef PG8_WAIT_L
#undef PG8_BAR
#undef PG8_SCHED
}

__device__ __forceinline__ u32x4 pack8(const f32x4 v0, const f32x4 v1) { u32x4 w; w.x = cvt_pk_bf16(v0[0], v0[1]); w.y = cvt_pk_bf16(v0[2], v0[3]); w.z = cvt_pk_bf16(v1[0], v1[1]); w.w = cvt_pk_bf16(v1[2], v1[3]); return w; }
__device__ __forceinline__ u32x2 pack8_fp8(const f32x4 v0, const f32x4 v1) { int lo = __builtin_amdgcn_cvt_pk_fp8_f32(v0[0], v0[1], 0, false); lo = __builtin_amdgcn_cvt_pk_fp8_f32(v0[2], v0[3], lo, true);
    int hi = __builtin_amdgcn_cvt_pk_fp8_f32(v1[0], v1[1], 0, false); hi = __builtin_amdgcn_cvt_pk_fp8_f32(v1[2], v1[3], hi, true); return (u32x2){(unsigned)lo, (unsigned)hi}; }
__device__ __forceinline__ void unpack8_fp8(const u32x2 w, f32x4& v0, f32x4& v1) { const f32x2 a = __builtin_amdgcn_cvt_pk_f32_fp8((int)w.x, false), b = __builtin_amdgcn_cvt_pk_f32_fp8((int)w.x, true),
        c = __builtin_amdgcn_cvt_pk_f32_fp8((int)w.y, false), d = __builtin_amdgcn_cvt_pk_f32_fp8((int)w.y, true); v0 = (f32x4){a.x, a.y, b.x, b.y}; v1 = (f32x4){c.x, c.y, d.x, d.y}; }
__device__ __forceinline__ void unpack8_i8(const u32x2 w, f32x4& v0, f32x4& v1) {
    v0 = (f32x4){(float)(signed char)w.x, (float)(signed char)(w.x >> 8), (float)(signed char)(w.x >> 16), (float)((int)w.x >> 24)};
    v1 = (f32x4){(float)(signed char)w.y, (float)(signed char)(w.y >> 8), (float)(signed char)(w.y >> 16), (float)((int)w.y >> 24)}; }
__device__ __forceinline__ void unpack8_u8(const u32x2 w, f32x4& v0, f32x4& v1) {
    v0 = (f32x4){(float)(w.x & 255u), (float)((w.x >> 8) & 255u), (float)((w.x >> 16) & 255u), (float)(w.x >> 24)};
    v1 = (f32x4){(float)(w.y & 255u), (float)((w.y >> 8) & 255u), (float)((w.y >> 16) & 255u), (float)(w.y >> 24)}; }
__device__ __forceinline__ unsigned pack4_u8(const f32x4 v) {
    const int a = (int)__builtin_rintf(v[0]) + 128, b = (int)__builtin_rintf(v[1]) + 128, c = (int)__builtin_rintf(v[2]) + 128, d = (int)__builtin_rintf(v[3]) + 128;
    return (unsigned)a | ((unsigned)b << 8) | ((unsigned)c << 16) | ((unsigned)d << 24); }
__device__ __forceinline__ void unpack8(const u32x4 w, f32x4& v0, f32x4& v1) {
    v0[0] = __uint_as_float(w.x << 16); v0[1] = __uint_as_float(w.x & 0xffff0000u); v0[2] = __uint_as_float(w.y << 16); v0[3] = __uint_as_float(w.y & 0xffff0000u);
    v1[0] = __uint_as_float(w.z << 16); v1[1] = __uint_as_float(w.z & 0xffff0000u); v1[2] = __uint_as_float(w.w << 16); v1[3] = __uint_as_float(w.w & 0xffff0000u); }

struct Epi1 {
    static constexpr bool PERM = true;
    bf16 *Zl, *GA, *UB, *V; float* VPART; const float* SA; const float* SB; LAS unsigned char* lds;
    static constexpr int SCL = 131072;
    __device__ __forceinline__ void stage(const Unit& u, LAS unsigned char* l, int wid) const { const int lane = lane_id();
        const float* src = wid < 4 ? SA + u.pm * BM + wid * 64 + lane : SB + u.pn * 256 + (wid - 4) * 64 + lane;
        __builtin_amdgcn_global_load_lds((const unsigned*)src, (LAS unsigned*)(l + SCL + wid * 256), 4, 0, 0); }
    static __device__ __forceinline__ f32x4 dq(const f32x4 a, const f32x4 s) { return __builtin_convertvector(__builtin_bit_cast(i32x4, a), f32x4) * s; }
    __device__ __forceinline__ void operator()(const f32x4 (&acc)[2][2][4][2], const Unit& u, int wr, int wc, int fr, int fq) const {
        const int row0 = u.pm * BM + wr * 64 + fr, pn = u.pn;
        const LAS float* SAl = (const LAS float*)(lds + SCL) + wr * 64 + fr;
        const LAS float* sbp = (const LAS float*)(lds + SCL + 1024) + wc * 32 + 8 * fq;
#define EPI1_SB() __builtin_amdgcn_sched_barrier(0); asm volatile("" : "+v"(sbp)); const f32x4 sb00 = *(const LAS f32x4*)sbp, sb01 = *(const LAS f32x4*)(sbp + 4), sb10 = *(const LAS f32x4*)(sbp + HALF), sb11 = *(const LAS f32x4*)(sbp + HALF + 4)
        if (pn < 4) {
            const int col0 = pn * 256 + wc * 32 + 8 * fq;
#pragma unroll
            for (int ai = 0; ai < 2; ++ai)
#pragma unroll
                for (int m = 0; m < 4; ++m) { EPI1_SB(); bf16* rowp = Zl + (size_t)(row0 + ai * HALF + m * 16) * D + col0; const float sa = SAl[ai * HALF + m * 16];
#pragma unroll
                    for (int bj = 0; bj < 2; ++bj) *(u32x4*)(rowp + bj * HALF) = pack8(dq(acc[ai][bj][m][0], (bj ? sb10 : sb00) * sa), dq(acc[ai][bj][m][1], (bj ? sb11 : sb01) * sa)); }
        } else if (pn < 20) {
            bf16* O = pn < 12 ? GA : UB; const int uu = pn < 12 ? pn - 4 : pn - 12; const int col0 = uu * 128 + wc * 32 + 8 * fq;
#pragma unroll
            for (int ai = 0; ai < 2; ++ai)
#pragma unroll
                for (int m = 0; m < 4; ++m) { EPI1_SB(); f32x4 v[2]; const float sa = SAl[ai * HALF + m * 16];
#pragma unroll
                    for (int n = 0; n < 2; ++n) { const f32x4 za = dq(acc[ai][0][m][n], (n ? sb01 : sb00) * sa), zb = dq(acc[ai][1][m][n], (n ? sb11 : sb10) * sa); v[n] = za * vrcp(vgelu_den(za) * vsigm_den(zb)); }
                    *(u32x4*)(O + (size_t)(row0 + ai * HALF + m * 16) * D + col0) = pack8(v[0], v[1]); }
        } else {
            const int col0 = (pn - 20) * 256 + wc * 32 + 8 * fq;
#pragma unroll
            for (int ai = 0; ai < 2; ++ai)
#pragma unroll
                for (int m = 0; m < 4; ++m) { EPI1_SB(); const int row = row0 + ai * HALF + m * 16; f32x4 s1v = {0.f, 0.f, 0.f, 0.f}, s2v = {0.f, 0.f, 0.f, 0.f}; const float sa = SAl[ai * HALF + m * 16];
#pragma unroll
                    for (int bj = 0; bj < 2; ++bj) { f32x4 v[2];
#pragma unroll
                        for (int n = 0; n < 2; ++n) { const f32x4 z = dq(acc[ai][bj][m][n], (bj ? (n ? sb11 : sb10) : (n ? sb01 : sb00)) * sa); v[n] = z * vrcp(vgelu_den(z)); s1v += v[n]; s2v += v[n] * v[n]; }
                        *(u32x4*)(V + (size_t)row * D + col0 + bj * HALF) = pack8(v[0], v[1]); }
                    float s1 = hsum4(s1v), s2 = hsum4(s2v);
                    s1 += __shfl_xor(s1, 16); s1 += __shfl_xor(s1, 32); s2 += __shfl_xor(s2, 16); s2 += __shfl_xor(s2, 32);
                    if (fq == 0) *(f32x2*)(VPART + (size_t)row * 32 + ((pn - 20) * 4 + wc) * 2) = (f32x2){s1, s2}; }
        }
    }
};
template <> struct epi_stage<Epi1> { static constexpr bool v = true; };
struct EpiPlain {
    static constexpr bool PERM = true;
    unsigned char* O; float* SPU;
    __device__ __forceinline__ void operator()(const f32x4 (&acc)[2][2][4][2], const Unit& u, int wr, int wc, int fr, int fq) const {
        const int row0 = u.pm * BM + wr * 64 + fr, col0 = u.pn * 256 + wc * 32 + 8 * fq;
#pragma unroll
        for (int ai = 0; ai < 2; ++ai)
#pragma unroll
            for (int m = 0; m < 4; ++m) { const int row = row0 + ai * HALF + m * 16;
                f32x4 mv = {0.f, 0.f, 0.f, 0.f};
#pragma unroll
                for (int bj = 0; bj < 2; ++bj)
#pragma unroll
                    for (int n = 0; n < 2; ++n)
#pragma unroll
                        for (int i = 0; i < 4; ++i) mv[i] = fmaxf(mv[i], fabsf(acc[ai][bj][m][n][i]));
                float mx = fmaxf(fmaxf(mv[0], mv[1]), fmaxf(mv[2], mv[3]));
                mx = fmaxf(mx, __shfl_xor(mx, 16)); mx = fmaxf(mx, __shfl_xor(mx, 32)); mx = fmaxf(mx, 1.0e-30f);
                const float q = 127.f / mx;
                if (fq == 0) SPU[(size_t)row * 16 + u.pn * 4 + wc] = mx * (1.f / 127.f);
#pragma unroll
                for (int bj = 0; bj < 2; ++bj) *(u32x2*)(O + (size_t)row * D + col0 + bj * HALF) = (u32x2){pack4_u8(acc[ai][bj][m][0] * q), pack4_u8(acc[ai][bj][m][1] * q)}; }
    }
};
struct Epi2 {
    static constexpr bool PERM = true;
    const bf16* XN; const float* RI0; const float* GINV; bf16* X1b; float* SS1; unsigned* mixc; int one; int wave;
    __device__ __forceinline__ void init(f32x4 (&acc)[2][2][4][2], const Unit& u, int wr, int wc, int fr, int fq) const {
        if (!one) return;
        const int row0 = u.pm * BM + wr * 64 + fr, col0 = u.pn * 256 + wc * 32 + 8 * fq;
        u32x4 xr[2][4][2]; float ri[2][4];
#pragma unroll
        for (int ai = 0; ai < 2; ++ai)
#pragma unroll
            for (int m = 0; m < 4; ++m) { const int row = row0 + ai * HALF + m * 16; ri[ai][m] = RI0[row];
#pragma unroll
                for (int bj = 0; bj < 2; ++bj) xr[ai][m][bj] = *(const u32x4*)(XN + (size_t)row * D + col0 + bj * HALF); }
        const f32x4 g00 = *(const f32x4*)(GINV + col0), g01 = *(const f32x4*)(GINV + col0 + 4), g10 = *(const f32x4*)(GINV + col0 + HALF), g11 = *(const f32x4*)(GINV + col0 + HALF + 4);
        if (mixc) {
            if (wave == 0) { asm volatile("buffer_inv sc1" ::: "memory");
                unsigned sp = 0;
                while ((unsigned)__builtin_amdgcn_readfirstlane(__hip_atomic_load(mixc + 64 * u.pm, __ATOMIC_RELAXED, __HIP_MEMORY_SCOPE_AGENT)) < 128u) { if (++sp > (1u << 22)) break; __builtin_amdgcn_s_sleep(2); }
                asm volatile("s_waitcnt vmcnt(0)" ::: "memory"); }
            __syncthreads();
        }
#pragma unroll
        for (int ai = 0; ai < 2; ++ai)
#pragma unroll
            for (int m = 0; m < 4; ++m)
#pragma unroll
                for (int bj = 0; bj < 2; ++bj) { f32x4 x0, x1; unpack8(xr[ai][m][bj], x0, x1);
                    acc[ai][bj][m][0] = x0 * ri[ai][m] * (bj ? g10 : g00); acc[ai][bj][m][1] = x1 * ri[ai][m] * (bj ? g11 : g01); }
    }
    __device__ __forceinline__ void operator()(const f32x4 (&acc)[2][2][4][2], const Unit& u, int wr, int wc, int fr, int fq) const {
        const int row0 = u.pm * BM + wr * 64 + fr, col0 = u.pn * 256 + wc * 32 + 8 * fq;
#pragma unroll
        for (int ai = 0; ai < 2; ++ai)
#pragma unroll
            for (int m = 0; m < 4; ++m) { const int row = row0 + ai * HALF + m * 16; float ss = 0.f;
#pragma unroll
                for (int bj = 0; bj < 2; ++bj) { f32x4 v0 = acc[ai][bj][m][0], v1 = acc[ai][bj][m][1];
                    if (!one) { f32x4 x0, x1; unpack8(*(const u32x4*)(XN + (size_t)row * D + col0 + bj * HALF), x0, x1); const float ri = RI0[row];
                        const f32x4 g0 = *(const f32x4*)(GINV + col0 + bj * HALF), g1 = *(const f32x4*)(GINV + col0 + bj * HALF + 4);
                        v0 = v0 + x0 * ri * g0; v1 = v1 + x1 * ri * g1; }
                    ss += hsum4(v0 * v0 + v1 * v1);
                    *(u32x4*)(X1b + (size_t)row * D + col0 + bj * HALF) = pack8(v0, v1); }
                ss += __shfl_xor(ss, 16); ss += __shfl_xor(ss, 32);
                if (fq == 0) SS1[(size_t)row * 16 + u.pn * 4 + wc] = ss; }
    }
};
template <> struct epi_init<Epi2> { static constexpr bool v = true; };
struct EpiPle {
    static constexpr bool PERM = true;
    const signed char* X2i; const float* SX; const float* SG; const unsigned char* PU; const float* SPU; const float* RSTD2; bf16* X3; float* SS3;
    __device__ __forceinline__ void operator()(const f32x4 (&acc)[2][2][4][2], const Unit& u, int wr, int wc, int fr, int fq) const {
        const int row0 = u.pm * BM + wr * 64 + fr, col0 = u.pn * 256 + wc * 32 + 8 * fq;
        const f32x4 sg00 = *(const f32x4*)(SG + col0), sg01 = *(const f32x4*)(SG + col0 + 4), sg10 = *(const f32x4*)(SG + col0 + HALF), sg11 = *(const f32x4*)(SG + col0 + HALF + 4);
#pragma unroll
        for (int ai = 0; ai < 2; ++ai)
#pragma unroll
            for (int m = 0; m < 4; ++m) { const int row = row0 + ai * HALF + m * 16; float ss = 0.f; const float sx = SX[row], r2n = RSTD2[row] * (-1.4426950409f) * sx, spu = SPU[(size_t)row * 16 + u.pn * 4 + wc], spo = -128.f * spu;
#pragma unroll
                for (int bj = 0; bj < 2; ++bj) { const size_t o = (size_t)row * D + col0 + bj * HALF;
                    f32x4 x0, x1, p0, p1; unpack8_i8(*(const u32x2*)(X2i + o), x0, x1); unpack8_u8(*(const u32x2*)(PU + o), p0, p1);
                    x0 = x0 * sx; x1 = x1 * sx; p0 = p0 * spu + spo; p1 = p1 * spu + spo;
                    const f32x4 l0 = __builtin_convertvector(__builtin_bit_cast(i32x4, acc[ai][bj][m][0]), f32x4) * ((bj ? sg10 : sg00) * r2n), l1 = __builtin_convertvector(__builtin_bit_cast(i32x4, acc[ai][bj][m][1]), f32x4) * ((bj ? sg11 : sg01) * r2n);
                    const f32x4 v0 = x0 + vrcp(1.f + vexp2(l0)) * p0, v1 = x1 + vrcp(1.f + vexp2(l1)) * p1;
                    ss += hsum4(v0 * v0 + v1 * v1);
                    *(u32x4*)(X3 + o) = pack8(v0, v1); }
                ss += __shfl_xor(ss, 16); ss += __shfl_xor(ss, 32);
                if (fq == 0) SS3[(size_t)row * 16 + u.pn * 4 + wc] = ss; }
    }
};

struct EpiPleFinal {
    static constexpr bool PERM = true;
    const signed char* X2i; const float* SX; const float* SG; const unsigned char* PU; const float* SPU; const float* RSTD2; const float* fn; float* out; float* XCH; unsigned* cnt; LAS float* xl; int wave; int xp;
    __device__ __forceinline__ void operator()(f32x4 (&acc)[2][2][4][2], const Unit& u, int wr, int wc, int fr, int fq) const {
        const int tid = wave * 64 + lane_id();
        const int rl0 = wr * 64 + fr, col0 = u.pn * 256 + wc * 32 + 8 * fq;
        const f32x4 sg00 = *(const f32x4*)(SG + col0), sg01 = *(const f32x4*)(SG + col0 + 4), sg10 = *(const f32x4*)(SG + col0 + HALF), sg11 = *(const f32x4*)(SG + col0 + HALF + 4);
#pragma unroll
        for (int ai = 0; ai < 2; ++ai)
#pragma unroll
            for (int m = 0; m < 4; ++m) { const int rl = rl0 + ai * HALF + m * 16, row = u.pm * BM + rl; float ss = 0.f; const float sx = SX[row], r2n = RSTD2[row] * (-1.4426950409f) * sx, spu = SPU[(size_t)row * 16 + u.pn * 4 + wc], spo = -128.f * spu;
#pragma unroll
                for (int bj = 0; bj < 2; ++bj) { const size_t o = (size_t)row * D + col0 + bj * HALF, ox = (size_t)row * xp + col0 + bj * HALF;
                    f32x4 x0, x1, p0, p1; unpack8_i8(*(const u32x2*)(X2i + ox), x0, x1); unpack8_u8(*(const u32x2*)(PU + o), p0, p1);
                    x0 = x0 * sx; x1 = x1 * sx; p0 = p0 * spu + spo; p1 = p1 * spu + spo;
                    const f32x4 l0 = __builtin_convertvector(__builtin_bit_cast(i32x4, acc[ai][bj][m][0]), f32x4) * ((bj ? sg10 : sg00) * r2n), l1 = __builtin_convertvector(__builtin_bit_cast(i32x4, acc[ai][bj][m][1]), f32x4) * ((bj ? sg11 : sg01) * r2n);
                    const f32x4 v0 = x0 + vrcp(1.f + vexp2(l0)) * p0, v1 = x1 + vrcp(1.f + vexp2(l1)) * p1;
                    ss += hsum4(v0 * v0 + v1 * v1);
                    acc[ai][bj][m][0] = v0; acc[ai][bj][m][1] = v1; }
                ss += __shfl_xor(ss, 16); ss += __shfl_xor(ss, 32);
                if (fq == 0) xl[rl * 4 + wc] = ss; }
        __syncthreads();
        if (tid < 256) { const f32x4 p = *(const LAS f32x4*)(xl + tid * 4);
            __hip_atomic_store(XCH + (size_t)(u.pm * BM + tid) * 4 + u.pn, (p[0] + p[1]) + (p[2] + p[3]), __ATOMIC_RELAXED, __HIP_MEMORY_SCOPE_AGENT); }
        asm volatile("s_waitcnt vmcnt(0)" ::: "memory");
        if (tid < 256 && (tid & 63) == 0) __hip_atomic_fetch_add(cnt + 64 * u.pm, 1u, __ATOMIC_RELAXED, __HIP_MEMORY_SCOPE_AGENT);
        if (tid < 64) { unsigned sp = 0;
            while ((unsigned)__builtin_amdgcn_readfirstlane(__hip_atomic_load(cnt + 64 * u.pm, __ATOMIC_RELAXED, __HIP_MEMORY_SCOPE_AGENT)) < 16u) { if (++sp > (1u << 22)) break; __builtin_amdgcn_s_sleep(1); } }
        __syncthreads();
        if (tid < 256) { const float* xs = XCH + (size_t)(u.pm * BM + tid) * 4; float tot = 0.f;
#pragma unroll
            for (int q = 0; q < 4; ++q) tot += __hip_atomic_load(xs + q, __ATOMIC_RELAXED, __HIP_MEMORY_SCOPE_AGENT);
            xl[1024 + tid] = rsqrtf(tot * (1.f / D) + EPS); }
        __syncthreads();
#pragma unroll
        for (int ai = 0; ai < 2; ++ai)
#pragma unroll
            for (int m = 0; m < 4; ++m) { const int rl = rl0 + ai * HALF + m * 16; const float rs = xl[1024 + rl]; float* op = out + (size_t)(u.pm * BM + rl) * D + col0;
#pragma unroll
                for (int bj = 0; bj < 2; ++bj) { const f32x4 f0 = *(const f32x4*)(fn + col0 + bj * HALF), f1 = *(const f32x4*)(fn + col0 + bj * HALF + 4);
                    *(f32x4*)(op + bj * HALF) = acc[ai][bj][m][0] * rs * f0; *(f32x4*)(op + bj * HALF + 4) = acc[ai][bj][m][1] * rs * f1; } }
    }
};

template <int MODE> struct MoeOrder {
    const LAS int* tab; const int* LIST; unsigned* dcnt; unsigned rowb;
    __device__ __forceinline__ bool next(int i, Unit& u) const {
        const int n = __builtin_amdgcn_readfirstlane(tab[0]); if (i >= n) return false;
        const LAS int* p = tab + 4 + 8 * i;
        u.pm = __builtin_amdgcn_readfirstlane(p[0]); u.pn = __builtin_amdgcn_readfirstlane(p[1]); u.e = __builtin_amdgcn_readfirstlane(p[2]);
        u.tile = __builtin_amdgcn_readfirstlane(p[3]); u.cnt = __builtin_amdgcn_readfirstlane(p[4]); return true;
    }
    __device__ __forceinline__ unsigned row_off(const Unit& u, int r) const { int idx = u.tile * 256 + r; idx = idx < u.cnt ? idx : u.cnt - 1; const int pair = LIST[u.e * 16384 + idx]; return (unsigned)(pair >> 1) * rowb; }
    __device__ __forceinline__ void a_ready(const Unit&) const {}
    struct Pre {}; __device__ __forceinline__ void pre(int, Pre&) const {}
    __device__ __forceinline__ void post(int, Pre&) const {}
    __device__ __forceinline__ bool half(const Unit& u) const { return MODE == 1 && (u.cnt - u.tile * 256) <= 128; }
    __device__ __forceinline__ void done(const Unit& u) const {
        if constexpr (MODE == 1) {
            asm volatile("s_waitcnt vmcnt(0)" ::: "memory");
            if (lane_id() == 0) __hip_atomic_fetch_add(dcnt + 64 * u.pm, 1u, __ATOMIC_RELAXED, __HIP_MEMORY_SCOPE_AGENT);
        }
    }
};
__device__ __forceinline__ void store16_sc1(void* p, u32x4 v) { asm volatile("global_store_dwordx4 %0, %1, off sc1\n\ts_nop 1" :: "v"(p), "v"(v) : "memory"); }
__device__ __forceinline__ void store8_sc1(void* p, u32x2 v) { asm volatile("global_store_dwordx2 %0, %1, off sc1\n\ts_nop 1" :: "v"(p), "v"(v) : "memory"); }
struct EpiMoe1 {
    static constexpr bool PERM = true;
    unsigned char* H; const float* LISTR; LAS unsigned char* lds;
    static constexpr int SCL = 131072;
    __device__ __forceinline__ void stage(const Unit& u, LAS unsigned char* l, int wid) const { if (wid < 4) { int idx = u.tile * 256 + wid * 64 + lane_id(); idx = idx < u.cnt ? idx : u.cnt - 1;
        __builtin_amdgcn_global_load_lds((const unsigned*)(LISTR + u.e * 16384 + idx), (LAS unsigned*)(l + SCL + wid * 256), 4, 0, 0); } }
    __device__ __forceinline__ void operator()(const f32x4 (&acc)[2][2][4][2], const Unit& u, int wr, int wc, int fr, int fq) const {
        const int col0 = (u.pn & 1) * 128 + wc * 32 + 8 * fq; const LAS float* rsl = (const LAS float*)(lds + SCL) + wr * 64 + fr;
        const int colb = (u.pn & 1) * 128 + wc * 32 + 16 * (fq >> 1);
#pragma unroll
        for (int ai = 0; ai < 2; ++ai)
#pragma unroll
            for (int mp = 0; mp < 2; ++mp) { u32x2 pc[2];
#pragma unroll
                for (int q = 0; q < 2; ++q) { const int m = 2 * mp + q; const float rs = rsl[ai * HALF + m * 16] * (1.f / 32.f); f32x4 v[2];
#pragma unroll
                    for (int n = 0; n < 2; ++n) { const f32x4 a1 = acc[ai][0][m][n] * rs, a3 = acc[ai][1][m][n] * rs; v[n] = a1 * a3 * vrcp(vsigm_den(a1)); }
                    pc[q] = pack8_fp8(v[0], v[1]); }
                const u32x2 sa = __builtin_amdgcn_permlane16_swap(pc[0].x, pc[1].x, false, false), sb = __builtin_amdgcn_permlane16_swap(pc[0].y, pc[1].y, false, false);
                const int r = ai * HALF + wr * 64 + (2 * mp + (fq & 1)) * 16 + fr;
                store16_sc1(H + (size_t)(u.pm * 256 + r) * 256 + colb, (u32x4){sa.x, sb.x, sa.y, sb.y}); }
    }
};
struct EpiMoe2 {
    static constexpr bool PERM = true;
    unsigned char* Y; const int* LIST; const float* LISTG; LAS unsigned char* lds;
    static constexpr int SCL = 131072;
    __device__ __forceinline__ void stage(const Unit& u, LAS unsigned char* l, int wid) const { int idx = u.tile * 256 + (wid & 3) * 64 + lane_id(); idx = idx < u.cnt ? idx : u.cnt - 1;
        const unsigned* src = wid < 4 ? (const unsigned*)(LIST + u.e * 16384 + idx) : (const unsigned*)(LISTG + u.e * 16384 + idx);
        __builtin_amdgcn_global_load_lds(src, (LAS unsigned*)(l + SCL + u.par * 2048 + wid * 256), 4, 0, 0); }
    __device__ __forceinline__ void operator()(const f32x4 (&acc)[2][2][4][2], const Unit& u, int wr, int wc, int fr, int fq) const {
        const int col0 = (u.pn & 3) * 256 + wc * 32 + 8 * fq; const LAS int* prl = (const LAS int*)(lds + SCL + u.par * 2048) + wr * 64 + fr; const LAS float* gtl = (const LAS float*)(lds + SCL + u.par * 2048 + 1024) + wr * 64 + fr;
        int pr[2][4]; float gt[2][4];
#pragma unroll
        for (int ai = 0; ai < 2; ++ai)
#pragma unroll
            for (int m = 0; m < 4; ++m) { pr[ai][m] = prl[ai * HALF + m * 16]; gt[ai][m] = gtl[ai * HALF + m * 16]; }
        const int colb = (u.pn & 3) * 256 + wc * 32 + 16 * (fq >> 1);
#pragma unroll
        for (int ai = 0; ai < 2; ++ai)
#pragma unroll
            for (int mp = 0; mp < 2; ++mp) { const int m0 = 2 * mp, m1 = m0 + 1, ms = m0 + (fq & 1);
                const int idx = u.tile * 256 + ai * HALF + wr * 64 + ms * 16 + fr; const int prs = (fq & 1) ? pr[ai][m1] : pr[ai][m0];
                unsigned char* yp = Y + (size_t)prs * D + colb;
#pragma unroll
                for (int bj = 0; bj < 2; ++bj) { const u32x2 p0 = pack8_fp8(acc[ai][bj][m0][0] * gt[ai][m0], acc[ai][bj][m0][1] * gt[ai][m0]), p1 = pack8_fp8(acc[ai][bj][m1][0] * gt[ai][m1], acc[ai][bj][m1][1] * gt[ai][m1]);
                    const u32x2 sa = __builtin_amdgcn_permlane16_swap(p0.x, p1.x, false, false), sb = __builtin_amdgcn_permlane16_swap(p0.y, p1.y, false, false);
                    if (idx < u.cnt) *(u32x4*)(yp + bj * HALF) = (u32x4){sa.x, sb.x, sa.y, sb.y}; } }
    }
};
template <> struct epi_stage<EpiMoe1> { static constexpr bool v = true; };
template <> struct epi_stage<EpiMoe2> { static constexpr bool v = true; };
}

constexpr int NWAVES = 8;
constexpr int RING_BYTES = 131072, LDSCTL_OFF = 139264, MISC_OFF = LDSCTL_OFF + 320, TAB_OFF = LDSCTL_OFF + 512, LDS_BYTES = 147456;
constexpr size_t WS_WLRU = 8 * MiB + 512 * 1024;
constexpr size_t WS_WSGU = 8 * MiB + 768 * 1024;
constexpr size_t WS_WR = 9 * MiB;
constexpr size_t WS_WUP = 9 * MiB + 512 * 1024;
constexpr size_t WS_WIN = 10 * MiB;
constexpr size_t WS_WOUT = 22 * MiB;
constexpr size_t WS_WG = 24 * MiB;
constexpr size_t WS_W13 = 26 * MiB;
constexpr size_t WS_W2 = 58 * MiB;
constexpr size_t WS_PB = 66 * MiB;
constexpr size_t WS_XNI = 42 * MiB;
constexpr size_t WS_RSTD1 = 25 * MiB;
constexpr size_t WS_RSTD0 = 25 * MiB + 128 * 1024;
constexpr size_t WS_GINV = 25 * MiB + 256 * 1024;
constexpr size_t WS_SPL8 = 25 * MiB + 512 * 1024;
constexpr size_t WS_SB = 21 * MiB + 512 * 1024;
constexpr size_t WS_XCH = 21 * MiB;
constexpr size_t WS_LISTG = 16 * MiB;
constexpr size_t WS_LISTR = 18 * MiB;
constexpr size_t WS_SPU = 20 * MiB;
constexpr size_t WS_MEGA_END = 234 * MiB;
constexpr int CW_BAR = 4096;
constexpr int CW_DONE1 = 131072;
constexpr int CW_X2 = 151552;
constexpr int CW_MIX = 147456;
constexpr int CW_PANEL = 65536;

typedef GAS unsigned gu32;
#define RLX_AGENT __ATOMIC_RELAXED, __HIP_MEMORY_SCOPE_AGENT
#define LDS_WAIT() asm volatile("s_waitcnt lgkmcnt(0)" ::: "memory")
#define VM_WAIT() asm volatile("s_waitcnt vmcnt(0)" ::: "memory")

#define XB_TMO      128
#define XB_XCNT(j)  (256  + 64 * (j))
#define XB_XSUB(j)  (1280 + 64 * (j))
#define XB_XGEN(j)  (2304 + 64 * (j))
#define XB_TOP      3328
#define XB_TOPGEN   3392
#define XCD_BAR_WORDS 3456
#define XB_SPIN_CAP (1u << 18)
__device__ __forceinline__ unsigned xb_ld(unsigned* p)              { return __hip_atomic_load(p, __ATOMIC_RELAXED, __HIP_MEMORY_SCOPE_AGENT); }
__device__ __forceinline__ unsigned xb_add(unsigned* p, unsigned v) { return __hip_atomic_fetch_add(p, v, __ATOMIC_RELAXED, __HIP_MEMORY_SCOPE_AGENT); }
__device__ __forceinline__ unsigned xb_xcc_id() { return (unsigned)__builtin_amdgcn_s_getreg((3 << 11) | 20) & 0xFu; }
#define XB_SPIN(cond, bar) do { unsigned _sp = 0; while (cond) { __builtin_amdgcn_s_sleep(1); \
    if ((++_sp & 255u) == 0u) { if (xb_ld(&(bar)[XB_TMO])) break; if (_sp > XB_SPIN_CAP) { atomicAdd(&(bar)[XB_TMO], 1u); break; } } } } while (0)
struct XcdBarrier { unsigned* bar; unsigned x; volatile LAS unsigned* st; int wave; };
__device__ __forceinline__ XcdBarrier xcd_barrier_post(unsigned* bar, volatile LAS unsigned* st, int wave) {
    XcdBarrier b; b.bar = bar; b.x = xb_xcc_id(); b.st = st; b.wave = wave;
    if (wave == 0 && pg8::lane_id() == 0) (void)xb_add(&bar[XB_XCNT(b.x)], 1u);
    return b;
}
__device__ __forceinline__ void xcd_barrier_complete(unsigned* bar, unsigned x, unsigned& nloc, unsigned& nx) {
    const unsigned G = gridDim.x * gridDim.y * gridDim.z;
    unsigned sum, cnt, mine, sp = 0u;
    for (;;) {
        sum = 0u; cnt = 0u; mine = 0u;
#pragma unroll
        for (unsigned j = 0; j < 16; ++j) { const unsigned c = xb_ld(&bar[XB_XCNT(j)]); sum += c; cnt += (c > 0u) ? 1u : 0u; mine = (j == x) ? c : mine; }
        if (sum == G) break;
        __builtin_amdgcn_s_sleep(1);
        if ((++sp & 255u) == 0u) { if (xb_ld(&bar[XB_TMO])) break; if (sp > XB_SPIN_CAP) { atomicAdd(&bar[XB_TMO], 1u); break; } }
    }
    nloc = mine > 0u ? mine : 1u; nx = cnt > 0u ? cnt : 1u;
}
__device__ __forceinline__ void xcd_barrier_begin() { asm volatile("s_waitcnt vmcnt(0)" ::: "memory"); __syncthreads(); }
__device__ __forceinline__ void xcd_barrier_protocol(const XcdBarrier& b) {
    if (b.wave == 0 && pg8::lane_id() == 0) {
        unsigned* bar = b.bar;
        __builtin_amdgcn_s_waitcnt(0);
        unsigned nloc = b.st[0], nx = b.st[1];
        if (nloc == 0u) { xcd_barrier_complete(bar, b.x, nloc, nx); b.st[0] = nloc; b.st[1] = nx; }
        const unsigned old = xb_add(&bar[XB_XSUB(b.x)], 1u);
        const unsigned gen = old / nloc;
        if (old + 1u == (gen + 1u) * nloc) {
            __builtin_amdgcn_fence(__ATOMIC_RELEASE, "agent");
            asm volatile("s_waitcnt vmcnt(0)" ::: "memory");
            const unsigned og = xb_add(&bar[XB_TOP], 1u);
            const unsigned tg = og / nx;
            asm volatile("buffer_inv sc1" ::: "memory");
            if (og + 1u == (tg + 1u) * nx) xb_add(&bar[XB_TOPGEN], 1u);
            else XB_SPIN(xb_ld(&bar[XB_TOPGEN]) == tg, bar);
            xb_add(&bar[XB_XGEN(b.x)], 1u);
            asm volatile("s_waitcnt vmcnt(0)" ::: "memory");
        } else {
            asm volatile("buffer_inv sc1" ::: "memory");
            XB_SPIN(xb_ld(&bar[XB_XGEN(b.x)]) == gen, bar);
            asm volatile("s_waitcnt vmcnt(0)" ::: "memory");
        }
    }
}
__device__ __forceinline__ void xcd_barrier(const XcdBarrier& b) { xcd_barrier_begin(); xcd_barrier_protocol(b); __syncthreads(); }

__device__ __forceinline__ unsigned pk2(float lo, float hi) { return (unsigned)f2bf(lo) | ((unsigned)f2bf(hi) << 16); }

struct TrItem { pg8::f32x4 v[8]; };
template <bool NT = false> __device__ __forceinline__ void tr_load(TrItem& t, const float* __restrict__ W, int ldn, int k0, int n_src0, int lane) {
    const int kb = lane >> 3, n4 = lane & 7;
    const float* src = W + (size_t)(k0 + 8 * kb) * ldn + n_src0 + 4 * n4;
#pragma unroll
    for (int q = 0; q < 8; ++q) t.v[q] = NT ? __builtin_nontemporal_load((const pg8::f32x4*)(src + (size_t)q * ldn)) : *(const pg8::f32x4*)(src + (size_t)q * ldn);
}
template <bool NT = false> __device__ __forceinline__ void tr_store(TrItem& t, int k0, bf16* __restrict__ WT, int Kd, int drow0, const float* __restrict__ gk, int lane) {
    const int kb = lane >> 3, n4 = lane & 7;
    if (gk) { const pg8::f32x4 g0 = *(const pg8::f32x4*)(gk + k0 + 8 * kb), g1 = *(const pg8::f32x4*)(gk + k0 + 8 * kb + 4);
#pragma unroll
        for (int q = 0; q < 8; ++q) t.v[q] = t.v[q] * (q < 4 ? g0[q & 3] : g1[q & 3]); }
#pragma unroll
    for (int i = 0; i < 4; ++i) { pg8::u32x4 o; o.x = pk2(t.v[0][i], t.v[1][i]); o.y = pk2(t.v[2][i], t.v[3][i]); o.z = pk2(t.v[4][i], t.v[5][i]); o.w = pk2(t.v[6][i], t.v[7][i]);
        if (NT) __builtin_nontemporal_store(o, (pg8::u32x4*)(WT + (size_t)(drow0 + 4 * n4 + i) * Kd + k0 + 8 * kb)); else *(pg8::u32x4*)(WT + (size_t)(drow0 + 4 * n4 + i) * Kd + k0 + 8 * kb) = o; }
}
__device__ __forceinline__ void tr_store_fp8(TrItem& t, int k0, unsigned char* __restrict__ W8, int Kd, int drow0, const float* __restrict__ gk, float wscale, int lane) {
    const int kb = lane >> 3, n4 = lane & 7;
    pg8::f32x4 g0 = {wscale, wscale, wscale, wscale}, g1 = g0;
    if (gk) { g0 = *(const pg8::f32x4*)(gk + k0 + 8 * kb) * wscale; g1 = *(const pg8::f32x4*)(gk + k0 + 8 * kb + 4) * wscale; }
#pragma unroll
    for (int i = 0; i < 4; ++i) { const pg8::f32x4 a = {t.v[0][i] * g0[0], t.v[1][i] * g0[1], t.v[2][i] * g0[2], t.v[3][i] * g0[3]}, b = {t.v[4][i] * g1[0], t.v[5][i] * g1[1], t.v[6][i] * g1[2], t.v[7][i] * g1[3]};
        *(pg8::u32x2*)(W8 + (size_t)(drow0 + 4 * n4 + i) * Kd + k0 + 8 * kb) = pg8::pack8_fp8(a, b); }
}
__device__ __forceinline__ void tr_store_fp8g(TrItem& t, int k0, unsigned char* __restrict__ W8, int Kd, int drow0, const pg8::f32x4 g0, const pg8::f32x4 g1, int lane) {
    const int kb = lane >> 3, n4 = lane & 7;
#pragma unroll
    for (int i = 0; i < 4; ++i) { const pg8::f32x4 a = {t.v[0][i] * g0[0], t.v[1][i] * g0[1], t.v[2][i] * g0[2], t.v[3][i] * g0[3]}, b = {t.v[4][i] * g1[0], t.v[5][i] * g1[1], t.v[6][i] * g1[2], t.v[7][i] * g1[3]};
        *(pg8::u32x2*)(W8 + (size_t)(drow0 + 4 * n4 + i) * Kd + k0 + 8 * kb) = pg8::pack8_fp8(a, b); }
}
__device__ __forceinline__ void p0_transpose_item(const float* __restrict__ W, int ldn, int k0, int n_src0, bf16* __restrict__ WT, int Kd, int drow0, const float* __restrict__ gk, LAS float*, int lane) {
    TrItem t; tr_load<true>(t, W, ldn, k0, n_src0, lane); tr_store(t, k0, WT, Kd, drow0, gk, lane);
}
__device__ __forceinline__ int win_dest_row(int n) {
    const int grp = n >> 10, j = n & 1023;
    switch (grp) {
        case 0: return j;
        case 1: return 1024 + (j >> 7) * 256 + (j & 127);
        case 2: return 3072 + (j >> 7) * 256 + (j & 127);
        case 3: return 5120 + j;
        case 4: return 1024 + (j >> 7) * 256 + 128 + (j & 127);
        default: return 3072 + (j >> 7) * 256 + 128 + (j & 127);
    }
}


struct DefW { const float* const* in; unsigned char* ws; };
constexpr int DF_OUT = 8 * 32, DF_E13 = 32 * 2 * 64, DF_E2 = 32 * 64, DF_G = 8 * 32, DF_UP = 2 * 32, DF_N = DF_OUT + DF_E13 + DF_E2 + DF_G + DF_UP;
struct DefDesc { const float* W; const float* gk; bf16* WT; int ldn, k0, n0, Kd, drow; };
__device__ __forceinline__ DefDesc deferred_desc(const DefW& w, int it) {
    int r = it; DefDesc d;
    if (r < DF_OUT) { const int kb = r / 16, np = r % 16; d = DefDesc{w.in[15], nullptr, (bf16*)(w.ws + WS_WOUT), 1024, kb * 64, np * 64, 1024, np * 64}; return d; } r -= DF_OUT;
    if (r < DF_E13) { const int e = r / 128, which = (r / 64) & 1, q = r % 64, kb = q / 4, np = q % 4;
        const int f0 = np * 64, drow = e * 512 + (f0 >> 7) * 256 + which * 128 + (f0 & 127);
        d = DefDesc{w.in[which ? 22 : 21] + (size_t)e * 1024 * 256, w.in[16], (bf16*)(w.ws + WS_W13), 256, kb * 64, f0, 1024, drow}; return d; } r -= DF_E13;
    if (r < DF_E2) { const int e = r / 64, q = r % 64, kb = q / 16, np = q % 16;
        d = DefDesc{w.in[23] + (size_t)e * 256 * 1024, nullptr, (bf16*)(w.ws + WS_W2), 1024, kb * 64, np * 64, 256, e * 1024 + np * 64}; return d; } r -= DF_E2;
    if (r < DF_G) { const int kb = r / 16, np = r % 16; d = DefDesc{w.in[25], w.in[24], (bf16*)(w.ws + WS_WG), 1024, kb * 64, np * 64, 1024, np * 64}; return d; } r -= DF_G;
    { const int kb = r / 16, np = r % 16; d = DefDesc{w.in[26], nullptr, (bf16*)(w.ws + WS_WUP), 1024, kb * 64, np * 64, 256, np * 64}; return d; }
}
struct Gemm1Order : pg8::StaticOrder {
    DefW w; int wave; int gi;
    struct Pre { TrItem t; };
    LAS unsigned char* lds; static constexpr int GAIN_OFF = 131072 + 2048;
    static constexpr int G0 = DF_OUT + DF_E13 + DF_E2, G1 = G0 + DF_G;
    static constexpr int GR_IT = 2 * (DF_N - DF_G), GR_N = GR_IT + 2048;
    static __device__ __forceinline__ bool is_e13(int it) { return it >= DF_OUT && it < DF_OUT + DF_E13; }
    static __device__ __forceinline__ bool is_e2(int it) { return it >= DF_OUT + DF_E13 && it < DF_OUT + DF_E13 + DF_E2; }
    static __device__ __forceinline__ int gr_item(int g) { const int j = g >> 1; return j < G0 ? j : j + DF_G; }
    __device__ __forceinline__ void gr_load(Pre& P, int g, int lane) const {
        if (g < GR_IT) { const DefDesc d = deferred_desc(w, gr_item(g));
            tr_load<true>(P.t, d.W, d.ldn, d.k0, d.n0 + 32 * (g & 1), lane);
        } else { const pg8::f32x4* psrc = (const pg8::f32x4*)w.in[1] + (size_t)(g - GR_IT) * 512 + lane;
#pragma unroll
            for (int q = 0; q < 8; ++q) P.t.v[q] = __builtin_nontemporal_load(psrc + q * 64); }
    }
    static __device__ __forceinline__ void st_fp8(unsigned char* base, unsigned off, unsigned pitch, const TrItem& t, const pg8::f32x4 g0, const pg8::f32x4 g1) {
#pragma unroll
        for (int i = 0; i < 4; ++i) { const pg8::f32x4 a = {t.v[0][i] * g0[0], t.v[1][i] * g0[1], t.v[2][i] * g0[2], t.v[3][i] * g0[3]}, b = {t.v[4][i] * g1[0], t.v[5][i] * g1[1], t.v[6][i] * g1[2], t.v[7][i] * g1[3]};
            *(pg8::u32x2*)(base + (off + (unsigned)i * pitch)) = pg8::pack8_fp8(a, b); }
    }
    static __device__ __forceinline__ void st_bf16(unsigned char* base, unsigned off, unsigned pitch, const TrItem& t) {
#pragma unroll
        for (int i = 0; i < 4; ++i) { pg8::u32x4 o; o.x = pk2(t.v[0][i], t.v[1][i]); o.y = pk2(t.v[2][i], t.v[3][i]); o.z = pk2(t.v[4][i], t.v[5][i]); o.w = pk2(t.v[6][i], t.v[7][i]);
            __builtin_nontemporal_store(o, (pg8::u32x4*)(base + (off + (unsigned)i * pitch))); }
    }
    __device__ __forceinline__ void gr_store(Pre& P, int g, int lane) const {
        int gv = g; asm volatile("" : "+v"(gv));
        if (g >= GR_IT) { unsigned long long* pdst = (unsigned long long*)(w.ws + WS_PB) + (size_t)(g - GR_IT) * 512 + lane;
#pragma unroll
            for (int q = 0; q < 8; ++q) { const pg8::f32x4 v = P.t.v[q]; __builtin_nontemporal_store((unsigned long long)pk2(v.x, v.y) | ((unsigned long long)pk2(v.z, v.w) << 32), pdst + q * 64); }
            return; }
        const int it = gr_item(g);
        const unsigned kbl = (unsigned)lane >> 3, n4 = (unsigned)lane & 7u, hv = (unsigned)gv & 1u, jv = (unsigned)gv >> 1;
        if (is_e13(it)) {
            const unsigned r = jv - (unsigned)DF_OUT, e = r >> 7, which = (r >> 6) & 1u, q = r & 63u, kb = q >> 2, f0 = (q & 3u) * 64u, drow = e * 512u + (f0 >> 7) * 256u + which * 128u + (f0 & 127u) + 32u * hv;
            const unsigned off = (unsigned)WS_W13 + (drow + 4u * n4) * 1024u + kb * 64u + 8u * kbl;
            const LAS float* gl = (const LAS float*)(lds + GAIN_OFF) + kb * 64u + 8u * kbl;
            st_fp8(w.ws, off, 1024u, P.t, *(const LAS pg8::f32x4*)gl * 32.f, *(const LAS pg8::f32x4*)(gl + 4) * 32.f);
        } else if (is_e2(it)) {
            const unsigned r = jv - (unsigned)(DF_OUT + DF_E13), e = r >> 6, q = r & 63u, kb = q >> 4, drow = e * 1024u + (q & 15u) * 64u + 32u * hv;
            const unsigned off = (unsigned)WS_W2 + (drow + 4u * n4) * 256u + kb * 64u + 8u * kbl;
            const pg8::f32x4 gg = {16.f, 16.f, 16.f, 16.f};
            st_fp8(w.ws, off, 256u, P.t, gg, gg);
        } else {
            const bool up = it >= DF_OUT;
            const unsigned r = up ? jv - (unsigned)(DF_OUT + DF_E13 + DF_E2) : jv, kb = r >> 4, drow = (r & 15u) * 64u + 32u * hv, Kd = up ? 256u : 1024u;
            const unsigned off = (unsigned)(up ? WS_WUP : WS_WOUT) + ((drow + 4u * n4) * Kd + kb * 64u + 8u * kbl) * 2u;
            st_bf16(w.ws, off, Kd * 2u, P.t);
        }
    }
    __device__ __forceinline__ void pre(int ui, Pre& P) const { const int g = c * 8 + wave + (G == 256 ? 2048 * ui : 0); const DefDesc d = deferred_desc(w, gr_item(g));
        tr_load<true>(P.t, d.W, d.ldn, d.k0, d.n0 + 32 * (g & 1), pg8::lane_id()); }
    __device__ __forceinline__ void post(int ui, Pre& P) const {
        const int lane = pg8::lane_id(), slot = c * 8 + wave, nslot = G * 8;
        if (G == 256) gr_store(P, slot + 2048 * ui, lane);
        if (ui != gi) return;
#pragma unroll 1
        for (int g = slot + (G == 256 ? 6 * 2048 : 0); g < GR_N; g += nslot) { Pre Q; gr_load(Q, g, lane); gr_store(Q, g, lane); }
    }
};

constexpr int MY_VT = 0, MY_XA = 32768, MY_SP = 67584, MY_WS = 102400, MY_ST = 135168, MY_RS = 272;
__device__ __forceinline__ float bflo(unsigned u) { return __uint_as_float(u << 16); }
__device__ __forceinline__ float bfhi(unsigned u) { return __uint_as_float(u & 0xffff0000u); }
template <int N> __device__ __forceinline__ float row_shr(float ident, float v) {
    return __builtin_bit_cast(float, __builtin_amdgcn_update_dpp(__builtin_bit_cast(int, ident), __builtin_bit_cast(int, v), 0x110 + N, 0xf, 0xf, false)); }
#define MX_DPP_STEP(N) \
    "v_fmac_f32_dpp %4, %4, %0 row_shr:" #N " row_mask:0xf bank_mask:0xf\n\tv_fmac_f32_dpp %5, %5, %1 row_shr:" #N " row_mask:0xf bank_mask:0xf\n\t" \
    "v_fmac_f32_dpp %6, %6, %2 row_shr:" #N " row_mask:0xf bank_mask:0xf\n\tv_fmac_f32_dpp %7, %7, %3 row_shr:" #N " row_mask:0xf bank_mask:0xf\n\t" \
    "v_mul_f32_dpp %0, %0, %0 row_shr:" #N " row_mask:0xf bank_mask:0xf\n\tv_mul_f32_dpp %1, %1, %1 row_shr:" #N " row_mask:0xf bank_mask:0xf\n\t" \
    "v_mul_f32_dpp %2, %2, %2 row_shr:" #N " row_mask:0xf bank_mask:0xf\n\tv_mul_f32_dpp %3, %3, %3 row_shr:" #N " row_mask:0xf bank_mask:0xf\n\t"
__device__ __forceinline__ void scan16x4(pg8::f32x4& A, pg8::f32x4& U) { using pg8::f32x4;
    float a0 = A[0], a1 = A[1], a2 = A[2], a3 = A[3], u0 = U[0], u1 = U[1], u2 = U[2], u3 = U[3];
    asm("s_nop 1\n\t" MX_DPP_STEP(1) MX_DPP_STEP(2) MX_DPP_STEP(4) MX_DPP_STEP(8) "s_nop 0"
        : "+v"(a0), "+v"(a1), "+v"(a2), "+v"(a3), "+v"(u0), "+v"(u1), "+v"(u2), "+v"(u3));
    A = (f32x4){a0, a1, a2, a3}; U = (f32x4){u0, u1, u2, u3};
}
__device__ __forceinline__ void mixer_phase(LAS unsigned char* lds, const int vcu, const int G, const int tid, const int lane, const int wave,
                                            const bf16* __restrict__ Zl, const bf16* GA, const bf16* __restrict__ UB, const bf16* __restrict__ V, const float* __restrict__ VPART,
                                            unsigned long long* AGG, bf16* MG  , unsigned* mixc, const bf16* __restrict__ WLRU, const bf16* __restrict__ WSGU, const float* __restrict__ SPL8, const float* const* in) {
    using namespace pg8;
    constexpr int RS = MY_RS;
    constexpr float L2E = 1.4426950409f;
    const int fr = lane & 15, grp = lane >> 4, cp = tid & 63, tg = wave;
    const int pr = lane & 3, sch = lane >> 2, srow = 8 * sch + 2 * pr;
    LAS float* ST = (LAS float*)(lds + MY_ST);
    int gprev = -1;
    f32x2 cw0, cw1, cw2, cw3, ccb;
    u32x4 zqa, zqb, zqc, zqd, zqe, vv00, vv01, vv10, vv11;
#define MX_ZR(k) ((k) < 4 ? zqa[(k) & 3] : (k) < 8 ? zqb[(k) & 3] : (k) < 12 ? zqc[(k) & 3] : (k) < 16 ? zqd[(k) & 3] : zqe[(k) & 3])
#define MX_SETZR(k, v) do { if ((k) < 4) zqa[(k) & 3] = (v); else if ((k) < 8) zqb[(k) & 3] = (v); else if ((k) < 12) zqc[(k) & 3] = (v); else if ((k) < 16) zqd[(k) & 3] = (v); else zqe[(k) & 3] = (v); } while (0)
#define MX_PREFETCH(uu) do { const int ck_ = (uu) >> 3, g_ = (uu) & 7, t0_ = ck_ * 128, c0_ = g_ * 128; const bool first_ = (ck_ & 15) == 0; \
        const unsigned zo_ = ((unsigned)(t0_ + 16 * tg) * D + c0_ + 2 * cp) * 2u; \
        _Pragma("unroll") for (int k = 0; k < 19; ++k) { unsigned zv_ = 0u; if (!(k < 3 && first_ && tg == 0)) zv_ = *(const unsigned*)((const char*)Zl + (zo_ + (unsigned)((k - 3) * D * 2))); MX_SETZR(k, zv_); } \
        { const unsigned vo_ = ((unsigned)(t0_ + srow) * D + c0_ + 16 * wave) * 2u; vv00 = *(const u32x4*)((const char*)V + vo_); vv01 = *(const u32x4*)((const char*)V + (vo_ + D * 2)); vv10 = *(const u32x4*)((const char*)V + (vo_ + 16)); vv11 = *(const u32x4*)((const char*)V + (vo_ + D * 2 + 16)); } \
        } while (0)
    zqe = (u32x4){0u, 0u, 0u, 0u};
#define MX_STATS_LOAD(uu, q0, q1) do { const unsigned vpo_ = ((unsigned)(((uu) >> 3) * 128 + (tid >> 2)) * 32 + (tid & 3) * 8) * 4u; q0 = *(const f32x4*)((const char*)VPART + vpo_); q1 = *(const f32x4*)((const char*)VPART + (vpo_ + 16)); } while (0)
#define MX_STATS_WRITE(q0, q1) do { float s1 = (q0[0] + q0[2]) + (q1[0] + q1[2]), s2 = (q0[1] + q0[3]) + (q1[1] + q1[3]); \
        s1 += __shfl_xor(s1, 1); s1 += __shfl_xor(s1, 2); s2 += __shfl_xor(s2, 1); s2 += __shfl_xor(s2, 2); \
        if ((tid & 3) == 0) { const float mean = s1 * (1.f / 1024.f); float var = s2 * (1.f / 1024.f) - mean * mean; var = var < 0.f ? 0.f : var; ST[tid >> 2] = mean; ST[128 + (tid >> 2)] = rsqrtf(var + EPS); } } while (0)
    int u = vcu;
    if (u < 1024) { MX_PREFETCH(u); f32x4 q0, q1; MX_STATS_LOAD(u, q0, q1); MX_STATS_WRITE(q0, q1); }
    for (; u < 1024; u += G) {
        const int ck = u >> 3, g = u & 7, t0 = ck * 128, c0 = g * 128, j = ck & 15;
        const int cch = c0 + 16 * wave + 4 * grp;
        if (g != gprev) {
            gprev = g;
#pragma unroll
            for (int it = 0; it < 4; ++it) { const int idx = it * 512 + tid, row = idx >> 4, ch = idx & 15;
                *(LAS u32x4*)(lds + MY_WS + row * 256 + ((ch ^ (row & 15)) << 4)) = *(const u32x4*)(WSGU + ((size_t)(g * 128 + row)) * 128 + ch * 8); }
            const int cc = c0 + 2 * cp;
            cw0 = *(const f32x2*)(in[4] + cc); cw1 = *(const f32x2*)(in[4] + 1024 + cc); cw2 = *(const f32x2*)(in[4] + 2048 + cc); cw3 = *(const f32x2*)(in[4] + 3072 + cc); ccb = *(const f32x2*)(in[5] + cc);
        }
        const int hblk = 2 * g + (wave >> 2), jj0 = (16 * wave) & 63;
        const bf16x8 bw00 = *(const bf16x8*)(WLRU + ((size_t)((0 * 16 + hblk) * 64 + jj0 + fr)) * 64 + 0 * 32 + 8 * grp), bw01 = *(const bf16x8*)(WLRU + ((size_t)((0 * 16 + hblk) * 64 + jj0 + fr)) * 64 + 1 * 32 + 8 * grp);
        const bf16x8 bw10 = *(const bf16x8*)(WLRU + ((size_t)((1 * 16 + hblk) * 64 + jj0 + fr)) * 64 + 0 * 32 + 8 * grp), bw11 = *(const bf16x8*)(WLRU + ((size_t)((1 * 16 + hblk) * 64 + jj0 + fr)) * 64 + 1 * 32 + 8 * grp);
        const f32x4 nba = *(const f32x4*)(in[7] + cch) * (-L2E), nbi = *(const f32x4*)(in[9] + cch) * (-L2E), ksp = *(const f32x4*)(SPL8 + cch);
        {
#pragma unroll
            for (int i = 0; i < 16; ++i) {
                const unsigned z0 = MX_ZR(i), z1 = MX_ZR(i + 1), z2 = MX_ZR(i + 2), z3 = MX_ZR(i + 3);
                const f32x2 xv = ccb + cw0 * (f32x2){bflo(z0), bfhi(z0)} + cw1 * (f32x2){bflo(z1), bfhi(z1)} + cw2 * (f32x2){bflo(z2), bfhi(z2)} + cw3 * (f32x2){bflo(z3), bfhi(z3)};
                *(LAS unsigned*)(lds + MY_XA + (16 * tg + i) * RS + 4 * cp) = cvt_pk_bf16(xv.x, xv.y);
            }
        }
        __syncthreads();
        {
            const float mua = ST[srow], rsa = ST[128 + srow], mub = ST[srow + 1], rsb = ST[128 + srow + 1];
#pragma unroll
            for (int ci = 0; ci < 2; ++ci) { const int chunk = 2 * wave + ci, cbase = c0 + 8 * chunk;
                f32x4 a0, a1, b0, b1; unpack8(ci ? vv10 : vv00, a0, a1); unpack8(ci ? vv11 : vv01, b0, b1);
                const f32x4 g0 = *(const f32x4*)(in[11] + cbase), g1 = *(const f32x4*)(in[11] + cbase + 4), l0 = *(const f32x4*)(in[12] + cbase), l1 = *(const f32x4*)(in[12] + cbase + 4);
                a0 = (a0 - mua) * rsa * g0 + l0; a1 = (a1 - mua) * rsa * g1 + l1; b0 = (b0 - mub) * rsb * g0 + l0; b1 = (b1 - mub) * rsb * g1 + l1;
#pragma unroll
                for (int i = 0; i < 8; ++i) { const int cl = 8 * chunk + i; const float va = i < 4 ? a0[i & 3] : a1[i & 3], vb = i < 4 ? b0[i & 3] : b1[i & 3];
                    *(LAS unsigned*)(lds + MY_VT + cl * 256 + ((sch ^ (cl & 15)) << 4) + 4 * pr) = cvt_pk_bf16(va, vb); }
            }
        }
        f32x4 R[8], I[8];
#pragma unroll
        for (int mt = 0; mt < 8; ++mt) { R[mt] = (f32x4){0.f, 0.f, 0.f, 0.f}; I[mt] = (f32x4){0.f, 0.f, 0.f, 0.f};
#pragma unroll
            for (int ks = 0; ks < 2; ++ks) { const bf16x8 a = *(const LAS bf16x8*)(lds + MY_XA + (mt * 16 + fr) * RS + ((wave >> 2) * 64 + ks * 32 + 8 * grp) * 2);
                R[mt] = __builtin_amdgcn_mfma_f32_16x16x32_bf16(ks ? bw01 : bw00, a, R[mt], 0, 0, 0); I[mt] = __builtin_amdgcn_mfma_f32_16x16x32_bf16(ks ? bw11 : bw10, a, I[mt], 0, 0, 0); } }
#pragma unroll
        for (int mt = 0; mt < 8; ++mt) {
            const u32x2 xw = *(const LAS u32x2*)(lds + MY_XA + (mt * 16 + fr) * RS + (16 * wave + 4 * grp) * 2);
            const f32x4 xa4 = {bflo(xw.x), bfhi(xw.x), bflo(xw.y), bfhi(xw.y)};
            const f32x4 t1 = R[mt] * (-L2E) + nba, t2 = I[mt] * (-L2E) + nbi;
            f32x4 d1, d2, inv;
#pragma unroll
            for (int r = 0; r < 4; ++r) { d1[r] = 1.f + __builtin_amdgcn_exp2f(t1[r]); d2[r] = 1.f + __builtin_amdgcn_exp2f(t2[r]); }
            const f32x4 dd = d1 * d2;
#pragma unroll
            for (int r = 0; r < 4; ++r) inv[r] = __builtin_amdgcn_rcpf(dd[r]);
            const f32x4 rr = d2 * inv, ii = d1 * inv, la = rr * ksp;
            const f32x4 w = la * (1.f + la * (0.5f + la * (0.16666667f + la * (0.041666667f + la * 0.0083333333f))));
            f32x4 av = 1.f + w;
            const f32x4 om = -w * (2.f + w);
            f32x4 uv;
#pragma unroll
            for (int r = 0; r < 4; ++r) uv[r] = __builtin_amdgcn_sqrtf(om[r]);
            uv = uv * ii * xa4;
            scan16x4(av, uv); R[mt] = av; I[mt] = uv;
        }
        {
            f32x4 Pc = {1.f, 1.f, 1.f, 1.f}, Hc = {0.f, 0.f, 0.f, 0.f};
#pragma unroll
            for (int mt = 0; mt < 8; ++mt) { Hc = Hc * R[mt] + I[mt]; Pc = Pc * R[mt]; }
            if (fr == 15) {
#pragma unroll
                for (int r = 0; r < 4; ++r) __hip_atomic_store(AGG + (size_t)ck * 1024 + cch + r, ((unsigned long long)__float_as_uint(Hc[r]) << 32) | (unsigned long long)__float_as_uint(Pc[r]), __ATOMIC_RELAXED, __HIP_MEMORY_SCOPE_AGENT);
            }
        }
        __syncthreads();
        if (u + G < 1024) MX_PREFETCH(u + G);
        unsigned long long ag0 = 0x000000003f800000ull, ag1 = 0x000000003f800000ull, ag2 = 0x000000003f800000ull, ag3 = 0x000000003f800000ull;
        if (j > 0 && fr < j) { const unsigned long long* ap = AGG + (size_t)(ck - j + fr) * 1024 + cch;
            ag0 = __hip_atomic_load(ap, __ATOMIC_RELAXED, __HIP_MEMORY_SCOPE_AGENT); ag1 = __hip_atomic_load(ap + 1, __ATOMIC_RELAXED, __HIP_MEMORY_SCOPE_AGENT);
            ag2 = __hip_atomic_load(ap + 2, __ATOMIC_RELAXED, __HIP_MEMORY_SCOPE_AGENT); ag3 = __hip_atomic_load(ap + 3, __ATOMIC_RELAXED, __HIP_MEMORY_SCOPE_AGENT); }
        {
            bf16x8 q[4];
#pragma unroll
            for (int ks = 0; ks < 4; ++ks) q[ks] = *(const LAS bf16x8*)(lds + MY_VT + (16 * wave + fr) * 256 + (((ks * 4 + grp) ^ fr) << 4));
#pragma unroll
            for (int mt = 0; mt < 8; ++mt) { f32x4 Sx = {0.f, 0.f, 0.f, 0.f};
#pragma unroll
                for (int ks = 0; ks <= mt / 2; ++ks) { const bf16x8 p = *(const LAS bf16x8*)(lds + MY_WS + (mt * 16 + fr) * 256 + (((ks * 4 + grp) ^ fr) << 4));
                    Sx = __builtin_amdgcn_mfma_f32_16x16x32_bf16(q[ks], p, Sx, 0, 0, 0); }
                *(LAS u32x2*)(lds + MY_SP + (mt * 16 + fr) * RS + (16 * wave + 4 * grp) * 2) = (u32x2){cvt_pk_bf16_cv(Sx[0], Sx[1]), cvt_pk_bf16_cv(Sx[2], Sx[3])}; }
        }
        {
            f32x4 hc0 = {0.f, 0.f, 0.f, 0.f};
            if (j > 0) {
                f32x4 lp, lh; unsigned spin = 0;
                for (;;) {
                    lp[0] = __uint_as_float((unsigned)ag0); lh[0] = __uint_as_float((unsigned)(ag0 >> 32)); lp[1] = __uint_as_float((unsigned)ag1); lh[1] = __uint_as_float((unsigned)(ag1 >> 32));
                    lp[2] = __uint_as_float((unsigned)ag2); lh[2] = __uint_as_float((unsigned)(ag2 >> 32)); lp[3] = __uint_as_float((unsigned)ag3); lh[3] = __uint_as_float((unsigned)(ag3 >> 32));
                    const bool ok = (lp[0] != 0.f) && (lp[1] != 0.f) && (lp[2] != 0.f) && (lp[3] != 0.f);
                    if (__all(ok)) break;
                    if (++spin > (1u << 22)) break;
                    __builtin_amdgcn_s_sleep(1);
                    if (fr < j) { const unsigned long long* ap = AGG + (size_t)(ck - j + fr) * 1024 + cch;
                        ag0 = __hip_atomic_load(ap, __ATOMIC_RELAXED, __HIP_MEMORY_SCOPE_AGENT); ag1 = __hip_atomic_load(ap + 1, __ATOMIC_RELAXED, __HIP_MEMORY_SCOPE_AGENT);
                        ag2 = __hip_atomic_load(ap + 2, __ATOMIC_RELAXED, __HIP_MEMORY_SCOPE_AGENT); ag3 = __hip_atomic_load(ap + 3, __ATOMIC_RELAXED, __HIP_MEMORY_SCOPE_AGENT); } }
                scan16x4(lp, lh);
#pragma unroll
                for (int r = 0; r < 4; ++r) hc0[r] = __shfl(lh[r], (lane & 48) | 15);
            }
            f32x4 s = hc0;
#pragma unroll
            for (int mt = 0; mt < 8; ++mt) { f32x4 hb;
#pragma unroll
                for (int r = 0; r < 4; ++r) hb[r] = __shfl(s[r], (lane & 48) | 15);
                s = R[mt] * s + I[mt];
                const f32x4 hv = I[mt] + R[mt] * hb;
                *(LAS u32x2*)(lds + MY_XA + (mt * 16 + fr) * RS + (16 * wave + 4 * grp) * 2) = (u32x2){cvt_pk_bf16(hv[0], hv[1]), cvt_pk_bf16(hv[2], hv[3])}; }
        }
        u32x4 ga[4], ub[4]; float bsr[4]; f32x4 nq0 = {0.f, 0.f, 0.f, 0.f}, nq1 = {0.f, 0.f, 0.f, 0.f};
        if (u + G < 1024) MX_STATS_LOAD(u + G, nq0, nq1);
#pragma unroll
        for (int it = 0; it < 4; ++it) { const int idx = it * 512 + tid, row = idx >> 4, ch = idx & 15; const unsigned o = ((unsigned)(t0 + row) * D + c0 + ch * 8) * 2u; ga[it] = *(const u32x4*)((const char*)GA + o); ub[it] = *(const u32x4*)((const char*)UB + o); bsr[it] = in[14][g * 128 + row]; }
        __syncthreads();
#pragma unroll
        for (int it = 0; it < 4; ++it) { const int idx = it * 512 + tid, row = idx >> 4, ch = idx & 15;
            f32x4 g0, g1, u0, u1, h0, h1, s0, s1; unpack8(ga[it], g0, g1); unpack8(ub[it], u0, u1);
            unpack8(*(const LAS u32x4*)(lds + MY_XA + row * RS + ch * 16), h0, h1); unpack8(*(const LAS u32x4*)(lds + MY_SP + row * RS + ch * 16), s0, s1);
            store16_sc1((char*)MG + ((unsigned)(t0 + row) * D + c0 + ch * 8) * 2u, pack8(g0 * h0 + u0 * (s0 + bsr[it]), g1 * h1 + u1 * (s1 + bsr[it]))); }
        if (u + G < 1024) MX_STATS_WRITE(nq0, nq1);
        asm volatile("s_waitcnt vmcnt(0)" ::: "memory");
        if (lane == 0) __hip_atomic_fetch_add(mixc + 64 * (ck >> 1), 1u, __ATOMIC_RELAXED, __HIP_MEMORY_SCOPE_AGENT);
        __syncthreads();
    }
#undef MX_PREFETCH
#undef MX_STATS_LOAD
#undef MX_STATS_WRITE
#undef MX_ZR
#undef MX_SETZR
}

__device__ __forceinline__ void build_moe_units(LAS int* tab1, LAS int* tab2, LAS int* tab3, const int* CNT, int vcu, int G, int wave, LAS int* flags) {
    const int tid = wave * 64 + pg8::lane_id();
    int NT = 0, my_e = 0, my_tile = 0, my_cnt = 0, my_rt = 0;
    for (int e = 0; e < 32; ++e) { const int cnt = CNT[e]; const int ntl = (cnt + 255) >> 8;
        if (tid >= NT && tid < NT + ntl) { my_e = e; my_tile = tid - NT; my_cnt = cnt; my_rt = tid; }
        NT += ntl; }
    const bool have = tid < NT;
    const bool heavy = have && (my_cnt - my_tile * 256) > 128;
    flags[tid] = heavy ? 1 : 0;
    __syncthreads();
    int hb = 0, NH = 0;
    for (int i = 0; i < NT; ++i) { const int f = flags[i]; NH += f; hb += (i < tid) ? f : 0; }
    const int slot = heavy ? hb : NH + (tid - hb);
    const int U1 = 2 * NT, U2 = 4 * NT; int nlate = (U1 > G && U1 < 2 * G) ? U1 - G : 0; if (G - nlate < 64) nlate = 0;
    const int Ge = G - nlate, c2 = vcu - nlate, ssplit = nlate ? G / 2 : NT, Lsplit = 4 * ssplit;
    const int n1 = vcu < U1 ? (U1 - 1 - vcu) / G + 1 : 0;
    const int tot2 = (c2 >= 0 && c2 < U2) ? (U2 - 1 - c2) / Ge + 1 : 0;
    int n2 = (c2 >= 0 && c2 < Lsplit) ? (Lsplit - 1 - c2) / Ge + 1 : 0; n2 = n2 < tot2 ? n2 : tot2;
    const int n3 = tot2 - n2;
    if (tid == 0) { tab1[0] = n1 < 12 ? n1 : 12; tab2[0] = n2 < 12 ? n2 : 12; tab3[0] = n3 < 12 ? n3 : 12; }
    if (have) {
#pragma unroll
        for (int q = 0; q < 2; ++q) { const int L = 2 * slot + q; if (L % G == vcu && L / G < 12) { LAS int* p = tab1 + 4 + 8 * (L / G); p[0] = my_rt; p[1] = my_e * 2 + q; p[2] = my_e; p[3] = my_tile; p[4] = my_cnt; } }
        if (c2 >= 0) {
#pragma unroll
            for (int q = 0; q < 4; ++q) { const int L2 = 4 * slot + q; if (L2 % Ge == c2) { const int k = L2 / Ge; const bool early = slot < ssplit; const int idx = early ? k : k - n2;
                if (idx >= 0 && idx < 12) { LAS int* p = (early ? tab2 : tab3) + 4 + 8 * idx; p[0] = my_rt; p[1] = my_e * 4 + q; p[2] = my_e; p[3] = my_tile; p[4] = my_cnt; } } }
        }
    }
    __syncthreads();
}
__device__ __forceinline__ void moe_wait_tiles(const LAS int* tab, unsigned* dcnt, int wave) {
    if (wave == 0) {
        const int n = __builtin_amdgcn_readfirstlane(tab[0]);
        asm volatile("buffer_inv sc1" ::: "memory");
        for (int i = 0; i < n; ++i) { const int rt = __builtin_amdgcn_readfirstlane(tab[4 + 8 * i]); unsigned sp = 0;
            while ((unsigned)__builtin_amdgcn_readfirstlane(__hip_atomic_load(dcnt + 64 * rt, __ATOMIC_RELAXED, __HIP_MEMORY_SCOPE_AGENT)) < 16u) { if (++sp > (1u << 22)) break; __builtin_amdgcn_s_sleep(2); } }
        asm volatile("s_waitcnt vmcnt(0)" ::: "memory");
    }
    __syncthreads();
}

struct Args { const float* in[28]; float* out; unsigned char* ws; int ph_lo, ph_hi, li, pad; };

__global__ void __launch_bounds__(NWAVES * 64, 2) mega_fwd(Args args) {
    extern __shared__ __attribute__((aligned(16))) unsigned char lds_raw[];
    LAS unsigned char* lds = (LAS unsigned char*)lds_raw;
    volatile LAS unsigned* MISC = (volatile LAS unsigned*)(lds + MISC_OFF);
    const int tid0 = threadIdx.x, wave = __builtin_amdgcn_readfirstlane(tid0 >> 6);
#define PHASE_IDS() int lane = pg8::lane_id(); asm volatile("" : "+v"(lane)); const int tid = wave * 64 + lane; (void)tid
    const int G = gridDim.x;
    const int vcu = (G % 8 == 0) ? ((int)blockIdx.x % 8) * (G / 8) + (int)blockIdx.x / 8 : (int)blockIdx.x;
    unsigned char* ws = args.ws;
    unsigned* ctl = (unsigned*)(ws + WS_CTL);
    for (int u = tid0; u < (LDS_BYTES - LDSCTL_OFF) / 4; u += NWAVES * 64) ((LAS unsigned*)(lds + LDSCTL_OFF))[u] = 0u;
    __syncthreads();
    XcdBarrier bar = xcd_barrier_post(ctl + CW_BAR + args.li * XCD_BAR_WORDS, MISC + 8, wave);
    const int lo = args.ph_lo, hi = args.ph_hi;
#define IN(k) (lo <= (k) && (k) < hi)
#define BOTH(k) (IN(k) && IN((k) + 1))
    const float* const* in = args.in;
    bf16 *XN = (bf16*)(ws + WS_A0), *MG = (bf16*)(ws + WS_A2)  , *X2b = (bf16*)(ws + WS_A0);
    float *RSTD0 = (float*)(ws + WS_RSTD0), *GINV = (float*)(ws + WS_GINV), *SA = (float*)(ws + WS_RSTD1), *SB = (float*)(ws + WS_SB);
    signed char* XNi = (signed char*)(ws + WS_XNI);
    signed char* WinTi = (signed char*)(ws + WS_WIN);
    bf16 *Zl = (bf16*)(ws + WS_A1), *X1b = (bf16*)(ws + WS_A0);
    bf16 *GA = (bf16*)(ws + WS_A2), *UB = (bf16*)(ws + WS_A3), *V = (bf16*)(ws + WS_A4);
    bf16 *X3 = (bf16*)(ws + WS_A3);
    unsigned char* X1q = ws + WS_A1 + 16 * MiB;
    signed char* X2i = (signed char*)(ws + WS_A1);
    float *SX = (float*)(ws + WS_RSTD1) + T, *SG = (float*)(ws + WS_SB) + 8192, *SPU = (float*)(ws + WS_SPU);
    signed char* WgTi = (signed char*)(ws + WS_WG);
    unsigned char* PU = ws + WS_A2;
    bf16 *Pb = (bf16*)(ws + WS_PB);
    bf16 *WinT = (bf16*)(ws + WS_WIN), *WoutT = (bf16*)(ws + WS_WOUT), *WgT = (bf16*)(ws + WS_WG), *W13T = (bf16*)(ws + WS_W13), *W2T = (bf16*)(ws + WS_W2), *WupT = (bf16*)(ws + WS_WUP);
    float *VPART = (float*)(ws + WS_VPART), *SS1 = (float*)(ws + WS_SS1), *SS3 = (float*)(ws + WS_SS3), *RSTD2 = (float*)(ws + WS_RSTD2), *RSTD1 = (float*)(ws + WS_RSTD1), *LISTG = (float*)(ws + WS_LISTG), *LISTR = (float*)(ws + WS_LISTR);
    int *CNT = (int*)(ws + WS_CTL), *LIST = (int*)(ws + WS_LIST), *TOKE = (int*)(ws + WS_TOKE);
    bf16 *Hb = (bf16*)(ws + WS_A2), *Yb = (bf16*)(ws + WS_A3), *WrT = (bf16*)(ws + WS_WR), *WLRU = (bf16*)(ws + WS_WLRU), *WSGU = (bf16*)(ws + WS_WSGU);
    unsigned long long* AGGQ = (unsigned long long*)(ws + WS_AGG); float* SPL8 = (float*)(ws + WS_SPL8);

    if (IN(0)) {
        PHASE_IDS();
        LAS float* scr0 = (LAS float*)lds;
        const bool tab_fast = (G * 512 == 131072);
        float tf_lru = 0.f, tf_sgu = 0.f, tf10 = 0.f, tf2 = 1.f, tfr = 0.f;
        if (tab_fast) {
            const int i = vcu * 512 + tid, gate = i >> 16, h = (i >> 12) & 15, j = (i >> 6) & 63, ii = i & 63;
            const float f_lru = (gate ? in[8] : in[6])[(h * 64 + ii) * 64 + j], f_sgu = in[13][i];
            const int i10 = i < 1024 ? i : 0; const float f10 = in[10][i10], f2 = in[2][i10];
            const int n = (i >> 10) & 63, k = i & 1023; const float fa = in[17][k * 4 + (n < 4 ? n : 0)], fb = in[19][k * 32 + ((n >= 4 && n < 36) ? n - 4 : 0)], fk = in[16][k];
            tf_lru = f_lru; tf_sgu = f_sgu; tf10 = f10; tf2 = f2; tfr = n < 4 ? fa * fk : (n < 36 ? fb * fk : 0.f);
        }
        const int gw = vcu * NWAVES + wave, NGW = G * NWAVES;
        for (int cbx = vcu; cbx < 224; cbx += G) {
            const bool isg = cbx >= 192; const int cb = isg ? cbx - 192 : cbx;
            const int kb8 = lane >> 3, n4 = lane & 7, dr0 = isg ? cb * 32 : win_dest_row(cb * 32);
            const float* wsrc = isg ? in[25] : in[3]; const int wld = isg ? 1024 : 6144; signed char* wdst = isg ? WgTi : WinTi; float* sdst = isg ? SG : SB;
            TrItem t0, t1; tr_load<true>(t0, wsrc, wld, 128 * wave, cb * 32, lane); tr_load<true>(t1, wsrc, wld, 128 * wave + 64, cb * 32, lane);
            if (isg) { const float* gk = in[24] + 128 * wave + 8 * kb8;
#pragma unroll
                for (int q = 0; q < 8; ++q) { t0.v[q] = t0.v[q] * gk[q]; t1.v[q] = t1.v[q] * gk[64 + q]; } }
            pg8::f32x4 cm = {0.f, 0.f, 0.f, 0.f};
#pragma unroll
            for (int q = 0; q < 8; ++q)
#pragma unroll
                for (int i = 0; i < 4; ++i) cm[i] = fmaxf(cm[i], fmaxf(fabsf(t0.v[q][i]), fabsf(t1.v[q][i])));
#pragma unroll
            for (int i = 0; i < 4; ++i) { cm[i] = fmaxf(cm[i], __shfl_xor(cm[i], 8)); cm[i] = fmaxf(cm[i], __shfl_xor(cm[i], 16)); cm[i] = fmaxf(cm[i], __shfl_xor(cm[i], 32)); }
            if (kb8 == 0) *(LAS pg8::f32x4*)(scr0 + wave * 32 + 4 * n4) = cm;
            __syncthreads();
#pragma unroll
            for (int w8 = 0; w8 < 8; ++w8) { const pg8::f32x4 o = *(const LAS pg8::f32x4*)(scr0 + w8 * 32 + 4 * n4);
#pragma unroll
                for (int i = 0; i < 4; ++i) cm[i] = fmaxf(cm[i], o[i]); }
            pg8::f32x4 qs;
#pragma unroll
            for (int i = 0; i < 4; ++i) { cm[i] = fmaxf(cm[i], 1.0e-30f); qs[i] = 127.f / cm[i]; }
            if (wave == 0 && kb8 == 0) *(pg8::f32x4*)(sdst + dr0 + 4 * n4) = cm * (1.f / 127.f);
#pragma unroll
            for (int i = 0; i < 4; ++i) { const float q_ = qs[i]; signed char* dst = wdst + (size_t)(dr0 + 4 * n4 + i) * 1024 + 128 * wave + 8 * kb8;
                *(pg8::u32x2*)dst = (pg8::u32x2){pack4_i8(t0.v[0][i] * q_, t0.v[1][i] * q_, t0.v[2][i] * q_, t0.v[3][i] * q_), pack4_i8(t0.v[4][i] * q_, t0.v[5][i] * q_, t0.v[6][i] * q_, t0.v[7][i] * q_)};
                *(pg8::u32x2*)(dst + 64) = (pg8::u32x2){pack4_i8(t1.v[0][i] * q_, t1.v[1][i] * q_, t1.v[2][i] * q_, t1.v[3][i] * q_), pack4_i8(t1.v[4][i] * q_, t1.v[5][i] * q_, t1.v[6][i] * q_, t1.v[7][i] * q_)}; }
            __syncthreads();
        }
        if (tab_fast) { const int i = vcu * 512 + tid, t = (i >> 7) & 127, s_ = i & 127;
            WLRU[i] = f2bf(tf_lru); WSGU[i] = s_ <= t ? f2bf(tf_sgu) : (bf16)0;
            if (i < 1024) { SPL8[i] = -8.f * log1pf(expf(-tf10)); GINV[i] = 1.f / tf2; }
            if (i < 64 * 1024) WrT[i] = f2bf(tfr); }
        for (int m = gw; m < T; m += 2 * NGW) {
            const int m2 = m + NGW < T ? m + NGW : m;
            const pg8::f32x4* xr = (const pg8::f32x4*)(in[0] + (size_t)m * D) + lane; const pg8::f32x4* xr2 = (const pg8::f32x4*)(in[0] + (size_t)m2 * D) + lane; const pg8::f32x4* gr = (const pg8::f32x4*)in[2] + lane;
            pg8::f32x4 v[4], w[4]; float s = 0.f, s2 = 0.f;
#pragma unroll
            for (int j = 0; j < 4; ++j) { v[j] = __builtin_nontemporal_load(xr + 64 * j); w[j] = __builtin_nontemporal_load(xr2 + 64 * j); }
#pragma unroll
            for (int j = 0; j < 4; ++j) { s += (v[j].x * v[j].x + v[j].y * v[j].y) + (v[j].z * v[j].z + v[j].w * v[j].w); s2 += (w[j].x * w[j].x + w[j].y * w[j].y) + (w[j].z * w[j].z + w[j].w * w[j].w); }
            const float rstd = rsqrtf(wave_sum(s) * (1.f / D) + EPS), rstd2 = rsqrtf(wave_sum(s2) * (1.f / D) + EPS);
            if (lane == 0) { RSTD0[m] = 1.f / rstd; RSTD0[m2] = 1.f / rstd2; }
            unsigned long long* o8 = (unsigned long long*)(XN + (size_t)m * D) + lane; unsigned long long* o82 = (unsigned long long*)(XN + (size_t)m2 * D) + lane;
            float mx = 0.f, mx2 = 0.f;
#pragma unroll
            for (int j = 0; j < 4; ++j) { const pg8::f32x4 gg = gr[64 * j]; v[j] = v[j] * rstd * gg; w[j] = w[j] * rstd2 * gg;
                mx = fmaxf(fmaxf(mx, fmaxf(fabsf(v[j].x), fabsf(v[j].y))), fmaxf(fabsf(v[j].z), fabsf(v[j].w))); mx2 = fmaxf(fmaxf(mx2, fmaxf(fabsf(w[j].x), fabsf(w[j].y))), fmaxf(fabsf(w[j].z), fabsf(w[j].w)));
                o8[64 * j] = (unsigned long long)pk2(v[j].x, v[j].y) | ((unsigned long long)pk2(v[j].z, v[j].w) << 32);
                o82[64 * j] = (unsigned long long)pk2(w[j].x, w[j].y) | ((unsigned long long)pk2(w[j].z, w[j].w) << 32); }
            mx = fmaxf(wave_max(mx), 1.0e-30f); mx2 = fmaxf(wave_max(mx2), 1.0e-30f);
            const float qi = 127.f / mx, qi2 = 127.f / mx2;
            if (lane == 0) { SA[m] = mx * (1.f / 127.f); SA[m2] = mx2 * (1.f / 127.f); }
            unsigned* i8 = (unsigned*)(XNi + (size_t)m * D) + lane; unsigned* i82 = (unsigned*)(XNi + (size_t)m2 * D) + lane;
#pragma unroll
            for (int j = 0; j < 4; ++j) { i8[64 * j] = pack4_i8(v[j].x * qi, v[j].y * qi, v[j].z * qi, v[j].w * qi); i82[64 * j] = pack4_i8(w[j].x * qi2, w[j].y * qi2, w[j].z * qi2, w[j].w * qi2); }
        }
        if (!tab_fast) {
        for (int i = vcu * 512 + tid; i < 2 * 16 * 64 * 64; i += G * 512) { const int gate = i >> 16, h = (i >> 12) & 15, j = (i >> 6) & 63, ii = i & 63;
            WLRU[i] = f2bf(in[gate ? 8 : 6][(h * 64 + ii) * 64 + j]); }
        for (int i = vcu * 512 + tid; i < 8 * 128 * 128; i += G * 512) { const int t = (i >> 7) & 127, s = i & 127; WSGU[i] = s <= t ? f2bf(in[13][i]) : (bf16)0; }
        for (int i = vcu * 512 + tid; i < 1024; i += G * 512) { SPL8[i] = -8.f * log1pf(expf(-in[10][i])); GINV[i] = 1.f / in[2][i]; }
        for (int i = vcu * 512 + tid; i < 64 * 1024; i += G * 512) { const int n = i >> 10, k = i & 1023; float v = 0.f;
            if (n < 4) v = in[17][k * 4 + n] * in[16][k]; else if (n < 36) v = in[19][k * 32 + (n - 4)] * in[16][k];
            WrT[i] = f2bf(v); }
        }
        if (BOTH(0)) xcd_barrier(bar);
    }
    if (IN(1)) {
        { pg8::Gemm g{(const bf16*)XNi, (const bf16*)WinTi, 512}; Gemm1Order S;   S.init(T, 6144, G, (int)blockIdx.x);
          S.wave = wave; { const int upw = (64 * 24) / G > 0 ? (64 * 24) / G : 1; const int c_ = (int)blockIdx.x; S.gi = c_ % upw; if (upw == 6) S.gi = 5 * ((c_ >> 3) & 1); }     S.w = DefW{args.in, ws};
          S.lds = lds;
          { PHASE_IDS(); for (int i = tid; i < 1024; i += NWAVES * 64) ((LAS float*)(lds + Gemm1Order::GAIN_OFF))[i] = in[16][i]; }
          pg8::Epi1 E{Zl, GA, UB, V, VPART, SA, SB, lds};
          pg8::gemm_phase<pg8::Epi1, Gemm1Order, true, true, false, 2>(lds, g, S, E, wave); }
        if (BOTH(1)) xcd_barrier(bar);
    }

    if (IN(3)) {
        PHASE_IDS();
        mixer_phase(lds, vcu, G, tid, lane, wave, Zl, GA, UB, V, VPART, AGGQ, MG, ctl + CW_MIX, WLRU, WSGU, SPL8, in);
    }
    if (IN(4)) {
        pg8::Gemm g{MG, WoutT, 1024}; pg8::StaticOrder S; S.init(T, 1024, G, (int)blockIdx.x);
        const int one = (S.nwg <= G) ? 1 : 0;
        pg8::Epi2 E{XN, RSTD0, GINV, X1b, SS1, (BOTH(3) && one) ? ctl + CW_MIX : nullptr, one, wave};
        if (BOTH(3) && !one) {
            if (wave == 0) { pg8::Unit u0; asm volatile("buffer_inv sc1" ::: "memory");
                for (int i = 0; S.next(i, u0); ++i) { unsigned sp = 0;
                    while ((unsigned)__builtin_amdgcn_readfirstlane(__hip_atomic_load(ctl + CW_MIX + 64 * u0.pm, __ATOMIC_RELAXED, __HIP_MEMORY_SCOPE_AGENT)) < 128u) { if (++sp > (1u << 22)) break; __builtin_amdgcn_s_sleep(2); } }
                asm volatile("s_waitcnt vmcnt(0)" ::: "memory"); }
            __syncthreads();
        }
        pg8::gemm_phase<pg8::Epi2, pg8::StaticOrder, true, true, false>(lds, g, S, E, wave);
        if (BOTH(4)) xcd_barrier(bar);
    }

    if (IN(5)) {
        PHASE_IDS();
        constexpr int LS = 52;
        LAS float* sP = (LAS float*)lds;
        LAS float* sL = (LAS float*)(lds + 8 * 64 * LS * 4);
        LAS int* sCnt = (LAS int*)(lds + 9 * 64 * LS * 4); LAS int* sBase = sCnt + 32;
        const int fr = lane & 15, grp = lane >> 4;
        for (int tile = vcu; tile < T / 64; tile += G) {
            const int tok0 = tile * 64;
            if (tid < 32) sCnt[tid] = 0;
            pg8::bf16x8 a[4][4], b[3][4];
#pragma unroll
            for (int mt = 0; mt < 4; ++mt)
#pragma unroll
                for (int ks = 0; ks < 4; ++ks) a[mt][ks] = *(const pg8::bf16x8*)(X1b + (size_t)(tok0 + 16 * mt + fr) * D + wave * 128 + ks * 32 + 8 * grp);
#pragma unroll
            for (int nt = 0; nt < 3; ++nt)
#pragma unroll
                for (int ks = 0; ks < 4; ++ks) b[nt][ks] = *(const pg8::bf16x8*)(WrT + (size_t)(16 * nt + fr) * D + wave * 128 + ks * 32 + 8 * grp);
            pg8::f32x4 q0 = {0.f, 0.f, 0.f, 0.f}, q1 = q0, q2 = q0, q3 = q0;
#pragma unroll
            for (int mt = 0; mt < 4; ++mt)
#pragma unroll
                for (int ks = 0; ks < 4; ++ks) { pg8::f32x4 e0, e1; pg8::unpack8(__builtin_bit_cast(pg8::u32x4, a[mt][ks]), e0, e1);
                    *(pg8::u32x2*)(X1q + (size_t)(tok0 + 16 * mt + fr) * D + wave * 128 + ks * 32 + 8 * grp) = pg8::pack8_fp8(e0, e1); }
            if (tid < 64) { const float* sp = SS1 + (size_t)(tok0 + tid) * 16; q0 = *(const pg8::f32x4*)sp; q1 = *(const pg8::f32x4*)(sp + 4); q2 = *(const pg8::f32x4*)(sp + 8); q3 = *(const pg8::f32x4*)(sp + 12); }
#pragma unroll
            for (int mt = 0; mt < 4; ++mt)
#pragma unroll
                for (int nt = 0; nt < 3; ++nt) { pg8::f32x4 acc = {0.f, 0.f, 0.f, 0.f};
#pragma unroll
                    for (int ks = 0; ks < 4; ++ks) acc = __builtin_amdgcn_mfma_f32_16x16x32_bf16(a[mt][ks], b[nt][ks], acc, 0, 0, 0);
#pragma unroll
                    for (int r = 0; r < 4; ++r) sP[(wave * 64 + 16 * mt + 4 * grp + r) * LS + 16 * nt + fr] = acc[r]; }
            __syncthreads();
            { const int tk = tid >> 3, c0 = (tid & 7) * 6;
#pragma unroll
              for (int c = 0; c < 6; ++c) { float sum = 0.f;
#pragma unroll
                  for (int w = 0; w < 8; ++w) sum += sP[(w * 64 + tk) * LS + c0 + c];
                  sL[tk * LS + c0 + c] = sum; } }
            __syncthreads();
            int e1 = 0, e2 = 0, r1 = 0, r2 = 0; float g1 = 0.f, g2 = 0.f, rstd = 0.f;
            if (tid < 64) {
                const int t = tok0 + tid;
                const pg8::f32x4 qs = (q0 + q1) + (q2 + q3);
                const float ss = (qs[0] + qs[1]) + (qs[2] + qs[3]);
                rstd = rsqrtf(ss * (1.f / D) + EPS);
                const LAS float* l = sL + tid * LS;
                float gl[4];
#pragma unroll
                for (int q = 0; q < 4; ++q) gl[q] = rstd * l[q] + in[18][q];
                float mx = gl[0]; int gi = 0;
#pragma unroll
                for (int q = 1; q < 4; ++q) if (gl[q] > mx) { mx = gl[q]; gi = q; }
                float den = 0.f;
#pragma unroll
                for (int q = 0; q < 4; ++q) den += expf(gl[q] - mx);
                const float gtop = 1.f / den;
                float m1 = -3.0e38f, m2 = -3.0e38f; int i1 = 0, i2 = 0;
                for (int j = 0; j < 8; ++j) { const float v = rstd * l[4 + gi * 8 + j] + in[20][gi * 8 + j];
                    if (v > m1) { m2 = m1; i2 = i1; m1 = v; i1 = j; } else if (v > m2) { m2 = v; i2 = j; } }
                const float p2 = expf(m2 - m1);
                g1 = gtop / (1.f + p2); g2 = gtop * p2 / (1.f + p2);
                e1 = gi * 8 + i1; e2 = gi * 8 + i2;
                r1 = __hip_atomic_fetch_add(&sCnt[e1], 1, __ATOMIC_RELAXED, __HIP_MEMORY_SCOPE_WORKGROUP); r2 = __hip_atomic_fetch_add(&sCnt[e2], 1, __ATOMIC_RELAXED, __HIP_MEMORY_SCOPE_WORKGROUP);
            }
            __syncthreads();
            if (tid < 32) { const int c = sCnt[tid]; sBase[tid] = c ? atomicAdd(&CNT[tid], c) : 0; }
            __syncthreads();
            if (tid < 64) { const int t = tok0 + tid, p1 = e1 * 16384 + sBase[e1] + r1, p2 = e2 * 16384 + sBase[e2] + r2;
                LIST[p1] = t * 2; LIST[p2] = t * 2 + 1; LISTG[p1] = g1; LISTG[p2] = g2; LISTR[p1] = rstd; LISTR[p2] = rstd; }
            __syncthreads();
        }
        if (BOTH(5)) xcd_barrier(bar);
    }
    if (IN(6)) {
        LAS int* tab1 = (LAS int*)(lds + TAB_OFF); LAS int* tab2 = (LAS int*)(lds + TAB_OFF + 512); LAS int* tab3 = (LAS int*)(lds + TAB_OFF + 1024);
        build_moe_units(tab1, tab2, tab3, CNT, vcu, G, wave, (LAS int*)lds);
        unsigned* dcnt = ctl + CW_DONE1;
        { pg8::Gemm g{(const bf16*)X1q, W13T, 512}; pg8::MoeOrder<1> S{tab1, LIST, dcnt, 1024u};
          pg8::EpiMoe1 E{(unsigned char*)Hb, LISTR, lds};
          pg8::gemm_phase<pg8::EpiMoe1, pg8::MoeOrder<1>, true, true, true, 1>(lds, g, S, E, wave); }
        pg8::Gemm g2{Hb, W2T, 128}; pg8::EpiMoe2 E2{(unsigned char*)Yb, LIST, LISTG, lds};
#pragma unroll 1
        for (int pass = 0; pass < 2; ++pass) {
            LAS int* const tb = pass ? tab3 : tab2;
            moe_wait_tiles(tb, dcnt, wave);
            pg8::MoeOrder<0> S{tb, LIST, dcnt, 2048u}; pg8::gemm_phase<pg8::EpiMoe2, pg8::MoeOrder<0>, true, true, false, 1>(lds, g2, S, E2, wave);
        }
        if (BOTH(6) && !((G == 256) && IN(9))) xcd_barrier(bar);
    }
    const bool fuse_final = (G == 256);
    if (IN(8) && !fuse_final) {
        const bool split = (G % 16 == 0);
        const int q8 = (int)blockIdx.x >> 3, x8 = (int)blockIdx.x & 7;
        const bool do_gemm = !split || (q8 & 1), do_comb = !split || !(q8 & 1);
        if (do_comb) {
            PHASE_IDS();
            const int NGW = (split ? G / 2 : G) * NWAVES, gw = (split ? (q8 >> 1) * 8 + x8 : vcu) * NWAVES + wave;
            for (int row = gw; row < T; row += 2 * NGW) {
                const int row2 = row + NGW; const bool two = row2 < T; const int rb = two ? row2 : row;
                pg8::u32x4 la[2][2]; pg8::u32x2 lb[2][2], lc[2][2];
#pragma unroll
                for (int rr = 0; rr < 2; ++rr)
#pragma unroll
                    for (int hh = 0; hh < 2; ++hh) { const int r = rr ? rb : row;
                        la[rr][hh] = __builtin_nontemporal_load((const pg8::u32x4*)(X1b + (size_t)r * D + hh * 512 + lane * 8));
                        lb[rr][hh] = __builtin_nontemporal_load((const pg8::u32x2*)((const unsigned char*)Yb + (size_t)r * 2 * D + hh * 512 + lane * 8));
                        lc[rr][hh] = __builtin_nontemporal_load((const pg8::u32x2*)((const unsigned char*)Yb + ((size_t)r * 2 + 1) * D + hh * 512 + lane * 8)); }
#pragma unroll
                for (int rr = 0; rr < 2; ++rr) { const int r = rr ? rb : row; float ss = 0.f, mx = 0.f; pg8::f32x4 av[2][2];
#pragma unroll
                    for (int hh = 0; hh < 2; ++hh) { pg8::f32x4 a0, a1, b0, b1, c0, c1; pg8::unpack8(la[rr][hh], a0, a1); pg8::unpack8_fp8(lb[rr][hh], b0, b1); pg8::unpack8_fp8(lc[rr][hh], c0, c1);
                        a0 = a0 + (b0 + c0) * (1.f / 16.f); a1 = a1 + (b1 + c1) * (1.f / 16.f);
                        ss += pg8::hsum4(a0 * a0 + a1 * a1);
#pragma unroll
                        for (int i = 0; i < 4; ++i) mx = fmaxf(mx, fmaxf(fabsf(a0[i]), fabsf(a1[i])));
                        av[hh][0] = a0; av[hh][1] = a1; }
                    ss = wave_sum(ss); mx = fmaxf(wave_max(mx), 1.0e-30f);
                    const float qx = 127.f / mx;
                    if (rr == 0 || two) {
#pragma unroll
                        for (int hh = 0; hh < 2; ++hh) { const pg8::f32x4 a0 = av[hh][0] * qx, a1 = av[hh][1] * qx;
                            *(pg8::u32x2*)(X2i + (size_t)r * D + hh * 512 + lane * 8) = (pg8::u32x2){pack4_i8(a0[0], a0[1], a0[2], a0[3]), pack4_i8(a1[0], a1[1], a1[2], a1[3])}; }
                        if (lane == 0) { RSTD2[r] = rsqrtf(ss * (1.f / D) + EPS); SX[r] = mx * (1.f / 127.f); } } }
            }
        }
        if (do_gemm) {
            pg8::Gemm g{Pb, WupT, 256}; pg8::StaticOrder S; S.init(T, 1024, split ? G / 2 : G, split ? (q8 >> 1) * 8 + x8 : (int)blockIdx.x);
            pg8::EpiPlain E{PU, SPU};
            pg8::gemm_phase<pg8::EpiPlain, pg8::StaticOrder, true, true, false>(lds, g, S, E, wave);
        }
        if (BOTH(8)) xcd_barrier(bar);
    }
    if (IN(9)) {
        pg8::Gemm g{(const bf16*)X2i, (const bf16*)WgTi, 512}; pg8::StaticOrder S; S.init(T, 1024, G, (int)blockIdx.x);
        if (fuse_final) {
            pg8::Unit u0; S.next(0, u0);
            { PHASE_IDS();
              const bool hb = IN(6);
              signed char* const X2p = (signed char*)X1b;
              const int r0 = u0.pm * 256 + u0.pn * 64 + (wave == 0 ? 63 : (wave - 1) * 9), rstep = wave == 0 ? 0 : 1;
              pg8::u32x4 la[9][2];
              if (hb) xcd_barrier_begin();
              if (wave != 0) {
#pragma unroll
                  for (int i = 0; i < 9; ++i)
#pragma unroll
                      for (int hh = 0; hh < 2; ++hh) la[i][hh] = __builtin_nontemporal_load((const pg8::u32x4*)(X1b + (size_t)(r0 + i * rstep) * D + hh * 512 + lane * 8));
              } else { if (hb) xcd_barrier_protocol(bar);
#pragma unroll
                  for (int i = 0; i < 9; ++i)
#pragma unroll
                      for (int hh = 0; hh < 2; ++hh) la[i][hh] = __builtin_nontemporal_load((const pg8::u32x4*)(X1b + (size_t)(r0 + i * rstep) * D + hh * 512 + lane * 8));
              }
              if (hb) __syncthreads();
              pg8::u32x2 lb[9][2], lc[9][2];
#pragma unroll
              for (int i = 0; i < 9; ++i)
#pragma unroll
                  for (int hh = 0; hh < 2; ++hh) { const int r = r0 + i * rstep;
                      lb[i][hh] = __builtin_nontemporal_load((const pg8::u32x2*)((const unsigned char*)Yb + (size_t)r * 2 * D + hh * 512 + lane * 8));
                      lc[i][hh] = __builtin_nontemporal_load((const pg8::u32x2*)((const unsigned char*)Yb + ((size_t)r * 2 + 1) * D + hh * 512 + lane * 8)); }
#pragma unroll
              for (int i = 0; i < 9; ++i) { const int r = r0 + i * rstep; float ss = 0.f, mx = 0.f; pg8::f32x4 av[2][2];
#pragma unroll
                  for (int hh = 0; hh < 2; ++hh) { pg8::f32x4 a0, a1, b0, b1, c0, c1; pg8::unpack8(la[i][hh], a0, a1); pg8::unpack8_fp8(lb[i][hh], b0, b1); pg8::unpack8_fp8(lc[i][hh], c0, c1);
                      a0 = a0 + (b0 + c0) * (1.f / 16.f); a1 = a1 + (b1 + c1) * (1.f / 16.f);
                      ss += pg8::hsum4(a0 * a0 + a1 * a1);
#pragma unroll
                      for (int q = 0; q < 4; ++q) mx = fmaxf(mx, fmaxf(fabsf(a0[q]), fabsf(a1[q])));
                      av[hh][0] = a0; av[hh][1] = a1; }
                  ss = wave_sum(ss); mx = fmaxf(wave_max(mx), 1.0e-30f);
                  const float qx = 127.f / mx;
#pragma unroll
                  for (int hh = 0; hh < 2; ++hh) { const pg8::f32x4 a0 = av[hh][0] * qx, a1 = av[hh][1] * qx;
                      pg8::store8_sc1(X2p + (size_t)r * 2 * D + hh * 512 + lane * 8, (pg8::u32x2){pack4_i8(a0[0], a0[1], a0[2], a0[3]), pack4_i8(a1[0], a1[1], a1[2], a1[3])}); }
                  if (lane == 0) { __hip_atomic_store(RSTD2 + r, rsqrtf(ss * (1.f / D) + EPS), __ATOMIC_RELAXED, __HIP_MEMORY_SCOPE_AGENT); __hip_atomic_store(SX + r, mx * (1.f / 127.f), __ATOMIC_RELAXED, __HIP_MEMORY_SCOPE_AGENT); } }
              asm volatile("s_waitcnt vmcnt(0)" ::: "memory");
              if (lane == 0) __hip_atomic_fetch_add(ctl + CW_X2 + 64 * u0.pm, 1u, __ATOMIC_RELAXED, __HIP_MEMORY_SCOPE_AGENT);
            }
            { pg8::Gemm gp{Pb, WupT, 256}; pg8::EpiPlain Ep{PU, SPU};
              pg8::gemm_phase<pg8::EpiPlain, pg8::StaticOrder, true, true, false>(lds, gp, S, Ep, wave); }
            if (wave == 0) { unsigned sp = 0; asm volatile("buffer_inv sc1" ::: "memory");
                while ((unsigned)__builtin_amdgcn_readfirstlane(__hip_atomic_load(ctl + CW_X2 + 64 * u0.pm, __ATOMIC_RELAXED, __HIP_MEMORY_SCOPE_AGENT)) < 32u) { if (++sp > (1u << 22)) break; __builtin_amdgcn_s_sleep(2); }
                asm volatile("s_waitcnt vmcnt(0)" ::: "memory"); }
            __syncthreads();
            pg8::EpiPleFinal E{(const signed char*)X1b, SX, SG, PU, SPU, RSTD2, in[27], args.out, (float*)(ws + WS_XCH), ctl + CW_PANEL, (LAS float*)(lds + RING_BYTES), wave, 2 * D};
            pg8::Gemm g2{X1b, (const bf16*)WgTi, 512, 1024};
            pg8::gemm_phase<pg8::EpiPleFinal, pg8::StaticOrder, true, true, false, 2>(lds, g2, S, E, wave);
        } else {
            pg8::EpiPle E{X2i, SX, SG, PU, SPU, RSTD2, X3, SS3};
            pg8::gemm_phase<pg8::EpiPle, pg8::StaticOrder, true, true, false, 2>(lds, g, S, E, wave);
            if (BOTH(9)) xcd_barrier(bar);
        }
    }

    if (IN(10) && !fuse_final) {
        PHASE_IDS();
        const int gw = vcu * NWAVES + wave, NGW = G * NWAVES;
        for (int row = gw; row < T; row += NGW) { float ss = 0.f;
            if (lane < 16) ss = SS3[(size_t)row * 16 + lane];
            ss = wave_sum(ss);
            const float rstd = rsqrtf(ss * (1.f / D) + EPS);
#pragma unroll
            for (int hh = 0; hh < 2; ++hh) { const size_t o = (size_t)row * D + hh * 512 + lane * 8; pg8::f32x4 a0, a1; pg8::unpack8(*(const pg8::u32x4*)(X3 + o), a0, a1);
                const pg8::f32x4 f0 = *(const pg8::f32x4*)(in[27] + hh * 512 + lane * 8), f1 = *(const pg8::f32x4*)(in[27] + hh * 512 + lane * 8 + 4);
                *(pg8::f32x4*)(args.out + o) = a0 * rstd * f0; *(pg8::f32x4*)(args.out + o + 4) = a1 * rstd * f1; } }
    }
#undef IN
#undef BOTH
#undef PHASE_IDS
}

static int mega_grid() {
    static int grid = 0;
    if (grid == 0) {
        int dev = 0, cus = 0;
        if (hipGetDevice(&dev) != hipSuccess || hipDeviceGetAttribute(&cus, hipDeviceAttributeMultiprocessorCount, dev) != hipSuccess) { fprintf(stderr, "mega: device query failed\n"); grid = -1; return grid; }
        if (hipFuncSetAttribute((const void*)mega_fwd, hipFuncAttributeMaxDynamicSharedMemorySize, LDS_BYTES) != hipSuccess) { fprintf(stderr, "mega: hipFuncSetAttribute failed\n"); grid = -1; return grid; }
        (void)hipGetLastError();
        grid = cus;
    }
    return grid;
}
static void launch_mega(void* const* d_in, void* d_out, void* d_ws, int lo, int hi, int li, hipStream_t stream) {
    const int grid = mega_grid(); if (grid <= 0) return;
    Args a{};
    for (int i = 0; i < 28; ++i) a.in[i] = (const float*)d_in[i];
    a.out = (float*)d_out; a.ws = (unsigned char*)d_ws; a.ph_lo = lo; a.ph_hi = hi; a.li = li; a.pad = 0;
    hipLaunchKernelGGL(mega_fwd, dim3(grid), dim3(NWAVES * 64), LDS_BYTES, stream, a);
}

extern "C" void kernel_launch(void* const* d_in, const int* in_sizes, int n_in, void* d_out, int out_size, void* d_ws, size_t ws_size, hipStream_t stream) {
    if (n_in != 28 || in_sizes[0] != T * D || out_size != T * D || ws_size < WS_MEGA_END) { fprintf(stderr, "kernel_launch: unexpected shapes (n_in %d, ws %zu)\n", n_in, ws_size); return; }
    (void)hipMemsetAsync(d_ws, 0, 2 * MiB, stream);
    launch_mega(d_in, d_out, d_ws, 0, 11, 0, stream);
}
```
